# Optimizing an MI355X kernel written in HIP

```python
import jax, jax.numpy as jnp
from jax import lax
import numpy as np

D_MODEL = 1024
BATCH = 2
SEQ = 8192
DEPTH = 1

EPS = 1e-6
NEG_INF = -1e30
FORCE_SCORE = 1e9
ROPE_THETA = 500000.0
Q_BLOCK = 128

A_HEADS = 8
A_KV_HEADS = 2
A_HEAD_DIM = 64
A_ROPE_DIM = A_HEAD_DIM // 4
CMP_LEN = 32
CMP_STRIDE = 16
CMP_HIDDEN = 256
SLC_LEN = 64
SLC_TOPK = 16
WINDOW = 512
A_WIDTH = A_HEADS * A_HEAD_DIM
A_KV_WIDTH = A_KV_HEADS * A_HEAD_DIM

B_HEADS = 8
Q_LORA = 256
KV_LORA = 128
B_NOPE = 64
B_ROPE = 32
B_V = 64
B_QK = B_NOPE + B_ROPE
B_WIDTH = B_HEADS * B_V

MIX_WIDTH = A_WIDTH + B_WIDTH
IN_SIZES = (A_WIDTH, A_KV_WIDTH, A_KV_WIDTH, A_KV_WIDTH, A_KV_WIDTH, A_KV_WIDTH, A_KV_WIDTH,
            3 * A_HEADS, Q_LORA, KV_LORA, B_ROPE)
IN_WIDTH = sum(IN_SIZES)

P_HEADS = 8
N_KEYS = 128
N_EXPERTS = N_KEYS * N_KEYS
P_KEY_DIM = 256
P_TOPK = 16
P_CHUNK = 128

kernel_name = 'hybrid_nsa_mla_peer_layer'


def _rms(x):
    xf = x.astype(jnp.float32)
    return xf * lax.rsqrt(jnp.mean(xf * xf, axis=-1, keepdims=True) + EPS)


def rmsnorm(x, gain):
    return (_rms(x) * gain.astype(jnp.float32)).astype(x.dtype)


def rope_tables(pos, rot_dim):
    inv_freq = ROPE_THETA ** (-jnp.arange(0, rot_dim, 2, dtype=jnp.float32) / rot_dim)
    ang = pos.astype(jnp.float32)[..., None] * inv_freq
    return jnp.cos(ang), jnp.sin(ang)


def apply_rope(x, cos, sin):
    half = cos.shape[-1]
    xf = x.astype(jnp.float32)
    x1, x2, rest = xf[..., :half], xf[..., half:2 * half], xf[..., 2 * half:]
    out = jnp.concatenate([x1 * cos - x2 * sin, x2 * cos + x1 * sin, rest], axis=-1)
    return out.astype(x.dtype)


def masked_softmax(s, mask):
    s = jnp.where(mask, s.astype(jnp.float32), NEG_INF)
    p = jax.nn.softmax(s, axis=-1)
    return jnp.where(mask, p, 0.0)


def nsa_mixer(q, k_cmp, v_cmp, k_slc, v_slc, k_win, v_win, gates, positions,
              q_gain, kc_gain, ks_gain, kw_gain, cmp_pos, cmp_k_w1, cmp_k_w2, cmp_v_w1, cmp_v_w2):
    B, S = q.shape[:2]
    G, R, dk = A_KV_HEADS, A_HEADS // A_KV_HEADS, A_HEAD_DIM
    scale = dk ** -0.5
    cos, sin = rope_tables(positions, A_ROPE_DIM)
    cos_h, sin_h = cos[:, :, None, :], sin[:, :, None, :]
    q = apply_rope(rmsnorm(q, q_gain), cos_h, sin_h)
    k_slc = apply_rope(rmsnorm(k_slc, ks_gain), cos_h, sin_h)
    k_win = apply_rope(rmsnorm(k_win, kw_gain), cos_h, sin_h)

    n_cmp = (S - CMP_LEN) // CMP_STRIDE + 1
    cmp_idx = jnp.arange(n_cmp)[:, None] * CMP_STRIDE + jnp.arange(CMP_LEN)[None, :]
    cmp_start, cmp_end = cmp_idx[:, 0], cmp_idx[:, -1]

    def compress(t, w1, w2):
        blk = t[:, cmp_idx] + cmp_pos[:, None, :]
        blk = blk.transpose(0, 1, 3, 2, 4).reshape(B, n_cmp, G, CMP_LEN * dk)
        return jax.nn.gelu(blk @ w1) @ w2

    kc = compress(k_cmp, cmp_k_w1, cmp_k_w2)
    vc = compress(v_cmp, cmp_v_w1, cmp_v_w2)
    cos_c, sin_c = rope_tables(positions[:, cmp_end], A_ROPE_DIM)
    kc = apply_rope(rmsnorm(kc, kc_gain), cos_c[:, :, None, :], sin_c[:, :, None, :])

    n_slc = S // SLC_LEN
    topk = min(SLC_TOPK, n_slc)
    slc_start = jnp.arange(n_slc) * SLC_LEN
    overlap = ((cmp_start[:, None] < slc_start[None, :] + SLC_LEN)
               & (cmp_end[:, None] >= slc_start[None, :])).astype(jnp.float32)
    ks_blocks = k_slc.reshape(B, n_slc, SLC_LEN, G, dk).transpose(0, 3, 1, 2, 4)
    vs_blocks = v_slc.reshape(B, n_slc, SLC_LEN, G, dk).transpose(0, 3, 1, 2, 4)

    pad = ((0, 0), (WINDOW, 0), (0, 0), (0, 0))
    kw_pad, vw_pad = jnp.pad(k_win, pad), jnp.pad(v_win, pad)

    def block(qb):
        q0 = qb * Q_BLOCK
        t = q0 + jnp.arange(Q_BLOCK)
        qblk = lax.dynamic_slice_in_dim(q, q0, Q_BLOCK, axis=1).reshape(B, Q_BLOCK, G, R, dk)
        gblk = lax.dynamic_slice_in_dim(gates, q0, Q_BLOCK, axis=1).reshape(B, Q_BLOCK, G, R, 3)

        s_c = jnp.einsum('bqgrd,bngd->bgrqn', qblk, kc) * scale
        p_c = masked_softmax(s_c, cmp_end[None, :] <= t[:, None])
        o_c = jnp.einsum('bgrqn,bngd->bqgrd', p_c.astype(vc.dtype), vc)

        imp = jnp.einsum('bgrqn,nj->bgqj', p_c, overlap)
        j = jnp.arange(n_slc)
        forced = (j[None, :] == (t // SLC_LEN)[:, None]) | (j[None, :] == 0)
        causal_blk = slc_start[None, :] <= t[:, None]
        imp = jnp.where(forced, FORCE_SCORE, jnp.where(causal_blk, imp, NEG_INF))
        _, sel = lax.top_k(imp, topk)
        flat = sel.reshape(B, G, Q_BLOCK * topk)[..., None, None]
        ks = jnp.take_along_axis(ks_blocks, flat, axis=2).reshape(B, G, Q_BLOCK, topk * SLC_LEN, dk)
        vs = jnp.take_along_axis(vs_blocks, flat, axis=2).reshape(B, G, Q_BLOCK, topk * SLC_LEN, dk)
        tok = (sel[..., None] * SLC_LEN + jnp.arange(SLC_LEN)).reshape(B, G, Q_BLOCK, topk * SLC_LEN)
        mask_s = (tok <= t[:, None])[:, :, None]
        s_s = jnp.einsum('bqgrd,bgqsd->bgrqs', qblk, ks) * scale
        p_s = masked_softmax(s_s, mask_s)
        o_s = jnp.einsum('bgrqs,bgqsd->bqgrd', p_s.astype(vs.dtype), vs)

        kw = lax.dynamic_slice_in_dim(kw_pad, q0, Q_BLOCK + WINDOW, axis=1)
        vw = lax.dynamic_slice_in_dim(vw_pad, q0, Q_BLOCK + WINDOW, axis=1)
        s_pos = q0 - WINDOW + jnp.arange(Q_BLOCK + WINDOW)
        mask_w = ((s_pos[None, :] <= t[:, None]) & (s_pos[None, :] > t[:, None] - WINDOW)
                  & (s_pos[None, :] >= 0))
        s_w = jnp.einsum('bqgrd,bsgd->bgrqs', qblk, kw) * scale
        p_w = masked_softmax(s_w, mask_w)
        o_w = jnp.einsum('bgrqs,bsgd->bqgrd', p_w.astype(vw.dtype), vw)

        return gblk[..., 0:1] * o_c + gblk[..., 1:2] * o_s + gblk[..., 2:3] * o_w

    out = lax.map(block, jnp.arange(S // Q_BLOCK))
    return out.transpose(1, 0, 2, 3, 4, 5).reshape(B, S, A_WIDTH)


def mla_mixer(c_q, c_kv, k_rope, positions, q_lora_gain, w_uq, kv_lora_gain, w_ukv, q_gain, k_gain):
    B, S = c_q.shape[:2]
    H = B_HEADS
    cos, sin = rope_tables(positions, B_ROPE)
    cos_h, sin_h = cos[:, :, None, :], sin[:, :, None, :]
    q = (rmsnorm(c_q, q_lora_gain) @ w_uq).reshape(B, S, H, B_QK)
    kv = (rmsnorm(c_kv, kv_lora_gain) @ w_ukv).reshape(B, S, H, B_NOPE + B_V)
    k_nope, v = kv[..., :B_NOPE], kv[..., B_NOPE:]
    k = jnp.concatenate([k_nope, jnp.broadcast_to(k_rope[:, :, None, :], (B, S, H, B_ROPE))], axis=-1)
    q, k = rmsnorm(q, q_gain), rmsnorm(k, k_gain)
    q = jnp.concatenate([q[..., :B_NOPE], apply_rope(q[..., B_NOPE:], cos_h, sin_h)], axis=-1)
    k = jnp.concatenate([k[..., :B_NOPE], apply_rope(k[..., B_NOPE:], cos_h, sin_h)], axis=-1)
    scale = B_QK ** -0.5
    key_idx = jnp.arange(S)

    def block(qb):
        q0 = qb * Q_BLOCK
        t = q0 + jnp.arange(Q_BLOCK)
        qblk = lax.dynamic_slice_in_dim(q, q0, Q_BLOCK, axis=1)
        s = jnp.einsum('bqhd,bshd->bhqs', qblk, k) * scale
        p = masked_softmax(s, key_idx[None, :] <= t[:, None])
        return jnp.einsum('bhqs,bshd->bqhd', p.astype(v.dtype), v)

    out = lax.map(block, jnp.arange(S // Q_BLOCK))
    return out.transpose(1, 0, 2, 3, 4).reshape(B, S, B_WIDTH)


def peer_ffn(x, w_q, sub_keys, expert_u, expert_v):
    B, S, D = x.shape
    T = B * S
    xt = x.reshape(T, D)
    q = _rms((xt @ w_q).reshape(T, P_HEADS, P_KEY_DIM)).astype(x.dtype)
    half = P_KEY_DIM // 2
    s1 = jnp.einsum('thd,hnd->thn', q[..., :half], sub_keys[:, 0]).astype(jnp.float32)
    s2 = jnp.einsum('thd,hnd->thn', q[..., half:], sub_keys[:, 1]).astype(jnp.float32)
    v1, i1 = lax.top_k(s1, P_TOPK)
    v2, i2 = lax.top_k(s2, P_TOPK)
    cand = (v1[..., :, None] + v2[..., None, :]).reshape(T, P_HEADS, P_TOPK * P_TOPK)
    vals, ci = lax.top_k(cand, P_TOPK)
    e = (jnp.take_along_axis(i1, ci // P_TOPK, axis=-1) * N_KEYS
         + jnp.take_along_axis(i2, ci % P_TOPK, axis=-1))
    g = jax.nn.softmax(vals, axis=-1)
    n_chunks = T // P_CHUNK

    def chunk(args):
        xc, ec, gc = args
        a = jnp.einsum('cd,ckd->ck', xc, expert_u[ec])
        w = (gc * jax.nn.gelu(a.astype(jnp.float32))).astype(x.dtype)
        return jnp.einsum('ck,ckd->cd', w, expert_v[ec])

    y = lax.map(chunk, (xt.reshape(n_chunks, P_CHUNK, D),
                        e.reshape(n_chunks, P_CHUNK, P_HEADS * P_TOPK),
                        g.reshape(n_chunks, P_CHUNK, P_HEADS * P_TOPK)))
    return y.reshape(B, S, D)


def hybrid_layer(x, positions, norm1_gain, w_in,
                 nsa_q_gain, nsa_kc_gain, nsa_ks_gain, nsa_kw_gain,
                 cmp_pos, cmp_k_w1, cmp_k_w2, cmp_v_w1, cmp_v_w2,
                 mla_q_lora_gain, mla_w_uq, mla_kv_lora_gain, mla_w_ukv, mla_q_gain, mla_k_gain,
                 out_gain_a, out_gain_b, w_out,
                 norm2_gain, peer_w_q, peer_sub_keys, peer_u, peer_v):
    B, S, _ = x.shape
    proj = rmsnorm(x, norm1_gain) @ w_in
    pts = [int(p) for p in np.cumsum(IN_SIZES)[:-1]]
    (a_q, a_kc, a_vc, a_ks, a_vs, a_kw, a_vw, a_gate, b_cq, b_ckv, b_kr) = jnp.split(proj, pts, axis=-1)
    kvs = lambda t: t.reshape(B, S, A_KV_HEADS, A_HEAD_DIM)
    gates = jax.nn.sigmoid(a_gate).reshape(B, S, A_HEADS, 3)
    o_a = nsa_mixer(a_q.reshape(B, S, A_HEADS, A_HEAD_DIM), kvs(a_kc), kvs(a_vc), kvs(a_ks), kvs(a_vs),
                    kvs(a_kw), kvs(a_vw), gates, positions,
                    nsa_q_gain, nsa_kc_gain, nsa_ks_gain, nsa_kw_gain,
                    cmp_pos, cmp_k_w1, cmp_k_w2, cmp_v_w1, cmp_v_w2)
    o_b = mla_mixer(b_cq, b_ckv, b_kr, positions, mla_q_lora_gain, mla_w_uq,
                    mla_kv_lora_gain, mla_w_ukv, mla_q_gain, mla_k_gain)
    mixed = jnp.concatenate([rmsnorm(o_a, out_gain_a), rmsnorm(o_b, out_gain_b)], axis=-1) @ w_out
    h = x + mixed
    return h + peer_ffn(rmsnorm(h, norm2_gain), peer_w_q, peer_sub_keys, peer_u, peer_v)


def setup_inputs(seed: int = 0) -> dict:
    key = jax.random.key(seed)
    ks = jax.random.split(key, 32)
    L = DEPTH
    nrm = lambda k, shape, s: jax.random.normal(k, shape, jnp.float32) * s
    gain = lambda k, n: 1.0 + 0.02 * jax.random.normal(k, (L, n), jnp.float32)
    start = jax.random.randint(ks[1], (BATCH, 1), 0, 4096, dtype=jnp.int32)
    return {
        'x': nrm(ks[0], (BATCH, SEQ, D_MODEL), 1.0),
        'positions': (start + jnp.arange(SEQ, dtype=jnp.int32)[None, :]).astype(jnp.int32),
        'norm1_gain': gain(ks[2], D_MODEL),
        'w_in': nrm(ks[3], (L, D_MODEL, IN_WIDTH), D_MODEL ** -0.5),
        'nsa_q_gain': gain(ks[4], A_HEAD_DIM),
        'nsa_kc_gain': gain(ks[5], A_HEAD_DIM),
        'nsa_ks_gain': gain(ks[6], A_HEAD_DIM),
        'nsa_kw_gain': gain(ks[7], A_HEAD_DIM),
        'cmp_pos': nrm(ks[8], (L, CMP_LEN, A_HEAD_DIM), 0.1),
        'cmp_k_w1': nrm(ks[9], (L, CMP_LEN * A_HEAD_DIM, CMP_HIDDEN), (CMP_LEN * A_HEAD_DIM) ** -0.5),
        'cmp_k_w2': nrm(ks[10], (L, CMP_HIDDEN, A_HEAD_DIM), CMP_HIDDEN ** -0.5),
        'cmp_v_w1': nrm(ks[11], (L, CMP_LEN * A_HEAD_DIM, CMP_HIDDEN), (CMP_LEN * A_HEAD_DIM) ** -0.5),
        'cmp_v_w2': nrm(ks[12], (L, CMP_HIDDEN, A_HEAD_DIM), CMP_HIDDEN ** -0.5),
        'mla_q_lora_gain': gain(ks[13], Q_LORA),
        'mla_w_uq': nrm(ks[14], (L, Q_LORA, B_HEADS * B_QK), Q_LORA ** -0.5),
        'mla_kv_lora_gain': gain(ks[15], KV_LORA),
        'mla_w_ukv': nrm(ks[16], (L, KV_LORA, B_HEADS * (B_NOPE + B_V)), KV_LORA ** -0.5),
        'mla_q_gain': gain(ks[17], B_QK),
        'mla_k_gain': gain(ks[18], B_QK),
        'out_gain_a': gain(ks[19], A_WIDTH),
        'out_gain_b': gain(ks[20], B_WIDTH),
        'w_out': nrm(ks[21], (L, MIX_WIDTH, D_MODEL), MIX_WIDTH ** -0.5),
        'norm2_gain': gain(ks[22], D_MODEL),
        'peer_w_q': nrm(ks[23], (L, D_MODEL, P_HEADS * P_KEY_DIM), D_MODEL ** -0.5),
        'peer_sub_keys': nrm(ks[24], (L, P_HEADS, 2, N_KEYS, P_KEY_DIM // 2), (P_KEY_DIM // 2) ** -0.5),
        'peer_u': nrm(ks[25], (L, N_EXPERTS, D_MODEL), D_MODEL ** -0.5),
        'peer_v': nrm(ks[26], (L, N_EXPERTS, D_MODEL), D_MODEL ** -0.5),
    }


def reference(x, positions, norm1_gain, w_in,
              nsa_q_gain, nsa_kc_gain, nsa_ks_gain, nsa_kw_gain,
              cmp_pos, cmp_k_w1, cmp_k_w2, cmp_v_w1, cmp_v_w2,
              mla_q_lora_gain, mla_w_uq, mla_kv_lora_gain, mla_w_ukv, mla_q_gain, mla_k_gain,
              out_gain_a, out_gain_b, w_out,
              norm2_gain, peer_w_q, peer_sub_keys, peer_u, peer_v):
    h = x
    for l in range(DEPTH):
        h = hybrid_layer(h, positions, norm1_gain[l], w_in[l],
                         nsa_q_gain[l], nsa_kc_gain[l], nsa_ks_gain[l], nsa_kw_gain[l],
                         cmp_pos[l], cmp_k_w1[l], cmp_k_w2[l], cmp_v_w1[l], cmp_v_w2[l],
                         mla_q_lora_gain[l], mla_w_uq[l], mla_kv_lora_gain[l], mla_w_ukv[l],
                         mla_q_gain[l], mla_k_gain[l],
                         out_gain_a[l], out_gain_b[l], w_out[l],
                         norm2_gain[l], peer_w_q[l], peer_sub_keys[l], peer_u[l], peer_v[l])
    return h
```

```cpp
#include <hip/hip_runtime.h>
#include <cmath>
#include <cstdint>
#include <cstdio>

constexpr int B_ = 2, S_ = 8192, T_ = B_ * S_, D_ = 1024, INW = 1720;
constexpr int G_ = 2, NCMP = 511;
constexpr float EPS = 1e-6f;
constexpr int C_Q = 0, C_KC = 512, C_VC = 640, C_KS = 768, C_VS = 896, C_KW = 1024, C_VW = 1152, C_GATE = 1280, C_CQ = 1304, C_CKV = 1560, C_KR = 1688;

#define WSYNC() do { __builtin_amdgcn_wave_barrier(); asm volatile("s_waitcnt lgkmcnt(0)" ::: "memory"); __builtin_amdgcn_wave_barrier(); } while (0)

__device__ __forceinline__ float wsum(float v) {
#pragma unroll
    for (int o = 32; o > 0; o >>= 1) v += __shfl_xor(v, o);
    return v;
}
__device__ __forceinline__ float wmax(float v) {
#pragma unroll
    for (int o = 32; o > 0; o >>= 1) v = fmaxf(v, __shfl_xor(v, o));
    return v;
}
__device__ __forceinline__ float gelu_tanh(float x) {
    const float u = 0.7978845608028654f * (x + 0.044715f * x * x * x);
    return 0.5f * x * (1.f + tanhf(u));
}

struct RopeTab { float f16[8]; float f32[16]; };

__global__ __launch_bounds__(256) void k_rmsnorm1024(const float* __restrict__ in, const float* __restrict__ gain, float* __restrict__ out, int rows) {
    const int lane = threadIdx.x & 63, w = threadIdx.x >> 6;
    for (int r = blockIdx.x * 4 + w; r < rows; r += gridDim.x * 4) {
        const float4* p = (const float4*)(in + (long)r * 1024);
        float4 v[4]; float ss = 0.f;
#pragma unroll
        for (int k = 0; k < 4; ++k) { v[k] = p[k * 64 + lane]; ss += v[k].x * v[k].x + v[k].y * v[k].y + v[k].z * v[k].z + v[k].w * v[k].w; }
        ss = wsum(ss);
        const float rs = rsqrtf(ss * (1.f / 1024.f) + EPS);
        float4* o = (float4*)(out + (long)r * 1024);
#pragma unroll
        for (int k = 0; k < 4; ++k) { const float4 g = ((const float4*)gain)[k * 64 + lane]; float4 t; t.x = v[k].x * rs * g.x; t.y = v[k].y * rs * g.y; t.z = v[k].z * rs * g.z; t.w = v[k].w * rs * g.w; o[k * 64 + lane] = t; }
    }
}

template <int EPI>
__global__ __launch_bounds__(256) void k_gemm(const float* __restrict__ A, long lda, const float* __restrict__ Bm, long ldb, float* __restrict__ C, long ldc,
                                              int M, int N, int K, const float* __restrict__ avec, const float* __restrict__ R) {
    __shared__ float As[16][65];
    __shared__ float Bs[16][64];
    const int tx = threadIdx.x & 15, ty = threadIdx.x >> 4;
    const int m0 = blockIdx.y * 64, n0 = blockIdx.x * 64;
    float acc[4][4];
#pragma unroll
    for (int i = 0; i < 4; ++i)
#pragma unroll
        for (int j = 0; j < 4; ++j) acc[i][j] = 0.f;
    for (int k0 = 0; k0 < K; k0 += 16) {
#pragma unroll
        for (int i = 0; i < 4; ++i) {
            const int idx = threadIdx.x + i * 256; const int r = idx >> 4, c = idx & 15; const int m = m0 + r;
            float v = 0.f; if (m < M) { v = A[(long)m * lda + k0 + c]; if (avec) v += avec[k0 + c]; }
            As[c][r] = v;
        }
#pragma unroll
        for (int i = 0; i < 4; ++i) {
            const int idx = threadIdx.x + i * 256; const int r = idx >> 6, c = idx & 63; const int n = n0 + c;
            Bs[r][c] = (n < N) ? Bm[(long)(k0 + r) * ldb + n] : 0.f;
        }
        __syncthreads();
#pragma unroll
        for (int kk = 0; kk < 16; ++kk) {
            float a[4], b[4];
#pragma unroll
            for (int i = 0; i < 4; ++i) a[i] = As[kk][ty * 4 + i];
#pragma unroll
            for (int j = 0; j < 4; ++j) b[j] = Bs[kk][tx * 4 + j];
#pragma unroll
            for (int i = 0; i < 4; ++i)
#pragma unroll
                for (int j = 0; j < 4; ++j) acc[i][j] += a[i] * b[j];
        }
        __syncthreads();
    }
#pragma unroll
    for (int i = 0; i < 4; ++i) {
        const int m = m0 + ty * 4 + i; if (m >= M) continue;
#pragma unroll
        for (int j = 0; j < 4; ++j) {
            const int n = n0 + tx * 4 + j; if (n >= N) continue;
            float v = acc[i][j];
            if (EPI == 1) v = gelu_tanh(v);
            if (EPI == 2) v += R[(long)m * ldc + n];
            C[(long)m * ldc + n] = v;
        }
    }
}

struct PostArgs {
    const float* proj; const int* positions;
    const float *q_gain, *ks_gain, *kw_gain, *qlora_gain, *kvlora_gain;
    float *qa, *kslc, *kwin, *vslc, *vwin, *kcmp, *vcmp, *gates, *cqn, *ckvn, *kr, *rope;
    RopeTab tab;
};
__device__ __forceinline__ float rope16(float vn, int lane, const float* cs) {
    const float other = __shfl_xor(vn, 8);
    const int i = lane & 7; const float c = cs[i], s = cs[8 + i];
    if (lane < 8) return vn * c - other * s;
    if (lane < 16) return vn * c + other * s;
    return vn;
}
__global__ __launch_bounds__(256) void k_token_post(PostArgs a) {
    __shared__ float cs_s[4][48];
    const int lane = threadIdx.x & 63, w = threadIdx.x >> 6;
    for (int t = blockIdx.x * 4 + w; t < T_; t += gridDim.x * 4) {
        const int b = t / S_, s = t % S_;
        const float* p = a.proj + (long)t * INW;
        const int pos = a.positions[t];
        if (lane < 24) {
            const float f = lane < 8 ? a.tab.f16[lane] : a.tab.f32[lane - 8];
            const float angf = (float)pos * f;
            const double ang = (double)angf;
            const double k = rint(ang * 0.15915494309189535);
            const float r = (float)(ang - k * 6.283185307179586);
            const float c = cosf(r), sn = sinf(r);
            if (lane < 8) { cs_s[w][lane] = c; cs_s[w][8 + lane] = sn; }
            else { cs_s[w][16 + lane - 8] = c; cs_s[w][32 + lane - 8] = sn; }
        }
        WSYNC();
        if (lane < 48) a.rope[(long)t * 48 + lane] = cs_s[w][lane];
        const float* cs = cs_s[w];
        for (int h = 0; h < 8; ++h) {
            const float v = p[C_Q + h * 64 + lane];
            const float ss = wsum(v * v);
            const float vn = v * rsqrtf(ss * (1.f / 64.f) + EPS) * a.q_gain[lane];
            a.qa[(long)t * 512 + h * 64 + lane] = rope16(vn, lane, cs);
        }
        for (int g = 0; g < 2; ++g) {
            { const float v = p[C_KS + g * 64 + lane]; const float ss = wsum(v * v);
              const float vn = v * rsqrtf(ss * (1.f / 64.f) + EPS) * a.ks_gain[lane];
              a.kslc[((long)t * 2 + g) * 64 + lane] = rope16(vn, lane, cs); }
            { const float v = p[C_KW + g * 64 + lane]; const float ss = wsum(v * v);
              const float vn = v * rsqrtf(ss * (1.f / 64.f) + EPS) * a.kw_gain[lane];
              a.kwin[((long)t * 2 + g) * 64 + lane] = rope16(vn, lane, cs); }
            a.vslc[((long)t * 2 + g) * 64 + lane] = p[C_VS + g * 64 + lane];
            a.vwin[((long)t * 2 + g) * 64 + lane] = p[C_VW + g * 64 + lane];
            a.kcmp[(((long)(b * 2 + g)) * S_ + s) * 64 + lane] = p[C_KC + g * 64 + lane];
            a.vcmp[(((long)(b * 2 + g)) * S_ + s) * 64 + lane] = p[C_VC + g * 64 + lane];
        }
        if (lane < 24) a.gates[(long)t * 24 + lane] = 1.f / (1.f + expf(-p[C_GATE + lane]));
        { float v[4]; float ss = 0.f;
#pragma unroll
          for (int k = 0; k < 4; ++k) { v[k] = p[C_CQ + lane + 64 * k]; ss += v[k] * v[k]; }
          ss = wsum(ss); const float rs = rsqrtf(ss * (1.f / 256.f) + EPS);
#pragma unroll
          for (int k = 0; k < 4; ++k) a.cqn[(long)t * 256 + lane + 64 * k] = v[k] * rs * a.qlora_gain[lane + 64 * k]; }
        { float v[2]; float ss = 0.f;
#pragma unroll
          for (int k = 0; k < 2; ++k) { v[k] = p[C_CKV + lane + 64 * k]; ss += v[k] * v[k]; }
          ss = wsum(ss); const float rs = rsqrtf(ss * (1.f / 128.f) + EPS);
#pragma unroll
          for (int k = 0; k < 2; ++k) a.ckvn[(long)t * 128 + lane + 64 * k] = v[k] * rs * a.kvlora_gain[lane + 64 * k]; }
        if (lane < 32) a.kr[(long)t * 32 + lane] = p[C_KR + lane];
        WSYNC();
    }
}

struct Post2Args { float* qb; float* kvb; const float* kr; const float* rope; const float *q_gain, *k_gain; float* kbrope; };
__device__ __forceinline__ float rope32(float vn, int lane, const float* cs) {
    const float other = __shfl_xor(vn, 16);
    const int i = lane & 15; const float c = cs[i], s = cs[16 + i];
    if (lane < 16) return vn * c - other * s;
    return vn * c + other * s;
}
__global__ __launch_bounds__(256) void k_token_post2(Post2Args a) {
    const int lane = threadIdx.x & 63, w = threadIdx.x >> 6;
    for (int t = blockIdx.x * 4 + w; t < T_; t += gridDim.x * 4) {
        const float* cs = a.rope + (long)t * 48 + 16;
        const float krv = (lane < 32) ? a.kr[(long)t * 32 + lane] : 0.f;
        const float krss = wsum(krv * krv);
        for (int h = 0; h < 8; ++h) {
            float* q = a.qb + (long)t * 768 + h * 96;
            const float v0 = q[lane]; const float v1 = (lane < 32) ? q[64 + lane] : 0.f;
            const float ss = wsum(v0 * v0 + v1 * v1);
            const float rs = rsqrtf(ss * (1.f / 96.f) + EPS);
            const float n0 = v0 * rs * a.q_gain[lane];
            const float n1 = (lane < 32) ? v1 * rs * a.q_gain[64 + lane] : 0.f;
            const float r1 = rope32(n1, lane & 31, cs);
            q[lane] = n0; if (lane < 32) q[64 + lane] = r1;
            float* kk = a.kvb + (long)t * 1024 + h * 128;
            const float k0 = kk[lane];
            const float kss = wsum(k0 * k0) + krss;
            const float krs = rsqrtf(kss * (1.f / 96.f) + EPS);
            kk[lane] = k0 * krs * a.k_gain[lane];
            const float kn1 = (lane < 32) ? krv * krs * a.k_gain[64 + lane] : 0.f;
            const float kr1 = rope32(kn1, lane & 31, cs);
            if (lane < 32) a.kbrope[((long)t * 8 + h) * 32 + lane] = kr1;
        }
    }
}

__global__ __launch_bounds__(256) void k_kc_post(const float* __restrict__ kcraw, const float* __restrict__ gain, const float* __restrict__ rope, float* __restrict__ kc) {
    const int lane = threadIdx.x & 63, w = threadIdx.x >> 6;
    for (int m = blockIdx.x * 4 + w; m < 4 * 512; m += gridDim.x * 4) {
        const int n = m & 511, bg = m >> 9, b = bg >> 1;
        if (n >= NCMP) continue;
        const float v = kcraw[(long)m * 64 + lane];
        const float ss = wsum(v * v);
        const float vn = v * rsqrtf(ss * (1.f / 64.f) + EPS) * gain[lane];
        const float* cs = rope + ((long)b * S_ + 16 * n + 31) * 48;
        kc[(long)m * 64 + lane] = rope16(vn, lane, cs);
    }
}

struct NsaArgs { float* qa; const float *kc, *vc, *kslc, *vslc, *kwin, *vwin, *gates; };
__device__ __forceinline__ void dot4h(const float* qs, const float* krow, float* acc) {
#pragma unroll
    for (int d4 = 0; d4 < 16; ++d4) {
        const float4 kv = ((const float4*)krow)[d4];
#pragma unroll
        for (int h = 0; h < 4; ++h) {
            const float4 qv = ((const float4*)(qs + h * 64))[d4];
            acc[h] += qv.x * kv.x + qv.y * kv.y + qv.z * kv.z + qv.w * kv.w;
        }
    }
}
__global__ __launch_bounds__(256) void k_nsa(NsaArgs a) {
    __shared__ __attribute__((aligned(16))) float sm[4][256 + 2048 + 512 + 128 + 256];
    const int lane = threadIdx.x & 63, w = threadIdx.x >> 6;
    float* qs = sm[w]; float* pl = qs + 256; float* psum = pl + 2048; float* impl = psum + 512; float* pb = impl + 128;
    const float scale = 0.125f;
    for (int item = blockIdx.x * 4 + w; item < B_ * G_ * S_; item += gridDim.x * 4) {
        const int t = item % S_, g = (item / S_) % G_, b = item / (S_ * G_);
        const long tok = (long)b * S_ + t; const int bg = b * 2 + g;
#pragma unroll
        for (int h = 0; h < 4; ++h) qs[h * 64 + lane] = a.qa[tok * 512 + (g * 4 + h) * 64 + lane];
        WSYNC();
        int nvis = (t >= 31) ? ((t - 31) / 16 + 1) : 0; if (nvis > NCMP) nvis = NCMP;
        const float* kcb = a.kc + (long)bg * 512 * 64; const float* vcb = a.vc + (long)bg * 512 * 64;
        float pacc[8];
#pragma unroll
        for (int c = 0; c < 8; ++c) pacc[c] = 0.f;
        float oc[4] = {0.f, 0.f, 0.f, 0.f};
        if (nvis > 0) {
            float sc[8][4];
#pragma unroll
            for (int c = 0; c < 8; ++c) {
                const int i = lane + 64 * c;
                float acc[4] = {0.f, 0.f, 0.f, 0.f};
                if (i < nvis) dot4h(qs, kcb + (long)i * 64, acc);
#pragma unroll
                for (int h = 0; h < 4; ++h) sc[c][h] = (i < nvis) ? acc[h] * scale : -INFINITY;
            }
#pragma unroll
            for (int h = 0; h < 4; ++h) {
                float m = sc[0][h];
#pragma unroll
                for (int c = 1; c < 8; ++c) m = fmaxf(m, sc[c][h]);
                m = wmax(m);
                float e[8]; float l = 0.f;
#pragma unroll
                for (int c = 0; c < 8; ++c) { e[c] = (lane + 64 * c < nvis) ? expf(sc[c][h] - m) : 0.f; l += e[c]; }
                l = wsum(l); const float inv = 1.f / l;
#pragma unroll
                for (int c = 0; c < 8; ++c) { const float pn = e[c] * inv; pacc[c] += pn; pl[h * 512 + lane + 64 * c] = pn; }
            }
            WSYNC();
            for (int i = 0; i < nvis; ++i) {
                const float vv = vcb[(long)i * 64 + lane];
#pragma unroll
                for (int h = 0; h < 4; ++h) oc[h] += pl[h * 512 + i] * vv;
            }
        }
#pragma unroll
        for (int c = 0; c < 8; ++c) psum[lane + 64 * c] = pacc[c];
        WSYNC();
        float myv[2];
#pragma unroll
        for (int jj = 0; jj < 2; ++jj) {
            const int j = lane + 64 * jj; float v = 0.f;
            for (int i = 4 * j - 1; i <= 4 * j + 3; ++i) if (i >= 0 && i < NCMP) v += psum[i];
            const bool forced = (j == t / 64) || (j == 0); const bool causal = 64 * j <= t;
            const float val = forced ? 1e9f : (causal ? v : -1e30f);
            impl[j] = val; myv[jj] = val;
        }
        WSYNC();
        bool selb[2];
#pragma unroll
        for (int jj = 0; jj < 2; ++jj) {
            const int j = lane + 64 * jj; int r = 0;
            for (int k = 0; k < 128; ++k) { const float vk = impl[k]; r += (vk > myv[jj] || (vk == myv[jj] && k < j)) ? 1 : 0; }
            selb[jj] = r < 16;
        }
        const unsigned long long mask0 = __ballot(selb[0]), mask1 = __ballot(selb[1]);
        float os[4] = {0.f, 0.f, 0.f, 0.f}, ms[4] = {-INFINITY, -INFINITY, -INFINITY, -INFINITY}, ls[4] = {0.f, 0.f, 0.f, 0.f};
        for (int jb = 0; jb < 128; ++jb) {
            const bool sel = jb < 64 ? ((mask0 >> jb) & 1ull) : ((mask1 >> (jb - 64)) & 1ull);
            if (!sel || 64 * jb > t) continue;
            const int key = jb * 64 + lane; const bool valid = key <= t;
            float acc[4] = {0.f, 0.f, 0.f, 0.f};
            if (valid) dot4h(qs, a.kslc + (((long)b * S_ + key) * 2 + g) * 64, acc);
#pragma unroll
            for (int h = 0; h < 4; ++h) {
                const float s = valid ? acc[h] * scale : -INFINITY;
                const float mn = fmaxf(ms[h], wmax(s));
                const float alpha = expf(ms[h] - mn);
                const float pe = valid ? expf(s - mn) : 0.f;
                ls[h] = ls[h] * alpha + wsum(pe); ms[h] = mn; os[h] *= alpha; pb[h * 64 + lane] = pe;
            }
            WSYNC();
            for (int k = 0; k < 64; ++k) {
                const float vv = a.vslc[(((long)b * S_ + jb * 64 + k) * 2 + g) * 64 + lane];
#pragma unroll
                for (int h = 0; h < 4; ++h) os[h] += pb[h * 64 + k] * vv;
            }
            WSYNC();
        }
        float ow[4] = {0.f, 0.f, 0.f, 0.f}, mw[4] = {-INFINITY, -INFINITY, -INFINITY, -INFINITY}, lw[4] = {0.f, 0.f, 0.f, 0.f};
        for (int c = 0; c < 8; ++c) {
            const int kb0 = t - 511 + 64 * c; if (kb0 + 63 < 0) continue;
            const int key = kb0 + lane; const bool valid = key >= 0;
            float acc[4] = {0.f, 0.f, 0.f, 0.f};
            if (valid) dot4h(qs, a.kwin + (((long)b * S_ + key) * 2 + g) * 64, acc);
#pragma unroll
            for (int h = 0; h < 4; ++h) {
                const float s = valid ? acc[h] * scale : -INFINITY;
                const float mn = fmaxf(mw[h], wmax(s));
                const float alpha = expf(mw[h] - mn);
                const float pe = valid ? expf(s - mn) : 0.f;
                lw[h] = lw[h] * alpha + wsum(pe); mw[h] = mn; ow[h] *= alpha; pb[h * 64 + lane] = pe;
            }
            WSYNC();
            for (int k = 0; k < 64; ++k) {
                int kk = kb0 + k; if (kk < 0) kk = 0;
                const float vv = a.vwin[(((long)b * S_ + kk) * 2 + g) * 64 + lane];
#pragma unroll
                for (int h = 0; h < 4; ++h) ow[h] += pb[h * 64 + k] * vv;
            }
            WSYNC();
        }
#pragma unroll
        for (int h = 0; h < 4; ++h) {
            const float* gt = a.gates + tok * 24 + (g * 4 + h) * 3;
            const float o = gt[0] * oc[h] + gt[1] * (os[h] / ls[h]) + gt[2] * (ow[h] / lw[h]);
            a.qa[tok * 512 + (g * 4 + h) * 64 + lane] = o;
        }
        WSYNC();
    }
}

struct MlaArgs { float* qb; const float* kvb; const float* kbrope; };
__global__ __launch_bounds__(256) void k_mla(MlaArgs a) {
    __shared__ __attribute__((aligned(16))) float sm[4][96 + 64];
    const int lane = threadIdx.x & 63, w = threadIdx.x >> 6;
    float* qs = sm[w]; float* pb = qs + 96;
    const float scale = 0.10206207261596575f;
    for (int item = blockIdx.x * 4 + w; item < T_ * 8; item += gridDim.x * 4) {
        const int h = item & 7; const int tt = item >> 3; const int b = tt / S_; const int t = S_ - 1 - (tt % S_);
        const long tok = (long)b * S_ + t;
        float* q = a.qb + tok * 768 + h * 96;
        qs[lane] = q[lane]; if (lane < 32) qs[64 + lane] = q[64 + lane];
        WSYNC();
        float o = 0.f, m = -INFINITY, l = 0.f;
        for (int c = 0; c <= t / 64; ++c) {
            const int key = 64 * c + lane; const bool valid = key <= t;
            float s = -INFINITY;
            if (valid) {
                const float4* kn = (const float4*)(a.kvb + ((long)b * S_ + key) * 1024 + h * 128);
                const float4* kr = (const float4*)(a.kbrope + (((long)b * S_ + key) * 8 + h) * 32);
                float acc = 0.f;
#pragma unroll
                for (int d4 = 0; d4 < 16; ++d4) { const float4 kv = kn[d4]; const float4 qv = ((const float4*)qs)[d4]; acc += qv.x * kv.x + qv.y * kv.y + qv.z * kv.z + qv.w * kv.w; }
#pragma unroll
                for (int d4 = 0; d4 < 8; ++d4) { const float4 kv = kr[d4]; const float4 qv = ((const float4*)(qs + 64))[d4]; acc += qv.x * kv.x + qv.y * kv.y + qv.z * kv.z + qv.w * kv.w; }
                s = acc * scale;
            }
            const float mn = fmaxf(m, wmax(s));
            const float alpha = expf(m - mn);
            const float pe = valid ? expf(s - mn) : 0.f;
            l = l * alpha + wsum(pe); m = mn; o *= alpha; pb[lane] = pe;
            WSYNC();
            const float* vb = a.kvb + ((long)b * S_ + 64 * c) * 1024 + h * 128 + 64 + lane;
#pragma unroll 8
            for (int k = 0; k < 64; ++k) o += pb[k] * vb[(long)k * 1024];
            WSYNC();
        }
        q[lane] = o / l;
        WSYNC();
    }
}

__global__ __launch_bounds__(256) void k_mixnorm(const float* __restrict__ oa, const float* __restrict__ ob, const float* __restrict__ ga, const float* __restrict__ gb, float* __restrict__ mixn) {
    const int lane = threadIdx.x & 63, w = threadIdx.x >> 6;
    for (int t = blockIdx.x * 4 + w; t < T_; t += gridDim.x * 4) {
        float va[8], vb[8]; float sa = 0.f, sb = 0.f;
#pragma unroll
        for (int k = 0; k < 8; ++k) { va[k] = oa[(long)t * 512 + k * 64 + lane]; sa += va[k] * va[k]; vb[k] = ob[(long)t * 768 + k * 96 + lane]; sb += vb[k] * vb[k]; }
        sa = wsum(sa); sb = wsum(sb);
        const float ra = rsqrtf(sa * (1.f / 512.f) + EPS), rb = rsqrtf(sb * (1.f / 512.f) + EPS);
#pragma unroll
        for (int k = 0; k < 8; ++k) {
            mixn[(long)t * 1024 + k * 64 + lane] = va[k] * ra * ga[k * 64 + lane];
            mixn[(long)t * 1024 + 512 + k * 64 + lane] = vb[k] * rb * gb[k * 64 + lane];
        }
    }
}

__global__ __launch_bounds__(256) void k_peer_route(const float* __restrict__ pq, const float* __restrict__ sk, int* __restrict__ eo, float* __restrict__ go, int tok0, int ntok) {
    __shared__ __attribute__((aligned(16))) float sm[4][256 + 128 + 128 + 16 + 16 + 16 + 16 + 256 + 16 + 16];
    const int lane = threadIdx.x & 63, w = threadIdx.x >> 6;
    float* qs = sm[w]; float* s1l = qs + 256; float* s2l = s1l + 128; float* v1l = s2l + 128; float* v2l = v1l + 16;
    int* i1l = (int*)(v2l + 16); int* i2l = i1l + 16; float* candl = (float*)(i2l + 16); float* selv = candl + 256; int* sele = (int*)(selv + 16);
    for (int item = blockIdx.x * 4 + w; item < ntok * 8; item += gridDim.x * 4) {
        const int h = item & 7, tl = item >> 3;
        const float* q = pq + (long)tl * 2048 + h * 256;
        float v[4]; float ss = 0.f;
#pragma unroll
        for (int k = 0; k < 4; ++k) { v[k] = q[lane + 64 * k]; ss += v[k] * v[k]; }
        ss = wsum(ss); const float rs = rsqrtf(ss * (1.f / 256.f) + EPS);
#pragma unroll
        for (int k = 0; k < 4; ++k) qs[lane + 64 * k] = v[k] * rs;
        WSYNC();
        float my1[2], my2[2];
#pragma unroll
        for (int jj = 0; jj < 2; ++jj) {
            const int n = lane + 64 * jj;
            const float4* k1 = (const float4*)(sk + ((long)(h * 2 + 0) * 128 + n) * 128);
            const float4* k2 = (const float4*)(sk + ((long)(h * 2 + 1) * 128 + n) * 128);
            float a1 = 0.f, a2 = 0.f;
#pragma unroll 8
            for (int d4 = 0; d4 < 32; ++d4) {
                const float4 x1 = k1[d4], x2 = k2[d4]; const float4 q1 = ((const float4*)qs)[d4], q2 = ((const float4*)(qs + 128))[d4];
                a1 += q1.x * x1.x + q1.y * x1.y + q1.z * x1.z + q1.w * x1.w;
                a2 += q2.x * x2.x + q2.y * x2.y + q2.z * x2.z + q2.w * x2.w;
            }
            my1[jj] = a1; my2[jj] = a2; s1l[n] = a1; s2l[n] = a2;
        }
        WSYNC();
#pragma unroll
        for (int jj = 0; jj < 2; ++jj) {
            const int n = lane + 64 * jj; int r1 = 0, r2 = 0;
            for (int k = 0; k < 128; ++k) {
                const float a1 = s1l[k], a2 = s2l[k];
                r1 += (a1 > my1[jj] || (a1 == my1[jj] && k < n)) ? 1 : 0;
                r2 += (a2 > my2[jj] || (a2 == my2[jj] && k < n)) ? 1 : 0;
            }
            if (r1 < 16) { v1l[r1] = my1[jj]; i1l[r1] = n; }
            if (r2 < 16) { v2l[r2] = my2[jj]; i2l[r2] = n; }
        }
        WSYNC();
        float cv[4];
#pragma unroll
        for (int k = 0; k < 4; ++k) { const int c = lane + 64 * k; cv[k] = v1l[c >> 4] + v2l[c & 15]; candl[c] = cv[k]; }
        WSYNC();
#pragma unroll
        for (int k = 0; k < 4; ++k) {
            const int c = lane + 64 * k; int r = 0;
            for (int m = 0; m < 256; ++m) { const float vm = candl[m]; r += (vm > cv[k] || (vm == cv[k] && m < c)) ? 1 : 0; }
            if (r < 16) { selv[r] = cv[k]; sele[r] = i1l[c >> 4] * 128 + i2l[c & 15]; }
        }
        WSYNC();
        {
            const float val = (lane < 16) ? selv[lane] : -INFINITY;
            const float m = wmax(val);
            const float e = (lane < 16) ? expf(val - m) : 0.f;
            const float l = wsum(e);
            if (lane < 16) { const long o = ((long)(tok0 + tl) * 8 + h) * 16 + lane; eo[o] = sele[lane]; go[o] = e / l; }
        }
        WSYNC();
    }
}

__global__ __launch_bounds__(256) void k_peer_experts(const float* __restrict__ hn, const int* __restrict__ eo, const float* __restrict__ go,
                                                      const float* __restrict__ U, const float* __restrict__ V, float* out) {
    const int lane = threadIdx.x & 63, w = threadIdx.x >> 6;
    for (int t = blockIdx.x * 4 + w; t < T_; t += gridDim.x * 4) {
        float4 x[4], y[4];
#pragma unroll
        for (int k = 0; k < 4; ++k) { x[k] = ((const float4*)(hn + (long)t * 1024))[k * 64 + lane]; y[k] = make_float4(0.f, 0.f, 0.f, 0.f); }
        for (int j = 0; j < 128; ++j) {
            const int e = eo[(long)t * 128 + j]; const float gg = go[(long)t * 128 + j];
            const float4* ur = (const float4*)(U + (long)e * 1024); const float4* vr = (const float4*)(V + (long)e * 1024);
            float acc = 0.f;
#pragma unroll
            for (int k = 0; k < 4; ++k) { const float4 u = ur[k * 64 + lane]; acc += u.x * x[k].x + u.y * x[k].y + u.z * x[k].z + u.w * x[k].w; }
            acc = wsum(acc);
            const float wgt = gg * gelu_tanh(acc);
#pragma unroll
            for (int k = 0; k < 4; ++k) { const float4 vv = vr[k * 64 + lane]; y[k].x += wgt * vv.x; y[k].y += wgt * vv.y; y[k].z += wgt * vv.z; y[k].w += wgt * vv.w; }
        }
        float4* o = (float4*)(out + (long)t * 1024);
#pragma unroll
        for (int k = 0; k < 4; ++k) { float4 hv = o[k * 64 + lane]; hv.x += y[k].x; hv.y += y[k].y; hv.z += y[k].z; hv.w += y[k].w; o[k * 64 + lane] = hv; }
    }
}

template <int EPI>
static void gemm(hipStream_t st, const float* A, long lda, const float* Bm, long ldb, float* C, long ldc, int M, int N, int K, const float* avec = nullptr, const float* R = nullptr) {
    dim3 grid((N + 63) / 64, (M + 63) / 64);
    hipLaunchKernelGGL(k_gemm<EPI>, grid, dim3(256), 0, st, A, lda, Bm, ldb, C, ldc, M, N, K, avec, R);
}

extern "C" void kernel_launch(void* const* d_in, const int* in_sizes, int n_in, void* d_out, int out_size, void* d_ws, size_t ws_size, hipStream_t stream) {
    const float* x = (const float*)d_in[0];
    const int* positions = (const int*)d_in[1];
    const float* norm1_gain = (const float*)d_in[2];
    const float* w_in = (const float*)d_in[3];
    const float* nsa_q_gain = (const float*)d_in[4];
    const float* nsa_kc_gain = (const float*)d_in[5];
    const float* nsa_ks_gain = (const float*)d_in[6];
    const float* nsa_kw_gain = (const float*)d_in[7];
    const float* cmp_pos = (const float*)d_in[8];
    const float* cmp_k_w1 = (const float*)d_in[9];
    const float* cmp_k_w2 = (const float*)d_in[10];
    const float* cmp_v_w1 = (const float*)d_in[11];
    const float* cmp_v_w2 = (const float*)d_in[12];
    const float* mla_q_lora_gain = (const float*)d_in[13];
    const float* mla_w_uq = (const float*)d_in[14];
    const float* mla_kv_lora_gain = (const float*)d_in[15];
    const float* mla_w_ukv = (const float*)d_in[16];
    const float* mla_q_gain = (const float*)d_in[17];
    const float* mla_k_gain = (const float*)d_in[18];
    const float* out_gain_a = (const float*)d_in[19];
    const float* out_gain_b = (const float*)d_in[20];
    const float* w_out = (const float*)d_in[21];
    const float* norm2_gain = (const float*)d_in[22];
    const float* peer_w_q = (const float*)d_in[23];
    const float* peer_sub_keys = (const float*)d_in[24];
    const float* peer_u = (const float*)d_in[25];
    const float* peer_v = (const float*)d_in[26];
    float* out = (float*)d_out;
    float* W = (float*)d_ws;

    const long M1 = 1 << 20;
    float* proj = W;
    float* qb = W;
    float* kvb = W + 12 * M1;
    long o = 30 * M1;
    float* xn = W + o;
    float* cqn = W + o;          o += 4 * M1;
    float* ckvn = W + o;         o += 2 * M1;
    float* kcmp = W + o;         o += 2 * M1 + 4096;
    float* vcmp = W + o;         o += 2 * M1 + 4096;
    float* kslc = W + o;         o += 2 * M1;
    float* kwin = W + o;         o += 2 * M1;
    float* vslc = W + o;         o += 2 * M1;
    float* vwin = W + o;         o += 2 * M1;
    float* kr = W + o;           o += M1 / 2;
    float* gates = W + o;        o += M1 / 2;
    float* kbrope = W + o;       o += 4 * M1;
    float* rope = W + o;         o += M1;
    float* hidk = W + o;         o += M1 / 2;
    float* hidv = W + o;         o += M1 / 2;
    float* kcraw = W + o;        o += M1 / 8;
    float* kc = W + o;           o += M1 / 8;
    float* vc = W + o;           o += M1 / 8;
    float* qa = W + o;           o += 8 * M1;
    float* mixn = W + 30 * M1;
    float* hn = W;
    float* pqc = W + 16 * M1;
    int* eo = (int*)(W + 24 * M1);
    float* go = W + 26 * M1;
    (void)ws_size; (void)in_sizes; (void)n_in; (void)out_size;

    RopeTab tab;
    for (int i = 0; i < 8; ++i) tab.f16[i] = powf(500000.0f, -(float)(2 * i) / 16.0f);
    for (int i = 0; i < 16; ++i) tab.f32[i] = powf(500000.0f, -(float)(2 * i) / 32.0f);

    const int NB = 2048;
    hipLaunchKernelGGL(k_rmsnorm1024, dim3(NB), dim3(256), 0, stream, x, norm1_gain, xn, T_);
    gemm<0>(stream, xn, 1024, w_in, INW, proj, INW, T_, INW, 1024);
    PostArgs pa{}; pa.proj = proj; pa.positions = positions; pa.q_gain = nsa_q_gain; pa.ks_gain = nsa_ks_gain; pa.kw_gain = nsa_kw_gain;
    pa.qlora_gain = mla_q_lora_gain; pa.kvlora_gain = mla_kv_lora_gain;
    pa.qa = qa; pa.kslc = kslc; pa.kwin = kwin; pa.vslc = vslc; pa.vwin = vwin; pa.kcmp = kcmp; pa.vcmp = vcmp; pa.gates = gates; pa.cqn = cqn; pa.ckvn = ckvn; pa.kr = kr; pa.rope = rope; pa.tab = tab;
    hipLaunchKernelGGL(k_token_post, dim3(NB), dim3(256), 0, stream, pa);
    gemm<0>(stream, cqn, 256, mla_w_uq, 768, qb, 768, T_, 768, 256);
    gemm<0>(stream, ckvn, 128, mla_w_ukv, 1024, kvb, 1024, T_, 1024, 128);
    Post2Args p2{}; p2.qb = qb; p2.kvb = kvb; p2.kr = kr; p2.rope = rope; p2.q_gain = mla_q_gain; p2.k_gain = mla_k_gain; p2.kbrope = kbrope;
    hipLaunchKernelGGL(k_token_post2, dim3(NB), dim3(256), 0, stream, p2);
    gemm<1>(stream, kcmp, 1024, cmp_k_w1, 256, hidk, 256, 2048, 256, 2048, cmp_pos);
    gemm<0>(stream, hidk, 256, cmp_k_w2, 64, kcraw, 64, 2048, 64, 256);
    gemm<1>(stream, vcmp, 1024, cmp_v_w1, 256, hidv, 256, 2048, 256, 2048, cmp_pos);
    gemm<0>(stream, hidv, 256, cmp_v_w2, 64, vc, 64, 2048, 64, 256);
    hipLaunchKernelGGL(k_kc_post, dim3(512), dim3(256), 0, stream, kcraw, nsa_kc_gain, rope, kc);
    NsaArgs na{}; na.qa = qa; na.kc = kc; na.vc = vc; na.kslc = kslc; na.vslc = vslc; na.kwin = kwin; na.vwin = vwin; na.gates = gates;
    hipLaunchKernelGGL(k_nsa, dim3(B_ * G_ * S_ / 4), dim3(256), 0, stream, na);
    MlaArgs ma{}; ma.qb = qb; ma.kvb = kvb; ma.kbrope = kbrope;
    hipLaunchKernelGGL(k_mla, dim3(T_ * 8 / 4), dim3(256), 0, stream, ma);
    hipLaunchKernelGGL(k_mixnorm, dim3(NB), dim3(256), 0, stream, qa, qb, out_gain_a, out_gain_b, mixn);
    gemm<2>(stream, mixn, 1024, w_out, 1024, out, 1024, T_, 1024, 1024, nullptr, x);
    hipLaunchKernelGGL(k_rmsnorm1024, dim3(NB), dim3(256), 0, stream, out, norm2_gain, hn, T_);
    for (int c = 0; c < 4; ++c) {
        gemm<0>(stream, hn + (long)c * 4096 * 1024, 1024, peer_w_q, 2048, pqc, 2048, 4096, 2048, 1024);
        hipLaunchKernelGGL(k_peer_route, dim3(4096 * 8 / 4), dim3(256), 0, stream, pqc, peer_sub_keys, eo, go, c * 4096, 4096);
    }
    hipLaunchKernelGGL(k_peer_experts, dim3(T_ / 4), dim3(256), 0, stream, hn, eo, go, peer_u, peer_v, out);
}
```

```cpp
#include <hip/hip_runtime.h>
#include <cmath>
#include <cstdint>
#include <cstdio>

#define XB_TMO      128
#define XB_XCNT(j)  (256  + 64 * (j))
#define XB_XSUB(j)  (1280 + 64 * (j))
#define XB_XGEN(j)  (2304 + 64 * (j))
#define XB_TOP      3328
#define XB_TOPGEN   3392
#define XCD_BAR_WORDS 3456
#define XB_SPIN_CAP (1u << 18)
#define LAS __attribute__((address_space(3)))

__device__ __forceinline__ unsigned xb_ld(unsigned* p)              { return __hip_atomic_load(p, __ATOMIC_RELAXED, __HIP_MEMORY_SCOPE_AGENT); }
__device__ __forceinline__ unsigned xb_add(unsigned* p, unsigned v) { return __hip_atomic_fetch_add(p, v, __ATOMIC_RELAXED, __HIP_MEMORY_SCOPE_AGENT); }
__device__ __forceinline__ unsigned xb_xcc_id() { return (unsigned)__builtin_amdgcn_s_getreg((3 << 11) | 20) & 0xFu; }
#define XB_SPIN(cond, bar) do { unsigned _sp = 0; while (cond) { __builtin_amdgcn_s_sleep(1); \
    if ((++_sp & 255u) == 0u) { if (xb_ld(&(bar)[XB_TMO])) break; if (_sp > XB_SPIN_CAP) { atomicAdd(&(bar)[XB_TMO], 1u); break; } } } } while (0)

struct XcdBarrier {
    unsigned* bar; unsigned x;
    volatile LAS unsigned* st;
};

__device__ __forceinline__ XcdBarrier xcd_barrier_post(unsigned* bar, volatile LAS unsigned* st) {
    XcdBarrier b; b.bar = bar; b.x = xb_xcc_id(); b.st = st;
    if (threadIdx.x == 0) (void)xb_add(&bar[XB_XCNT(b.x)], 1u);
    return b;
}
__device__ __forceinline__ void xcd_barrier_complete(unsigned* bar, unsigned x, unsigned& nloc, unsigned& nx) {
    const unsigned G = gridDim.x * gridDim.y * gridDim.z;
    unsigned sum, cnt, mine, sp = 0u;
    for (;;) {
        sum = 0u; cnt = 0u; mine = 0u;
#pragma unroll
        for (unsigned j = 0; j < 16; ++j) { const unsigned c = xb_ld(&bar[XB_XCNT(j)]); sum += c; cnt += (c > 0u) ? 1u : 0u; mine = (j == x) ? c : mine; }
        if (sum == G) break;
        __builtin_amdgcn_s_sleep(1);
        if ((++sp & 255u) == 0u) { if (xb_ld(&bar[XB_TMO])) break; if (sp > XB_SPIN_CAP) { atomicAdd(&bar[XB_TMO], 1u); break; } }
    }
    nloc = mine > 0u ? mine : 1u; nx = cnt > 0u ? cnt : 1u;
}

__device__ __forceinline__ void xcd_barrier(const XcdBarrier& b) {
    asm volatile("s_waitcnt vmcnt(0)" ::: "memory");
    __syncthreads();
    if (threadIdx.x == 0) {
        unsigned* bar = b.bar;
        __builtin_amdgcn_s_waitcnt(0);
        unsigned nloc = b.st[0], nx = b.st[1];
        if (nloc == 0u) { xcd_barrier_complete(bar, b.x, nloc, nx); b.st[0] = nloc; b.st[1] = nx; }
        const unsigned old = xb_add(&bar[XB_XSUB(b.x)], 1u);
        const unsigned gen = old / nloc;
        if (old + 1u == (gen + 1u) * nloc) {
            __builtin_amdgcn_fence(__ATOMIC_RELEASE, "agent");
            asm volatile("s_waitcnt vmcnt(0)" ::: "memory");
            const unsigned og = xb_add(&bar[XB_TOP], 1u);
            const unsigned tg = og / nx;
            if (og + 1u == (tg + 1u) * nx) xb_add(&bar[XB_TOPGEN], 1u);
            else XB_SPIN(xb_ld(&bar[XB_TOPGEN]) == tg, bar);
            __builtin_amdgcn_fence(__ATOMIC_ACQUIRE, "agent");
            xb_add(&bar[XB_XGEN(b.x)], 1u);
            asm volatile("s_waitcnt vmcnt(0)" ::: "memory");
        } else {
            XB_SPIN(xb_ld(&bar[XB_XGEN(b.x)]) == gen, bar);
            __builtin_amdgcn_fence(__ATOMIC_ACQUIRE, "agent");
            asm volatile("s_waitcnt vmcnt(0)" ::: "memory");
        }
    }
    __syncthreads();
}


#define AS1 __attribute__((address_space(1)))
constexpr int NBLK = 256;
constexpr int B_ = 2, S_ = 8192, T_ = B_ * S_, D_ = 1024, INW = 1720;
constexpr int G_ = 2, NCMP = 511;
constexpr float EPS = 1e-6f;
constexpr int C_Q = 0, C_KC = 512, C_VC = 640, C_KS = 768, C_VS = 896, C_KW = 1024, C_VW = 1152, C_GATE = 1280, C_CQ = 1304, C_CKV = 1560, C_KR = 1688;

#define WSYNC() do { __builtin_amdgcn_wave_barrier(); asm volatile("s_waitcnt lgkmcnt(0)" ::: "memory"); __builtin_amdgcn_wave_barrier(); } while (0)

__device__ __forceinline__ int tid_() { int t = threadIdx.x; asm volatile("" : "+v"(t)); return t; }
template <class T> __device__ __forceinline__ T* as_global(T* p) { return (T*)(__attribute__((address_space(1))) T*)p; }
__device__ __forceinline__ float wsum(float v) {
#pragma unroll
    for (int o = 32; o > 0; o >>= 1) v += __shfl_xor(v, o);
    return v;
}
__device__ __forceinline__ float wmax(float v) {
#pragma unroll
    for (int o = 32; o > 0; o >>= 1) v = fmaxf(v, __shfl_xor(v, o));
    return v;
}
__device__ __forceinline__ float gelu_tanh(float x) {
    const float u = 0.7978845608028654f * (x + 0.044715f * x * x * x);
    return 0.5f * x * (1.f + tanhf(u));
}

__device__ const float ROPE_F16[8] = {1.000000000e+00f, 1.939227432e-01f, 3.760603070e-02f, 7.292664610e-03f, 1.414213562e-03f, 2.742481884e-04f, 5.318296098e-05f, 1.031338616e-05f};
__device__ const float ROPE_F32[16] = {1.000000000e+00f, 4.403665960e-01f, 1.939227432e-01f, 8.539710194e-02f, 3.760603070e-02f, 1.656043902e-02f, 7.292664610e-03f, 3.211445874e-03f,
                                       1.414213562e-03f, 6.227723788e-04f, 2.742481884e-04f, 1.207697351e-04f, 5.318296098e-05f, 2.341999971e-05f, 1.031338616e-05f, 4.541670478e-06f};

typedef __attribute__((ext_vector_type(8))) short bf16x8;
typedef __attribute__((ext_vector_type(16))) float f32x16;
typedef __attribute__((ext_vector_type(2))) __bf16 bf16x2_t;
__device__ __forceinline__ unsigned cvtpk(float lo, float hi) { unsigned r; asm("v_cvt_pk_bf16_f32 %0, %1, %2" : "=v"(r) : "v"(lo), "v"(hi)); return r; }
__device__ __forceinline__ float bflo(unsigned u) { return __uint_as_float(u << 16); }
__device__ __forceinline__ float bfhi(unsigned u) { return __uint_as_float(u & 0xffff0000u); }
__device__ __forceinline__ float dot2bf(unsigned a, unsigned b, float c) { return __builtin_amdgcn_fdot2_f32_bf16(__builtin_bit_cast(bf16x2_t, a), __builtin_bit_cast(bf16x2_t, b), c, false); }

__device__ __forceinline__ float pair_max(float x) { auto rr = __builtin_amdgcn_permlane32_swap(__float_as_uint(x), __float_as_uint(x), false, false); return fmaxf(__uint_as_float(rr[0]), __uint_as_float(rr[1])); }
__device__ __forceinline__ float pair_sum(float x) { auto rr = __builtin_amdgcn_permlane32_swap(__float_as_uint(x), __float_as_uint(x), false, false); return __uint_as_float(rr[0]) + __uint_as_float(rr[1]); }
__device__ __forceinline__ float quad_sum(float x) {
    float y = x + __uint_as_float(__builtin_amdgcn_mov_dpp(__float_as_uint(x), 0xB1, 0xF, 0xF, true));
    return y + __uint_as_float(__builtin_amdgcn_mov_dpp(__float_as_uint(y), 0x4E, 0xF, 0xF, true));
}
#define MFMA32(a, b, c) __builtin_amdgcn_mfma_f32_32x32x16_bf16(a, b, c, 0, 0, 0)
typedef unsigned u32x4 __attribute__((ext_vector_type(4)));
constexpr int LDS_PITCH = 144;
__device__ __forceinline__ int crow(int r, int hi) { return (r & 3) + 8 * (r >> 2) + 4 * hi; }

template <int WM_, int WN_, int MI_, int NI_>
struct GemmShape {
    static constexpr int WM = WM_, WN = WN_, MI = MI_, NI = NI_;
    static constexpr int BM = WM * MI * 32, BN = WN * NI * 32, ROWS = BM + BN;
    static constexpr int CHUNKS = ROWS * 8 / 512;
    static constexpr int STAGE_BYTES = ROWS * LDS_PITCH;
    static_assert(WM * WN == 8 && (ROWS * 8) % 512 == 0, "8 waves; whole chunks per thread");
};
template <class SH, unsigned TOKMASK, int CUR>
__device__ __forceinline__ void gemm_step(unsigned char* lds, const unsigned short* const (&gp)[SH::CHUNKS], const int (&lo)[SH::CHUNKS], u32x4 (&g)[2][SH::CHUNKS],
                                          f32x16 (&acc)[SH::MI][SH::NI], int kt, int nk, int aoff, int boff) {
    const unsigned char* st = lds + (kt & 1) * SH::STAGE_BYTES;
    if (kt + 2 < nk) {
#pragma unroll
        for (int i = 0; i < SH::CHUNKS; ++i) g[CUR][i] = *(const u32x4*)(gp[i] + (long)(kt + 2) * 64);
    }
#pragma unroll
    for (int ks = 0; ks < 4; ++ks) {
        bf16x8 af[SH::MI], bfr[SH::NI];
#pragma unroll
        for (int mi = 0; mi < SH::MI; ++mi) af[mi] = *(const bf16x8*)(st + aoff + mi * 32 * LDS_PITCH + ks * 32);
#pragma unroll
        for (int ni = 0; ni < SH::NI; ++ni) bfr[ni] = *(const bf16x8*)(st + boff + ni * 32 * LDS_PITCH + ks * 32);
#pragma unroll
        for (int mi = 0; mi < SH::MI; ++mi)
#pragma unroll
            for (int ni = 0; ni < SH::NI; ++ni)
                acc[mi][ni] = ((TOKMASK >> ni) & 1u) ? MFMA32(bfr[ni], af[mi], acc[mi][ni]) : MFMA32(af[mi], bfr[ni], acc[mi][ni]);
    }
    if (kt + 1 < nk) {
        unsigned char* sn = lds + ((kt + 1) & 1) * SH::STAGE_BYTES;
#pragma unroll
        for (int i = 0; i < SH::CHUNKS; ++i) *(u32x4*)(sn + lo[i]) = g[CUR ^ 1][i];
    }
    __syncthreads();
}
template <class SH, unsigned TOKMASK>
__device__ __forceinline__ void gemm_mainloop(const unsigned short* __restrict__ A0, long lda, const unsigned short* __restrict__ B0, long ldb, int K,
                                              unsigned char* lds, f32x16 (&acc)[SH::MI][SH::NI], int tid) {
    const int lane = tid & 63, wave = __builtin_amdgcn_readfirstlane(tid >> 6), r32 = lane & 31, hi = lane >> 5;
    const int wm = wave / SH::WN, wn = wave % SH::WN;
    const unsigned short* gp[SH::CHUNKS]; int lo[SH::CHUNKS];
#pragma unroll
    for (int i = 0; i < SH::CHUNKS; ++i) {
        const int c = tid + i * 512, row = c >> 3, kc = c & 7;
        gp[i] = (row < SH::BM) ? (A0 + (long)row * lda + kc * 8) : (B0 + (long)(row - SH::BM) * ldb + kc * 8);
        lo[i] = row * LDS_PITCH + kc * 16;
    }
    u32x4 g[2][SH::CHUNKS];
    const int nk = K >> 6;
#pragma unroll
    for (int i = 0; i < SH::CHUNKS; ++i) { g[0][i] = *(const u32x4*)gp[i]; g[1][i] = *(const u32x4*)(gp[i] + 64); }
#pragma unroll
    for (int i = 0; i < SH::CHUNKS; ++i) *(u32x4*)(lds + lo[i]) = g[0][i];
    __syncthreads();
    const int aoff = (wm * SH::MI * 32 + r32) * LDS_PITCH + hi * 16;
    const int boff = (SH::BM + wn * SH::NI * 32 + r32) * LDS_PITCH + hi * 16;
    for (int kt = 0; kt < nk; kt += 2) {
        gemm_step<SH, TOKMASK, 0>(lds, gp, lo, g, acc, kt, nk, aoff, boff);
        gemm_step<SH, TOKMASK, 1>(lds, gp, lo, g, acc, kt + 1, nk, aoff, boff);
    }
}

__device__ __forceinline__ int nmap_in(int n) {
    if (n < 1280) return n;
    if (n < 1304) return n - 1280 + 1696;
    if (n < 1560) return n - 1304 + 1280;
    if (n < 1688) return n - 1560 + 1536;
    return n - 1688 + 1664;
}
template <int NMAP>
__device__ __forceinline__ void cvt_transpose(float* ldsf, const float* __restrict__ Wsrc, int K, int N, unsigned short* __restrict__ Wt, const float* __restrict__ kgain_lo, const float* __restrict__ kgain_hi, int ksplit, int vb = blockIdx.x, int nb = NBLK) {
    const int tid = tid_();
    float (*tl)[65] = (float (*)[65])ldsf;
    const int tk = K / 64, tn = (N + 63) / 64;
    for (int tile = vb; tile < tk * tn; tile += nb) {
        const int k0 = (tile / tn) * 64, n0 = (tile % tn) * 64;
#pragma unroll
        for (int i = 0; i < 8; ++i) {
            const int kl = (tid >> 6) + 8 * i, nl = tid & 63; const int n = n0 + nl, k = k0 + kl;
            float v = (n < N) ? Wsrc[(long)k * N + n] : 0.f;
            if (kgain_lo) v *= (k < ksplit) ? kgain_lo[k] : kgain_hi[k - ksplit];
            tl[kl][nl] = v;
        }
        __syncthreads();
        {
            const int nl = tid >> 3, kc = (tid & 7) * 8; const int n = n0 + nl;
            if (n < N) {
                uint4 o; o.x = cvtpk(tl[kc][nl], tl[kc + 1][nl]); o.y = cvtpk(tl[kc + 2][nl], tl[kc + 3][nl]); o.z = cvtpk(tl[kc + 4][nl], tl[kc + 5][nl]); o.w = cvtpk(tl[kc + 6][nl], tl[kc + 7][nl]);
                const int nn = NMAP ? nmap_in(n) : n;
                *(uint4*)(Wt + (long)nn * K + k0 + kc) = o;
            }
        }
        __syncthreads();
    }
}

typedef __attribute__((ext_vector_type(4))) float f32x4_t;
namespace g256 {
constexpr int BK = 64, HALF = 128, HT = HALF * BK;
__device__ __forceinline__ int lds_byte(int r, int c) { const int st = (r >> 4) * 2 + (c >> 5), rr = r & 15, cc = c & 31, ob = rr * 64 + cc * 2; return st * 1024 + (ob ^ (((ob >> 9) & 1) << 5)); }
__device__ __forceinline__ void stage_rc(int b, int& R, int& C) { const int st = b / 1024, sb = b % 1024, swz = sb ^ (((sb >> 9) & 1) << 5); R = (st >> 1) * 16 + swz / 64; C = (st & 1) * 32 + (swz % 64) / 2; }
template <int K, int PITCH = K>
__device__ __forceinline__ void mainloop(const unsigned short* __restrict__ A, const unsigned short* __restrict__ Bt, int brow, int bcol, unsigned short* shm, f32x4_t (&acc)[2][2][4][2]) {
#define SA(b, h) (shm + ((b) * 2 + (h)) * HT)
#define SB(b, h) (shm + (4 + (b) * 2 + (h)) * HT)
#define STAGE_X(T, P, BASE, br, kt) do { const AS1 char* ub_ = (const AS1 char*)(BASE) + ((long)(br) * PITCH + (long)(kt) * BK) * 2;     \
    for (int i_ = 0; i_ < 2; ++i_) { const int b_ = (T) * 16 + i_ * 8192; int r_, c_; stage_rc(b_, r_, c_); \
      __builtin_amdgcn_global_load_lds((const AS1 unsigned*)(ub_ + (unsigned)(r_ * PITCH + c_) * 2u), (LAS unsigned*)((LAS char*)(P) + b_), 16, 0, 0); } } while (0)
#define STAGE(P, BASE, br, kt) STAGE_X(tx, P, BASE, br, kt)
#define LDA(dst, b, h) for (int m = 0; m < 4; ++m) for (int k = 0; k < 2; ++k) dst[m][k] = *reinterpret_cast<const bf16x8*>((char*)SA(b, h) + lds_byte(wr * 64 + m * 16 + fr, k * 32 + fq * 8))
#define LDB(dst, b, h) for (int n = 0; n < 2; ++n) for (int k = 0; k < 2; ++k) dst[n][k] = *reinterpret_cast<const bf16x8*>((char*)SB(b, h) + lds_byte(wc * 32 + n * 16 + fr, k * 32 + fq * 8))
#define MMA(ai, bj, At_, Bt_) do { __builtin_amdgcn_s_setprio(1); \
    for (int m = 0; m < 4; ++m) for (int n = 0; n < 2; ++n) for (int k = 0; k < 2; ++k) acc[ai][bj][m][n] = __builtin_amdgcn_mfma_f32_16x16x32_bf16(At_[m][k], Bt_[n][k], acc[ai][bj][m][n], 0, 0, 0); \
    __builtin_amdgcn_s_setprio(0); } while (0)
#define WAIT_V(n) asm volatile("s_waitcnt vmcnt(" #n ")" ::: "memory")
#define WAIT_L(n) asm volatile("s_waitcnt lgkmcnt(" #n ")" ::: "memory")
#define BAR __builtin_amdgcn_s_barrier()
#define SCHED __builtin_amdgcn_sched_barrier(0)
    int tx = threadIdx.x; asm volatile("" : "+v"(tx));
    int wid = tx >> 6, lane = tx & 63, wr = wid >> 2, wc = wid & 3, fr = lane & 15, fq = lane >> 4;
    bf16x8 At[4][2], B0[2][2], B1[2][2];
    const int nt = K / BK;
    STAGE(SB(0, 0), Bt, bcol, 0); STAGE(SA(0, 0), A, brow, 0);
    STAGE(SB(0, 1), Bt, bcol + HALF, 0); STAGE(SA(0, 1), A, brow + HALF, 0);
    if (wr == 1) BAR;
    WAIT_V(4); BAR;
    STAGE(SB(1, 0), Bt, bcol, 1); STAGE(SA(1, 0), A, brow, 1); STAGE(SB(1, 1), Bt, bcol + HALF, 1);
    WAIT_V(6); BAR;
    for (int t = 0; t < nt - 2; t += 2) {
        LDB(B0, 0, 0); SCHED; LDA(At, 0, 0); STAGE(SA(1, 1), A, brow + HALF, t + 1);
        WAIT_L(8); BAR; WAIT_L(0); MMA(0, 0, At, B0); BAR; SCHED;
        LDB(B1, 0, 1); STAGE(SB(0, 0), Bt, bcol, t + 2);
        BAR; WAIT_L(0); MMA(0, 1, At, B1); BAR;
        LDA(At, 0, 1); STAGE(SA(0, 0), A, brow, t + 2);
        BAR; WAIT_L(0); MMA(1, 0, At, B0); BAR; SCHED;
        STAGE(SB(0, 1), Bt, bcol + HALF, t + 2);
        WAIT_V(6); BAR; MMA(1, 1, At, B1); BAR;
        LDB(B0, 1, 0); SCHED; LDA(At, 1, 0); STAGE(SA(0, 1), A, brow + HALF, t + 2);
        WAIT_L(8); BAR; WAIT_L(0); MMA(0, 0, At, B0); BAR; SCHED;
        LDB(B1, 1, 1); STAGE(SB(1, 0), Bt, bcol, t + 3);
        BAR; WAIT_L(0); MMA(0, 1, At, B1); BAR;
        LDA(At, 1, 1); STAGE(SA(1, 0), A, brow, t + 3);
        BAR; WAIT_L(0); MMA(1, 0, At, B0); BAR; SCHED;
        STAGE(SB(1, 1), Bt, bcol + HALF, t + 3);
        WAIT_V(6); BAR; MMA(1, 1, At, B1); BAR;
    }
    int tz = threadIdx.x; asm volatile("" : "+v"(tz)); wid = tz >> 6; lane = tz & 63; wr = wid >> 2; wc = wid & 3; fr = lane & 15; fq = lane >> 4;
    { LDB(B0, 0, 0); WAIT_V(0); LDA(At, 0, 0); STAGE_X(tz, SA(1, 1), A, brow + HALF, nt - 1);
      BAR; WAIT_L(0); MMA(0, 0, At, B0); BAR;
      LDB(B1, 0, 1); BAR; WAIT_L(0); MMA(0, 1, At, B1); BAR;
      LDA(At, 0, 1); WAIT_V(4); BAR; WAIT_L(0); MMA(1, 0, At, B0); MMA(1, 1, At, B1); BAR; }
    { LDB(B0, 1, 0); LDA(At, 1, 0); WAIT_V(2); BAR; WAIT_L(0); MMA(0, 0, At, B0); BAR;
      LDB(B1, 1, 1); WAIT_V(0); BAR; WAIT_L(0); MMA(0, 1, At, B1); BAR;
      LDA(At, 1, 1); BAR; WAIT_L(0); MMA(1, 0, At, B0); MMA(1, 1, At, B1); BAR; }
    if (wr == 0) BAR;
#undef SA
#undef SB
#undef STAGE_X
#undef STAGE
#undef LDA
#undef LDB
#undef MMA
#undef WAIT_V
#undef WAIT_L
#undef BAR
#undef SCHED
}
}

__device__ __forceinline__ void p5_outproj_256(unsigned char* lds, const unsigned short* __restrict__ mix, const unsigned short* __restrict__ wt_out, const float* __restrict__ ssqa, const float* __restrict__ ssqb,
                                               const float* __restrict__ x, float* __restrict__ out, unsigned short* __restrict__ hb, float* __restrict__ hss) {
    const int vcu = (blockIdx.x & 7) * (NBLK / 8) + (blockIdx.x >> 3);
    for (int tile = vcu; tile < 64 * 4; tile += NBLK) {
        const int m0 = (tile >> 2) * 256, n0 = (tile & 3) * 256;
        f32x4_t acc[2][2][4][2];
#pragma unroll
        for (int ai = 0; ai < 2; ++ai)
#pragma unroll
            for (int bj = 0; bj < 2; ++bj)
#pragma unroll
                for (int m = 0; m < 4; ++m)
#pragma unroll
                    for (int n = 0; n < 2; ++n) acc[ai][bj][m][n] = f32x4_t{0.f, 0.f, 0.f, 0.f};
        g256::mainloop<512, 1024>(wt_out, mix, n0, m0, (unsigned short*)lds, acc);
        float rb[2][2];
        {
            const int tid = tid_(); const int lane = tid & 63, wave = __builtin_amdgcn_readfirstlane(tid >> 6), wc = wave & 3, fr = lane & 15;
#pragma unroll
            for (int bj = 0; bj < 2; ++bj)
#pragma unroll
                for (int n = 0; n < 2; ++n) {
                    const long tok = m0 + bj * 128 + wc * 32 + n * 16 + fr; float sa = 0.f, sb = 0.f;
#pragma unroll
                    for (int hh = 0; hh < 8; ++hh) { sa += ssqa[(long)hh * T_ + tok]; sb += ssqb[(long)hh * T_ + tok]; }
                    rb[bj][n] = rsqrtf(sb * (1.f / 512.f) + EPS); const float ratio = rsqrtf(sa * (1.f / 512.f) + EPS) / rb[bj][n];
#pragma unroll
                    for (int ai = 0; ai < 2; ++ai)
#pragma unroll
                        for (int m = 0; m < 4; ++m) acc[ai][bj][m][n] *= ratio;
                }
        }
        g256::mainloop<512, 1024>(wt_out + 512, mix + 512, n0, m0, (unsigned short*)lds, acc);
        const int tid = tid_(); const int lane = tid & 63, wave = __builtin_amdgcn_readfirstlane(tid >> 6), wr = wave >> 2, wc = wave & 3, fr = lane & 15, fq = lane >> 4;
#pragma unroll
        for (int bj = 0; bj < 2; ++bj)
#pragma unroll
            for (int n = 0; n < 2; ++n) {
                const long tok = m0 + bj * 128 + wc * 32 + n * 16 + fr; const float r = rb[bj][n];
                float ss = 0.f;
#pragma unroll
                for (int ai = 0; ai < 2; ++ai)
#pragma unroll
                    for (int m = 0; m < 4; ++m) {
                        const int nrow = n0 + ai * 128 + wr * 64 + m * 16 + fq * 4;
                        const float4 xv = *(const float4*)(x + tok * 1024 + nrow);
                        float4 hv; hv.x = xv.x + acc[ai][bj][m][n][0] * r; hv.y = xv.y + acc[ai][bj][m][n][1] * r; hv.z = xv.z + acc[ai][bj][m][n][2] * r; hv.w = xv.w + acc[ai][bj][m][n][3] * r;
                        *(float4*)(out + tok * 1024 + nrow) = hv;
                        uint2 pk; pk.x = cvtpk(hv.x, hv.y); pk.y = cvtpk(hv.z, hv.w);
                        *(uint2*)(hb + tok * 1024 + nrow) = pk;
                        ss += hv.x * hv.x + hv.y * hv.y + hv.z * hv.z + hv.w * hv.w;
                    }
                { auto r1 = __builtin_amdgcn_permlane16_swap(__float_as_uint(ss), __float_as_uint(ss), false, false); ss = __uint_as_float(r1[0]) + __uint_as_float(r1[1]); }
                ss = pair_sum(ss);
                if (fq == 0) { hss[tok * 16 + (n0 >> 8) * 4 + wr] = ss; hss[tok * 16 + (n0 >> 8) * 4 + 2 + wr] = 0.f; }
            }
        __syncthreads();
    }
}
__device__ __forceinline__ void p6_peerq_256(unsigned char* lds, const unsigned short* __restrict__ hb, const unsigned short* __restrict__ wt_q, const float* __restrict__ hss,
                                             unsigned short* __restrict__ pqb, float* __restrict__ pss) {
    const int vcu = (blockIdx.x & 7) * (NBLK / 8) + (blockIdx.x >> 3);
    for (int tile = vcu; tile < 64 * 8; tile += NBLK) {
        const int m0 = (tile >> 3) * 256, n0 = (tile & 7) * 256;
        f32x4_t acc[2][2][4][2];
#pragma unroll
        for (int ai = 0; ai < 2; ++ai)
#pragma unroll
            for (int bj = 0; bj < 2; ++bj)
#pragma unroll
                for (int m = 0; m < 4; ++m)
#pragma unroll
                    for (int n = 0; n < 2; ++n) acc[ai][bj][m][n] = f32x4_t{0.f, 0.f, 0.f, 0.f};
        g256::mainloop<1024>(wt_q, hb, n0, m0, (unsigned short*)lds, acc);
        const int tid = tid_(); const int lane = tid & 63, wave = __builtin_amdgcn_readfirstlane(tid >> 6), wr = wave >> 2, wc = wave & 3, fr = lane & 15, fq = lane >> 4;
#pragma unroll
        for (int bj = 0; bj < 2; ++bj)
#pragma unroll
            for (int n = 0; n < 2; ++n) {
                const long tok = m0 + bj * 128 + wc * 32 + n * 16 + fr;
                const float4* hp = (const float4*)(hss + tok * 16);
                const float4 s0 = hp[0], s1 = hp[1], s2 = hp[2], s3 = hp[3];
                const float rs = rsqrtf((s0.x + s0.y + s0.z + s0.w + s1.x + s1.y + s1.z + s1.w + s2.x + s2.y + s2.z + s2.w + s3.x + s3.y + s3.z + s3.w) * (1.f / 1024.f) + EPS);
                float ss = 0.f;
#pragma unroll
                for (int ai = 0; ai < 2; ++ai)
#pragma unroll
                    for (int m = 0; m < 4; ++m) {
                        const int nrow = n0 + ai * 128 + wr * 64 + m * 16 + fq * 4;
                        const float v0 = acc[ai][bj][m][n][0] * rs, v1 = acc[ai][bj][m][n][1] * rs, v2 = acc[ai][bj][m][n][2] * rs, v3 = acc[ai][bj][m][n][3] * rs;
                        uint2 pk; pk.x = cvtpk(v0, v1); pk.y = cvtpk(v2, v3);
                        *(uint2*)(pqb + tok * 2048 + nrow) = pk;
                        ss += v0 * v0 + v1 * v1 + v2 * v2 + v3 * v3;
                    }
                { auto r1 = __builtin_amdgcn_permlane16_swap(__float_as_uint(ss), __float_as_uint(ss), false, false); ss = __uint_as_float(r1[0]) + __uint_as_float(r1[1]); }
                ss = pair_sum(ss);
                if (fq == 0) { pss[tok * 32 + (n0 >> 8) * 4 + wr] = ss; pss[tok * 32 + (n0 >> 8) * 4 + 2 + wr] = 0.f; }
            }
        __syncthreads();
    }
}

__device__ __forceinline__ unsigned ordkey(float f) { const unsigned u = __float_as_uint(f); return (u & 0x80000000u) ? ~u : (u | 0x80000000u); }
__device__ __forceinline__ float orddec(unsigned k) { return __uint_as_float((k & 0x80000000u) ? (k & 0x7fffffffu) : ~k); }
#define CE_DESC(a, b) do { const unsigned mx_ = max(a, b), mn_ = min(a, b); a = mx_; b = mn_; } while (0)
__device__ __forceinline__ void sort16_desc(unsigned (&v)[16]) {
#pragma unroll
    for (int k = 2; k <= 16; k <<= 1)
#pragma unroll
        for (int j = k >> 1; j > 0; j >>= 1)
#pragma unroll
            for (int i = 0; i < 16; ++i) {
                const int l = i ^ j;
                if (l > i) { if ((i & k) == 0) { CE_DESC(v[i], v[l]); } else { CE_DESC(v[l], v[i]); } }
            }
}
__device__ __forceinline__ void merge16_desc(unsigned (&a)[16], const unsigned (&b)[16]) {
#pragma unroll
    for (int i = 0; i < 16; ++i) a[i] = max(a[i], b[15 - i]);
#pragma unroll
    for (int j = 8; j > 0; j >>= 1)
#pragma unroll
        for (int i = 0; i < 16; ++i) { const int l = i ^ j; if (l > i) CE_DESC(a[i], a[l]); }
}
__device__ __forceinline__ void top16_of_lanepair(unsigned (&k0)[16], unsigned (&k1)[16], unsigned (&k2)[16], unsigned (&k3)[16]) {
    sort16_desc(k0); sort16_desc(k1); sort16_desc(k2); sort16_desc(k3);
    merge16_desc(k0, k1); merge16_desc(k2, k3); merge16_desc(k0, k2);
    unsigned o[16];
#pragma unroll
    for (int i = 0; i < 16; ++i) { auto rr = __builtin_amdgcn_permlane32_swap(k0[i], k0[i], false, false); k0[i] = rr[0]; o[i] = rr[1]; }
    merge16_desc(k0, o);
}
__device__ __forceinline__ void peer_route_mfma(unsigned char* lds, const unsigned short* __restrict__ pqb, const float* __restrict__ pss, const unsigned short* __restrict__ sk16, int* __restrict__ eo, float* __restrict__ go) {
    const int tid = tid_(); const int lane = tid & 63, w = __builtin_amdgcn_readfirstlane(tid >> 6), r32 = lane & 31, hi = lane >> 5;
    const int h = blockIdx.x & 7;
    constexpr int SKP = 272;
    for (int c16 = tid; c16 < 256 * 16; c16 += 512) { const int row = c16 >> 4, ch = c16 & 15; *(uint4*)(lds + row * SKP + ch * 16) = *(const uint4*)(sk16 + ((long)h * 256 + row) * 128 + ch * 8); }
    __syncthreads();
    for (int it = 0; it < 2; ++it) {
        const long tok = (long)((blockIdx.x >> 3) * 16 + w * 2 + it) * 32 + r32;
        const float4 ps = *(const float4*)(pss + tok * 32 + h * 4);
        const float rs = rsqrtf((ps.x + ps.y + ps.z + ps.w) * (1.f / 256.f) + EPS);
        unsigned T1[16], T2[16];
#pragma unroll
        for (int c = 0; c < 2; ++c) {
            f32x16 acc[4];
#pragma unroll
            for (int mt = 0; mt < 4; ++mt)
#pragma unroll
                for (int r = 0; r < 16; ++r) acc[mt][r] = 0.f;
            const unsigned short* qrow = pqb + tok * 2048 + h * 256 + c * 128 + hi * 8;
            const unsigned char* krow = lds + (c * 128 + r32) * SKP + hi * 16;
#pragma unroll 2
            for (int ks = 0; ks < 8; ++ks) {
                const bf16x8 qf = *(const bf16x8*)(qrow + ks * 16);
#pragma unroll
                for (int mt = 0; mt < 4; ++mt) { const bf16x8 kf = *(const bf16x8*)(krow + mt * 32 * SKP + ks * 32); acc[mt] = MFMA32(kf, qf, acc[mt]); }
            }
            unsigned k0[16], k1[16], k2[16], k3[16];
#pragma unroll
            for (int r = 0; r < 16; ++r) {
                const unsigned idx = 127u - (unsigned)crow(r, hi);
                k0[r] = (ordkey(acc[0][r] * rs) & ~127u) | idx; k1[r] = (ordkey(acc[1][r] * rs) & ~127u) | (idx - 32u);
                k2[r] = (ordkey(acc[2][r] * rs) & ~127u) | (idx - 64u); k3[r] = (ordkey(acc[3][r] * rs) & ~127u) | (idx - 96u);
            }
            top16_of_lanepair(k0, k1, k2, k3);
            if (c == 0) {
#pragma unroll
                for (int i = 0; i < 16; ++i) T1[i] = k0[i];
            } else {
#pragma unroll
                for (int i = 0; i < 16; ++i) T2[i] = k0[i];
            }
        }
        float v1[16], v2[16]; unsigned p1[4] = {0u, 0u, 0u, 0u}, p2[4] = {0u, 0u, 0u, 0u};
#pragma unroll
        for (int i = 0; i < 16; ++i) {
            v1[i] = orddec(T1[i] & ~127u); v2[i] = orddec(T2[i] & ~127u);
            p1[i >> 2] |= (127u - (T1[i] & 127u)) << (8 * (i & 3)); p2[i >> 2] |= (127u - (T2[i] & 127u)) << (8 * (i & 3));
        }
        unsigned c0[16], c1[16], c2[16], c3[16];
#define CAND(a, b) ((ordkey(v1[a] + v2[b]) & ~255u) | (255u - (unsigned)((a) * 16 + (b))))
        c0[0] = CAND(0, 0); c0[1] = CAND(0, 1); c0[2] = CAND(0, 2); c0[3] = CAND(0, 3); c0[4] = CAND(0, 4); c0[5] = CAND(0, 5); c0[6] = CAND(0, 6); c0[7] = CAND(0, 7);
        c0[8] = CAND(0, 8); c0[9] = CAND(0, 9); c0[10] = CAND(0, 10); c0[11] = CAND(0, 11); c0[12] = CAND(0, 12); c0[13] = CAND(0, 13); c0[14] = CAND(0, 14); c0[15] = CAND(0, 15);
        c1[0] = CAND(1, 0); c1[1] = CAND(1, 1); c1[2] = CAND(1, 2); c1[3] = CAND(1, 3); c1[4] = CAND(1, 4); c1[5] = CAND(1, 5); c1[6] = CAND(1, 6); c1[7] = CAND(1, 7);
        c1[8] = CAND(2, 0); c1[9] = CAND(2, 1); c1[10] = CAND(2, 2); c1[11] = CAND(2, 3); c1[12] = CAND(2, 4); c1[13] = CAND(3, 0); c1[14] = CAND(3, 1); c1[15] = CAND(3, 2);
        c2[0] = CAND(3, 3); c2[1] = CAND(4, 0); c2[2] = CAND(4, 1); c2[3] = CAND(4, 2); c2[4] = CAND(5, 0); c2[5] = CAND(5, 1); c2[6] = CAND(6, 0); c2[7] = CAND(6, 1);
        c2[8] = CAND(7, 0); c2[9] = CAND(7, 1); c2[10] = CAND(8, 0); c2[11] = CAND(9, 0); c2[12] = CAND(10, 0); c2[13] = CAND(11, 0); c2[14] = CAND(12, 0); c2[15] = CAND(13, 0);
        c3[0] = CAND(14, 0); c3[1] = CAND(15, 0);
#pragma unroll
        for (int i = 2; i < 16; ++i) c3[i] = 0u;
#undef CAND
        sort16_desc(c0); sort16_desc(c1); sort16_desc(c2); sort16_desc(c3);
        merge16_desc(c0, c1); merge16_desc(c2, c3); merge16_desc(c0, c2);
        float ev[16]; int ee[16]; float l = 0.f; const float mx = orddec(c0[0] & ~255u);
#pragma unroll
        for (int i = 0; i < 16; ++i) {
            const unsigned ci = 255u - (c0[i] & 255u); const unsigned a = ci >> 4, b = ci & 15u;
            const unsigned wa = (a >> 2) == 0 ? p1[0] : ((a >> 2) == 1 ? p1[1] : ((a >> 2) == 2 ? p1[2] : p1[3]));
            const unsigned wb = (b >> 2) == 0 ? p2[0] : ((b >> 2) == 1 ? p2[1] : ((b >> 2) == 2 ? p2[2] : p2[3]));
            const unsigned i1 = (wa >> (8 * (a & 3u))) & 255u, i2 = (wb >> (8 * (b & 3u))) & 255u;
            ee[i] = (int)(i1 * 128u + i2);
            ev[i] = __expf(orddec(c0[i] & ~255u) - mx); l += ev[i];
        }
        const float inv = 1.f / l;
        if (hi == 0) {
            int4* ep = (int4*)(eo + tok * 128 + h * 16);
            ep[0] = make_int4(ee[0], ee[1], ee[2], ee[3]); ep[1] = make_int4(ee[4], ee[5], ee[6], ee[7]); ep[2] = make_int4(ee[8], ee[9], ee[10], ee[11]); ep[3] = make_int4(ee[12], ee[13], ee[14], ee[15]);
        } else {
            float4* gp = (float4*)(go + tok * 128 + h * 16);
            gp[0] = make_float4(ev[0] * inv, ev[1] * inv, ev[2] * inv, ev[3] * inv); gp[1] = make_float4(ev[4] * inv, ev[5] * inv, ev[6] * inv, ev[7] * inv);
            gp[2] = make_float4(ev[8] * inv, ev[9] * inv, ev[10] * inv, ev[11] * inv); gp[3] = make_float4(ev[12] * inv, ev[13] * inv, ev[14] * inv, ev[15] * inv);
        }
    }
}

template <int DQK>
struct FA {
    static constexpr int NDS = DQK / 16, KP = DQK * 2 + 16, KBYTES = 64 * KP, VP = 144, VBYTES = 64 * VP, STAGE = KBYTES + VBYTES;
    static constexpr int KCH = 64 * DQK / 8, NCH = KCH + 512, SLOTS = (NCH + 511) / 512;
};
constexpr float FA_THR = 8.f;
constexpr float FA_NEG = -1e30f;
struct FaRegs { uint4 g0, g1, g2; };
template <int DQK>
__device__ __forceinline__ uint4 fa_load1(const unsigned short* __restrict__ Kg, int kpitch, const unsigned short* __restrict__ Vg, int vpitch, int tid, int i) {
    int c = tid + i * 512; if (c >= FA<DQK>::NCH) c = 0;
    const int key = c / (DQK / 8), kc = c % (DQK / 8); const int c2 = c - FA<DQK>::KCH; const int d = c2 >> 3, vc = c2 & 7;
    const unsigned koff = (unsigned)(key * kpitch + kc * 8) * 2u, voff = (unsigned)(d * vpitch + vc * 8) * 2u;
#if defined(__HIP_DEVICE_COMPILE__)
    typedef unsigned u32x4_t __attribute__((ext_vector_type(4)));
    const u32x4_t v = (c < FA<DQK>::KCH) ? *(const AS1 u32x4_t*)((const AS1 char*)Kg + koff) : *(const AS1 u32x4_t*)((const AS1 char*)Vg + voff);
    return make_uint4(v.x, v.y, v.z, v.w);
#else
    (void)koff; (void)voff; return make_uint4(0u, 0u, 0u, 0u);
#endif
}
template <int DQK>
__device__ __forceinline__ void fa_store1(unsigned char* st, const uint4& g, int tid, int i) {
    const int c = tid + i * 512;
    const int key = c / (DQK / 8), kc = c % (DQK / 8); const int c2 = c - FA<DQK>::KCH; const int d = c2 >> 3, vc = c2 & 7;
    const int off = (c < FA<DQK>::KCH) ? (key * FA<DQK>::KP + kc * 16) : (FA<DQK>::KBYTES + d * FA<DQK>::VP + vc * 16);
    if (c < FA<DQK>::NCH) *(uint4*)(st + off) = g;
}
template <int DQK>
__device__ __forceinline__ void fa_load(const unsigned short* __restrict__ Kg, int kpitch, const unsigned short* __restrict__ Vg, int vpitch, FaRegs& g, int tid) {
    g.g0 = fa_load1<DQK>(Kg, kpitch, Vg, vpitch, tid, 0); g.g1 = fa_load1<DQK>(Kg, kpitch, Vg, vpitch, tid, 1);
    if (FA<DQK>::SLOTS > 2) g.g2 = fa_load1<DQK>(Kg, kpitch, Vg, vpitch, tid, 2);
}
template <int DQK>
__device__ __forceinline__ void fa_store(unsigned char* st, const FaRegs& g, int tid) {
    fa_store1<DQK>(st, g.g0, tid, 0); fa_store1<DQK>(st, g.g1, tid, 1);
    if (FA<DQK>::SLOTS > 2) fa_store1<DQK>(st, g.g2, tid, 2);
}
template <int DQK, int MODE, bool STATS_ONLY = false>
__device__ __forceinline__ void fa_tile(const unsigned char* st, const bf16x8 (&qf)[FA<DQK>::NDS], f32x16 (&o)[2], float& mref, float& l, int key0, int qpos, int lane, bool need_mask, bool colsel = true) {
    asm volatile("" : "+v"(lane));
    const int r32 = lane & 31, hi = lane >> 5;
    f32x16 s0, s1;
#pragma unroll
    for (int r = 0; r < 16; ++r) { s0[r] = 0.f; s1[r] = 0.f; }
    {
        bf16x8 k0 = *(const bf16x8*)(st + r32 * FA<DQK>::KP + hi * 16);
        bf16x8 k1 = *(const bf16x8*)(st + (32 + r32) * FA<DQK>::KP + hi * 16);
#pragma unroll
        for (int ds = 0; ds < FA<DQK>::NDS; ++ds) {
            bf16x8 n0 = k0, n1 = k1;
            if (ds + 1 < FA<DQK>::NDS) {
                n0 = *(const bf16x8*)(st + r32 * FA<DQK>::KP + (ds + 1) * 32 + hi * 16);
                n1 = *(const bf16x8*)(st + (32 + r32) * FA<DQK>::KP + (ds + 1) * 32 + hi * 16);
            }
            s0 = MFMA32(k0, qf[ds], s0); s1 = MFMA32(k1, qf[ds], s1);
            k0 = n0; k1 = n1;
            __builtin_amdgcn_sched_barrier(0);
        }
    }
    __builtin_amdgcn_sched_barrier(0);
    if (MODE != 0 && need_mask) {
#pragma unroll
        for (int r = 0; r < 16; ++r) {
            const int ka = key0 + crow(r, hi), kb = ka + 32;
            bool ma, mb;
            if (MODE == 4) { ma = 16 * ka + 31 > qpos; mb = 16 * kb + 31 > qpos; }
            else { ma = ka > qpos; mb = kb > qpos; }
            if (MODE == 2) { ma = ma || (ka <= qpos - 512); mb = mb || (kb <= qpos - 512); }
            if (ma) s0[r] = -INFINITY;
            if (mb) s1[r] = -INFINITY;
        }
    }
    if (MODE == 3) {
        if (!colsel) {
#pragma unroll
            for (int r = 0; r < 16; ++r) { s0[r] = -INFINITY; s1[r] = -INFINITY; }
        }
    }
    float mx = fmaxf(s0[0], s1[0]);
#pragma unroll
    for (int r = 1; r < 16; ++r) mx = fmaxf(mx, fmaxf(s0[r], s1[r]));
    mx = pair_max(mx);
    if (__any(mx > mref + FA_THR)) {
        const float mnew = (mx > mref + FA_THR) ? mx : mref;
        const float alpha = __builtin_amdgcn_exp2f(mref - mnew);
        mref = mnew; l *= alpha;
#pragma unroll
        for (int r = 0; r < 16; ++r) { o[0][r] *= alpha; o[1][r] *= alpha; }
    }
    float ps = 0.f;
#pragma unroll
    for (int r = 0; r < 16; ++r) { s0[r] = __builtin_amdgcn_exp2f(s0[r] - mref); s1[r] = __builtin_amdgcn_exp2f(s1[r] - mref); ps += s0[r] + s1[r]; }
    l += ps;
    if (STATS_ONLY) return;
    bf16x8 pk[4];
#pragma unroll
    for (int s = 0; s < 2; ++s) {
        uint4 a, b;
        a.x = cvtpk(s0[8 * s], s0[8 * s + 1]); a.y = cvtpk(s0[8 * s + 2], s0[8 * s + 3]); a.z = cvtpk(s0[8 * s + 4], s0[8 * s + 5]); a.w = cvtpk(s0[8 * s + 6], s0[8 * s + 7]);
        b.x = cvtpk(s1[8 * s], s1[8 * s + 1]); b.y = cvtpk(s1[8 * s + 2], s1[8 * s + 3]); b.z = cvtpk(s1[8 * s + 4], s1[8 * s + 5]); b.w = cvtpk(s1[8 * s + 6], s1[8 * s + 7]);
        pk[s] = __builtin_bit_cast(bf16x8, a); pk[2 + s] = __builtin_bit_cast(bf16x8, b);
    }
    const unsigned char* vt = st + FA<DQK>::KBYTES;
    __builtin_amdgcn_sched_barrier(0);
    {
        bf16x8 v0 = *(const bf16x8*)(vt + r32 * FA<DQK>::VP + hi * 16);
        bf16x8 v1 = *(const bf16x8*)(vt + (32 + r32) * FA<DQK>::VP + hi * 16);
#pragma unroll
        for (int ks = 0; ks < 4; ++ks) {
            bf16x8 n0 = v0, n1 = v1;
            if (ks + 1 < 4) {
                n0 = *(const bf16x8*)(vt + r32 * FA<DQK>::VP + (ks + 1) * 32 + hi * 16);
                n1 = *(const bf16x8*)(vt + (32 + r32) * FA<DQK>::VP + (ks + 1) * 32 + hi * 16);
            }
            o[0] = MFMA32(v0, pk[ks], o[0]); o[1] = MFMA32(v1, pk[ks], o[1]);
            v0 = n0; v1 = n1;
            __builtin_amdgcn_sched_barrier(0);
        }
    }
}
template <int DQK>
__device__ __forceinline__ void fa_qk(const unsigned char* st, const bf16x8 (&qf)[FA<DQK>::NDS], f32x16& s0, f32x16& s1, int lane) {
    const int r32 = lane & 31, hi = lane >> 5;
#pragma unroll
    for (int r = 0; r < 16; ++r) { s0[r] = 0.f; s1[r] = 0.f; }
#pragma unroll
    for (int ds = 0; ds < FA<DQK>::NDS; ++ds) {
        const bf16x8 k0 = *(const bf16x8*)(st + r32 * FA<DQK>::KP + ds * 32 + hi * 16);
        const bf16x8 k1 = *(const bf16x8*)(st + (32 + r32) * FA<DQK>::KP + ds * 32 + hi * 16);
        s0 = MFMA32(k0, qf[ds], s0); s1 = MFMA32(k1, qf[ds], s1);
    }
}
template <int DQK, int MODE>
__device__ __forceinline__ void fa_step(const unsigned char* stc, const unsigned char* stn, const bf16x8 (&qf)[FA<DQK>::NDS], f32x16& s0, f32x16& s1, f32x16& n0, f32x16& n1,
                                        f32x16 (&o)[2], float& mref, float& l, int key0, int qpos, int lane, bool need_mask, bool colsel = true) {
    const int r32 = lane & 31, hi = lane >> 5;
    if (MODE != 0 && need_mask) {
#pragma unroll
        for (int r = 0; r < 16; ++r) {
            const int ka = key0 + crow(r, hi), kb = ka + 32;
            bool ma, mb;
            if (MODE == 4) { ma = 16 * ka + 31 > qpos; mb = 16 * kb + 31 > qpos; }
            else { ma = ka > qpos; mb = kb > qpos; }
            if (MODE == 2) { ma = ma || (ka <= qpos - 512); mb = mb || (kb <= qpos - 512); }
            if (ma) s0[r] = -INFINITY;
            if (mb) s1[r] = -INFINITY;
        }
    }
    if (MODE == 3) {
        if (!colsel) {
#pragma unroll
            for (int r = 0; r < 16; ++r) { s0[r] = -INFINITY; s1[r] = -INFINITY; }
        }
    }
    float mx = fmaxf(s0[0], s1[0]);
#pragma unroll
    for (int r = 1; r < 16; ++r) mx = fmaxf(mx, fmaxf(s0[r], s1[r]));
    mx = pair_max(mx);
    if (__any(mx > mref + FA_THR)) {
        const float mnew = (mx > mref + FA_THR) ? mx : mref;
        const float alpha = __builtin_amdgcn_exp2f(mref - mnew);
        mref = mnew; l *= alpha;
#pragma unroll
        for (int r = 0; r < 16; ++r) { o[0][r] *= alpha; o[1][r] *= alpha; }
    }
    __builtin_amdgcn_sched_barrier(0);
#pragma unroll
    for (int r = 0; r < 16; ++r) { n0[r] = 0.f; n1[r] = 0.f; }
    float ps = 0.f;
    constexpr int PER = (32 + FA<DQK>::NDS - 1) / FA<DQK>::NDS;
    {
        bf16x8 k0 = *(const bf16x8*)(stn + r32 * FA<DQK>::KP + hi * 16);
        bf16x8 k1 = *(const bf16x8*)(stn + (32 + r32) * FA<DQK>::KP + hi * 16);
#pragma unroll
        for (int ds = 0; ds < FA<DQK>::NDS; ++ds) {
            bf16x8 f0 = k0, f1 = k1;
            if (ds + 1 < FA<DQK>::NDS) {
                f0 = *(const bf16x8*)(stn + r32 * FA<DQK>::KP + (ds + 1) * 32 + hi * 16);
                f1 = *(const bf16x8*)(stn + (32 + r32) * FA<DQK>::KP + (ds + 1) * 32 + hi * 16);
            }
            n0 = MFMA32(k0, qf[ds], n0); n1 = MFMA32(k1, qf[ds], n1);
#pragma unroll
            for (int j = ds * PER; j < (ds + 1) * PER && j < 32; ++j) {
                if (j < 16) { s0[j] = __builtin_amdgcn_exp2f(s0[j] - mref); ps += s0[j]; }
                else { s1[j - 16] = __builtin_amdgcn_exp2f(s1[j - 16] - mref); ps += s1[j - 16]; }
            }
            asm volatile("" : "+v"(ps));
            k0 = f0; k1 = f1;
            __builtin_amdgcn_sched_barrier(0);
        }
    }
    l += ps;
    bf16x8 pk[4];
#pragma unroll
    for (int s = 0; s < 2; ++s) {
        uint4 a, b;
        a.x = cvtpk(s0[8 * s], s0[8 * s + 1]); a.y = cvtpk(s0[8 * s + 2], s0[8 * s + 3]); a.z = cvtpk(s0[8 * s + 4], s0[8 * s + 5]); a.w = cvtpk(s0[8 * s + 6], s0[8 * s + 7]);
        b.x = cvtpk(s1[8 * s], s1[8 * s + 1]); b.y = cvtpk(s1[8 * s + 2], s1[8 * s + 3]); b.z = cvtpk(s1[8 * s + 4], s1[8 * s + 5]); b.w = cvtpk(s1[8 * s + 6], s1[8 * s + 7]);
        pk[s] = __builtin_bit_cast(bf16x8, a); pk[2 + s] = __builtin_bit_cast(bf16x8, b);
    }
    const unsigned char* vt = stc + FA<DQK>::KBYTES;
    {
        bf16x8 v0 = *(const bf16x8*)(vt + r32 * FA<DQK>::VP + hi * 16);
        bf16x8 v1 = *(const bf16x8*)(vt + (32 + r32) * FA<DQK>::VP + hi * 16);
#pragma unroll
        for (int ks = 0; ks < 4; ++ks) {
            bf16x8 f0 = v0, f1 = v1;
            if (ks + 1 < 4) {
                f0 = *(const bf16x8*)(vt + r32 * FA<DQK>::VP + (ks + 1) * 32 + hi * 16);
                f1 = *(const bf16x8*)(vt + (32 + r32) * FA<DQK>::VP + (ks + 1) * 32 + hi * 16);
            }
            o[0] = MFMA32(v0, pk[ks], o[0]); o[1] = MFMA32(v1, pk[ks], o[1]);
            v0 = f0; v1 = f1;
            __builtin_amdgcn_sched_barrier(0);
        }
    }
}
__device__ __forceinline__ int vperm(int s) { const int g = (s >> 2) & 3; const int pg = (g == 1) ? 2 : ((g == 2) ? 1 : g); return (s & ~15) | (pg << 2) | (s & 3); }

constexpr float MLA_QSCALE = 0.10206207261596575f * 1.4426950408889634f;
__device__ __forceinline__ void mla_unit(unsigned char* lds, int b, int h, int qb, const unsigned short* __restrict__ Q16, const unsigned short* __restrict__ K16, const unsigned short* __restrict__ VT16,
                                         unsigned short* __restrict__ ob16, float* __restrict__ ssqb, int tid) {
    typedef FA<96> F;
    const int lane = tid & 63, wave = __builtin_amdgcn_readfirstlane(tid >> 6), r32 = lane & 31, hi = lane >> 5;
    const int q0 = qb * 256, qpos = q0 + wave * 32 + r32; const long tok = (long)b * S_ + qpos;
    bf16x8 qf[F::NDS];
#pragma unroll
    for (int ds = 0; ds < F::NDS; ++ds) qf[ds] = *(const bf16x8*)(Q16 + tok * 768 + h * 96 + ds * 16 + hi * 8);
    f32x16 o[2];
#pragma unroll
    for (int r = 0; r < 16; ++r) { o[0][r] = 0.f; o[1][r] = 0.f; }
    float mref = FA_NEG, l = 0.f;
    const unsigned short* Kb = K16 + ((long)(b * 8 + h)) * S_ * 96;
    const unsigned short* Vb = VT16 + ((long)(b * 8 + h)) * 64 * S_;
    const int nt = (q0 + 256) / 64;
    FaRegs g;
    fa_load<96>(Kb, 96, Vb, S_, g, tid); fa_store<96>(lds, g, tid);
    fa_load<96>(Kb + (long)64 * 96, 96, Vb + 64, S_, g, tid); fa_store<96>(lds + F::STAGE, g, tid);
    __syncthreads();
    const int wmin = q0 + wave * 32, wmax = wmin + 31;
    f32x16 sa0, sa1, sb0, sb1;
    fa_qk<96>(lds, qf, sa0, sa1, lane);
#define MLA_STEP(C0, C1, N0, N1, t) do { \
        const int sc_ = (t) % 3, sn_ = ((t) + 1) % 3, sw_ = ((t) + 2) % 3; \
        if ((t) + 2 < nt) fa_load<96>(Kb + (long)((t) + 2) * 64 * 96, 96, Vb + ((t) + 2) * 64, S_, g, tid); \
        const int key0 = (t) * 64; \
        if (key0 <= wmax) fa_step<96, 1>(lds + sc_ * F::STAGE, lds + sn_ * F::STAGE, qf, C0, C1, N0, N1, o, mref, l, key0, qpos, lane, key0 + 63 > wmin); \
        if ((t) + 2 < nt) fa_store<96>(lds + sw_ * F::STAGE, g, tid); \
        __syncthreads(); } while (0)
    for (int t = 0; t < nt; t += 2) {
        MLA_STEP(sa0, sa1, sb0, sb1, t);
        MLA_STEP(sb0, sb1, sa0, sa1, t + 1);
    }
#undef MLA_STEP
    l = pair_sum(l);
    const float inv = 1.f / l;
    float ss = 0.f;
#pragma unroll
    for (int dt = 0; dt < 2; ++dt)
#pragma unroll
        for (int gq = 0; gq < 4; ++gq) {
            const float v0 = o[dt][4 * gq] * inv, v1 = o[dt][4 * gq + 1] * inv, v2 = o[dt][4 * gq + 2] * inv, v3 = o[dt][4 * gq + 3] * inv;
            uint2 pk; pk.x = cvtpk(v0, v1); pk.y = cvtpk(v2, v3);
            *(uint2*)(ob16 + tok * 1024 + 512 + h * 64 + dt * 32 + 8 * gq + 4 * hi) = pk;
            ss += v0 * v0 + v1 * v1 + v2 * v2 + v3 * v3;
        }
    ss = pair_sum(ss);
    if (hi == 0) ssqb[(long)h * T_ + tok] = ss;
}
__device__ __forceinline__ void mla_phase(unsigned char* lds, const unsigned short* __restrict__ Q16, const unsigned short* __restrict__ K16, const unsigned short* __restrict__ VT16,
                                          unsigned short* __restrict__ ob16, float* __restrict__ ssqb) {
    const int tid = tid_();
    for (int i = blockIdx.x; i < 256; i += NBLK) {
        const int xcd = i & 7, slot = i >> 3;
        { const int bh = xcd * 2; mla_unit(lds, bh >> 3, bh & 7, 31 - slot, Q16, K16, VT16, ob16, ssqb, tid); }
        { const int bh = xcd * 2 + 1; mla_unit(lds, bh >> 3, bh & 7, slot, Q16, K16, VT16, ob16, ssqb, tid); }
    }
}
constexpr float NSA_QSCALE = 0.125f * 1.4426950408889634f;
constexpr int IMP_PITCH = 129;
__device__ __forceinline__ void fa_tile_cmp2(const unsigned char* st, const bf16x8 (&qf)[4], f32x16 (&o)[2], float mref, float linv, int key0, int qpos, int lane, float* imp_row) {
    typedef FA<64> F;
    asm volatile("" : "+v"(lane));
    const int r32 = lane & 31, hi = lane >> 5;
    f32x16 s0, s1;
#pragma unroll
    for (int r = 0; r < 16; ++r) { s0[r] = 0.f; s1[r] = 0.f; }
#pragma unroll
    for (int ds = 0; ds < 4; ++ds) {
        const bf16x8 k0 = *(const bf16x8*)(st + r32 * F::KP + ds * 32 + hi * 16);
        const bf16x8 k1 = *(const bf16x8*)(st + (32 + r32) * F::KP + ds * 32 + hi * 16);
        s0 = MFMA32(k0, qf[ds], s0); s1 = MFMA32(k1, qf[ds], s1);
    }
#pragma unroll
    for (int r = 0; r < 16; ++r) {
        const int ka = key0 + crow(r, hi), kb = ka + 32;
        s0[r] = (16 * ka + 31 > qpos) ? 0.f : __builtin_amdgcn_exp2f(s0[r] - mref) * linv;
        s1[r] = (16 * kb + 31 > qpos) ? 0.f : __builtin_amdgcn_exp2f(s1[r] - mref) * linv;
    }
    bf16x8 pk[4];
#pragma unroll
    for (int s = 0; s < 2; ++s) {
        uint4 a, b;
        a.x = cvtpk(s0[8 * s], s0[8 * s + 1]); a.y = cvtpk(s0[8 * s + 2], s0[8 * s + 3]); a.z = cvtpk(s0[8 * s + 4], s0[8 * s + 5]); a.w = cvtpk(s0[8 * s + 6], s0[8 * s + 7]);
        b.x = cvtpk(s1[8 * s], s1[8 * s + 1]); b.y = cvtpk(s1[8 * s + 2], s1[8 * s + 3]); b.z = cvtpk(s1[8 * s + 4], s1[8 * s + 5]); b.w = cvtpk(s1[8 * s + 6], s1[8 * s + 7]);
        pk[s] = __builtin_bit_cast(bf16x8, a); pk[2 + s] = __builtin_bit_cast(bf16x8, b);
    }
    const unsigned char* vt = st + F::KBYTES;
#pragma unroll
    for (int ks = 0; ks < 4; ++ks) {
        const bf16x8 v0 = *(const bf16x8*)(vt + r32 * F::VP + ks * 32 + hi * 16);
        const bf16x8 v1 = *(const bf16x8*)(vt + (32 + r32) * F::VP + ks * 32 + hi * 16);
        o[0] = MFMA32(v0, pk[ks], o[0]); o[1] = MFMA32(v1, pk[ks], o[1]);
    }
#pragma unroll
    for (int r = 0; r < 16; ++r) {
        s0[r] = quad_sum(s0[r]); s1[r] = quad_sum(s1[r]);
    }
    if ((lane & 3) == 0) {
#pragma unroll
        for (int g4 = 0; g4 < 4; ++g4) {
            { const int j = (key0 + 8 * g4 + 4 * hi) >> 2;
              atomicAdd(imp_row + j, s0[4 * g4] + s0[4 * g4 + 1] + s0[4 * g4 + 2] + s0[4 * g4 + 3]);
              if (j + 1 < 128) atomicAdd(imp_row + j + 1, s0[4 * g4 + 3]); }
            { const int j = (key0 + 32 + 8 * g4 + 4 * hi) >> 2;
              atomicAdd(imp_row + j, s1[4 * g4] + s1[4 * g4 + 1] + s1[4 * g4 + 2] + s1[4 * g4 + 3]);
              if (j + 1 < 128) atomicAdd(imp_row + j + 1, s1[4 * g4 + 3]); }
        }
    }
}
#define NSA_STEP_(GCUR, GNEXT, Kbase, kpitch, Vbase, vpitch, t_lo, t_hi, t_, ...) do { \
        const unsigned char* st = stg + (((t_) - (t_lo)) & 1) * FA<64>::STAGE; \
        if ((t_) + 2 <= (t_hi)) fa_load<64>((Kbase) + (long)((t_) + 2) * 64 * (kpitch), (kpitch), (Vbase) + ((t_) + 2) * 64, (vpitch), GCUR, tid); \
        const int key0 = (t_) * 64; (void)key0; \
        __VA_ARGS__ \
        if ((t_) + 1 <= (t_hi)) fa_store<64>(stg + (((t_) + 1 - (t_lo)) & 1) * FA<64>::STAGE, GNEXT, tid); \
        __syncthreads(); } while (0)
#define NSA_STREAM(Kbase, kpitch, Vbase, vpitch, t_lo, t_hi, ...) do { \
    FaRegs ga_, gb_; fa_load<64>((Kbase) + (long)(t_lo) * 64 * (kpitch), (kpitch), (Vbase) + (t_lo) * 64, (vpitch), ga_, tid); \
    if ((t_lo) + 1 <= (t_hi)) fa_load<64>((Kbase) + (long)((t_lo) + 1) * 64 * (kpitch), (kpitch), (Vbase) + ((t_lo) + 1) * 64, (vpitch), gb_, tid); \
    fa_store<64>(stg, ga_, tid); __syncthreads(); \
    for (int t_ = (t_lo); t_ <= (t_hi); t_ += 2) { \
        NSA_STEP_(ga_, gb_, Kbase, kpitch, Vbase, vpitch, t_lo, t_hi, t_, __VA_ARGS__); \
        if (t_ + 1 <= (t_hi)) { const int tt_ = t_ + 1; NSA_STEP2_(gb_, ga_, Kbase, kpitch, Vbase, vpitch, t_lo, t_hi, tt_, __VA_ARGS__); } \
    } } while (0)
#define NSA_STEP2_(GCUR, GNEXT, Kbase, kpitch, Vbase, vpitch, t_lo, t_hi, tq_, ...) do { \
        const int t_ = tq_; \
        const unsigned char* st = stg + ((t_ - (t_lo)) & 1) * FA<64>::STAGE; \
        if (t_ + 2 <= (t_hi)) fa_load<64>((Kbase) + (long)(t_ + 2) * 64 * (kpitch), (kpitch), (Vbase) + (t_ + 2) * 64, (vpitch), GCUR, tid); \
        const int key0 = t_ * 64; (void)key0; \
        __VA_ARGS__ \
        if (t_ + 1 <= (t_hi)) fa_store<64>(stg + ((t_ + 1 - (t_lo)) & 1) * FA<64>::STAGE, GNEXT, tid); \
        __syncthreads(); } while (0)

__device__ __forceinline__ void nsa_unit(unsigned char* lds, int b, int g, int qblk, const unsigned short* __restrict__ Q16A, const unsigned short* __restrict__ KC16, const unsigned short* __restrict__ VCT16,
                                         const unsigned short* __restrict__ KS16, const unsigned short* __restrict__ VST16, const unsigned short* __restrict__ KW16, const unsigned short* __restrict__ VWT16,
                                         const float* __restrict__ gates, unsigned short* __restrict__ oa16, float* __restrict__ ssqa, int tid) {
    typedef FA<64> F;
    const int lane = tid & 63, wave = __builtin_amdgcn_readfirstlane(tid >> 6), r32 = lane & 31, hi = lane >> 5;
    unsigned char* stg = lds;
    float* imp = (float*)(lds + 2 * F::STAGE);
    unsigned* selm = (unsigned*)(lds + 2 * F::STAGE + 64 * IMP_PITCH * 4);
    const int q0 = qblk * 64, cur = qblk;
    const int ql = wave * 8 + (r32 >> 2), hh = g * 4 + (r32 & 3), qpos = q0 + ql; const long tok = (long)b * S_ + qpos; const int bg = b * 2 + g;
    bf16x8 qf[4];
#pragma unroll
    for (int ds = 0; ds < 4; ++ds) qf[ds] = *(const bf16x8*)(Q16A + tok * 512 + hh * 64 + ds * 16 + hi * 8);
    for (int i = tid; i < 64 * IMP_PITCH; i += 512) imp[i] = 0.f;
    f32x16 acc[2], o[2];
#pragma unroll
    for (int r = 0; r < 16; ++r) { acc[0][r] = 0.f; acc[1][r] = 0.f; }
    const int wq_lo = q0 + wave * 8, wq_hi = wq_lo + 7;
    const int nvis_max = (q0 + 63 >= 31) ? ((q0 + 63 - 31) / 16 + 1) : 0;
    if (nvis_max > 0) {
        const int tc_hi = (nvis_max - 1) >> 6;
        const unsigned short* Kc = KC16 + (long)bg * 512 * 64; const unsigned short* Vc = VCT16 + (long)bg * 64 * 512;
        float mref = FA_NEG, l = 0.f;
        NSA_STREAM(Kc, 64, Vc, 512, 0, tc_hi, {
            if (16 * key0 + 31 <= wq_hi) fa_tile<64, 4, true>(st, qf, o, mref, l, key0, qpos, lane, 16 * (key0 + 63) + 31 > wq_lo);
        });
        l = pair_sum(l);
        const float linv = (l > 0.f) ? 1.f / l : 0.f;
#pragma unroll
        for (int r = 0; r < 16; ++r) { o[0][r] = 0.f; o[1][r] = 0.f; }
        NSA_STREAM(Kc, 64, Vc, 512, 0, tc_hi, {
            if (16 * key0 + 31 <= wq_hi) fa_tile_cmp2(st, qf, o, mref, linv, key0, qpos, lane, imp + ql * IMP_PITCH);
        });
        const float g_c = gates[tok * 24 + hh * 3];
#pragma unroll
        for (int r = 0; r < 16; ++r) { acc[0][r] += g_c * o[0][r]; acc[1][r] += g_c * o[1][r]; }
    } else { __syncthreads(); }
    if (wave < 2) {
        const int qi = wave * 32 + r32;
        int his = hi; asm volatile("" : "+v"(his));
#define IMPKEY(jj) ({ const int j_ = (jj); const float v_ = (j_ == 0 || j_ == cur) ? 1e9f : ((j_ > cur) ? -1e30f : imp[qi * IMP_PITCH + j_]); (ordkey(v_) & ~127u) | (127u - (unsigned)j_); })
        unsigned k0[16];
        {
            unsigned k1[16];
#pragma unroll
            for (int i = 0; i < 16; ++i) { k0[i] = IMPKEY(his * 64 + i); k1[i] = IMPKEY(his * 64 + 16 + i); }
            sort16_desc(k0); sort16_desc(k1); merge16_desc(k0, k1);
        }
        __builtin_amdgcn_sched_barrier(0);
        {
            unsigned k2[16], k3[16];
#pragma unroll
            for (int i = 0; i < 16; ++i) { k2[i] = IMPKEY(his * 64 + 32 + i); k3[i] = IMPKEY(his * 64 + 48 + i); }
            sort16_desc(k2); sort16_desc(k3); merge16_desc(k2, k3); merge16_desc(k0, k2);
        }
#undef IMPKEY
        {
            unsigned o2[16];
#pragma unroll
            for (int i = 0; i < 16; ++i) { auto rr = __builtin_amdgcn_permlane32_swap(k0[i], k0[i], false, false); k0[i] = rr[0]; o2[i] = rr[1]; }
            merge16_desc(k0, o2);
        }
        unsigned m0 = 0u, m1 = 0u, m2 = 0u, m3 = 0u;
#pragma unroll
        for (int i = 0; i < 16; ++i) {
            const unsigned j = 127u - (k0[i] & 127u); const unsigned bit = 1u << (j & 31u); const unsigned wsel = j >> 5;
            m0 |= (wsel == 0u) ? bit : 0u; m1 |= (wsel == 1u) ? bit : 0u; m2 |= (wsel == 2u) ? bit : 0u; m3 |= (wsel == 3u) ? bit : 0u;
        }
        if (hi == 0) { selm[qi * 4] = m0; selm[qi * 4 + 1] = m1; selm[qi * 4 + 2] = m2; selm[qi * 4 + 3] = m3; }
    }
    __syncthreads();
    unsigned sm0 = selm[ql * 4], sm1 = selm[ql * 4 + 1], sm2 = selm[ql * 4 + 2], sm3 = selm[ql * 4 + 3];
    {
        float mref = FA_NEG, l = 0.f;
#pragma unroll
        for (int r = 0; r < 16; ++r) { o[0][r] = 0.f; o[1][r] = 0.f; }
        const unsigned short* Ks = KS16 + (long)bg * S_ * 64; const unsigned short* Vs = VST16 + (long)bg * 64 * S_;
        NSA_STREAM(Ks, 64, Vs, S_, 0, cur, {
            const int jw = t_ >> 5; const unsigned wsel = (jw == 0) ? sm0 : ((jw == 1) ? sm1 : ((jw == 2) ? sm2 : sm3));
            const bool colsel = (wsel >> (t_ & 31)) & 1u;
            if (__any(colsel)) fa_tile<64, 3>(st, qf, o, mref, l, key0, qpos, lane, t_ == cur, colsel);
        });
        l = pair_sum(l);
        const float sc = gates[tok * 24 + hh * 3 + 1] / l;
#pragma unroll
        for (int r = 0; r < 16; ++r) { acc[0][r] += sc * o[0][r]; acc[1][r] += sc * o[1][r]; }
    }
    {
        float mref = FA_NEG, l = 0.f;
#pragma unroll
        for (int r = 0; r < 16; ++r) { o[0][r] = 0.f; o[1][r] = 0.f; }
        const unsigned short* Kw = KW16 + (long)bg * S_ * 64; const unsigned short* Vw = VWT16 + (long)bg * 64 * S_;
        const int tw_lo = (cur >= 8) ? cur - 8 : 0;
        NSA_STREAM(Kw, 64, Vw, S_, tw_lo, cur, {
            fa_tile<64, 2>(st, qf, o, mref, l, key0, qpos, lane, (t_ == cur) || (t_ == cur - 8));
        });
        l = pair_sum(l);
        const float sc = gates[tok * 24 + hh * 3 + 2] / l;
#pragma unroll
        for (int r = 0; r < 16; ++r) { acc[0][r] += sc * o[0][r]; acc[1][r] += sc * o[1][r]; }
    }
    float ss = 0.f;
#pragma unroll
    for (int dt = 0; dt < 2; ++dt)
#pragma unroll
        for (int gq = 0; gq < 4; ++gq) {
            const float v0 = acc[dt][4 * gq], v1 = acc[dt][4 * gq + 1], v2 = acc[dt][4 * gq + 2], v3 = acc[dt][4 * gq + 3];
            uint2 pk; pk.x = cvtpk(v0, v1); pk.y = cvtpk(v2, v3);
            *(uint2*)(oa16 + tok * 1024 + hh * 64 + dt * 32 + 8 * gq + 4 * hi) = pk;
            ss += v0 * v0 + v1 * v1 + v2 * v2 + v3 * v3;
        }
    ss = pair_sum(ss);
    if (hi == 0) ssqa[(long)hh * T_ + tok] = ss;
    __syncthreads();
}
__device__ __forceinline__ void nsa_phase(unsigned char* lds, const unsigned short* __restrict__ Q16A, const unsigned short* __restrict__ KC16, const unsigned short* __restrict__ VCT16,
                                          const unsigned short* __restrict__ KS16, const unsigned short* __restrict__ VST16, const unsigned short* __restrict__ KW16, const unsigned short* __restrict__ VWT16,
                                          const float* __restrict__ gates, unsigned short* __restrict__ oa16, float* __restrict__ ssqa) {
    const int tid = tid_();
    for (int i = blockIdx.x; i < 256; i += NBLK) {
        const int xcd = i & 7, slot = i >> 3; const int bg = xcd >> 1, pr = (xcd & 1) * 32 + slot;
        nsa_unit(lds, bg >> 1, bg & 1, 127 - pr, Q16A, KC16, VCT16, KS16, VST16, KW16, VWT16, gates, oa16, ssqa, tid);
        nsa_unit(lds, bg >> 1, bg & 1, pr, Q16A, KC16, VCT16, KS16, VST16, KW16, VWT16, gates, oa16, ssqa, tid);
    }
}
__device__ __forceinline__ int nmap_in2(int n) {
    if (n < 768) return n;
    if (n < 896) return n;
    if (n < 1024) return n - 896 + 1024;
    if (n < 1152) return n - 1024 + 896;
    if (n < 1280) return n;
    if (n < 1304) return n - 1280 + 1696;
    if (n < 1560) return n - 1304 + 1280;
    if (n < 1688) return n - 1560 + 1536;
    return n - 1688 + 1664;
}
template <int NMAP>
__device__ __forceinline__ void cvt_transpose2(float* ldsf, const float* __restrict__ Wsrc, int K, int N, unsigned short* __restrict__ Wt, const float* __restrict__ kgain) {
    const int tid = tid_();
    float (*tl)[65] = (float (*)[65])ldsf;
    const int tk = K / 64, tn = (N + 63) / 64;
    for (int tile = blockIdx.x; tile < tk * tn; tile += NBLK) {
        const int k0 = (tile / tn) * 64, n0 = (tile % tn) * 64;
#pragma unroll
        for (int i = 0; i < 8; ++i) {
            const int kl = (tid >> 6) + 8 * i, nl = tid & 63; const int n = n0 + nl, k = k0 + kl;
            float v = (n < N) ? Wsrc[(long)k * N + n] : 0.f;
            if (kgain) v *= kgain[k];
            tl[kl][nl] = v;
        }
        __syncthreads();
        {
            const int nl = tid >> 3, kc = (tid & 7) * 8; const int n = n0 + nl;
            if (n < N) {
                uint4 o; o.x = cvtpk(tl[kc][nl], tl[kc + 1][nl]); o.y = cvtpk(tl[kc + 2][nl], tl[kc + 3][nl]); o.z = cvtpk(tl[kc + 4][nl], tl[kc + 5][nl]); o.w = cvtpk(tl[kc + 6][nl], tl[kc + 7][nl]);
                const int nn = (NMAP == 2) ? nmap_in2(n) : n;
                *(uint4*)(Wt + (long)nn * K + k0 + kc) = o;
            }
        }
        __syncthreads();
    }
}
__device__ __forceinline__ void p0_xn_rope(const float* __restrict__ x, const float* __restrict__ g1, const int* __restrict__ positions, unsigned short* __restrict__ xn16, float* __restrict__ rope) {
    const int tid = tid_(); const int lane = tid & 63, w = __builtin_amdgcn_readfirstlane(tid >> 6);
    for (int t = blockIdx.x * 8 + w; t < T_; t += NBLK * 8) {
        const float4* xp = (const float4*)(x + (long)t * 1024);
        float4 a0 = xp[lane * 2], a1 = xp[lane * 2 + 1], b0 = xp[128 + lane * 2], b1 = xp[128 + lane * 2 + 1];
        float ss = a0.x * a0.x + a0.y * a0.y + a0.z * a0.z + a0.w * a0.w + a1.x * a1.x + a1.y * a1.y + a1.z * a1.z + a1.w * a1.w
                 + b0.x * b0.x + b0.y * b0.y + b0.z * b0.z + b0.w * b0.w + b1.x * b1.x + b1.y * b1.y + b1.z * b1.z + b1.w * b1.w;
        ss = wsum(ss); const float rs = rsqrtf(ss * (1.f / 1024.f) + EPS);
        const float4* gp = (const float4*)g1; const float4 ga0 = gp[lane * 2], ga1 = gp[lane * 2 + 1], gb0 = gp[128 + lane * 2], gb1 = gp[128 + lane * 2 + 1];
        uint4 pa, pb;
        pa.x = cvtpk(a0.x * rs * ga0.x, a0.y * rs * ga0.y); pa.y = cvtpk(a0.z * rs * ga0.z, a0.w * rs * ga0.w); pa.z = cvtpk(a1.x * rs * ga1.x, a1.y * rs * ga1.y); pa.w = cvtpk(a1.z * rs * ga1.z, a1.w * rs * ga1.w);
        pb.x = cvtpk(b0.x * rs * gb0.x, b0.y * rs * gb0.y); pb.y = cvtpk(b0.z * rs * gb0.z, b0.w * rs * gb0.w); pb.z = cvtpk(b1.x * rs * gb1.x, b1.y * rs * gb1.y); pb.w = cvtpk(b1.z * rs * gb1.z, b1.w * rs * gb1.w);
        ((uint4*)(xn16 + (long)t * 1024))[lane] = pa; ((uint4*)(xn16 + (long)t * 1024))[64 + lane] = pb;
        if (lane < 24) {
            const float f = lane < 8 ? ROPE_F16[lane] : ROPE_F32[lane - 8];
            const float angf = (float)positions[t] * f;
            const double ang = (double)angf; const double k = rint(ang * 0.15915494309189535);
            const float r = (float)(ang - k * 6.283185307179586);
            const float c = cosf(r), sn = sinf(r);
            if (lane < 8) { rope[(long)t * 48 + lane] = c; rope[(long)t * 48 + 8 + lane] = sn; }
            else { rope[(long)t * 48 + 16 + lane - 8] = c; rope[(long)t * 48 + 32 + lane - 8] = sn; }
        }
    }
}
__device__ __forceinline__ void p0_cbias(const float* __restrict__ pos, const float* __restrict__ w1k, const float* __restrict__ w1v, float* __restrict__ cbias) {
    const int tid = tid_(); const int lane = tid & 63, w = __builtin_amdgcn_readfirstlane(tid >> 6);
    for (int task = blockIdx.x * 8 + w; task < 512; task += NBLK * 8) {
        const int mat = task >> 8, n = task & 255; const float* w1 = mat ? w1v : w1k;
        float acc = 0.f;
#pragma unroll 8
        for (int i = 0; i < 32; ++i) { const int k = lane + 64 * i; acc += pos[k] * w1[(long)k * 256 + n]; }
        acc = wsum(acc);
        if (lane == 0) cbias[task] = acc;
    }
}
__device__ __forceinline__ void zero_stream(unsigned short* __restrict__ p, long n) {
    const int tid = tid_();
    for (long c = (long)blockIdx.x * 512 + tid; c < (n >> 3); c += (long)NBLK * 512) ((uint4*)p)[c] = make_uint4(0u, 0u, 0u, 0u);
}

struct P1Out {
    unsigned short *q16a, *ks16, *kw16, *vst16, *vwt16, *kcmp16, *vcmp16, *cq16, *ckv16;
    float *krr, *ssq_kr, *ssq_cq, *ssq_ckv, *gates;
    const float *rope, *q_gain, *ks_gain, *kw_gain, *k_gain;
};
__device__ __forceinline__ void norm_rope64(f32x16& a0, f32x16& a1, const float* __restrict__ gain, const float* __restrict__ rope_t, int hi, float outscale) {
    float ss = 0.f;
#pragma unroll
    for (int r = 0; r < 16; ++r) ss += a0[r] * a0[r] + a1[r] * a1[r];
    ss = pair_sum(ss);
    const float rs = rsqrtf(ss * (1.f / 64.f) + EPS);
#pragma unroll
    for (int g = 0; g < 4; ++g) {
        const float4 g0 = *(const float4*)(gain + 8 * g + 4 * hi), g1 = *(const float4*)(gain + 32 + 8 * g + 4 * hi);
        a0[4 * g] *= rs * g0.x; a0[4 * g + 1] *= rs * g0.y; a0[4 * g + 2] *= rs * g0.z; a0[4 * g + 3] *= rs * g0.w;
        a1[4 * g] *= rs * g1.x; a1[4 * g + 1] *= rs * g1.y; a1[4 * g + 2] *= rs * g1.z; a1[4 * g + 3] *= rs * g1.w;
    }
    const float4 c4 = *(const float4*)(rope_t + 4 * hi), s4 = *(const float4*)(rope_t + 8 + 4 * hi);
    const float cc[4] = {c4.x, c4.y, c4.z, c4.w}, sn[4] = {s4.x, s4.y, s4.z, s4.w};
#pragma unroll
    for (int j = 0; j < 4; ++j) { const float x1 = a0[j], x2 = a0[4 + j]; a0[j] = x1 * cc[j] - x2 * sn[j]; a0[4 + j] = x2 * cc[j] + x1 * sn[j]; }
#pragma unroll
    for (int r = 0; r < 16; ++r) { a0[r] *= outscale; a1[r] *= outscale; }
}
__device__ __forceinline__ void store_row64(unsigned short* __restrict__ dst, const f32x16& a0, const f32x16& a1, int hi) {
#pragma unroll
    for (int g = 0; g < 4; ++g) {
        uint2 p0, p1; p0.x = cvtpk(a0[4 * g], a0[4 * g + 1]); p0.y = cvtpk(a0[4 * g + 2], a0[4 * g + 3]); p1.x = cvtpk(a1[4 * g], a1[4 * g + 1]); p1.y = cvtpk(a1[4 * g + 2], a1[4 * g + 3]);
        *(uint2*)(dst + 8 * g + 4 * hi) = p0; *(uint2*)(dst + 32 + 8 * g + 4 * hi) = p1;
    }
}
__device__ __forceinline__ float ssq64(const f32x16& a0, const f32x16& a1) {
    float ss = 0.f;
#pragma unroll
    for (int r = 0; r < 16; ++r) ss += a0[r] * a0[r] + a1[r] * a1[r];
    return pair_sum(ss);
}
__device__ __forceinline__ float sum4fq(float v) {
    auto r1 = __builtin_amdgcn_permlane16_swap(__float_as_uint(v), __float_as_uint(v), false, false);
    return pair_sum(__uint_as_float(r1[0]) + __uint_as_float(r1[1]));
}
#define P1V(m, j) acc[ai][bj][m][n][j]
__device__ __forceinline__ void p1_inproj_256(unsigned char* lds, const unsigned short* __restrict__ xn16, const unsigned short* __restrict__ wt_in, const P1Out& Oin) {
    const P1Out O = Oin;
    const int vcu = (blockIdx.x & 7) * (NBLK / 8) + (blockIdx.x >> 3);
    for (int tile = vcu; tile < 64 * 7; tile += NBLK) {
        const int mt = tile / 7, nt = tile % 7; const int m0 = mt * 256;
        f32x4_t acc[2][2][4][2];
#pragma unroll
        for (int ai = 0; ai < 2; ++ai)
#pragma unroll
            for (int bj = 0; bj < 2; ++bj)
#pragma unroll
                for (int m = 0; m < 4; ++m)
#pragma unroll
                    for (int n = 0; n < 2; ++n) acc[ai][bj][m][n] = f32x4_t{0.f, 0.f, 0.f, 0.f};
        if (nt == 4) g256::mainloop<1024>(xn16, wt_in, m0, nt * 256, (unsigned short*)lds, acc);
        else g256::mainloop<1024>(wt_in, xn16, nt * 256, m0, (unsigned short*)lds, acc);
        const int tid = tid_(); const int lane = tid & 63, wave = __builtin_amdgcn_readfirstlane(tid >> 6), wr = wave >> 2, wc = wave & 3, fr = lane & 15, fq = lane >> 4;
        if (nt == 4) {
#pragma unroll
            for (int bj = 0; bj < 2; ++bj)
#pragma unroll
                for (int n = 0; n < 2; ++n) {
                    const int pc = bj * 2 + (wc >> 1), d = (wc & 1) * 32 + n * 16 + fr;
                    unsigned short* vt = (pc < 2) ? O.vst16 : O.vwt16; const int g = pc & 1;
#pragma unroll
                    for (int ai = 0; ai < 2; ++ai)
#pragma unroll
                        for (int m = 0; m < 4; ++m) {
                            const int tb = m0 + ai * 128 + wr * 64 + m * 16 + fq * 4; const int b = tb / S_, s0 = tb % S_;
                            uint2 pk; pk.x = cvtpk(P1V(m, 0), P1V(m, 1)); pk.y = cvtpk(P1V(m, 2), P1V(m, 3));
                            *(uint2*)(vt + ((long)(b * 2 + g) * 64 + d) * S_ + vperm(s0)) = pk;
                        }
                }
        } else {
#pragma unroll
            for (int ai = 0; ai < 2; ++ai) {
                const int pc = ai * 2 + wr;
#pragma unroll
                for (int bj = 0; bj < 2; ++bj)
#pragma unroll
                    for (int n = 0; n < 2; ++n) {
                        const long tok = m0 + bj * 128 + wc * 32 + n * 16 + fr; const int b = (int)(tok / S_), s = (int)(tok % S_);
                        const float* rope_t = O.rope + tok * 48;
                        const bool is_q = nt < 2, is_k = nt == 3;
                        if (is_q || is_k) {
                            const float* gain = is_q ? O.q_gain : ((pc < 2) ? O.ks_gain : O.kw_gain);
                            float ss = 0.f;
#pragma unroll
                            for (int m = 0; m < 4; ++m)
#pragma unroll
                                for (int j = 0; j < 4; ++j) ss += P1V(m, j) * P1V(m, j);
                            const float rs = rsqrtf(sum4fq(ss) * (1.f / 64.f) + EPS) ;
#pragma unroll
                            for (int m = 0; m < 4; ++m) { const float4 gv = *(const float4*)(gain + m * 16 + fq * 4);
                                P1V(m, 0) *= rs * gv.x; P1V(m, 1) *= rs * gv.y; P1V(m, 2) *= rs * gv.z; P1V(m, 3) *= rs * gv.w; }
                            { const float4 c4 = *(const float4*)(rope_t + (fq & 1) * 4), s4 = *(const float4*)(rope_t + 8 + (fq & 1) * 4);
                              const float cc[4] = {c4.x, c4.y, c4.z, c4.w}, sn[4] = {s4.x, s4.y, s4.z, s4.w};
#pragma unroll
                              for (int j = 0; j < 4; ++j) {
                                  auto rr = __builtin_amdgcn_permlane32_swap(__float_as_uint(P1V(0, j)), __float_as_uint(P1V(0, j)), false, false);
                                  const float x1 = __uint_as_float(rr[0]), x2 = __uint_as_float(rr[1]);
                                  P1V(0, j) = (fq < 2) ? (x1 * cc[j] - x2 * sn[j]) : (x2 * cc[j] + x1 * sn[j]);
                              } }
                            const float osc = is_q ? NSA_QSCALE : 1.f;
                            unsigned short* dst = is_q ? (O.q16a + tok * 512 + (nt * 4 + pc) * 64) : ((pc < 2 ? O.ks16 : O.kw16) + ((long)(b * 2 + (pc & 1)) * S_ + s) * 64);
#pragma unroll
                            for (int m = 0; m < 4; ++m) { uint2 pk; pk.x = cvtpk(P1V(m, 0) * osc, P1V(m, 1) * osc); pk.y = cvtpk(P1V(m, 2) * osc, P1V(m, 3) * osc); *(uint2*)(dst + m * 16 + fq * 4) = pk; }
                        } else if (nt == 2 || nt == 5 || (nt == 6 && pc < 2)) {
                            unsigned short* dst;
                            if (nt == 2) dst = (pc < 2 ? O.kcmp16 : O.vcmp16) + ((long)(b * 2 + (pc & 1)) * S_ + s) * 64;
                            else if (nt == 5) dst = O.cq16 + tok * 256 + pc * 64;
                            else dst = O.ckv16 + tok * 128 + pc * 64;
                            float ss = 0.f;
#pragma unroll
                            for (int m = 0; m < 4; ++m) { uint2 pk; pk.x = cvtpk(P1V(m, 0), P1V(m, 1)); pk.y = cvtpk(P1V(m, 2), P1V(m, 3)); *(uint2*)(dst + m * 16 + fq * 4) = pk;
#pragma unroll
                                for (int j = 0; j < 4; ++j) ss += P1V(m, j) * P1V(m, j); }
                            if (nt != 2) { ss = sum4fq(ss); if (fq == 0) { if (nt == 5) O.ssq_cq[(long)pc * T_ + tok] = ss; else O.ssq_ckv[(long)pc * T_ + tok] = ss; } }
                        } else if (nt == 6 && pc == 2) {
                            float ss = 0.f;
#pragma unroll
                            for (int m = 0; m < 2; ++m)
#pragma unroll
                                for (int j = 0; j < 4; ++j) ss += P1V(m, j) * P1V(m, j);
                            ss = sum4fq(ss);
                            if (fq == 0) O.ssq_kr[tok] = ss;
                            {
                                const float4 g0 = *(const float4*)(O.k_gain + 64 + fq * 4), g1 = *(const float4*)(O.k_gain + 80 + fq * 4);
                                const float4 c4 = *(const float4*)(rope_t + 16 + fq * 4), s4 = *(const float4*)(rope_t + 32 + fq * 4);
                                const float ga[4] = {g0.x, g0.y, g0.z, g0.w}, gb[4] = {g1.x, g1.y, g1.z, g1.w}, cc[4] = {c4.x, c4.y, c4.z, c4.w}, sn[4] = {s4.x, s4.y, s4.z, s4.w};
                                float o1[4], o2[4];
#pragma unroll
                                for (int j = 0; j < 4; ++j) { const float x1 = P1V(0, j) * ga[j], x2 = P1V(1, j) * gb[j]; o1[j] = x1 * cc[j] - x2 * sn[j]; o2[j] = x2 * cc[j] + x1 * sn[j]; }
                                *(float4*)(O.krr + tok * 32 + fq * 4) = make_float4(o1[0], o1[1], o1[2], o1[3]);
                                *(float4*)(O.krr + tok * 32 + 16 + fq * 4) = make_float4(o2[0], o2[1], o2[2], o2[3]);
                            }
                            *(float4*)(O.gates + tok * 24 + fq * 4) = make_float4(1.f / (1.f + __expf(-P1V(2, 0))), 1.f / (1.f + __expf(-P1V(2, 1))), 1.f / (1.f + __expf(-P1V(2, 2))), 1.f / (1.f + __expf(-P1V(2, 3))));
                            if (fq < 2) *(float4*)(O.gates + tok * 24 + 16 + fq * 4) = make_float4(1.f / (1.f + __expf(-P1V(3, 0))), 1.f / (1.f + __expf(-P1V(3, 1))), 1.f / (1.f + __expf(-P1V(3, 2))), 1.f / (1.f + __expf(-P1V(3, 3))));
                        }
                    }
            }
        }
        __syncthreads();
    }
}
#undef P1V

typedef GemmShape<2, 4, 2, 2> ShBig;
typedef GemmShape<4, 2, 1, 3> ShQb;
typedef GemmShape<4, 2, 1, 4> ShKvb;
struct P2Args {
    const unsigned short *cq16, *ckv16, *wt_uq, *wt_ukv, *kcmp16, *vcmp16, *w1t_k, *w1t_v;
    const float *ssq_cq, *ssq_ckv, *ssq_kr, *krr, *rope, *q_gain, *k_gain;
    unsigned short *q16, *k16, *vt16; float* hid;
};
__device__ __forceinline__ void p2_phase(unsigned char* lds, const P2Args& A) {
    const int tid = tid_(); const int lane = tid & 63, wave = __builtin_amdgcn_readfirstlane(tid >> 6), r32 = lane & 31, hi = lane >> 5;
    const int nmine = (blockIdx.x < 128) ? 4 : 5;
    for (int it = 0; it < nmine; ++it) {
        int u;
        if (blockIdx.x < 128) { if (it == 0) u = blockIdx.x; else { const int s = blockIdx.x * 3 + (it - 1); u = (s & 1) ? 640 + (s >> 1) : 128 + (s >> 1); } }
        else { const int s = 384 + (blockIdx.x - 128) * 5 + it; u = (s & 1) ? 640 + (s >> 1) : 128 + (s >> 1); }
        if (u < 128) {
            const int mat = u >> 6, mtile = (u >> 2) & 15, ks = u & 3; const int wm = wave >> 2, wn = wave & 3;
            f32x16 acc[2][2];
#pragma unroll
            for (int mi = 0; mi < 2; ++mi)
#pragma unroll
                for (int ni = 0; ni < 2; ++ni)
#pragma unroll
                    for (int r = 0; r < 16; ++r) acc[mi][ni][r] = 0.f;
            gemm_mainloop<ShBig, 3u>((mat ? A.vcmp16 : A.kcmp16) + (long)mtile * 128 * 1024 + ks * 512, 1024, (mat ? A.w1t_v : A.w1t_k) + ks * 512, 2048, 512, lds, acc, tid);
            float* slab = A.hid + (long)(mat * 4 + ks) * 2048 * 256;
#pragma unroll
            for (int mi = 0; mi < 2; ++mi) {
                const long row = mtile * 128 + wm * 64 + mi * 32 + r32;
#pragma unroll
                for (int ni = 0; ni < 2; ++ni)
#pragma unroll
                    for (int g = 0; g < 4; ++g)
                        *(float4*)(slab + row * 256 + wn * 64 + ni * 32 + 8 * g + 4 * hi) = make_float4(acc[mi][ni][4 * g], acc[mi][ni][4 * g + 1], acc[mi][ni][4 * g + 2], acc[mi][ni][4 * g + 3]);
            }
        } else if (u < 128 + 512) {
            const int v = u - 128; const int mt = v >> 2, nt = v & 3; const int m0 = mt * 128; const int wm = wave >> 1, wn = wave & 1; const int head = nt * 2 + wn;
            f32x16 acc[1][4];
#pragma unroll
            for (int ni = 0; ni < 4; ++ni)
#pragma unroll
                for (int r = 0; r < 16; ++r) acc[0][ni][r] = 0.f;
            gemm_mainloop<ShKvb, 3u>(A.ckv16 + (long)m0 * 128, 128, A.wt_ukv + (long)nt * 256 * 128, 128, 128, lds, acc, tid);
            {
                const long tok = m0 + wm * 32 + r32; const int b = (int)(tok / S_), s = (int)(tok % S_);
                const float rc = rsqrtf((A.ssq_ckv[tok] + A.ssq_ckv[(long)T_ + tok]) * (1.f / 128.f) + EPS);
                float ss = 0.f;
#pragma unroll
                for (int r = 0; r < 16; ++r) { acc[0][0][r] *= rc; acc[0][1][r] *= rc; ss += acc[0][0][r] * acc[0][0][r] + acc[0][1][r] * acc[0][1][r]; }
                ss = pair_sum(ss) + A.ssq_kr[tok];
                const float rk = rsqrtf(ss * (1.f / 96.f) + EPS);
#pragma unroll
                for (int g = 0; g < 4; ++g) {
                    const float4 g0 = *(const float4*)(A.k_gain + 8 * g + 4 * hi), g1 = *(const float4*)(A.k_gain + 32 + 8 * g + 4 * hi);
                    acc[0][0][4 * g] *= rk * g0.x; acc[0][0][4 * g + 1] *= rk * g0.y; acc[0][0][4 * g + 2] *= rk * g0.z; acc[0][0][4 * g + 3] *= rk * g0.w;
                    acc[0][1][4 * g] *= rk * g1.x; acc[0][1][4 * g + 1] *= rk * g1.y; acc[0][1][4 * g + 2] *= rk * g1.z; acc[0][1][4 * g + 3] *= rk * g1.w;
                }
                unsigned short* krow = A.k16 + ((long)(b * 8 + head) * S_ + s) * 96;
                store_row64(krow, acc[0][0], acc[0][1], hi);
                const float4* kp = (const float4*)(A.krr + tok * 32 + hi * 16);
                const float4 k0 = kp[0], k1 = kp[1], k2 = kp[2], k3 = kp[3];
                uint4 o0, o1; o0.x = cvtpk(k0.x * rk, k0.y * rk); o0.y = cvtpk(k0.z * rk, k0.w * rk); o0.z = cvtpk(k1.x * rk, k1.y * rk); o0.w = cvtpk(k1.z * rk, k1.w * rk);
                o1.x = cvtpk(k2.x * rk, k2.y * rk); o1.y = cvtpk(k2.z * rk, k2.w * rk); o1.z = cvtpk(k3.x * rk, k3.y * rk); o1.w = cvtpk(k3.z * rk, k3.w * rk);
                *(uint4*)(krow + 64 + hi * 16) = o0; *(uint4*)(krow + 64 + hi * 16 + 8) = o1;
            }
            {
#pragma unroll
                for (int ni = 2; ni < 4; ++ni)
#pragma unroll
                    for (int g4 = 0; g4 < 4; ++g4) {
                        const int tb = m0 + wm * 32 + 8 * g4 + 4 * hi; const int b = tb / S_, s0 = tb % S_; const int d = (ni - 2) * 32 + r32;
                        const float4 sa = *(const float4*)(A.ssq_ckv + tb), sb = *(const float4*)(A.ssq_ckv + (long)T_ + tb);
                        const float r0 = rsqrtf((sa.x + sb.x) * (1.f / 128.f) + EPS), r1 = rsqrtf((sa.y + sb.y) * (1.f / 128.f) + EPS), r2 = rsqrtf((sa.z + sb.z) * (1.f / 128.f) + EPS), r3 = rsqrtf((sa.w + sb.w) * (1.f / 128.f) + EPS);
                        uint2 pk; pk.x = cvtpk(acc[0][ni][4 * g4] * r0, acc[0][ni][4 * g4 + 1] * r1); pk.y = cvtpk(acc[0][ni][4 * g4 + 2] * r2, acc[0][ni][4 * g4 + 3] * r3);
                        *(uint2*)(A.vt16 + ((long)(b * 8 + head) * 64 + d) * S_ + vperm(s0)) = pk;
                    }
            }
        } else {
            const int v = u - 640; const int mt = v >> 2, nt = v & 3; const int m0 = mt * 128; const int wm = wave >> 1, wn = wave & 1; const int head = nt * 2 + wn;
            f32x16 acc[1][3];
#pragma unroll
            for (int ni = 0; ni < 3; ++ni)
#pragma unroll
                for (int r = 0; r < 16; ++r) acc[0][ni][r] = 0.f;
            gemm_mainloop<ShQb, 7u>(A.cq16 + (long)m0 * 256, 256, A.wt_uq + (long)nt * 192 * 256, 256, 256, lds, acc, tid);
            const long tok = m0 + wm * 32 + r32;
            const float rc = rsqrtf((A.ssq_cq[tok] + A.ssq_cq[(long)T_ + tok] + A.ssq_cq[2L * T_ + tok] + A.ssq_cq[3L * T_ + tok]) * (1.f / 256.f) + EPS);
            float ss = 0.f;
#pragma unroll
            for (int ni = 0; ni < 3; ++ni)
#pragma unroll
                for (int r = 0; r < 16; ++r) { acc[0][ni][r] *= rc; ss += acc[0][ni][r] * acc[0][ni][r]; }
            ss = pair_sum(ss);
            const float rq = rsqrtf(ss * (1.f / 96.f) + EPS);
#pragma unroll
            for (int ni = 0; ni < 3; ++ni)
#pragma unroll
                for (int g = 0; g < 4; ++g) {
                    const float4 gg = *(const float4*)(A.q_gain + ni * 32 + 8 * g + 4 * hi);
                    acc[0][ni][4 * g] *= rq * gg.x; acc[0][ni][4 * g + 1] *= rq * gg.y; acc[0][ni][4 * g + 2] *= rq * gg.z; acc[0][ni][4 * g + 3] *= rq * gg.w;
                }
            const float* rope_t = A.rope + tok * 48;
#pragma unroll
            for (int g = 0; g < 2; ++g) {
                const float4 c4 = *(const float4*)(rope_t + 16 + 8 * g + 4 * hi), s4 = *(const float4*)(rope_t + 32 + 8 * g + 4 * hi);
                const float cc[4] = {c4.x, c4.y, c4.z, c4.w}, sn[4] = {s4.x, s4.y, s4.z, s4.w};
#pragma unroll
                for (int j = 0; j < 4; ++j) { const float x1 = acc[0][2][4 * g + j], x2 = acc[0][2][8 + 4 * g + j]; acc[0][2][4 * g + j] = x1 * cc[j] - x2 * sn[j]; acc[0][2][8 + 4 * g + j] = x2 * cc[j] + x1 * sn[j]; }
            }
            unsigned short* qrow = A.q16 + tok * 768 + head * 96;
#pragma unroll
            for (int ni = 0; ni < 3; ++ni)
#pragma unroll
                for (int g = 0; g < 4; ++g) {
                    uint2 pk; pk.x = cvtpk(acc[0][ni][4 * g] * MLA_QSCALE, acc[0][ni][4 * g + 1] * MLA_QSCALE); pk.y = cvtpk(acc[0][ni][4 * g + 2] * MLA_QSCALE, acc[0][ni][4 * g + 3] * MLA_QSCALE);
                    *(uint2*)(qrow + ni * 32 + 8 * g + 4 * hi) = pk;
                }
        }
    }
}
__device__ __forceinline__ void p3_cmp2(const float* __restrict__ hid, const float* __restrict__ cbias, const unsigned short* __restrict__ w2t_k, const unsigned short* __restrict__ w2t_v,
                                        const float* __restrict__ kc_gain, const float* __restrict__ rope, unsigned short* __restrict__ kc16, unsigned short* __restrict__ vct16) {
    const int tid = tid_(); const int lane = tid & 63, w = __builtin_amdgcn_readfirstlane(tid >> 6), r32 = lane & 31, hi = lane >> 5;
    for (int task = blockIdx.x * 8 + w; task < 128; task += NBLK * 8) {
        const int mat = task >> 6, rt = task & 63; const long row = rt * 32 + r32;
        const unsigned short* w2t = mat ? w2t_v : w2t_k;
        f32x16 acc[2];
#pragma unroll
        for (int r = 0; r < 16; ++r) { acc[0][r] = 0.f; acc[1][r] = 0.f; }
#pragma unroll 4
        for (int ks = 0; ks < 16; ++ks) {
            const int k0 = ks * 16 + hi * 8;
            float h[8];
            { const float4 b0 = *(const float4*)(cbias + mat * 256 + k0), b1 = *(const float4*)(cbias + mat * 256 + k0 + 4);
              h[0] = b0.x; h[1] = b0.y; h[2] = b0.z; h[3] = b0.w; h[4] = b1.x; h[5] = b1.y; h[6] = b1.z; h[7] = b1.w; }
#pragma unroll
            for (int sp = 0; sp < 4; ++sp) {
                const float* hp = hid + ((long)(mat * 4 + sp) * 2048 + row) * 256 + k0;
                const float4 a0 = *(const float4*)hp, a1 = *(const float4*)(hp + 4);
                h[0] += a0.x; h[1] += a0.y; h[2] += a0.z; h[3] += a0.w; h[4] += a1.x; h[5] += a1.y; h[6] += a1.z; h[7] += a1.w;
            }
            uint4 pk; pk.x = cvtpk(gelu_tanh(h[0]), gelu_tanh(h[1])); pk.y = cvtpk(gelu_tanh(h[2]), gelu_tanh(h[3])); pk.z = cvtpk(gelu_tanh(h[4]), gelu_tanh(h[5])); pk.w = cvtpk(gelu_tanh(h[6]), gelu_tanh(h[7]));
            const bf16x8 hf = __builtin_bit_cast(bf16x8, pk);
            const bf16x8 w0 = *(const bf16x8*)(w2t + (long)r32 * 256 + k0), w1 = *(const bf16x8*)(w2t + (long)(32 + r32) * 256 + k0);
            acc[0] = MFMA32(w0, hf, acc[0]); acc[1] = MFMA32(w1, hf, acc[1]);
        }
        const int bg = (int)(row >> 9), n = (int)(row & 511); const bool valid = n < NCMP;
        if (mat == 0) {
            if (valid) {
                const long tokp = (long)(bg >> 1) * S_ + 16 * n + 31;
                norm_rope64(acc[0], acc[1], kc_gain, rope + tokp * 48, hi, 1.f);
            } else {
#pragma unroll
                for (int r = 0; r < 16; ++r) { acc[0][r] = 0.f; acc[1][r] = 0.f; }
            }
            store_row64(kc16 + row * 64, acc[0], acc[1], hi);
        } else {
#pragma unroll
            for (int ni = 0; ni < 2; ++ni)
#pragma unroll
                for (int r = 0; r < 16; ++r) {
                    const float v = valid ? acc[ni][r] : 0.f;
                    const float other = __uint_as_float(__builtin_amdgcn_mov_dpp(__float_as_uint(v), 0xB1, 0xF, 0xF, true));
                    if ((lane & 1) == 0) *(unsigned*)(vct16 + ((long)bg * 64 + ni * 32 + crow(r, hi)) * 512 + vperm(n)) = cvtpk(v, other);
                }
        }
    }
}

__device__ __forceinline__ void cvt_stream(const float* __restrict__ in, unsigned short* __restrict__ out, long n, int vb = blockIdx.x, int nb = NBLK) {
    const long nchunk = n >> 3;
    const int tid = tid_();
    for (long c = (long)vb * 512 + tid; c < nchunk; c += (long)nb * 512) {
        const float4 a = ((const float4*)in)[2 * c], b = ((const float4*)in)[2 * c + 1];
        uint4 o; o.x = cvtpk(a.x, a.y); o.y = cvtpk(a.z, a.w); o.z = cvtpk(b.x, b.y); o.w = cvtpk(b.z, b.w);
        ((uint4*)out)[c] = o;
    }
}


typedef float f32x2_t __attribute__((ext_vector_type(2)));
__device__ __forceinline__ void cvt_rows_fp8(const float* __restrict__ in, unsigned char* __restrict__ out8, float* __restrict__ scale, int rows, int vb = blockIdx.x, int nb = NBLK) {
    const int tid = tid_(); const int lane = tid & 63, w = __builtin_amdgcn_readfirstlane(tid >> 6);
    for (int r = vb * 8 + w; r < rows; r += nb * 8) {
        const float4* p = (const float4*)(in + (long)r * 1024 + lane * 16);
        const float4 a = p[0], b = p[1], c = p[2], d = p[3];
        float m = fmaxf(fmaxf(fmaxf(fabsf(a.x), fabsf(a.y)), fmaxf(fabsf(a.z), fabsf(a.w))), fmaxf(fmaxf(fabsf(b.x), fabsf(b.y)), fmaxf(fabsf(b.z), fabsf(b.w))));
        m = fmaxf(m, fmaxf(fmaxf(fmaxf(fabsf(c.x), fabsf(c.y)), fmaxf(fabsf(c.z), fabsf(c.w))), fmaxf(fmaxf(fabsf(d.x), fabsf(d.y)), fmaxf(fabsf(d.z), fabsf(d.w)))));
        m = wmax(m);
        const float q = (m > 0.f) ? 240.f / m : 1.f;
        int w0 = 0, w1 = 0, w2 = 0, w3 = 0;
        w0 = __builtin_amdgcn_cvt_pk_fp8_f32(a.x * q, a.y * q, w0, false); w0 = __builtin_amdgcn_cvt_pk_fp8_f32(a.z * q, a.w * q, w0, true);
        w1 = __builtin_amdgcn_cvt_pk_fp8_f32(b.x * q, b.y * q, w1, false); w1 = __builtin_amdgcn_cvt_pk_fp8_f32(b.z * q, b.w * q, w1, true);
        w2 = __builtin_amdgcn_cvt_pk_fp8_f32(c.x * q, c.y * q, w2, false); w2 = __builtin_amdgcn_cvt_pk_fp8_f32(c.z * q, c.w * q, w2, true);
        w3 = __builtin_amdgcn_cvt_pk_fp8_f32(d.x * q, d.y * q, w3, false); w3 = __builtin_amdgcn_cvt_pk_fp8_f32(d.z * q, d.w * q, w3, true);
        *(uint4*)(out8 + (long)r * 1024 + lane * 16) = make_uint4((unsigned)w0, (unsigned)w1, (unsigned)w2, (unsigned)w3);
        if (lane == 0) scale[r] = (m > 0.f) ? m * (1.f / 240.f) : 1.f;
    }
}
__device__ __forceinline__ float dot4_fp8(unsigned w, float x0, float x1, float x2, float x3, float acc) {
    const f32x2_t lo = __builtin_amdgcn_cvt_pk_f32_fp8((int)w, false), hi = __builtin_amdgcn_cvt_pk_f32_fp8((int)w, true);
    acc = fmaf(lo.x, x0, acc); acc = fmaf(lo.y, x1, acc); acc = fmaf(hi.x, x2, acc); return fmaf(hi.y, x3, acc);
}
__device__ __forceinline__ void peer_sweep_a(const float* __restrict__ hss, const float* __restrict__ g2, const int* __restrict__ eo, const float* __restrict__ go,
                                             const unsigned char* __restrict__ U8, const float* __restrict__ su, const float* __restrict__ sv, const float* __restrict__ h, float* __restrict__ wout) {
    const int tid = tid_(); const int lane = tid & 63, w = __builtin_amdgcn_readfirstlane(tid >> 6);
    const int kcls = ((lane >> 5) & 1) * 4 + ((lane >> 4) & 1) * 2 + ((lane >> 3) & 1);
    for (int t = blockIdx.x * 8 + w; t < T_; t += NBLK * 8) {
        float x[16];
        {
            const float4* xp = (const float4*)(h + (long)t * 1024 + lane * 16); const float4* gp = (const float4*)(g2 + lane * 16); const float4* hp = (const float4*)(hss + (long)t * 16);
            const float4 s0 = hp[0], s1 = hp[1], s2 = hp[2], s3 = hp[3];
            const float rs = rsqrtf((s0.x + s0.y + s0.z + s0.w + s1.x + s1.y + s1.z + s1.w + s2.x + s2.y + s2.z + s2.w + s3.x + s3.y + s3.z + s3.w) * (1.f / 1024.f) + EPS);
#pragma unroll
            for (int k = 0; k < 4; ++k) { const float4 hv = xp[k], gv = gp[k]; x[4 * k] = hv.x * rs * gv.x; x[4 * k + 1] = hv.y * rs * gv.y; x[4 * k + 2] = hv.z * rs * gv.z; x[4 * k + 3] = hv.w * rs * gv.w; }
        }
        const int elo = eo[(long)t * 128 + lane], ehi = eo[(long)t * 128 + 64 + lane];
        const float glo = go[(long)t * 128 + lane], ghi = go[(long)t * 128 + 64 + lane];
        for (int bt = 0; bt < 16; ++bt) {
            int e[8];
#pragma unroll
            for (int k = 0; k < 8; ++k) e[k] = __builtin_amdgcn_readlane(bt < 8 ? elo : ehi, (bt * 8 + k) & 63);
            uint4 u[8];
#pragma unroll
            for (int k = 0; k < 8; ++k) u[k] = *(const uint4*)(U8 + (long)e[k] * 1024 + lane * 16);
            const int emine = __shfl(bt < 8 ? elo : ehi, (bt * 8 + kcls) & 63);
            const float sum = su[emine], svm = sv[emine];
            const float gk = __shfl(bt < 8 ? glo : ghi, (bt * 8 + kcls) & 63);
            float a[8];
#pragma unroll
            for (int k = 0; k < 8; ++k) {
                float s = dot4_fp8(u[k].x, x[0], x[1], x[2], x[3], 0.f); s = dot4_fp8(u[k].y, x[4], x[5], x[6], x[7], s);
                s = dot4_fp8(u[k].z, x[8], x[9], x[10], x[11], s); a[k] = dot4_fp8(u[k].w, x[12], x[13], x[14], x[15], s);
            }
            float b4[4], c2[2], d1;
#pragma unroll
            for (int i = 0; i < 4; ++i) {
                auto rr = __builtin_amdgcn_permlane32_swap(__float_as_uint(a[i]), __float_as_uint(a[i + 4]), false, false);
                b4[i] = __uint_as_float(rr[0]) + __uint_as_float(rr[1]);
            }
#pragma unroll
            for (int i = 0; i < 2; ++i) {
                auto rr = __builtin_amdgcn_permlane16_swap(__float_as_uint(b4[i]), __float_as_uint(b4[i + 2]), false, false);
                c2[i] = __uint_as_float(rr[0]) + __uint_as_float(rr[1]);
            }
            { const bool up = (lane & 8) != 0; const float keep = up ? c2[1] : c2[0], send = up ? c2[0] : c2[1];
              d1 = keep + __uint_as_float(__builtin_amdgcn_mov_dpp(__float_as_uint(send), 0x128, 0xF, 0xF, true)); }
            d1 = quad_sum(d1);
            d1 += __uint_as_float(__builtin_amdgcn_mov_dpp(__float_as_uint(d1), 0x141, 0xF, 0xF, true));
            const float wl = gk * gelu_tanh(d1 * sum) * svm;
            if ((lane & 7) == 0) wout[(long)t * 128 + bt * 8 + kcls] = wl;
        }
    }
}
__device__ __forceinline__ void peer_sweep_b(const int* __restrict__ eo, const float* __restrict__ win, const unsigned char* __restrict__ V8, float* out) {
    const int tid = tid_(); const int lane = tid & 63, w = __builtin_amdgcn_readfirstlane(tid >> 6);
    for (int t = blockIdx.x * 8 + w; t < T_; t += NBLK * 8) {
        float y[16];
#pragma unroll
        for (int i = 0; i < 16; ++i) y[i] = 0.f;
        const int elo = eo[(long)t * 128 + lane], ehi = eo[(long)t * 128 + 64 + lane];
        const float wlo = win[(long)t * 128 + lane], whi = win[(long)t * 128 + 64 + lane];
        for (int bt = 0; bt < 16; ++bt) {
            int e[8]; float wk[8];
#pragma unroll
            for (int k = 0; k < 8; ++k) {
                e[k] = __builtin_amdgcn_readlane(bt < 8 ? elo : ehi, (bt * 8 + k) & 63);
                wk[k] = __uint_as_float(__builtin_amdgcn_readlane(__float_as_uint(bt < 8 ? wlo : whi), (bt * 8 + k) & 63));
            }
            uint4 v[8];
#pragma unroll
            for (int k = 0; k < 8; ++k) v[k] = *(const uint4*)(V8 + (long)e[k] * 1024 + lane * 16);
#pragma unroll
            for (int k = 0; k < 8; ++k) {
                const unsigned vw[4] = {v[k].x, v[k].y, v[k].z, v[k].w};
#pragma unroll
                for (int q = 0; q < 4; ++q) {
                    const f32x2_t lo = __builtin_amdgcn_cvt_pk_f32_fp8((int)vw[q], false), hi = __builtin_amdgcn_cvt_pk_f32_fp8((int)vw[q], true);
                    y[4 * q] = fmaf(wk[k], lo.x, y[4 * q]); y[4 * q + 1] = fmaf(wk[k], lo.y, y[4 * q + 1]); y[4 * q + 2] = fmaf(wk[k], hi.x, y[4 * q + 2]); y[4 * q + 3] = fmaf(wk[k], hi.y, y[4 * q + 3]);
                }
            }
        }
        float4* o = (float4*)(out + (long)t * 1024 + lane * 16);
#pragma unroll
        for (int k = 0; k < 4; ++k) { float4 hv = o[k]; hv.x += y[4 * k]; hv.y += y[4 * k + 1]; hv.z += y[4 * k + 2]; hv.w += y[4 * k + 3]; o[k] = hv; }
    }
}

struct Params {
    const float* x; const int* positions; const float* norm1_gain; const float* w_in;
    const float *nsa_q_gain, *nsa_kc_gain, *nsa_ks_gain, *nsa_kw_gain, *cmp_pos, *cmp_k_w1, *cmp_k_w2, *cmp_v_w1, *cmp_v_w2;
    const float *mla_q_lora_gain, *mla_w_uq, *mla_kv_lora_gain, *mla_w_ukv, *mla_q_gain, *mla_k_gain, *out_gain_a, *out_gain_b, *w_out;
    const float *norm2_gain, *peer_w_q, *peer_sub_keys, *peer_u, *peer_v;
    float* out; float* W; unsigned* bar;
};
constexpr int LDS_BYTES = 64 + 131072;
static_assert(LDS_BYTES >= 8 * 3200 * 4 + 64, "naive NSA phase needs 102,464 B");

typedef __attribute__((address_space(4))) const Params* cparams_t;
__device__ __forceinline__ cparams_t params_ptr() {
    cparams_t pp = (cparams_t)__builtin_amdgcn_kernarg_segment_ptr();
    asm volatile("" : "+s"(pp));
    return pp;
}
constexpr long M1 = 1 << 20;
constexpr long F_U8 = 0, F_V8 = 4 * M1, F_SU = 21 * M1 + 3 * M1 / 8, F_SV = F_SU + 16384,
               F_WTIN = 16 * M1, F_WTUQ = 17 * M1, F_WTUKV = 17 * M1 + M1 / 8, F_W1TK = 17 * M1 + M1 / 4, F_W1TV = 17 * M1 + M1 / 2, F_W2TK = 17 * M1 + 3 * M1 / 4,
               F_W2TV = F_W2TK + 8192, F_CBIAS = F_W2TV + 8192, F_WTOUT = 18 * M1, F_WTQ = 18 * M1 + M1 / 2, F_SK16 = 19 * M1 + M1 / 2,
               F_SSQCQ = 19 * M1 + 5 * M1 / 8, F_SSQCKV = F_SSQCQ + 4 * 16384, F_SSQKR = F_SSQCKV + 2 * 16384, F_SSQA = 19 * M1 + 3 * M1 / 4, F_SSQB = F_SSQA + 8 * 16384,
               F_ROPE = 20 * M1, F_GATES = 21 * M1, F_KRR = 21 * M1 + M1 / 2,
               F_XN16 = 22 * M1, F_MIX = 22 * M1,
               F_Q16A = 30 * M1, F_KS16 = 34 * M1, F_KW16 = 35 * M1, F_VST16 = 36 * M1, F_VWT16 = 37 * M1, F_KCMP16 = 38 * M1, F_VCMP16 = 39 * M1 + M1 / 8,
               F_CQ16 = 40 * M1 + M1 / 4, F_CKV16 = 42 * M1 + M1 / 4,
               F_Q16 = 43 * M1 + M1 / 2, F_K16 = 49 * M1 + M1 / 2, F_VT16 = 55 * M1 + M1 / 2, F_HID = 59 * M1 + M1 / 2, F_KC16 = 63 * M1 + M1 / 2, F_VCT16 = F_KC16 + M1 / 8,
               F_HB = 30 * M1, F_HSS = 38 * M1, F_PSS = 38 * M1 + M1 / 2, F_EO = 39 * M1, F_GO = 41 * M1, F_PQB = 43 * M1 + M1 / 2;
static_assert(F_SSQKR + 16384 <= F_SSQA && F_SSQB + 8 * 16384 <= F_ROPE && F_VCT16 + M1 / 8 <= 64 * M1 - 16384 && F_CKV16 + M1 <= F_Q16 && F_PQB + 16 * M1 <= F_HID, "workspace map");

#define G(x) (x)
__global__ __launch_bounds__(512, 2) void mega(Params p_unused) {
    extern __shared__ __attribute__((aligned(16))) unsigned char lds_raw[];
    float* ldsf = (float*)(lds_raw + 64);
    { const unsigned bid_ = blockIdx.x; __builtin_assume(bid_ < (unsigned)NBLK); }
    if (threadIdx.x == 0) *(uint4*)lds_raw = make_uint4(0u, 0u, 0u, 0u);
    __syncthreads();
    XcdBarrier bar = xcd_barrier_post(params_ptr()->bar, (volatile LAS unsigned*)lds_raw);
#define GRID_SYNC() xcd_barrier(bar)
#define U16P(off) ((unsigned short*)(W + (off)))
    { cparams_t p = params_ptr(); float* W = p->W;
      p0_xn_rope(p->x, p->norm1_gain, p->positions, U16P(F_XN16), W + F_ROPE); }
    { cparams_t p = params_ptr(); float* W = p->W;
      cvt_transpose2<2>(ldsf, p->w_in, 1024, INW, U16P(F_WTIN), nullptr);
      zero_stream(U16P(F_WTIN) + (long)1720 * 1024, (long)72 * 1024); }
    { cparams_t p = params_ptr(); float* W = p->W;
      cvt_transpose2<0>(ldsf, p->mla_w_uq, 256, 768, U16P(F_WTUQ), p->mla_q_lora_gain);
      cvt_transpose2<0>(ldsf, p->mla_w_ukv, 128, 1024, U16P(F_WTUKV), p->mla_kv_lora_gain); }
    { cparams_t p = params_ptr(); float* W = p->W;
      cvt_transpose2<0>(ldsf, p->cmp_k_w1, 2048, 256, U16P(F_W1TK), nullptr);
      cvt_transpose2<0>(ldsf, p->cmp_v_w1, 2048, 256, U16P(F_W1TV), nullptr);
      cvt_transpose2<0>(ldsf, p->cmp_k_w2, 256, 64, U16P(F_W2TK), nullptr);
      cvt_transpose2<0>(ldsf, p->cmp_v_w2, 256, 64, U16P(F_W2TV), nullptr);
      p0_cbias(p->cmp_pos, p->cmp_k_w1, p->cmp_v_w1, W + F_CBIAS); }
    GRID_SYNC();
    { cparams_t p = params_ptr(); float* W = p->W;
      P1Out O; O.q16a = U16P(F_Q16A); O.ks16 = U16P(F_KS16); O.kw16 = U16P(F_KW16); O.vst16 = U16P(F_VST16); O.vwt16 = U16P(F_VWT16); O.kcmp16 = U16P(F_KCMP16); O.vcmp16 = U16P(F_VCMP16);
      O.cq16 = U16P(F_CQ16); O.ckv16 = U16P(F_CKV16); O.krr = W + F_KRR; O.ssq_kr = W + F_SSQKR; O.ssq_cq = W + F_SSQCQ; O.ssq_ckv = W + F_SSQCKV; O.gates = W + F_GATES;
      O.rope = W + F_ROPE; O.q_gain = p->nsa_q_gain; O.ks_gain = p->nsa_ks_gain; O.kw_gain = p->nsa_kw_gain; O.k_gain = p->mla_k_gain;
      p1_inproj_256(lds_raw + 64, U16P(F_XN16), U16P(F_WTIN), O); }
    GRID_SYNC();
    { cparams_t p = params_ptr(); float* W = p->W;
      P2Args A; A.cq16 = U16P(F_CQ16); A.ckv16 = U16P(F_CKV16); A.wt_uq = U16P(F_WTUQ); A.wt_ukv = U16P(F_WTUKV); A.kcmp16 = U16P(F_KCMP16); A.vcmp16 = U16P(F_VCMP16); A.w1t_k = U16P(F_W1TK); A.w1t_v = U16P(F_W1TV);
      A.ssq_cq = W + F_SSQCQ; A.ssq_ckv = W + F_SSQCKV; A.ssq_kr = W + F_SSQKR; A.krr = W + F_KRR; A.rope = W + F_ROPE; A.q_gain = p->mla_q_gain; A.k_gain = p->mla_k_gain;
      A.q16 = U16P(F_Q16); A.k16 = U16P(F_K16); A.vt16 = U16P(F_VT16); A.hid = W + F_HID;
      p2_phase(lds_raw + 64, A); }
    GRID_SYNC();
    { cparams_t p = params_ptr(); float* W = p->W;
      p3_cmp2(W + F_HID, W + F_CBIAS, U16P(F_W2TK), U16P(F_W2TV), p->nsa_kc_gain, W + F_ROPE, U16P(F_KC16), U16P(F_VCT16)); }
    if (blockIdx.x >= 16) {
      const int vb = blockIdx.x - 16, nb = NBLK - 16;
      { cparams_t p = params_ptr(); float* W = p->W;
        cvt_transpose<0>(ldsf, p->w_out, 1024, 1024, U16P(F_WTOUT), p->out_gain_a, p->out_gain_b, 512, vb, nb); }
      { cparams_t p = params_ptr(); float* W = p->W;
        cvt_transpose<0>(ldsf, p->peer_w_q, 1024, 2048, U16P(F_WTQ), p->norm2_gain, p->norm2_gain, 1 << 30, vb, nb); }
      { cparams_t p = params_ptr(); float* W = p->W;
        cvt_stream(p->peer_sub_keys, U16P(F_SK16), (long)8 * 2 * 128 * 128, vb, nb);
        cvt_rows_fp8(p->peer_u, (unsigned char*)(W + F_U8), W + F_SU, 16384, vb, nb);
        cvt_rows_fp8(p->peer_v, (unsigned char*)(W + F_V8), W + F_SV, 16384, vb, nb); }
    }
    GRID_SYNC();
    { cparams_t p = params_ptr(); float* W = p->W;
      nsa_phase(lds_raw + 64, U16P(F_Q16A), U16P(F_KC16), U16P(F_VCT16), U16P(F_KS16), U16P(F_VST16), U16P(F_KW16), U16P(F_VWT16), W + F_GATES, U16P(F_MIX), W + F_SSQA); }
    { cparams_t p = params_ptr(); float* W = p->W;
      mla_phase(lds_raw + 64, U16P(F_Q16), U16P(F_K16), U16P(F_VT16), U16P(F_MIX), W + F_SSQB); }
    GRID_SYNC();
    { cparams_t p = params_ptr(); float* W = p->W;
      p5_outproj_256(lds_raw + 64, U16P(F_MIX), U16P(F_WTOUT), W + F_SSQA, W + F_SSQB, p->x, p->out, U16P(F_HB), W + F_HSS); }
    GRID_SYNC();
    { cparams_t p = params_ptr(); float* W = p->W;
      p6_peerq_256(lds_raw + 64, U16P(F_HB), U16P(F_WTQ), W + F_HSS, U16P(F_PQB), W + F_PSS); }
    GRID_SYNC();
    { cparams_t p = params_ptr(); float* W = p->W;
      peer_route_mfma(lds_raw + 64, U16P(F_PQB), W + F_PSS, U16P(F_SK16), (int*)(W + F_EO), W + F_GO); }
    GRID_SYNC();
    { cparams_t p = params_ptr(); float* W = p->W;
      peer_sweep_a(W + F_HSS, p->norm2_gain, (const int*)(W + F_EO), W + F_GO, (const unsigned char*)(W + F_U8), W + F_SU, W + F_SV, p->out, W + F_PQB); }
    GRID_SYNC();
    { cparams_t p = params_ptr(); float* W = p->W;
      peer_sweep_b((const int*)(W + F_EO), W + F_PQB, (const unsigned char*)(W + F_V8), p->out); }
}

extern "C" void kernel_launch(void* const* d_in, const int* in_sizes, int n_in, void* d_out, int out_size, void* d_ws, size_t ws_size, hipStream_t stream) {
    (void)ws_size; (void)in_sizes; (void)n_in; (void)out_size;
    static int grid = 0;
    if (grid == 0) {
        int dev = 0, cus = 0, per_cu = 0;
        (void)hipGetDevice(&dev);
        (void)hipDeviceGetAttribute(&cus, hipDeviceAttributeMultiprocessorCount, dev);
        (void)hipFuncSetAttribute((const void*)mega, hipFuncAttributeMaxDynamicSharedMemorySize, LDS_BYTES);
        (void)hipOccupancyMaxActiveBlocksPerMultiprocessor(&per_cu, (const void*)mega, 512, LDS_BYTES);
        (void)hipGetLastError();
        if (per_cu < 1) fprintf(stderr, "kernel_launch: occupancy query reports %d blocks per CU\n", per_cu);
        if (cus != NBLK) fprintf(stderr, "kernel_launch: built for %d CUs, device reports %d\n", NBLK, cus);
        grid = NBLK;
    }
    Params p{};
    p.x = (const float*)d_in[0]; p.positions = (const int*)d_in[1]; p.norm1_gain = (const float*)d_in[2]; p.w_in = (const float*)d_in[3];
    p.nsa_q_gain = (const float*)d_in[4]; p.nsa_kc_gain = (const float*)d_in[5]; p.nsa_ks_gain = (const float*)d_in[6]; p.nsa_kw_gain = (const float*)d_in[7];
    p.cmp_pos = (const float*)d_in[8]; p.cmp_k_w1 = (const float*)d_in[9]; p.cmp_k_w2 = (const float*)d_in[10]; p.cmp_v_w1 = (const float*)d_in[11]; p.cmp_v_w2 = (const float*)d_in[12];
    p.mla_q_lora_gain = (const float*)d_in[13]; p.mla_w_uq = (const float*)d_in[14]; p.mla_kv_lora_gain = (const float*)d_in[15]; p.mla_w_ukv = (const float*)d_in[16];
    p.mla_q_gain = (const float*)d_in[17]; p.mla_k_gain = (const float*)d_in[18]; p.out_gain_a = (const float*)d_in[19]; p.out_gain_b = (const float*)d_in[20]; p.w_out = (const float*)d_in[21];
    p.norm2_gain = (const float*)d_in[22]; p.peer_w_q = (const float*)d_in[23]; p.peer_sub_keys = (const float*)d_in[24]; p.peer_u = (const float*)d_in[25]; p.peer_v = (const float*)d_in[26];
    p.out = (float*)d_out;
    p.bar = (unsigned*)d_ws;
    p.W = (float*)d_ws + 16384;
    (void)hipMemsetAsync(d_ws, 0, XCD_BAR_WORDS * sizeof(unsigned), stream);
    hipLaunchKernelGGL(mega, dim3(grid), dim3(512), LDS_BYTES, stream, p);
}
```

```cpp
#include <hip/hip_runtime.h>
#include <cmath>
#include <cstdint>
#include <cstdio>

#define XB_TMO      128
#define XB_XCNT(j)  (256  + 64 * (j))
#define XB_XSUB(j)  (1280 + 64 * (j))
#define XB_XGEN(j)  (2304 + 64 * (j))
#define XB_TOP      3328
#define XB_TOPGEN   3392
#define XCD_BAR_WORDS 3456
#define XB_SPIN_CAP (1u << 18)
#define LAS __attribute__((address_space(3)))

__device__ __forceinline__ unsigned xb_ld(unsigned* p)              { return __hip_atomic_load(p, __ATOMIC_RELAXED, __HIP_MEMORY_SCOPE_AGENT); }
__device__ __forceinline__ unsigned xb_add(unsigned* p, unsigned v) { return __hip_atomic_fetch_add(p, v, __ATOMIC_RELAXED, __HIP_MEMORY_SCOPE_AGENT); }
__device__ __forceinline__ unsigned xb_xcc_id() { return (unsigned)__builtin_amdgcn_s_getreg((3 << 11) | 20) & 0xFu; }
#define XB_SPIN(cond, bar) do { unsigned _sp = 0; while (cond) { __builtin_amdgcn_s_sleep(1); \
    if ((++_sp & 255u) == 0u) { if (xb_ld(&(bar)[XB_TMO])) break; if (_sp > XB_SPIN_CAP) { atomicAdd(&(bar)[XB_TMO], 1u); break; } } } } while (0)

struct XcdBarrier {
    unsigned* bar; unsigned x;
    volatile LAS unsigned* st;
};

__device__ __forceinline__ XcdBarrier xcd_barrier_post(unsigned* bar, volatile LAS unsigned* st) {
    XcdBarrier b; b.bar = bar; b.x = xb_xcc_id(); b.st = st;
    if (threadIdx.x == 0) (void)xb_add(&bar[XB_XCNT(b.x)], 1u);
    return b;
}
__device__ __forceinline__ void xcd_barrier_complete(unsigned* bar, unsigned x, unsigned& nloc, unsigned& nx) {
    const unsigned G = gridDim.x * gridDim.y * gridDim.z;
    unsigned sum, cnt, mine, sp = 0u;
    for (;;) {
        sum = 0u; cnt = 0u; mine = 0u;
#pragma unroll
        for (unsigned j = 0; j < 16; ++j) { const unsigned c = xb_ld(&bar[XB_XCNT(j)]); sum += c; cnt += (c > 0u) ? 1u : 0u; mine = (j == x) ? c : mine; }
        if (sum == G) break;
        __builtin_amdgcn_s_sleep(1);
        if ((++sp & 255u) == 0u) { if (xb_ld(&bar[XB_TMO])) break; if (sp > XB_SPIN_CAP) { atomicAdd(&bar[XB_TMO], 1u); break; } }
    }
    nloc = mine > 0u ? mine : 1u; nx = cnt > 0u ? cnt : 1u;
}

__device__ __forceinline__ void xcd_barrier(const XcdBarrier& b) {
    asm volatile("s_waitcnt vmcnt(0)" ::: "memory");
    __syncthreads();
    if (threadIdx.x == 0) {
        unsigned* bar = b.bar;
        __builtin_amdgcn_s_waitcnt(0);
        unsigned nloc = b.st[0], nx = b.st[1];
        if (nloc == 0u) { xcd_barrier_complete(bar, b.x, nloc, nx); b.st[0] = nloc; b.st[1] = nx; }
        const unsigned old = xb_add(&bar[XB_XSUB(b.x)], 1u);
        const unsigned gen = old / nloc;
        if (old + 1u == (gen + 1u) * nloc) {
            __builtin_amdgcn_fence(__ATOMIC_RELEASE, "agent");
            asm volatile("s_waitcnt vmcnt(0)" ::: "memory");
            const unsigned og = xb_add(&bar[XB_TOP], 1u);
            const unsigned tg = og / nx;
            if (og + 1u == (tg + 1u) * nx) xb_add(&bar[XB_TOPGEN], 1u);
            else XB_SPIN(xb_ld(&bar[XB_TOPGEN]) == tg, bar);
            __builtin_amdgcn_fence(__ATOMIC_ACQUIRE, "agent");
            xb_add(&bar[XB_XGEN(b.x)], 1u);
            asm volatile("s_waitcnt vmcnt(0)" ::: "memory");
        } else {
            XB_SPIN(xb_ld(&bar[XB_XGEN(b.x)]) == gen, bar);
            __builtin_amdgcn_fence(__ATOMIC_ACQUIRE, "agent");
            asm volatile("s_waitcnt vmcnt(0)" ::: "memory");
        }
    }
    __syncthreads();
}


#define AS1 __attribute__((address_space(1)))
constexpr int NBLK = 256;
constexpr int B_ = 2, S_ = 8192, T_ = B_ * S_, D_ = 1024, INW = 1720;
constexpr int G_ = 2, NCMP = 511;
constexpr float EPS = 1e-6f;
constexpr int C_Q = 0, C_KC = 512, C_VC = 640, C_KS = 768, C_VS = 896, C_KW = 1024, C_VW = 1152, C_GATE = 1280, C_CQ = 1304, C_CKV = 1560, C_KR = 1688;

#define WSYNC() do { __builtin_amdgcn_wave_barrier(); asm volatile("s_waitcnt lgkmcnt(0)" ::: "memory"); __builtin_amdgcn_wave_barrier(); } while (0)

__device__ __forceinline__ int tid_() { int t = threadIdx.x; asm volatile("" : "+v"(t)); return t; }
template <class T> __device__ __forceinline__ T* as_global(T* p) { return (T*)(__attribute__((address_space(1))) T*)p; }
__device__ __forceinline__ float wsum(float v) {
#pragma unroll
    for (int o = 32; o > 0; o >>= 1) v += __shfl_xor(v, o);
    return v;
}
__device__ __forceinline__ float wmax(float v) {
#pragma unroll
    for (int o = 32; o > 0; o >>= 1) v = fmaxf(v, __shfl_xor(v, o));
    return v;
}
__device__ __forceinline__ float gelu_tanh(float x) {
    const float u = 0.7978845608028654f * (x + 0.044715f * x * x * x);
    return 0.5f * x * (1.f + tanhf(u));
}

__device__ const float ROPE_F16[8] = {1.000000000e+00f, 1.939227432e-01f, 3.760603070e-02f, 7.292664610e-03f, 1.414213562e-03f, 2.742481884e-04f, 5.318296098e-05f, 1.031338616e-05f};
__device__ const float ROPE_F32[16] = {1.000000000e+00f, 4.403665960e-01f, 1.939227432e-01f, 8.539710194e-02f, 3.760603070e-02f, 1.656043902e-02f, 7.292664610e-03f, 3.211445874e-03f,
                                       1.414213562e-03f, 6.227723788e-04f, 2.742481884e-04f, 1.207697351e-04f, 5.318296098e-05f, 2.341999971e-05f, 1.031338616e-05f, 4.541670478e-06f};

typedef __attribute__((ext_vector_type(8))) short bf16x8;
typedef __attribute__((ext_vector_type(16))) float f32x16;
typedef __attribute__((ext_vector_type(2))) __bf16 bf16x2_t;
__device__ __forceinline__ unsigned cvtpk(float lo, float hi) { unsigned r; asm("v_cvt_pk_bf16_f32 %0, %1, %2" : "=v"(r) : "v"(lo), "v"(hi)); return r; }
__device__ __forceinline__ float bflo(unsigned u) { return __uint_as_float(u << 16); }
__device__ __forceinline__ float bfhi(unsigned u) { return __uint_as_float(u & 0xffff0000u); }
__device__ __forceinline__ float dot2bf(unsigned a, unsigned b, float c) { return __builtin_amdgcn_fdot2_f32_bf16(__builtin_bit_cast(bf16x2_t, a), __builtin_bit_cast(bf16x2_t, b), c, false); }

__device__ __forceinline__ float pair_max(float x) { auto rr = __builtin_amdgcn_permlane32_swap(__float_as_uint(x), __float_as_uint(x), false, false); return fmaxf(__uint_as_float(rr[0]), __uint_as_float(rr[1])); }
__device__ __forceinline__ float pair_sum(float x) { auto rr = __builtin_amdgcn_permlane32_swap(__float_as_uint(x), __float_as_uint(x), false, false); return __uint_as_float(rr[0]) + __uint_as_float(rr[1]); }
__device__ __forceinline__ float quad_sum(float x) {
    float y = x + __uint_as_float(__builtin_amdgcn_mov_dpp(__float_as_uint(x), 0xB1, 0xF, 0xF, true));
    return y + __uint_as_float(__builtin_amdgcn_mov_dpp(__float_as_uint(y), 0x4E, 0xF, 0xF, true));
}
#define MFMA32(a, b, c) __builtin_amdgcn_mfma_f32_32x32x16_bf16(a, b, c, 0, 0, 0)
typedef unsigned u32x4 __attribute__((ext_vector_type(4)));
constexpr int LDS_PITCH = 144;
__device__ __forceinline__ int crow(int r, int hi) { return (r & 3) + 8 * (r >> 2) + 4 * hi; }

template <int WM_, int WN_, int MI_, int NI_>
struct GemmShape {
    static constexpr int WM = WM_, WN = WN_, MI = MI_, NI = NI_;
    static constexpr int BM = WM * MI * 32, BN = WN * NI * 32, ROWS = BM + BN;
    static constexpr int CHUNKS = ROWS * 8 / 512;
    static constexpr int STAGE_BYTES = ROWS * LDS_PITCH;
    static_assert(WM * WN == 8 && (ROWS * 8) % 512 == 0, "8 waves; whole chunks per thread");
};
template <class SH, unsigned TOKMASK, int CUR>
__device__ __forceinline__ void gemm_step(unsigned char* lds, const unsigned short* const (&gp)[SH::CHUNKS], const int (&lo)[SH::CHUNKS], u32x4 (&g)[2][SH::CHUNKS],
                                          f32x16 (&acc)[SH::MI][SH::NI], int kt, int nk, int aoff, int boff) {
    const unsigned char* st = lds + (kt & 1) * SH::STAGE_BYTES;
    if (kt + 2 < nk) {
#pragma unroll
        for (int i = 0; i < SH::CHUNKS; ++i) g[CUR][i] = *(const u32x4*)(gp[i] + (long)(kt + 2) * 64);
    }
#pragma unroll
    for (int ks = 0; ks < 4; ++ks) {
        bf16x8 af[SH::MI], bfr[SH::NI];
#pragma unroll
        for (int mi = 0; mi < SH::MI; ++mi) af[mi] = *(const bf16x8*)(st + aoff + mi * 32 * LDS_PITCH + ks * 32);
#pragma unroll
        for (int ni = 0; ni < SH::NI; ++ni) bfr[ni] = *(const bf16x8*)(st + boff + ni * 32 * LDS_PITCH + ks * 32);
#pragma unroll
        for (int mi = 0; mi < SH::MI; ++mi)
#pragma unroll
            for (int ni = 0; ni < SH::NI; ++ni)
                acc[mi][ni] = ((TOKMASK >> ni) & 1u) ? MFMA32(bfr[ni], af[mi], acc[mi][ni]) : MFMA32(af[mi], bfr[ni], acc[mi][ni]);
    }
    if (kt + 1 < nk) {
        unsigned char* sn = lds + ((kt + 1) & 1) * SH::STAGE_BYTES;
#pragma unroll
        for (int i = 0; i < SH::CHUNKS; ++i) *(u32x4*)(sn + lo[i]) = g[CUR ^ 1][i];
    }
    __syncthreads();
}
template <class SH, unsigned TOKMASK>
__device__ __forceinline__ void gemm_mainloop(const unsigned short* __restrict__ A0, long lda, const unsigned short* __restrict__ B0, long ldb, int K,
                                              unsigned char* lds, f32x16 (&acc)[SH::MI][SH::NI], int tid) {
    const int lane = tid & 63, wave = __builtin_amdgcn_readfirstlane(tid >> 6), r32 = lane & 31, hi = lane >> 5;
    const int wm = wave / SH::WN, wn = wave % SH::WN;
    const unsigned short* gp[SH::CHUNKS]; int lo[SH::CHUNKS];
#pragma unroll
    for (int i = 0; i < SH::CHUNKS; ++i) {
        const int c = tid + i * 512, row = c >> 3, kc = c & 7;
        gp[i] = (row < SH::BM) ? (A0 + (long)row * lda + kc * 8) : (B0 + (long)(row - SH::BM) * ldb + kc * 8);
        lo[i] = row * LDS_PITCH + kc * 16;
    }
    u32x4 g[2][SH::CHUNKS];
    const int nk = K >> 6;
#pragma unroll
    for (int i = 0; i < SH::CHUNKS; ++i) { g[0][i] = *(const u32x4*)gp[i]; g[1][i] = *(const u32x4*)(gp[i] + 64); }
#pragma unroll
    for (int i = 0; i < SH::CHUNKS; ++i) *(u32x4*)(lds + lo[i]) = g[0][i];
    __syncthreads();
    const int aoff = (wm * SH::MI * 32 + r32) * LDS_PITCH + hi * 16;
    const int boff = (SH::BM + wn * SH::NI * 32 + r32) * LDS_PITCH + hi * 16;
    for (int kt = 0; kt < nk; kt += 2) {
        gemm_step<SH, TOKMASK, 0>(lds, gp, lo, g, acc, kt, nk, aoff, boff);
        gemm_step<SH, TOKMASK, 1>(lds, gp, lo, g, acc, kt + 1, nk, aoff, boff);
    }
}

__device__ __forceinline__ int nmap_in(int n) {
    if (n < 1280) return n;
    if (n < 1304) return n - 1280 + 1696;
    if (n < 1560) return n - 1304 + 1280;
    if (n < 1688) return n - 1560 + 1536;
    return n - 1688 + 1664;
}
template <int NMAP>
__device__ __forceinline__ void cvt_transpose(float* ldsf, const float* __restrict__ Wsrc, int K, int N, unsigned short* __restrict__ Wt, const float* __restrict__ kgain_lo, const float* __restrict__ kgain_hi, int ksplit, int vb = blockIdx.x, int nb = NBLK) {
    const int tid = tid_();
    float (*tl)[65] = (float (*)[65])ldsf;
    const int tk = K / 64, tn = (N + 63) / 64;
    for (int tile = vb; tile < tk * tn; tile += nb) {
        const int k0 = (tile / tn) * 64, n0 = (tile % tn) * 64;
#pragma unroll
        for (int i = 0; i < 8; ++i) {
            const int kl = (tid >> 6) + 8 * i, nl = tid & 63; const int n = n0 + nl, k = k0 + kl;
            float v = (n < N) ? Wsrc[(long)k * N + n] : 0.f;
            if (kgain_lo) v *= (k < ksplit) ? kgain_lo[k] : kgain_hi[k - ksplit];
            tl[kl][nl] = v;
        }
        __syncthreads();
        {
            const int nl = tid >> 3, kc = (tid & 7) * 8; const int n = n0 + nl;
            if (n < N) {
                uint4 o; o.x = cvtpk(tl[kc][nl], tl[kc + 1][nl]); o.y = cvtpk(tl[kc + 2][nl], tl[kc + 3][nl]); o.z = cvtpk(tl[kc + 4][nl], tl[kc + 5][nl]); o.w = cvtpk(tl[kc + 6][nl], tl[kc + 7][nl]);
                const int nn = NMAP ? nmap_in(n) : n;
                *(uint4*)(Wt + (long)nn * K + k0 + kc) = o;
            }
        }
        __syncthreads();
    }
}

typedef __attribute__((ext_vector_type(4))) float f32x4_t;
namespace g256 {
constexpr int BK = 64, HALF = 128, HT = HALF * BK;
__device__ __forceinline__ int lds_byte(int r, int c) { const int st = (r >> 4) * 2 + (c >> 5), rr = r & 15, cc = c & 31, ob = rr * 64 + cc * 2; return st * 1024 + (ob ^ (((ob >> 9) & 1) << 5)); }
__device__ __forceinline__ void stage_rc(int b, int& R, int& C) { const int st = b / 1024, sb = b % 1024, swz = sb ^ (((sb >> 9) & 1) << 5); R = (st >> 1) * 16 + swz / 64; C = (st & 1) * 32 + (swz % 64) / 2; }
template <int K, int PITCH = K>
__device__ __forceinline__ void mainloop(const unsigned short* __restrict__ A, const unsigned short* __restrict__ Bt, int brow, int bcol, unsigned short* shm, f32x4_t (&acc)[2][2][4][2]) {
#define SA(b, h) (shm + ((b) * 2 + (h)) * HT)
#define SB(b, h) (shm + (4 + (b) * 2 + (h)) * HT)
#define STAGE_X(T, P, BASE, br, kt) do { const AS1 char* ub_ = (const AS1 char*)(BASE) + ((long)(br) * PITCH + (long)(kt) * BK) * 2;     \
    for (int i_ = 0; i_ < 2; ++i_) { const int b_ = (T) * 16 + i_ * 8192; int r_, c_; stage_rc(b_, r_, c_); \
      __builtin_amdgcn_global_load_lds((const AS1 unsigned*)(ub_ + (unsigned)(r_ * PITCH + c_) * 2u), (LAS unsigned*)((LAS char*)(P) + b_), 16, 0, 0); } } while (0)
#define STAGE(P, BASE, br, kt) STAGE_X(tx, P, BASE, br, kt)
#define LDA(dst, b, h) for (int m = 0; m < 4; ++m) for (int k = 0; k < 2; ++k) dst[m][k] = *reinterpret_cast<const bf16x8*>((char*)SA(b, h) + lds_byte(wr * 64 + m * 16 + fr, k * 32 + fq * 8))
#define LDB(dst, b, h) for (int n = 0; n < 2; ++n) for (int k = 0; k < 2; ++k) dst[n][k] = *reinterpret_cast<const bf16x8*>((char*)SB(b, h) + lds_byte(wc * 32 + n * 16 + fr, k * 32 + fq * 8))
#define MMA(ai, bj, At_, Bt_) do { __builtin_amdgcn_s_setprio(1); \
    for (int m = 0; m < 4; ++m) for (int n = 0; n < 2; ++n) for (int k = 0; k < 2; ++k) acc[ai][bj][m][n] = __builtin_amdgcn_mfma_f32_16x16x32_bf16(At_[m][k], Bt_[n][k], acc[ai][bj][m][n], 0, 0, 0); \
    __builtin_amdgcn_s_setprio(0); } while (0)
#define WAIT_V(n) asm volatile("s_waitcnt vmcnt(" #n ")" ::: "memory")
#define WAIT_L(n) asm volatile("s_waitcnt lgkmcnt(" #n ")" ::: "memory")
#define BAR __builtin_amdgcn_s_barrier()
#define SCHED __builtin_amdgcn_sched_barrier(0)
    int tx = threadIdx.x; asm volatile("" : "+v"(tx));
    int wid = tx >> 6, lane = tx & 63, wr = wid >> 2, wc = wid & 3, fr = lane & 15, fq = lane >> 4;
    bf16x8 At[4][2], B0[2][2], B1[2][2];
    const int nt = K / BK;
    STAGE(SB(0, 0), Bt, bcol, 0); STAGE(SA(0, 0), A, brow, 0);
    STAGE(SB(0, 1), Bt, bcol + HALF, 0); STAGE(SA(0, 1), A, brow + HALF, 0);
    if (wr == 1) BAR;
    WAIT_V(4); BAR;
    STAGE(SB(1, 0), Bt, bcol, 1); STAGE(SA(1, 0), A, brow, 1); STAGE(SB(1, 1), Bt, bcol + HALF, 1);
    WAIT_V(6); BAR;
    for (int t = 0; t < nt - 2; t += 2) {
        LDB(B0, 0, 0); SCHED; LDA(At, 0, 0); STAGE(SA(1, 1), A, brow + HALF, t + 1);
        WAIT_L(8); BAR; WAIT_L(0); MMA(0, 0, At, B0); BAR; SCHED;
        LDB(B1, 0, 1); STAGE(SB(0, 0), Bt, bcol, t + 2);
        BAR; WAIT_L(0); MMA(0, 1, At, B1); BAR;
        LDA(At, 0, 1); STAGE(SA(0, 0), A, brow, t + 2);
        BAR; WAIT_L(0); MMA(1, 0, At, B0); BAR; SCHED;
        STAGE(SB(0, 1), Bt, bcol + HALF, t + 2);
        WAIT_V(6); BAR; MMA(1, 1, At, B1); BAR;
        LDB(B0, 1, 0); SCHED; LDA(At, 1, 0); STAGE(SA(0, 1), A, brow + HALF, t + 2);
        WAIT_L(8); BAR; WAIT_L(0); MMA(0, 0, At, B0); BAR; SCHED;
        LDB(B1, 1, 1); STAGE(SB(1, 0), Bt, bcol, t + 3);
        BAR; WAIT_L(0); MMA(0, 1, At, B1); BAR;
        LDA(At, 1, 1); STAGE(SA(1, 0), A, brow, t + 3);
        BAR; WAIT_L(0); MMA(1, 0, At, B0); BAR; SCHED;
        STAGE(SB(1, 1), Bt, bcol + HALF, t + 3);
        WAIT_V(6); BAR; MMA(1, 1, At, B1); BAR;
    }
    int tz = threadIdx.x; asm volatile("" : "+v"(tz)); wid = tz >> 6; lane = tz & 63; wr = wid >> 2; wc = wid & 3; fr = lane & 15; fq = lane >> 4;
    { LDB(B0, 0, 0); WAIT_V(0); LDA(At, 0, 0); STAGE_X(tz, SA(1, 1), A, brow + HALF, nt - 1);
      BAR; WAIT_L(0); MMA(0, 0, At, B0); BAR;
      LDB(B1, 0, 1); BAR; WAIT_L(0); MMA(0, 1, At, B1); BAR;
      LDA(At, 0, 1); WAIT_V(4); BAR; WAIT_L(0); MMA(1, 0, At, B0); MMA(1, 1, At, B1); BAR; }
    { LDB(B0, 1, 0); LDA(At, 1, 0); WAIT_V(2); BAR; WAIT_L(0); MMA(0, 0, At, B0); BAR;
      LDB(B1, 1, 1); WAIT_V(0); BAR; WAIT_L(0); MMA(0, 1, At, B1); BAR;
      LDA(At, 1, 1); BAR; WAIT_L(0); MMA(1, 0, At, B0); MMA(1, 1, At, B1); BAR; }
    if (wr == 0) BAR;
#undef SA
#undef SB
#undef STAGE_X
#undef STAGE
#undef LDA
#undef LDB
#undef MMA
#undef WAIT_V
#undef WAIT_L
#undef BAR
#undef SCHED
}
}

__device__ __forceinline__ void p5_outproj_256(unsigned char* lds, const unsigned short* __restrict__ mix, const unsigned short* __restrict__ wt_out, const float* __restrict__ ssqa, const float* __restrict__ ssqb,
                                               const float* __restrict__ x, float* __restrict__ out, unsigned short* __restrict__ hb, float* __restrict__ hss) {
    const int vcu = (blockIdx.x & 7) * (NBLK / 8) + (blockIdx.x >> 3);
    for (int tile = vcu; tile < 64 * 4; tile += NBLK) {
        const int m0 = (tile >> 2) * 256, n0 = (tile & 3) * 256;
        f32x4_t acc[2][2][4][2];
#pragma unroll
        for (int ai = 0; ai < 2; ++ai)
#pragma unroll
            for (int bj = 0; bj < 2; ++bj)
#pragma unroll
                for (int m = 0; m < 4; ++m)
#pragma unroll
                    for (int n = 0; n < 2; ++n) acc[ai][bj][m][n] = f32x4_t{0.f, 0.f, 0.f, 0.f};
        g256::mainloop<512, 1024>(wt_out, mix, n0, m0, (unsigned short*)lds, acc);
        float rb[2][2];
        {
            const int tid = tid_(); const int lane = tid & 63, wave = __builtin_amdgcn_readfirstlane(tid >> 6), wc = wave & 3, fr = lane & 15;
#pragma unroll
            for (int bj = 0; bj < 2; ++bj)
#pragma unroll
                for (int n = 0; n < 2; ++n) {
                    const long tok = m0 + bj * 128 + wc * 32 + n * 16 + fr; float sa = 0.f, sb = 0.f;
#pragma unroll
                    for (int hh = 0; hh < 8; ++hh) { sa += ssqa[(long)hh * T_ + tok]; sb += ssqb[(long)hh * T_ + tok]; }
                    rb[bj][n] = rsqrtf(sb * (1.f / 512.f) + EPS); const float ratio = rsqrtf(sa * (1.f / 512.f) + EPS) / rb[bj][n];
#pragma unroll
                    for (int ai = 0; ai < 2; ++ai)
#pragma unroll
                        for (int m = 0; m < 4; ++m) acc[ai][bj][m][n] *= ratio;
                }
        }
        g256::mainloop<512, 1024>(wt_out + 512, mix + 512, n0, m0, (unsigned short*)lds, acc);
        const int tid = tid_(); const int lane = tid & 63, wave = __builtin_amdgcn_readfirstlane(tid >> 6), wr = wave >> 2, wc = wave & 3, fr = lane & 15, fq = lane >> 4;
#pragma unroll
        for (int bj = 0; bj < 2; ++bj)
#pragma unroll
            for (int n = 0; n < 2; ++n) {
                const long tok = m0 + bj * 128 + wc * 32 + n * 16 + fr; const float r = rb[bj][n];
                float ss = 0.f;
#pragma unroll
                for (int ai = 0; ai < 2; ++ai)
#pragma unroll
                    for (int m = 0; m < 4; ++m) {
                        const int nrow = n0 + ai * 128 + wr * 64 + m * 16 + fq * 4;
                        const float4 xv = *(const float4*)(x + tok * 1024 + nrow);
                        float4 hv; hv.x = xv.x + acc[ai][bj][m][n][0] * r; hv.y = xv.y + acc[ai][bj][m][n][1] * r; hv.z = xv.z + acc[ai][bj][m][n][2] * r; hv.w = xv.w + acc[ai][bj][m][n][3] * r;
                        *(float4*)(out + tok * 1024 + nrow) = hv;
                        uint2 pk; pk.x = cvtpk(hv.x, hv.y); pk.y = cvtpk(hv.z, hv.w);
                        *(uint2*)(hb + tok * 1024 + nrow) = pk;
                        ss += hv.x * hv.x + hv.y * hv.y + hv.z * hv.z + hv.w * hv.w;
                    }
                { auto r1 = __builtin_amdgcn_permlane16_swap(__float_as_uint(ss), __float_as_uint(ss), false, false); ss = __uint_as_float(r1[0]) + __uint_as_float(r1[1]); }
                ss = pair_sum(ss);
                if (fq == 0) { hss[tok * 16 + (n0 >> 8) * 4 + wr] = ss; hss[tok * 16 + (n0 >> 8) * 4 + 2 + wr] = 0.f; }
            }
        __syncthreads();
    }
}
__device__ __forceinline__ void p6_peerq_256(unsigned char* lds, const unsigned short* __restrict__ hb, const unsigned short* __restrict__ wt_q, const float* __restrict__ hss,
                                             unsigned short* __restrict__ pqb, float* __restrict__ pss) {
    const int vcu = (blockIdx.x & 7) * (NBLK / 8) + (blockIdx.x >> 3);
    for (int tile = vcu; tile < 64 * 8; tile += NBLK) {
        const int m0 = (tile >> 3) * 256, n0 = (tile & 7) * 256;
        f32x4_t acc[2][2][4][2];
#pragma unroll
        for (int ai = 0; ai < 2; ++ai)
#pragma unroll
            for (int bj = 0; bj < 2; ++bj)
#pragma unroll
                for (int m = 0; m < 4; ++m)
#pragma unroll
                    for (int n = 0; n < 2; ++n) acc[ai][bj][m][n] = f32x4_t{0.f, 0.f, 0.f, 0.f};
        g256::mainloop<1024>(wt_q, hb, n0, m0, (unsigned short*)lds, acc);
        const int tid = tid_(); const int lane = tid & 63, wave = __builtin_amdgcn_readfirstlane(tid >> 6), wr = wave >> 2, wc = wave & 3, fr = lane & 15, fq = lane >> 4;
#pragma unroll
        for (int bj = 0; bj < 2; ++bj)
#pragma unroll
            for (int n = 0; n < 2; ++n) {
                const long tok = m0 + bj * 128 + wc * 32 + n * 16 + fr;
                const float4* hp = (const float4*)(hss + tok * 16);
                const float4 s0 = hp[0], s1 = hp[1], s2 = hp[2], s3 = hp[3];
                const float rs = rsqrtf((s0.x + s0.y + s0.z + s0.w + s1.x + s1.y + s1.z + s1.w + s2.x + s2.y + s2.z + s2.w + s3.x + s3.y + s3.z + s3.w) * (1.f / 1024.f) + EPS);
                float ss = 0.f;
#pragma unroll
                for (int ai = 0; ai < 2; ++ai)
#pragma unroll
                    for (int m = 0; m < 4; ++m) {
                        const int nrow = n0 + ai * 128 + wr * 64 + m * 16 + fq * 4;
                        const float v0 = acc[ai][bj][m][n][0] * rs, v1 = acc[ai][bj][m][n][1] * rs, v2 = acc[ai][bj][m][n][2] * rs, v3 = acc[ai][bj][m][n][3] * rs;
                        uint2 pk; pk.x = cvtpk(v0, v1); pk.y = cvtpk(v2, v3);
                        *(uint2*)(pqb + tok * 2048 + nrow) = pk;
                        ss += v0 * v0 + v1 * v1 + v2 * v2 + v3 * v3;
                    }
                { auto r1 = __builtin_amdgcn_permlane16_swap(__float_as_uint(ss), __float_as_uint(ss), false, false); ss = __uint_as_float(r1[0]) + __uint_as_float(r1[1]); }
                ss = pair_sum(ss);
                if (fq == 0) { pss[tok * 32 + (n0 >> 8) * 4 + wr] = ss; pss[tok * 32 + (n0 >> 8) * 4 + 2 + wr] = 0.f; }
            }
        __syncthreads();
    }
}

__device__ __forceinline__ unsigned ordkey(float f) { const unsigned u = __float_as_uint(f); return (u & 0x80000000u) ? ~u : (u | 0x80000000u); }
__device__ __forceinline__ float orddec(unsigned k) { return __uint_as_float((k & 0x80000000u) ? (k & 0x7fffffffu) : ~k); }
#define CE_DESC(a, b) do { const unsigned mx_ = max(a, b), mn_ = min(a, b); a = mx_; b = mn_; } while (0)
__device__ __forceinline__ void sort16_desc(unsigned (&v)[16]) {
#pragma unroll
    for (int k = 2; k <= 16; k <<= 1)
#pragma unroll
        for (int j = k >> 1; j > 0; j >>= 1)
#pragma unroll
            for (int i = 0; i < 16; ++i) {
                const int l = i ^ j;
                if (l > i) { if ((i & k) == 0) { CE_DESC(v[i], v[l]); } else { CE_DESC(v[l], v[i]); } }
            }
}
__device__ __forceinline__ void merge16_desc(unsigned (&a)[16], const unsigned (&b)[16]) {
#pragma unroll
    for (int i = 0; i < 16; ++i) a[i] = max(a[i], b[15 - i]);
#pragma unroll
    for (int j = 8; j > 0; j >>= 1)
#pragma unroll
        for (int i = 0; i < 16; ++i) { const int l = i ^ j; if (l > i) CE_DESC(a[i], a[l]); }
}
__device__ __forceinline__ void top16_of_lanepair(unsigned (&k0)[16], unsigned (&k1)[16], unsigned (&k2)[16], unsigned (&k3)[16]) {
    sort16_desc(k0); sort16_desc(k1); sort16_desc(k2); sort16_desc(k3);
    merge16_desc(k0, k1); merge16_desc(k2, k3); merge16_desc(k0, k2);
    unsigned o[16];
#pragma unroll
    for (int i = 0; i < 16; ++i) { auto rr = __builtin_amdgcn_permlane32_swap(k0[i], k0[i], false, false); k0[i] = rr[0]; o[i] = rr[1]; }
    merge16_desc(k0, o);
}
__device__ __forceinline__ void peer_route_mfma(unsigned char* lds, const unsigned short* __restrict__ pqb, const float* __restrict__ pss, const unsigned short* __restrict__ sk16, int* __restrict__ eo, float* __restrict__ go) {
    const int tid = tid_(); const int lane = tid & 63, w = __builtin_amdgcn_readfirstlane(tid >> 6), r32 = lane & 31, hi = lane >> 5;
    const int h = blockIdx.x & 7;
    constexpr int SKP = 272;
    for (int c16 = tid; c16 < 256 * 16; c16 += 512) { const int row = c16 >> 4, ch = c16 & 15; *(uint4*)(lds + row * SKP + ch * 16) = *(const uint4*)(sk16 + ((long)h * 256 + row) * 128 + ch * 8); }
    __syncthreads();
    for (int it = 0; it < 2; ++it) {
        const long tok = (long)((blockIdx.x >> 3) * 16 + w * 2 + it) * 32 + r32;
        const float4 ps = *(const float4*)(pss + tok * 32 + h * 4);
        const float rs = rsqrtf((ps.x + ps.y + ps.z + ps.w) * (1.f / 256.f) + EPS);
        unsigned T1[16], T2[16];
#pragma unroll
        for (int c = 0; c < 2; ++c) {
            f32x16 acc[4];
#pragma unroll
            for (int mt = 0; mt < 4; ++mt)
#pragma unroll
                for (int r = 0; r < 16; ++r) acc[mt][r] = 0.f;
            const unsigned short* qrow = pqb + tok * 2048 + h * 256 + c * 128 + hi * 8;
            const unsigned char* krow = lds + (c * 128 + r32) * SKP + hi * 16;
#pragma unroll 2
            for (int ks = 0; ks < 8; ++ks) {
                const bf16x8 qf = *(const bf16x8*)(qrow + ks * 16);
#pragma unroll
                for (int mt = 0; mt < 4; ++mt) { const bf16x8 kf = *(const bf16x8*)(krow + mt * 32 * SKP + ks * 32); acc[mt] = MFMA32(kf, qf, acc[mt]); }
            }
            unsigned k0[16], k1[16], k2[16], k3[16];
#pragma unroll
            for (int r = 0; r < 16; ++r) {
                const unsigned idx = 127u - (unsigned)crow(r, hi);
                k0[r] = (ordkey(acc[0][r] * rs) & ~127u) | idx; k1[r] = (ordkey(acc[1][r] * rs) & ~127u) | (idx - 32u);
                k2[r] = (ordkey(acc[2][r] * rs) & ~127u) | (idx - 64u); k3[r] = (ordkey(acc[3][r] * rs) & ~127u) | (idx - 96u);
            }
            top16_of_lanepair(k0, k1, k2, k3);
            if (c == 0) {
#pragma unroll
                for (int i = 0; i < 16; ++i) T1[i] = k0[i];
            } else {
#pragma unroll
                for (int i = 0; i < 16; ++i) T2[i] = k0[i];
            }
        }
        float v1[16], v2[16]; unsigned p1[4] = {0u, 0u, 0u, 0u}, p2[4] = {0u, 0u, 0u, 0u};
#pragma unroll
        for (int i = 0; i < 16; ++i) {
            v1[i] = orddec(T1[i] & ~127u); v2[i] = orddec(T2[i] & ~127u);
            p1[i >> 2] |= (127u - (T1[i] & 127u)) << (8 * (i & 3)); p2[i >> 2] |= (127u - (T2[i] & 127u)) << (8 * (i & 3));
        }
        unsigned c0[16], c1[16], c2[16], c3[16];
#define CAND(a, b) ((ordkey(v1[a] + v2[b]) & ~255u) | (255u - (unsigned)((a) * 16 + (b))))
        c0[0] = CAND(0, 0); c0[1] = CAND(0, 1); c0[2] = CAND(0, 2); c0[3] = CAND(0, 3); c0[4] = CAND(0, 4); c0[5] = CAND(0, 5); c0[6] = CAND(0, 6); c0[7] = CAND(0, 7);
        c0[8] = CAND(0, 8); c0[9] = CAND(0, 9); c0[10] = CAND(0, 10); c0[11] = CAND(0, 11); c0[12] = CAND(0, 12); c0[13] = CAND(0, 13); c0[14] = CAND(0, 14); c0[15] = CAND(0, 15);
        c1[0] = CAND(1, 0); c1[1] = CAND(1, 1); c1[2] = CAND(1, 2); c1[3] = CAND(1, 3); c1[4] = CAND(1, 4); c1[5] = CAND(1, 5); c1[6] = CAND(1, 6); c1[7] = CAND(1, 7);
        c1[8] = CAND(2, 0); c1[9] = CAND(2, 1); c1[10] = CAND(2, 2); c1[11] = CAND(2, 3); c1[12] = CAND(2, 4); c1[13] = CAND(3, 0); c1[14] = CAND(3, 1); c1[15] = CAND(3, 2);
        c2[0] = CAND(3, 3); c2[1] = CAND(4, 0); c2[2] = CAND(4, 1); c2[3] = CAND(4, 2); c2[4] = CAND(5, 0); c2[5] = CAND(5, 1); c2[6] = CAND(6, 0); c2[7] = CAND(6, 1);
        c2[8] = CAND(7, 0); c2[9] = CAND(7, 1); c2[10] = CAND(8, 0); c2[11] = CAND(9, 0); c2[12] = CAND(10, 0); c2[13] = CAND(11, 0); c2[14] = CAND(12, 0); c2[15] = CAND(13, 0);
        c3[0] = CAND(14, 0); c3[1] = CAND(15, 0);
#pragma unroll
        for (int i = 2; i < 16; ++i) c3[i] = 0u;
#undef CAND
        sort16_desc(c0); sort16_desc(c1); sort16_desc(c2); sort16_desc(c3);
        merge16_desc(c0, c1); merge16_desc(c2, c3); merge16_desc(c0, c2);
        float ev[16]; int ee[16]; float l = 0.f; const float mx = orddec(c0[0] & ~255u);
#pragma unroll
        for (int i = 0; i < 16; ++i) {
            const unsigned ci = 255u - (c0[i] & 255u); const unsigned a = ci >> 4, b = ci & 15u;
            const unsigned wa = (a >> 2) == 0 ? p1[0] : ((a >> 2) == 1 ? p1[1] : ((a >> 2) == 2 ? p1[2] : p1[3]));
            const unsigned wb = (b >> 2) == 0 ? p2[0] : ((b >> 2) == 1 ? p2[1] : ((b >> 2) == 2 ? p2[2] : p2[3]));
            const unsigned i1 = (wa >> (8 * (a & 3u))) & 255u, i2 = (wb >> (8 * (b & 3u))) & 255u;
            ee[i] = (int)(i1 * 128u + i2);
            ev[i] = __expf(orddec(c0[i] & ~255u) - mx); l += ev[i];
        }
        const float inv = 1.f / l;
        if (hi == 0) {
            int4* ep = (int4*)(eo + tok * 128 + h * 16);
            ep[0] = make_int4(ee[0], ee[1], ee[2], ee[3]); ep[1] = make_int4(ee[4], ee[5], ee[6], ee[7]); ep[2] = make_int4(ee[8], ee[9], ee[10], ee[11]); ep[3] = make_int4(ee[12], ee[13], ee[14], ee[15]);
        } else {
            float4* gp = (float4*)(go + tok * 128 + h * 16);
            gp[0] = make_float4(ev[0] * inv, ev[1] * inv, ev[2] * inv, ev[3] * inv); gp[1] = make_float4(ev[4] * inv, ev[5] * inv, ev[6] * inv, ev[7] * inv);
            gp[2] = make_float4(ev[8] * inv, ev[9] * inv, ev[10] * inv, ev[11] * inv); gp[3] = make_float4(ev[12] * inv, ev[13] * inv, ev[14] * inv, ev[15] * inv);
        }
    }
}

template <int DQK>
struct FA {
    static constexpr int NDS = DQK / 16, KP = DQK * 2 + 16, KBYTES = 64 * KP, VP = 144, VBYTES = 64 * VP, STAGE = KBYTES + VBYTES;
    static constexpr int KCH = 64 * DQK / 8, NCH = KCH + 512, SLOTS = (NCH + 511) / 512;
};
constexpr float FA_THR = 8.f;
constexpr float FA_NEG = -1e30f;
struct FaRegs { uint4 g0, g1, g2; };
template <int DQK>
__device__ __forceinline__ uint4 fa_load1(const unsigned short* __restrict__ Kg, int kpitch, const unsigned short* __restrict__ Vg, int vpitch, int tid, int i) {
    int c = tid + i * 512; if (c >= FA<DQK>::NCH) c = 0;
    const int key = c / (DQK / 8), kc = c % (DQK / 8); const int c2 = c - FA<DQK>::KCH; const int d = c2 >> 3, vc = c2 & 7;
    const unsigned koff = (unsigned)(key * kpitch + kc * 8) * 2u, voff = (unsigned)(d * vpitch + vc * 8) * 2u;
#if defined(__HIP_DEVICE_COMPILE__)
    typedef unsigned u32x4_t __attribute__((ext_vector_type(4)));
    const u32x4_t v = (c < FA<DQK>::KCH) ? *(const AS1 u32x4_t*)((const AS1 char*)Kg + koff) : *(const AS1 u32x4_t*)((const AS1 char*)Vg + voff);
    return make_uint4(v.x, v.y, v.z, v.w);
#else
    (void)koff; (void)voff; return make_uint4(0u, 0u, 0u, 0u);
#endif
}
template <int DQK>
__device__ __forceinline__ void fa_store1(unsigned char* st, const uint4& g, int tid, int i) {
    const int c = tid + i * 512;
    const int key = c / (DQK / 8), kc = c % (DQK / 8); const int c2 = c - FA<DQK>::KCH; const int d = c2 >> 3, vc = c2 & 7;
    const int off = (c < FA<DQK>::KCH) ? (key * FA<DQK>::KP + kc * 16) : (FA<DQK>::KBYTES + d * FA<DQK>::VP + vc * 16);
    if (c < FA<DQK>::NCH) *(uint4*)(st + off) = g;
}
template <int DQK>
__device__ __forceinline__ void fa_load(const unsigned short* __restrict__ Kg, int kpitch, const unsigned short* __restrict__ Vg, int vpitch, FaRegs& g, int tid) {
    g.g0 = fa_load1<DQK>(Kg, kpitch, Vg, vpitch, tid, 0); g.g1 = fa_load1<DQK>(Kg, kpitch, Vg, vpitch, tid, 1);
    if (FA<DQK>::SLOTS > 2) g.g2 = fa_load1<DQK>(Kg, kpitch, Vg, vpitch, tid, 2);
}
template <int DQK>
__device__ __forceinline__ void fa_store(unsigned char* st, const FaRegs& g, int tid) {
    fa_store1<DQK>(st, g.g0, tid, 0); fa_store1<DQK>(st, g.g1, tid, 1);
    if (FA<DQK>::SLOTS > 2) fa_store1<DQK>(st, g.g2, tid, 2);
}
template <int DQK, int MODE, bool STATS_ONLY = false>
__device__ __forceinline__ void fa_tile(const unsigned char* st, const bf16x8 (&qf)[FA<DQK>::NDS], f32x16 (&o)[2], float& mref, float& l, int key0, int qpos, int lane, bool need_mask, bool colsel = true) {
    asm volatile("" : "+v"(lane));
    const int r32 = lane & 31, hi = lane >> 5;
    f32x16 s0, s1;
#pragma unroll
    for (int r = 0; r < 16; ++r) { s0[r] = 0.f; s1[r] = 0.f; }
    {
        bf16x8 k0 = *(const bf16x8*)(st + r32 * FA<DQK>::KP + hi * 16);
        bf16x8 k1 = *(const bf16x8*)(st + (32 + r32) * FA<DQK>::KP + hi * 16);
#pragma unroll
        for (int ds = 0; ds < FA<DQK>::NDS; ++ds) {
            bf16x8 n0 = k0, n1 = k1;
            if (ds + 1 < FA<DQK>::NDS) {
                n0 = *(const bf16x8*)(st + r32 * FA<DQK>::KP + (ds + 1) * 32 + hi * 16);
                n1 = *(const bf16x8*)(st + (32 + r32) * FA<DQK>::KP + (ds + 1) * 32 + hi * 16);
            }
            s0 = MFMA32(k0, qf[ds], s0); s1 = MFMA32(k1, qf[ds], s1);
            k0 = n0; k1 = n1;
            __builtin_amdgcn_sched_barrier(0);
        }
    }
    __builtin_amdgcn_sched_barrier(0);
    if (MODE != 0 && need_mask) {
#pragma unroll
        for (int r = 0; r < 16; ++r) {
            const int ka = key0 + crow(r, hi), kb = ka + 32;
            bool ma, mb;
            if (MODE == 4) { ma = 16 * ka + 31 > qpos; mb = 16 * kb + 31 > qpos; }
            else { ma = ka > qpos; mb = kb > qpos; }
            if (MODE == 2) { ma = ma || (ka <= qpos - 512); mb = mb || (kb <= qpos - 512); }
            if (ma) s0[r] = -INFINITY;
            if (mb) s1[r] = -INFINITY;
        }
    }
    if (MODE == 3) {
        if (!colsel) {
#pragma unroll
            for (int r = 0; r < 16; ++r) { s0[r] = -INFINITY; s1[r] = -INFINITY; }
        }
    }
    float mx = fmaxf(s0[0], s1[0]);
#pragma unroll
    for (int r = 1; r < 16; ++r) mx = fmaxf(mx, fmaxf(s0[r], s1[r]));
    mx = pair_max(mx);
    if (__any(mx > mref + FA_THR)) {
        const float mnew = (mx > mref + FA_THR) ? mx : mref;
        const float alpha = __builtin_amdgcn_exp2f(mref - mnew);
        mref = mnew; l *= alpha;
#pragma unroll
        for (int r = 0; r < 16; ++r) { o[0][r] *= alpha; o[1][r] *= alpha; }
    }
    float ps = 0.f;
#pragma unroll
    for (int r = 0; r < 16; ++r) { s0[r] = __builtin_amdgcn_exp2f(s0[r] - mref); s1[r] = __builtin_amdgcn_exp2f(s1[r] - mref); ps += s0[r] + s1[r]; }
    l += ps;
    if (STATS_ONLY) return;
    bf16x8 pk[4];
#pragma unroll
    for (int s = 0; s < 2; ++s) {
        uint4 a, b;
        a.x = cvtpk(s0[8 * s], s0[8 * s + 1]); a.y = cvtpk(s0[8 * s + 2], s0[8 * s + 3]); a.z = cvtpk(s0[8 * s + 4], s0[8 * s + 5]); a.w = cvtpk(s0[8 * s + 6], s0[8 * s + 7]);
        b.x = cvtpk(s1[8 * s], s1[8 * s + 1]); b.y = cvtpk(s1[8 * s + 2], s1[8 * s + 3]); b.z = cvtpk(s1[8 * s + 4], s1[8 * s + 5]); b.w = cvtpk(s1[8 * s + 6], s1[8 * s + 7]);
        pk[s] = __builtin_bit_cast(bf16x8, a); pk[2 + s] = __builtin_bit_cast(bf16x8, b);
    }
    const unsigned char* vt = st + FA<DQK>::KBYTES;
    __builtin_amdgcn_sched_barrier(0);
    {
        bf16x8 v0 = *(const bf16x8*)(vt + r32 * FA<DQK>::VP + hi * 16);
        bf16x8 v1 = *(const bf16x8*)(vt + (32 + r32) * FA<DQK>::VP + hi * 16);
#pragma unroll
        for (int ks = 0; ks < 4; ++ks) {
            bf16x8 n0 = v0, n1 = v1;
            if (ks + 1 < 4) {
                n0 = *(const bf16x8*)(vt + r32 * FA<DQK>::VP + (ks + 1) * 32 + hi * 16);
                n1 = *(const bf16x8*)(vt + (32 + r32) * FA<DQK>::VP + (ks + 1) * 32 + hi * 16);
            }
            o[0] = MFMA32(v0, pk[ks], o[0]); o[1] = MFMA32(v1, pk[ks], o[1]);
            v0 = n0; v1 = n1;
            __builtin_amdgcn_sched_barrier(0);
        }
    }
}
template <int DQK>
__device__ __forceinline__ void fa_qk(const unsigned char* st, const bf16x8 (&qf)[FA<DQK>::NDS], f32x16& s0, f32x16& s1, int lane) {
    const int r32 = lane & 31, hi = lane >> 5;
#pragma unroll
    for (int r = 0; r < 16; ++r) { s0[r] = 0.f; s1[r] = 0.f; }
#pragma unroll
    for (int ds = 0; ds < FA<DQK>::NDS; ++ds) {
        const bf16x8 k0 = *(const bf16x8*)(st + r32 * FA<DQK>::KP + ds * 32 + hi * 16);
        const bf16x8 k1 = *(const bf16x8*)(st + (32 + r32) * FA<DQK>::KP + ds * 32 + hi * 16);
        s0 = MFMA32(k0, qf[ds], s0); s1 = MFMA32(k1, qf[ds], s1);
    }
}
template <int DQK, int MODE>
__device__ __forceinline__ void fa_step(const unsigned char* stc, const unsigned char* stn, const bf16x8 (&qf)[FA<DQK>::NDS], f32x16& s0, f32x16& s1, f32x16& n0, f32x16& n1,
                                        f32x16 (&o)[2], float& mref, float& l, int key0, int qpos, int lane, bool need_mask, bool colsel = true) {
    const int r32 = lane & 31, hi = lane >> 5;
    if (MODE != 0 && need_mask) {
#pragma unroll
        for (int r = 0; r < 16; ++r) {
            const int ka = key0 + crow(r, hi), kb = ka + 32;
            bool ma, mb;
            if (MODE == 4) { ma = 16 * ka + 31 > qpos; mb = 16 * kb + 31 > qpos; }
            else { ma = ka > qpos; mb = kb > qpos; }
            if (MODE == 2) { ma = ma || (ka <= qpos - 512); mb = mb || (kb <= qpos - 512); }
            if (ma) s0[r] = -INFINITY;
            if (mb) s1[r] = -INFINITY;
        }
    }
    if (MODE == 3) {
        if (!colsel) {
#pragma unroll
            for (int r = 0; r < 16; ++r) { s0[r] = -INFINITY; s1[r] = -INFINITY; }
        }
    }
    float mx = fmaxf(s0[0], s1[0]);
#pragma unroll
    for (int r = 1; r < 16; ++r) mx = fmaxf(mx, fmaxf(s0[r], s1[r]));
    mx = pair_max(mx);
    if (__any(mx > mref + FA_THR)) {
        const float mnew = (mx > mref + FA_THR) ? mx : mref;
        const float alpha = __builtin_amdgcn_exp2f(mref - mnew);
        mref = mnew; l *= alpha;
#pragma unroll
        for (int r = 0; r < 16; ++r) { o[0][r] *= alpha; o[1][r] *= alpha; }
    }
    __builtin_amdgcn_sched_barrier(0);
#pragma unroll
    for (int r = 0; r < 16; ++r) { n0[r] = 0.f; n1[r] = 0.f; }
    float ps = 0.f;
    constexpr int PER = (32 + FA<DQK>::NDS - 1) / FA<DQK>::NDS;
    {
        bf16x8 k0 = *(const bf16x8*)(stn + r32 * FA<DQK>::KP + hi * 16);
        bf16x8 k1 = *(const bf16x8*)(stn + (32 + r32) * FA<DQK>::KP + hi * 16);
#pragma unroll
        for (int ds = 0; ds < FA<DQK>::NDS; ++ds) {
            bf16x8 f0 = k0, f1 = k1;
            if (ds + 1 < FA<DQK>::NDS) {
                f0 = *(const bf16x8*)(stn + r32 * FA<DQK>::KP + (ds + 1) * 32 + hi * 16);
                f1 = *(const bf16x8*)(stn + (32 + r32) * FA<DQK>::KP + (ds + 1) * 32 + hi * 16);
            }
            n0 = MFMA32(k0, qf[ds], n0); n1 = MFMA32(k1, qf[ds], n1);
#pragma unroll
            for (int j = ds * PER; j < (ds + 1) * PER && j < 32; ++j) {
                if (j < 16) { s0[j] = __builtin_amdgcn_exp2f(s0[j] - mref); ps += s0[j]; }
                else { s1[j - 16] = __builtin_amdgcn_exp2f(s1[j - 16] - mref); ps += s1[j - 16]; }
            }
            asm volatile("" : "+v"(ps));
            k0 = f0; k1 = f1;
            __builtin_amdgcn_sched_barrier(0);
        }
    }
    l += ps;
    bf16x8 pk[4];
#pragma unroll
    for (int s = 0; s < 2; ++s) {
        uint4 a, b;
        a.x = cvtpk(s0[8 * s], s0[8 * s + 1]); a.y = cvtpk(s0[8 * s + 2], s0[8 * s + 3]); a.z = cvtpk(s0[8 * s + 4], s0[8 * s + 5]); a.w = cvtpk(s0[8 * s + 6], s0[8 * s + 7]);
        b.x = cvtpk(s1[8 * s], s1[8 * s + 1]); b.y = cvtpk(s1[8 * s + 2], s1[8 * s + 3]); b.z = cvtpk(s1[8 * s + 4], s1[8 * s + 5]); b.w = cvtpk(s1[8 * s + 6], s1[8 * s + 7]);
        pk[s] = __builtin_bit_cast(bf16x8, a); pk[2 + s] = __builtin_bit_cast(bf16x8, b);
    }
    const unsigned char* vt = stc + FA<DQK>::KBYTES;
    {
        bf16x8 v0 = *(const bf16x8*)(vt + r32 * FA<DQK>::VP + hi * 16);
        bf16x8 v1 = *(const bf16x8*)(vt + (32 + r32) * FA<DQK>::VP + hi * 16);
#pragma unroll
        for (int ks = 0; ks < 4; ++ks) {
            bf16x8 f0 = v0, f1 = v1;
            if (ks + 1 < 4) {
                f0 = *(const bf16x8*)(vt + r32 * FA<DQK>::VP + (ks + 1) * 32 + hi * 16);
                f1 = *(const bf16x8*)(vt + (32 + r32) * FA<DQK>::VP + (ks + 1) * 32 + hi * 16);
            }
            o[0] = MFMA32(v0, pk[ks], o[0]); o[1] = MFMA32(v1, pk[ks], o[1]);
            v0 = f0; v1 = f1;
            __builtin_amdgcn_sched_barrier(0);
        }
    }
}
__device__ __forceinline__ int vperm(int s) { const int g = (s >> 2) & 3; const int pg = (g == 1) ? 2 : ((g == 2) ? 1 : g); return (s & ~15) | (pg << 2) | (s & 3); }

constexpr float MLA_QSCALE = 0.10206207261596575f * 1.4426950408889634f;
__device__ __forceinline__ void mla_unit(unsigned char* lds, int b, int h, int qb, const unsigned short* __restrict__ Q16, const unsigned short* __restrict__ K16, const unsigned short* __restrict__ VT16,
                                         unsigned short* __restrict__ ob16, float* __restrict__ ssqb, int tid) {
    typedef FA<96> F;
    const int lane = tid & 63, wave = __builtin_amdgcn_readfirstlane(tid >> 6), r32 = lane & 31, hi = lane >> 5;
    const int q0 = qb * 256, qpos = q0 + wave * 32 + r32; const long tok = (long)b * S_ + qpos;
    bf16x8 qf[F::NDS];
#pragma unroll
    for (int ds = 0; ds < F::NDS; ++ds) qf[ds] = *(const bf16x8*)(Q16 + tok * 768 + h * 96 + ds * 16 + hi * 8);
    f32x16 o[2];
#pragma unroll
    for (int r = 0; r < 16; ++r) { o[0][r] = 0.f; o[1][r] = 0.f; }
    float mref = FA_NEG, l = 0.f;
    const unsigned short* Kb = K16 + ((long)(b * 8 + h)) * S_ * 96;
    const unsigned short* Vb = VT16 + ((long)(b * 8 + h)) * 64 * S_;
    const int nt = (q0 + 256) / 64;
    FaRegs g;
    fa_load<96>(Kb, 96, Vb, S_, g, tid); fa_store<96>(lds, g, tid);
    fa_load<96>(Kb + (long)64 * 96, 96, Vb + 64, S_, g, tid); fa_store<96>(lds + F::STAGE, g, tid);
    __syncthreads();
    const int wmin = q0 + wave * 32, wmax = wmin + 31;
    f32x16 sa0, sa1, sb0, sb1;
    fa_qk<96>(lds, qf, sa0, sa1, lane);
#define MLA_STEP(C0, C1, N0, N1, t) do { \
        const int sc_ = (t) % 3, sn_ = ((t) + 1) % 3, sw_ = ((t) + 2) % 3; \
        if ((t) + 2 < nt) fa_load<96>(Kb + (long)((t) + 2) * 64 * 96, 96, Vb + ((t) + 2) * 64, S_, g, tid); \
        const int key0 = (t) * 64; \
        if (key0 <= wmax) fa_step<96, 1>(lds + sc_ * F::STAGE, lds + sn_ * F::STAGE, qf, C0, C1, N0, N1, o, mref, l, key0, qpos, lane, key0 + 63 > wmin); \
        if ((t) + 2 < nt) fa_store<96>(lds + sw_ * F::STAGE, g, tid); \
        __syncthreads(); } while (0)
    for (int t = 0; t < nt; t += 2) {
        MLA_STEP(sa0, sa1, sb0, sb1, t);
        MLA_STEP(sb0, sb1, sa0, sa1, t + 1);
    }
#undef MLA_STEP
    l = pair_sum(l);
    const float inv = 1.f / l;
    float ss = 0.f;
#pragma unroll
    for (int dt = 0; dt < 2; ++dt)
#pragma unroll
        for (int gq = 0; gq < 4; ++gq) {
            const float v0 = o[dt][4 * gq] * inv, v1 = o[dt][4 * gq + 1] * inv, v2 = o[dt][4 * gq + 2] * inv, v3 = o[dt][4 * gq + 3] * inv;
            uint2 pk; pk.x = cvtpk(v0, v1); pk.y = cvtpk(v2, v3);
            *(uint2*)(ob16 + tok * 1024 + 512 + h * 64 + dt * 32 + 8 * gq + 4 * hi) = pk;
            ss += v0 * v0 + v1 * v1 + v2 * v2 + v3 * v3;
        }
    ss = pair_sum(ss);
    if (hi == 0) ssqb[(long)h * T_ + tok] = ss;
}
__device__ __forceinline__ void mla_phase(unsigned char* lds, const unsigned short* __restrict__ Q16, const unsigned short* __restrict__ K16, const unsigned short* __restrict__ VT16,
                                          unsigned short* __restrict__ ob16, float* __restrict__ ssqb) {
    const int tid = tid_();
    for (int i = blockIdx.x; i < 256; i += NBLK) {
        const int xcd = i & 7, slot = i >> 3;
        { const int bh = xcd * 2; mla_unit(lds, bh >> 3, bh & 7, 31 - slot, Q16, K16, VT16, ob16, ssqb, tid); }
        { const int bh = xcd * 2 + 1; mla_unit(lds, bh >> 3, bh & 7, slot, Q16, K16, VT16, ob16, ssqb, tid); }
    }
}
constexpr float NSA_QSCALE = 0.125f * 1.4426950408889634f;
constexpr int IMP_PITCH = 129;
__device__ __forceinline__ void fa_tile_cmp2(const unsigned char* st, const bf16x8 (&qf)[4], f32x16 (&o)[2], float mref, float linv, int key0, int qpos, int lane, float* imp_row) {
    typedef FA<64> F;
    asm volatile("" : "+v"(lane));
    const int r32 = lane & 31, hi = lane >> 5;
    f32x16 s0, s1;
#pragma unroll
    for (int r = 0; r < 16; ++r) { s0[r] = 0.f; s1[r] = 0.f; }
#pragma unroll
    for (int ds = 0; ds < 4; ++ds) {
        const bf16x8 k0 = *(const bf16x8*)(st + r32 * F::KP + ds * 32 + hi * 16);
        const bf16x8 k1 = *(const bf16x8*)(st + (32 + r32) * F::KP + ds * 32 + hi * 16);
        s0 = MFMA32(k0, qf[ds], s0); s1 = MFMA32(k1, qf[ds], s1);
    }
#pragma unroll
    for (int r = 0; r < 16; ++r) {
        const int ka = key0 + crow(r, hi), kb = ka + 32;
        s0[r] = (16 * ka + 31 > qpos) ? 0.f : __builtin_amdgcn_exp2f(s0[r] - mref) * linv;
        s1[r] = (16 * kb + 31 > qpos) ? 0.f : __builtin_amdgcn_exp2f(s1[r] - mref) * linv;
    }
    bf16x8 pk[4];
#pragma unroll
    for (int s = 0; s < 2; ++s) {
        uint4 a, b;
        a.x = cvtpk(s0[8 * s], s0[8 * s + 1]); a.y = cvtpk(s0[8 * s + 2], s0[8 * s + 3]); a.z = cvtpk(s0[8 * s + 4], s0[8 * s + 5]); a.w = cvtpk(s0[8 * s + 6], s0[8 * s + 7]);
        b.x = cvtpk(s1[8 * s], s1[8 * s + 1]); b.y = cvtpk(s1[8 * s + 2], s1[8 * s + 3]); b.z = cvtpk(s1[8 * s + 4], s1[8 * s + 5]); b.w = cvtpk(s1[8 * s + 6], s1[8 * s + 7]);
        pk[s] = __builtin_bit_cast(bf16x8, a); pk[2 + s] = __builtin_bit_cast(bf16x8, b);
    }
    const unsigned char* vt = st + F::KBYTES;
#pragma unroll
    for (int ks = 0; ks < 4; ++ks) {
        const bf16x8 v0 = *(const bf16x8*)(vt + r32 * F::VP + ks * 32 + hi * 16);
        const bf16x8 v1 = *(const bf16x8*)(vt + (32 + r32) * F::VP + ks * 32 + hi * 16);
        o[0] = MFMA32(v0, pk[ks], o[0]); o[1] = MFMA32(v1, pk[ks], o[1]);
    }
#pragma unroll
    for (int r = 0; r < 16; ++r) {
        s0[r] = quad_sum(s0[r]); s1[r] = quad_sum(s1[r]);
    }
    if ((lane & 3) == 0) {
#pragma unroll
        for (int g4 = 0; g4 < 4; ++g4) {
            { const int j = (key0 + 8 * g4 + 4 * hi) >> 2;
              atomicAdd(imp_row + j, s0[4 * g4] + s0[4 * g4 + 1] + s0[4 * g4 + 2] + s0[4 * g4 + 3]);
              if (j + 1 < 128) atomicAdd(imp_row + j + 1, s0[4 * g4 + 3]); }
            { const int j = (key0 + 32 + 8 * g4 + 4 * hi) >> 2;
              atomicAdd(imp_row + j, s1[4 * g4] + s1[4 * g4 + 1] + s1[4 * g4 + 2] + s1[4 * g4 + 3]);
              if (j + 1 < 128) atomicAdd(imp_row + j + 1, s1[4 * g4 + 3]); }
        }
    }
}
#define NSA_STEP_(GCUR, GNEXT, Kbase, kpitch, Vbase, vpitch, t_lo, t_hi, t_, ...) do { \
        const unsigned char* st = stg + (((t_) - (t_lo)) & 1) * FA<64>::STAGE; \
        if ((t_) + 2 <= (t_hi)) fa_load<64>((Kbase) + (long)((t_) + 2) * 64 * (kpitch), (kpitch), (Vbase) + ((t_) + 2) * 64, (vpitch), GCUR, tid); \
        const int key0 = (t_) * 64; (void)key0; \
        __VA_ARGS__ \
        if ((t_) + 1 <= (t_hi)) fa_store<64>(stg + (((t_) + 1 - (t_lo)) & 1) * FA<64>::STAGE, GNEXT, tid); \
        __syncthreads(); } while (0)
#define NSA_STREAM(Kbase, kpitch, Vbase, vpitch, t_lo, t_hi, ...) do { \
    FaRegs ga_, gb_; fa_load<64>((Kbase) + (long)(t_lo) * 64 * (kpitch), (kpitch), (Vbase) + (t_lo) * 64, (vpitch), ga_, tid); \
    if ((t_lo) + 1 <= (t_hi)) fa_load<64>((Kbase) + (long)((t_lo) + 1) * 64 * (kpitch), (kpitch), (Vbase) + ((t_lo) + 1) * 64, (vpitch), gb_, tid); \
    fa_store<64>(stg, ga_, tid); __syncthreads(); \
    for (int t_ = (t_lo); t_ <= (t_hi); t_ += 2) { \
        NSA_STEP_(ga_, gb_, Kbase, kpitch, Vbase, vpitch, t_lo, t_hi, t_, __VA_ARGS__); \
        if (t_ + 1 <= (t_hi)) { const int tt_ = t_ + 1; NSA_STEP2_(gb_, ga_, Kbase, kpitch, Vbase, vpitch, t_lo, t_hi, tt_, __VA_ARGS__); } \
    } } while (0)
#define NSA_STEP2_(GCUR, GNEXT, Kbase, kpitch, Vbase, vpitch, t_lo, t_hi, tq_, ...) do { \
        const int t_ = tq_; \
        const unsigned char* st = stg + ((t_ - (t_lo)) & 1) * FA<64>::STAGE; \
        if (t_ + 2 <= (t_hi)) fa_load<64>((Kbase) + (long)(t_ + 2) * 64 * (kpitch), (kpitch), (Vbase) + (t_ + 2) * 64, (vpitch), GCUR, tid); \
        const int key0 = t_ * 64; (void)key0; \
        __VA_ARGS__ \
        if (t_ + 1 <= (t_hi)) fa_store<64>(stg + ((t_ + 1 - (t_lo)) & 1) * FA<64>::STAGE, GNEXT, tid); \
        __syncthreads(); } while (0)

__device__ __forceinline__ void nsa_unit(unsigned char* lds, int b, int g, int qblk, const unsigned short* __restrict__ Q16A, const unsigned short* __restrict__ KC16, const unsigned short* __restrict__ VCT16,
                                         const unsigned short* __restrict__ KS16, const unsigned short* __restrict__ VST16, const unsigned short* __restrict__ KW16, const unsigned short* __restrict__ VWT16,
                                         const float* __restrict__ gates, unsigned short* __restrict__ oa16, float* __restrict__ ssqa, int tid) {
    typedef FA<64> F;
    const int lane = tid & 63, wave = __builtin_amdgcn_readfirstlane(tid >> 6), r32 = lane & 31, hi = lane >> 5;
    unsigned char* stg = lds;
    float* imp = (float*)(lds + 2 * F::STAGE);
    unsigned* selm = (unsigned*)(lds + 2 * F::STAGE + 64 * IMP_PITCH * 4);
    const int q0 = qblk * 64, cur = qblk;
    const int ql = wave * 8 + (r32 >> 2), hh = g * 4 + (r32 & 3), qpos = q0 + ql; const long tok = (long)b * S_ + qpos; const int bg = b * 2 + g;
    bf16x8 qf[4];
#pragma unroll
    for (int ds = 0; ds < 4; ++ds) qf[ds] = *(const bf16x8*)(Q16A + tok * 512 + hh * 64 + ds * 16 + hi * 8);
    for (int i = tid; i < 64 * IMP_PITCH; i += 512) imp[i] = 0.f;
    f32x16 acc[2], o[2];
#pragma unroll
    for (int r = 0; r < 16; ++r) { acc[0][r] = 0.f; acc[1][r] = 0.f; }
    const int wq_lo = q0 + wave * 8, wq_hi = wq_lo + 7;
    const int nvis_max = (q0 + 63 >= 31) ? ((q0 + 63 - 31) / 16 + 1) : 0;
    if (nvis_max > 0) {
        const int tc_hi = (nvis_max - 1) >> 6;
        const unsigned short* Kc = KC16 + (long)bg * 512 * 64; const unsigned short* Vc = VCT16 + (long)bg * 64 * 512;
        float mref = FA_NEG, l = 0.f;
        NSA_STREAM(Kc, 64, Vc, 512, 0, tc_hi, {
            if (16 * key0 + 31 <= wq_hi) fa_tile<64, 4, true>(st, qf, o, mref, l, key0, qpos, lane, 16 * (key0 + 63) + 31 > wq_lo);
        });
        l = pair_sum(l);
        const float linv = (l > 0.f) ? 1.f / l : 0.f;
#pragma unroll
        for (int r = 0; r < 16; ++r) { o[0][r] = 0.f; o[1][r] = 0.f; }
        NSA_STREAM(Kc, 64, Vc, 512, 0, tc_hi, {
            if (16 * key0 + 31 <= wq_hi) fa_tile_cmp2(st, qf, o, mref, linv, key0, qpos, lane, imp + ql * IMP_PITCH);
        });
        const float g_c = gates[tok * 24 + hh * 3];
#pragma unroll
        for (int r = 0; r < 16; ++r) { acc[0][r] += g_c * o[0][r]; acc[1][r] += g_c * o[1][r]; }
    } else { __syncthreads(); }
    if (wave < 2) {
        const int qi = wave * 32 + r32;
        int his = hi; asm volatile("" : "+v"(his));
#define IMPKEY(jj) ({ const int j_ = (jj); const float v_ = (j_ == 0 || j_ == cur) ? 1e9f : ((j_ > cur) ? -1e30f : imp[qi * IMP_PITCH + j_]); (ordkey(v_) & ~127u) | (127u - (unsigned)j_); })
        unsigned k0[16];
        {
            unsigned k1[16];
#pragma unroll
            for (int i = 0; i < 16; ++i) { k0[i] = IMPKEY(his * 64 + i); k1[i] = IMPKEY(his * 64 + 16 + i); }
            sort16_desc(k0); sort16_desc(k1); merge16_desc(k0, k1);
        }
        __builtin_amdgcn_sched_barrier(0);
        {
            unsigned k2[16], k3[16];
#pragma unroll
            for (int i = 0; i < 16; ++i) { k2[i] = IMPKEY(his * 64 + 32 + i); k3[i] = IMPKEY(his * 64 + 48 + i); }
            sort16_desc(k2); sort16_desc(k3); merge16_desc(k2, k3); merge16_desc(k0, k2);
        }
#undef IMPKEY
        {
            unsigned o2[16];
#pragma unroll
            for (int i = 0; i < 16; ++i) { auto rr = __builtin_amdgcn_permlane32_swap(k0[i], k0[i], false, false); k0[i] = rr[0]; o2[i] = rr[1]; }
            merge16_desc(k0, o2);
        }
        unsigned m0 = 0u, m1 = 0u, m2 = 0u, m3 = 0u;
#pragma unroll
        for (int i = 0; i < 16; ++i) {
            const unsigned j = 127u - (k0[i] & 127u); const unsigned bit = 1u << (j & 31u); const unsigned wsel = j >> 5;
            m0 |= (wsel == 0u) ? bit : 0u; m1 |= (wsel == 1u) ? bit : 0u; m2 |= (wsel == 2u) ? bit : 0u; m3 |= (wsel == 3u) ? bit : 0u;
        }
        if (hi == 0) { selm[qi * 4] = m0; selm[qi * 4 + 1] = m1; selm[qi * 4 + 2] = m2; selm[qi * 4 + 3] = m3; }
    }
    __syncthreads();
    unsigned sm0 = selm[ql * 4], sm1 = selm[ql * 4 + 1], sm2 = selm[ql * 4 + 2], sm3 = selm[ql * 4 + 3];
    {
        float mref = FA_NEG, l = 0.f;
#pragma unroll
        for (int r = 0; r < 16; ++r) { o[0][r] = 0.f; o[1][r] = 0.f; }
        const unsigned short* Ks = KS16 + (long)bg * S_ * 64; const unsigned short* Vs = VST16 + (long)bg * 64 * S_;
        NSA_STREAM(Ks, 64, Vs, S_, 0, cur, {
            const int jw = t_ >> 5; const unsigned wsel = (jw == 0) ? sm0 : ((jw == 1) ? sm1 : ((jw == 2) ? sm2 : sm3));
            const bool colsel = (wsel >> (t_ & 31)) & 1u;
            if (__any(colsel)) fa_tile<64, 3>(st, qf, o, mref, l, key0, qpos, lane, t_ == cur, colsel);
        });
        l = pair_sum(l);
        const float sc = gates[tok * 24 + hh * 3 + 1] / l;
#pragma unroll
        for (int r = 0; r < 16; ++r) { acc[0][r] += sc * o[0][r]; acc[1][r] += sc * o[1][r]; }
    }
    {
        float mref = FA_NEG, l = 0.f;
#pragma unroll
        for (int r = 0; r < 16; ++r) { o[0][r] = 0.f; o[1][r] = 0.f; }
        const unsigned short* Kw = KW16 + (long)bg * S_ * 64; const unsigned short* Vw = VWT16 + (long)bg * 64 * S_;
        const int tw_lo = (cur >= 8) ? cur - 8 : 0;
        NSA_STREAM(Kw, 64, Vw, S_, tw_lo, cur, {
            fa_tile<64, 2>(st, qf, o, mref, l, key0, qpos, lane, (t_ == cur) || (t_ == cur - 8));
        });
        l = pair_sum(l);
        const float sc = gates[tok * 24 + hh * 3 + 2] / l;
#pragma unroll
        for (int r = 0; r < 16; ++r) { acc[0][r] += sc * o[0][r]; acc[1][r] += sc * o[1][r]; }
    }
    float ss = 0.f;
#pragma unroll
    for (int dt = 0; dt < 2; ++dt)
#pragma unroll
        for (int gq = 0; gq < 4; ++gq) {
            const float v0 = acc[dt][4 * gq], v1 = acc[dt][4 * gq + 1], v2 = acc[dt][4 * gq + 2], v3 = acc[dt][4 * gq + 3];
            uint2 pk; pk.x = cvtpk(v0, v1); pk.y = cvtpk(v2, v3);
            *(uint2*)(oa16 + tok * 1024 + hh * 64 + dt * 32 + 8 * gq + 4 * hi) = pk;
            ss += v0 * v0 + v1 * v1 + v2 * v2 + v3 * v3;
        }
    ss = pair_sum(ss);
    if (hi == 0) ssqa[(long)hh * T_ + tok] = ss;
    __syncthreads();
}
__device__ __forceinline__ void nsa_phase(unsigned char* lds, const unsigned short* __restrict__ Q16A, const unsigned short* __restrict__ KC16, const unsigned short* __restrict__ VCT16,
                                          const unsigned short* __restrict__ KS16, const unsigned short* __restrict__ VST16, const unsigned short* __restrict__ KW16, const unsigned short* __restrict__ VWT16,
                                          const float* __restrict__ gates, unsigned short* __restrict__ oa16, float* __restrict__ ssqa) {
    const int tid = tid_();
    for (int i = blockIdx.x; i < 256; i += NBLK) {
        const int xcd = i & 7, slot = i >> 3; const int bg = xcd >> 1, pr = (xcd & 1) * 32 + slot;
        nsa_unit(lds, bg >> 1, bg & 1, 127 - pr, Q16A, KC16, VCT16, KS16, VST16, KW16, VWT16, gates, oa16, ssqa, tid);
        nsa_unit(lds, bg >> 1, bg & 1, pr, Q16A, KC16, VCT16, KS16, VST16, KW16, VWT16, gates, oa16, ssqa, tid);
    }
}
__device__ __forceinline__ int nmap_in2(int n) {
    if (n < 768) return n;
    if (n < 896) return n;
    if (n < 1024) return n - 896 + 1024;
    if (n < 1152) return n - 1024 + 896;
    if (n < 1280) return n;
    if (n < 1304) return n - 1280 + 1696;
    if (n < 1560) return n - 1304 + 1280;
    if (n < 1688) return n - 1560 + 1536;
    return n - 1688 + 1664;
}
template <int NMAP>
__device__ __forceinline__ void cvt_transpose2(float* ldsf, const float* __restrict__ Wsrc, int K, int N, unsigned short* __restrict__ Wt, const float* __restrict__ kgain) {
    const int tid = tid_();
    float (*tl)[65] = (float (*)[65])ldsf;
    const int tk = K / 64, tn = (N + 63) / 64;
    for (int tile = blockIdx.x; tile < tk * tn; tile += NBLK) {
        const int k0 = (tile / tn) * 64, n0 = (tile % tn) * 64;
#pragma unroll
        for (int i = 0; i < 8; ++i) {
            const int kl = (tid >> 6) + 8 * i, nl = tid & 63; const int n = n0 + nl, k = k0 + kl;
            float v = (n < N) ? Wsrc[(long)k * N + n] : 0.f;
            if (kgain) v *= kgain[k];
            tl[kl][nl] = v;
        }
        __syncthreads();
        {
            const int nl = tid >> 3, kc = (tid & 7) * 8; const int n = n0 + nl;
            if (n < N) {
                uint4 o; o.x = cvtpk(tl[kc][nl], tl[kc + 1][nl]); o.y = cvtpk(tl[kc + 2][nl], tl[kc + 3][nl]); o.z = cvtpk(tl[kc + 4][nl], tl[kc + 5][nl]); o.w = cvtpk(tl[kc + 6][nl], tl[kc + 7][nl]);
                const int nn = (NMAP == 2) ? nmap_in2(n) : n;
                *(uint4*)(Wt + (long)nn * K + k0 + kc) = o;
            }
        }
        __syncthreads();
    }
}
__device__ __forceinline__ void p0_xn_rope(const float* __restrict__ x, const float* __restrict__ g1, const int* __restrict__ positions, unsigned short* __restrict__ xn16, float* __restrict__ rope) {
    const int tid = tid_(); const int lane = tid & 63, w = __builtin_amdgcn_readfirstlane(tid >> 6);
    for (int t = blockIdx.x * 8 + w; t < T_; t += NBLK * 8) {
        const float4* xp = (const float4*)(x + (long)t * 1024);
        float4 a0 = xp[lane * 2], a1 = xp[lane * 2 + 1], b0 = xp[128 + lane * 2], b1 = xp[128 + lane * 2 + 1];
        float ss = a0.x * a0.x + a0.y * a0.y + a0.z * a0.z + a0.w * a0.w + a1.x * a1.x + a1.y * a1.y + a1.z * a1.z + a1.w * a1.w
                 + b0.x * b0.x + b0.y * b0.y + b0.z * b0.z + b0.w * b0.w + b1.x * b1.x + b1.y * b1.y + b1.z * b1.z + b1.w * b1.w;
        ss = wsum(ss); const float rs = rsqrtf(ss * (1.f / 1024.f) + EPS);
        const float4* gp = (const float4*)g1; const float4 ga0 = gp[lane * 2], ga1 = gp[lane * 2 + 1], gb0 = gp[128 + lane * 2], gb1 = gp[128 + lane * 2 + 1];
        uint4 pa, pb;
        pa.x = cvtpk(a0.x * rs * ga0.x, a0.y * rs * ga0.y); pa.y = cvtpk(a0.z * rs * ga0.z, a0.w * rs * ga0.w); pa.z = cvtpk(a1.x * rs * ga1.x, a1.y * rs * ga1.y); pa.w = cvtpk(a1.z * rs * ga1.z, a1.w * rs * ga1.w);
        pb.x = cvtpk(b0.x * rs * gb0.x, b0.y * rs * gb0.y); pb.y = cvtpk(b0.z * rs * gb0.z, b0.w * rs * gb0.w); pb.z = cvtpk(b1.x * rs * gb1.x, b1.y * rs * gb1.y); pb.w = cvtpk(b1.z * rs * gb1.z, b1.w * rs * gb1.w);
        ((uint4*)(xn16 + (long)t * 1024))[lane] = pa; ((uint4*)(xn16 + (long)t * 1024))[64 + lane] = pb;
        if (lane < 24) {
            const float f = lane < 8 ? ROPE_F16[lane] : ROPE_F32[lane - 8];
            const float angf = (float)positions[t] * f;
            const double ang = (double)angf; const double k = rint(ang * 0.15915494309189535);
            const float r = (float)(ang - k * 6.283185307179586);
            const float c = cosf(r), sn = sinf(r);
            if (lane < 8) { rope[(long)t * 48 + lane] = c; rope[(long)t * 48 + 8 + lane] = sn; }
            else { rope[(long)t * 48 + 16 + lane - 8] = c; rope[(long)t * 48 + 32 + lane - 8] = sn; }
        }
    }
}
__device__ __forceinline__ void p0_cbias(const float* __restrict__ pos, const float* __restrict__ w1k, const float* __restrict__ w1v, float* __restrict__ cbias) {
    const int tid = tid_(); const int lane = tid & 63, w = __builtin_amdgcn_readfirstlane(tid >> 6);
    for (int task = blockIdx.x * 8 + w; task < 512; task += NBLK * 8) {
        const int mat = task >> 8, n = task & 255; const float* w1 = mat ? w1v : w1k;
        float acc = 0.f;
#pragma unroll 8
        for (int i = 0; i < 32; ++i) { const int k = lane + 64 * i; acc += pos[k] * w1[(long)k * 256 + n]; }
        acc = wsum(acc);
        if (lane == 0) cbias[task] = acc;
    }
}
__device__ __forceinline__ void zero_stream(unsigned short* __restrict__ p, long n) {
    const int tid = tid_();
    for (long c = (long)blockIdx.x * 512 + tid; c < (n >> 3); c += (long)NBLK * 512) ((uint4*)p)[c] = make_uint4(0u, 0u, 0u, 0u);
}

struct P1Out {
    unsigned short *q16a, *ks16, *kw16, *vst16, *vwt16, *kcmp16, *vcmp16, *cq16, *ckv16;
    float *krr, *ssq_kr, *ssq_cq, *ssq_ckv, *gates;
    const float *rope, *q_gain, *ks_gain, *kw_gain, *k_gain;
};
__device__ __forceinline__ void norm_rope64(f32x16& a0, f32x16& a1, const float* __restrict__ gain, const float* __restrict__ rope_t, int hi, float outscale) {
    float ss = 0.f;
#pragma unroll
    for (int r = 0; r < 16; ++r) ss += a0[r] * a0[r] + a1[r] * a1[r];
    ss = pair_sum(ss);
    const float rs = rsqrtf(ss * (1.f / 64.f) + EPS);
#pragma unroll
    for (int g = 0; g < 4; ++g) {
        const float4 g0 = *(const float4*)(gain + 8 * g + 4 * hi), g1 = *(const float4*)(gain + 32 + 8 * g + 4 * hi);
        a0[4 * g] *= rs * g0.x; a0[4 * g + 1] *= rs * g0.y; a0[4 * g + 2] *= rs * g0.z; a0[4 * g + 3] *= rs * g0.w;
        a1[4 * g] *= rs * g1.x; a1[4 * g + 1] *= rs * g1.y; a1[4 * g + 2] *= rs * g1.z; a1[4 * g + 3] *= rs * g1.w;
    }
    const float4 c4 = *(const float4*)(rope_t + 4 * hi), s4 = *(const float4*)(rope_t + 8 + 4 * hi);
    const float cc[4] = {c4.x, c4.y, c4.z, c4.w}, sn[4] = {s4.x, s4.y, s4.z, s4.w};
#pragma unroll
    for (int j = 0; j < 4; ++j) { const float x1 = a0[j], x2 = a0[4 + j]; a0[j] = x1 * cc[j] - x2 * sn[j]; a0[4 + j] = x2 * cc[j] + x1 * sn[j]; }
#pragma unroll
    for (int r = 0; r < 16; ++r) { a0[r] *= outscale; a1[r] *= outscale; }
}
__device__ __forceinline__ void store_row64(unsigned short* __restrict__ dst, const f32x16& a0, const f32x16& a1, int hi) {
#pragma unroll
    for (int g = 0; g < 4; ++g) {
        uint2 p0, p1; p0.x = cvtpk(a0[4 * g], a0[4 * g + 1]); p0.y = cvtpk(a0[4 * g + 2], a0[4 * g + 3]); p1.x = cvtpk(a1[4 * g], a1[4 * g + 1]); p1.y = cvtpk(a1[4 * g + 2], a1[4 * g + 3]);
        *(uint2*)(dst + 8 * g + 4 * hi) = p0; *(uint2*)(dst + 32 + 8 * g + 4 * hi) = p1;
    }
}
__device__ __forceinline__ float ssq64(const f32x16& a0, const f32x16& a1) {
    float ss = 0.f;
#pragma unroll
    for (int r = 0; r < 16; ++r) ss += a0[r] * a0[r] + a1[r] * a1[r];
    return pair_sum(ss);
}
__device__ __forceinline__ float sum4fq(float v) {
    auto r1 = __builtin_amdgcn_permlane16_swap(__float_as_uint(v), __float_as_uint(v), false, false);
    return pair_sum(__uint_as_float(r1[0]) + __uint_as_float(r1[1]));
}
#define P1V(m, j) acc[ai][bj][m][n][j]
__device__ __forceinline__ void p1_inproj_256(unsigned char* lds, const unsigned short* __restrict__ xn16, const unsigned short* __restrict__ wt_in, const P1Out& Oin) {
    const P1Out O = Oin;
    const int vcu = (blockIdx.x & 7) * (NBLK / 8) + (blockIdx.x >> 3);
    for (int tile = vcu; tile < 64 * 7; tile += NBLK) {
        const int mt = tile / 7, nt = tile % 7; const int m0 = mt * 256;
        f32x4_t acc[2][2][4][2];
#pragma unroll
        for (int ai = 0; ai < 2; ++ai)
#pragma unroll
            for (int bj = 0; bj < 2; ++bj)
#pragma unroll
                for (int m = 0; m < 4; ++m)
#pragma unroll
                    for (int n = 0; n < 2; ++n) acc[ai][bj][m][n] = f32x4_t{0.f, 0.f, 0.f, 0.f};
        if (nt == 4) g256::mainloop<1024>(xn16, wt_in, m0, nt * 256, (unsigned short*)lds, acc);
        else g256::mainloop<1024>(wt_in, xn16, nt * 256, m0, (unsigned short*)lds, acc);
        const int tid = tid_(); const int lane = tid & 63, wave = __builtin_amdgcn_readfirstlane(tid >> 6), wr = wave >> 2, wc = wave & 3, fr = lane & 15, fq = lane >> 4;
        if (nt == 4) {
#pragma unroll
            for (int bj = 0; bj < 2; ++bj)
#pragma unroll
                for (int n = 0; n < 2; ++n) {
                    const int pc = bj * 2 + (wc >> 1), d = (wc & 1) * 32 + n * 16 + fr;
                    unsigned short* vt = (pc < 2) ? O.vst16 : O.vwt16; const int g = pc & 1;
#pragma unroll
                    for (int ai = 0; ai < 2; ++ai)
#pragma unroll
                        for (int m = 0; m < 4; ++m) {
                            const int tb = m0 + ai * 128 + wr * 64 + m * 16 + fq * 4; const int b = tb / S_, s0 = tb % S_;
                            uint2 pk; pk.x = cvtpk(P1V(m, 0), P1V(m, 1)); pk.y = cvtpk(P1V(m, 2), P1V(m, 3));
                            *(uint2*)(vt + ((long)(b * 2 + g) * 64 + d) * S_ + vperm(s0)) = pk;
                        }
                }
        } else {
#pragma unroll
            for (int ai = 0; ai < 2; ++ai) {
                const int pc = ai * 2 + wr;
#pragma unroll
                for (int bj = 0; bj < 2; ++bj)
#pragma unroll
                    for (int n = 0; n < 2; ++n) {
                        const long tok = m0 + bj * 128 + wc * 32 + n * 16 + fr; const int b = (int)(tok / S_), s = (int)(tok % S_);
                        const float* rope_t = O.rope + tok * 48;
                        const bool is_q = nt < 2, is_k = nt == 3;
                        if (is_q || is_k) {
                            const float* gain = is_q ? O.q_gain : ((pc < 2) ? O.ks_gain : O.kw_gain);
                            float ss = 0.f;
#pragma unroll
                            for (int m = 0; m < 4; ++m)
#pragma unroll
                                for (int j = 0; j < 4; ++j) ss += P1V(m, j) * P1V(m, j);
                            const float rs = rsqrtf(sum4fq(ss) * (1.f / 64.f) + EPS) ;
#pragma unroll
                            for (int m = 0; m < 4; ++m) { const float4 gv = *(const float4*)(gain + m * 16 + fq * 4);
                                P1V(m, 0) *= rs * gv.x; P1V(m, 1) *= rs * gv.y; P1V(m, 2) *= rs * gv.z; P1V(m, 3) *= rs * gv.w; }
                            { const float4 c4 = *(const float4*)(rope_t + (fq & 1) * 4), s4 = *(const float4*)(rope_t + 8 + (fq & 1) * 4);
                              const float cc[4] = {c4.x, c4.y, c4.z, c4.w}, sn[4] = {s4.x, s4.y, s4.z, s4.w};
#pragma unroll
                              for (int j = 0; j < 4; ++j) {
                                  auto rr = __builtin_amdgcn_permlane32_swap(__float_as_uint(P1V(0, j)), __float_as_uint(P1V(0, j)), false, false);
                                  const float x1 = __uint_as_float(rr[0]), x2 = __uint_as_float(rr[1]);
                                  P1V(0, j) = (fq < 2) ? (x1 * cc[j] - x2 * sn[j]) : (x2 * cc[j] + x1 * sn[j]);
                              } }
                            const float osc = is_q ? NSA_QSCALE : 1.f;
                            unsigned short* dst = is_q ? (O.q16a + tok * 512 + (nt * 4 + pc) * 64) : ((pc < 2 ? O.ks16 : O.kw16) + ((long)(b * 2 + (pc & 1)) * S_ + s) * 64);
#pragma unroll
                            for (int m = 0; m < 4; ++m) { uint2 pk; pk.x = cvtpk(P1V(m, 0) * osc, P1V(m, 1) * osc); pk.y = cvtpk(P1V(m, 2) * osc, P1V(m, 3) * osc); *(uint2*)(dst + m * 16 + fq * 4) = pk; }
                        } else if (nt == 2 || nt == 5 || (nt == 6 && pc < 2)) {
                            unsigned short* dst;
                            if (nt == 2) dst = (pc < 2 ? O.kcmp16 : O.vcmp16) + ((long)(b * 2 + (pc & 1)) * S_ + s) * 64;
                            else if (nt == 5) dst = O.cq16 + tok * 256 + pc * 64;
                            else dst = O.ckv16 + tok * 128 + pc * 64;
                            float ss = 0.f;
#pragma unroll
                            for (int m = 0; m < 4; ++m) { uint2 pk; pk.x = cvtpk(P1V(m, 0), P1V(m, 1)); pk.y = cvtpk(P1V(m, 2), P1V(m, 3)); *(uint2*)(dst + m * 16 + fq * 4) = pk;
#pragma unroll
                                for (int j = 0; j < 4; ++j) ss += P1V(m, j) * P1V(m, j); }
                            if (nt != 2) { ss = sum4fq(ss); if (fq == 0) { if (nt == 5) O.ssq_cq[(long)pc * T_ + tok] = ss; else O.ssq_ckv[(long)pc * T_ + tok] = ss; } }
                        } else if (nt == 6 && pc == 2) {
                            float ss = 0.f;
#pragma unroll
                            for (int m = 0; m < 2; ++m)
#pragma unroll
                                for (int j = 0; j < 4; ++j) ss += P1V(m, j) * P1V(m, j);
                            ss = sum4fq(ss);
                            if (fq == 0) O.ssq_kr[tok] = ss;
                            {
                                const float4 g0 = *(const float4*)(O.k_gain + 64 + fq * 4), g1 = *(const float4*)(O.k_gain + 80 + fq * 4);
                                const float4 c4 = *(const float4*)(rope_t + 16 + fq * 4), s4 = *(const float4*)(rope_t + 32 + fq * 4);
                                const float ga[4] = {g0.x, g0.y, g0.z, g0.w}, gb[4] = {g1.x, g1.y, g1.z, g1.w}, cc[4] = {c4.x, c4.y, c4.z, c4.w}, sn[4] = {s4.x, s4.y, s4.z, s4.w};
                                float o1[4], o2[4];
#pragma unroll
                                for (int j = 0; j < 4; ++j) { const float x1 = P1V(0, j) * ga[j], x2 = P1V(1, j) * gb[j]; o1[j] = x1 * cc[j] - x2 * sn[j]; o2[j] = x2 * cc[j] + x1 * sn[j]; }
                                *(float4*)(O.krr + tok * 32 + fq * 4) = make_float4(o1[0], o1[1], o1[2], o1[3]);
                                *(float4*)(O.krr + tok * 32 + 16 + fq * 4) = make_float4(o2[0], o2[1], o2[2], o2[3]);
                            }
                            *(float4*)(O.gates + tok * 24 + fq * 4) = make_float4(1.f / (1.f + __expf(-P1V(2, 0))), 1.f / (1.f + __expf(-P1V(2, 1))), 1.f / (1.f + __expf(-P1V(2, 2))), 1.f / (1.f + __expf(-P1V(2, 3))));
                            if (fq < 2) *(float4*)(O.gates + tok * 24 + 16 + fq * 4) = make_float4(1.f / (1.f + __expf(-P1V(3, 0))), 1.f / (1.f + __expf(-P1V(3, 1))), 1.f / (1.f + __expf(-P1V(3, 2))), 1.f / (1.f + __expf(-P1V(3, 3))));
                        }
                    }
            }
        }
        __syncthreads();
    }
}
#undef P1V

typedef GemmShape<2, 4, 2, 2> ShBig;
typedef GemmShape<4, 2, 1, 3> ShQb;
typedef GemmShape<4, 2, 1, 4> ShKvb;
struct P2Args {
    const unsigned short *cq16, *ckv16, *wt_uq, *wt_ukv, *kcmp16, *vcmp16, *w1t_k, *w1t_v;
    const float *ssq_cq, *ssq_ckv, *ssq_kr, *krr, *rope, *q_gain, *k_gain;
    unsigned short *q16, *k16, *vt16; float* hid;
};
__device__ __forceinline__ void p2_phase(unsigned char* lds, const P2Args& A) {
    const int tid = tid_(); const int lane = tid & 63, wave = __builtin_amdgcn_readfirstlane(tid >> 6), r32 = lane & 31, hi = lane >> 5;
    const int nmine = (blockIdx.x < 128) ? 4 : 5;
    for (int it = 0; it < nmine; ++it) {
        int u;
        if (blockIdx.x < 128) { if (it == 0) u = blockIdx.x; else { const int s = blockIdx.x * 3 + (it - 1); u = (s & 1) ? 640 + (s >> 1) : 128 + (s >> 1); } }
        else { const int s = 384 + (blockIdx.x - 128) * 5 + it; u = (s & 1) ? 640 + (s >> 1) : 128 + (s >> 1); }
        if (u < 128) {
            const int mat = u >> 6, mtile = (u >> 2) & 15, ks = u & 3; const int wm = wave >> 2, wn = wave & 3;
            f32x16 acc[2][2];
#pragma unroll
            for (int mi = 0; mi < 2; ++mi)
#pragma unroll
                for (int ni = 0; ni < 2; ++ni)
#pragma unroll
                    for (int r = 0; r < 16; ++r) acc[mi][ni][r] = 0.f;
            gemm_mainloop<ShBig, 3u>((mat ? A.vcmp16 : A.kcmp16) + (long)mtile * 128 * 1024 + ks * 512, 1024, (mat ? A.w1t_v : A.w1t_k) + ks * 512, 2048, 512, lds, acc, tid);
            float* slab = A.hid + (long)(mat * 4 + ks) * 2048 * 256;
#pragma unroll
            for (int mi = 0; mi < 2; ++mi) {
                const long row = mtile * 128 + wm * 64 + mi * 32 + r32;
#pragma unroll
                for (int ni = 0; ni < 2; ++ni)
#pragma unroll
                    for (int g = 0; g < 4; ++g)
                        *(float4*)(slab + row * 256 + wn * 64 + ni * 32 + 8 * g + 4 * hi) = make_float4(acc[mi][ni][4 * g], acc[mi][ni][4 * g + 1], acc[mi][ni][4 * g + 2], acc[mi][ni][4 * g + 3]);
            }
        } else if (u < 128 + 512) {
            const int v = u - 128; const int mt = v >> 2, nt = v & 3; const int m0 = mt * 128; const int wm = wave >> 1, wn = wave & 1; const int head = nt * 2 + wn;
            f32x16 acc[1][4];
#pragma unroll
            for (int ni = 0; ni < 4; ++ni)
#pragma unroll
                for (int r = 0; r < 16; ++r) acc[0][ni][r] = 0.f;
            gemm_mainloop<ShKvb, 3u>(A.ckv16 + (long)m0 * 128, 128, A.wt_ukv + (long)nt * 256 * 128, 128, 128, lds, acc, tid);
            {
                const long tok = m0 + wm * 32 + r32; const int b = (int)(tok / S_), s = (int)(tok % S_);
                const float rc = rsqrtf((A.ssq_ckv[tok] + A.ssq_ckv[(long)T_ + tok]) * (1.f / 128.f) + EPS);
                float ss = 0.f;
#pragma unroll
                for (int r = 0; r < 16; ++r) { acc[0][0][r] *= rc; acc[0][1][r] *= rc; ss += acc[0][0][r] * acc[0][0][r] + acc[0][1][r] * acc[0][1][r]; }
                ss = pair_sum(ss) + A.ssq_kr[tok];
                const float rk = rsqrtf(ss * (1.f / 96.f) + EPS);
#pragma unroll
                for (int g = 0; g < 4; ++g) {
                    const float4 g0 = *(const float4*)(A.k_gain + 8 * g + 4 * hi), g1 = *(const float4*)(A.k_gain + 32 + 8 * g + 4 * hi);
                    acc[0][0][4 * g] *= rk * g0.x; acc[0][0][4 * g + 1] *= rk * g0.y; acc[0][0][4 * g + 2] *= rk * g0.z; acc[0][0][4 * g + 3] *= rk * g0.w;
                    acc[0][1][4 * g] *= rk * g1.x; acc[0][1][4 * g + 1] *= rk * g1.y; acc[0][1][4 * g + 2] *= rk * g1.z; acc[0][1][4 * g + 3] *= rk * g1.w;
                }
                unsigned short* krow = A.k16 + ((long)(b * 8 + head) * S_ + s) * 96;
                store_row64(krow, acc[0][0], acc[0][1], hi);
                const float4* kp = (const float4*)(A.krr + tok * 32 + hi * 16);
                const float4 k0 = kp[0], k1 = kp[1], k2 = kp[2], k3 = kp[3];
                uint4 o0, o1; o0.x = cvtpk(k0.x * rk, k0.y * rk); o0.y = cvtpk(k0.z * rk, k0.w * rk); o0.z = cvtpk(k1.x * rk, k1.y * rk); o0.w = cvtpk(k1.z * rk, k1.w * rk);
                o1.x = cvtpk(k2.x * rk, k2.y * rk); o1.y = cvtpk(k2.z * rk, k2.w * rk); o1.z = cvtpk(k3.x * rk, k3.y * rk); o1.w = cvtpk(k3.z * rk, k3.w * rk);
                *(uint4*)(krow + 64 + hi * 16) = o0; *(uint4*)(krow + 64 + hi * 16 + 8) = o1;
            }
            {
#pragma unroll
                for (int ni = 2; ni < 4; ++ni)
#pragma unroll
                    for (int g4 = 0; g4 < 4; ++g4) {
                        const int tb = m0 + wm * 32 + 8 * g4 + 4 * hi; const int b = tb / S_, s0 = tb % S_; const int d = (ni - 2) * 32 + r32;
                        const float4 sa = *(const float4*)(A.ssq_ckv + tb), sb = *(const float4*)(A.ssq_ckv + (long)T_ + tb);
                        const float r0 = rsqrtf((sa.x + sb.x) * (1.f / 128.f) + EPS), r1 = rsqrtf((sa.y + sb.y) * (1.f / 128.f) + EPS), r2 = rsqrtf((sa.z + sb.z) * (1.f / 128.f) + EPS), r3 = rsqrtf((sa.w + sb.w) * (1.f / 128.f) + EPS);
                        uint2 pk; pk.x = cvtpk(acc[0][ni][4 * g4] * r0, acc[0][ni][4 * g4 + 1] * r1); pk.y = cvtpk(acc[0][ni][4 * g4 + 2] * r2, acc[0][ni][4 * g4 + 3] * r3);
                        *(uint2*)(A.vt16 + ((long)(b * 8 + head) * 64 + d) * S_ + vperm(s0)) = pk;
                    }
            }
        } else {
            const int v = u - 640; const int mt = v >> 2, nt = v & 3; const int m0 = mt * 128; const int wm = wave >> 1, wn = wave & 1; const int head = nt * 2 + wn;
            f32x16 acc[1][3];
#pragma unroll
            for (int ni = 0; ni < 3; ++ni)
#pragma unroll
                for (int r = 0; r < 16; ++r) acc[0][ni][r] = 0.f;
            gemm_mainloop<ShQb, 7u>(A.cq16 + (long)m0 * 256, 256, A.wt_uq + (long)nt * 192 * 256, 256, 256, lds, acc, tid);
            const long tok = m0 + wm * 32 + r32;
            const float rc = rsqrtf((A.ssq_cq[tok] + A.ssq_cq[(long)T_ + tok] + A.ssq_cq[2L * T_ + tok] + A.ssq_cq[3L * T_ + tok]) * (1.f / 256.f) + EPS);
            float ss = 0.f;
#pragma unroll
            for (int ni = 0; ni < 3; ++ni)
#pragma unroll
                for (int r = 0; r < 16; ++r) { acc[0][ni][r] *= rc; ss += acc[0][ni][r] * acc[0][ni][r]; }
            ss = pair_sum(ss);
            const float rq = rsqrtf(ss * (1.f / 96.f) + EPS);
#pragma unroll
            for (int ni = 0; ni < 3; ++ni)
#pragma unroll
                for (int g = 0; g < 4; ++g) {
                    const float4 gg = *(const float4*)(A.q_gain + ni * 32 + 8 * g + 4 * hi);
                    acc[0][ni][4 * g] *= rq * gg.x; acc[0][ni][4 * g + 1] *= rq * gg.y; acc[0][ni][4 * g + 2] *= rq * gg.z; acc[0][ni][4 * g + 3] *= rq * gg.w;
                }
            const float* rope_t = A.rope + tok * 48;
#pragma unroll
            for (int g = 0; g < 2; ++g) {
                const float4 c4 = *(const float4*)(rope_t + 16 + 8 * g + 4 * hi), s4 = *(const float4*)(rope_t + 32 + 8 * g + 4 * hi);
                const float cc[4] = {c4.x, c4.y, c4.z, c4.w}, sn[4] = {s4.x, s4.y, s4.z, s4.w};
#pragma unroll
                for (int j = 0; j < 4; ++j) { const float x1 = acc[0][2][4 * g + j], x2 = acc[0][2][8 + 4 * g + j]; acc[0][2][4 * g + j] = x1 * cc[j] - x2 * sn[j]; acc[0][2][8 + 4 * g + j] = x2 * cc[j] + x1 * sn[j]; }
            }
            unsigned short* qrow = A.q16 + tok * 768 + head * 96;
#pragma unroll
            for (int ni = 0; ni < 3; ++ni)
#pragma unroll
                for (int g = 0; g < 4; ++g) {
                    uint2 pk; pk.x = cvtpk(acc[0][ni][4 * g] * MLA_QSCALE, acc[0][ni][4 * g + 1] * MLA_QSCALE); pk.y = cvtpk(acc[0][ni][4 * g + 2] * MLA_QSCALE, acc[0][ni][4 * g + 3] * MLA_QSCALE);
                    *(uint2*)(qrow + ni * 32 + 8 * g + 4 * hi) = pk;
                }
        }
    }
}
__device__ __forceinline__ void p3_cmp2(const float* __restrict__ hid, const float* __restrict__ cbias, const unsigned short* __restrict__ w2t_k, const unsigned short* __restrict__ w2t_v,
                                        const float* __restrict__ kc_gain, const float* __restrict__ rope, unsigned short* __restrict__ kc16, unsigned short* __restrict__ vct16) {
    const int tid = tid_(); const int lane = tid & 63, w = __builtin_amdgcn_readfirstlane(tid >> 6), r32 = lane & 31, hi = lane >> 5;
    for (int task = blockIdx.x * 8 + w; task < 128; task += NBLK * 8) {
        const int mat = task >> 6, rt = task & 63; const long row = rt * 32 + r32;
        const unsigned short* w2t = mat ? w2t_v : w2t_k;
        f32x16 acc[2];
#pragma unroll
        for (int r = 0; r < 16; ++r) { acc[0][r] = 0.f; acc[1][r] = 0.f; }
#pragma unroll 4
        for (int ks = 0; ks < 16; ++ks) {
            const int k0 = ks * 16 + hi * 8;
            float h[8];
            { const float4 b0 = *(const float4*)(cbias + mat * 256 + k0), b1 = *(const float4*)(cbias + mat * 256 + k0 + 4);
              h[0] = b0.x; h[1] = b0.y; h[2] = b0.z; h[3] = b0.w; h[4] = b1.x; h[5] = b1.y; h[6] = b1.z; h[7] = b1.w; }
#pragma unroll
            for (int sp = 0; sp < 4; ++sp) {
                const float* hp = hid + ((long)(mat * 4 + sp) * 2048 + row) * 256 + k0;
                const float4 a0 = *(const float4*)hp, a1 = *(const float4*)(hp + 4);
                h[0] += a0.x; h[1] += a0.y; h[2] += a0.z; h[3] += a0.w; h[4] += a1.x; h[5] += a1.y; h[6] += a1.z; h[7] += a1.w;
            }
            uint4 pk; pk.x = cvtpk(gelu_tanh(h[0]), gelu_tanh(h[1])); pk.y = cvtpk(gelu_tanh(h[2]), gelu_tanh(h[3])); pk.z = cvtpk(gelu_tanh(h[4]), gelu_tanh(h[5])); pk.w = cvtpk(gelu_tanh(h[6]), gelu_tanh(h[7]));
            const bf16x8 hf = __builtin_bit_cast(bf16x8, pk);
            const bf16x8 w0 = *(const bf16x8*)(w2t + (long)r32 * 256 + k0), w1 = *(const bf16x8*)(w2t + (long)(32 + r32) * 256 + k0);
            acc[0] = MFMA32(w0, hf, acc[0]); acc[1] = MFMA32(w1, hf, acc[1]);
        }
        const int bg = (int)(row >> 9), n = (int)(row & 511); const bool valid = n < NCMP;
        if (mat == 0) {
            if (valid) {
                const long tokp = (long)(bg >> 1) * S_ + 16 * n + 31;
                norm_rope64(acc[0], acc[1], kc_gain, rope + tokp * 48, hi, 1.f);
            } else {
#pragma unroll
                for (int r = 0; r < 16; ++r) { acc[0][r] = 0.f; acc[1][r] = 0.f; }
            }
            store_row64(kc16 + row * 64, acc[0], acc[1], hi);
        } else {
#pragma unroll
            for (int ni = 0; ni < 2; ++ni)
#pragma unroll
                for (int r = 0; r < 16; ++r) {
                    const float v = valid ? acc[ni][r] : 0.f;
                    const float other = __uint_as_float(__builtin_amdgcn_mov_dpp(__float_as_uint(v), 0xB1, 0xF, 0xF, true));
                    if ((lane & 1) == 0) *(unsigned*)(vct16 + ((long)bg * 64 + ni * 32 + crow(r, hi)) * 512 + vperm(n)) = cvtpk(v, other);
                }
        }
    }
}

__device__ __forceinline__ void cvt_stream(const float* __restrict__ in, unsigned short* __restrict__ out, long n, int vb = blockIdx.x, int nb = NBLK) {
    const long nchunk = n >> 3;
    const int tid = tid_();
    for (long c = (long)vb * 512 + tid; c < nchunk; c += (long)nb * 512) {
        const float4 a = ((const float4*)in)[2 * c], b = ((const float4*)in)[2 * c + 1];
        uint4 o; o.x = cvtpk(a.x, a.y); o.y = cvtpk(a.z, a.w); o.z = cvtpk(b.x, b.y); o.w = cvtpk(b.z, b.w);
        ((uint4*)out)[c] = o;
    }
}


typedef unsigned u32x3 __attribute__((ext_vector_type(3)));
typedef unsigned u32x6 __attribute__((ext_vector_type(6)));
typedef float f32x32 __attribute__((ext_vector_type(32)));
constexpr int PROW = 768;
__device__ __forceinline__ void cvt_rows_fp6(const float* __restrict__ in, unsigned char* __restrict__ out6, float* __restrict__ scale, int rows, int vb = blockIdx.x, int nb = NBLK) {
    const int tid = tid_(); const int lane = tid & 63, w = __builtin_amdgcn_readfirstlane(tid >> 6);
    for (int r = vb * 8 + w; r < rows; r += nb * 8) {
        const float4* p = (const float4*)(in + (long)r * 1024 + lane * 16);
        const float4 a = p[0], b = p[1], c = p[2], d = p[3];
        float m = fmaxf(fmaxf(fmaxf(fabsf(a.x), fabsf(a.y)), fmaxf(fabsf(a.z), fabsf(a.w))), fmaxf(fmaxf(fabsf(b.x), fabsf(b.y)), fmaxf(fabsf(b.z), fabsf(b.w))));
        m = fmaxf(m, fmaxf(fmaxf(fmaxf(fabsf(c.x), fabsf(c.y)), fmaxf(fabsf(c.z), fabsf(c.w))), fmaxf(fmaxf(fabsf(d.x), fabsf(d.y)), fmaxf(fabsf(d.z), fabsf(d.w)))));
        m = wmax(m);
        const float q = (m > 0.f) ? 7.5f / m : 1.f;
        const f32x16 ve = {a.x * q, a.z * q, b.x * q, b.z * q, c.x * q, c.z * q, d.x * q, d.z * q, 0.f, 0.f, 0.f, 0.f, 0.f, 0.f, 0.f, 0.f};
        const f32x16 vo = {a.y * q, a.w * q, b.y * q, b.w * q, c.y * q, c.w * q, d.y * q, d.w * q, 0.f, 0.f, 0.f, 0.f, 0.f, 0.f, 0.f, 0.f};
        const u32x6 pk = __builtin_amdgcn_cvt_scalef32_2xpk16_fp6_f32(ve, vo, 1.0f);
        *(u32x3*)(out6 + (long)r * PROW + lane * 12) = u32x3{pk[0], pk[1], pk[2]};
        if (lane == 0) scale[r] = (m > 0.f) ? m * (1.f / 7.5f) : 1.f;
    }
}
__device__ __forceinline__ f32x32 dec2_fp6(const u32x3& r0, const u32x3& r1) {
    const u32x6 pk = {r0.x, r0.y, r0.z, r1.x, r1.y, r1.z};
    return __builtin_amdgcn_cvt_scalef32_pk32_f32_fp6(pk, 1.0f);
}
__device__ __forceinline__ void peer_sweep_a(const float* __restrict__ hss, const float* __restrict__ g2, const int* __restrict__ eo, const float* __restrict__ go,
                                             const unsigned char* __restrict__ U6, const float* __restrict__ su, const float* __restrict__ sv, const float* __restrict__ h, float* __restrict__ wout) {
    const int tid = tid_(); const int lane = tid & 63, w = __builtin_amdgcn_readfirstlane(tid >> 6);
    const int kcls = ((lane >> 5) & 1) * 4 + ((lane >> 4) & 1) * 2 + ((lane >> 3) & 1);
    for (int t = blockIdx.x * 8 + w; t < T_; t += NBLK * 8) {
        float x[16];
        {
            const float4* xp = (const float4*)(h + (long)t * 1024 + lane * 16); const float4* gp = (const float4*)(g2 + lane * 16); const float4* hp = (const float4*)(hss + (long)t * 16);
            const float4 s0 = hp[0], s1 = hp[1], s2 = hp[2], s3 = hp[3];
            const float rs = rsqrtf((s0.x + s0.y + s0.z + s0.w + s1.x + s1.y + s1.z + s1.w + s2.x + s2.y + s2.z + s2.w + s3.x + s3.y + s3.z + s3.w) * (1.f / 1024.f) + EPS);
#pragma unroll
            for (int k = 0; k < 4; ++k) { const float4 hv = xp[k], gv = gp[k]; x[4 * k] = hv.x * rs * gv.x; x[4 * k + 1] = hv.y * rs * gv.y; x[4 * k + 2] = hv.z * rs * gv.z; x[4 * k + 3] = hv.w * rs * gv.w; }
        }
        const int elo = eo[(long)t * 128 + lane], ehi = eo[(long)t * 128 + 64 + lane];
        const float glo = go[(long)t * 128 + lane], ghi = go[(long)t * 128 + 64 + lane];
        for (int bt = 0; bt < 16; ++bt) {
            int e[8];
#pragma unroll
            for (int k = 0; k < 8; ++k) e[k] = __builtin_amdgcn_readlane(bt < 8 ? elo : ehi, (bt * 8 + k) & 63);
            u32x3 u[8];
#pragma unroll
            for (int k = 0; k < 8; ++k) u[k] = *(const u32x3*)(U6 + (long)e[k] * PROW + lane * 12);
            const int emine = __shfl(bt < 8 ? elo : ehi, (bt * 8 + kcls) & 63);
            const float sum = su[emine], svm = sv[emine];
            const float gk = __shfl(bt < 8 ? glo : ghi, (bt * 8 + kcls) & 63);
            float a[8];
#pragma unroll
            for (int k = 0; k < 8; k += 2) {
                const f32x32 d = dec2_fp6(u[k], u[k + 1]);
                float s0 = 0.f, s1 = 0.f;
#pragma unroll
                for (int i = 0; i < 16; ++i) { s0 = fmaf(d[i], x[i], s0); s1 = fmaf(d[16 + i], x[i], s1); }
                a[k] = s0; a[k + 1] = s1;
            }
            float b4[4], c2[2], d1;
#pragma unroll
            for (int i = 0; i < 4; ++i) {
                auto rr = __builtin_amdgcn_permlane32_swap(__float_as_uint(a[i]), __float_as_uint(a[i + 4]), false, false);
                b4[i] = __uint_as_float(rr[0]) + __uint_as_float(rr[1]);
            }
#pragma unroll
            for (int i = 0; i < 2; ++i) {
                auto rr = __builtin_amdgcn_permlane16_swap(__float_as_uint(b4[i]), __float_as_uint(b4[i + 2]), false, false);
                c2[i] = __uint_as_float(rr[0]) + __uint_as_float(rr[1]);
            }
            { const bool up = (lane & 8) != 0; const float keep = up ? c2[1] : c2[0], send = up ? c2[0] : c2[1];
              d1 = keep + __uint_as_float(__builtin_amdgcn_mov_dpp(__float_as_uint(send), 0x128, 0xF, 0xF, true)); }
            d1 = quad_sum(d1);
            d1 += __uint_as_float(__builtin_amdgcn_mov_dpp(__float_as_uint(d1), 0x141, 0xF, 0xF, true));
            const float wl = gk * gelu_tanh(d1 * sum) * svm;
            if ((lane & 7) == 0) wout[(long)t * 128 + bt * 8 + kcls] = wl;
        }
    }
}
__device__ __forceinline__ void peer_sweep_b(const int* __restrict__ eo, const float* __restrict__ win, const unsigned char* __restrict__ V6, float* out) {
    const int tid = tid_(); const int lane = tid & 63, w = __builtin_amdgcn_readfirstlane(tid >> 6);
    for (int t = blockIdx.x * 8 + w; t < T_; t += NBLK * 8) {
        float y[16];
#pragma unroll
        for (int i = 0; i < 16; ++i) y[i] = 0.f;
        const int elo = eo[(long)t * 128 + lane], ehi = eo[(long)t * 128 + 64 + lane];
        const float wlo = win[(long)t * 128 + lane], whi = win[(long)t * 128 + 64 + lane];
        for (int bt = 0; bt < 16; ++bt) {
            int e[8]; float wk[8];
#pragma unroll
            for (int k = 0; k < 8; ++k) {
                e[k] = __builtin_amdgcn_readlane(bt < 8 ? elo : ehi, (bt * 8 + k) & 63);
                wk[k] = __uint_as_float(__builtin_amdgcn_readlane(__float_as_uint(bt < 8 ? wlo : whi), (bt * 8 + k) & 63));
            }
            u32x3 v[8];
#pragma unroll
            for (int k = 0; k < 8; ++k) v[k] = *(const u32x3*)(V6 + (long)e[k] * PROW + lane * 12);
#pragma unroll
            for (int k = 0; k < 8; k += 2) {
                const f32x32 d = dec2_fp6(v[k], v[k + 1]);
#pragma unroll
                for (int i = 0; i < 16; ++i) y[i] = fmaf(wk[k + 1], d[16 + i], fmaf(wk[k], d[i], y[i]));
            }
        }
        float4* o = (float4*)(out + (long)t * 1024 + lane * 16);
#pragma unroll
        for (int k = 0; k < 4; ++k) { float4 hv = o[k]; hv.x += y[4 * k]; hv.y += y[4 * k + 1]; hv.z += y[4 * k + 2]; hv.w += y[4 * k + 3]; o[k] = hv; }
    }
}

struct Params {
    const float* x; const int* positions; const float* norm1_gain; const float* w_in;
    const float *nsa_q_gain, *nsa_kc_gain, *nsa_ks_gain, *nsa_kw_gain, *cmp_pos, *cmp_k_w1, *cmp_k_w2, *cmp_v_w1, *cmp_v_w2;
    const float *mla_q_lora_gain, *mla_w_uq, *mla_kv_lora_gain, *mla_w_ukv, *mla_q_gain, *mla_k_gain, *out_gain_a, *out_gain_b, *w_out;
    const float *norm2_gain, *peer_w_q, *peer_sub_keys, *peer_u, *peer_v;
    float* out; float* W; unsigned* bar;
};
constexpr int LDS_BYTES = 64 + 131072;
static_assert(LDS_BYTES >= 8 * 3200 * 4 + 64, "naive NSA phase needs 102,464 B");

typedef __attribute__((address_space(4))) const Params* cparams_t;
__device__ __forceinline__ cparams_t params_ptr() {
    cparams_t pp = (cparams_t)__builtin_amdgcn_kernarg_segment_ptr();
    asm volatile("" : "+s"(pp));
    return pp;
}
constexpr long M1 = 1 << 20;
constexpr long F_U8 = 0, F_V8 = 4 * M1, F_SU = 21 * M1 + 3 * M1 / 8, F_SV = F_SU + 16384,
               F_WTIN = 16 * M1, F_WTUQ = 17 * M1, F_WTUKV = 17 * M1 + M1 / 8, F_W1TK = 17 * M1 + M1 / 4, F_W1TV = 17 * M1 + M1 / 2, F_W2TK = 17 * M1 + 3 * M1 / 4,
               F_W2TV = F_W2TK + 8192, F_CBIAS = F_W2TV + 8192, F_WTOUT = 18 * M1, F_WTQ = 18 * M1 + M1 / 2, F_SK16 = 19 * M1 + M1 / 2,
               F_SSQCQ = 19 * M1 + 5 * M1 / 8, F_SSQCKV = F_SSQCQ + 4 * 16384, F_SSQKR = F_SSQCKV + 2 * 16384, F_SSQA = 19 * M1 + 3 * M1 / 4, F_SSQB = F_SSQA + 8 * 16384,
               F_ROPE = 20 * M1, F_GATES = 21 * M1, F_KRR = 21 * M1 + M1 / 2,
               F_XN16 = 22 * M1, F_MIX = 22 * M1,
               F_Q16A = 30 * M1, F_KS16 = 34 * M1, F_KW16 = 35 * M1, F_VST16 = 36 * M1, F_VWT16 = 37 * M1, F_KCMP16 = 38 * M1, F_VCMP16 = 39 * M1 + M1 / 8,
               F_CQ16 = 40 * M1 + M1 / 4, F_CKV16 = 42 * M1 + M1 / 4,
               F_Q16 = 43 * M1 + M1 / 2, F_K16 = 49 * M1 + M1 / 2, F_VT16 = 55 * M1 + M1 / 2, F_HID = 59 * M1 + M1 / 2, F_KC16 = 63 * M1 + M1 / 2, F_VCT16 = F_KC16 + M1 / 8,
               F_HB = 30 * M1, F_HSS = 38 * M1, F_PSS = 38 * M1 + M1 / 2, F_EO = 39 * M1, F_GO = 41 * M1, F_PQB = 43 * M1 + M1 / 2;
static_assert(F_SSQKR + 16384 <= F_SSQA && F_SSQB + 8 * 16384 <= F_ROPE && F_VCT16 + M1 / 8 <= 64 * M1 - 16384 && F_CKV16 + M1 <= F_Q16 && F_PQB + 16 * M1 <= F_HID, "workspace map");

#define G(x) (x)
__global__ __launch_bounds__(512, 2) void mega(Params p_unused) {
    extern __shared__ __attribute__((aligned(16))) unsigned char lds_raw[];
    float* ldsf = (float*)(lds_raw + 64);
    { const unsigned bid_ = blockIdx.x; __builtin_assume(bid_ < (unsigned)NBLK); }
    if (threadIdx.x == 0) *(uint4*)lds_raw = make_uint4(0u, 0u, 0u, 0u);
    __syncthreads();
    XcdBarrier bar = xcd_barrier_post(params_ptr()->bar, (volatile LAS unsigned*)lds_raw);
#define GRID_SYNC() xcd_barrier(bar)
#define U16P(off) ((unsigned short*)(W + (off)))
    { cparams_t p = params_ptr(); float* W = p->W;
      p0_xn_rope(p->x, p->norm1_gain, p->positions, U16P(F_XN16), W + F_ROPE); }
    { cparams_t p = params_ptr(); float* W = p->W;
      cvt_transpose2<2>(ldsf, p->w_in, 1024, INW, U16P(F_WTIN), nullptr);
      zero_stream(U16P(F_WTIN) + (long)1720 * 1024, (long)72 * 1024); }
    { cparams_t p = params_ptr(); float* W = p->W;
      cvt_transpose2<0>(ldsf, p->mla_w_uq, 256, 768, U16P(F_WTUQ), p->mla_q_lora_gain);
      cvt_transpose2<0>(ldsf, p->mla_w_ukv, 128, 1024, U16P(F_WTUKV), p->mla_kv_lora_gain); }
    { cparams_t p = params_ptr(); float* W = p->W;
      cvt_transpose2<0>(ldsf, p->cmp_k_w1, 2048, 256, U16P(F_W1TK), nullptr);
      cvt_transpose2<0>(ldsf, p->cmp_v_w1, 2048, 256, U16P(F_W1TV), nullptr);
      cvt_transpose2<0>(ldsf, p->cmp_k_w2, 256, 64, U16P(F_W2TK), nullptr);
      cvt_transpose2<0>(ldsf, p->cmp_v_w2, 256, 64, U16P(F_W2TV), nullptr);
      p0_cbias(p->cmp_pos, p->cmp_k_w1, p->cmp_v_w1, W + F_CBIAS); }
    GRID_SYNC();
    { cparams_t p = params_ptr(); float* W = p->W;
      P1Out O; O.q16a = U16P(F_Q16A); O.ks16 = U16P(F_KS16); O.kw16 = U16P(F_KW16); O.vst16 = U16P(F_VST16); O.vwt16 = U16P(F_VWT16); O.kcmp16 = U16P(F_KCMP16); O.vcmp16 = U16P(F_VCMP16);
      O.cq16 = U16P(F_CQ16); O.ckv16 = U16P(F_CKV16); O.krr = W + F_KRR; O.ssq_kr = W + F_SSQKR; O.ssq_cq = W + F_SSQCQ; O.ssq_ckv = W + F_SSQCKV; O.gates = W + F_GATES;
      O.rope = W + F_ROPE; O.q_gain = p->nsa_q_gain; O.ks_gain = p->nsa_ks_gain; O.kw_gain = p->nsa_kw_gain; O.k_gain = p->mla_k_gain;
      p1_inproj_256(lds_raw + 64, U16P(F_XN16), U16P(F_WTIN), O); }
    GRID_SYNC();
    { cparams_t p = params_ptr(); float* W = p->W;
      P2Args A; A.cq16 = U16P(F_CQ16); A.ckv16 = U16P(F_CKV16); A.wt_uq = U16P(F_WTUQ); A.wt_ukv = U16P(F_WTUKV); A.kcmp16 = U16P(F_KCMP16); A.vcmp16 = U16P(F_VCMP16); A.w1t_k = U16P(F_W1TK); A.w1t_v = U16P(F_W1TV);
      A.ssq_cq = W + F_SSQCQ; A.ssq_ckv = W + F_SSQCKV; A.ssq_kr = W + F_SSQKR; A.krr = W + F_KRR; A.rope = W + F_ROPE; A.q_gain = p->mla_q_gain; A.k_gain = p->mla_k_gain;
      A.q16 = U16P(F_Q16); A.k16 = U16P(F_K16); A.vt16 = U16P(F_VT16); A.hid = W + F_HID;
      p2_phase(lds_raw + 64, A); }
    GRID_SYNC();
    { cparams_t p = params_ptr(); float* W = p->W;
      p3_cmp2(W + F_HID, W + F_CBIAS, U16P(F_W2TK), U16P(F_W2TV), p->nsa_kc_gain, W + F_ROPE, U16P(F_KC16), U16P(F_VCT16)); }
    if (blockIdx.x >= 16) {
      const int vb = blockIdx.x - 16, nb = NBLK - 16;
      { cparams_t p = params_ptr(); float* W = p->W;
        cvt_transpose<0>(ldsf, p->w_out, 1024, 1024, U16P(F_WTOUT), p->out_gain_a, p->out_gain_b, 512, vb, nb); }
      { cparams_t p = params_ptr(); float* W = p->W;
        cvt_transpose<0>(ldsf, p->peer_w_q, 1024, 2048, U16P(F_WTQ), p->norm2_gain, p->norm2_gain, 1 << 30, vb, nb); }
      { cparams_t p = params_ptr(); float* W = p->W;
        cvt_stream(p->peer_sub_keys, U16P(F_SK16), (long)8 * 2 * 128 * 128, vb, nb);
        cvt_rows_fp6(p->peer_u, (unsigned char*)(W + F_U8), W + F_SU, 16384, vb, nb);
        cvt_rows_fp6(p->peer_v, (unsigned char*)(W + F_V8), W + F_SV, 16384, vb, nb); }
    }
    GRID_SYNC();
    { cparams_t p = params_ptr(); float* W = p->W;
      nsa_phase(lds_raw + 64, U16P(F_Q16A), U16P(F_KC16), U16P(F_VCT16), U16P(F_KS16), U16P(F_VST16), U16P(F_KW16), U16P(F_VWT16), W + F_GATES, U16P(F_MIX), W + F_SSQA); }
    { cparams_t p = params_ptr(); float* W = p->W;
      mla_phase(lds_raw + 64, U16P(F_Q16), U16P(F_K16), U16P(F_VT16), U16P(F_MIX), W + F_SSQB); }
    GRID_SYNC();
    { cparams_t p = params_ptr(); float* W = p->W;
      p5_outproj_256(lds_raw + 64, U16P(F_MIX), U16P(F_WTOUT), W + F_SSQA, W + F_SSQB, p->x, p->out, U16P(F_HB), W + F_HSS); }
    GRID_SYNC();
    { cparams_t p = params_ptr(); float* W = p->W;
      p6_peerq_256(lds_raw + 64, U16P(F_HB), U16P(F_WTQ), W + F_HSS, U16P(F_PQB), W + F_PSS); }
    GRID_SYNC();
    { cparams_t p = params_ptr(); float* W = p->W;
      peer_route_mfma(lds_raw + 64, U16P(F_PQB), W + F_PSS, U16P(F_SK16), (int*)(W + F_EO), W + F_GO); }
    GRID_SYNC();
    { cparams_t p = params_ptr(); float* W = p->W;
      peer_sweep_a(W + F_HSS, p->norm2_gain, (const int*)(W + F_EO), W + F_GO, (const unsigned char*)(W + F_U8), W + F_SU, W + F_SV, p->out, W + F_PQB); }
    GRID_SYNC();
    { cparams_t p = params_ptr(); float* W = p->W;
      peer_sweep_b((const int*)(W + F_EO), W + F_PQB, (const unsigned char*)(W + F_V8), p->out); }
}

extern "C" void kernel_launch(void* const* d_in, const int* in_sizes, int n_in, void* d_out, int out_size, void* d_ws, size_t ws_size, hipStream_t stream) {
    (void)ws_size; (void)in_sizes; (void)n_in; (void)out_size;
    static int grid = 0;
    if (grid == 0) {
        int dev = 0, cus = 0, per_cu = 0;
        (void)hipGetDevice(&dev);
        (void)hipDeviceGetAttribute(&cus, hipDeviceAttributeMultiprocessorCount, dev);
        (void)hipFuncSetAttribute((const void*)mega, hipFuncAttributeMaxDynamicSharedMemorySize, LDS_BYTES);
        (void)hipOccupancyMaxActiveBlocksPerMultiprocessor(&per_cu, (const void*)mega, 512, LDS_BYTES);
        (void)hipGetLastError();
        if (per_cu < 1) fprintf(stderr, "kernel_launch: occupancy query reports %d blocks per CU\n", per_cu);
        if (cus != NBLK) fprintf(stderr, "kernel_launch: built for %d CUs, device reports %d\n", NBLK, cus);
        grid = NBLK;
    }
    Params p{};
    p.x = (const float*)d_in[0]; p.positions = (const int*)d_in[1]; p.norm1_gain = (const float*)d_in[2]; p.w_in = (const float*)d_in[3];
    p.nsa_q_gain = (const float*)d_in[4]; p.nsa_kc_gain = (const float*)d_in[5]; p.nsa_ks_gain = (const float*)d_in[6]; p.nsa_kw_gain = (const float*)d_in[7];
    p.cmp_pos = (const float*)d_in[8]; p.cmp_k_w1 = (const float*)d_in[9]; p.cmp_k_w2 = (const float*)d_in[10]; p.cmp_v_w1 = (const float*)d_in[11]; p.cmp_v_w2 = (const float*)d_in[12];
    p.mla_q_lora_gain = (const float*)d_in[13]; p.mla_w_uq = (const float*)d_in[14]; p.mla_kv_lora_gain = (const float*)d_in[15]; p.mla_w_ukv = (const float*)d_in[16];
    p.mla_q_gain = (const float*)d_in[17]; p.mla_k_gain = (const float*)d_in[18]; p.out_gain_a = (const float*)d_in[19]; p.out_gain_b = (const float*)d_in[20]; p.w_out = (const float*)d_in[21];
    p.norm2_gain = (const float*)d_in[22]; p.peer_w_q = (const float*)d_in[23]; p.peer_sub_keys = (const float*)d_in[24]; p.peer_u = (const float*)d_in[25]; p.peer_v = (const float*)d_in[26];
    p.out = (float*)d_out;
    p.bar = (unsigned*)d_ws;
    p.W = (float*)d_ws + 16384;
    (void)hipMemsetAsync(d_ws, 0, XCD_BAR_WORDS * sizeof(unsigned), stream);
    hipLaunchKernelGGL(mega, dim3(grid), dim3(512), LDS_BYTES, stream, p);
}
```

```cpp
#include <hip/hip_runtime.h>
#include <cmath>
#include <cstdint>
#include <cstdio>

#define XB_TMO      128
#define XB_XCNT(j)  (256  + 64 * (j))
#define XB_XSUB(j)  (1280 + 64 * (j))
#define XB_XGEN(j)  (2304 + 64 * (j))
#define XB_TOP      3328
#define XB_TOPGEN   3392
#define XCD_BAR_WORDS 3456
#define XB_SPIN_CAP (1u << 18)
#define LAS __attribute__((address_space(3)))

__device__ __forceinline__ unsigned xb_ld(unsigned* p)              { return __hip_atomic_load(p, __ATOMIC_RELAXED, __HIP_MEMORY_SCOPE_AGENT); }
__device__ __forceinline__ unsigned xb_add(unsigned* p, unsigned v) { return __hip_atomic_fetch_add(p, v, __ATOMIC_RELAXED, __HIP_MEMORY_SCOPE_AGENT); }
__device__ __forceinline__ unsigned xb_xcc_id() { return (unsigned)__builtin_amdgcn_s_getreg((3 << 11) | 20) & 0xFu; }
#define XB_SPIN(cond, bar) do { unsigned _sp = 0; while (cond) { __builtin_amdgcn_s_sleep(1); \
    if ((++_sp & 255u) == 0u) { if (xb_ld(&(bar)[XB_TMO])) break; if (_sp > XB_SPIN_CAP) { atomicAdd(&(bar)[XB_TMO], 1u); break; } } } } while (0)

struct XcdBarrier {
    unsigned* bar; unsigned x;
    volatile LAS unsigned* st;
};

__device__ __forceinline__ XcdBarrier xcd_barrier_post(unsigned* bar, volatile LAS unsigned* st) {
    XcdBarrier b; b.bar = bar; b.x = xb_xcc_id(); b.st = st;
    if (threadIdx.x == 0) (void)xb_add(&bar[XB_XCNT(b.x)], 1u);
    return b;
}
__device__ __forceinline__ void xcd_barrier_complete(unsigned* bar, unsigned x, unsigned& nloc, unsigned& nx) {
    const unsigned G = gridDim.x * gridDim.y * gridDim.z;
    unsigned sum, cnt, mine, sp = 0u;
    for (;;) {
        sum = 0u; cnt = 0u; mine = 0u;
#pragma unroll
        for (unsigned j = 0; j < 16; ++j) { const unsigned c = xb_ld(&bar[XB_XCNT(j)]); sum += c; cnt += (c > 0u) ? 1u : 0u; mine = (j == x) ? c : mine; }
        if (sum == G) break;
        __builtin_amdgcn_s_sleep(1);
        if ((++sp & 255u) == 0u) { if (xb_ld(&bar[XB_TMO])) break; if (sp > XB_SPIN_CAP) { atomicAdd(&bar[XB_TMO], 1u); break; } }
    }
    nloc = mine > 0u ? mine : 1u; nx = cnt > 0u ? cnt : 1u;
}

__device__ __forceinline__ void xcd_barrier(const XcdBarrier& b) {
    asm volatile("s_waitcnt vmcnt(0)" ::: "memory");
    __syncthreads();
    if (threadIdx.x == 0) {
        unsigned* bar = b.bar;
        __builtin_amdgcn_s_waitcnt(0);
        unsigned nloc = b.st[0], nx = b.st[1];
        if (nloc == 0u) { xcd_barrier_complete(bar, b.x, nloc, nx); b.st[0] = nloc; b.st[1] = nx; }
        const unsigned old = xb_add(&bar[XB_XSUB(b.x)], 1u);
        const unsigned gen = old / nloc;
        if (old + 1u == (gen + 1u) * nloc) {
            __builtin_amdgcn_fence(__ATOMIC_RELEASE, "agent");
            asm volatile("s_waitcnt vmcnt(0)" ::: "memory");
            const unsigned og = xb_add(&bar[XB_TOP], 1u);
            const unsigned tg = og / nx;
            if (og + 1u == (tg + 1u) * nx) xb_add(&bar[XB_TOPGEN], 1u);
            else XB_SPIN(xb_ld(&bar[XB_TOPGEN]) == tg, bar);
            __builtin_amdgcn_fence(__ATOMIC_ACQUIRE, "agent");
            xb_add(&bar[XB_XGEN(b.x)], 1u);
            asm volatile("s_waitcnt vmcnt(0)" ::: "memory");
        } else {
            XB_SPIN(xb_ld(&bar[XB_XGEN(b.x)]) == gen, bar);
            __builtin_amdgcn_fence(__ATOMIC_ACQUIRE, "agent");
            asm volatile("s_waitcnt vmcnt(0)" ::: "memory");
        }
    }
    __syncthreads();
}


#define AS1 __attribute__((address_space(1)))
constexpr int NBLK = 256;
constexpr int B_ = 2, S_ = 8192, T_ = B_ * S_, D_ = 1024, INW = 1720;
constexpr int G_ = 2, NCMP = 511;
constexpr float EPS = 1e-6f;
constexpr int C_Q = 0, C_KC = 512, C_VC = 640, C_KS = 768, C_VS = 896, C_KW = 1024, C_VW = 1152, C_GATE = 1280, C_CQ = 1304, C_CKV = 1560, C_KR = 1688;

#define WSYNC() do { __builtin_amdgcn_wave_barrier(); asm volatile("s_waitcnt lgkmcnt(0)" ::: "memory"); __builtin_amdgcn_wave_barrier(); } while (0)

__device__ __forceinline__ int tid_() { int t = threadIdx.x; asm volatile("" : "+v"(t)); return t; }
template <class T> __device__ __forceinline__ T* as_global(T* p) { return (T*)(__attribute__((address_space(1))) T*)p; }
__device__ __forceinline__ float wsum(float v) {
#pragma unroll
    for (int o = 32; o > 0; o >>= 1) v += __shfl_xor(v, o);
    return v;
}
__device__ __forceinline__ float wmax(float v) {
#pragma unroll
    for (int o = 32; o > 0; o >>= 1) v = fmaxf(v, __shfl_xor(v, o));
    return v;
}
__device__ __forceinline__ float gelu_tanh(float x) {
    const float u = 0.7978845608028654f * (x + 0.044715f * x * x * x);
    return 0.5f * x * (1.f + tanhf(u));
}

__device__ const float ROPE_F16[8] = {1.000000000e+00f, 1.939227432e-01f, 3.760603070e-02f, 7.292664610e-03f, 1.414213562e-03f, 2.742481884e-04f, 5.318296098e-05f, 1.031338616e-05f};
__device__ const float ROPE_F32[16] = {1.000000000e+00f, 4.403665960e-01f, 1.939227432e-01f, 8.539710194e-02f, 3.760603070e-02f, 1.656043902e-02f, 7.292664610e-03f, 3.211445874e-03f,
                                       1.414213562e-03f, 6.227723788e-04f, 2.742481884e-04f, 1.207697351e-04f, 5.318296098e-05f, 2.341999971e-05f, 1.031338616e-05f, 4.541670478e-06f};

typedef __attribute__((ext_vector_type(8))) short bf16x8;
typedef __attribute__((ext_vector_type(16))) float f32x16;
typedef __attribute__((ext_vector_type(2))) __bf16 bf16x2_t;
__device__ __forceinline__ unsigned cvtpk(float lo, float hi) { unsigned r; asm("v_cvt_pk_bf16_f32 %0, %1, %2" : "=v"(r) : "v"(lo), "v"(hi)); return r; }
__device__ __forceinline__ float bflo(unsigned u) { return __uint_as_float(u << 16); }
__device__ __forceinline__ float bfhi(unsigned u) { return __uint_as_float(u & 0xffff0000u); }
__device__ __forceinline__ float dot2bf(unsigned a, unsigned b, float c) { return __builtin_amdgcn_fdot2_f32_bf16(__builtin_bit_cast(bf16x2_t, a), __builtin_bit_cast(bf16x2_t, b), c, false); }

__device__ __forceinline__ float pair_max(float x) { auto rr = __builtin_amdgcn_permlane32_swap(__float_as_uint(x), __float_as_uint(x), false, false); return fmaxf(__uint_as_float(rr[0]), __uint_as_float(rr[1])); }
__device__ __forceinline__ float pair_sum(float x) { auto rr = __builtin_amdgcn_permlane32_swap(__float_as_uint(x), __float_as_uint(x), false, false); return __uint_as_float(rr[0]) + __uint_as_float(rr[1]); }
__device__ __forceinline__ float quad_sum(float x) {
    float y = x + __uint_as_float(__builtin_amdgcn_mov_dpp(__float_as_uint(x), 0xB1, 0xF, 0xF, true));
    return y + __uint_as_float(__builtin_amdgcn_mov_dpp(__float_as_uint(y), 0x4E, 0xF, 0xF, true));
}
#define MFMA32(a, b, c) __builtin_amdgcn_mfma_f32_32x32x16_bf16(a, b, c, 0, 0, 0)
typedef unsigned u32x4 __attribute__((ext_vector_type(4)));
constexpr int LDS_PITCH = 144;
__device__ __forceinline__ int crow(int r, int hi) { return (r & 3) + 8 * (r >> 2) + 4 * hi; }

template <int WM_, int WN_, int MI_, int NI_>
struct GemmShape {
    static constexpr int WM = WM_, WN = WN_, MI = MI_, NI = NI_;
    static constexpr int BM = WM * MI * 32, BN = WN * NI * 32, ROWS = BM + BN;
    static constexpr int CHUNKS = ROWS * 8 / 512;
    static constexpr int STAGE_BYTES = ROWS * LDS_PITCH;
    static_assert(WM * WN == 8 && (ROWS * 8) % 512 == 0, "8 waves; whole chunks per thread");
};
template <class SH, unsigned TOKMASK, int CUR>
__device__ __forceinline__ void gemm_step(unsigned char* lds, const unsigned short* const (&gp)[SH::CHUNKS], const int (&lo)[SH::CHUNKS], u32x4 (&g)[2][SH::CHUNKS],
                                          f32x16 (&acc)[SH::MI][SH::NI], int kt, int nk, int aoff, int boff) {
    const unsigned char* st = lds + (kt & 1) * SH::STAGE_BYTES;
    if (kt + 2 < nk) {
#pragma unroll
        for (int i = 0; i < SH::CHUNKS; ++i) g[CUR][i] = *(const u32x4*)(gp[i] + (long)(kt + 2) * 64);
    }
#pragma unroll
    for (int ks = 0; ks < 4; ++ks) {
        bf16x8 af[SH::MI], bfr[SH::NI];
#pragma unroll
        for (int mi = 0; mi < SH::MI; ++mi) af[mi] = *(const bf16x8*)(st + aoff + mi * 32 * LDS_PITCH + ks * 32);
#pragma unroll
        for (int ni = 0; ni < SH::NI; ++ni) bfr[ni] = *(const bf16x8*)(st + boff + ni * 32 * LDS_PITCH + ks * 32);
#pragma unroll
        for (int mi = 0; mi < SH::MI; ++mi)
#pragma unroll
            for (int ni = 0; ni < SH::NI; ++ni)
                acc[mi][ni] = ((TOKMASK >> ni) & 1u) ? MFMA32(bfr[ni], af[mi], acc[mi][ni]) : MFMA32(af[mi], bfr[ni], acc[mi][ni]);
    }
    if (kt + 1 < nk) {
        unsigned char* sn = lds + ((kt + 1) & 1) * SH::STAGE_BYTES;
#pragma unroll
        for (int i = 0; i < SH::CHUNKS; ++i) *(u32x4*)(sn + lo[i]) = g[CUR ^ 1][i];
    }
    __syncthreads();
}
template <class SH, unsigned TOKMASK>
__device__ __forceinline__ void gemm_mainloop(const unsigned short* __restrict__ A0, long lda, const unsigned short* __restrict__ B0, long ldb, int K,
                                              unsigned char* lds, f32x16 (&acc)[SH::MI][SH::NI], int tid) {
    const int lane = tid & 63, wave = __builtin_amdgcn_readfirstlane(tid >> 6), r32 = lane & 31, hi = lane >> 5;
    const int wm = wave / SH::WN, wn = wave % SH::WN;
    const unsigned short* gp[SH::CHUNKS]; int lo[SH::CHUNKS];
#pragma unroll
    for (int i = 0; i < SH::CHUNKS; ++i) {
        const int c = tid + i * 512, row = c >> 3, kc = c & 7;
        gp[i] = (row < SH::BM) ? (A0 + (long)row * lda + kc * 8) : (B0 + (long)(row - SH::BM) * ldb + kc * 8);
        lo[i] = row * LDS_PITCH + kc * 16;
    }
    u32x4 g[2][SH::CHUNKS];
    const int nk = K >> 6;
#pragma unroll
    for (int i = 0; i < SH::CHUNKS; ++i) { g[0][i] = *(const u32x4*)gp[i]; g[1][i] = *(const u32x4*)(gp[i] + 64); }
#pragma unroll
    for (int i = 0; i < SH::CHUNKS; ++i) *(u32x4*)(lds + lo[i]) = g[0][i];
    __syncthreads();
    const int aoff = (wm * SH::MI * 32 + r32) * LDS_PITCH + hi * 16;
    const int boff = (SH::BM + wn * SH::NI * 32 + r32) * LDS_PITCH + hi * 16;
    for (int kt = 0; kt < nk; kt += 2) {
        gemm_step<SH, TOKMASK, 0>(lds, gp, lo, g, acc, kt, nk, aoff, boff);
        gemm_step<SH, TOKMASK, 1>(lds, gp, lo, g, acc, kt + 1, nk, aoff, boff);
    }
}

typedef __attribute__((ext_vector_type(4))) float f32x4_t;
namespace g256 {
constexpr int BK = 64, HALF = 128, HT = HALF * BK;
__device__ __forceinline__ int lds_byte(int r, int c) { const int st = (r >> 4) * 2 + (c >> 5), rr = r & 15, cc = c & 31, ob = rr * 64 + cc * 2; return st * 1024 + (ob ^ (((ob >> 9) & 1) << 5)); }
__device__ __forceinline__ void stage_rc(int b, int& R, int& C) { const int st = b / 1024, sb = b % 1024, swz = sb ^ (((sb >> 9) & 1) << 5); R = (st >> 1) * 16 + swz / 64; C = (st & 1) * 32 + (swz % 64) / 2; }
template <int K, int PITCH = K>
__device__ __forceinline__ void mainloop(const unsigned short* __restrict__ A, const unsigned short* __restrict__ Bt, int brow, int bcol, unsigned short* shm, f32x4_t (&acc)[2][2][4][2]) {
#define SA(b, h) (shm + ((b) * 2 + (h)) * HT)
#define SB(b, h) (shm + (4 + (b) * 2 + (h)) * HT)
#define STAGE_X(T, P, BASE, br, kt) do { const AS1 char* ub_ = (const AS1 char*)(BASE) + ((long)(br) * PITCH + (long)(kt) * BK) * 2;     \
    for (int i_ = 0; i_ < 2; ++i_) { const int b_ = (T) * 16 + i_ * 8192; int r_, c_; stage_rc(b_, r_, c_); \
      __builtin_amdgcn_global_load_lds((const AS1 unsigned*)(ub_ + (unsigned)(r_ * PITCH + c_) * 2u), (LAS unsigned*)((LAS char*)(P) + b_), 16, 0, 0); } } while (0)
#define STAGE(P, BASE, br, kt) STAGE_X(tx, P, BASE, br, kt)
#define LDA(dst, b, h) for (int m = 0; m < 4; ++m) for (int k = 0; k < 2; ++k) dst[m][k] = *reinterpret_cast<const bf16x8*>((char*)SA(b, h) + lds_byte(wr * 64 + m * 16 + fr, k * 32 + fq * 8))
#define LDB(dst, b, h) for (int n = 0; n < 2; ++n) for (int k = 0; k < 2; ++k) dst[n][k] = *reinterpret_cast<const bf16x8*>((char*)SB(b, h) + lds_byte(wc * 32 + n * 16 + fr, k * 32 + fq * 8))
#define MMA(ai, bj, At_, Bt_) do { __builtin_amdgcn_s_setprio(1); \
    for (int m = 0; m < 4; ++m) for (int n = 0; n < 2; ++n) for (int k = 0; k < 2; ++k) acc[ai][bj][m][n] = __builtin_amdgcn_mfma_f32_16x16x32_bf16(At_[m][k], Bt_[n][k], acc[ai][bj][m][n], 0, 0, 0); \
    __builtin_amdgcn_s_setprio(0); } while (0)
#define WAIT_V(n) asm volatile("s_waitcnt vmcnt(" #n ")" ::: "memory")
#define WAIT_L(n) asm volatile("s_waitcnt lgkmcnt(" #n ")" ::: "memory")
#define BAR __builtin_amdgcn_s_barrier()
#define SCHED __builtin_amdgcn_sched_barrier(0)
    int tx = threadIdx.x; asm volatile("" : "+v"(tx));
    int wid = tx >> 6, lane = tx & 63, wr = wid >> 2, wc = wid & 3, fr = lane & 15, fq = lane >> 4;
    bf16x8 At[4][2], B0[2][2], B1[2][2];
    const int nt = K / BK;
    STAGE(SB(0, 0), Bt, bcol, 0); STAGE(SA(0, 0), A, brow, 0);
    STAGE(SB(0, 1), Bt, bcol + HALF, 0); STAGE(SA(0, 1), A, brow + HALF, 0);
    if (wr == 1) BAR;
    WAIT_V(4); BAR;
    STAGE(SB(1, 0), Bt, bcol, 1); STAGE(SA(1, 0), A, brow, 1); STAGE(SB(1, 1), Bt, bcol + HALF, 1);
    WAIT_V(6); BAR;
    for (int t = 0; t < nt - 2; t += 2) {
        LDB(B0, 0, 0); SCHED; LDA(At, 0, 0); STAGE(SA(1, 1), A, brow + HALF, t + 1);
        WAIT_L(8); BAR; WAIT_L(0); MMA(0, 0, At, B0); BAR; SCHED;
        LDB(B1, 0, 1); STAGE(SB(0, 0), Bt, bcol, t + 2);
        BAR; WAIT_L(0); MMA(0, 1, At, B1); BAR;
        LDA(At, 0, 1); STAGE(SA(0, 0), A, brow, t + 2);
        BAR; WAIT_L(0); MMA(1, 0, At, B0); BAR; SCHED;
        STAGE(SB(0, 1), Bt, bcol + HALF, t + 2);
        WAIT_V(6); BAR; MMA(1, 1, At, B1); BAR;
        LDB(B0, 1, 0); SCHED; LDA(At, 1, 0); STAGE(SA(0, 1), A, brow + HALF, t + 2);
        WAIT_L(8); BAR; WAIT_L(0); MMA(0, 0, At, B0); BAR; SCHED;
        LDB(B1, 1, 1); STAGE(SB(1, 0), Bt, bcol, t + 3);
        BAR; WAIT_L(0); MMA(0, 1, At, B1); BAR;
        LDA(At, 1, 1); STAGE(SA(1, 0), A, brow, t + 3);
        BAR; WAIT_L(0); MMA(1, 0, At, B0); BAR; SCHED;
        STAGE(SB(1, 1), Bt, bcol + HALF, t + 3);
        WAIT_V(6); BAR; MMA(1, 1, At, B1); BAR;
    }
    int tz = threadIdx.x; asm volatile("" : "+v"(tz)); wid = tz >> 6; lane = tz & 63; wr = wid >> 2; wc = wid & 3; fr = lane & 15; fq = lane >> 4;
    { LDB(B0, 0, 0); WAIT_V(0); LDA(At, 0, 0); STAGE_X(tz, SA(1, 1), A, brow + HALF, nt - 1);
      BAR; WAIT_L(0); MMA(0, 0, At, B0); BAR;
      LDB(B1, 0, 1); BAR; WAIT_L(0); MMA(0, 1, At, B1); BAR;
      LDA(At, 0, 1); WAIT_V(4); BAR; WAIT_L(0); MMA(1, 0, At, B0); MMA(1, 1, At, B1); BAR; }
    { LDB(B0, 1, 0); LDA(At, 1, 0); WAIT_V(2); BAR; WAIT_L(0); MMA(0, 0, At, B0); BAR;
      LDB(B1, 1, 1); WAIT_V(0); BAR; WAIT_L(0); MMA(0, 1, At, B1); BAR;
      LDA(At, 1, 1); BAR; WAIT_L(0); MMA(1, 0, At, B0); MMA(1, 1, At, B1); BAR; }
    if (wr == 0) BAR;
#undef SA
#undef SB
#undef STAGE_X
#undef STAGE
#undef LDA
#undef LDB
#undef MMA
#undef WAIT_V
#undef WAIT_L
#undef BAR
#undef SCHED
}
}

__device__ __forceinline__ void p5_outproj_256(unsigned char* lds, const unsigned short* __restrict__ mix, const unsigned short* __restrict__ wt_out, const float* __restrict__ ssqa, const float* __restrict__ ssqb,
                                               const float* __restrict__ x, float* __restrict__ out, unsigned short* __restrict__ hb, float* __restrict__ hss) {
    const int vcu = (blockIdx.x & 7) * (NBLK / 8) + (blockIdx.x >> 3);
    for (int tile = vcu; tile < 64 * 4; tile += NBLK) {
        const int m0 = (tile >> 2) * 256, n0 = (tile & 3) * 256;
        f32x4_t acc[2][2][4][2];
#pragma unroll
        for (int ai = 0; ai < 2; ++ai)
#pragma unroll
            for (int bj = 0; bj < 2; ++bj)
#pragma unroll
                for (int m = 0; m < 4; ++m)
#pragma unroll
                    for (int n = 0; n < 2; ++n) acc[ai][bj][m][n] = f32x4_t{0.f, 0.f, 0.f, 0.f};
        g256::mainloop<512, 1024>(wt_out, mix, n0, m0, (unsigned short*)lds, acc);
        float rb[2][2];
        {
            const int tid = tid_(); const int lane = tid & 63, wave = __builtin_amdgcn_readfirstlane(tid >> 6), wc = wave & 3, fr = lane & 15;
#pragma unroll
            for (int bj = 0; bj < 2; ++bj)
#pragma unroll
                for (int n = 0; n < 2; ++n) {
                    const long tok = m0 + bj * 128 + wc * 32 + n * 16 + fr; float sa = 0.f, sb = 0.f;
#pragma unroll
                    for (int hh = 0; hh < 8; ++hh) { sa += ssqa[(long)hh * T_ + tok]; sb += ssqb[(long)hh * T_ + tok]; }
                    rb[bj][n] = rsqrtf(sb * (1.f / 512.f) + EPS); const float ratio = rsqrtf(sa * (1.f / 512.f) + EPS) / rb[bj][n];
#pragma unroll
                    for (int ai = 0; ai < 2; ++ai)
#pragma unroll
                        for (int m = 0; m < 4; ++m) acc[ai][bj][m][n] *= ratio;
                }
        }
        g256::mainloop<512, 1024>(wt_out + 512, mix + 512, n0, m0, (unsigned short*)lds, acc);
        const int tid = tid_(); const int lane = tid & 63, wave = __builtin_amdgcn_readfirstlane(tid >> 6), wr = wave >> 2, wc = wave & 3, fr = lane & 15, fq = lane >> 4;
#pragma unroll
        for (int bj = 0; bj < 2; ++bj)
#pragma unroll
            for (int n = 0; n < 2; ++n) {
                const long tok = m0 + bj * 128 + wc * 32 + n * 16 + fr; const float r = rb[bj][n];
                float ss = 0.f;
#pragma unroll
                for (int ai = 0; ai < 2; ++ai)
#pragma unroll
                    for (int m = 0; m < 4; ++m) {
                        const int nrow = n0 + ai * 128 + wr * 64 + m * 16 + fq * 4;
                        const float4 xv = *(const float4*)(x + tok * 1024 + nrow);
                        float4 hv; hv.x = xv.x + acc[ai][bj][m][n][0] * r; hv.y = xv.y + acc[ai][bj][m][n][1] * r; hv.z = xv.z + acc[ai][bj][m][n][2] * r; hv.w = xv.w + acc[ai][bj][m][n][3] * r;
                        *(float4*)(out + tok * 1024 + nrow) = hv;
                        uint2 pk; pk.x = cvtpk(hv.x, hv.y); pk.y = cvtpk(hv.z, hv.w);
                        *(uint2*)(hb + tok * 1024 + nrow) = pk;
                        ss += hv.x * hv.x + hv.y * hv.y + hv.z * hv.z + hv.w * hv.w;
                    }
                { auto r1 = __builtin_amdgcn_permlane16_swap(__float_as_uint(ss), __float_as_uint(ss), false, false); ss = __uint_as_float(r1[0]) + __uint_as_float(r1[1]); }
                ss = pair_sum(ss);
                if (fq == 0) { hss[tok * 16 + (n0 >> 8) * 4 + wr] = ss; hss[tok * 16 + (n0 >> 8) * 4 + 2 + wr] = 0.f; }
            }
        __syncthreads();
    }
}
__device__ __forceinline__ void p6_peerq_256(unsigned char* lds, const unsigned short* __restrict__ hb, const unsigned short* __restrict__ wt_q, const float* __restrict__ hss,
                                             unsigned short* __restrict__ pqb, float* __restrict__ pss) {
    const int vcu = (blockIdx.x & 7) * (NBLK / 8) + (blockIdx.x >> 3);
    for (int tile = vcu; tile < 64 * 8; tile += NBLK) {
        const int m0 = (tile >> 3) * 256, n0 = (tile & 7) * 256;
        f32x4_t acc[2][2][4][2];
#pragma unroll
        for (int ai = 0; ai < 2; ++ai)
#pragma unroll
            for (int bj = 0; bj < 2; ++bj)
#pragma unroll
                for (int m = 0; m < 4; ++m)
#pragma unroll
                    for (int n = 0; n < 2; ++n) acc[ai][bj][m][n] = f32x4_t{0.f, 0.f, 0.f, 0.f};
        g256::mainloop<1024>(wt_q, hb, n0, m0, (unsigned short*)lds, acc);
        const int tid = tid_(); const int lane = tid & 63, wave = __builtin_amdgcn_readfirstlane(tid >> 6), wr = wave >> 2, wc = wave & 3, fr = lane & 15, fq = lane >> 4;
#pragma unroll
        for (int bj = 0; bj < 2; ++bj)
#pragma unroll
            for (int n = 0; n < 2; ++n) {
                const long tok = m0 + bj * 128 + wc * 32 + n * 16 + fr;
                const float4* hp = (const float4*)(hss + tok * 16);
                const float4 s0 = hp[0], s1 = hp[1], s2 = hp[2], s3 = hp[3];
                const float rs = rsqrtf((s0.x + s0.y + s0.z + s0.w + s1.x + s1.y + s1.z + s1.w + s2.x + s2.y + s2.z + s2.w + s3.x + s3.y + s3.z + s3.w) * (1.f / 1024.f) + EPS);
                float ss = 0.f;
#pragma unroll
                for (int ai = 0; ai < 2; ++ai)
#pragma unroll
                    for (int m = 0; m < 4; ++m) {
                        const int nrow = n0 + ai * 128 + wr * 64 + m * 16 + fq * 4;
                        const float v0 = acc[ai][bj][m][n][0] * rs, v1 = acc[ai][bj][m][n][1] * rs, v2 = acc[ai][bj][m][n][2] * rs, v3 = acc[ai][bj][m][n][3] * rs;
                        uint2 pk; pk.x = cvtpk(v0, v1); pk.y = cvtpk(v2, v3);
                        *(uint2*)(pqb + tok * 2048 + nrow) = pk;
                        ss += v0 * v0 + v1 * v1 + v2 * v2 + v3 * v3;
                    }
                { auto r1 = __builtin_amdgcn_permlane16_swap(__float_as_uint(ss), __float_as_uint(ss), false, false); ss = __uint_as_float(r1[0]) + __uint_as_float(r1[1]); }
                ss = pair_sum(ss);
                if (fq == 0) { pss[tok * 32 + (n0 >> 8) * 4 + wr] = ss; pss[tok * 32 + (n0 >> 8) * 4 + 2 + wr] = 0.f; }
            }
        __syncthreads();
    }
}

__device__ __forceinline__ unsigned ordkey(float f) { const unsigned u = __float_as_uint(f); return (u & 0x80000000u) ? ~u : (u | 0x80000000u); }
__device__ __forceinline__ float orddec(unsigned k) { return __uint_as_float((k & 0x80000000u) ? (k & 0x7fffffffu) : ~k); }
#define CE_DESC(a, b) do { const unsigned mx_ = max(a, b), mn_ = min(a, b); a = mx_; b = mn_; } while (0)
__device__ __forceinline__ void sort16_desc(unsigned (&v)[16]) {
#pragma unroll
    for (int k = 2; k <= 16; k <<= 1)
#pragma unroll
        for (int j = k >> 1; j > 0; j >>= 1)
#pragma unroll
            for (int i = 0; i < 16; ++i) {
                const int l = i ^ j;
                if (l > i) { if ((i & k) == 0) { CE_DESC(v[i], v[l]); } else { CE_DESC(v[l], v[i]); } }
            }
}
__device__ __forceinline__ void merge16_desc(unsigned (&a)[16], const unsigned (&b)[16]) {
#pragma unroll
    for (int i = 0; i < 16; ++i) a[i] = max(a[i], b[15 - i]);
#pragma unroll
    for (int j = 8; j > 0; j >>= 1)
#pragma unroll
        for (int i = 0; i < 16; ++i) { const int l = i ^ j; if (l > i) CE_DESC(a[i], a[l]); }
}
__device__ __forceinline__ void top16_of_lanepair(unsigned (&k0)[16], unsigned (&k1)[16], unsigned (&k2)[16], unsigned (&k3)[16]) {
    sort16_desc(k0); sort16_desc(k1); sort16_desc(k2); sort16_desc(k3);
    merge16_desc(k0, k1); merge16_desc(k2, k3); merge16_desc(k0, k2);
    unsigned o[16];
#pragma unroll
    for (int i = 0; i < 16; ++i) { auto rr = __builtin_amdgcn_permlane32_swap(k0[i], k0[i], false, false); k0[i] = rr[0]; o[i] = rr[1]; }
    merge16_desc(k0, o);
}
__device__ __forceinline__ void peer_route_mfma(unsigned char* lds, const unsigned short* __restrict__ pqb, const float* __restrict__ pss, const unsigned short* __restrict__ sk16, int* __restrict__ eo, float* __restrict__ go) {
    const int tid = tid_(); const int lane = tid & 63, w = __builtin_amdgcn_readfirstlane(tid >> 6), r32 = lane & 31, hi = lane >> 5;
    const int h = blockIdx.x & 7;
    constexpr int SKP = 272;
    for (int c16 = tid; c16 < 256 * 16; c16 += 512) { const int row = c16 >> 4, ch = c16 & 15; *(uint4*)(lds + row * SKP + ch * 16) = *(const uint4*)(sk16 + ((long)h * 256 + row) * 128 + ch * 8); }
    __syncthreads();
    for (int it = 0; it < 2; ++it) {
        const long tok = (long)((blockIdx.x >> 3) * 16 + w * 2 + it) * 32 + r32;
        const float4 ps = *(const float4*)(pss + tok * 32 + h * 4);
        const float rs = rsqrtf((ps.x + ps.y + ps.z + ps.w) * (1.f / 256.f) + EPS);
        unsigned T1[16], T2[16];
#pragma unroll
        for (int c = 0; c < 2; ++c) {
            f32x16 acc[4];
#pragma unroll
            for (int mt = 0; mt < 4; ++mt)
#pragma unroll
                for (int r = 0; r < 16; ++r) acc[mt][r] = 0.f;
            const unsigned short* qrow = pqb + tok * 2048 + h * 256 + c * 128 + hi * 8;
            const unsigned char* krow = lds + (c * 128 + r32) * SKP + hi * 16;
#pragma unroll 2
            for (int ks = 0; ks < 8; ++ks) {
                const bf16x8 qf = *(const bf16x8*)(qrow + ks * 16);
#pragma unroll
                for (int mt = 0; mt < 4; ++mt) { const bf16x8 kf = *(const bf16x8*)(krow + mt * 32 * SKP + ks * 32); acc[mt] = MFMA32(kf, qf, acc[mt]); }
            }
            unsigned k0[16], k1[16], k2[16], k3[16];
#pragma unroll
            for (int r = 0; r < 16; ++r) {
                const unsigned idx = 127u - (unsigned)crow(r, hi);
                k0[r] = (ordkey(acc[0][r] * rs) & ~127u) | idx; k1[r] = (ordkey(acc[1][r] * rs) & ~127u) | (idx - 32u);
                k2[r] = (ordkey(acc[2][r] * rs) & ~127u) | (idx - 64u); k3[r] = (ordkey(acc[3][r] * rs) & ~127u) | (idx - 96u);
            }
            top16_of_lanepair(k0, k1, k2, k3);
            if (c == 0) {
#pragma unroll
                for (int i = 0; i < 16; ++i) T1[i] = k0[i];
            } else {
#pragma unroll
                for (int i = 0; i < 16; ++i) T2[i] = k0[i];
            }
        }
        float v1[16], v2[16]; unsigned p1[4] = {0u, 0u, 0u, 0u}, p2[4] = {0u, 0u, 0u, 0u};
#pragma unroll
        for (int i = 0; i < 16; ++i) {
            v1[i] = orddec(T1[i] & ~127u); v2[i] = orddec(T2[i] & ~127u);
            p1[i >> 2] |= (127u - (T1[i] & 127u)) << (8 * (i & 3)); p2[i >> 2] |= (127u - (T2[i] & 127u)) << (8 * (i & 3));
        }
        unsigned c0[16], c1[16], c2[16], c3[16];
#define CAND(a, b) ((ordkey(v1[a] + v2[b]) & ~255u) | (255u - (unsigned)((a) * 16 + (b))))
        c0[0] = CAND(0, 0); c0[1] = CAND(0, 1); c0[2] = CAND(0, 2); c0[3] = CAND(0, 3); c0[4] = CAND(0, 4); c0[5] = CAND(0, 5); c0[6] = CAND(0, 6); c0[7] = CAND(0, 7);
        c0[8] = CAND(0, 8); c0[9] = CAND(0, 9); c0[10] = CAND(0, 10); c0[11] = CAND(0, 11); c0[12] = CAND(0, 12); c0[13] = CAND(0, 13); c0[14] = CAND(0, 14); c0[15] = CAND(0, 15);
        c1[0] = CAND(1, 0); c1[1] = CAND(1, 1); c1[2] = CAND(1, 2); c1[3] = CAND(1, 3); c1[4] = CAND(1, 4); c1[5] = CAND(1, 5); c1[6] = CAND(1, 6); c1[7] = CAND(1, 7);
        c1[8] = CAND(2, 0); c1[9] = CAND(2, 1); c1[10] = CAND(2, 2); c1[11] = CAND(2, 3); c1[12] = CAND(2, 4); c1[13] = CAND(3, 0); c1[14] = CAND(3, 1); c1[15] = CAND(3, 2);
        c2[0] = CAND(3, 3); c2[1] = CAND(4, 0); c2[2] = CAND(4, 1); c2[3] = CAND(4, 2); c2[4] = CAND(5, 0); c2[5] = CAND(5, 1); c2[6] = CAND(6, 0); c2[7] = CAND(6, 1);
        c2[8] = CAND(7, 0); c2[9] = CAND(7, 1); c2[10] = CAND(8, 0); c2[11] = CAND(9, 0); c2[12] = CAND(10, 0); c2[13] = CAND(11, 0); c2[14] = CAND(12, 0); c2[15] = CAND(13, 0);
        c3[0] = CAND(14, 0); c3[1] = CAND(15, 0);
#pragma unroll
        for (int i = 2; i < 16; ++i) c3[i] = 0u;
#undef CAND
        sort16_desc(c0); sort16_desc(c1); sort16_desc(c2); sort16_desc(c3);
        merge16_desc(c0, c1); merge16_desc(c2, c3); merge16_desc(c0, c2);
        float ev[16]; int ee[16]; float l = 0.f; const float mx = orddec(c0[0] & ~255u);
#pragma unroll
        for (int i = 0; i < 16; ++i) {
            const unsigned ci = 255u - (c0[i] & 255u); const unsigned a = ci >> 4, b = ci & 15u;
            const unsigned wa = (a >> 2) == 0 ? p1[0] : ((a >> 2) == 1 ? p1[1] : ((a >> 2) == 2 ? p1[2] : p1[3]));
            const unsigned wb = (b >> 2) == 0 ? p2[0] : ((b >> 2) == 1 ? p2[1] : ((b >> 2) == 2 ? p2[2] : p2[3]));
            const unsigned i1 = (wa >> (8 * (a & 3u))) & 255u, i2 = (wb >> (8 * (b & 3u))) & 255u;
            ee[i] = (int)(i1 * 128u + i2);
            ev[i] = __expf(orddec(c0[i] & ~255u) - mx); l += ev[i];
        }
        const float inv = 1.f / l;
        if (hi == 0) {
            int4* ep = (int4*)(eo + tok * 128 + h * 16);
            ep[0] = make_int4(ee[0], ee[1], ee[2], ee[3]); ep[1] = make_int4(ee[4], ee[5], ee[6], ee[7]); ep[2] = make_int4(ee[8], ee[9], ee[10], ee[11]); ep[3] = make_int4(ee[12], ee[13], ee[14], ee[15]);
        } else {
            float4* gp = (float4*)(go + tok * 128 + h * 16);
            gp[0] = make_float4(ev[0] * inv, ev[1] * inv, ev[2] * inv, ev[3] * inv); gp[1] = make_float4(ev[4] * inv, ev[5] * inv, ev[6] * inv, ev[7] * inv);
            gp[2] = make_float4(ev[8] * inv, ev[9] * inv, ev[10] * inv, ev[11] * inv); gp[3] = make_float4(ev[12] * inv, ev[13] * inv, ev[14] * inv, ev[15] * inv);
        }
    }
}

template <int DQK>
struct FA {
    static constexpr int NDS = DQK / 16, KP = DQK * 2 + 16, KBYTES = 64 * KP, VP = 144, VBYTES = 64 * VP, STAGE = KBYTES + VBYTES;
    static constexpr int KCH = 64 * DQK / 8, NCH = KCH + 512, SLOTS = (NCH + 511) / 512;
};
constexpr float FA_THR = 8.f;
constexpr float FA_NEG = -1e30f;
struct FaRegs { uint4 g0, g1, g2; };
template <int DQK>
__device__ __forceinline__ uint4 fa_load1(const unsigned short* __restrict__ Kg, int kpitch, const unsigned short* __restrict__ Vg, int vpitch, int tid, int i) {
    int c = tid + i * 512; if (c >= FA<DQK>::NCH) c = 0;
    const int key = c / (DQK / 8), kc = c % (DQK / 8); const int c2 = c - FA<DQK>::KCH; const int d = c2 >> 3, vc = c2 & 7;
    const unsigned koff = (unsigned)(key * kpitch + kc * 8) * 2u, voff = (unsigned)(d * vpitch + vc * 8) * 2u;
#if defined(__HIP_DEVICE_COMPILE__)
    typedef unsigned u32x4_t __attribute__((ext_vector_type(4)));
    const u32x4_t v = (c < FA<DQK>::KCH) ? *(const AS1 u32x4_t*)((const AS1 char*)Kg + koff) : *(const AS1 u32x4_t*)((const AS1 char*)Vg + voff);
    return make_uint4(v.x, v.y, v.z, v.w);
#else
    (void)koff; (void)voff; return make_uint4(0u, 0u, 0u, 0u);
#endif
}
template <int DQK>
__device__ __forceinline__ void fa_store1(unsigned char* st, const uint4& g, int tid, int i) {
    const int c = tid + i * 512;
    const int key = c / (DQK / 8), kc = c % (DQK / 8); const int c2 = c - FA<DQK>::KCH; const int d = c2 >> 3, vc = c2 & 7;
    const int off = (c < FA<DQK>::KCH) ? (key * FA<DQK>::KP + kc * 16) : (FA<DQK>::KBYTES + d * FA<DQK>::VP + vc * 16);
    if (c < FA<DQK>::NCH) *(uint4*)(st + off) = g;
}
template <int DQK>
__device__ __forceinline__ void fa_load(const unsigned short* __restrict__ Kg, int kpitch, const unsigned short* __restrict__ Vg, int vpitch, FaRegs& g, int tid) {
    g.g0 = fa_load1<DQK>(Kg, kpitch, Vg, vpitch, tid, 0); g.g1 = fa_load1<DQK>(Kg, kpitch, Vg, vpitch, tid, 1);
    if (FA<DQK>::SLOTS > 2) g.g2 = fa_load1<DQK>(Kg, kpitch, Vg, vpitch, tid, 2);
}
template <int DQK>
__device__ __forceinline__ void fa_store(unsigned char* st, const FaRegs& g, int tid) {
    fa_store1<DQK>(st, g.g0, tid, 0); fa_store1<DQK>(st, g.g1, tid, 1);
    if (FA<DQK>::SLOTS > 2) fa_store1<DQK>(st, g.g2, tid, 2);
}
template <int DQK, int MODE, bool STATS_ONLY = false>
__device__ __forceinline__ void fa_tile(const unsigned char* st, const bf16x8 (&qf)[FA<DQK>::NDS], f32x16 (&o)[2], float& mref, float& l, int key0, int qpos, int lane, bool need_mask, bool colsel = true) {
    asm volatile("" : "+v"(lane));
    const int r32 = lane & 31, hi = lane >> 5;
    f32x16 s0, s1;
#pragma unroll
    for (int r = 0; r < 16; ++r) { s0[r] = 0.f; s1[r] = 0.f; }
    {
        bf16x8 k0 = *(const bf16x8*)(st + r32 * FA<DQK>::KP + hi * 16);
        bf16x8 k1 = *(const bf16x8*)(st + (32 + r32) * FA<DQK>::KP + hi * 16);
#pragma unroll
        for (int ds = 0; ds < FA<DQK>::NDS; ++ds) {
            bf16x8 n0 = k0, n1 = k1;
            if (ds + 1 < FA<DQK>::NDS) {
                n0 = *(const bf16x8*)(st + r32 * FA<DQK>::KP + (ds + 1) * 32 + hi * 16);
                n1 = *(const bf16x8*)(st + (32 + r32) * FA<DQK>::KP + (ds + 1) * 32 + hi * 16);
            }
            s0 = MFMA32(k0, qf[ds], s0); s1 = MFMA32(k1, qf[ds], s1);
            k0 = n0; k1 = n1;
            __builtin_amdgcn_sched_barrier(0);
        }
    }
    __builtin_amdgcn_sched_barrier(0);
    if (MODE != 0 && need_mask) {
#pragma unroll
        for (int r = 0; r < 16; ++r) {
            const int ka = key0 + crow(r, hi), kb = ka + 32;
            bool ma, mb;
            if (MODE == 4) { ma = 16 * ka + 31 > qpos; mb = 16 * kb + 31 > qpos; }
            else { ma = ka > qpos; mb = kb > qpos; }
            if (MODE == 2) { ma = ma || (ka <= qpos - 512); mb = mb || (kb <= qpos - 512); }
            if (ma) s0[r] = -INFINITY;
            if (mb) s1[r] = -INFINITY;
        }
    }
    if (MODE == 3) {
        if (!colsel) {
#pragma unroll
            for (int r = 0; r < 16; ++r) { s0[r] = -INFINITY; s1[r] = -INFINITY; }
        }
    }
    float mx = fmaxf(s0[0], s1[0]);
#pragma unroll
    for (int r = 1; r < 16; ++r) mx = fmaxf(mx, fmaxf(s0[r], s1[r]));
    mx = pair_max(mx);
    if (__any(mx > mref + FA_THR)) {
        const float mnew = (mx > mref + FA_THR) ? mx : mref;
        const float alpha = __builtin_amdgcn_exp2f(mref - mnew);
        mref = mnew; l *= alpha;
#pragma unroll
        for (int r = 0; r < 16; ++r) { o[0][r] *= alpha; o[1][r] *= alpha; }
    }
    float ps = 0.f;
#pragma unroll
    for (int r = 0; r < 16; ++r) { s0[r] = __builtin_amdgcn_exp2f(s0[r] - mref); s1[r] = __builtin_amdgcn_exp2f(s1[r] - mref); ps += s0[r] + s1[r]; }
    l += ps;
    if (STATS_ONLY) return;
    bf16x8 pk[4];
#pragma unroll
    for (int s = 0; s < 2; ++s) {
        uint4 a, b;
        a.x = cvtpk(s0[8 * s], s0[8 * s + 1]); a.y = cvtpk(s0[8 * s + 2], s0[8 * s + 3]); a.z = cvtpk(s0[8 * s + 4], s0[8 * s + 5]); a.w = cvtpk(s0[8 * s + 6], s0[8 * s + 7]);
        b.x = cvtpk(s1[8 * s], s1[8 * s + 1]); b.y = cvtpk(s1[8 * s + 2], s1[8 * s + 3]); b.z = cvtpk(s1[8 * s + 4], s1[8 * s + 5]); b.w = cvtpk(s1[8 * s + 6], s1[8 * s + 7]);
        pk[s] = __builtin_bit_cast(bf16x8, a); pk[2 + s] = __builtin_bit_cast(bf16x8, b);
    }
    const unsigned char* vt = st + FA<DQK>::KBYTES;
    __builtin_amdgcn_sched_barrier(0);
    {
        bf16x8 v0 = *(const bf16x8*)(vt + r32 * FA<DQK>::VP + hi * 16);
        bf16x8 v1 = *(const bf16x8*)(vt + (32 + r32) * FA<DQK>::VP + hi * 16);
#pragma unroll
        for (int ks = 0; ks < 4; ++ks) {
            bf16x8 n0 = v0, n1 = v1;
            if (ks + 1 < 4) {
                n0 = *(const bf16x8*)(vt + r32 * FA<DQK>::VP + (ks + 1) * 32 + hi * 16);
                n1 = *(const bf16x8*)(vt + (32 + r32) * FA<DQK>::VP + (ks + 1) * 32 + hi * 16);
            }
            o[0] = MFMA32(v0, pk[ks], o[0]); o[1] = MFMA32(v1, pk[ks], o[1]);
            v0 = n0; v1 = n1;
            __builtin_amdgcn_sched_barrier(0);
        }
    }
}
template <int DQK>
__device__ __forceinline__ void fa_qk(const unsigned char* st, const bf16x8 (&qf)[FA<DQK>::NDS], f32x16& s0, f32x16& s1, int lane) {
    const int r32 = lane & 31, hi = lane >> 5;
#pragma unroll
    for (int r = 0; r < 16; ++r) { s0[r] = 0.f; s1[r] = 0.f; }
#pragma unroll
    for (int ds = 0; ds < FA<DQK>::NDS; ++ds) {
        const bf16x8 k0 = *(const bf16x8*)(st + r32 * FA<DQK>::KP + ds * 32 + hi * 16);
        const bf16x8 k1 = *(const bf16x8*)(st + (32 + r32) * FA<DQK>::KP + ds * 32 + hi * 16);
        s0 = MFMA32(k0, qf[ds], s0); s1 = MFMA32(k1, qf[ds], s1);
    }
}
template <int DQK, int MODE>
__device__ __forceinline__ void fa_step(const unsigned char* stc, const unsigned char* stn, const bf16x8 (&qf)[FA<DQK>::NDS], f32x16& s0, f32x16& s1, f32x16& n0, f32x16& n1,
                                        f32x16 (&o)[2], float& mref, float& l, int key0, int qpos, int lane, bool need_mask, bool colsel = true) {
    const int r32 = lane & 31, hi = lane >> 5;
    if (MODE != 0 && need_mask) {
#pragma unroll
        for (int r = 0; r < 16; ++r) {
            const int ka = key0 + crow(r, hi), kb = ka + 32;
            bool ma, mb;
            if (MODE == 4) { ma = 16 * ka + 31 > qpos; mb = 16 * kb + 31 > qpos; }
            else { ma = ka > qpos; mb = kb > qpos; }
            if (MODE == 2) { ma = ma || (ka <= qpos - 512); mb = mb || (kb <= qpos - 512); }
            if (ma) s0[r] = -INFINITY;
            if (mb) s1[r] = -INFINITY;
        }
    }
    if (MODE == 3) {
        if (!colsel) {
#pragma unroll
            for (int r = 0; r < 16; ++r) { s0[r] = -INFINITY; s1[r] = -INFINITY; }
        }
    }
    float mx = fmaxf(s0[0], s1[0]);
#pragma unroll
    for (int r = 1; r < 16; ++r) mx = fmaxf(mx, fmaxf(s0[r], s1[r]));
    mx = pair_max(mx);
    if (__any(mx > mref + FA_THR)) {
        const float mnew = (mx > mref + FA_THR) ? mx : mref;
        const float alpha = __builtin_amdgcn_exp2f(mref - mnew);
        mref = mnew; l *= alpha;
#pragma unroll
        for (int r = 0; r < 16; ++r) { o[0][r] *= alpha; o[1][r] *= alpha; }
    }
    __builtin_amdgcn_sched_barrier(0);
#pragma unroll
    for (int r = 0; r < 16; ++r) { n0[r] = 0.f; n1[r] = 0.f; }
    float ps = 0.f;
    constexpr int PER = (32 + FA<DQK>::NDS - 1) / FA<DQK>::NDS;
    {
        bf16x8 k0 = *(const bf16x8*)(stn + r32 * FA<DQK>::KP + hi * 16);
        bf16x8 k1 = *(const bf16x8*)(stn + (32 + r32) * FA<DQK>::KP + hi * 16);
#pragma unroll
        for (int ds = 0; ds < FA<DQK>::NDS; ++ds) {
            bf16x8 f0 = k0, f1 = k1;
            if (ds + 1 < FA<DQK>::NDS) {
                f0 = *(const bf16x8*)(stn + r32 * FA<DQK>::KP + (ds + 1) * 32 + hi * 16);
                f1 = *(const bf16x8*)(stn + (32 + r32) * FA<DQK>::KP + (ds + 1) * 32 + hi * 16);
            }
            n0 = MFMA32(k0, qf[ds], n0); n1 = MFMA32(k1, qf[ds], n1);
#pragma unroll
            for (int j = ds * PER; j < (ds + 1) * PER && j < 32; ++j) {
                if (j < 16) { s0[j] = __builtin_amdgcn_exp2f(s0[j] - mref); ps += s0[j]; }
                else { s1[j - 16] = __builtin_amdgcn_exp2f(s1[j - 16] - mref); ps += s1[j - 16]; }
            }
            asm volatile("" : "+v"(ps));
            k0 = f0; k1 = f1;
            __builtin_amdgcn_sched_barrier(0);
        }
    }
    l += ps;
    bf16x8 pk[4];
#pragma unroll
    for (int s = 0; s < 2; ++s) {
        uint4 a, b;
        a.x = cvtpk(s0[8 * s], s0[8 * s + 1]); a.y = cvtpk(s0[8 * s + 2], s0[8 * s + 3]); a.z = cvtpk(s0[8 * s + 4], s0[8 * s + 5]); a.w = cvtpk(s0[8 * s + 6], s0[8 * s + 7]);
        b.x = cvtpk(s1[8 * s], s1[8 * s + 1]); b.y = cvtpk(s1[8 * s + 2], s1[8 * s + 3]); b.z = cvtpk(s1[8 * s + 4], s1[8 * s + 5]); b.w = cvtpk(s1[8 * s + 6], s1[8 * s + 7]);
        pk[s] = __builtin_bit_cast(bf16x8, a); pk[2 + s] = __builtin_bit_cast(bf16x8, b);
    }
    const unsigned char* vt = stc + FA<DQK>::KBYTES;
    {
        bf16x8 v0 = *(const bf16x8*)(vt + r32 * FA<DQK>::VP + hi * 16);
        bf16x8 v1 = *(const bf16x8*)(vt + (32 + r32) * FA<DQK>::VP + hi * 16);
#pragma unroll
        for (int ks = 0; ks < 4; ++ks) {
            bf16x8 f0 = v0, f1 = v1;
            if (ks + 1 < 4) {
                f0 = *(const bf16x8*)(vt + r32 * FA<DQK>::VP + (ks + 1) * 32 + hi * 16);
                f1 = *(const bf16x8*)(vt + (32 + r32) * FA<DQK>::VP + (ks + 1) * 32 + hi * 16);
            }
            o[0] = MFMA32(v0, pk[ks], o[0]); o[1] = MFMA32(v1, pk[ks], o[1]);
            v0 = f0; v1 = f1;
            __builtin_amdgcn_sched_barrier(0);
        }
    }
}
__device__ __forceinline__ int vperm(int s) { const int g = (s >> 2) & 3; const int pg = (g == 1) ? 2 : ((g == 2) ? 1 : g); return (s & ~15) | (pg << 2) | (s & 3); }

constexpr float MLA_QSCALE = 0.10206207261596575f * 1.4426950408889634f;
__device__ __forceinline__ void mla_unit(unsigned char* lds, int b, int h, int qb, const unsigned short* __restrict__ Q16, const unsigned short* __restrict__ K16, const unsigned short* __restrict__ VT16,
                                         unsigned short* __restrict__ ob16, float* __restrict__ ssqb, int tid) {
    typedef FA<96> F;
    const int lane = tid & 63, wave = __builtin_amdgcn_readfirstlane(tid >> 6), r32 = lane & 31, hi = lane >> 5;
    const int q0 = qb * 256, qpos = q0 + wave * 32 + r32; const long tok = (long)b * S_ + qpos;
    bf16x8 qf[F::NDS];
#pragma unroll
    for (int ds = 0; ds < F::NDS; ++ds) qf[ds] = *(const bf16x8*)(Q16 + tok * 768 + h * 96 + ds * 16 + hi * 8);
    f32x16 o[2];
#pragma unroll
    for (int r = 0; r < 16; ++r) { o[0][r] = 0.f; o[1][r] = 0.f; }
    float mref = FA_NEG, l = 0.f;
    const unsigned short* Kb = K16 + ((long)(b * 8 + h)) * S_ * 96;
    const unsigned short* Vb = VT16 + ((long)(b * 8 + h)) * 64 * S_;
    const int nt = (q0 + 256) / 64;
    FaRegs g;
    fa_load<96>(Kb, 96, Vb, S_, g, tid); fa_store<96>(lds, g, tid);
    fa_load<96>(Kb + (long)64 * 96, 96, Vb + 64, S_, g, tid); fa_store<96>(lds + F::STAGE, g, tid);
    __syncthreads();
    const int wmin = q0 + wave * 32, wmax = wmin + 31;
    f32x16 sa0, sa1, sb0, sb1;
    fa_qk<96>(lds, qf, sa0, sa1, lane);
#define MLA_STEP(C0, C1, N0, N1, t) do { \
        const int sc_ = (t) % 3, sn_ = ((t) + 1) % 3, sw_ = ((t) + 2) % 3; \
        if ((t) + 2 < nt) fa_load<96>(Kb + (long)((t) + 2) * 64 * 96, 96, Vb + ((t) + 2) * 64, S_, g, tid); \
        const int key0 = (t) * 64; \
        if (key0 <= wmax) fa_step<96, 1>(lds + sc_ * F::STAGE, lds + sn_ * F::STAGE, qf, C0, C1, N0, N1, o, mref, l, key0, qpos, lane, key0 + 63 > wmin); \
        if ((t) + 2 < nt) fa_store<96>(lds + sw_ * F::STAGE, g, tid); \
        __syncthreads(); } while (0)
    for (int t = 0; t < nt; t += 2) {
        MLA_STEP(sa0, sa1, sb0, sb1, t);
        MLA_STEP(sb0, sb1, sa0, sa1, t + 1);
    }
#undef MLA_STEP
    l = pair_sum(l);
    const float inv = 1.f / l;
    float ss = 0.f;
#pragma unroll
    for (int dt = 0; dt < 2; ++dt)
#pragma unroll
        for (int gq = 0; gq < 4; ++gq) {
            const float v0 = o[dt][4 * gq] * inv, v1 = o[dt][4 * gq + 1] * inv, v2 = o[dt][4 * gq + 2] * inv, v3 = o[dt][4 * gq + 3] * inv;
            uint2 pk; pk.x = cvtpk(v0, v1); pk.y = cvtpk(v2, v3);
            *(uint2*)(ob16 + tok * 1024 + 512 + h * 64 + dt * 32 + 8 * gq + 4 * hi) = pk;
            ss += v0 * v0 + v1 * v1 + v2 * v2 + v3 * v3;
        }
    ss = pair_sum(ss);
    if (hi == 0) ssqb[(long)h * T_ + tok] = ss;
}
__device__ __forceinline__ void mla_phase(unsigned char* lds, const unsigned short* __restrict__ Q16, const unsigned short* __restrict__ K16, const unsigned short* __restrict__ VT16,
                                          unsigned short* __restrict__ ob16, float* __restrict__ ssqb) {
    const int tid = tid_();
    for (int i = blockIdx.x; i < 256; i += NBLK) {
        const int xcd = i & 7, slot = i >> 3;
        { const int bh = xcd * 2; mla_unit(lds, bh >> 3, bh & 7, 31 - slot, Q16, K16, VT16, ob16, ssqb, tid); }
        { const int bh = xcd * 2 + 1; mla_unit(lds, bh >> 3, bh & 7, slot, Q16, K16, VT16, ob16, ssqb, tid); }
    }
}
constexpr float NSA_QSCALE = 0.125f * 1.4426950408889634f;
constexpr int IMP_PITCH = 129;
__device__ __forceinline__ void fa_tile_cmp2(const unsigned char* st, const bf16x8 (&qf)[4], f32x16 (&o)[2], float mref, float linv, int key0, int qpos, int lane, float* imp_row) {
    typedef FA<64> F;
    asm volatile("" : "+v"(lane));
    const int r32 = lane & 31, hi = lane >> 5;
    f32x16 s0, s1;
#pragma unroll
    for (int r = 0; r < 16; ++r) { s0[r] = 0.f; s1[r] = 0.f; }
#pragma unroll
    for (int ds = 0; ds < 4; ++ds) {
        const bf16x8 k0 = *(const bf16x8*)(st + r32 * F::KP + ds * 32 + hi * 16);
        const bf16x8 k1 = *(const bf16x8*)(st + (32 + r32) * F::KP + ds * 32 + hi * 16);
        s0 = MFMA32(k0, qf[ds], s0); s1 = MFMA32(k1, qf[ds], s1);
    }
#pragma unroll
    for (int r = 0; r < 16; ++r) {
        const int ka = key0 + crow(r, hi), kb = ka + 32;
        s0[r] = (16 * ka + 31 > qpos) ? 0.f : __builtin_amdgcn_exp2f(s0[r] - mref) * linv;
        s1[r] = (16 * kb + 31 > qpos) ? 0.f : __builtin_amdgcn_exp2f(s1[r] - mref) * linv;
    }
    bf16x8 pk[4];
#pragma unroll
    for (int s = 0; s < 2; ++s) {
        uint4 a, b;
        a.x = cvtpk(s0[8 * s], s0[8 * s + 1]); a.y = cvtpk(s0[8 * s + 2], s0[8 * s + 3]); a.z = cvtpk(s0[8 * s + 4], s0[8 * s + 5]); a.w = cvtpk(s0[8 * s + 6], s0[8 * s + 7]);
        b.x = cvtpk(s1[8 * s], s1[8 * s + 1]); b.y = cvtpk(s1[8 * s + 2], s1[8 * s + 3]); b.z = cvtpk(s1[8 * s + 4], s1[8 * s + 5]); b.w = cvtpk(s1[8 * s + 6], s1[8 * s + 7]);
        pk[s] = __builtin_bit_cast(bf16x8, a); pk[2 + s] = __builtin_bit_cast(bf16x8, b);
    }
    const unsigned char* vt = st + F::KBYTES;
#pragma unroll
    for (int ks = 0; ks < 4; ++ks) {
        const bf16x8 v0 = *(const bf16x8*)(vt + r32 * F::VP + ks * 32 + hi * 16);
        const bf16x8 v1 = *(const bf16x8*)(vt + (32 + r32) * F::VP + ks * 32 + hi * 16);
        o[0] = MFMA32(v0, pk[ks], o[0]); o[1] = MFMA32(v1, pk[ks], o[1]);
    }
#pragma unroll
    for (int r = 0; r < 16; ++r) {
        s0[r] = quad_sum(s0[r]); s1[r] = quad_sum(s1[r]);
    }
    if ((lane & 3) == 0) {
#pragma unroll
        for (int g4 = 0; g4 < 4; ++g4) {
            { const int j = (key0 + 8 * g4 + 4 * hi) >> 2;
              atomicAdd(imp_row + j, s0[4 * g4] + s0[4 * g4 + 1] + s0[4 * g4 + 2] + s0[4 * g4 + 3]);
              if (j + 1 < 128) atomicAdd(imp_row + j + 1, s0[4 * g4 + 3]); }
            { const int j = (key0 + 32 + 8 * g4 + 4 * hi) >> 2;
              atomicAdd(imp_row + j, s1[4 * g4] + s1[4 * g4 + 1] + s1[4 * g4 + 2] + s1[4 * g4 + 3]);
              if (j + 1 < 128) atomicAdd(imp_row + j + 1, s1[4 * g4 + 3]); }
        }
    }
}
#define NSA_STEP_(GCUR, GNEXT, Kbase, kpitch, Vbase, vpitch, t_lo, t_hi, t_, ...) do { \
        const unsigned char* st = stg + (((t_) - (t_lo)) & 1) * FA<64>::STAGE; \
        if ((t_) + 2 <= (t_hi)) fa_load<64>((Kbase) + (long)((t_) + 2) * 64 * (kpitch), (kpitch), (Vbase) + ((t_) + 2) * 64, (vpitch), GCUR, tid); \
        const int key0 = (t_) * 64; (void)key0; \
        __VA_ARGS__ \
        if ((t_) + 1 <= (t_hi)) fa_store<64>(stg + (((t_) + 1 - (t_lo)) & 1) * FA<64>::STAGE, GNEXT, tid); \
        __syncthreads(); } while (0)
#define NSA_STREAM(Kbase, kpitch, Vbase, vpitch, t_lo, t_hi, ...) do { \
    FaRegs ga_, gb_; fa_load<64>((Kbase) + (long)(t_lo) * 64 * (kpitch), (kpitch), (Vbase) + (t_lo) * 64, (vpitch), ga_, tid); \
    if ((t_lo) + 1 <= (t_hi)) fa_load<64>((Kbase) + (long)((t_lo) + 1) * 64 * (kpitch), (kpitch), (Vbase) + ((t_lo) + 1) * 64, (vpitch), gb_, tid); \
    fa_store<64>(stg, ga_, tid); __syncthreads(); \
    for (int t_ = (t_lo); t_ <= (t_hi); t_ += 2) { \
        NSA_STEP_(ga_, gb_, Kbase, kpitch, Vbase, vpitch, t_lo, t_hi, t_, __VA_ARGS__); \
        if (t_ + 1 <= (t_hi)) { const int tt_ = t_ + 1; NSA_STEP2_(gb_, ga_, Kbase, kpitch, Vbase, vpitch, t_lo, t_hi, tt_, __VA_ARGS__); } \
    } } while (0)
#define NSA_STEP2_(GCUR, GNEXT, Kbase, kpitch, Vbase, vpitch, t_lo, t_hi, tq_, ...) do { \
        const int t_ = tq_; \
        const unsigned char* st = stg + ((t_ - (t_lo)) & 1) * FA<64>::STAGE; \
        if (t_ + 2 <= (t_hi)) fa_load<64>((Kbase) + (long)(t_ + 2) * 64 * (kpitch), (kpitch), (Vbase) + (t_ + 2) * 64, (vpitch), GCUR, tid); \
        const int key0 = t_ * 64; (void)key0; \
        __VA_ARGS__ \
        if (t_ + 1 <= (t_hi)) fa_store<64>(stg + ((t_ + 1 - (t_lo)) & 1) * FA<64>::STAGE, GNEXT, tid); \
        __syncthreads(); } while (0)

__device__ __forceinline__ void nsa_unit(unsigned char* lds, int b, int g, int qblk, const unsigned short* __restrict__ Q16A, const unsigned short* __restrict__ KC16, const unsigned short* __restrict__ VCT16,
                                         const unsigned short* __restrict__ KS16, const unsigned short* __restrict__ VST16, const unsigned short* __restrict__ KW16, const unsigned short* __restrict__ VWT16,
                                         const float* __restrict__ gates, unsigned short* __restrict__ oa16, float* __restrict__ ssqa, int tid) {
    typedef FA<64> F;
    const int lane = tid & 63, wave = __builtin_amdgcn_readfirstlane(tid >> 6), r32 = lane & 31, hi = lane >> 5;
    unsigned char* stg = lds;
    float* imp = (float*)(lds + 2 * F::STAGE);
    unsigned* selm = (unsigned*)(lds + 2 * F::STAGE + 64 * IMP_PITCH * 4);
    const int q0 = qblk * 64, cur = qblk;
    const int ql = wave * 8 + (r32 >> 2), hh = g * 4 + (r32 & 3), qpos = q0 + ql; const long tok = (long)b * S_ + qpos; const int bg = b * 2 + g;
    bf16x8 qf[4];
#pragma unroll
    for (int ds = 0; ds < 4; ++ds) qf[ds] = *(const bf16x8*)(Q16A + tok * 512 + hh * 64 + ds * 16 + hi * 8);
    for (int i = tid; i < 64 * IMP_PITCH; i += 512) imp[i] = 0.f;
    f32x16 acc[2], o[2];
#pragma unroll
    for (int r = 0; r < 16; ++r) { acc[0][r] = 0.f; acc[1][r] = 0.f; }
    const int wq_lo = q0 + wave * 8, wq_hi = wq_lo + 7;
    const int nvis_max = (q0 + 63 >= 31) ? ((q0 + 63 - 31) / 16 + 1) : 0;
    if (nvis_max > 0) {
        const int tc_hi = (nvis_max - 1) >> 6;
        const unsigned short* Kc = KC16 + (long)bg * 512 * 64; const unsigned short* Vc = VCT16 + (long)bg * 64 * 512;
        float mref = FA_NEG, l = 0.f;
        NSA_STREAM(Kc, 64, Vc, 512, 0, tc_hi, {
            if (16 * key0 + 31 <= wq_hi) fa_tile<64, 4, true>(st, qf, o, mref, l, key0, qpos, lane, 16 * (key0 + 63) + 31 > wq_lo);
        });
        l = pair_sum(l);
        const float linv = (l > 0.f) ? 1.f / l : 0.f;
#pragma unroll
        for (int r = 0; r < 16; ++r) { o[0][r] = 0.f; o[1][r] = 0.f; }
        NSA_STREAM(Kc, 64, Vc, 512, 0, tc_hi, {
            if (16 * key0 + 31 <= wq_hi) fa_tile_cmp2(st, qf, o, mref, linv, key0, qpos, lane, imp + ql * IMP_PITCH);
        });
        const float g_c = gates[tok * 24 + hh * 3];
#pragma unroll
        for (int r = 0; r < 16; ++r) { acc[0][r] += g_c * o[0][r]; acc[1][r] += g_c * o[1][r]; }
    } else { __syncthreads(); }
    if (wave < 2) {
        const int qi = wave * 32 + r32;
        int his = hi; asm volatile("" : "+v"(his));
#define IMPKEY(jj) ({ const int j_ = (jj); const float v_ = (j_ == 0 || j_ == cur) ? 1e9f : ((j_ > cur) ? -1e30f : imp[qi * IMP_PITCH + j_]); (ordkey(v_) & ~127u) | (127u - (unsigned)j_); })
        unsigned k0[16];
        {
            unsigned k1[16];
#pragma unroll
            for (int i = 0; i < 16; ++i) { k0[i] = IMPKEY(his * 64 + i); k1[i] = IMPKEY(his * 64 + 16 + i); }
            sort16_desc(k0); sort16_desc(k1); merge16_desc(k0, k1);
        }
        __builtin_amdgcn_sched_barrier(0);
        {
            unsigned k2[16], k3[16];
#pragma unroll
            for (int i = 0; i < 16; ++i) { k2[i] = IMPKEY(his * 64 + 32 + i); k3[i] = IMPKEY(his * 64 + 48 + i); }
            sort16_desc(k2); sort16_desc(k3); merge16_desc(k2, k3); merge16_desc(k0, k2);
        }
#undef IMPKEY
        {
            unsigned o2[16];
#pragma unroll
            for (int i = 0; i < 16; ++i) { auto rr = __builtin_amdgcn_permlane32_swap(k0[i], k0[i], false, false); k0[i] = rr[0]; o2[i] = rr[1]; }
            merge16_desc(k0, o2);
        }
        unsigned m0 = 0u, m1 = 0u, m2 = 0u, m3 = 0u;
#pragma unroll
        for (int i = 0; i < 16; ++i) {
            const unsigned j = 127u - (k0[i] & 127u); const unsigned bit = 1u << (j & 31u); const unsigned wsel = j >> 5;
            m0 |= (wsel == 0u) ? bit : 0u; m1 |= (wsel == 1u) ? bit : 0u; m2 |= (wsel == 2u) ? bit : 0u; m3 |= (wsel == 3u) ? bit : 0u;
        }
        if (hi == 0) { selm[qi * 4] = m0; selm[qi * 4 + 1] = m1; selm[qi * 4 + 2] = m2; selm[qi * 4 + 3] = m3; }
    }
    __syncthreads();
    unsigned sm0 = selm[ql * 4], sm1 = selm[ql * 4 + 1], sm2 = selm[ql * 4 + 2], sm3 = selm[ql * 4 + 3];
    {
        float mref = FA_NEG, l = 0.f;
#pragma unroll
        for (int r = 0; r < 16; ++r) { o[0][r] = 0.f; o[1][r] = 0.f; }
        const unsigned short* Ks = KS16 + (long)bg * S_ * 64; const unsigned short* Vs = VST16 + (long)bg * 64 * S_;
        NSA_STREAM(Ks, 64, Vs, S_, 0, cur, {
            const int jw = t_ >> 5; const unsigned wsel = (jw == 0) ? sm0 : ((jw == 1) ? sm1 : ((jw == 2) ? sm2 : sm3));
            const bool colsel = (wsel >> (t_ & 31)) & 1u;
            if (__any(colsel)) fa_tile<64, 3>(st, qf, o, mref, l, key0, qpos, lane, t_ == cur, colsel);
        });
        l = pair_sum(l);
        const float sc = gates[tok * 24 + hh * 3 + 1] / l;
#pragma unroll
        for (int r = 0; r < 16; ++r) { acc[0][r] += sc * o[0][r]; acc[1][r] += sc * o[1][r]; }
    }
    {
        float mref = FA_NEG, l = 0.f;
#pragma unroll
        for (int r = 0; r < 16; ++r) { o[0][r] = 0.f; o[1][r] = 0.f; }
        const unsigned short* Kw = KW16 + (long)bg * S_ * 64; const unsigned short* Vw = VWT16 + (long)bg * 64 * S_;
        const int tw_lo = (cur >= 8) ? cur - 8 : 0;
        NSA_STREAM(Kw, 64, Vw, S_, tw_lo, cur, {
            fa_tile<64, 2>(st, qf, o, mref, l, key0, qpos, lane, (t_ == cur) || (t_ == cur - 8));
        });
        l = pair_sum(l);
        const float sc = gates[tok * 24 + hh * 3 + 2] / l;
#pragma unroll
        for (int r = 0; r < 16; ++r) { acc[0][r] += sc * o[0][r]; acc[1][r] += sc * o[1][r]; }
    }
    float ss = 0.f;
#pragma unroll
    for (int dt = 0; dt < 2; ++dt)
#pragma unroll
        for (int gq = 0; gq < 4; ++gq) {
            const float v0 = acc[dt][4 * gq], v1 = acc[dt][4 * gq + 1], v2 = acc[dt][4 * gq + 2], v3 = acc[dt][4 * gq + 3];
            uint2 pk; pk.x = cvtpk(v0, v1); pk.y = cvtpk(v2, v3);
            *(uint2*)(oa16 + tok * 1024 + hh * 64 + dt * 32 + 8 * gq + 4 * hi) = pk;
            ss += v0 * v0 + v1 * v1 + v2 * v2 + v3 * v3;
        }
    ss = pair_sum(ss);
    if (hi == 0) ssqa[(long)hh * T_ + tok] = ss;
    __syncthreads();
}
__device__ __forceinline__ void nsa_phase(unsigned char* lds, const unsigned short* __restrict__ Q16A, const unsigned short* __restrict__ KC16, const unsigned short* __restrict__ VCT16,
                                          const unsigned short* __restrict__ KS16, const unsigned short* __restrict__ VST16, const unsigned short* __restrict__ KW16, const unsigned short* __restrict__ VWT16,
                                          const float* __restrict__ gates, unsigned short* __restrict__ oa16, float* __restrict__ ssqa) {
    const int tid = tid_();
    for (int i = blockIdx.x; i < 256; i += NBLK) {
        const int xcd = i & 7, slot = i >> 3; const int bg = xcd >> 1, pr = (xcd & 1) * 32 + slot;
        nsa_unit(lds, bg >> 1, bg & 1, 127 - pr, Q16A, KC16, VCT16, KS16, VST16, KW16, VWT16, gates, oa16, ssqa, tid);
        nsa_unit(lds, bg >> 1, bg & 1, pr, Q16A, KC16, VCT16, KS16, VST16, KW16, VWT16, gates, oa16, ssqa, tid);
    }
}
__device__ __forceinline__ int nmap_in2(int n) {
    if (n < 768) return n;
    if (n < 896) return n;
    if (n < 1024) return n - 896 + 1024;
    if (n < 1152) return n - 1024 + 896;
    if (n < 1280) return n;
    if (n < 1304) return n - 1280 + 1696;
    if (n < 1560) return n - 1304 + 1280;
    if (n < 1688) return n - 1560 + 1536;
    return n - 1688 + 1664;
}
struct XT { const float* src; unsigned short* dst; const float* glo; const float* ghi; int K, N, ksplit, tile, nmap; };
__device__ __forceinline__ XT xt_make(const float* src, int K, int N, unsigned short* dst, const float* glo, const float* ghi, int ksplit, int nmap, int tile) {
    XT d; d.src = src; d.dst = dst; d.glo = glo; d.ghi = ghi; d.K = K; d.N = N; d.ksplit = ksplit; d.tile = tile; d.nmap = nmap; return d;
}
__device__ __forceinline__ void xt_load(const XT& d, float (&v)[8], int tid) {
    if (d.tile < 0) return;
    const int tn = (d.N + 63) >> 6; const int k0 = (d.tile / tn) * 64, n0 = (d.tile % tn) * 64;
    const float* __restrict__ s = as_global(d.src);
#pragma unroll
    for (int i = 0; i < 8; ++i) {
        const int kl = (tid >> 6) + 8 * i, n = n0 + (tid & 63), k = k0 + kl;
        float x = (n < d.N) ? s[(long)k * d.N + n] : 0.f;
        if (d.glo) x *= (k < d.ksplit) ? d.glo[k] : d.ghi[k - d.ksplit];
        v[i] = x;
    }
}
__device__ __forceinline__ void xt_store(const XT& d, const float (&v)[8], float* buf, int tid) {
    if (d.tile < 0) return;
    float (*tl)[65] = (float (*)[65])buf;
    const int tn = (d.N + 63) >> 6; const int k0 = (d.tile / tn) * 64, n0 = (d.tile % tn) * 64;
#pragma unroll
    for (int i = 0; i < 8; ++i) tl[(tid >> 6) + 8 * i][tid & 63] = v[i];
    __syncthreads();
    const int nl = tid >> 3, kc = (tid & 7) * 8; const int n = n0 + nl;
    if (n < d.N) {
        uint4 o; o.x = cvtpk(tl[kc][nl], tl[kc + 1][nl]); o.y = cvtpk(tl[kc + 2][nl], tl[kc + 3][nl]); o.z = cvtpk(tl[kc + 4][nl], tl[kc + 5][nl]); o.w = cvtpk(tl[kc + 6][nl], tl[kc + 7][nl]);
        const int nn = d.nmap ? nmap_in2(n) : n;
        *(uint4*)(d.dst + (long)nn * d.K + k0 + kc) = o;
    }
}
#define XT_RUN4(ldsf_, MAKE) do { const int tid_x = tid_(); float xv0[8], xv1[8], xv2[8], xv3[8]; \
    const XT xd0 = MAKE(0), xd1 = MAKE(1), xd2 = MAKE(2), xd3 = MAKE(3); \
    xt_load(xd0, xv0, tid_x); xt_load(xd1, xv1, tid_x); xt_load(xd2, xv2, tid_x); xt_load(xd3, xv3, tid_x); \
    xt_store(xd0, xv0, (ldsf_), tid_x); xt_store(xd1, xv1, (ldsf_) + 64 * 65, tid_x); xt_store(xd2, xv2, (ldsf_), tid_x); xt_store(xd3, xv3, (ldsf_) + 64 * 65, tid_x); __syncthreads(); } while (0)
__device__ __forceinline__ void p0_xn_rope(const float* __restrict__ x, const float* __restrict__ g1, const int* __restrict__ positions, unsigned short* __restrict__ xn16, float* __restrict__ rope) {
    const int tid = tid_(); const int lane = tid & 63, w = __builtin_amdgcn_readfirstlane(tid >> 6);
    const f32x4_t* gp = (const f32x4_t*)g1; const f32x4_t ga0 = gp[lane * 2], ga1 = gp[lane * 2 + 1], gb0 = gp[128 + lane * 2], gb1 = gp[128 + lane * 2 + 1];
    for (int t0 = blockIdx.x * 8 + w; t0 < T_; t0 += 4 * NBLK * 8) {
        f32x4_t v[4][4]; int pos[4];
#pragma unroll
        for (int j = 0; j < 4; ++j) {
            const int t = t0 + j * NBLK * 8;
            const f32x4_t* xp = (const f32x4_t*)(x + (long)t * 1024);
            v[j][0] = xp[lane * 2]; v[j][1] = xp[lane * 2 + 1]; v[j][2] = xp[128 + lane * 2]; v[j][3] = xp[128 + lane * 2 + 1];
            pos[j] = positions[t];
        }
#pragma unroll
        for (int j = 0; j < 4; ++j) {
            const int t = t0 + j * NBLK * 8;
            const f32x4_t a0 = v[j][0], a1 = v[j][1], b0 = v[j][2], b1 = v[j][3];
            float ss = a0.x * a0.x + a0.y * a0.y + a0.z * a0.z + a0.w * a0.w + a1.x * a1.x + a1.y * a1.y + a1.z * a1.z + a1.w * a1.w
                     + b0.x * b0.x + b0.y * b0.y + b0.z * b0.z + b0.w * b0.w + b1.x * b1.x + b1.y * b1.y + b1.z * b1.z + b1.w * b1.w;
            ss = wsum(ss); const float rs = rsqrtf(ss * (1.f / 1024.f) + EPS);
            uint4 pa, pb;
            pa.x = cvtpk(a0.x * rs * ga0.x, a0.y * rs * ga0.y); pa.y = cvtpk(a0.z * rs * ga0.z, a0.w * rs * ga0.w); pa.z = cvtpk(a1.x * rs * ga1.x, a1.y * rs * ga1.y); pa.w = cvtpk(a1.z * rs * ga1.z, a1.w * rs * ga1.w);
            pb.x = cvtpk(b0.x * rs * gb0.x, b0.y * rs * gb0.y); pb.y = cvtpk(b0.z * rs * gb0.z, b0.w * rs * gb0.w); pb.z = cvtpk(b1.x * rs * gb1.x, b1.y * rs * gb1.y); pb.w = cvtpk(b1.z * rs * gb1.z, b1.w * rs * gb1.w);
            ((uint4*)(xn16 + (long)t * 1024))[lane] = pa; ((uint4*)(xn16 + (long)t * 1024))[64 + lane] = pb;
            if (lane < 24) {
                const float f = lane < 8 ? ROPE_F16[lane] : ROPE_F32[lane - 8];
                const float angf = (float)pos[j] * f;
                const double ang = (double)angf; const double k = rint(ang * 0.15915494309189535);
                const float r = (float)(ang - k * 6.283185307179586);
                const float c = cosf(r), sn = sinf(r);
                if (lane < 8) { rope[(long)t * 48 + lane] = c; rope[(long)t * 48 + 8 + lane] = sn; }
                else { rope[(long)t * 48 + 16 + lane - 8] = c; rope[(long)t * 48 + 32 + lane - 8] = sn; }
            }
        }
    }
}
__device__ __forceinline__ void p0_cbias(const float* __restrict__ pos, const float* __restrict__ w1k, const float* __restrict__ w1v, float* __restrict__ cbias) {
    const int tid = tid_(); const int lane = tid & 63, w = __builtin_amdgcn_readfirstlane(tid >> 6);
    for (int task = blockIdx.x * 8 + w; task < 512; task += NBLK * 8) {
        const int mat = task >> 8, n = task & 255; const float* w1 = mat ? w1v : w1k;
        float acc = 0.f;
#pragma unroll 8
        for (int i = 0; i < 32; ++i) { const int k = lane + 64 * i; acc += pos[k] * w1[(long)k * 256 + n]; }
        acc = wsum(acc);
        if (lane == 0) cbias[task] = acc;
    }
}
__device__ __forceinline__ void zero_stream(unsigned short* __restrict__ p, long n) {
    const int tid = tid_();
    for (long c = (long)blockIdx.x * 512 + tid; c < (n >> 3); c += (long)NBLK * 512) ((uint4*)p)[c] = make_uint4(0u, 0u, 0u, 0u);
}

struct P1Out {
    unsigned short *q16a, *ks16, *kw16, *vst16, *vwt16, *kcmp16, *vcmp16, *cq16, *ckv16;
    float *krr, *ssq_kr, *ssq_cq, *ssq_ckv, *gates;
    const float *rope, *q_gain, *ks_gain, *kw_gain, *k_gain;
};
__device__ __forceinline__ void norm_rope64(f32x16& a0, f32x16& a1, const float* __restrict__ gain, const float* __restrict__ rope_t, int hi, float outscale) {
    float ss = 0.f;
#pragma unroll
    for (int r = 0; r < 16; ++r) ss += a0[r] * a0[r] + a1[r] * a1[r];
    ss = pair_sum(ss);
    const float rs = rsqrtf(ss * (1.f / 64.f) + EPS);
#pragma unroll
    for (int g = 0; g < 4; ++g) {
        const float4 g0 = *(const float4*)(gain + 8 * g + 4 * hi), g1 = *(const float4*)(gain + 32 + 8 * g + 4 * hi);
        a0[4 * g] *= rs * g0.x; a0[4 * g + 1] *= rs * g0.y; a0[4 * g + 2] *= rs * g0.z; a0[4 * g + 3] *= rs * g0.w;
        a1[4 * g] *= rs * g1.x; a1[4 * g + 1] *= rs * g1.y; a1[4 * g + 2] *= rs * g1.z; a1[4 * g + 3] *= rs * g1.w;
    }
    const float4 c4 = *(const float4*)(rope_t + 4 * hi), s4 = *(const float4*)(rope_t + 8 + 4 * hi);
    const float cc[4] = {c4.x, c4.y, c4.z, c4.w}, sn[4] = {s4.x, s4.y, s4.z, s4.w};
#pragma unroll
    for (int j = 0; j < 4; ++j) { const float x1 = a0[j], x2 = a0[4 + j]; a0[j] = x1 * cc[j] - x2 * sn[j]; a0[4 + j] = x2 * cc[j] + x1 * sn[j]; }
#pragma unroll
    for (int r = 0; r < 16; ++r) { a0[r] *= outscale; a1[r] *= outscale; }
}
__device__ __forceinline__ void store_row64(unsigned short* __restrict__ dst, const f32x16& a0, const f32x16& a1, int hi) {
#pragma unroll
    for (int g = 0; g < 4; ++g) {
        uint2 p0, p1; p0.x = cvtpk(a0[4 * g], a0[4 * g + 1]); p0.y = cvtpk(a0[4 * g + 2], a0[4 * g + 3]); p1.x = cvtpk(a1[4 * g], a1[4 * g + 1]); p1.y = cvtpk(a1[4 * g + 2], a1[4 * g + 3]);
        *(uint2*)(dst + 8 * g + 4 * hi) = p0; *(uint2*)(dst + 32 + 8 * g + 4 * hi) = p1;
    }
}
__device__ __forceinline__ float ssq64(const f32x16& a0, const f32x16& a1) {
    float ss = 0.f;
#pragma unroll
    for (int r = 0; r < 16; ++r) ss += a0[r] * a0[r] + a1[r] * a1[r];
    return pair_sum(ss);
}
__device__ __forceinline__ float sum4fq(float v) {
    auto r1 = __builtin_amdgcn_permlane16_swap(__float_as_uint(v), __float_as_uint(v), false, false);
    return pair_sum(__uint_as_float(r1[0]) + __uint_as_float(r1[1]));
}
#define P1V(m, j) acc[ai][bj][m][n][j]
__device__ __forceinline__ void p1_inproj_256(unsigned char* lds, const unsigned short* __restrict__ xn16, const unsigned short* __restrict__ wt_in, const P1Out& Oin) {
    const P1Out O = Oin;
    const int tbase = (blockIdx.x & 7) * 56;
    for (int tile = tbase + (blockIdx.x >> 3); tile < tbase + 56; tile += 32) {
        const int mt = tile / 7, nt = tile % 7; const int m0 = mt * 256;
        f32x4_t acc[2][2][4][2];
#pragma unroll
        for (int ai = 0; ai < 2; ++ai)
#pragma unroll
            for (int bj = 0; bj < 2; ++bj)
#pragma unroll
                for (int m = 0; m < 4; ++m)
#pragma unroll
                    for (int n = 0; n < 2; ++n) acc[ai][bj][m][n] = f32x4_t{0.f, 0.f, 0.f, 0.f};
        if (nt == 4) g256::mainloop<1024>(xn16, wt_in, m0, nt * 256, (unsigned short*)lds, acc);
        else g256::mainloop<1024>(wt_in, xn16, nt * 256, m0, (unsigned short*)lds, acc);
        const int tid = tid_(); const int lane = tid & 63, wave = __builtin_amdgcn_readfirstlane(tid >> 6), wr = wave >> 2, wc = wave & 3, fr = lane & 15, fq = lane >> 4;
        if (nt == 4) {
#pragma unroll
            for (int bj = 0; bj < 2; ++bj)
#pragma unroll
                for (int n = 0; n < 2; ++n) {
                    const int pc = bj * 2 + (wc >> 1), d = (wc & 1) * 32 + n * 16 + fr;
                    unsigned short* vt = (pc < 2) ? O.vst16 : O.vwt16; const int g = pc & 1;
#pragma unroll
                    for (int ai = 0; ai < 2; ++ai)
#pragma unroll
                        for (int m = 0; m < 4; ++m) {
                            const int tb = m0 + ai * 128 + wr * 64 + m * 16 + fq * 4; const int b = tb / S_, s0 = tb % S_;
                            uint2 pk; pk.x = cvtpk(P1V(m, 0), P1V(m, 1)); pk.y = cvtpk(P1V(m, 2), P1V(m, 3));
                            *(uint2*)(vt + ((long)(b * 2 + g) * 64 + d) * S_ + vperm(s0)) = pk;
                        }
                }
        } else {
#pragma unroll
            for (int ai = 0; ai < 2; ++ai) {
                const int pc = ai * 2 + wr;
#pragma unroll
                for (int bj = 0; bj < 2; ++bj)
#pragma unroll
                    for (int n = 0; n < 2; ++n) {
                        const long tok = m0 + bj * 128 + wc * 32 + n * 16 + fr; const int b = (int)(tok / S_), s = (int)(tok % S_);
                        const float* rope_t = O.rope + tok * 48;
                        const bool is_q = nt < 2, is_k = nt == 3;
                        if (is_q || is_k) {
                            const float* gain = is_q ? O.q_gain : ((pc < 2) ? O.ks_gain : O.kw_gain);
                            float ss = 0.f;
#pragma unroll
                            for (int m = 0; m < 4; ++m)
#pragma unroll
                                for (int j = 0; j < 4; ++j) ss += P1V(m, j) * P1V(m, j);
                            const float rs = rsqrtf(sum4fq(ss) * (1.f / 64.f) + EPS) ;
#pragma unroll
                            for (int m = 0; m < 4; ++m) { const float4 gv = *(const float4*)(gain + m * 16 + fq * 4);
                                P1V(m, 0) *= rs * gv.x; P1V(m, 1) *= rs * gv.y; P1V(m, 2) *= rs * gv.z; P1V(m, 3) *= rs * gv.w; }
                            { const float4 c4 = *(const float4*)(rope_t + (fq & 1) * 4), s4 = *(const float4*)(rope_t + 8 + (fq & 1) * 4);
                              const float cc[4] = {c4.x, c4.y, c4.z, c4.w}, sn[4] = {s4.x, s4.y, s4.z, s4.w};
#pragma unroll
                              for (int j = 0; j < 4; ++j) {
                                  auto rr = __builtin_amdgcn_permlane32_swap(__float_as_uint(P1V(0, j)), __float_as_uint(P1V(0, j)), false, false);
                                  const float x1 = __uint_as_float(rr[0]), x2 = __uint_as_float(rr[1]);
                                  P1V(0, j) = (fq < 2) ? (x1 * cc[j] - x2 * sn[j]) : (x2 * cc[j] + x1 * sn[j]);
                              } }
                            const float osc = is_q ? NSA_QSCALE : 1.f;
                            unsigned short* dst = is_q ? (O.q16a + tok * 512 + (nt * 4 + pc) * 64) : ((pc < 2 ? O.ks16 : O.kw16) + ((long)(b * 2 + (pc & 1)) * S_ + s) * 64);
#pragma unroll
                            for (int m = 0; m < 4; ++m) { uint2 pk; pk.x = cvtpk(P1V(m, 0) * osc, P1V(m, 1) * osc); pk.y = cvtpk(P1V(m, 2) * osc, P1V(m, 3) * osc); *(uint2*)(dst + m * 16 + fq * 4) = pk; }
                        } else if (nt == 2 || nt == 5 || (nt == 6 && pc < 2)) {
                            unsigned short* dst;
                            if (nt == 2) dst = (pc < 2 ? O.kcmp16 : O.vcmp16) + ((long)(b * 2 + (pc & 1)) * S_ + s) * 64;
                            else if (nt == 5) dst = O.cq16 + tok * 256 + pc * 64;
                            else dst = O.ckv16 + tok * 128 + pc * 64;
                            float ss = 0.f;
#pragma unroll
                            for (int m = 0; m < 4; ++m) { uint2 pk; pk.x = cvtpk(P1V(m, 0), P1V(m, 1)); pk.y = cvtpk(P1V(m, 2), P1V(m, 3)); *(uint2*)(dst + m * 16 + fq * 4) = pk;
#pragma unroll
                                for (int j = 0; j < 4; ++j) ss += P1V(m, j) * P1V(m, j); }
                            if (nt != 2) { ss = sum4fq(ss); if (fq == 0) { if (nt == 5) O.ssq_cq[(long)pc * T_ + tok] = ss; else O.ssq_ckv[(long)pc * T_ + tok] = ss; } }
                        } else if (nt == 6 && pc == 2) {
                            float ss = 0.f;
#pragma unroll
                            for (int m = 0; m < 2; ++m)
#pragma unroll
                                for (int j = 0; j < 4; ++j) ss += P1V(m, j) * P1V(m, j);
                            ss = sum4fq(ss);
                            if (fq == 0) O.ssq_kr[tok] = ss;
                            {
                                const float4 g0 = *(const float4*)(O.k_gain + 64 + fq * 4), g1 = *(const float4*)(O.k_gain + 80 + fq * 4);
                                const float4 c4 = *(const float4*)(rope_t + 16 + fq * 4), s4 = *(const float4*)(rope_t + 32 + fq * 4);
                                const float ga[4] = {g0.x, g0.y, g0.z, g0.w}, gb[4] = {g1.x, g1.y, g1.z, g1.w}, cc[4] = {c4.x, c4.y, c4.z, c4.w}, sn[4] = {s4.x, s4.y, s4.z, s4.w};
                                float o1[4], o2[4];
#pragma unroll
                                for (int j = 0; j < 4; ++j) { const float x1 = P1V(0, j) * ga[j], x2 = P1V(1, j) * gb[j]; o1[j] = x1 * cc[j] - x2 * sn[j]; o2[j] = x2 * cc[j] + x1 * sn[j]; }
                                *(float4*)(O.krr + tok * 32 + fq * 4) = make_float4(o1[0], o1[1], o1[2], o1[3]);
                                *(float4*)(O.krr + tok * 32 + 16 + fq * 4) = make_float4(o2[0], o2[1], o2[2], o2[3]);
                            }
                            *(float4*)(O.gates + tok * 24 + fq * 4) = make_float4(1.f / (1.f + __expf(-P1V(2, 0))), 1.f / (1.f + __expf(-P1V(2, 1))), 1.f / (1.f + __expf(-P1V(2, 2))), 1.f / (1.f + __expf(-P1V(2, 3))));
                            if (fq < 2) *(float4*)(O.gates + tok * 24 + 16 + fq * 4) = make_float4(1.f / (1.f + __expf(-P1V(3, 0))), 1.f / (1.f + __expf(-P1V(3, 1))), 1.f / (1.f + __expf(-P1V(3, 2))), 1.f / (1.f + __expf(-P1V(3, 3))));
                        }
                    }
            }
        }
        __syncthreads();
    }
}
#undef P1V

typedef GemmShape<2, 4, 2, 2> ShBig;
typedef GemmShape<4, 2, 1, 3> ShQb;
typedef GemmShape<4, 2, 1, 4> ShKvb;
struct P2Args {
    const unsigned short *cq16, *ckv16, *wt_uq, *wt_ukv, *kcmp16, *vcmp16, *w1t_k, *w1t_v;
    const float *ssq_cq, *ssq_ckv, *ssq_kr, *krr, *rope, *q_gain, *k_gain;
    unsigned short *q16, *k16, *vt16; float* hid;
};
__device__ __forceinline__ void p2_phase(unsigned char* lds, const P2Args& A) {
    const int tid = tid_(); const int lane = tid & 63, wave = __builtin_amdgcn_readfirstlane(tid >> 6), r32 = lane & 31, hi = lane >> 5;
    const int nmine = (blockIdx.x < 128) ? 4 : 5;
    for (int it = 0; it < nmine; ++it) {
        int u;
        if (blockIdx.x < 128) { if (it == 0) u = blockIdx.x; else { const int s = blockIdx.x * 3 + (it - 1); u = (s & 1) ? 640 + (s >> 1) : 128 + (s >> 1); } }
        else { const int s = 384 + (blockIdx.x - 128) * 5 + it; u = (s & 1) ? 640 + (s >> 1) : 128 + (s >> 1); }
        if (u < 128) {
            const int mat = u >> 6, mtile = (u >> 2) & 15, ks = u & 3; const int wm = wave >> 2, wn = wave & 3;
            f32x16 acc[2][2];
#pragma unroll
            for (int mi = 0; mi < 2; ++mi)
#pragma unroll
                for (int ni = 0; ni < 2; ++ni)
#pragma unroll
                    for (int r = 0; r < 16; ++r) acc[mi][ni][r] = 0.f;
            gemm_mainloop<ShBig, 3u>((mat ? A.vcmp16 : A.kcmp16) + (long)mtile * 128 * 1024 + ks * 512, 1024, (mat ? A.w1t_v : A.w1t_k) + ks * 512, 2048, 512, lds, acc, tid);
            float* slab = A.hid + (long)(mat * 4 + ks) * 2048 * 256;
#pragma unroll
            for (int mi = 0; mi < 2; ++mi) {
                const long row = mtile * 128 + wm * 64 + mi * 32 + r32;
#pragma unroll
                for (int ni = 0; ni < 2; ++ni)
#pragma unroll
                    for (int g = 0; g < 4; ++g)
                        *(float4*)(slab + row * 256 + wn * 64 + ni * 32 + 8 * g + 4 * hi) = make_float4(acc[mi][ni][4 * g], acc[mi][ni][4 * g + 1], acc[mi][ni][4 * g + 2], acc[mi][ni][4 * g + 3]);
            }
        } else if (u < 128 + 512) {
            const int v = u - 128; const int mt = v >> 2, nt = v & 3; const int m0 = mt * 128; const int wm = wave >> 1, wn = wave & 1; const int head = nt * 2 + wn;
            f32x16 acc[1][4];
#pragma unroll
            for (int ni = 0; ni < 4; ++ni)
#pragma unroll
                for (int r = 0; r < 16; ++r) acc[0][ni][r] = 0.f;
            gemm_mainloop<ShKvb, 3u>(A.ckv16 + (long)m0 * 128, 128, A.wt_ukv + (long)nt * 256 * 128, 128, 128, lds, acc, tid);
            {
                const long tok = m0 + wm * 32 + r32; const int b = (int)(tok / S_), s = (int)(tok % S_);
                const float rc = rsqrtf((A.ssq_ckv[tok] + A.ssq_ckv[(long)T_ + tok]) * (1.f / 128.f) + EPS);
                float ss = 0.f;
#pragma unroll
                for (int r = 0; r < 16; ++r) { acc[0][0][r] *= rc; acc[0][1][r] *= rc; ss += acc[0][0][r] * acc[0][0][r] + acc[0][1][r] * acc[0][1][r]; }
                ss = pair_sum(ss) + A.ssq_kr[tok];
                const float rk = rsqrtf(ss * (1.f / 96.f) + EPS);
#pragma unroll
                for (int g = 0; g < 4; ++g) {
                    const float4 g0 = *(const float4*)(A.k_gain + 8 * g + 4 * hi), g1 = *(const float4*)(A.k_gain + 32 + 8 * g + 4 * hi);
                    acc[0][0][4 * g] *= rk * g0.x; acc[0][0][4 * g + 1] *= rk * g0.y; acc[0][0][4 * g + 2] *= rk * g0.z; acc[0][0][4 * g + 3] *= rk * g0.w;
                    acc[0][1][4 * g] *= rk * g1.x; acc[0][1][4 * g + 1] *= rk * g1.y; acc[0][1][4 * g + 2] *= rk * g1.z; acc[0][1][4 * g + 3] *= rk * g1.w;
                }
                unsigned short* krow = A.k16 + ((long)(b * 8 + head) * S_ + s) * 96;
                store_row64(krow, acc[0][0], acc[0][1], hi);
                const float4* kp = (const float4*)(A.krr + tok * 32 + hi * 16);
                const float4 k0 = kp[0], k1 = kp[1], k2 = kp[2], k3 = kp[3];
                uint4 o0, o1; o0.x = cvtpk(k0.x * rk, k0.y * rk); o0.y = cvtpk(k0.z * rk, k0.w * rk); o0.z = cvtpk(k1.x * rk, k1.y * rk); o0.w = cvtpk(k1.z * rk, k1.w * rk);
                o1.x = cvtpk(k2.x * rk, k2.y * rk); o1.y = cvtpk(k2.z * rk, k2.w * rk); o1.z = cvtpk(k3.x * rk, k3.y * rk); o1.w = cvtpk(k3.z * rk, k3.w * rk);
                *(uint4*)(krow + 64 + hi * 16) = o0; *(uint4*)(krow + 64 + hi * 16 + 8) = o1;
            }
            {
#pragma unroll
                for (int ni = 2; ni < 4; ++ni)
#pragma unroll
                    for (int g4 = 0; g4 < 4; ++g4) {
                        const int tb = m0 + wm * 32 + 8 * g4 + 4 * hi; const int b = tb / S_, s0 = tb % S_; const int d = (ni - 2) * 32 + r32;
                        const float4 sa = *(const float4*)(A.ssq_ckv + tb), sb = *(const float4*)(A.ssq_ckv + (long)T_ + tb);
                        const float r0 = rsqrtf((sa.x + sb.x) * (1.f / 128.f) + EPS), r1 = rsqrtf((sa.y + sb.y) * (1.f / 128.f) + EPS), r2 = rsqrtf((sa.z + sb.z) * (1.f / 128.f) + EPS), r3 = rsqrtf((sa.w + sb.w) * (1.f / 128.f) + EPS);
                        uint2 pk; pk.x = cvtpk(acc[0][ni][4 * g4] * r0, acc[0][ni][4 * g4 + 1] * r1); pk.y = cvtpk(acc[0][ni][4 * g4 + 2] * r2, acc[0][ni][4 * g4 + 3] * r3);
                        *(uint2*)(A.vt16 + ((long)(b * 8 + head) * 64 + d) * S_ + vperm(s0)) = pk;
                    }
            }
        } else {
            const int v = u - 640; const int mt = v >> 2, nt = v & 3; const int m0 = mt * 128; const int wm = wave >> 1, wn = wave & 1; const int head = nt * 2 + wn;
            f32x16 acc[1][3];
#pragma unroll
            for (int ni = 0; ni < 3; ++ni)
#pragma unroll
                for (int r = 0; r < 16; ++r) acc[0][ni][r] = 0.f;
            gemm_mainloop<ShQb, 7u>(A.cq16 + (long)m0 * 256, 256, A.wt_uq + (long)nt * 192 * 256, 256, 256, lds, acc, tid);
            const long tok = m0 + wm * 32 + r32;
            const float rc = rsqrtf((A.ssq_cq[tok] + A.ssq_cq[(long)T_ + tok] + A.ssq_cq[2L * T_ + tok] + A.ssq_cq[3L * T_ + tok]) * (1.f / 256.f) + EPS);
            float ss = 0.f;
#pragma unroll
            for (int ni = 0; ni < 3; ++ni)
#pragma unroll
                for (int r = 0; r < 16; ++r) { acc[0][ni][r] *= rc; ss += acc[0][ni][r] * acc[0][ni][r]; }
            ss = pair_sum(ss);
            const float rq = rsqrtf(ss * (1.f / 96.f) + EPS);
#pragma unroll
            for (int ni = 0; ni < 3; ++ni)
#pragma unroll
                for (int g = 0; g < 4; ++g) {
                    const float4 gg = *(const float4*)(A.q_gain + ni * 32 + 8 * g + 4 * hi);
                    acc[0][ni][4 * g] *= rq * gg.x; acc[0][ni][4 * g + 1] *= rq * gg.y; acc[0][ni][4 * g + 2] *= rq * gg.z; acc[0][ni][4 * g + 3] *= rq * gg.w;
                }
            const float* rope_t = A.rope + tok * 48;
#pragma unroll
            for (int g = 0; g < 2; ++g) {
                const float4 c4 = *(const float4*)(rope_t + 16 + 8 * g + 4 * hi), s4 = *(const float4*)(rope_t + 32 + 8 * g + 4 * hi);
                const float cc[4] = {c4.x, c4.y, c4.z, c4.w}, sn[4] = {s4.x, s4.y, s4.z, s4.w};
#pragma unroll
                for (int j = 0; j < 4; ++j) { const float x1 = acc[0][2][4 * g + j], x2 = acc[0][2][8 + 4 * g + j]; acc[0][2][4 * g + j] = x1 * cc[j] - x2 * sn[j]; acc[0][2][8 + 4 * g + j] = x2 * cc[j] + x1 * sn[j]; }
            }
            unsigned short* qrow = A.q16 + tok * 768 + head * 96;
#pragma unroll
            for (int ni = 0; ni < 3; ++ni)
#pragma unroll
                for (int g = 0; g < 4; ++g) {
                    uint2 pk; pk.x = cvtpk(acc[0][ni][4 * g] * MLA_QSCALE, acc[0][ni][4 * g + 1] * MLA_QSCALE); pk.y = cvtpk(acc[0][ni][4 * g + 2] * MLA_QSCALE, acc[0][ni][4 * g + 3] * MLA_QSCALE);
                    *(uint2*)(qrow + ni * 32 + 8 * g + 4 * hi) = pk;
                }
        }
    }
}
__device__ __forceinline__ void p3_cmp2(const float* __restrict__ hid, const float* __restrict__ cbias, const unsigned short* __restrict__ w2t_k, const unsigned short* __restrict__ w2t_v,
                                        const float* __restrict__ kc_gain, const float* __restrict__ rope, unsigned short* __restrict__ kc16, unsigned short* __restrict__ vct16) {
    const int tid = tid_(); const int lane = tid & 63, w = __builtin_amdgcn_readfirstlane(tid >> 6), r32 = lane & 31, hi = lane >> 5;
    for (int task = blockIdx.x * 8 + w; task < 128; task += NBLK * 8) {
        const int mat = task >> 6, rt = task & 63; const long row = rt * 32 + r32;
        const unsigned short* w2t = mat ? w2t_v : w2t_k;
        f32x16 acc[2];
#pragma unroll
        for (int r = 0; r < 16; ++r) { acc[0][r] = 0.f; acc[1][r] = 0.f; }
#pragma unroll 4
        for (int ks = 0; ks < 16; ++ks) {
            const int k0 = ks * 16 + hi * 8;
            float h[8];
            { const float4 b0 = *(const float4*)(cbias + mat * 256 + k0), b1 = *(const float4*)(cbias + mat * 256 + k0 + 4);
              h[0] = b0.x; h[1] = b0.y; h[2] = b0.z; h[3] = b0.w; h[4] = b1.x; h[5] = b1.y; h[6] = b1.z; h[7] = b1.w; }
#pragma unroll
            for (int sp = 0; sp < 4; ++sp) {
                const float* hp = hid + ((long)(mat * 4 + sp) * 2048 + row) * 256 + k0;
                const float4 a0 = *(const float4*)hp, a1 = *(const float4*)(hp + 4);
                h[0] += a0.x; h[1] += a0.y; h[2] += a0.z; h[3] += a0.w; h[4] += a1.x; h[5] += a1.y; h[6] += a1.z; h[7] += a1.w;
            }
            uint4 pk; pk.x = cvtpk(gelu_tanh(h[0]), gelu_tanh(h[1])); pk.y = cvtpk(gelu_tanh(h[2]), gelu_tanh(h[3])); pk.z = cvtpk(gelu_tanh(h[4]), gelu_tanh(h[5])); pk.w = cvtpk(gelu_tanh(h[6]), gelu_tanh(h[7]));
            const bf16x8 hf = __builtin_bit_cast(bf16x8, pk);
            const bf16x8 w0 = *(const bf16x8*)(w2t + (long)r32 * 256 + k0), w1 = *(const bf16x8*)(w2t + (long)(32 + r32) * 256 + k0);
            acc[0] = MFMA32(w0, hf, acc[0]); acc[1] = MFMA32(w1, hf, acc[1]);
        }
        const int bg = (int)(row >> 9), n = (int)(row & 511); const bool valid = n < NCMP;
        if (mat == 0) {
            if (valid) {
                const long tokp = (long)(bg >> 1) * S_ + 16 * n + 31;
                norm_rope64(acc[0], acc[1], kc_gain, rope + tokp * 48, hi, 1.f);
            } else {
#pragma unroll
                for (int r = 0; r < 16; ++r) { acc[0][r] = 0.f; acc[1][r] = 0.f; }
            }
            store_row64(kc16 + row * 64, acc[0], acc[1], hi);
        } else {
#pragma unroll
            for (int ni = 0; ni < 2; ++ni)
#pragma unroll
                for (int r = 0; r < 16; ++r) {
                    const float v = valid ? acc[ni][r] : 0.f;
                    const float other = __uint_as_float(__builtin_amdgcn_mov_dpp(__float_as_uint(v), 0xB1, 0xF, 0xF, true));
                    if ((lane & 1) == 0) *(unsigned*)(vct16 + ((long)bg * 64 + ni * 32 + crow(r, hi)) * 512 + vperm(n)) = cvtpk(v, other);
                }
        }
    }
}

__device__ __forceinline__ void cvt_stream(const float* __restrict__ in, unsigned short* __restrict__ out, long n, int vb = blockIdx.x, int nb = NBLK) {
    const long nchunk = n >> 3;
    const int tid = tid_();
    for (long c = (long)vb * 512 + tid; c < nchunk; c += (long)nb * 512) {
        const float4 a = ((const float4*)in)[2 * c], b = ((const float4*)in)[2 * c + 1];
        uint4 o; o.x = cvtpk(a.x, a.y); o.y = cvtpk(a.z, a.w); o.z = cvtpk(b.x, b.y); o.w = cvtpk(b.z, b.w);
        ((uint4*)out)[c] = o;
    }
}


typedef unsigned u32x3 __attribute__((ext_vector_type(3)));
typedef unsigned u32x6 __attribute__((ext_vector_type(6)));
typedef float f32x32 __attribute__((ext_vector_type(32)));
constexpr int PROW = 768;
__device__ __forceinline__ void cvt_rows_fp6(const float* __restrict__ in, unsigned char* __restrict__ out6, float* __restrict__ scale, int rows, int vb = blockIdx.x, int nb = NBLK) {
    const int tid = tid_(); const int lane = tid & 63, w = __builtin_amdgcn_readfirstlane(tid >> 6);
    const int stride = nb * 8;
    for (int r0 = vb * 8 + w; r0 < rows; r0 += 4 * stride) {
        f32x4_t v[4][4];
#pragma unroll
        for (int j = 0; j < 4; ++j) {
            const int r = min(r0 + j * stride, rows - 1);
            const f32x4_t* p = (const f32x4_t*)(in + (long)r * 1024 + lane * 16);
#pragma unroll
            for (int i = 0; i < 4; ++i) v[j][i] = p[i];
        }
#pragma unroll
        for (int j = 0; j < 4; ++j) {
            const int r = r0 + j * stride;
            if (r < rows) {
                float m = 0.f;
#pragma unroll
                for (int i = 0; i < 4; ++i) m = fmaxf(m, fmaxf(fmaxf(fabsf(v[j][i].x), fabsf(v[j][i].y)), fmaxf(fabsf(v[j][i].z), fabsf(v[j][i].w))));
                m = wmax(m);
                const float q = (m > 0.f) ? 7.5f / m : 1.f;
                const f32x16 ve = {v[j][0].x * q, v[j][0].z * q, v[j][1].x * q, v[j][1].z * q, v[j][2].x * q, v[j][2].z * q, v[j][3].x * q, v[j][3].z * q, 0.f, 0.f, 0.f, 0.f, 0.f, 0.f, 0.f, 0.f};
                const f32x16 vo = {v[j][0].y * q, v[j][0].w * q, v[j][1].y * q, v[j][1].w * q, v[j][2].y * q, v[j][2].w * q, v[j][3].y * q, v[j][3].w * q, 0.f, 0.f, 0.f, 0.f, 0.f, 0.f, 0.f, 0.f};
                const u32x6 pk = __builtin_amdgcn_cvt_scalef32_2xpk16_fp6_f32(ve, vo, 1.0f);
                *(u32x3*)(out6 + (long)r * PROW + lane * 12) = u32x3{pk[0], pk[1], pk[2]};
                if (lane == 0) scale[r] = (m > 0.f) ? m * (1.f / 7.5f) : 1.f;
            }
        }
    }
}
__device__ __forceinline__ f32x32 dec2_fp6(const u32x3& r0, const u32x3& r1) {
    const u32x6 pk = {r0.x, r0.y, r0.z, r1.x, r1.y, r1.z};
    return __builtin_amdgcn_cvt_scalef32_pk32_f32_fp6(pk, 1.0f);
}
__device__ __forceinline__ void peer_sweep_a(const float* __restrict__ hss, const float* __restrict__ g2, const int* __restrict__ eo, const float* __restrict__ go,
                                             const unsigned char* __restrict__ U6, const float* __restrict__ su, const float* __restrict__ sv, const float* __restrict__ h, float* __restrict__ wout) {
    const int tid = tid_(); const int lane = tid & 63, w = __builtin_amdgcn_readfirstlane(tid >> 6);
    const int kcls = ((lane >> 5) & 1) * 4 + ((lane >> 4) & 1) * 2 + ((lane >> 3) & 1);
    for (int t = blockIdx.x * 8 + w; t < T_; t += NBLK * 8) {
        float x[16];
        {
            const float4* xp = (const float4*)(h + (long)t * 1024 + lane * 16); const float4* gp = (const float4*)(g2 + lane * 16); const float4* hp = (const float4*)(hss + (long)t * 16);
            const float4 s0 = hp[0], s1 = hp[1], s2 = hp[2], s3 = hp[3];
            const float rs = rsqrtf((s0.x + s0.y + s0.z + s0.w + s1.x + s1.y + s1.z + s1.w + s2.x + s2.y + s2.z + s2.w + s3.x + s3.y + s3.z + s3.w) * (1.f / 1024.f) + EPS);
#pragma unroll
            for (int k = 0; k < 4; ++k) { const float4 hv = xp[k], gv = gp[k]; x[4 * k] = hv.x * rs * gv.x; x[4 * k + 1] = hv.y * rs * gv.y; x[4 * k + 2] = hv.z * rs * gv.z; x[4 * k + 3] = hv.w * rs * gv.w; }
        }
        const int elo = eo[(long)t * 128 + lane], ehi = eo[(long)t * 128 + 64 + lane];
        const float glo = go[(long)t * 128 + lane], ghi = go[(long)t * 128 + 64 + lane];
        for (int bt = 0; bt < 16; ++bt) {
            int e[8];
#pragma unroll
            for (int k = 0; k < 8; ++k) e[k] = __builtin_amdgcn_readlane(bt < 8 ? elo : ehi, (bt * 8 + k) & 63);
            u32x3 u[8];
#pragma unroll
            for (int k = 0; k < 8; ++k) u[k] = *(const u32x3*)(U6 + (long)e[k] * PROW + lane * 12);
            const int emine = __shfl(bt < 8 ? elo : ehi, (bt * 8 + kcls) & 63);
            const float sum = su[emine], svm = sv[emine];
            const float gk = __shfl(bt < 8 ? glo : ghi, (bt * 8 + kcls) & 63);
            float a[8];
#pragma unroll
            for (int k = 0; k < 8; k += 2) {
                const f32x32 d = dec2_fp6(u[k], u[k + 1]);
                float s0 = 0.f, s1 = 0.f;
#pragma unroll
                for (int i = 0; i < 16; ++i) { s0 = fmaf(d[i], x[i], s0); s1 = fmaf(d[16 + i], x[i], s1); }
                a[k] = s0; a[k + 1] = s1;
            }
            float b4[4], c2[2], d1;
#pragma unroll
            for (int i = 0; i < 4; ++i) {
                auto rr = __builtin_amdgcn_permlane32_swap(__float_as_uint(a[i]), __float_as_uint(a[i + 4]), false, false);
                b4[i] = __uint_as_float(rr[0]) + __uint_as_float(rr[1]);
            }
#pragma unroll
            for (int i = 0; i < 2; ++i) {
                auto rr = __builtin_amdgcn_permlane16_swap(__float_as_uint(b4[i]), __float_as_uint(b4[i + 2]), false, false);
                c2[i] = __uint_as_float(rr[0]) + __uint_as_float(rr[1]);
            }
            { const bool up = (lane & 8) != 0; const float keep = up ? c2[1] : c2[0], send = up ? c2[0] : c2[1];
              d1 = keep + __uint_as_float(__builtin_amdgcn_mov_dpp(__float_as_uint(send), 0x128, 0xF, 0xF, true)); }
            d1 = quad_sum(d1);
            d1 += __uint_as_float(__builtin_amdgcn_mov_dpp(__float_as_uint(d1), 0x141, 0xF, 0xF, true));
            const float wl = gk * gelu_tanh(d1 * sum) * svm;
            if ((lane & 7) == 0) wout[(long)t * 128 + bt * 8 + kcls] = wl;
        }
    }
}
__device__ __forceinline__ void peer_sweep_b(const int* __restrict__ eo, const float* __restrict__ win, const unsigned char* __restrict__ V6, float* out) {
    const int tid = tid_(); const int lane = tid & 63, w = __builtin_amdgcn_readfirstlane(tid >> 6);
    for (int t = blockIdx.x * 8 + w; t < T_; t += NBLK * 8) {
        float y[16];
#pragma unroll
        for (int i = 0; i < 16; ++i) y[i] = 0.f;
        const int elo = eo[(long)t * 128 + lane], ehi = eo[(long)t * 128 + 64 + lane];
        const float wlo = win[(long)t * 128 + lane], whi = win[(long)t * 128 + 64 + lane];
        for (int bt = 0; bt < 16; ++bt) {
            int e[8]; float wk[8];
#pragma unroll
            for (int k = 0; k < 8; ++k) {
                e[k] = __builtin_amdgcn_readlane(bt < 8 ? elo : ehi, (bt * 8 + k) & 63);
                wk[k] = __uint_as_float(__builtin_amdgcn_readlane(__float_as_uint(bt < 8 ? wlo : whi), (bt * 8 + k) & 63));
            }
            u32x3 v[8];
#pragma unroll
            for (int k = 0; k < 8; ++k) v[k] = *(const u32x3*)(V6 + (long)e[k] * PROW + lane * 12);
#pragma unroll
            for (int k = 0; k < 8; k += 2) {
                const f32x32 d = dec2_fp6(v[k], v[k + 1]);
#pragma unroll
                for (int i = 0; i < 16; ++i) y[i] = fmaf(wk[k + 1], d[16 + i], fmaf(wk[k], d[i], y[i]));
            }
        }
        float4* o = (float4*)(out + (long)t * 1024 + lane * 16);
#pragma unroll
        for (int k = 0; k < 4; ++k) { float4 hv = o[k]; hv.x += y[4 * k]; hv.y += y[4 * k + 1]; hv.z += y[4 * k + 2]; hv.w += y[4 * k + 3]; o[k] = hv; }
    }
}

struct Params {
    const float* x; const int* positions; const float* norm1_gain; const float* w_in;
    const float *nsa_q_gain, *nsa_kc_gain, *nsa_ks_gain, *nsa_kw_gain, *cmp_pos, *cmp_k_w1, *cmp_k_w2, *cmp_v_w1, *cmp_v_w2;
    const float *mla_q_lora_gain, *mla_w_uq, *mla_kv_lora_gain, *mla_w_ukv, *mla_q_gain, *mla_k_gain, *out_gain_a, *out_gain_b, *w_out;
    const float *norm2_gain, *peer_w_q, *peer_sub_keys, *peer_u, *peer_v;
    float* out; float* W; unsigned* bar;
};
constexpr int LDS_BYTES = 64 + 131072;
static_assert(LDS_BYTES >= 8 * 3200 * 4 + 64, "naive NSA phase needs 102,464 B");

typedef __attribute__((address_space(4))) const Params* cparams_t;
__device__ __forceinline__ cparams_t params_ptr() {
    cparams_t pp = (cparams_t)__builtin_amdgcn_kernarg_segment_ptr();
    asm volatile("" : "+s"(pp));
    return pp;
}
constexpr long M1 = 1 << 20;
constexpr long F_U8 = 0, F_V8 = 4 * M1, F_SU = 21 * M1 + 3 * M1 / 8, F_SV = F_SU + 16384,
               F_WTIN = 16 * M1, F_WTUQ = 17 * M1, F_WTUKV = 17 * M1 + M1 / 8, F_W1TK = 17 * M1 + M1 / 4, F_W1TV = 17 * M1 + M1 / 2, F_W2TK = 17 * M1 + 3 * M1 / 4,
               F_W2TV = F_W2TK + 8192, F_CBIAS = F_W2TV + 8192, F_WTOUT = 18 * M1, F_WTQ = 18 * M1 + M1 / 2, F_SK16 = 19 * M1 + M1 / 2,
               F_SSQCQ = 19 * M1 + 5 * M1 / 8, F_SSQCKV = F_SSQCQ + 4 * 16384, F_SSQKR = F_SSQCKV + 2 * 16384, F_SSQA = 19 * M1 + 3 * M1 / 4, F_SSQB = F_SSQA + 8 * 16384,
               F_ROPE = 20 * M1, F_GATES = 21 * M1, F_KRR = 21 * M1 + M1 / 2,
               F_XN16 = 22 * M1, F_MIX = 22 * M1,
               F_Q16A = 30 * M1, F_KS16 = 34 * M1, F_KW16 = 35 * M1, F_VST16 = 36 * M1, F_VWT16 = 37 * M1, F_KCMP16 = 38 * M1, F_VCMP16 = 39 * M1 + M1 / 8,
               F_CQ16 = 40 * M1 + M1 / 4, F_CKV16 = 42 * M1 + M1 / 4,
               F_Q16 = 43 * M1 + M1 / 2, F_K16 = 49 * M1 + M1 / 2, F_VT16 = 55 * M1 + M1 / 2, F_HID = 59 * M1 + M1 / 2, F_KC16 = 63 * M1 + M1 / 2, F_VCT16 = F_KC16 + M1 / 8,
               F_HB = 30 * M1, F_HSS = 38 * M1, F_PSS = 38 * M1 + M1 / 2, F_EO = 39 * M1, F_GO = 41 * M1, F_PQB = 43 * M1 + M1 / 2;
static_assert(F_SSQKR + 16384 <= F_SSQA && F_SSQB + 8 * 16384 <= F_ROPE && F_VCT16 + M1 / 8 <= 64 * M1 - 16384 && F_CKV16 + M1 <= F_Q16 && F_PQB + 16 * M1 <= F_HID, "workspace map");

#define G(x) (x)
__global__ __launch_bounds__(512, 2) void mega(Params p_unused) {
    extern __shared__ __attribute__((aligned(16))) unsigned char lds_raw[];
    float* ldsf = (float*)(lds_raw + 64);
    { const unsigned bid_ = blockIdx.x; __builtin_assume(bid_ < (unsigned)NBLK); }
    if (threadIdx.x == 0) *(uint4*)lds_raw = make_uint4(0u, 0u, 0u, 0u);
    __syncthreads();
    XcdBarrier bar = xcd_barrier_post(params_ptr()->bar, (volatile LAS unsigned*)lds_raw);
#define GRID_SYNC() xcd_barrier(bar)
#define U16P(off) ((unsigned short*)(W + (off)))
    { cparams_t p = params_ptr(); float* W = p->W;
      p0_xn_rope(p->x, p->norm1_gain, p->positions, U16P(F_XN16), W + F_ROPE); }
    { cparams_t p = params_ptr(); float* W = p->W;
#define P0_XT(j) ({ const int v_ = (int)blockIdx.x + NBLK * (j); \
        (v_ < 432) ? xt_make(p->w_in, 1024, INW, U16P(F_WTIN), nullptr, nullptr, 0, 2, v_) : \
        (v_ < 480) ? xt_make(p->mla_w_uq, 256, 768, U16P(F_WTUQ), p->mla_q_lora_gain, p->mla_q_lora_gain, 1 << 30, 0, v_ - 432) : \
        (v_ < 512) ? xt_make(p->mla_w_ukv, 128, 1024, U16P(F_WTUKV), p->mla_kv_lora_gain, p->mla_kv_lora_gain, 1 << 30, 0, v_ - 480) : \
        (v_ < 640) ? xt_make(p->cmp_k_w1, 2048, 256, U16P(F_W1TK), nullptr, nullptr, 0, 0, v_ - 512) : \
        (v_ < 768) ? xt_make(p->cmp_v_w1, 2048, 256, U16P(F_W1TV), nullptr, nullptr, 0, 0, v_ - 640) : \
        (v_ < 772) ? xt_make(p->cmp_k_w2, 256, 64, U16P(F_W2TK), nullptr, nullptr, 0, 0, v_ - 768) : \
        (v_ < 776) ? xt_make(p->cmp_v_w2, 256, 64, U16P(F_W2TV), nullptr, nullptr, 0, 0, v_ - 772) : xt_make(nullptr, 64, 64, nullptr, nullptr, nullptr, 0, 0, -1); })
      XT_RUN4(ldsf, P0_XT);
      zero_stream(U16P(F_WTIN) + (long)1720 * 1024, (long)72 * 1024); }
    { cparams_t p = params_ptr(); float* W = p->W;
      p0_cbias(p->cmp_pos, p->cmp_k_w1, p->cmp_v_w1, W + F_CBIAS); }
    GRID_SYNC();
    { cparams_t p = params_ptr(); float* W = p->W;
      P1Out O; O.q16a = U16P(F_Q16A); O.ks16 = U16P(F_KS16); O.kw16 = U16P(F_KW16); O.vst16 = U16P(F_VST16); O.vwt16 = U16P(F_VWT16); O.kcmp16 = U16P(F_KCMP16); O.vcmp16 = U16P(F_VCMP16);
      O.cq16 = U16P(F_CQ16); O.ckv16 = U16P(F_CKV16); O.krr = W + F_KRR; O.ssq_kr = W + F_SSQKR; O.ssq_cq = W + F_SSQCQ; O.ssq_ckv = W + F_SSQCKV; O.gates = W + F_GATES;
      O.rope = W + F_ROPE; O.q_gain = p->nsa_q_gain; O.ks_gain = p->nsa_ks_gain; O.kw_gain = p->nsa_kw_gain; O.k_gain = p->mla_k_gain;
      p1_inproj_256(lds_raw + 64, U16P(F_XN16), U16P(F_WTIN), O); }
    if ((blockIdx.x >> 3) >= 24) {
      cparams_t p = params_ptr(); float* W = p->W;
      cvt_rows_fp6(p->peer_u, (unsigned char*)(W + F_U8), W + F_SU, 16384, (int)(blockIdx.x & 7) * 8 + (int)(blockIdx.x >> 3) - 24, 64); }
    GRID_SYNC();
    { cparams_t p = params_ptr(); float* W = p->W;
      P2Args A; A.cq16 = U16P(F_CQ16); A.ckv16 = U16P(F_CKV16); A.wt_uq = U16P(F_WTUQ); A.wt_ukv = U16P(F_WTUKV); A.kcmp16 = U16P(F_KCMP16); A.vcmp16 = U16P(F_VCMP16); A.w1t_k = U16P(F_W1TK); A.w1t_v = U16P(F_W1TV);
      A.ssq_cq = W + F_SSQCQ; A.ssq_ckv = W + F_SSQCKV; A.ssq_kr = W + F_SSQKR; A.krr = W + F_KRR; A.rope = W + F_ROPE; A.q_gain = p->mla_q_gain; A.k_gain = p->mla_k_gain;
      A.q16 = U16P(F_Q16); A.k16 = U16P(F_K16); A.vt16 = U16P(F_VT16); A.hid = W + F_HID;
      p2_phase(lds_raw + 64, A); }
    GRID_SYNC();
    { cparams_t p = params_ptr(); float* W = p->W;
      p3_cmp2(W + F_HID, W + F_CBIAS, U16P(F_W2TK), U16P(F_W2TV), p->nsa_kc_gain, W + F_ROPE, U16P(F_KC16), U16P(F_VCT16)); }
    if (blockIdx.x >= 16) {
      const int vb = blockIdx.x - 16, nb = NBLK - 16;
      { cparams_t p = params_ptr(); float* W = p->W;
#define P3_XT(j) ({ const int v_ = vb + nb * (j); \
          (v_ < 256) ? xt_make(p->w_out, 1024, 1024, U16P(F_WTOUT), p->out_gain_a, p->out_gain_b, 512, 0, v_) : \
          (v_ < 768) ? xt_make(p->peer_w_q, 1024, 2048, U16P(F_WTQ), p->norm2_gain, p->norm2_gain, 1 << 30, 0, v_ - 256) : xt_make(nullptr, 64, 64, nullptr, nullptr, nullptr, 0, 0, -1); })
        XT_RUN4(ldsf, P3_XT); }
      { cparams_t p = params_ptr(); float* W = p->W;
        cvt_stream(p->peer_sub_keys, U16P(F_SK16), (long)8 * 2 * 128 * 128, vb, nb);
        cvt_rows_fp6(p->peer_v, (unsigned char*)(W + F_V8), W + F_SV, 16384, vb, nb); }
    }
    GRID_SYNC();
    { cparams_t p = params_ptr(); float* W = p->W;
      nsa_phase(lds_raw + 64, U16P(F_Q16A), U16P(F_KC16), U16P(F_VCT16), U16P(F_KS16), U16P(F_VST16), U16P(F_KW16), U16P(F_VWT16), W + F_GATES, U16P(F_MIX), W + F_SSQA); }
    { cparams_t p = params_ptr(); float* W = p->W;
      mla_phase(lds_raw + 64, U16P(F_Q16), U16P(F_K16), U16P(F_VT16), U16P(F_MIX), W + F_SSQB); }
    GRID_SYNC();
    { cparams_t p = params_ptr(); float* W = p->W;
      p5_outproj_256(lds_raw + 64, U16P(F_MIX), U16P(F_WTOUT), W + F_SSQA, W + F_SSQB, p->x, p->out, U16P(F_HB), W + F_HSS); }
    GRID_SYNC();
    { cparams_t p = params_ptr(); float* W = p->W;
      p6_peerq_256(lds_raw + 64, U16P(F_HB), U16P(F_WTQ), W + F_HSS, U16P(F_PQB), W + F_PSS); }
    GRID_SYNC();
    { cparams_t p = params_ptr(); float* W = p->W;
      peer_route_mfma(lds_raw + 64, U16P(F_PQB), W + F_PSS, U16P(F_SK16), (int*)(W + F_EO), W + F_GO); }
    GRID_SYNC();
    { cparams_t p = params_ptr(); float* W = p->W;
      peer_sweep_a(W + F_HSS, p->norm2_gain, (const int*)(W + F_EO), W + F_GO, (const unsigned char*)(W + F_U8), W + F_SU, W + F_SV, p->out, W + F_PQB); }
    GRID_SYNC();
    { cparams_t p = params_ptr(); float* W = p->W;
      peer_sweep_b((const int*)(W + F_EO), W + F_PQB, (const unsigned char*)(W + F_V8), p->out); }
}

extern "C" void kernel_launch(void* const* d_in, const int* in_sizes, int n_in, void* d_out, int out_size, void* d_ws, size_t ws_size, hipStream_t stream) {
    (void)ws_size; (void)in_sizes; (void)n_in; (void)out_size;
    static int grid = 0;
    if (grid == 0) {
        int dev = 0, cus = 0, per_cu = 0;
        (void)hipGetDevice(&dev);
        (void)hipDeviceGetAttribute(&cus, hipDeviceAttributeMultiprocessorCount, dev);
        (void)hipFuncSetAttribute((const void*)mega, hipFuncAttributeMaxDynamicSharedMemorySize, LDS_BYTES);
        (void)hipOccupancyMaxActiveBlocksPerMultiprocessor(&per_cu, (const void*)mega, 512, LDS_BYTES);
        (void)hipGetLastError();
        if (per_cu < 1) fprintf(stderr, "kernel_launch: occupancy query reports %d blocks per CU\n", per_cu);
        if (cus != NBLK) fprintf(stderr, "kernel_launch: built for %d CUs, device reports %d\n", NBLK, cus);
        grid = NBLK;
    }
    Params p{};
    p.x = (const float*)d_in[0]; p.positions = (const int*)d_in[1]; p.norm1_gain = (const float*)d_in[2]; p.w_in = (const float*)d_in[3];
    p.nsa_q_gain = (const float*)d_in[4]; p.nsa_kc_gain = (const float*)d_in[5]; p.nsa_ks_gain = (const float*)d_in[6]; p.nsa_kw_gain = (const float*)d_in[7];
    p.cmp_pos = (const float*)d_in[8]; p.cmp_k_w1 = (const float*)d_in[9]; p.cmp_k_w2 = (const float*)d_in[10]; p.cmp_v_w1 = (const float*)d_in[11]; p.cmp_v_w2 = (const float*)d_in[12];
    p.mla_q_lora_gain = (const float*)d_in[13]; p.mla_w_uq = (const float*)d_in[14]; p.mla_kv_lora_gain = (const float*)d_in[15]; p.mla_w_ukv = (const float*)d_in[16];
    p.mla_q_gain = (const float*)d_in[17]; p.mla_k_gain = (const float*)d_in[18]; p.out_gain_a = (const float*)d_in[19]; p.out_gain_b = (const float*)d_in[20]; p.w_out = (const float*)d_in[21];
    p.norm2_gain = (const float*)d_in[22]; p.peer_w_q = (const float*)d_in[23]; p.peer_sub_keys = (const float*)d_in[24]; p.peer_u = (const float*)d_in[25]; p.peer_v = (const float*)d_in[26];
    p.out = (float*)d_out;
    p.bar = (unsigned*)d_ws;
    p.W = (float*)d_ws + 16384;
    (void)hipMemsetAsync(d_ws, 0, XCD_BAR_WORDS * sizeof(unsigned), stream);
    hipLaunchKernelGGL(mega, dim3(grid), dim3(512), LDS_BYTES, stream, p);
}
```

```cpp
#include <hip/hip_runtime.h>
#include <cmath>
#include <cstdint>
#include <cstdio>

#define XB_TMO      128
#define XB_XCNT(j)  (256  + 64 * (j))
#define XB_XSUB(j)  (1280 + 64 * (j))
#define XB_XGEN(j)  (2304 + 64 * (j))
#define XB_TOP      3328
#define XB_TOPGEN   3392
#define XCD_BAR_WORDS 3456
#define XB_SPIN_CAP (1u << 18)
#define LAS __attribute__((address_space(3)))

__device__ __forceinline__ unsigned xb_ld(unsigned* p)              { return __hip_atomic_load(p, __ATOMIC_RELAXED, __HIP_MEMORY_SCOPE_AGENT); }
__device__ __forceinline__ unsigned xb_add(unsigned* p, unsigned v) { return __hip_atomic_fetch_add(p, v, __ATOMIC_RELAXED, __HIP_MEMORY_SCOPE_AGENT); }
__device__ __forceinline__ unsigned xb_xcc_id() { return (unsigned)__builtin_amdgcn_s_getreg((3 << 11) | 20) & 0xFu; }
#define XB_SPIN(cond, bar) do { unsigned _sp = 0; while (cond) { __builtin_amdgcn_s_sleep(1); \
    if ((++_sp & 255u) == 0u) { if (xb_ld(&(bar)[XB_TMO])) break; if (_sp > XB_SPIN_CAP) { atomicAdd(&(bar)[XB_TMO], 1u); break; } } } } while (0)

struct XcdBarrier {
    unsigned* bar; unsigned x;
    volatile LAS unsigned* st;
};

__device__ __forceinline__ XcdBarrier xcd_barrier_post(unsigned* bar, volatile LAS unsigned* st) {
    XcdBarrier b; b.bar = bar; b.x = xb_xcc_id(); b.st = st;
    if (threadIdx.x == 0) (void)xb_add(&bar[XB_XCNT(b.x)], 1u);
    return b;
}
__device__ __forceinline__ void xcd_barrier_complete(unsigned* bar, unsigned x, unsigned& nloc, unsigned& nx) {
    const unsigned G = gridDim.x * gridDim.y * gridDim.z;
    unsigned sum, cnt, mine, sp = 0u;
    for (;;) {
        sum = 0u; cnt = 0u; mine = 0u;
#pragma unroll
        for (unsigned j = 0; j < 16; ++j) { const unsigned c = xb_ld(&bar[XB_XCNT(j)]); sum += c; cnt += (c > 0u) ? 1u : 0u; mine = (j == x) ? c : mine; }
        if (sum == G) break;
        __builtin_amdgcn_s_sleep(1);
        if ((++sp & 255u) == 0u) { if (xb_ld(&bar[XB_TMO])) break; if (sp > XB_SPIN_CAP) { atomicAdd(&bar[XB_TMO], 1u); break; } }
    }
    nloc = mine > 0u ? mine : 1u; nx = cnt > 0u ? cnt : 1u;
}

__device__ __forceinline__ void xcd_barrier(const XcdBarrier& b) {
    asm volatile("s_waitcnt vmcnt(0)" ::: "memory");
    __syncthreads();
    if (threadIdx.x == 0) {
        unsigned* bar = b.bar;
        __builtin_amdgcn_s_waitcnt(0);
        unsigned nloc = b.st[0], nx = b.st[1];
        if (nloc == 0u) { xcd_barrier_complete(bar, b.x, nloc, nx); b.st[0] = nloc; b.st[1] = nx; }
        const unsigned old = xb_add(&bar[XB_XSUB(b.x)], 1u);
        const unsigned gen = old / nloc;
        if (old + 1u == (gen + 1u) * nloc) {
            __builtin_amdgcn_fence(__ATOMIC_RELEASE, "agent");
            asm volatile("s_waitcnt vmcnt(0)" ::: "memory");
            const unsigned og = xb_add(&bar[XB_TOP], 1u);
            const unsigned tg = og / nx;
            if (og + 1u == (tg + 1u) * nx) xb_add(&bar[XB_TOPGEN], 1u);
            else XB_SPIN(xb_ld(&bar[XB_TOPGEN]) == tg, bar);
            __builtin_amdgcn_fence(__ATOMIC_ACQUIRE, "agent");
            xb_add(&bar[XB_XGEN(b.x)], 1u);
            asm volatile("s_waitcnt vmcnt(0)" ::: "memory");
        } else {
            XB_SPIN(xb_ld(&bar[XB_XGEN(b.x)]) == gen, bar);
            __builtin_amdgcn_fence(__ATOMIC_ACQUIRE, "agent");
            asm volatile("s_waitcnt vmcnt(0)" ::: "memory");
        }
    }
    __syncthreads();
}


#define AS1 __attribute__((address_space(1)))
constexpr int NBLK = 256;
constexpr int B_ = 2, S_ = 8192, T_ = B_ * S_, D_ = 1024, INW = 1720;
constexpr int G_ = 2, NCMP = 511;
constexpr float EPS = 1e-6f;
constexpr int C_Q = 0, C_KC = 512, C_VC = 640, C_KS = 768, C_VS = 896, C_KW = 1024, C_VW = 1152, C_GATE = 1280, C_CQ = 1304, C_CKV = 1560, C_KR = 1688;

#define WSYNC() do { __builtin_amdgcn_wave_barrier(); asm volatile("s_waitcnt lgkmcnt(0)" ::: "memory"); __builtin_amdgcn_wave_barrier(); } while (0)

__device__ __forceinline__ int tid_() { int t = threadIdx.x; asm volatile("" : "+v"(t)); return t; }
template <class T> __device__ __forceinline__ T* as_global(T* p) { return (T*)(__attribute__((address_space(1))) T*)p; }
__device__ __forceinline__ float wsum(float v) {
#pragma unroll
    for (int o = 32; o > 0; o >>= 1) v += __shfl_xor(v, o);
    return v;
}
__device__ __forceinline__ float wmax(float v) {
#pragma unroll
    for (int o = 32; o > 0; o >>= 1) v = fmaxf(v, __shfl_xor(v, o));
    return v;
}
__device__ __forceinline__ float gelu_tanh(float x) {
    const float u = 0.7978845608028654f * (x + 0.044715f * x * x * x);
    return 0.5f * x * (1.f + tanhf(u));
}

__device__ const float ROPE_F16[8] = {1.000000000e+00f, 1.939227432e-01f, 3.760603070e-02f, 7.292664610e-03f, 1.414213562e-03f, 2.742481884e-04f, 5.318296098e-05f, 1.031338616e-05f};
__device__ const float ROPE_F32[16] = {1.000000000e+00f, 4.403665960e-01f, 1.939227432e-01f, 8.539710194e-02f, 3.760603070e-02f, 1.656043902e-02f, 7.292664610e-03f, 3.211445874e-03f,
                                       1.414213562e-03f, 6.227723788e-04f, 2.742481884e-04f, 1.207697351e-04f, 5.318296098e-05f, 2.341999971e-05f, 1.031338616e-05f, 4.541670478e-06f};

typedef __attribute__((ext_vector_type(8))) short bf16x8;
typedef __attribute__((ext_vector_type(16))) float f32x16;
typedef __attribute__((ext_vector_type(2))) __bf16 bf16x2_t;
__device__ __forceinline__ unsigned cvtpk(float lo, float hi) { unsigned r; asm("v_cvt_pk_bf16_f32 %0, %1, %2" : "=v"(r) : "v"(lo), "v"(hi)); return r; }
__device__ __forceinline__ float bflo(unsigned u) { return __uint_as_float(u << 16); }
__device__ __forceinline__ float bfhi(unsigned u) { return __uint_as_float(u & 0xffff0000u); }
__device__ __forceinline__ float dot2bf(unsigned a, unsigned b, float c) { return __builtin_amdgcn_fdot2_f32_bf16(__builtin_bit_cast(bf16x2_t, a), __builtin_bit_cast(bf16x2_t, b), c, false); }

__device__ __forceinline__ float pair_max(float x) { auto rr = __builtin_amdgcn_permlane32_swap(__float_as_uint(x), __float_as_uint(x), false, false); return fmaxf(__uint_as_float(rr[0]), __uint_as_float(rr[1])); }
__device__ __forceinline__ float pair_sum(float x) { auto rr = __builtin_amdgcn_permlane32_swap(__float_as_uint(x), __float_as_uint(x), false, false); return __uint_as_float(rr[0]) + __uint_as_float(rr[1]); }
__device__ __forceinline__ float quad_sum(float x) {
    float y = x + __uint_as_float(__builtin_amdgcn_mov_dpp(__float_as_uint(x), 0xB1, 0xF, 0xF, true));
    return y + __uint_as_float(__builtin_amdgcn_mov_dpp(__float_as_uint(y), 0x4E, 0xF, 0xF, true));
}
#define MFMA32(a, b, c) __builtin_amdgcn_mfma_f32_32x32x16_bf16(a, b, c, 0, 0, 0)
typedef unsigned u32x4 __attribute__((ext_vector_type(4)));
constexpr int LDS_PITCH = 144;
__device__ __forceinline__ int crow(int r, int hi) { return (r & 3) + 8 * (r >> 2) + 4 * hi; }

template <int WM_, int WN_, int MI_, int NI_>
struct GemmShape {
    static constexpr int WM = WM_, WN = WN_, MI = MI_, NI = NI_;
    static constexpr int BM = WM * MI * 32, BN = WN * NI * 32, ROWS = BM + BN;
    static constexpr int CHUNKS = ROWS * 8 / 512;
    static constexpr int STAGE_BYTES = ROWS * LDS_PITCH;
    static_assert(WM * WN == 8 && (ROWS * 8) % 512 == 0, "8 waves; whole chunks per thread");
};
template <class SH, unsigned TOKMASK, int CUR>
__device__ __forceinline__ void gemm_step(unsigned char* lds, const unsigned short* const (&gp)[SH::CHUNKS], const int (&lo)[SH::CHUNKS], u32x4 (&g)[2][SH::CHUNKS],
                                          f32x16 (&acc)[SH::MI][SH::NI], int kt, int nk, int aoff, int boff) {
    const unsigned char* st = lds + (kt & 1) * SH::STAGE_BYTES;
    if (kt + 2 < nk) {
#pragma unroll
        for (int i = 0; i < SH::CHUNKS; ++i) g[CUR][i] = *(const u32x4*)(gp[i] + (long)(kt + 2) * 64);
    }
#pragma unroll
    for (int ks = 0; ks < 4; ++ks) {
        bf16x8 af[SH::MI], bfr[SH::NI];
#pragma unroll
        for (int mi = 0; mi < SH::MI; ++mi) af[mi] = *(const bf16x8*)(st + aoff + mi * 32 * LDS_PITCH + ks * 32);
#pragma unroll
        for (int ni = 0; ni < SH::NI; ++ni) bfr[ni] = *(const bf16x8*)(st + boff + ni * 32 * LDS_PITCH + ks * 32);
#pragma unroll
        for (int mi = 0; mi < SH::MI; ++mi)
#pragma unroll
            for (int ni = 0; ni < SH::NI; ++ni)
                acc[mi][ni] = ((TOKMASK >> ni) & 1u) ? MFMA32(bfr[ni], af[mi], acc[mi][ni]) : MFMA32(af[mi], bfr[ni], acc[mi][ni]);
    }
    if (kt + 1 < nk) {
        unsigned char* sn = lds + ((kt + 1) & 1) * SH::STAGE_BYTES;
#pragma unroll
        for (int i = 0; i < SH::CHUNKS; ++i) *(u32x4*)(sn + lo[i]) = g[CUR ^ 1][i];
    }
    __syncthreads();
}
template <class SH, unsigned TOKMASK>
__device__ __forceinline__ void gemm_mainloop(const unsigned short* __restrict__ A0, long lda, const unsigned short* __restrict__ B0, long ldb, int K,
                                              unsigned char* lds, f32x16 (&acc)[SH::MI][SH::NI], int tid) {
    const int lane = tid & 63, wave = __builtin_amdgcn_readfirstlane(tid >> 6), r32 = lane & 31, hi = lane >> 5;
    const int wm = wave / SH::WN, wn = wave % SH::WN;
    const unsigned short* gp[SH::CHUNKS]; int lo[SH::CHUNKS];
#pragma unroll
    for (int i = 0; i < SH::CHUNKS; ++i) {
        const int c = tid + i * 512, row = c >> 3, kc = c & 7;
        gp[i] = (row < SH::BM) ? (A0 + (long)row * lda + kc * 8) : (B0 + (long)(row - SH::BM) * ldb + kc * 8);
        lo[i] = row * LDS_PITCH + kc * 16;
    }
    u32x4 g[2][SH::CHUNKS];
    const int nk = K >> 6;
#pragma unroll
    for (int i = 0; i < SH::CHUNKS; ++i) { g[0][i] = *(const u32x4*)gp[i]; g[1][i] = *(const u32x4*)(gp[i] + 64); }
#pragma unroll
    for (int i = 0; i < SH::CHUNKS; ++i) *(u32x4*)(lds + lo[i]) = g[0][i];
    __syncthreads();
    const int aoff = (wm * SH::MI * 32 + r32) * LDS_PITCH + hi * 16;
    const int boff = (SH::BM + wn * SH::NI * 32 + r32) * LDS_PITCH + hi * 16;
    for (int kt = 0; kt < nk; kt += 2) {
        gemm_step<SH, TOKMASK, 0>(lds, gp, lo, g, acc, kt, nk, aoff, boff);
        gemm_step<SH, TOKMASK, 1>(lds, gp, lo, g, acc, kt + 1, nk, aoff, boff);
    }
}

typedef __attribute__((ext_vector_type(4))) float f32x4_t;
namespace g256 {
constexpr int BK = 64, HALF = 128, HT = HALF * BK;
__device__ __forceinline__ int lds_byte(int r, int c) { const int st = (r >> 4) * 2 + (c >> 5), rr = r & 15, cc = c & 31, ob = rr * 64 + cc * 2; return st * 1024 + (ob ^ (((ob >> 9) & 1) << 5)); }
__device__ __forceinline__ void stage_rc(int b, int& R, int& C) { const int st = b / 1024, sb = b % 1024, swz = sb ^ (((sb >> 9) & 1) << 5); R = (st >> 1) * 16 + swz / 64; C = (st & 1) * 32 + (swz % 64) / 2; }
template <int K, int PITCH = K>
__device__ __forceinline__ void mainloop(const unsigned short* __restrict__ A, const unsigned short* __restrict__ Bt, int brow, int bcol, unsigned short* shm, f32x4_t (&acc)[2][2][4][2]) {
#define SA(b, h) (shm + ((b) * 2 + (h)) * HT)
#define SB(b, h) (shm + (4 + (b) * 2 + (h)) * HT)
#define STAGE_X(T, P, BASE, br, kt) do { const AS1 char* ub_ = (const AS1 char*)(BASE) + ((long)(br) * PITCH + (long)(kt) * BK) * 2;     \
    for (int i_ = 0; i_ < 2; ++i_) { const int b_ = (T) * 16 + i_ * 8192; int r_, c_; stage_rc(b_, r_, c_); \
      __builtin_amdgcn_global_load_lds((const AS1 unsigned*)(ub_ + (unsigned)(r_ * PITCH + c_) * 2u), (LAS unsigned*)((LAS char*)(P) + b_), 16, 0, 0); } } while (0)
#define STAGE(P, BASE, br, kt) STAGE_X(tx, P, BASE, br, kt)
#define LDA(dst, b, h) for (int m = 0; m < 4; ++m) for (int k = 0; k < 2; ++k) dst[m][k] = *reinterpret_cast<const bf16x8*>((char*)SA(b, h) + lds_byte(wr * 64 + m * 16 + fr, k * 32 + fq * 8))
#define LDB(dst, b, h) for (int n = 0; n < 2; ++n) for (int k = 0; k < 2; ++k) dst[n][k] = *reinterpret_cast<const bf16x8*>((char*)SB(b, h) + lds_byte(wc * 32 + n * 16 + fr, k * 32 + fq * 8))
#define MMA(ai, bj, At_, Bt_) do { __builtin_amdgcn_s_setprio(1); \
    for (int m = 0; m < 4; ++m) for (int n = 0; n < 2; ++n) for (int k = 0; k < 2; ++k) acc[ai][bj][m][n] = __builtin_amdgcn_mfma_f32_16x16x32_bf16(At_[m][k], Bt_[n][k], acc[ai][bj][m][n], 0, 0, 0); \
    __builtin_amdgcn_s_setprio(0); } while (0)
#define WAIT_V(n) asm volatile("s_waitcnt vmcnt(" #n ")" ::: "memory")
#define WAIT_L(n) asm volatile("s_waitcnt lgkmcnt(" #n ")" ::: "memory")
#define BAR __builtin_amdgcn_s_barrier()
#define SCHED __builtin_amdgcn_sched_barrier(0)
    int tx = threadIdx.x; asm volatile("" : "+v"(tx));
    int wid = tx >> 6, lane = tx & 63, wr = wid >> 2, wc = wid & 3, fr = lane & 15, fq = lane >> 4;
    bf16x8 At[4][2], B0[2][2], B1[2][2];
    const int nt = K / BK;
    STAGE(SB(0, 0), Bt, bcol, 0); STAGE(SA(0, 0), A, brow, 0);
    STAGE(SB(0, 1), Bt, bcol + HALF, 0); STAGE(SA(0, 1), A, brow + HALF, 0);
    if (wr == 1) BAR;
    WAIT_V(4); BAR;
    STAGE(SB(1, 0), Bt, bcol, 1); STAGE(SA(1, 0), A, brow, 1); STAGE(SB(1, 1), Bt, bcol + HALF, 1);
    WAIT_V(6); BAR;
    for (int t = 0; t < nt - 2; t += 2) {
        LDB(B0, 0, 0); SCHED; LDA(At, 0, 0); STAGE(SA(1, 1), A, brow + HALF, t + 1);
        WAIT_L(8); BAR; WAIT_L(0); MMA(0, 0, At, B0); BAR; SCHED;
        LDB(B1, 0, 1); STAGE(SB(0, 0), Bt, bcol, t + 2);
        BAR; WAIT_L(0); MMA(0, 1, At, B1); BAR;
        LDA(At, 0, 1); STAGE(SA(0, 0), A, brow, t + 2);
        BAR; WAIT_L(0); MMA(1, 0, At, B0); BAR; SCHED;
        STAGE(SB(0, 1), Bt, bcol + HALF, t + 2);
        WAIT_V(6); BAR; MMA(1, 1, At, B1); BAR;
        LDB(B0, 1, 0); SCHED; LDA(At, 1, 0); STAGE(SA(0, 1), A, brow + HALF, t + 2);
        WAIT_L(8); BAR; WAIT_L(0); MMA(0, 0, At, B0); BAR; SCHED;
        LDB(B1, 1, 1); STAGE(SB(1, 0), Bt, bcol, t + 3);
        BAR; WAIT_L(0); MMA(0, 1, At, B1); BAR;
        LDA(At, 1, 1); STAGE(SA(1, 0), A, brow, t + 3);
        BAR; WAIT_L(0); MMA(1, 0, At, B0); BAR; SCHED;
        STAGE(SB(1, 1), Bt, bcol + HALF, t + 3);
        WAIT_V(6); BAR; MMA(1, 1, At, B1); BAR;
    }
    int tz = threadIdx.x; asm volatile("" : "+v"(tz)); wid = tz >> 6; lane = tz & 63; wr = wid >> 2; wc = wid & 3; fr = lane & 15; fq = lane >> 4;
    { LDB(B0, 0, 0); WAIT_V(0); LDA(At, 0, 0); STAGE_X(tz, SA(1, 1), A, brow + HALF, nt - 1);
      BAR; WAIT_L(0); MMA(0, 0, At, B0); BAR;
      LDB(B1, 0, 1); BAR; WAIT_L(0); MMA(0, 1, At, B1); BAR;
      LDA(At, 0, 1); WAIT_V(4); BAR; WAIT_L(0); MMA(1, 0, At, B0); MMA(1, 1, At, B1); BAR; }
    { LDB(B0, 1, 0); LDA(At, 1, 0); WAIT_V(2); BAR; WAIT_L(0); MMA(0, 0, At, B0); BAR;
      LDB(B1, 1, 1); WAIT_V(0); BAR; WAIT_L(0); MMA(0, 1, At, B1); BAR;
      LDA(At, 1, 1); BAR; WAIT_L(0); MMA(1, 0, At, B0); MMA(1, 1, At, B1); BAR; }
    if (wr == 0) BAR;
#undef SA
#undef SB
#undef STAGE_X
#undef STAGE
#undef LDA
#undef LDB
#undef MMA
#undef WAIT_V
#undef WAIT_L
#undef BAR
#undef SCHED
}
}

__device__ __forceinline__ void p5_outproj_256(unsigned char* lds, const unsigned short* __restrict__ mix, const unsigned short* __restrict__ wt_out, const float* __restrict__ ssqa, const float* __restrict__ ssqb,
                                               const float* __restrict__ x, float* __restrict__ out, unsigned short* __restrict__ hb, float* __restrict__ hss) {
    const int vcu = (blockIdx.x & 7) * (NBLK / 8) + (blockIdx.x >> 3);
    for (int tile = vcu; tile < 64 * 4; tile += NBLK) {
        const int m0 = (tile >> 2) * 256, n0 = (tile & 3) * 256;
        f32x4_t acc[2][2][4][2];
#pragma unroll
        for (int ai = 0; ai < 2; ++ai)
#pragma unroll
            for (int bj = 0; bj < 2; ++bj)
#pragma unroll
                for (int m = 0; m < 4; ++m)
#pragma unroll
                    for (int n = 0; n < 2; ++n) acc[ai][bj][m][n] = f32x4_t{0.f, 0.f, 0.f, 0.f};
        g256::mainloop<512, 1024>(wt_out, mix, n0, m0, (unsigned short*)lds, acc);
        float rb[2][2];
        {
            const int tid = tid_(); const int lane = tid & 63, wave = __builtin_amdgcn_readfirstlane(tid >> 6), wc = wave & 3, fr = lane & 15;
#pragma unroll
            for (int bj = 0; bj < 2; ++bj)
#pragma unroll
                for (int n = 0; n < 2; ++n) {
                    const long tok = m0 + bj * 128 + wc * 32 + n * 16 + fr; float sa = 0.f, sb = 0.f;
#pragma unroll
                    for (int hh = 0; hh < 8; ++hh) { sa += ssqa[(long)hh * T_ + tok]; sb += ssqb[(long)hh * T_ + tok]; }
                    rb[bj][n] = rsqrtf(sb * (1.f / 512.f) + EPS); const float ratio = rsqrtf(sa * (1.f / 512.f) + EPS) / rb[bj][n];
#pragma unroll
                    for (int ai = 0; ai < 2; ++ai)
#pragma unroll
                        for (int m = 0; m < 4; ++m) acc[ai][bj][m][n] *= ratio;
                }
        }
        g256::mainloop<512, 1024>(wt_out + 512, mix + 512, n0, m0, (unsigned short*)lds, acc);
        const int tid = tid_(); const int lane = tid & 63, wave = __builtin_amdgcn_readfirstlane(tid >> 6), wr = wave >> 2, wc = wave & 3, fr = lane & 15, fq = lane >> 4;
#pragma unroll
        for (int bj = 0; bj < 2; ++bj)
#pragma unroll
            for (int n = 0; n < 2; ++n) {
                const long tok = m0 + bj * 128 + wc * 32 + n * 16 + fr; const float r = rb[bj][n];
                float ss = 0.f;
#pragma unroll
                for (int ai = 0; ai < 2; ++ai)
#pragma unroll
                    for (int m = 0; m < 4; ++m) {
                        const int nrow = n0 + ai * 128 + wr * 64 + m * 16 + fq * 4;
                        const float4 xv = *(const float4*)(x + tok * 1024 + nrow);
                        float4 hv; hv.x = xv.x + acc[ai][bj][m][n][0] * r; hv.y = xv.y + acc[ai][bj][m][n][1] * r; hv.z = xv.z + acc[ai][bj][m][n][2] * r; hv.w = xv.w + acc[ai][bj][m][n][3] * r;
                        *(float4*)(out + tok * 1024 + nrow) = hv;
                        uint2 pk; pk.x = cvtpk(hv.x, hv.y); pk.y = cvtpk(hv.z, hv.w);
                        *(uint2*)(hb + tok * 1024 + nrow) = pk;
                        ss += hv.x * hv.x + hv.y * hv.y + hv.z * hv.z + hv.w * hv.w;
                    }
                { auto r1 = __builtin_amdgcn_permlane16_swap(__float_as_uint(ss), __float_as_uint(ss), false, false); ss = __uint_as_float(r1[0]) + __uint_as_float(r1[1]); }
                ss = pair_sum(ss);
                if (fq == 0) { hss[tok * 16 + (n0 >> 8) * 4 + wr] = ss; hss[tok * 16 + (n0 >> 8) * 4 + 2 + wr] = 0.f; }
            }
        __syncthreads();
    }
}
__device__ __forceinline__ void p6_peerq_256(unsigned char* lds, const unsigned short* __restrict__ hb, const unsigned short* __restrict__ wt_q, const float* __restrict__ hss,
                                             unsigned short* __restrict__ pqb, float* __restrict__ pss) {
    const int vcu = (blockIdx.x & 7) * (NBLK / 8) + (blockIdx.x >> 3);
    for (int tile = vcu; tile < 64 * 8; tile += NBLK) {
        const int m0 = (tile >> 3) * 256, n0 = (tile & 7) * 256;
        f32x4_t acc[2][2][4][2];
#pragma unroll
        for (int ai = 0; ai < 2; ++ai)
#pragma unroll
            for (int bj = 0; bj < 2; ++bj)
#pragma unroll
                for (int m = 0; m < 4; ++m)
#pragma unroll
                    for (int n = 0; n < 2; ++n) acc[ai][bj][m][n] = f32x4_t{0.f, 0.f, 0.f, 0.f};
        g256::mainloop<1024>(wt_q, hb, n0, m0, (unsigned short*)lds, acc);
        const int tid = tid_(); const int lane = tid & 63, wave = __builtin_amdgcn_readfirstlane(tid >> 6), wr = wave >> 2, wc = wave & 3, fr = lane & 15, fq = lane >> 4;
#pragma unroll
        for (int bj = 0; bj < 2; ++bj)
#pragma unroll
            for (int n = 0; n < 2; ++n) {
                const long tok = m0 + bj * 128 + wc * 32 + n * 16 + fr;
                const float4* hp = (const float4*)(hss + tok * 16);
                const float4 s0 = hp[0], s1 = hp[1], s2 = hp[2], s3 = hp[3];
                const float rs = rsqrtf((s0.x + s0.y + s0.z + s0.w + s1.x + s1.y + s1.z + s1.w + s2.x + s2.y + s2.z + s2.w + s3.x + s3.y + s3.z + s3.w) * (1.f / 1024.f) + EPS);
                float ss = 0.f;
#pragma unroll
                for (int ai = 0; ai < 2; ++ai)
#pragma unroll
                    for (int m = 0; m < 4; ++m) {
                        const int nrow = n0 + ai * 128 + wr * 64 + m * 16 + fq * 4;
                        const float v0 = acc[ai][bj][m][n][0] * rs, v1 = acc[ai][bj][m][n][1] * rs, v2 = acc[ai][bj][m][n][2] * rs, v3 = acc[ai][bj][m][n][3] * rs;
                        uint2 pk; pk.x = cvtpk(v0, v1); pk.y = cvtpk(v2, v3);
                        *(uint2*)(pqb + tok * 2048 + nrow) = pk;
                        ss += v0 * v0 + v1 * v1 + v2 * v2 + v3 * v3;
                    }
                { auto r1 = __builtin_amdgcn_permlane16_swap(__float_as_uint(ss), __float_as_uint(ss), false, false); ss = __uint_as_float(r1[0]) + __uint_as_float(r1[1]); }
                ss = pair_sum(ss);
                if (fq == 0) { pss[tok * 32 + (n0 >> 8) * 4 + wr] = ss; pss[tok * 32 + (n0 >> 8) * 4 + 2 + wr] = 0.f; }
            }
        __syncthreads();
    }
}

__device__ __forceinline__ unsigned ordkey(float f) { const unsigned u = __float_as_uint(f); return (u & 0x80000000u) ? ~u : (u | 0x80000000u); }
__device__ __forceinline__ float orddec(unsigned k) { return __uint_as_float((k & 0x80000000u) ? (k & 0x7fffffffu) : ~k); }
#define CE_DESC(a, b) do { const unsigned mx_ = max(a, b), mn_ = min(a, b); a = mx_; b = mn_; } while (0)
__device__ __forceinline__ void sort16_desc(unsigned (&v)[16]) {
#pragma unroll
    for (int k = 2; k <= 16; k <<= 1)
#pragma unroll
        for (int j = k >> 1; j > 0; j >>= 1)
#pragma unroll
            for (int i = 0; i < 16; ++i) {
                const int l = i ^ j;
                if (l > i) { if ((i & k) == 0) { CE_DESC(v[i], v[l]); } else { CE_DESC(v[l], v[i]); } }
            }
}
__device__ __forceinline__ void merge16_desc(unsigned (&a)[16], const unsigned (&b)[16]) {
#pragma unroll
    for (int i = 0; i < 16; ++i) a[i] = max(a[i], b[15 - i]);
#pragma unroll
    for (int j = 8; j > 0; j >>= 1)
#pragma unroll
        for (int i = 0; i < 16; ++i) { const int l = i ^ j; if (l > i) CE_DESC(a[i], a[l]); }
}
__device__ __forceinline__ void top16_of_lanepair(unsigned (&k0)[16], unsigned (&k1)[16], unsigned (&k2)[16], unsigned (&k3)[16]) {
    sort16_desc(k0); sort16_desc(k1); sort16_desc(k2); sort16_desc(k3);
    merge16_desc(k0, k1); merge16_desc(k2, k3); merge16_desc(k0, k2);
    unsigned o[16];
#pragma unroll
    for (int i = 0; i < 16; ++i) { auto rr = __builtin_amdgcn_permlane32_swap(k0[i], k0[i], false, false); k0[i] = rr[0]; o[i] = rr[1]; }
    merge16_desc(k0, o);
}
__device__ __forceinline__ void peer_route_mfma(unsigned char* lds, const unsigned short* __restrict__ pqb, const float* __restrict__ pss, const unsigned short* __restrict__ sk16, int* __restrict__ eo, float* __restrict__ go) {
    const int tid = tid_(); const int lane = tid & 63, w = __builtin_amdgcn_readfirstlane(tid >> 6), r32 = lane & 31, hi = lane >> 5;
    const int h = blockIdx.x & 7;
    constexpr int SKP = 272;
    for (int c16 = tid; c16 < 256 * 16; c16 += 512) { const int row = c16 >> 4, ch = c16 & 15; *(uint4*)(lds + row * SKP + ch * 16) = *(const uint4*)(sk16 + ((long)h * 256 + row) * 128 + ch * 8); }
    __syncthreads();
    for (int it = 0; it < 2; ++it) {
        const long tok = (long)((blockIdx.x >> 3) * 16 + w * 2 + it) * 32 + r32;
        const float4 ps = *(const float4*)(pss + tok * 32 + h * 4);
        const float rs = rsqrtf((ps.x + ps.y + ps.z + ps.w) * (1.f / 256.f) + EPS);
        unsigned T1[16], T2[16];
#pragma unroll
        for (int c = 0; c < 2; ++c) {
            f32x16 acc[4];
#pragma unroll
            for (int mt = 0; mt < 4; ++mt)
#pragma unroll
                for (int r = 0; r < 16; ++r) acc[mt][r] = 0.f;
            const unsigned short* qrow = pqb + tok * 2048 + h * 256 + c * 128 + hi * 8;
            const unsigned char* krow = lds + (c * 128 + r32) * SKP + hi * 16;
#pragma unroll 2
            for (int ks = 0; ks < 8; ++ks) {
                const bf16x8 qf = *(const bf16x8*)(qrow + ks * 16);
#pragma unroll
                for (int mt = 0; mt < 4; ++mt) { const bf16x8 kf = *(const bf16x8*)(krow + mt * 32 * SKP + ks * 32); acc[mt] = MFMA32(kf, qf, acc[mt]); }
            }
            unsigned k0[16], k1[16], k2[16], k3[16];
#pragma unroll
            for (int r = 0; r < 16; ++r) {
                const unsigned idx = 127u - (unsigned)crow(r, hi);
                k0[r] = (ordkey(acc[0][r] * rs) & ~127u) | idx; k1[r] = (ordkey(acc[1][r] * rs) & ~127u) | (idx - 32u);
                k2[r] = (ordkey(acc[2][r] * rs) & ~127u) | (idx - 64u); k3[r] = (ordkey(acc[3][r] * rs) & ~127u) | (idx - 96u);
            }
            top16_of_lanepair(k0, k1, k2, k3);
            if (c == 0) {
#pragma unroll
                for (int i = 0; i < 16; ++i) T1[i] = k0[i];
            } else {
#pragma unroll
                for (int i = 0; i < 16; ++i) T2[i] = k0[i];
            }
        }
        float v1[16], v2[16]; unsigned p1[4] = {0u, 0u, 0u, 0u}, p2[4] = {0u, 0u, 0u, 0u};
#pragma unroll
        for (int i = 0; i < 16; ++i) {
            v1[i] = orddec(T1[i] & ~127u); v2[i] = orddec(T2[i] & ~127u);
            p1[i >> 2] |= (127u - (T1[i] & 127u)) << (8 * (i & 3)); p2[i >> 2] |= (127u - (T2[i] & 127u)) << (8 * (i & 3));
        }
        unsigned c0[16], c1[16], c2[16], c3[16];
#define CAND(a, b) ((ordkey(v1[a] + v2[b]) & ~255u) | (255u - (unsigned)((a) * 16 + (b))))
        c0[0] = CAND(0, 0); c0[1] = CAND(0, 1); c0[2] = CAND(0, 2); c0[3] = CAND(0, 3); c0[4] = CAND(0, 4); c0[5] = CAND(0, 5); c0[6] = CAND(0, 6); c0[7] = CAND(0, 7);
        c0[8] = CAND(0, 8); c0[9] = CAND(0, 9); c0[10] = CAND(0, 10); c0[11] = CAND(0, 11); c0[12] = CAND(0, 12); c0[13] = CAND(0, 13); c0[14] = CAND(0, 14); c0[15] = CAND(0, 15);
        c1[0] = CAND(1, 0); c1[1] = CAND(1, 1); c1[2] = CAND(1, 2); c1[3] = CAND(1, 3); c1[4] = CAND(1, 4); c1[5] = CAND(1, 5); c1[6] = CAND(1, 6); c1[7] = CAND(1, 7);
        c1[8] = CAND(2, 0); c1[9] = CAND(2, 1); c1[10] = CAND(2, 2); c1[11] = CAND(2, 3); c1[12] = CAND(2, 4); c1[13] = CAND(3, 0); c1[14] = CAND(3, 1); c1[15] = CAND(3, 2);
        c2[0] = CAND(3, 3); c2[1] = CAND(4, 0); c2[2] = CAND(4, 1); c2[3] = CAND(4, 2); c2[4] = CAND(5, 0); c2[5] = CAND(5, 1); c2[6] = CAND(6, 0); c2[7] = CAND(6, 1);
        c2[8] = CAND(7, 0); c2[9] = CAND(7, 1); c2[10] = CAND(8, 0); c2[11] = CAND(9, 0); c2[12] = CAND(10, 0); c2[13] = CAND(11, 0); c2[14] = CAND(12, 0); c2[15] = CAND(13, 0);
        c3[0] = CAND(14, 0); c3[1] = CAND(15, 0);
#pragma unroll
        for (int i = 2; i < 16; ++i) c3[i] = 0u;
#undef CAND
        sort16_desc(c0); sort16_desc(c1); sort16_desc(c2); sort16_desc(c3);
        merge16_desc(c0, c1); merge16_desc(c2, c3); merge16_desc(c0, c2);
        float ev[16]; int ee[16]; float l = 0.f; const float mx = orddec(c0[0] & ~255u);
#pragma unroll
        for (int i = 0; i < 16; ++i) {
            const unsigned ci = 255u - (c0[i] & 255u); const unsigned a = ci >> 4, b = ci & 15u;
            const unsigned wa = (a >> 2) == 0 ? p1[0] : ((a >> 2) == 1 ? p1[1] : ((a >> 2) == 2 ? p1[2] : p1[3]));
            const unsigned wb = (b >> 2) == 0 ? p2[0] : ((b >> 2) == 1 ? p2[1] : ((b >> 2) == 2 ? p2[2] : p2[3]));
            const unsigned i1 = (wa >> (8 * (a & 3u))) & 255u, i2 = (wb >> (8 * (b & 3u))) & 255u;
            ee[i] = (int)(i1 * 128u + i2);
            ev[i] = __expf(orddec(c0[i] & ~255u) - mx); l += ev[i];
        }
        const float inv = 1.f / l;
        if (hi == 0) {
            int4* ep = (int4*)(eo + tok * 128 + h * 16);
            ep[0] = make_int4(ee[0], ee[1], ee[2], ee[3]); ep[1] = make_int4(ee[4], ee[5], ee[6], ee[7]); ep[2] = make_int4(ee[8], ee[9], ee[10], ee[11]); ep[3] = make_int4(ee[12], ee[13], ee[14], ee[15]);
        } else {
            float4* gp = (float4*)(go + tok * 128 + h * 16);
            gp[0] = make_float4(ev[0] * inv, ev[1] * inv, ev[2] * inv, ev[3] * inv); gp[1] = make_float4(ev[4] * inv, ev[5] * inv, ev[6] * inv, ev[7] * inv);
            gp[2] = make_float4(ev[8] * inv, ev[9] * inv, ev[10] * inv, ev[11] * inv); gp[3] = make_float4(ev[12] * inv, ev[13] * inv, ev[14] * inv, ev[15] * inv);
        }
    }
}

template <int DQK>
struct FA {
    static constexpr int NDS = DQK / 16, KP = DQK * 2 + 16, KBYTES = 64 * KP, VP = 144, VBYTES = 64 * VP, STAGE = KBYTES + VBYTES;
    static constexpr int KCH = 64 * DQK / 8, NCH = KCH + 512, SLOTS = (NCH + 511) / 512;
};
constexpr float FA_THR = 8.f;
constexpr float FA_NEG = -1e30f;
struct FaRegs { uint4 g0, g1, g2; };
template <int DQK>
__device__ __forceinline__ uint4 fa_load1(const unsigned short* __restrict__ Kg, int kpitch, const unsigned short* __restrict__ Vg, int vpitch, int tid, int i) {
    int c = tid + i * 512; if (c >= FA<DQK>::NCH) c = 0;
    const int key = c / (DQK / 8), kc = c % (DQK / 8); const int c2 = c - FA<DQK>::KCH; const int d = c2 >> 3, vc = c2 & 7;
    const unsigned koff = (unsigned)(key * kpitch + kc * 8) * 2u, voff = (unsigned)(d * vpitch + vc * 8) * 2u;
#if defined(__HIP_DEVICE_COMPILE__)
    typedef unsigned u32x4_t __attribute__((ext_vector_type(4)));
    const u32x4_t v = (c < FA<DQK>::KCH) ? *(const AS1 u32x4_t*)((const AS1 char*)Kg + koff) : *(const AS1 u32x4_t*)((const AS1 char*)Vg + voff);
    return make_uint4(v.x, v.y, v.z, v.w);
#else
    (void)koff; (void)voff; return make_uint4(0u, 0u, 0u, 0u);
#endif
}
template <int DQK>
__device__ __forceinline__ void fa_store1(unsigned char* st, const uint4& g, int tid, int i) {
    const int c = tid + i * 512;
    const int key = c / (DQK / 8), kc = c % (DQK / 8); const int c2 = c - FA<DQK>::KCH; const int d = c2 >> 3, vc = c2 & 7;
    const int off = (c < FA<DQK>::KCH) ? (key * FA<DQK>::KP + kc * 16) : (FA<DQK>::KBYTES + d * FA<DQK>::VP + vc * 16);
    if (c < FA<DQK>::NCH) *(uint4*)(st + off) = g;
}
template <int DQK>
__device__ __forceinline__ void fa_load(const unsigned short* __restrict__ Kg, int kpitch, const unsigned short* __restrict__ Vg, int vpitch, FaRegs& g, int tid) {
    g.g0 = fa_load1<DQK>(Kg, kpitch, Vg, vpitch, tid, 0); g.g1 = fa_load1<DQK>(Kg, kpitch, Vg, vpitch, tid, 1);
    if (FA<DQK>::SLOTS > 2) g.g2 = fa_load1<DQK>(Kg, kpitch, Vg, vpitch, tid, 2);
}
template <int DQK>
__device__ __forceinline__ void fa_store(unsigned char* st, const FaRegs& g, int tid) {
    fa_store1<DQK>(st, g.g0, tid, 0); fa_store1<DQK>(st, g.g1, tid, 1);
    if (FA<DQK>::SLOTS > 2) fa_store1<DQK>(st, g.g2, tid, 2);
}
template <int DQK, int MODE, bool STATS_ONLY = false>
__device__ __forceinline__ void fa_tile(const unsigned char* st, const bf16x8 (&qf)[FA<DQK>::NDS], f32x16 (&o)[2], float& mref, float& l, int key0, int qpos, int lane, bool need_mask, bool colsel = true) {
    asm volatile("" : "+v"(lane));
    const int r32 = lane & 31, hi = lane >> 5;
    f32x16 s0, s1;
#pragma unroll
    for (int r = 0; r < 16; ++r) { s0[r] = 0.f; s1[r] = 0.f; }
    {
        bf16x8 k0 = *(const bf16x8*)(st + r32 * FA<DQK>::KP + hi * 16);
        bf16x8 k1 = *(const bf16x8*)(st + (32 + r32) * FA<DQK>::KP + hi * 16);
#pragma unroll
        for (int ds = 0; ds < FA<DQK>::NDS; ++ds) {
            bf16x8 n0 = k0, n1 = k1;
            if (ds + 1 < FA<DQK>::NDS) {
                n0 = *(const bf16x8*)(st + r32 * FA<DQK>::KP + (ds + 1) * 32 + hi * 16);
                n1 = *(const bf16x8*)(st + (32 + r32) * FA<DQK>::KP + (ds + 1) * 32 + hi * 16);
            }
            s0 = MFMA32(k0, qf[ds], s0); s1 = MFMA32(k1, qf[ds], s1);
            k0 = n0; k1 = n1;
            __builtin_amdgcn_sched_barrier(0);
        }
    }
    __builtin_amdgcn_sched_barrier(0);
    if (MODE != 0 && need_mask) {
#pragma unroll
        for (int r = 0; r < 16; ++r) {
            const int ka = key0 + crow(r, hi), kb = ka + 32;
            bool ma, mb;
            if (MODE == 4) { ma = 16 * ka + 31 > qpos; mb = 16 * kb + 31 > qpos; }
            else { ma = ka > qpos; mb = kb > qpos; }
            if (MODE == 2) { ma = ma || (ka <= qpos - 512); mb = mb || (kb <= qpos - 512); }
            if (ma) s0[r] = -INFINITY;
            if (mb) s1[r] = -INFINITY;
        }
    }
    if (MODE == 3) {
        if (!colsel) {
#pragma unroll
            for (int r = 0; r < 16; ++r) { s0[r] = -INFINITY; s1[r] = -INFINITY; }
        }
    }
    float mx = fmaxf(s0[0], s1[0]);
#pragma unroll
    for (int r = 1; r < 16; ++r) mx = fmaxf(mx, fmaxf(s0[r], s1[r]));
    mx = pair_max(mx);
    if (__any(mx > mref + FA_THR)) {
        const float mnew = (mx > mref + FA_THR) ? mx : mref;
        const float alpha = __builtin_amdgcn_exp2f(mref - mnew);
        mref = mnew; l *= alpha;
#pragma unroll
        for (int r = 0; r < 16; ++r) { o[0][r] *= alpha; o[1][r] *= alpha; }
    }
    float ps = 0.f;
#pragma unroll
    for (int r = 0; r < 16; ++r) { s0[r] = __builtin_amdgcn_exp2f(s0[r] - mref); s1[r] = __builtin_amdgcn_exp2f(s1[r] - mref); ps += s0[r] + s1[r]; }
    l += ps;
    if (STATS_ONLY) return;
    bf16x8 pk[4];
#pragma unroll
    for (int s = 0; s < 2; ++s) {
        uint4 a, b;
        a.x = cvtpk(s0[8 * s], s0[8 * s + 1]); a.y = cvtpk(s0[8 * s + 2], s0[8 * s + 3]); a.z = cvtpk(s0[8 * s + 4], s0[8 * s + 5]); a.w = cvtpk(s0[8 * s + 6], s0[8 * s + 7]);
        b.x = cvtpk(s1[8 * s], s1[8 * s + 1]); b.y = cvtpk(s1[8 * s + 2], s1[8 * s + 3]); b.z = cvtpk(s1[8 * s + 4], s1[8 * s + 5]); b.w = cvtpk(s1[8 * s + 6], s1[8 * s + 7]);
        pk[s] = __builtin_bit_cast(bf16x8, a); pk[2 + s] = __builtin_bit_cast(bf16x8, b);
    }
    const unsigned char* vt = st + FA<DQK>::KBYTES;
    __builtin_amdgcn_sched_barrier(0);
    {
        bf16x8 v0 = *(const bf16x8*)(vt + r32 * FA<DQK>::VP + hi * 16);
        bf16x8 v1 = *(const bf16x8*)(vt + (32 + r32) * FA<DQK>::VP + hi * 16);
#pragma unroll
        for (int ks = 0; ks < 4; ++ks) {
            bf16x8 n0 = v0, n1 = v1;
            if (ks + 1 < 4) {
                n0 = *(const bf16x8*)(vt + r32 * FA<DQK>::VP + (ks + 1) * 32 + hi * 16);
                n1 = *(const bf16x8*)(vt + (32 + r32) * FA<DQK>::VP + (ks + 1) * 32 + hi * 16);
            }
            o[0] = MFMA32(v0, pk[ks], o[0]); o[1] = MFMA32(v1, pk[ks], o[1]);
            v0 = n0; v1 = n1;
            __builtin_amdgcn_sched_barrier(0);
        }
    }
}
template <int DQK>
__device__ __forceinline__ void fa_qk(const unsigned char* st, const bf16x8 (&qf)[FA<DQK>::NDS], f32x16& s0, f32x16& s1, int lane) {
    const int r32 = lane & 31, hi = lane >> 5;
#pragma unroll
    for (int r = 0; r < 16; ++r) { s0[r] = 0.f; s1[r] = 0.f; }
#pragma unroll
    for (int ds = 0; ds < FA<DQK>::NDS; ++ds) {
        const bf16x8 k0 = *(const bf16x8*)(st + r32 * FA<DQK>::KP + ds * 32 + hi * 16);
        const bf16x8 k1 = *(const bf16x8*)(st + (32 + r32) * FA<DQK>::KP + ds * 32 + hi * 16);
        s0 = MFMA32(k0, qf[ds], s0); s1 = MFMA32(k1, qf[ds], s1);
    }
}
template <int DQK, int MODE>
__device__ __forceinline__ void fa_step(const unsigned char* stc, const unsigned char* stn, const bf16x8 (&qf)[FA<DQK>::NDS], f32x16& s0, f32x16& s1, f32x16& n0, f32x16& n1,
                                        f32x16 (&o)[2], float& mref, float& l, int key0, int qpos, int lane, bool need_mask, bool colsel = true) {
    const int r32 = lane & 31, hi = lane >> 5;
    if (MODE != 0 && need_mask) {
#pragma unroll
        for (int r = 0; r < 16; ++r) {
            const int ka = key0 + crow(r, hi), kb = ka + 32;
            bool ma, mb;
            if (MODE == 4) { ma = 16 * ka + 31 > qpos; mb = 16 * kb + 31 > qpos; }
            else { ma = ka > qpos; mb = kb > qpos; }
            if (MODE == 2) { ma = ma || (ka <= qpos - 512); mb = mb || (kb <= qpos - 512); }
            if (ma) s0[r] = -INFINITY;
            if (mb) s1[r] = -INFINITY;
        }
    }
    if (MODE == 3) {
        if (!colsel) {
#pragma unroll
            for (int r = 0; r < 16; ++r) { s0[r] = -INFINITY; s1[r] = -INFINITY; }
        }
    }
    float mx = fmaxf(s0[0], s1[0]);
#pragma unroll
    for (int r = 1; r < 16; ++r) mx = fmaxf(mx, fmaxf(s0[r], s1[r]));
    mx = pair_max(mx);
    if (__any(mx > mref + FA_THR)) {
        const float mnew = (mx > mref + FA_THR) ? mx : mref;
        const float alpha = __builtin_amdgcn_exp2f(mref - mnew);
        mref = mnew; l *= alpha;
#pragma unroll
        for (int r = 0; r < 16; ++r) { o[0][r] *= alpha; o[1][r] *= alpha; }
    }
    __builtin_amdgcn_sched_barrier(0);
#pragma unroll
    for (int r = 0; r < 16; ++r) { n0[r] = 0.f; n1[r] = 0.f; }
    float ps = 0.f;
    constexpr int PER = (32 + FA<DQK>::NDS - 1) / FA<DQK>::NDS;
    {
        bf16x8 k0 = *(const bf16x8*)(stn + r32 * FA<DQK>::KP + hi * 16);
        bf16x8 k1 = *(const bf16x8*)(stn + (32 + r32) * FA<DQK>::KP + hi * 16);
#pragma unroll
        for (int ds = 0; ds < FA<DQK>::NDS; ++ds) {
            bf16x8 f0 = k0, f1 = k1;
            if (ds + 1 < FA<DQK>::NDS) {
                f0 = *(const bf16x8*)(stn + r32 * FA<DQK>::KP + (ds + 1) * 32 + hi * 16);
                f1 = *(const bf16x8*)(stn + (32 + r32) * FA<DQK>::KP + (ds + 1) * 32 + hi * 16);
            }
            n0 = MFMA32(k0, qf[ds], n0); n1 = MFMA32(k1, qf[ds], n1);
#pragma unroll
            for (int j = ds * PER; j < (ds + 1) * PER && j < 32; ++j) {
                if (j < 16) { s0[j] = __builtin_amdgcn_exp2f(s0[j] - mref); ps += s0[j]; }
                else { s1[j - 16] = __builtin_amdgcn_exp2f(s1[j - 16] - mref); ps += s1[j - 16]; }
            }
            asm volatile("" : "+v"(ps));
            k0 = f0; k1 = f1;
            __builtin_amdgcn_sched_barrier(0);
        }
    }
    l += ps;
    bf16x8 pk[4];
#pragma unroll
    for (int s = 0; s < 2; ++s) {
        uint4 a, b;
        a.x = cvtpk(s0[8 * s], s0[8 * s + 1]); a.y = cvtpk(s0[8 * s + 2], s0[8 * s + 3]); a.z = cvtpk(s0[8 * s + 4], s0[8 * s + 5]); a.w = cvtpk(s0[8 * s + 6], s0[8 * s + 7]);
        b.x = cvtpk(s1[8 * s], s1[8 * s + 1]); b.y = cvtpk(s1[8 * s + 2], s1[8 * s + 3]); b.z = cvtpk(s1[8 * s + 4], s1[8 * s + 5]); b.w = cvtpk(s1[8 * s + 6], s1[8 * s + 7]);
        pk[s] = __builtin_bit_cast(bf16x8, a); pk[2 + s] = __builtin_bit_cast(bf16x8, b);
    }
    const unsigned char* vt = stc + FA<DQK>::KBYTES;
    {
        bf16x8 v0 = *(const bf16x8*)(vt + r32 * FA<DQK>::VP + hi * 16);
        bf16x8 v1 = *(const bf16x8*)(vt + (32 + r32) * FA<DQK>::VP + hi * 16);
#pragma unroll
        for (int ks = 0; ks < 4; ++ks) {
            bf16x8 f0 = v0, f1 = v1;
            if (ks + 1 < 4) {
                f0 = *(const bf16x8*)(vt + r32 * FA<DQK>::VP + (ks + 1) * 32 + hi * 16);
                f1 = *(const bf16x8*)(vt + (32 + r32) * FA<DQK>::VP + (ks + 1) * 32 + hi * 16);
            }
            o[0] = MFMA32(v0, pk[ks], o[0]); o[1] = MFMA32(v1, pk[ks], o[1]);
            v0 = f0; v1 = f1;
            __builtin_amdgcn_sched_barrier(0);
        }
    }
}
__device__ __forceinline__ int vperm(int s) { const int g = (s >> 2) & 3; const int pg = (g == 1) ? 2 : ((g == 2) ? 1 : g); return (s & ~15) | (pg << 2) | (s & 3); }

constexpr float MLA_QSCALE = 0.10206207261596575f * 1.4426950408889634f;
__device__ __forceinline__ void mla_unit(unsigned char* lds, int b, int h, int qb, const unsigned short* __restrict__ Q16, const unsigned short* __restrict__ K16, const unsigned short* __restrict__ VT16,
                                         unsigned short* __restrict__ ob16, float* __restrict__ ssqb, int tid) {
    typedef FA<96> F;
    const int lane = tid & 63, wave = __builtin_amdgcn_readfirstlane(tid >> 6), r32 = lane & 31, hi = lane >> 5;
    const int q0 = qb * 256, qpos = q0 + wave * 32 + r32; const long tok = (long)b * S_ + qpos;
    bf16x8 qf[F::NDS];
#pragma unroll
    for (int ds = 0; ds < F::NDS; ++ds) qf[ds] = *(const bf16x8*)(Q16 + tok * 768 + h * 96 + ds * 16 + hi * 8);
    f32x16 o[2];
#pragma unroll
    for (int r = 0; r < 16; ++r) { o[0][r] = 0.f; o[1][r] = 0.f; }
    float mref = FA_NEG, l = 0.f;
    const unsigned short* Kb = K16 + ((long)(b * 8 + h)) * S_ * 96;
    const unsigned short* Vb = VT16 + ((long)(b * 8 + h)) * 64 * S_;
    const int nt = (q0 + 256) / 64;
    FaRegs g;
    fa_load<96>(Kb, 96, Vb, S_, g, tid); fa_store<96>(lds, g, tid);
    fa_load<96>(Kb + (long)64 * 96, 96, Vb + 64, S_, g, tid); fa_store<96>(lds + F::STAGE, g, tid);
    __syncthreads();
    const int wmin = q0 + wave * 32, wmax = wmin + 31;
    f32x16 sa0, sa1, sb0, sb1;
    fa_qk<96>(lds, qf, sa0, sa1, lane);
#define MLA_STEP(C0, C1, N0, N1, t) do { \
        const int sc_ = (t) % 3, sn_ = ((t) + 1) % 3, sw_ = ((t) + 2) % 3; \
        if ((t) + 2 < nt) fa_load<96>(Kb + (long)((t) + 2) * 64 * 96, 96, Vb + ((t) + 2) * 64, S_, g, tid); \
        const int key0 = (t) * 64; \
        if (key0 <= wmax) fa_step<96, 1>(lds + sc_ * F::STAGE, lds + sn_ * F::STAGE, qf, C0, C1, N0, N1, o, mref, l, key0, qpos, lane, key0 + 63 > wmin); \
        if ((t) + 2 < nt) fa_store<96>(lds + sw_ * F::STAGE, g, tid); \
        __syncthreads(); } while (0)
    for (int t = 0; t < nt; t += 2) {
        MLA_STEP(sa0, sa1, sb0, sb1, t);
        MLA_STEP(sb0, sb1, sa0, sa1, t + 1);
    }
#undef MLA_STEP
    l = pair_sum(l);
    const float inv = 1.f / l;
    float ss = 0.f;
#pragma unroll
    for (int dt = 0; dt < 2; ++dt)
#pragma unroll
        for (int gq = 0; gq < 4; ++gq) {
            const float v0 = o[dt][4 * gq] * inv, v1 = o[dt][4 * gq + 1] * inv, v2 = o[dt][4 * gq + 2] * inv, v3 = o[dt][4 * gq + 3] * inv;
            uint2 pk; pk.x = cvtpk(v0, v1); pk.y = cvtpk(v2, v3);
            *(uint2*)(ob16 + tok * 1024 + 512 + h * 64 + dt * 32 + 8 * gq + 4 * hi) = pk;
            ss += v0 * v0 + v1 * v1 + v2 * v2 + v3 * v3;
        }
    ss = pair_sum(ss);
    if (hi == 0) ssqb[(long)h * T_ + tok] = ss;
}
__device__ __forceinline__ void mla_phase(unsigned char* lds, const unsigned short* __restrict__ Q16, const unsigned short* __restrict__ K16, const unsigned short* __restrict__ VT16,
                                          unsigned short* __restrict__ ob16, float* __restrict__ ssqb) {
    const int tid = tid_();
    for (int i = blockIdx.x; i < 256; i += NBLK) {
        const int xcd = i & 7, slot = i >> 3;
        { const int bh = xcd * 2; mla_unit(lds, bh >> 3, bh & 7, 31 - slot, Q16, K16, VT16, ob16, ssqb, tid); }
        { const int bh = xcd * 2 + 1; mla_unit(lds, bh >> 3, bh & 7, slot, Q16, K16, VT16, ob16, ssqb, tid); }
    }
}
constexpr float NSA_QSCALE = 0.125f * 1.4426950408889634f;
constexpr int IMP_PITCH = 129;
__device__ __forceinline__ void fa_tile_cmp2(const unsigned char* st, const bf16x8 (&qf)[4], f32x16 (&o)[2], float mref, float linv, int key0, int qpos, int lane, float* imp_row) {
    typedef FA<64> F;
    asm volatile("" : "+v"(lane));
    const int r32 = lane & 31, hi = lane >> 5;
    f32x16 s0, s1;
#pragma unroll
    for (int r = 0; r < 16; ++r) { s0[r] = 0.f; s1[r] = 0.f; }
#pragma unroll
    for (int ds = 0; ds < 4; ++ds) {
        const bf16x8 k0 = *(const bf16x8*)(st + r32 * F::KP + ds * 32 + hi * 16);
        const bf16x8 k1 = *(const bf16x8*)(st + (32 + r32) * F::KP + ds * 32 + hi * 16);
        s0 = MFMA32(k0, qf[ds], s0); s1 = MFMA32(k1, qf[ds], s1);
    }
#pragma unroll
    for (int r = 0; r < 16; ++r) {
        const int ka = key0 + crow(r, hi), kb = ka + 32;
        s0[r] = (16 * ka + 31 > qpos) ? 0.f : __builtin_amdgcn_exp2f(s0[r] - mref) * linv;
        s1[r] = (16 * kb + 31 > qpos) ? 0.f : __builtin_amdgcn_exp2f(s1[r] - mref) * linv;
    }
    bf16x8 pk[4];
#pragma unroll
    for (int s = 0; s < 2; ++s) {
        uint4 a, b;
        a.x = cvtpk(s0[8 * s], s0[8 * s + 1]); a.y = cvtpk(s0[8 * s + 2], s0[8 * s + 3]); a.z = cvtpk(s0[8 * s + 4], s0[8 * s + 5]); a.w = cvtpk(s0[8 * s + 6], s0[8 * s + 7]);
        b.x = cvtpk(s1[8 * s], s1[8 * s + 1]); b.y = cvtpk(s1[8 * s + 2], s1[8 * s + 3]); b.z = cvtpk(s1[8 * s + 4], s1[8 * s + 5]); b.w = cvtpk(s1[8 * s + 6], s1[8 * s + 7]);
        pk[s] = __builtin_bit_cast(bf16x8, a); pk[2 + s] = __builtin_bit_cast(bf16x8, b);
    }
    const unsigned char* vt = st + F::KBYTES;
#pragma unroll
    for (int ks = 0; ks < 4; ++ks) {
        const bf16x8 v0 = *(const bf16x8*)(vt + r32 * F::VP + ks * 32 + hi * 16);
        const bf16x8 v1 = *(const bf16x8*)(vt + (32 + r32) * F::VP + ks * 32 + hi * 16);
        o[0] = MFMA32(v0, pk[ks], o[0]); o[1] = MFMA32(v1, pk[ks], o[1]);
    }
#pragma unroll
    for (int r = 0; r < 16; ++r) {
        s0[r] = quad_sum(s0[r]); s1[r] = quad_sum(s1[r]);
    }
    if ((lane & 3) == 0) {
#pragma unroll
        for (int g4 = 0; g4 < 4; ++g4) {
            { const int j = (key0 + 8 * g4 + 4 * hi) >> 2;
              atomicAdd(imp_row + j, s0[4 * g4] + s0[4 * g4 + 1] + s0[4 * g4 + 2] + s0[4 * g4 + 3]);
              if (j + 1 < 128) atomicAdd(imp_row + j + 1, s0[4 * g4 + 3]); }
            { const int j = (key0 + 32 + 8 * g4 + 4 * hi) >> 2;
              atomicAdd(imp_row + j, s1[4 * g4] + s1[4 * g4 + 1] + s1[4 * g4 + 2] + s1[4 * g4 + 3]);
              if (j + 1 < 128) atomicAdd(imp_row + j + 1, s1[4 * g4 + 3]); }
        }
    }
}
#define NSA_STEP_(GCUR, GNEXT, Kbase, kpitch, Vbase, vpitch, t_lo, t_hi, t_, ...) do { \
        const unsigned char* st = stg + (((t_) - (t_lo)) & 1) * FA<64>::STAGE; \
        if ((t_) + 2 <= (t_hi)) fa_load<64>((Kbase) + (long)((t_) + 2) * 64 * (kpitch), (kpitch), (Vbase) + ((t_) + 2) * 64, (vpitch), GCUR, tid); \
        const int key0 = (t_) * 64; (void)key0; \
        __VA_ARGS__ \
        if ((t_) + 1 <= (t_hi)) fa_store<64>(stg + (((t_) + 1 - (t_lo)) & 1) * FA<64>::STAGE, GNEXT, tid); \
        __syncthreads(); } while (0)
#define NSA_STREAM(Kbase, kpitch, Vbase, vpitch, t_lo, t_hi, ...) do { \
    FaRegs ga_, gb_; fa_load<64>((Kbase) + (long)(t_lo) * 64 * (kpitch), (kpitch), (Vbase) + (t_lo) * 64, (vpitch), ga_, tid); \
    if ((t_lo) + 1 <= (t_hi)) fa_load<64>((Kbase) + (long)((t_lo) + 1) * 64 * (kpitch), (kpitch), (Vbase) + ((t_lo) + 1) * 64, (vpitch), gb_, tid); \
    fa_store<64>(stg, ga_, tid); __syncthreads(); \
    for (int t_ = (t_lo); t_ <= (t_hi); t_ += 2) { \
        NSA_STEP_(ga_, gb_, Kbase, kpitch, Vbase, vpitch, t_lo, t_hi, t_, __VA_ARGS__); \
        if (t_ + 1 <= (t_hi)) { const int tt_ = t_ + 1; NSA_STEP2_(gb_, ga_, Kbase, kpitch, Vbase, vpitch, t_lo, t_hi, tt_, __VA_ARGS__); } \
    } } while (0)
#define NSA_STEP2_(GCUR, GNEXT, Kbase, kpitch, Vbase, vpitch, t_lo, t_hi, tq_, ...) do { \
        const int t_ = tq_; \
        const unsigned char* st = stg + ((t_ - (t_lo)) & 1) * FA<64>::STAGE; \
        if (t_ + 2 <= (t_hi)) fa_load<64>((Kbase) + (long)(t_ + 2) * 64 * (kpitch), (kpitch), (Vbase) + (t_ + 2) * 64, (vpitch), GCUR, tid); \
        const int key0 = t_ * 64; (void)key0; \
        __VA_ARGS__ \
        if (t_ + 1 <= (t_hi)) fa_store<64>(stg + ((t_ + 1 - (t_lo)) & 1) * FA<64>::STAGE, GNEXT, tid); \
        __syncthreads(); } while (0)

__device__ __forceinline__ void nsa_unit(unsigned char* lds, int b, int g, int qblk, const unsigned short* __restrict__ Q16A, const unsigned short* __restrict__ KC16, const unsigned short* __restrict__ VCT16,
                                         const unsigned short* __restrict__ KS16, const unsigned short* __restrict__ VST16, const unsigned short* __restrict__ KW16, const unsigned short* __restrict__ VWT16,
                                         const float* __restrict__ gates, unsigned short* __restrict__ oa16, float* __restrict__ ssqa, int tid) {
    typedef FA<64> F;
    const int lane = tid & 63, wave = __builtin_amdgcn_readfirstlane(tid >> 6), r32 = lane & 31, hi = lane >> 5;
    unsigned char* stg = lds;
    float* imp = (float*)(lds + 2 * F::STAGE);
    unsigned* selm = (unsigned*)(lds + 2 * F::STAGE + 64 * IMP_PITCH * 4);
    const int q0 = qblk * 64, cur = qblk;
    const int ql = wave * 8 + (r32 >> 2), hh = g * 4 + (r32 & 3), qpos = q0 + ql; const long tok = (long)b * S_ + qpos; const int bg = b * 2 + g;
    bf16x8 qf[4];
#pragma unroll
    for (int ds = 0; ds < 4; ++ds) qf[ds] = *(const bf16x8*)(Q16A + tok * 512 + hh * 64 + ds * 16 + hi * 8);
    for (int i = tid; i < 64 * IMP_PITCH; i += 512) imp[i] = 0.f;
    f32x16 acc[2], o[2];
#pragma unroll
    for (int r = 0; r < 16; ++r) { acc[0][r] = 0.f; acc[1][r] = 0.f; }
    const int wq_lo = q0 + wave * 8, wq_hi = wq_lo + 7;
    const int nvis_max = (q0 + 63 >= 31) ? ((q0 + 63 - 31) / 16 + 1) : 0;
    if (nvis_max > 0) {
        const int tc_hi = (nvis_max - 1) >> 6;
        const unsigned short* Kc = KC16 + (long)bg * 512 * 64; const unsigned short* Vc = VCT16 + (long)bg * 64 * 512;
        float mref = FA_NEG, l = 0.f;
        NSA_STREAM(Kc, 64, Vc, 512, 0, tc_hi, {
            if (16 * key0 + 31 <= wq_hi) fa_tile<64, 4, true>(st, qf, o, mref, l, key0, qpos, lane, 16 * (key0 + 63) + 31 > wq_lo);
        });
        l = pair_sum(l);
        const float linv = (l > 0.f) ? 1.f / l : 0.f;
#pragma unroll
        for (int r = 0; r < 16; ++r) { o[0][r] = 0.f; o[1][r] = 0.f; }
        NSA_STREAM(Kc, 64, Vc, 512, 0, tc_hi, {
            if (16 * key0 + 31 <= wq_hi) fa_tile_cmp2(st, qf, o, mref, linv, key0, qpos, lane, imp + ql * IMP_PITCH);
        });
        const float g_c = gates[tok * 24 + hh * 3];
#pragma unroll
        for (int r = 0; r < 16; ++r) { acc[0][r] += g_c * o[0][r]; acc[1][r] += g_c * o[1][r]; }
    } else { __syncthreads(); }
    if (wave < 2) {
        const int qi = wave * 32 + r32;
        int his = hi; asm volatile("" : "+v"(his));
#define IMPKEY(jj) ({ const int j_ = (jj); const float v_ = (j_ == 0 || j_ == cur) ? 1e9f : ((j_ > cur) ? -1e30f : imp[qi * IMP_PITCH + j_]); (ordkey(v_) & ~127u) | (127u - (unsigned)j_); })
        unsigned k0[16];
        {
            unsigned k1[16];
#pragma unroll
            for (int i = 0; i < 16; ++i) { k0[i] = IMPKEY(his * 64 + i); k1[i] = IMPKEY(his * 64 + 16 + i); }
            sort16_desc(k0); sort16_desc(k1); merge16_desc(k0, k1);
        }
        __builtin_amdgcn_sched_barrier(0);
        {
            unsigned k2[16], k3[16];
#pragma unroll
            for (int i = 0; i < 16; ++i) { k2[i] = IMPKEY(his * 64 + 32 + i); k3[i] = IMPKEY(his * 64 + 48 + i); }
            sort16_desc(k2); sort16_desc(k3); merge16_desc(k2, k3); merge16_desc(k0, k2);
        }
#undef IMPKEY
        {
            unsigned o2[16];
#pragma unroll
            for (int i = 0; i < 16; ++i) { auto rr = __builtin_amdgcn_permlane32_swap(k0[i], k0[i], false, false); k0[i] = rr[0]; o2[i] = rr[1]; }
            merge16_desc(k0, o2);
        }
        unsigned m0 = 0u, m1 = 0u, m2 = 0u, m3 = 0u;
#pragma unroll
        for (int i = 0; i < 16; ++i) {
            const unsigned j = 127u - (k0[i] & 127u); const unsigned bit = 1u << (j & 31u); const unsigned wsel = j >> 5;
            m0 |= (wsel == 0u) ? bit : 0u; m1 |= (wsel == 1u) ? bit : 0u; m2 |= (wsel == 2u) ? bit : 0u; m3 |= (wsel == 3u) ? bit : 0u;
        }
        if (hi == 0) { selm[qi * 4] = m0; selm[qi * 4 + 1] = m1; selm[qi * 4 + 2] = m2; selm[qi * 4 + 3] = m3; }
    }
    __syncthreads();
    unsigned sm0 = selm[ql * 4], sm1 = selm[ql * 4 + 1], sm2 = selm[ql * 4 + 2], sm3 = selm[ql * 4 + 3];
    {
        float mref = FA_NEG, l = 0.f;
#pragma unroll
        for (int r = 0; r < 16; ++r) { o[0][r] = 0.f; o[1][r] = 0.f; }
        const unsigned short* Ks = KS16 + (long)bg * S_ * 64; const unsigned short* Vs = VST16 + (long)bg * 64 * S_;
        NSA_STREAM(Ks, 64, Vs, S_, 0, cur, {
            const int jw = t_ >> 5; const unsigned wsel = (jw == 0) ? sm0 : ((jw == 1) ? sm1 : ((jw == 2) ? sm2 : sm3));
            const bool colsel = (wsel >> (t_ & 31)) & 1u;
            if (__any(colsel)) fa_tile<64, 3>(st, qf, o, mref, l, key0, qpos, lane, t_ == cur, colsel);
        });
        l = pair_sum(l);
        const float sc = gates[tok * 24 + hh * 3 + 1] / l;
#pragma unroll
        for (int r = 0; r < 16; ++r) { acc[0][r] += sc * o[0][r]; acc[1][r] += sc * o[1][r]; }
    }
    {
        float mref = FA_NEG, l = 0.f;
#pragma unroll
        for (int r = 0; r < 16; ++r) { o[0][r] = 0.f; o[1][r] = 0.f; }
        const unsigned short* Kw = KW16 + (long)bg * S_ * 64; const unsigned short* Vw = VWT16 + (long)bg * 64 * S_;
        const int tw_lo = (cur >= 8) ? cur - 8 : 0;
        NSA_STREAM(Kw, 64, Vw, S_, tw_lo, cur, {
            fa_tile<64, 2>(st, qf, o, mref, l, key0, qpos, lane, (t_ == cur) || (t_ == cur - 8));
        });
        l = pair_sum(l);
        const float sc = gates[tok * 24 + hh * 3 + 2] / l;
#pragma unroll
        for (int r = 0; r < 16; ++r) { acc[0][r] += sc * o[0][r]; acc[1][r] += sc * o[1][r]; }
    }
    float ss = 0.f;
#pragma unroll
    for (int dt = 0; dt < 2; ++dt)
#pragma unroll
        for (int gq = 0; gq < 4; ++gq) {
            const float v0 = acc[dt][4 * gq], v1 = acc[dt][4 * gq + 1], v2 = acc[dt][4 * gq + 2], v3 = acc[dt][4 * gq + 3];
            uint2 pk; pk.x = cvtpk(v0, v1); pk.y = cvtpk(v2, v3);
            *(uint2*)(oa16 + tok * 1024 + hh * 64 + dt * 32 + 8 * gq + 4 * hi) = pk;
            ss += v0 * v0 + v1 * v1 + v2 * v2 + v3 * v3;
        }
    ss = pair_sum(ss);
    if (hi == 0) ssqa[(long)hh * T_ + tok] = ss;
    __syncthreads();
}
__device__ __forceinline__ void nsa_phase(unsigned char* lds, const unsigned short* __restrict__ Q16A, const unsigned short* __restrict__ KC16, const unsigned short* __restrict__ VCT16,
                                          const unsigned short* __restrict__ KS16, const unsigned short* __restrict__ VST16, const unsigned short* __restrict__ KW16, const unsigned short* __restrict__ VWT16,
                                          const float* __restrict__ gates, unsigned short* __restrict__ oa16, float* __restrict__ ssqa) {
    const int tid = tid_();
    for (int i = blockIdx.x; i < 256; i += NBLK) {
        const int xcd = i & 7, slot = i >> 3; const int bg = xcd >> 1, pr = (xcd & 1) * 32 + slot;
        nsa_unit(lds, bg >> 1, bg & 1, 127 - pr, Q16A, KC16, VCT16, KS16, VST16, KW16, VWT16, gates, oa16, ssqa, tid);
        nsa_unit(lds, bg >> 1, bg & 1, pr, Q16A, KC16, VCT16, KS16, VST16, KW16, VWT16, gates, oa16, ssqa, tid);
    }
}
__device__ __forceinline__ int nmap_in2(int n) {
    if (n < 768) return n;
    if (n < 896) return n;
    if (n < 1024) return n - 896 + 1024;
    if (n < 1152) return n - 1024 + 896;
    if (n < 1280) return n;
    if (n < 1304) return n - 1280 + 1696;
    if (n < 1560) return n - 1304 + 1280;
    if (n < 1688) return n - 1560 + 1536;
    return n - 1688 + 1664;
}
struct XT { const float* src; unsigned short* dst; const float* glo; const float* ghi; int K, N, ksplit, tile, nmap; };
__device__ __forceinline__ XT xt_make(const float* src, int K, int N, unsigned short* dst, const float* glo, const float* ghi, int ksplit, int nmap, int tile) {
    XT d; d.src = src; d.dst = dst; d.glo = glo; d.ghi = ghi; d.K = K; d.N = N; d.ksplit = ksplit; d.tile = tile; d.nmap = nmap; return d;
}
__device__ __forceinline__ void xt_load(const XT& d, float (&v)[8], int tid) {
    if (d.tile < 0) return;
    const int tn = (d.N + 63) >> 6; const int k0 = (d.tile / tn) * 64, n0 = (d.tile % tn) * 64;
    const float* __restrict__ s = as_global(d.src);
#pragma unroll
    for (int i = 0; i < 8; ++i) {
        const int kl = (tid >> 6) + 8 * i, n = n0 + (tid & 63), k = k0 + kl;
        float x = (n < d.N) ? s[(long)k * d.N + n] : 0.f;
        if (d.glo) x *= (k < d.ksplit) ? d.glo[k] : d.ghi[k - d.ksplit];
        v[i] = x;
    }
}
__device__ __forceinline__ void xt_store(const XT& d, const float (&v)[8], float* buf, int tid) {
    if (d.tile < 0) return;
    float (*tl)[65] = (float (*)[65])buf;
    const int tn = (d.N + 63) >> 6; const int k0 = (d.tile / tn) * 64, n0 = (d.tile % tn) * 64;
#pragma unroll
    for (int i = 0; i < 8; ++i) tl[(tid >> 6) + 8 * i][tid & 63] = v[i];
    __syncthreads();
    const int nl = tid >> 3, kc = (tid & 7) * 8; const int n = n0 + nl;
    if (n < d.N) {
        uint4 o; o.x = cvtpk(tl[kc][nl], tl[kc + 1][nl]); o.y = cvtpk(tl[kc + 2][nl], tl[kc + 3][nl]); o.z = cvtpk(tl[kc + 4][nl], tl[kc + 5][nl]); o.w = cvtpk(tl[kc + 6][nl], tl[kc + 7][nl]);
        const int nn = d.nmap ? nmap_in2(n) : n;
        *(uint4*)(d.dst + (long)nn * d.K + k0 + kc) = o;
    }
}
#define XT_RUN4(ldsf_, MAKE) do { const int tid_x = tid_(); float xv0[8], xv1[8], xv2[8], xv3[8]; \
    const XT xd0 = MAKE(0), xd1 = MAKE(1), xd2 = MAKE(2), xd3 = MAKE(3); \
    xt_load(xd0, xv0, tid_x); xt_load(xd1, xv1, tid_x); xt_load(xd2, xv2, tid_x); xt_load(xd3, xv3, tid_x); \
    xt_store(xd0, xv0, (ldsf_), tid_x); xt_store(xd1, xv1, (ldsf_) + 64 * 65, tid_x); xt_store(xd2, xv2, (ldsf_), tid_x); xt_store(xd3, xv3, (ldsf_) + 64 * 65, tid_x); __syncthreads(); } while (0)
__device__ __forceinline__ void p0_xn_rope(const float* __restrict__ x, const float* __restrict__ g1, const int* __restrict__ positions, unsigned short* __restrict__ xn16, float* __restrict__ rope) {
    const int tid = tid_(); const int lane = tid & 63, w = __builtin_amdgcn_readfirstlane(tid >> 6);
    const f32x4_t* gp = (const f32x4_t*)g1; const f32x4_t ga0 = gp[lane * 2], ga1 = gp[lane * 2 + 1], gb0 = gp[128 + lane * 2], gb1 = gp[128 + lane * 2 + 1];
    for (int t0 = blockIdx.x * 8 + w; t0 < T_; t0 += 4 * NBLK * 8) {
        f32x4_t v[4][4]; int pos[4];
#pragma unroll
        for (int j = 0; j < 4; ++j) {
            const int t = t0 + j * NBLK * 8;
            const f32x4_t* xp = (const f32x4_t*)(x + (long)t * 1024);
            v[j][0] = xp[lane * 2]; v[j][1] = xp[lane * 2 + 1]; v[j][2] = xp[128 + lane * 2]; v[j][3] = xp[128 + lane * 2 + 1];
            pos[j] = positions[t];
        }
#pragma unroll
        for (int j = 0; j < 4; ++j) {
            const int t = t0 + j * NBLK * 8;
            const f32x4_t a0 = v[j][0], a1 = v[j][1], b0 = v[j][2], b1 = v[j][3];
            float ss = a0.x * a0.x + a0.y * a0.y + a0.z * a0.z + a0.w * a0.w + a1.x * a1.x + a1.y * a1.y + a1.z * a1.z + a1.w * a1.w
                     + b0.x * b0.x + b0.y * b0.y + b0.z * b0.z + b0.w * b0.w + b1.x * b1.x + b1.y * b1.y + b1.z * b1.z + b1.w * b1.w;
            ss = wsum(ss); const float rs = rsqrtf(ss * (1.f / 1024.f) + EPS);
            uint4 pa, pb;
            pa.x = cvtpk(a0.x * rs * ga0.x, a0.y * rs * ga0.y); pa.y = cvtpk(a0.z * rs * ga0.z, a0.w * rs * ga0.w); pa.z = cvtpk(a1.x * rs * ga1.x, a1.y * rs * ga1.y); pa.w = cvtpk(a1.z * rs * ga1.z, a1.w * rs * ga1.w);
            pb.x = cvtpk(b0.x * rs * gb0.x, b0.y * rs * gb0.y); pb.y = cvtpk(b0.z * rs * gb0.z, b0.w * rs * gb0.w); pb.z = cvtpk(b1.x * rs * gb1.x, b1.y * rs * gb1.y); pb.w = cvtpk(b1.z * rs * gb1.z, b1.w * rs * gb1.w);
            ((uint4*)(xn16 + (long)t * 1024))[lane] = pa; ((uint4*)(xn16 + (long)t * 1024))[64 + lane] = pb;
            if (lane < 24) {
                const float f = lane < 8 ? ROPE_F16[lane] : ROPE_F32[lane - 8];
                const float angf = (float)pos[j] * f;
                const double ang = (double)angf; const double k = rint(ang * 0.15915494309189535);
                const float r = (float)(ang - k * 6.283185307179586);
                const float c = cosf(r), sn = sinf(r);
                if (lane < 8) { rope[(long)t * 48 + lane] = c; rope[(long)t * 48 + 8 + lane] = sn; }
                else { rope[(long)t * 48 + 16 + lane - 8] = c; rope[(long)t * 48 + 32 + lane - 8] = sn; }
            }
        }
    }
}
__device__ __forceinline__ void p0_cbias(const float* __restrict__ pos, const float* __restrict__ w1k, const float* __restrict__ w1v, float* __restrict__ cbias) {
    const int tid = tid_(); const int lane = tid & 63, w = __builtin_amdgcn_readfirstlane(tid >> 6);
    for (int task = blockIdx.x * 8 + w; task < 512; task += NBLK * 8) {
        const int mat = task >> 8, n = task & 255; const float* w1 = mat ? w1v : w1k;
        float acc = 0.f;
#pragma unroll 8
        for (int i = 0; i < 32; ++i) { const int k = lane + 64 * i; acc += pos[k] * w1[(long)k * 256 + n]; }
        acc = wsum(acc);
        if (lane == 0) cbias[task] = acc;
    }
}
__device__ __forceinline__ void zero_stream(unsigned short* __restrict__ p, long n) {
    const int tid = tid_();
    for (long c = (long)blockIdx.x * 512 + tid; c < (n >> 3); c += (long)NBLK * 512) ((uint4*)p)[c] = make_uint4(0u, 0u, 0u, 0u);
}

struct P1Out {
    unsigned short *q16a, *ks16, *kw16, *vst16, *vwt16, *kcmp16, *vcmp16, *cq16, *ckv16;
    float *krr, *ssq_kr, *ssq_cq, *ssq_ckv, *gates;
    const float *rope, *q_gain, *ks_gain, *kw_gain, *k_gain;
};
__device__ __forceinline__ void norm_rope64(f32x16& a0, f32x16& a1, const float* __restrict__ gain, const float* __restrict__ rope_t, int hi, float outscale) {
    float ss = 0.f;
#pragma unroll
    for (int r = 0; r < 16; ++r) ss += a0[r] * a0[r] + a1[r] * a1[r];
    ss = pair_sum(ss);
    const float rs = rsqrtf(ss * (1.f / 64.f) + EPS);
#pragma unroll
    for (int g = 0; g < 4; ++g) {
        const float4 g0 = *(const float4*)(gain + 8 * g + 4 * hi), g1 = *(const float4*)(gain + 32 + 8 * g + 4 * hi);
        a0[4 * g] *= rs * g0.x; a0[4 * g + 1] *= rs * g0.y; a0[4 * g + 2] *= rs * g0.z; a0[4 * g + 3] *= rs * g0.w;
        a1[4 * g] *= rs * g1.x; a1[4 * g + 1] *= rs * g1.y; a1[4 * g + 2] *= rs * g1.z; a1[4 * g + 3] *= rs * g1.w;
    }
    const float4 c4 = *(const float4*)(rope_t + 4 * hi), s4 = *(const float4*)(rope_t + 8 + 4 * hi);
    const float cc[4] = {c4.x, c4.y, c4.z, c4.w}, sn[4] = {s4.x, s4.y, s4.z, s4.w};
#pragma unroll
    for (int j = 0; j < 4; ++j) { const float x1 = a0[j], x2 = a0[4 + j]; a0[j] = x1 * cc[j] - x2 * sn[j]; a0[4 + j] = x2 * cc[j] + x1 * sn[j]; }
#pragma unroll
    for (int r = 0; r < 16; ++r) { a0[r] *= outscale; a1[r] *= outscale; }
}
__device__ __forceinline__ void store_row64(unsigned short* __restrict__ dst, const f32x16& a0, const f32x16& a1, int hi) {
#pragma unroll
    for (int g = 0; g < 4; ++g) {
        uint2 p0, p1; p0.x = cvtpk(a0[4 * g], a0[4 * g + 1]); p0.y = cvtpk(a0[4 * g + 2], a0[4 * g + 3]); p1.x = cvtpk(a1[4 * g], a1[4 * g + 1]); p1.y = cvtpk(a1[4 * g + 2], a1[4 * g + 3]);
        *(uint2*)(dst + 8 * g + 4 * hi) = p0; *(uint2*)(dst + 32 + 8 * g + 4 * hi) = p1;
    }
}
__device__ __forceinline__ float ssq64(const f32x16& a0, const f32x16& a1) {
    float ss = 0.f;
#pragma unroll
    for (int r = 0; r < 16; ++r) ss += a0[r] * a0[r] + a1[r] * a1[r];
    return pair_sum(ss);
}
__device__ __forceinline__ float sum4fq(float v) {
    auto r1 = __builtin_amdgcn_permlane16_swap(__float_as_uint(v), __float_as_uint(v), false, false);
    return pair_sum(__uint_as_float(r1[0]) + __uint_as_float(r1[1]));
}
#define P1V(m, j) acc[ai][bj][m][n][j]
__device__ __forceinline__ void p1_inproj_256(unsigned char* lds, const unsigned short* __restrict__ xn16, const unsigned short* __restrict__ wt_in, const P1Out& Oin) {
    const P1Out O = Oin;
    const int tbase = (blockIdx.x & 7) * 56;
    for (int tile = tbase + (blockIdx.x >> 3); tile < tbase + 56; tile += 32) {
        const int mt = tile / 7, nt = tile % 7; const int m0 = mt * 256;
        f32x4_t acc[2][2][4][2];
#pragma unroll
        for (int ai = 0; ai < 2; ++ai)
#pragma unroll
            for (int bj = 0; bj < 2; ++bj)
#pragma unroll
                for (int m = 0; m < 4; ++m)
#pragma unroll
                    for (int n = 0; n < 2; ++n) acc[ai][bj][m][n] = f32x4_t{0.f, 0.f, 0.f, 0.f};
        if (nt == 4) g256::mainloop<1024>(xn16, wt_in, m0, nt * 256, (unsigned short*)lds, acc);
        else g256::mainloop<1024>(wt_in, xn16, nt * 256, m0, (unsigned short*)lds, acc);
        const int tid = tid_(); const int lane = tid & 63, wave = __builtin_amdgcn_readfirstlane(tid >> 6), wr = wave >> 2, wc = wave & 3, fr = lane & 15, fq = lane >> 4;
        if (nt == 4) {
#pragma unroll
            for (int bj = 0; bj < 2; ++bj)
#pragma unroll
                for (int n = 0; n < 2; ++n) {
                    const int pc = bj * 2 + (wc >> 1), d = (wc & 1) * 32 + n * 16 + fr;
                    unsigned short* vt = (pc < 2) ? O.vst16 : O.vwt16; const int g = pc & 1;
#pragma unroll
                    for (int ai = 0; ai < 2; ++ai)
#pragma unroll
                        for (int m = 0; m < 4; ++m) {
                            const int tb = m0 + ai * 128 + wr * 64 + m * 16 + fq * 4; const int b = tb / S_, s0 = tb % S_;
                            uint2 pk; pk.x = cvtpk(P1V(m, 0), P1V(m, 1)); pk.y = cvtpk(P1V(m, 2), P1V(m, 3));
                            *(uint2*)(vt + ((long)(b * 2 + g) * 64 + d) * S_ + vperm(s0)) = pk;
                        }
                }
        } else {
#pragma unroll
            for (int ai = 0; ai < 2; ++ai) {
                const int pc = ai * 2 + wr;
#pragma unroll
                for (int bj = 0; bj < 2; ++bj)
#pragma unroll
                    for (int n = 0; n < 2; ++n) {
                        const long tok = m0 + bj * 128 + wc * 32 + n * 16 + fr; const int b = (int)(tok / S_), s = (int)(tok % S_);
                        const float* rope_t = O.rope + tok * 48;
                        const bool is_q = nt < 2, is_k = nt == 3;
                        if (is_q || is_k) {
                            const float* gain = is_q ? O.q_gain : ((pc < 2) ? O.ks_gain : O.kw_gain);
                            float ss = 0.f;
#pragma unroll
                            for (int m = 0; m < 4; ++m)
#pragma unroll
                                for (int j = 0; j < 4; ++j) ss += P1V(m, j) * P1V(m, j);
                            const float rs = rsqrtf(sum4fq(ss) * (1.f / 64.f) + EPS) ;
#pragma unroll
                            for (int m = 0; m < 4; ++m) { const float4 gv = *(const float4*)(gain + m * 16 + fq * 4);
                                P1V(m, 0) *= rs * gv.x; P1V(m, 1) *= rs * gv.y; P1V(m, 2) *= rs * gv.z; P1V(m, 3) *= rs * gv.w; }
                            { const float4 c4 = *(const float4*)(rope_t + (fq & 1) * 4), s4 = *(const float4*)(rope_t + 8 + (fq & 1) * 4);
                              const float cc[4] = {c4.x, c4.y, c4.z, c4.w}, sn[4] = {s4.x, s4.y, s4.z, s4.w};
#pragma unroll
                              for (int j = 0; j < 4; ++j) {
                                  auto rr = __builtin_amdgcn_permlane32_swap(__float_as_uint(P1V(0, j)), __float_as_uint(P1V(0, j)), false, false);
                                  const float x1 = __uint_as_float(rr[0]), x2 = __uint_as_float(rr[1]);
                                  P1V(0, j) = (fq < 2) ? (x1 * cc[j] - x2 * sn[j]) : (x2 * cc[j] + x1 * sn[j]);
                              } }
                            const float osc = is_q ? NSA_QSCALE : 1.f;
                            unsigned short* dst = is_q ? (O.q16a + tok * 512 + (nt * 4 + pc) * 64) : ((pc < 2 ? O.ks16 : O.kw16) + ((long)(b * 2 + (pc & 1)) * S_ + s) * 64);
#pragma unroll
                            for (int m = 0; m < 4; ++m) { uint2 pk; pk.x = cvtpk(P1V(m, 0) * osc, P1V(m, 1) * osc); pk.y = cvtpk(P1V(m, 2) * osc, P1V(m, 3) * osc); *(uint2*)(dst + m * 16 + fq * 4) = pk; }
                        } else if (nt == 2 || nt == 5 || (nt == 6 && pc < 2)) {
                            unsigned short* dst;
                            if (nt == 2) dst = (pc < 2 ? O.kcmp16 : O.vcmp16) + ((long)(b * 2 + (pc & 1)) * S_ + s) * 64;
                            else if (nt == 5) dst = O.cq16 + tok * 256 + pc * 64;
                            else dst = O.ckv16 + tok * 128 + pc * 64;
                            float ss = 0.f;
#pragma unroll
                            for (int m = 0; m < 4; ++m) { uint2 pk; pk.x = cvtpk(P1V(m, 0), P1V(m, 1)); pk.y = cvtpk(P1V(m, 2), P1V(m, 3)); *(uint2*)(dst + m * 16 + fq * 4) = pk;
#pragma unroll
                                for (int j = 0; j < 4; ++j) ss += P1V(m, j) * P1V(m, j); }
                            if (nt != 2) { ss = sum4fq(ss); if (fq == 0) { if (nt == 5) O.ssq_cq[(long)pc * T_ + tok] = ss; else O.ssq_ckv[(long)pc * T_ + tok] = ss; } }
                        } else if (nt == 6 && pc == 2) {
                            float ss = 0.f;
#pragma unroll
                            for (int m = 0; m < 2; ++m)
#pragma unroll
                                for (int j = 0; j < 4; ++j) ss += P1V(m, j) * P1V(m, j);
                            ss = sum4fq(ss);
                            if (fq == 0) O.ssq_kr[tok] = ss;
                            {
                                const float4 g0 = *(const float4*)(O.k_gain + 64 + fq * 4), g1 = *(const float4*)(O.k_gain + 80 + fq * 4);
                                const float4 c4 = *(const float4*)(rope_t + 16 + fq * 4), s4 = *(const float4*)(rope_t + 32 + fq * 4);
                                const float ga[4] = {g0.x, g0.y, g0.z, g0.w}, gb[4] = {g1.x, g1.y, g1.z, g1.w}, cc[4] = {c4.x, c4.y, c4.z, c4.w}, sn[4] = {s4.x, s4.y, s4.z, s4.w};
                                float o1[4], o2[4];
#pragma unroll
                                for (int j = 0; j < 4; ++j) { const float x1 = P1V(0, j) * ga[j], x2 = P1V(1, j) * gb[j]; o1[j] = x1 * cc[j] - x2 * sn[j]; o2[j] = x2 * cc[j] + x1 * sn[j]; }
                                *(float4*)(O.krr + tok * 32 + fq * 4) = make_float4(o1[0], o1[1], o1[2], o1[3]);
                                *(float4*)(O.krr + tok * 32 + 16 + fq * 4) = make_float4(o2[0], o2[1], o2[2], o2[3]);
                            }
                            *(float4*)(O.gates + tok * 24 + fq * 4) = make_float4(1.f / (1.f + __expf(-P1V(2, 0))), 1.f / (1.f + __expf(-P1V(2, 1))), 1.f / (1.f + __expf(-P1V(2, 2))), 1.f / (1.f + __expf(-P1V(2, 3))));
                            if (fq < 2) *(float4*)(O.gates + tok * 24 + 16 + fq * 4) = make_float4(1.f / (1.f + __expf(-P1V(3, 0))), 1.f / (1.f + __expf(-P1V(3, 1))), 1.f / (1.f + __expf(-P1V(3, 2))), 1.f / (1.f + __expf(-P1V(3, 3))));
                        }
                    }
            }
        }
        __syncthreads();
    }
}
#undef P1V

typedef GemmShape<2, 4, 2, 2> ShBig;
typedef GemmShape<4, 2, 1, 3> ShQb;
typedef GemmShape<4, 2, 1, 4> ShKvb;
struct P2Args {
    const unsigned short *cq16, *ckv16, *wt_uq, *wt_ukv, *kcmp16, *vcmp16, *w1t_k, *w1t_v;
    const float *ssq_cq, *ssq_ckv, *ssq_kr, *krr, *rope, *q_gain, *k_gain;
    unsigned short *q16, *k16, *vt16; float* hid;
};
__device__ __forceinline__ void p2_phase(unsigned char* lds, const P2Args& A) {
    const int tid = tid_(); const int lane = tid & 63, wave = __builtin_amdgcn_readfirstlane(tid >> 6), r32 = lane & 31, hi = lane >> 5;
    const int nmine = (blockIdx.x < 128) ? 4 : 5;
    for (int it = 0; it < nmine; ++it) {
        int u;
        if (blockIdx.x < 128) { if (it == 0) u = blockIdx.x; else { const int s = blockIdx.x * 3 + (it - 1); u = (s & 1) ? 640 + (s >> 1) : 128 + (s >> 1); } }
        else { const int s = 384 + (blockIdx.x - 128) * 5 + it; u = (s & 1) ? 640 + (s >> 1) : 128 + (s >> 1); }
        if (u < 128) {
            const int mat = u >> 6, mtile = (u >> 2) & 15, ks = u & 3; const int wm = wave >> 2, wn = wave & 3;
            f32x16 acc[2][2];
#pragma unroll
            for (int mi = 0; mi < 2; ++mi)
#pragma unroll
                for (int ni = 0; ni < 2; ++ni)
#pragma unroll
                    for (int r = 0; r < 16; ++r) acc[mi][ni][r] = 0.f;
            gemm_mainloop<ShBig, 3u>((mat ? A.vcmp16 : A.kcmp16) + (long)mtile * 128 * 1024 + ks * 512, 1024, (mat ? A.w1t_v : A.w1t_k) + ks * 512, 2048, 512, lds, acc, tid);
            float* slab = A.hid + (long)(mat * 4 + ks) * 2048 * 256;
#pragma unroll
            for (int mi = 0; mi < 2; ++mi) {
                const long row = mtile * 128 + wm * 64 + mi * 32 + r32;
#pragma unroll
                for (int ni = 0; ni < 2; ++ni)
#pragma unroll
                    for (int g = 0; g < 4; ++g)
                        *(float4*)(slab + row * 256 + wn * 64 + ni * 32 + 8 * g + 4 * hi) = make_float4(acc[mi][ni][4 * g], acc[mi][ni][4 * g + 1], acc[mi][ni][4 * g + 2], acc[mi][ni][4 * g + 3]);
            }
        } else if (u < 128 + 512) {
            const int v = u - 128; const int mt = v >> 2, nt = v & 3; const int m0 = mt * 128; const int wm = wave >> 1, wn = wave & 1; const int head = nt * 2 + wn;
            f32x16 acc[1][4];
#pragma unroll
            for (int ni = 0; ni < 4; ++ni)
#pragma unroll
                for (int r = 0; r < 16; ++r) acc[0][ni][r] = 0.f;
            const long tok = m0 + wm * 32 + r32;
            const float e_c0 = A.ssq_ckv[tok], e_c1 = A.ssq_ckv[(long)T_ + tok], e_kr = A.ssq_kr[tok];
            f32x4_t e_k[4];
#pragma unroll
            for (int i = 0; i < 4; ++i) e_k[i] = ((const f32x4_t*)(A.krr + tok * 32 + hi * 16))[i];
            gemm_mainloop<ShKvb, 3u>(A.ckv16 + (long)m0 * 128, 128, A.wt_ukv + (long)nt * 256 * 128, 128, 128, lds, acc, tid);
            {
                const int b = (int)(tok / S_), s = (int)(tok % S_);
                const float rc = rsqrtf((e_c0 + e_c1) * (1.f / 128.f) + EPS);
                float ss = 0.f;
#pragma unroll
                for (int r = 0; r < 16; ++r) { acc[0][0][r] *= rc; acc[0][1][r] *= rc; ss += acc[0][0][r] * acc[0][0][r] + acc[0][1][r] * acc[0][1][r]; }
                ss = pair_sum(ss) + e_kr;
                const float rk = rsqrtf(ss * (1.f / 96.f) + EPS);
#pragma unroll
                for (int g = 0; g < 4; ++g) {
                    const float4 g0 = *(const float4*)(A.k_gain + 8 * g + 4 * hi), g1 = *(const float4*)(A.k_gain + 32 + 8 * g + 4 * hi);
                    acc[0][0][4 * g] *= rk * g0.x; acc[0][0][4 * g + 1] *= rk * g0.y; acc[0][0][4 * g + 2] *= rk * g0.z; acc[0][0][4 * g + 3] *= rk * g0.w;
                    acc[0][1][4 * g] *= rk * g1.x; acc[0][1][4 * g + 1] *= rk * g1.y; acc[0][1][4 * g + 2] *= rk * g1.z; acc[0][1][4 * g + 3] *= rk * g1.w;
                }
                unsigned short* krow = A.k16 + ((long)(b * 8 + head) * S_ + s) * 96;
                store_row64(krow, acc[0][0], acc[0][1], hi);
                const f32x4_t k0 = e_k[0], k1 = e_k[1], k2 = e_k[2], k3 = e_k[3];
                uint4 o0, o1; o0.x = cvtpk(k0.x * rk, k0.y * rk); o0.y = cvtpk(k0.z * rk, k0.w * rk); o0.z = cvtpk(k1.x * rk, k1.y * rk); o0.w = cvtpk(k1.z * rk, k1.w * rk);
                o1.x = cvtpk(k2.x * rk, k2.y * rk); o1.y = cvtpk(k2.z * rk, k2.w * rk); o1.z = cvtpk(k3.x * rk, k3.y * rk); o1.w = cvtpk(k3.z * rk, k3.w * rk);
                *(uint4*)(krow + 64 + hi * 16) = o0; *(uint4*)(krow + 64 + hi * 16 + 8) = o1;
            }
            {
#pragma unroll
                for (int ni = 2; ni < 4; ++ni)
#pragma unroll
                    for (int g4 = 0; g4 < 4; ++g4) {
                        const int tb = m0 + wm * 32 + 8 * g4 + 4 * hi; const int b = tb / S_, s0 = tb % S_; const int d = (ni - 2) * 32 + r32;
                        const f32x4_t sa = *(const f32x4_t*)(A.ssq_ckv + tb), sb = *(const f32x4_t*)(A.ssq_ckv + (long)T_ + tb);
                        const float r0 = rsqrtf((sa.x + sb.x) * (1.f / 128.f) + EPS), r1 = rsqrtf((sa.y + sb.y) * (1.f / 128.f) + EPS), r2 = rsqrtf((sa.z + sb.z) * (1.f / 128.f) + EPS), r3 = rsqrtf((sa.w + sb.w) * (1.f / 128.f) + EPS);
                        uint2 pk; pk.x = cvtpk(acc[0][ni][4 * g4] * r0, acc[0][ni][4 * g4 + 1] * r1); pk.y = cvtpk(acc[0][ni][4 * g4 + 2] * r2, acc[0][ni][4 * g4 + 3] * r3);
                        *(uint2*)(A.vt16 + ((long)(b * 8 + head) * 64 + d) * S_ + vperm(s0)) = pk;
                    }
            }
        } else {
            const int v = u - 640; const int mt = v >> 2, nt = v & 3; const int m0 = mt * 128; const int wm = wave >> 1, wn = wave & 1; const int head = nt * 2 + wn;
            f32x16 acc[1][3];
#pragma unroll
            for (int ni = 0; ni < 3; ++ni)
#pragma unroll
                for (int r = 0; r < 16; ++r) acc[0][ni][r] = 0.f;
            const long tok = m0 + wm * 32 + r32;
            const float e_q0 = A.ssq_cq[tok], e_q1 = A.ssq_cq[(long)T_ + tok], e_q2 = A.ssq_cq[2L * T_ + tok], e_q3 = A.ssq_cq[3L * T_ + tok];
            const float* rope_t = A.rope + tok * 48;
            f32x4_t e_c[2], e_s[2];
#pragma unroll
            for (int g = 0; g < 2; ++g) { e_c[g] = *(const f32x4_t*)(rope_t + 16 + 8 * g + 4 * hi); e_s[g] = *(const f32x4_t*)(rope_t + 32 + 8 * g + 4 * hi); }
            gemm_mainloop<ShQb, 7u>(A.cq16 + (long)m0 * 256, 256, A.wt_uq + (long)nt * 192 * 256, 256, 256, lds, acc, tid);
            const float rc = rsqrtf((e_q0 + e_q1 + e_q2 + e_q3) * (1.f / 256.f) + EPS);
            float ss = 0.f;
#pragma unroll
            for (int ni = 0; ni < 3; ++ni)
#pragma unroll
                for (int r = 0; r < 16; ++r) { acc[0][ni][r] *= rc; ss += acc[0][ni][r] * acc[0][ni][r]; }
            ss = pair_sum(ss);
            const float rq = rsqrtf(ss * (1.f / 96.f) + EPS);
#pragma unroll
            for (int ni = 0; ni < 3; ++ni)
#pragma unroll
                for (int g = 0; g < 4; ++g) {
                    const float4 gg = *(const float4*)(A.q_gain + ni * 32 + 8 * g + 4 * hi);
                    acc[0][ni][4 * g] *= rq * gg.x; acc[0][ni][4 * g + 1] *= rq * gg.y; acc[0][ni][4 * g + 2] *= rq * gg.z; acc[0][ni][4 * g + 3] *= rq * gg.w;
                }
#pragma unroll
            for (int g = 0; g < 2; ++g) {
                const f32x4_t c4 = e_c[g], s4 = e_s[g];
                const float cc[4] = {c4.x, c4.y, c4.z, c4.w}, sn[4] = {s4.x, s4.y, s4.z, s4.w};
#pragma unroll
                for (int j = 0; j < 4; ++j) { const float x1 = acc[0][2][4 * g + j], x2 = acc[0][2][8 + 4 * g + j]; acc[0][2][4 * g + j] = x1 * cc[j] - x2 * sn[j]; acc[0][2][8 + 4 * g + j] = x2 * cc[j] + x1 * sn[j]; }
            }
            unsigned short* qrow = A.q16 + tok * 768 + head * 96;
#pragma unroll
            for (int ni = 0; ni < 3; ++ni)
#pragma unroll
                for (int g = 0; g < 4; ++g) {
                    uint2 pk; pk.x = cvtpk(acc[0][ni][4 * g] * MLA_QSCALE, acc[0][ni][4 * g + 1] * MLA_QSCALE); pk.y = cvtpk(acc[0][ni][4 * g + 2] * MLA_QSCALE, acc[0][ni][4 * g + 3] * MLA_QSCALE);
                    *(uint2*)(qrow + ni * 32 + 8 * g + 4 * hi) = pk;
                }
        }
    }
}
__device__ __forceinline__ void p3_cmp2(unsigned char* lds, const float* __restrict__ hid, const float* __restrict__ cbias, const unsigned short* __restrict__ w2t_k, const unsigned short* __restrict__ w2t_v,
                                        const float* __restrict__ kc_gain, const float* __restrict__ rope, unsigned short* __restrict__ kc16, unsigned short* __restrict__ vct16) {
    if (blockIdx.x >= 128) return;
    const int tid = tid_(); const int lane = tid & 63, w = __builtin_amdgcn_readfirstlane(tid >> 6), r32 = lane & 31, hi = lane >> 5;
    const int task = blockIdx.x; const int mat = task >> 6, rt = task & 63; const long row = rt * 32 + r32;
    const unsigned short* w2t = mat ? w2t_v : w2t_k;
    f32x16 acc[2];
#pragma unroll
    for (int r = 0; r < 16; ++r) { acc[0][r] = 0.f; acc[1][r] = 0.f; }
    f32x4_t hv[2][10]; bf16x8 wf[2][2];
#pragma unroll
    for (int s = 0; s < 2; ++s) {
        const int k0 = (w * 2 + s) * 16 + hi * 8;
        hv[s][0] = *(const f32x4_t*)(cbias + mat * 256 + k0); hv[s][1] = *(const f32x4_t*)(cbias + mat * 256 + k0 + 4);
#pragma unroll
        for (int sp = 0; sp < 4; ++sp) {
            const float* hp = hid + ((long)(mat * 4 + sp) * 2048 + row) * 256 + k0;
            hv[s][2 + 2 * sp] = *(const f32x4_t*)hp; hv[s][3 + 2 * sp] = *(const f32x4_t*)(hp + 4);
        }
        wf[s][0] = *(const bf16x8*)(w2t + (long)r32 * 256 + k0); wf[s][1] = *(const bf16x8*)(w2t + (long)(32 + r32) * 256 + k0);
    }
#pragma unroll
    for (int s = 0; s < 2; ++s) {
        f32x4_t lo = hv[s][0], up = hv[s][1];
#pragma unroll
        for (int sp = 0; sp < 4; ++sp) { lo += hv[s][2 + 2 * sp]; up += hv[s][3 + 2 * sp]; }
        uint4 pk; pk.x = cvtpk(gelu_tanh(lo.x), gelu_tanh(lo.y)); pk.y = cvtpk(gelu_tanh(lo.z), gelu_tanh(lo.w)); pk.z = cvtpk(gelu_tanh(up.x), gelu_tanh(up.y)); pk.w = cvtpk(gelu_tanh(up.z), gelu_tanh(up.w));
        const bf16x8 hf = __builtin_bit_cast(bf16x8, pk);
        acc[0] = MFMA32(wf[s][0], hf, acc[0]); acc[1] = MFMA32(wf[s][1], hf, acc[1]);
    }
    f32x4_t* red = (f32x4_t*)lds;
#pragma unroll
    for (int q = 0; q < 8; ++q) red[(w * 8 + q) * 64 + lane] = f32x4_t{acc[q >> 2][4 * (q & 3)], acc[q >> 2][4 * (q & 3) + 1], acc[q >> 2][4 * (q & 3) + 2], acc[q >> 2][4 * (q & 3) + 3]};
    __syncthreads();
    if (w != 0) return;
#pragma unroll
    for (int q = 0; q < 8; ++q) {
        f32x4_t s = red[q * 64 + lane];
#pragma unroll
        for (int ww = 1; ww < 8; ++ww) s += red[(ww * 8 + q) * 64 + lane];
        acc[q >> 2][4 * (q & 3)] = s.x; acc[q >> 2][4 * (q & 3) + 1] = s.y; acc[q >> 2][4 * (q & 3) + 2] = s.z; acc[q >> 2][4 * (q & 3) + 3] = s.w;
    }
    const int bg = (int)(row >> 9), n = (int)(row & 511); const bool valid = n < NCMP;
    if (mat == 0) {
        if (valid) {
            const long tokp = (long)(bg >> 1) * S_ + 16 * n + 31;
            norm_rope64(acc[0], acc[1], kc_gain, rope + tokp * 48, hi, 1.f);
        } else {
#pragma unroll
            for (int r = 0; r < 16; ++r) { acc[0][r] = 0.f; acc[1][r] = 0.f; }
        }
        store_row64(kc16 + row * 64, acc[0], acc[1], hi);
    } else {
#pragma unroll
        for (int ni = 0; ni < 2; ++ni)
#pragma unroll
            for (int r = 0; r < 16; ++r) {
                const float v = valid ? acc[ni][r] : 0.f;
                const float other = __uint_as_float(__builtin_amdgcn_mov_dpp(__float_as_uint(v), 0xB1, 0xF, 0xF, true));
                if ((lane & 1) == 0) *(unsigned*)(vct16 + ((long)bg * 64 + ni * 32 + crow(r, hi)) * 512 + vperm(n)) = cvtpk(v, other);
            }
    }
}

__device__ __forceinline__ void cvt_stream(const float* __restrict__ in, unsigned short* __restrict__ out, long n, int vb = blockIdx.x, int nb = NBLK) {
    const long nchunk = n >> 3;
    const int tid = tid_();
    for (long c = (long)vb * 512 + tid; c < nchunk; c += (long)nb * 512) {
        const float4 a = ((const float4*)in)[2 * c], b = ((const float4*)in)[2 * c + 1];
        uint4 o; o.x = cvtpk(a.x, a.y); o.y = cvtpk(a.z, a.w); o.z = cvtpk(b.x, b.y); o.w = cvtpk(b.z, b.w);
        ((uint4*)out)[c] = o;
    }
}


typedef unsigned u32x3 __attribute__((ext_vector_type(3)));
typedef unsigned u32x6 __attribute__((ext_vector_type(6)));
typedef float f32x32 __attribute__((ext_vector_type(32)));
constexpr int PROW = 768;
constexpr int PU_SPLIT = 12288;
template <int NR>
__device__ __forceinline__ void cvt_rows_fp6(const float* __restrict__ in, unsigned char* __restrict__ out6, float* __restrict__ scale, int rows, int vb = blockIdx.x, int nb = NBLK) {
    const int tid = tid_(); const int lane = tid & 63, w = __builtin_amdgcn_readfirstlane(tid >> 6);
    const int stride = nb * 8;
    for (int r0 = vb * 8 + w; r0 < rows; r0 += NR * stride) {
        f32x4_t v[NR][4];
#pragma unroll
        for (int j = 0; j < NR; ++j) {
            const int r = min(r0 + j * stride, rows - 1);
            const f32x4_t* p = (const f32x4_t*)(in + (long)r * 1024 + lane * 16);
#pragma unroll
            for (int i = 0; i < 4; ++i) v[j][i] = p[i];
        }
#pragma unroll
        for (int j = 0; j < NR; ++j) {
            const int r = r0 + j * stride;
            if (r < rows) {
                float m = 0.f;
#pragma unroll
                for (int i = 0; i < 4; ++i) m = fmaxf(m, fmaxf(fmaxf(fabsf(v[j][i].x), fabsf(v[j][i].y)), fmaxf(fabsf(v[j][i].z), fabsf(v[j][i].w))));
                m = wmax(m);
                const float q = (m > 0.f) ? 7.5f / m : 1.f;
                const f32x16 ve = {v[j][0].x * q, v[j][0].z * q, v[j][1].x * q, v[j][1].z * q, v[j][2].x * q, v[j][2].z * q, v[j][3].x * q, v[j][3].z * q, 0.f, 0.f, 0.f, 0.f, 0.f, 0.f, 0.f, 0.f};
                const f32x16 vo = {v[j][0].y * q, v[j][0].w * q, v[j][1].y * q, v[j][1].w * q, v[j][2].y * q, v[j][2].w * q, v[j][3].y * q, v[j][3].w * q, 0.f, 0.f, 0.f, 0.f, 0.f, 0.f, 0.f, 0.f};
                const u32x6 pk = __builtin_amdgcn_cvt_scalef32_2xpk16_fp6_f32(ve, vo, 1.0f);
                *(u32x3*)(out6 + (long)r * PROW + lane * 12) = u32x3{pk[0], pk[1], pk[2]};
                if (lane == 0) scale[r] = (m > 0.f) ? m * (1.f / 7.5f) : 1.f;
            }
        }
    }
}
__device__ __forceinline__ f32x32 dec2_fp6(const u32x3& r0, const u32x3& r1) {
    const u32x6 pk = {r0.x, r0.y, r0.z, r1.x, r1.y, r1.z};
    return __builtin_amdgcn_cvt_scalef32_pk32_f32_fp6(pk, 1.0f);
}
__device__ __forceinline__ void peer_sweep_a(const float* __restrict__ hss, const float* __restrict__ g2, const int* __restrict__ eo, const float* __restrict__ go,
                                             const unsigned char* __restrict__ U6, const float* __restrict__ su, const float* __restrict__ sv, const float* __restrict__ h, float* __restrict__ wout) {
    const int tid = tid_(); const int lane = tid & 63, w = __builtin_amdgcn_readfirstlane(tid >> 6);
    const int kcls = ((lane >> 5) & 1) * 4 + ((lane >> 4) & 1) * 2 + ((lane >> 3) & 1);
    for (int t = blockIdx.x * 8 + w; t < T_; t += NBLK * 8) {
        float x[16];
        {
            const float4* xp = (const float4*)(h + (long)t * 1024 + lane * 16); const float4* gp = (const float4*)(g2 + lane * 16); const float4* hp = (const float4*)(hss + (long)t * 16);
            const float4 s0 = hp[0], s1 = hp[1], s2 = hp[2], s3 = hp[3];
            const float rs = rsqrtf((s0.x + s0.y + s0.z + s0.w + s1.x + s1.y + s1.z + s1.w + s2.x + s2.y + s2.z + s2.w + s3.x + s3.y + s3.z + s3.w) * (1.f / 1024.f) + EPS);
#pragma unroll
            for (int k = 0; k < 4; ++k) { const float4 hv = xp[k], gv = gp[k]; x[4 * k] = hv.x * rs * gv.x; x[4 * k + 1] = hv.y * rs * gv.y; x[4 * k + 2] = hv.z * rs * gv.z; x[4 * k + 3] = hv.w * rs * gv.w; }
        }
        const int elo = eo[(long)t * 128 + lane], ehi = eo[(long)t * 128 + 64 + lane];
        const float glo = go[(long)t * 128 + lane], ghi = go[(long)t * 128 + 64 + lane];
        for (int bt = 0; bt < 16; ++bt) {
            int e[8];
#pragma unroll
            for (int k = 0; k < 8; ++k) e[k] = __builtin_amdgcn_readlane(bt < 8 ? elo : ehi, (bt * 8 + k) & 63);
            u32x3 u[8];
#pragma unroll
            for (int k = 0; k < 8; ++k) u[k] = *(const u32x3*)(U6 + (long)e[k] * PROW + lane * 12);
            const int emine = __shfl(bt < 8 ? elo : ehi, (bt * 8 + kcls) & 63);
            const float sum = su[emine], svm = sv[emine];
            const float gk = __shfl(bt < 8 ? glo : ghi, (bt * 8 + kcls) & 63);
            float a[8];
#pragma unroll
            for (int k = 0; k < 8; k += 2) {
                const f32x32 d = dec2_fp6(u[k], u[k + 1]);
                float s0 = 0.f, s1 = 0.f;
#pragma unroll
                for (int i = 0; i < 16; ++i) { s0 = fmaf(d[i], x[i], s0); s1 = fmaf(d[16 + i], x[i], s1); }
                a[k] = s0; a[k + 1] = s1;
            }
            float b4[4], c2[2], d1;
#pragma unroll
            for (int i = 0; i < 4; ++i) {
                auto rr = __builtin_amdgcn_permlane32_swap(__float_as_uint(a[i]), __float_as_uint(a[i + 4]), false, false);
                b4[i] = __uint_as_float(rr[0]) + __uint_as_float(rr[1]);
            }
#pragma unroll
            for (int i = 0; i < 2; ++i) {
                auto rr = __builtin_amdgcn_permlane16_swap(__float_as_uint(b4[i]), __float_as_uint(b4[i + 2]), false, false);
                c2[i] = __uint_as_float(rr[0]) + __uint_as_float(rr[1]);
            }
            { const bool up = (lane & 8) != 0; const float keep = up ? c2[1] : c2[0], send = up ? c2[0] : c2[1];
              d1 = keep + __uint_as_float(__builtin_amdgcn_mov_dpp(__float_as_uint(send), 0x128, 0xF, 0xF, true)); }
            d1 = quad_sum(d1);
            d1 += __uint_as_float(__builtin_amdgcn_mov_dpp(__float_as_uint(d1), 0x141, 0xF, 0xF, true));
            const float wl = gk * gelu_tanh(d1 * sum) * svm;
            if ((lane & 7) == 0) wout[(long)t * 128 + bt * 8 + kcls] = wl;
        }
    }
}
__device__ __forceinline__ void peer_sweep_b(const int* __restrict__ eo, const float* __restrict__ win, const unsigned char* __restrict__ V6, float* out) {
    const int tid = tid_(); const int lane = tid & 63, w = __builtin_amdgcn_readfirstlane(tid >> 6);
    for (int t = blockIdx.x * 8 + w; t < T_; t += NBLK * 8) {
        float y[16];
#pragma unroll
        for (int i = 0; i < 16; ++i) y[i] = 0.f;
        const int elo = eo[(long)t * 128 + lane], ehi = eo[(long)t * 128 + 64 + lane];
        const float wlo = win[(long)t * 128 + lane], whi = win[(long)t * 128 + 64 + lane];
        for (int bt = 0; bt < 16; ++bt) {
            int e[8]; float wk[8];
#pragma unroll
            for (int k = 0; k < 8; ++k) {
                e[k] = __builtin_amdgcn_readlane(bt < 8 ? elo : ehi, (bt * 8 + k) & 63);
                wk[k] = __uint_as_float(__builtin_amdgcn_readlane(__float_as_uint(bt < 8 ? wlo : whi), (bt * 8 + k) & 63));
            }
            u32x3 v[8];
#pragma unroll
            for (int k = 0; k < 8; ++k) v[k] = *(const u32x3*)(V6 + (long)e[k] * PROW + lane * 12);
#pragma unroll
            for (int k = 0; k < 8; k += 2) {
                const f32x32 d = dec2_fp6(v[k], v[k + 1]);
#pragma unroll
                for (int i = 0; i < 16; ++i) y[i] = fmaf(wk[k + 1], d[16 + i], fmaf(wk[k], d[i], y[i]));
            }
        }
        float4* o = (float4*)(out + (long)t * 1024 + lane * 16);
#pragma unroll
        for (int k = 0; k < 4; ++k) { float4 hv = o[k]; hv.x += y[4 * k]; hv.y += y[4 * k + 1]; hv.z += y[4 * k + 2]; hv.w += y[4 * k + 3]; o[k] = hv; }
    }
}

struct Params {
    const float* x; const int* positions; const float* norm1_gain; const float* w_in;
    const float *nsa_q_gain, *nsa_kc_gain, *nsa_ks_gain, *nsa_kw_gain, *cmp_pos, *cmp_k_w1, *cmp_k_w2, *cmp_v_w1, *cmp_v_w2;
    const float *mla_q_lora_gain, *mla_w_uq, *mla_kv_lora_gain, *mla_w_ukv, *mla_q_gain, *mla_k_gain, *out_gain_a, *out_gain_b, *w_out;
    const float *norm2_gain, *peer_w_q, *peer_sub_keys, *peer_u, *peer_v;
    float* out; float* W; unsigned* bar;
};
constexpr int LDS_BYTES = 64 + 131072;
static_assert(LDS_BYTES >= 8 * 3200 * 4 + 64, "naive NSA phase needs 102,464 B");

typedef __attribute__((address_space(4))) const Params* cparams_t;
__device__ __forceinline__ cparams_t params_ptr() {
    cparams_t pp = (cparams_t)__builtin_amdgcn_kernarg_segment_ptr();
    asm volatile("" : "+s"(pp));
    return pp;
}
constexpr long M1 = 1 << 20;
constexpr long F_U8 = 0, F_V8 = 4 * M1, F_SU = 21 * M1 + 3 * M1 / 8, F_SV = F_SU + 16384,
               F_WTIN = 16 * M1, F_WTUQ = 17 * M1, F_WTUKV = 17 * M1 + M1 / 8, F_W1TK = 17 * M1 + M1 / 4, F_W1TV = 17 * M1 + M1 / 2, F_W2TK = 17 * M1 + 3 * M1 / 4,
               F_W2TV = F_W2TK + 8192, F_CBIAS = F_W2TV + 8192, F_WTOUT = 18 * M1, F_WTQ = 18 * M1 + M1 / 2, F_SK16 = 19 * M1 + M1 / 2,
               F_SSQCQ = 19 * M1 + 5 * M1 / 8, F_SSQCKV = F_SSQCQ + 4 * 16384, F_SSQKR = F_SSQCKV + 2 * 16384, F_SSQA = 19 * M1 + 3 * M1 / 4, F_SSQB = F_SSQA + 8 * 16384,
               F_ROPE = 20 * M1, F_GATES = 21 * M1, F_KRR = 21 * M1 + M1 / 2,
               F_XN16 = 22 * M1, F_MIX = 22 * M1,
               F_Q16A = 30 * M1, F_KS16 = 34 * M1, F_KW16 = 35 * M1, F_VST16 = 36 * M1, F_VWT16 = 37 * M1, F_KCMP16 = 38 * M1, F_VCMP16 = 39 * M1 + M1 / 8,
               F_CQ16 = 40 * M1 + M1 / 4, F_CKV16 = 42 * M1 + M1 / 4,
               F_Q16 = 43 * M1 + M1 / 2, F_K16 = 49 * M1 + M1 / 2, F_VT16 = 55 * M1 + M1 / 2, F_HID = 59 * M1 + M1 / 2, F_KC16 = 63 * M1 + M1 / 2, F_VCT16 = F_KC16 + M1 / 8,
               F_HB = 30 * M1, F_HSS = 38 * M1, F_PSS = 38 * M1 + M1 / 2, F_EO = 39 * M1, F_GO = 41 * M1, F_PQB = 43 * M1 + M1 / 2;
static_assert(F_SSQKR + 16384 <= F_SSQA && F_SSQB + 8 * 16384 <= F_ROPE && F_VCT16 + M1 / 8 <= 64 * M1 - 16384 && F_CKV16 + M1 <= F_Q16 && F_PQB + 16 * M1 <= F_HID, "workspace map");

#define G(x) (x)
__global__ __launch_bounds__(512, 2) void mega(Params p_unused) {
    extern __shared__ __attribute__((aligned(16))) unsigned char lds_raw[];
    float* ldsf = (float*)(lds_raw + 64);
    { const unsigned bid_ = blockIdx.x; __builtin_assume(bid_ < (unsigned)NBLK); }
    if (threadIdx.x == 0) *(uint4*)lds_raw = make_uint4(0u, 0u, 0u, 0u);
    __syncthreads();
    XcdBarrier bar = xcd_barrier_post(params_ptr()->bar, (volatile LAS unsigned*)lds_raw);
#define GRID_SYNC() xcd_barrier(bar)
#define U16P(off) ((unsigned short*)(W + (off)))
    { cparams_t p = params_ptr(); float* W = p->W;
      p0_xn_rope(p->x, p->norm1_gain, p->positions, U16P(F_XN16), W + F_ROPE); }
    { cparams_t p = params_ptr(); float* W = p->W;
#define P0_XT(j) ({ const int v_ = (int)blockIdx.x + NBLK * (j); \
        (v_ < 432) ? xt_make(p->w_in, 1024, INW, U16P(F_WTIN), nullptr, nullptr, 0, 2, v_) : \
        (v_ < 480) ? xt_make(p->mla_w_uq, 256, 768, U16P(F_WTUQ), p->mla_q_lora_gain, p->mla_q_lora_gain, 1 << 30, 0, v_ - 432) : \
        (v_ < 512) ? xt_make(p->mla_w_ukv, 128, 1024, U16P(F_WTUKV), p->mla_kv_lora_gain, p->mla_kv_lora_gain, 1 << 30, 0, v_ - 480) : \
        (v_ < 640) ? xt_make(p->cmp_k_w1, 2048, 256, U16P(F_W1TK), nullptr, nullptr, 0, 0, v_ - 512) : \
        (v_ < 768) ? xt_make(p->cmp_v_w1, 2048, 256, U16P(F_W1TV), nullptr, nullptr, 0, 0, v_ - 640) : \
        (v_ < 772) ? xt_make(p->cmp_k_w2, 256, 64, U16P(F_W2TK), nullptr, nullptr, 0, 0, v_ - 768) : \
        (v_ < 776) ? xt_make(p->cmp_v_w2, 256, 64, U16P(F_W2TV), nullptr, nullptr, 0, 0, v_ - 772) : xt_make(nullptr, 64, 64, nullptr, nullptr, nullptr, 0, 0, -1); })
      XT_RUN4(ldsf, P0_XT);
      zero_stream(U16P(F_WTIN) + (long)1720 * 1024, (long)72 * 1024); }
    { cparams_t p = params_ptr(); float* W = p->W;
      p0_cbias(p->cmp_pos, p->cmp_k_w1, p->cmp_v_w1, W + F_CBIAS); }
    GRID_SYNC();
    { cparams_t p = params_ptr(); float* W = p->W;
      P1Out O; O.q16a = U16P(F_Q16A); O.ks16 = U16P(F_KS16); O.kw16 = U16P(F_KW16); O.vst16 = U16P(F_VST16); O.vwt16 = U16P(F_VWT16); O.kcmp16 = U16P(F_KCMP16); O.vcmp16 = U16P(F_VCMP16);
      O.cq16 = U16P(F_CQ16); O.ckv16 = U16P(F_CKV16); O.krr = W + F_KRR; O.ssq_kr = W + F_SSQKR; O.ssq_cq = W + F_SSQCQ; O.ssq_ckv = W + F_SSQCKV; O.gates = W + F_GATES;
      O.rope = W + F_ROPE; O.q_gain = p->nsa_q_gain; O.ks_gain = p->nsa_ks_gain; O.kw_gain = p->nsa_kw_gain; O.k_gain = p->mla_k_gain;
      p1_inproj_256(lds_raw + 64, U16P(F_XN16), U16P(F_WTIN), O); }
    if ((blockIdx.x >> 3) >= 24) {
      cparams_t p = params_ptr(); float* W = p->W;
      cvt_rows_fp6<8>(p->peer_u, (unsigned char*)(W + F_U8), W + F_SU, PU_SPLIT, (int)(blockIdx.x & 7) * 8 + (int)(blockIdx.x >> 3) - 24, 64); }
    GRID_SYNC();
    { cparams_t p = params_ptr(); float* W = p->W;
      P2Args A; A.cq16 = U16P(F_CQ16); A.ckv16 = U16P(F_CKV16); A.wt_uq = U16P(F_WTUQ); A.wt_ukv = U16P(F_WTUKV); A.kcmp16 = U16P(F_KCMP16); A.vcmp16 = U16P(F_VCMP16); A.w1t_k = U16P(F_W1TK); A.w1t_v = U16P(F_W1TV);
      A.ssq_cq = W + F_SSQCQ; A.ssq_ckv = W + F_SSQCKV; A.ssq_kr = W + F_SSQKR; A.krr = W + F_KRR; A.rope = W + F_ROPE; A.q_gain = p->mla_q_gain; A.k_gain = p->mla_k_gain;
      A.q16 = U16P(F_Q16); A.k16 = U16P(F_K16); A.vt16 = U16P(F_VT16); A.hid = W + F_HID;
      p2_phase(lds_raw + 64, A); }
    GRID_SYNC();
    { const int vb = blockIdx.x, nb = NBLK;
      { cparams_t p = params_ptr(); float* W = p->W;
#define P3_XT(j) ({ const int v_ = vb + nb * (j); \
          (v_ < 256) ? xt_make(p->w_out, 1024, 1024, U16P(F_WTOUT), p->out_gain_a, p->out_gain_b, 512, 0, v_) : \
          (v_ < 768) ? xt_make(p->peer_w_q, 1024, 2048, U16P(F_WTQ), p->norm2_gain, p->norm2_gain, 1 << 30, 0, v_ - 256) : xt_make(nullptr, 64, 64, nullptr, nullptr, nullptr, 0, 0, -1); })
        XT_RUN4(ldsf, P3_XT); }
      { cparams_t p = params_ptr(); float* W = p->W;
        p3_cmp2(lds_raw + 64 + 36864, W + F_HID, W + F_CBIAS, U16P(F_W2TK), U16P(F_W2TV), p->nsa_kc_gain, W + F_ROPE, U16P(F_KC16), U16P(F_VCT16)); }
      { cparams_t p = params_ptr(); float* W = p->W;
        cvt_stream(p->peer_sub_keys, U16P(F_SK16), (long)8 * 2 * 128 * 128, vb, nb);
        cvt_rows_fp6<4>(p->peer_v, (unsigned char*)(W + F_V8), W + F_SV, 16384, vb, nb);
        cvt_rows_fp6<2>(p->peer_u + (long)PU_SPLIT * 1024, (unsigned char*)(W + F_U8) + (long)PU_SPLIT * PROW, W + F_SU + PU_SPLIT, 16384 - PU_SPLIT, vb, nb); }
    }
    GRID_SYNC();
    { cparams_t p = params_ptr(); float* W = p->W;
      nsa_phase(lds_raw + 64, U16P(F_Q16A), U16P(F_KC16), U16P(F_VCT16), U16P(F_KS16), U16P(F_VST16), U16P(F_KW16), U16P(F_VWT16), W + F_GATES, U16P(F_MIX), W + F_SSQA); }
    { cparams_t p = params_ptr(); float* W = p->W;
      mla_phase(lds_raw + 64, U16P(F_Q16), U16P(F_K16), U16P(F_VT16), U16P(F_MIX), W + F_SSQB); }
    GRID_SYNC();
    { cparams_t p = params_ptr(); float* W = p->W;
      p5_outproj_256(lds_raw + 64, U16P(F_MIX), U16P(F_WTOUT), W + F_SSQA, W + F_SSQB, p->x, p->out, U16P(F_HB), W + F_HSS); }
    GRID_SYNC();
    { cparams_t p = params_ptr(); float* W = p->W;
      p6_peerq_256(lds_raw + 64, U16P(F_HB), U16P(F_WTQ), W + F_HSS, U16P(F_PQB), W + F_PSS); }
    GRID_SYNC();
    { cparams_t p = params_ptr(); float* W = p->W;
      peer_route_mfma(lds_raw + 64, U16P(F_PQB), W + F_PSS, U16P(F_SK16), (int*)(W + F_EO), W + F_GO); }
    GRID_SYNC();
    { cparams_t p = params_ptr(); float* W = p->W;
      peer_sweep_a(W + F_HSS, p->norm2_gain, (const int*)(W + F_EO), W + F_GO, (const unsigned char*)(W + F_U8), W + F_SU, W + F_SV, p->out, W + F_PQB); }
    GRID_SYNC();
    { cparams_t p = params_ptr(); float* W = p->W;
      peer_sweep_b((const int*)(W + F_EO), W + F_PQB, (const unsigned char*)(W + F_V8), p->out); }
}

extern "C" void kernel_launch(void* const* d_in, const int* in_sizes, int n_in, void* d_out, int out_size, void* d_ws, size_t ws_size, hipStream_t stream) {
    (void)ws_size; (void)in_sizes; (void)n_in; (void)out_size;
    static int grid = 0;
    if (grid == 0) {
        int dev = 0, cus = 0, per_cu = 0;
        (void)hipGetDevice(&dev);
        (void)hipDeviceGetAttribute(&cus, hipDeviceAttributeMultiprocessorCount, dev);
        (void)hipFuncSetAttribute((const void*)mega, hipFuncAttributeMaxDynamicSharedMemorySize, LDS_BYTES);
        (void)hipOccupancyMaxActiveBlocksPerMultiprocessor(&per_cu, (const void*)mega, 512, LDS_BYTES);
        (void)hipGetLastError();
        if (per_cu < 1) fprintf(stderr, "kernel_launch: occupancy query reports %d blocks per CU\n", per_cu);
        if (cus != NBLK) fprintf(stderr, "kernel_launch: built for %d CUs, device reports %d\n", NBLK, cus);
        grid = NBLK;
    }
    Params p{};
    p.x = (const float*)d_in[0]; p.positions = (const int*)d_in[1]; p.norm1_gain = (const float*)d_in[2]; p.w_in = (const float*)d_in[3];
    p.nsa_q_gain = (const float*)d_in[4]; p.nsa_kc_gain = (const float*)d_in[5]; p.nsa_ks_gain = (const float*)d_in[6]; p.nsa_kw_gain = (const float*)d_in[7];
    p.cmp_pos = (const float*)d_in[8]; p.cmp_k_w1 = (const float*)d_in[9]; p.cmp_k_w2 = (const float*)d_in[10]; p.cmp_v_w1 = (const float*)d_in[11]; p.cmp_v_w2 = (const float*)d_in[12];
    p.mla_q_lora_gain = (const float*)d_in[13]; p.mla_w_uq = (const float*)d_in[14]; p.mla_kv_lora_gain = (const float*)d_in[15]; p.mla_w_ukv = (const float*)d_in[16];
    p.mla_q_gain = (const float*)d_in[17]; p.mla_k_gain = (const float*)d_in[18]; p.out_gain_a = (const float*)d_in[19]; p.out_gain_b = (const float*)d_in[20]; p.w_out = (const float*)d_in[21];
    p.norm2_gain = (const float*)d_in[22]; p.peer_w_q = (const float*)d_in[23]; p.peer_sub_keys = (const float*)d_in[24]; p.peer_u = (const float*)d_in[25]; p.peer_v = (const float*)d_in[26];
    p.out = (float*)d_out;
    p.bar = (unsigned*)d_ws;
    p.W = (float*)d_ws + 16384;
    (void)hipMemsetAsync(d_ws, 0, XCD_BAR_WORDS * sizeof(unsigned), stream);
    hipLaunchKernelGGL(mega, dim3(grid), dim3(512), LDS_BYTES, stream, p);
}
```

```cpp
#include <hip/hip_runtime.h>
#include <cmath>
#include <cstdint>
#include <cstdio>

#define XB_TMO      128
#define XB_XCNT(j)  (256  + 64 * (j))
#define XB_XSUB(j)  (1280 + 64 * (j))
#define XB_XGEN(j)  (2304 + 64 * (j))
#define XB_TOP      3328
#define XB_TOPGEN   3392
#define XCD_BAR_WORDS 3456
#define XB_SPIN_CAP (1u << 18)
#define LAS __attribute__((address_space(3)))

__device__ __forceinline__ unsigned xb_ld(unsigned* p)              { return __hip_atomic_load(p, __ATOMIC_RELAXED, __HIP_MEMORY_SCOPE_AGENT); }
__device__ __forceinline__ unsigned xb_add(unsigned* p, unsigned v) { return __hip_atomic_fetch_add(p, v, __ATOMIC_RELAXED, __HIP_MEMORY_SCOPE_AGENT); }
__device__ __forceinline__ unsigned xb_xcc_id() { return (unsigned)__builtin_amdgcn_s_getreg((3 << 11) | 20) & 0xFu; }
#define XB_SPIN(cond, bar) do { unsigned _sp = 0; while (cond) { __builtin_amdgcn_s_sleep(1); \
    if ((++_sp & 255u) == 0u) { if (xb_ld(&(bar)[XB_TMO])) break; if (_sp > XB_SPIN_CAP) { atomicAdd(&(bar)[XB_TMO], 1u); break; } } } } while (0)

struct XcdBarrier {
    unsigned* bar; unsigned x;
    volatile LAS unsigned* st;
};

__device__ __forceinline__ XcdBarrier xcd_barrier_post(unsigned* bar, volatile LAS unsigned* st) {
    XcdBarrier b; b.bar = bar; b.x = xb_xcc_id(); b.st = st;
    if (threadIdx.x == 0) (void)xb_add(&bar[XB_XCNT(b.x)], 1u);
    return b;
}
__device__ __forceinline__ void xcd_barrier_complete(unsigned* bar, unsigned x, unsigned& nloc, unsigned& nx) {
    const unsigned G = gridDim.x * gridDim.y * gridDim.z;
    unsigned sum, cnt, mine, sp = 0u;
    for (;;) {
        sum = 0u; cnt = 0u; mine = 0u;
#pragma unroll
        for (unsigned j = 0; j < 16; ++j) { const unsigned c = xb_ld(&bar[XB_XCNT(j)]); sum += c; cnt += (c > 0u) ? 1u : 0u; mine = (j == x) ? c : mine; }
        if (sum == G) break;
        __builtin_amdgcn_s_sleep(1);
        if ((++sp & 255u) == 0u) { if (xb_ld(&bar[XB_TMO])) break; if (sp > XB_SPIN_CAP) { atomicAdd(&bar[XB_TMO], 1u); break; } }
    }
    nloc = mine > 0u ? mine : 1u; nx = cnt > 0u ? cnt : 1u;
}

__device__ __forceinline__ void xcd_barrier(const XcdBarrier& b) {
    asm volatile("s_waitcnt vmcnt(0)" ::: "memory");
    __syncthreads();
    if (threadIdx.x == 0) {
        unsigned* bar = b.bar;
        __builtin_amdgcn_s_waitcnt(0);
        unsigned nloc = b.st[0], nx = b.st[1];
        if (nloc == 0u) { xcd_barrier_complete(bar, b.x, nloc, nx); b.st[0] = nloc; b.st[1] = nx; }
        const unsigned old = xb_add(&bar[XB_XSUB(b.x)], 1u);
        const unsigned gen = old / nloc;
        if (old + 1u == (gen + 1u) * nloc) {
            __builtin_amdgcn_fence(__ATOMIC_RELEASE, "agent");
            asm volatile("s_waitcnt vmcnt(0)" ::: "memory");
            const unsigned og = xb_add(&bar[XB_TOP], 1u);
            const unsigned tg = og / nx;
            if (og + 1u == (tg + 1u) * nx) xb_add(&bar[XB_TOPGEN], 1u);
            else XB_SPIN(xb_ld(&bar[XB_TOPGEN]) == tg, bar);
            __builtin_amdgcn_fence(__ATOMIC_ACQUIRE, "agent");
            xb_add(&bar[XB_XGEN(b.x)], 1u);
            asm volatile("s_waitcnt vmcnt(0)" ::: "memory");
        } else {
            XB_SPIN(xb_ld(&bar[XB_XGEN(b.x)]) == gen, bar);
            __builtin_amdgcn_fence(__ATOMIC_ACQUIRE, "agent");
            asm volatile("s_waitcnt vmcnt(0)" ::: "memory");
        }
    }
    __syncthreads();
}


#define AS1 __attribute__((address_space(1)))
constexpr int NBLK = 256;
constexpr int B_ = 2, S_ = 8192, T_ = B_ * S_, D_ = 1024, INW = 1720;
constexpr int G_ = 2, NCMP = 511;
constexpr float EPS = 1e-6f;
constexpr int C_Q = 0, C_KC = 512, C_VC = 640, C_KS = 768, C_VS = 896, C_KW = 1024, C_VW = 1152, C_GATE = 1280, C_CQ = 1304, C_CKV = 1560, C_KR = 1688;

#define WSYNC() do { __builtin_amdgcn_wave_barrier(); asm volatile("s_waitcnt lgkmcnt(0)" ::: "memory"); __builtin_amdgcn_wave_barrier(); } while (0)

__device__ __forceinline__ int tid_() { int t = threadIdx.x; asm volatile("" : "+v"(t)); return t; }
template <class T> __device__ __forceinline__ T* as_global(T* p) { return (T*)(__attribute__((address_space(1))) T*)p; }
__device__ __forceinline__ float wsum(float v) {
#pragma unroll
    for (int o = 32; o > 0; o >>= 1) v += __shfl_xor(v, o);
    return v;
}
__device__ __forceinline__ float wmax(float v) {
#pragma unroll
    for (int o = 32; o > 0; o >>= 1) v = fmaxf(v, __shfl_xor(v, o));
    return v;
}
__device__ __forceinline__ float gelu_tanh(float x) {
    const float u = 0.7978845608028654f * (x + 0.044715f * x * x * x);
    return 0.5f * x * (1.f + tanhf(u));
}

__device__ const float ROPE_F16[8] = {1.000000000e+00f, 1.939227432e-01f, 3.760603070e-02f, 7.292664610e-03f, 1.414213562e-03f, 2.742481884e-04f, 5.318296098e-05f, 1.031338616e-05f};
__device__ const float ROPE_F32[16] = {1.000000000e+00f, 4.403665960e-01f, 1.939227432e-01f, 8.539710194e-02f, 3.760603070e-02f, 1.656043902e-02f, 7.292664610e-03f, 3.211445874e-03f,
                                       1.414213562e-03f, 6.227723788e-04f, 2.742481884e-04f, 1.207697351e-04f, 5.318296098e-05f, 2.341999971e-05f, 1.031338616e-05f, 4.541670478e-06f};

typedef __attribute__((ext_vector_type(8))) short bf16x8;
typedef __attribute__((ext_vector_type(16))) float f32x16;
typedef __attribute__((ext_vector_type(2))) __bf16 bf16x2_t;
__device__ __forceinline__ unsigned cvtpk(float lo, float hi) { unsigned r; asm("v_cvt_pk_bf16_f32 %0, %1, %2" : "=v"(r) : "v"(lo), "v"(hi)); return r; }
__device__ __forceinline__ float bflo(unsigned u) { return __uint_as_float(u << 16); }
__device__ __forceinline__ float bfhi(unsigned u) { return __uint_as_float(u & 0xffff0000u); }
__device__ __forceinline__ float dot2bf(unsigned a, unsigned b, float c) { return __builtin_amdgcn_fdot2_f32_bf16(__builtin_bit_cast(bf16x2_t, a), __builtin_bit_cast(bf16x2_t, b), c, false); }

__device__ __forceinline__ float pair_max(float x) { auto rr = __builtin_amdgcn_permlane32_swap(__float_as_uint(x), __float_as_uint(x), false, false); return fmaxf(__uint_as_float(rr[0]), __uint_as_float(rr[1])); }
__device__ __forceinline__ float pair_sum(float x) { auto rr = __builtin_amdgcn_permlane32_swap(__float_as_uint(x), __float_as_uint(x), false, false); return __uint_as_float(rr[0]) + __uint_as_float(rr[1]); }
typedef float f32x2_t __attribute__((ext_vector_type(2)));
__device__ __forceinline__ float max3f(float a, float b, float c) { float r; asm("v_max3_f32 %0, %1, %2, %3" : "=v"(r) : "v"(a), "v"(b), "v"(c)); return r; }
__device__ __forceinline__ float quad_sum(float x) {
    float y = x + __uint_as_float(__builtin_amdgcn_mov_dpp(__float_as_uint(x), 0xB1, 0xF, 0xF, true));
    return y + __uint_as_float(__builtin_amdgcn_mov_dpp(__float_as_uint(y), 0x4E, 0xF, 0xF, true));
}
#define MFMA32(a, b, c) __builtin_amdgcn_mfma_f32_32x32x16_bf16(a, b, c, 0, 0, 0)
typedef unsigned u32x4 __attribute__((ext_vector_type(4)));
constexpr int LDS_PITCH = 144;
__device__ __forceinline__ int crow(int r, int hi) { return (r & 3) + 8 * (r >> 2) + 4 * hi; }

template <int WM_, int WN_, int MI_, int NI_>
struct GemmShape {
    static constexpr int WM = WM_, WN = WN_, MI = MI_, NI = NI_;
    static constexpr int BM = WM * MI * 32, BN = WN * NI * 32, ROWS = BM + BN;
    static constexpr int CHUNKS = ROWS * 8 / 512;
    static constexpr int STAGE_BYTES = ROWS * LDS_PITCH;
    static_assert(WM * WN == 8 && (ROWS * 8) % 512 == 0, "8 waves; whole chunks per thread");
};
template <class SH, unsigned TOKMASK, int CUR>
__device__ __forceinline__ void gemm_step(unsigned char* lds, const unsigned short* const (&gp)[SH::CHUNKS], const int (&lo)[SH::CHUNKS], u32x4 (&g)[2][SH::CHUNKS],
                                          f32x16 (&acc)[SH::MI][SH::NI], int kt, int nk, int aoff, int boff) {
    const unsigned char* st = lds + (kt & 1) * SH::STAGE_BYTES;
    if (kt + 2 < nk) {
#pragma unroll
        for (int i = 0; i < SH::CHUNKS; ++i) g[CUR][i] = *(const u32x4*)(gp[i] + (long)(kt + 2) * 64);
    }
#pragma unroll
    for (int ks = 0; ks < 4; ++ks) {
        bf16x8 af[SH::MI], bfr[SH::NI];
#pragma unroll
        for (int mi = 0; mi < SH::MI; ++mi) af[mi] = *(const bf16x8*)(st + aoff + mi * 32 * LDS_PITCH + ks * 32);
#pragma unroll
        for (int ni = 0; ni < SH::NI; ++ni) bfr[ni] = *(const bf16x8*)(st + boff + ni * 32 * LDS_PITCH + ks * 32);
#pragma unroll
        for (int mi = 0; mi < SH::MI; ++mi)
#pragma unroll
            for (int ni = 0; ni < SH::NI; ++ni)
                acc[mi][ni] = ((TOKMASK >> ni) & 1u) ? MFMA32(bfr[ni], af[mi], acc[mi][ni]) : MFMA32(af[mi], bfr[ni], acc[mi][ni]);
    }
    if (kt + 1 < nk) {
        unsigned char* sn = lds + ((kt + 1) & 1) * SH::STAGE_BYTES;
#pragma unroll
        for (int i = 0; i < SH::CHUNKS; ++i) *(u32x4*)(sn + lo[i]) = g[CUR ^ 1][i];
    }
    __syncthreads();
}
template <class SH, unsigned TOKMASK>
__device__ __forceinline__ void gemm_mainloop(const unsigned short* __restrict__ A0, long lda, const unsigned short* __restrict__ B0, long ldb, int K,
                                              unsigned char* lds, f32x16 (&acc)[SH::MI][SH::NI], int tid) {
    const int lane = tid & 63, wave = __builtin_amdgcn_readfirstlane(tid >> 6), r32 = lane & 31, hi = lane >> 5;
    const int wm = wave / SH::WN, wn = wave % SH::WN;
    const unsigned short* gp[SH::CHUNKS]; int lo[SH::CHUNKS];
#pragma unroll
    for (int i = 0; i < SH::CHUNKS; ++i) {
        const int c = tid + i * 512, row = c >> 3, kc = c & 7;
        gp[i] = (row < SH::BM) ? (A0 + (long)row * lda + kc * 8) : (B0 + (long)(row - SH::BM) * ldb + kc * 8);
        lo[i] = row * LDS_PITCH + kc * 16;
    }
    u32x4 g[2][SH::CHUNKS];
    const int nk = K >> 6;
#pragma unroll
    for (int i = 0; i < SH::CHUNKS; ++i) { g[0][i] = *(const u32x4*)gp[i]; g[1][i] = *(const u32x4*)(gp[i] + 64); }
#pragma unroll
    for (int i = 0; i < SH::CHUNKS; ++i) *(u32x4*)(lds + lo[i]) = g[0][i];
    __syncthreads();
    const int aoff = (wm * SH::MI * 32 + r32) * LDS_PITCH + hi * 16;
    const int boff = (SH::BM + wn * SH::NI * 32 + r32) * LDS_PITCH + hi * 16;
    for (int kt = 0; kt < nk; kt += 2) {
        gemm_step<SH, TOKMASK, 0>(lds, gp, lo, g, acc, kt, nk, aoff, boff);
        gemm_step<SH, TOKMASK, 1>(lds, gp, lo, g, acc, kt + 1, nk, aoff, boff);
    }
}

typedef __attribute__((ext_vector_type(4))) float f32x4_t;
namespace g256 {
constexpr int BK = 64, HALF = 128, HT = HALF * BK;
__device__ __forceinline__ int lds_byte(int r, int c) { const int st = (r >> 4) * 2 + (c >> 5), rr = r & 15, cc = c & 31, ob = rr * 64 + cc * 2; return st * 1024 + (ob ^ (((ob >> 9) & 1) << 5)); }
__device__ __forceinline__ void stage_rc(int b, int& R, int& C) { const int st = b / 1024, sb = b % 1024, swz = sb ^ (((sb >> 9) & 1) << 5); R = (st >> 1) * 16 + swz / 64; C = (st & 1) * 32 + (swz % 64) / 2; }
template <int K, int PITCH = K>
__device__ __forceinline__ void mainloop(const unsigned short* __restrict__ A, const unsigned short* __restrict__ Bt, int brow, int bcol, unsigned short* shm, f32x4_t (&acc)[2][2][4][2]) {
#define SA(b, h) (shm + ((b) * 2 + (h)) * HT)
#define SB(b, h) (shm + (4 + (b) * 2 + (h)) * HT)
#define STAGE_X(T, P, BASE, br, kt) do { const AS1 char* ub_ = (const AS1 char*)(BASE) + ((long)(br) * PITCH + (long)(kt) * BK) * 2;     \
    for (int i_ = 0; i_ < 2; ++i_) { const int b_ = (T) * 16 + i_ * 8192; int r_, c_; stage_rc(b_, r_, c_); \
      __builtin_amdgcn_global_load_lds((const AS1 unsigned*)(ub_ + (unsigned)(r_ * PITCH + c_) * 2u), (LAS unsigned*)((LAS char*)(P) + b_), 16, 0, 0); } } while (0)
#define STAGE(P, BASE, br, kt) STAGE_X(tx, P, BASE, br, kt)
#define LDA(dst, b, h) for (int m = 0; m < 4; ++m) for (int k = 0; k < 2; ++k) dst[m][k] = *reinterpret_cast<const bf16x8*>((char*)SA(b, h) + lds_byte(wr * 64 + m * 16 + fr, k * 32 + fq * 8))
#define LDB(dst, b, h) for (int n = 0; n < 2; ++n) for (int k = 0; k < 2; ++k) dst[n][k] = *reinterpret_cast<const bf16x8*>((char*)SB(b, h) + lds_byte(wc * 32 + n * 16 + fr, k * 32 + fq * 8))
#define MMA(ai, bj, At_, Bt_) do { __builtin_amdgcn_s_setprio(1); \
    for (int m = 0; m < 4; ++m) for (int n = 0; n < 2; ++n) for (int k = 0; k < 2; ++k) acc[ai][bj][m][n] = __builtin_amdgcn_mfma_f32_16x16x32_bf16(At_[m][k], Bt_[n][k], acc[ai][bj][m][n], 0, 0, 0); \
    __builtin_amdgcn_s_setprio(0); } while (0)
#define WAIT_V(n) asm volatile("s_waitcnt vmcnt(" #n ")" ::: "memory")
#define WAIT_L(n) asm volatile("s_waitcnt lgkmcnt(" #n ")" ::: "memory")
#define BAR __builtin_amdgcn_s_barrier()
#define SCHED __builtin_amdgcn_sched_barrier(0)
    int tx = threadIdx.x; asm volatile("" : "+v"(tx));
    int wid = tx >> 6, lane = tx & 63, wr = wid >> 2, wc = wid & 3, fr = lane & 15, fq = lane >> 4;
    bf16x8 At[4][2], B0[2][2], B1[2][2];
    const int nt = K / BK;
    STAGE(SB(0, 0), Bt, bcol, 0); STAGE(SA(0, 0), A, brow, 0);
    STAGE(SB(0, 1), Bt, bcol + HALF, 0); STAGE(SA(0, 1), A, brow + HALF, 0);
    if (wr == 1) BAR;
    WAIT_V(4); BAR;
    STAGE(SB(1, 0), Bt, bcol, 1); STAGE(SA(1, 0), A, brow, 1); STAGE(SB(1, 1), Bt, bcol + HALF, 1);
    WAIT_V(6); BAR;
    for (int t = 0; t < nt - 2; t += 2) {
        LDB(B0, 0, 0); SCHED; LDA(At, 0, 0); STAGE(SA(1, 1), A, brow + HALF, t + 1);
        WAIT_L(8); BAR; WAIT_L(0); MMA(0, 0, At, B0); BAR; SCHED;
        LDB(B1, 0, 1); STAGE(SB(0, 0), Bt, bcol, t + 2);
        BAR; WAIT_L(0); MMA(0, 1, At, B1); BAR;
        LDA(At, 0, 1); STAGE(SA(0, 0), A, brow, t + 2);
        BAR; WAIT_L(0); MMA(1, 0, At, B0); BAR; SCHED;
        STAGE(SB(0, 1), Bt, bcol + HALF, t + 2);
        WAIT_V(6); BAR; MMA(1, 1, At, B1); BAR;
        LDB(B0, 1, 0); SCHED; LDA(At, 1, 0); STAGE(SA(0, 1), A, brow + HALF, t + 2);
        WAIT_L(8); BAR; WAIT_L(0); MMA(0, 0, At, B0); BAR; SCHED;
        LDB(B1, 1, 1); STAGE(SB(1, 0), Bt, bcol, t + 3);
        BAR; WAIT_L(0); MMA(0, 1, At, B1); BAR;
        LDA(At, 1, 1); STAGE(SA(1, 0), A, brow, t + 3);
        BAR; WAIT_L(0); MMA(1, 0, At, B0); BAR; SCHED;
        STAGE(SB(1, 1), Bt, bcol + HALF, t + 3);
        WAIT_V(6); BAR; MMA(1, 1, At, B1); BAR;
    }
    int tz = threadIdx.x; asm volatile("" : "+v"(tz)); wid = tz >> 6; lane = tz & 63; wr = wid >> 2; wc = wid & 3; fr = lane & 15; fq = lane >> 4;
    { LDB(B0, 0, 0); WAIT_V(0); LDA(At, 0, 0); STAGE_X(tz, SA(1, 1), A, brow + HALF, nt - 1);
      BAR; WAIT_L(0); MMA(0, 0, At, B0); BAR;
      LDB(B1, 0, 1); BAR; WAIT_L(0); MMA(0, 1, At, B1); BAR;
      LDA(At, 0, 1); WAIT_V(4); BAR; WAIT_L(0); MMA(1, 0, At, B0); MMA(1, 1, At, B1); BAR; }
    { LDB(B0, 1, 0); LDA(At, 1, 0); WAIT_V(2); BAR; WAIT_L(0); MMA(0, 0, At, B0); BAR;
      LDB(B1, 1, 1); WAIT_V(0); BAR; WAIT_L(0); MMA(0, 1, At, B1); BAR;
      LDA(At, 1, 1); BAR; WAIT_L(0); MMA(1, 0, At, B0); MMA(1, 1, At, B1); BAR; }
    if (wr == 0) BAR;
#undef SA
#undef SB
#undef STAGE_X
#undef STAGE
#undef LDA
#undef LDB
#undef MMA
#undef WAIT_V
#undef WAIT_L
#undef BAR
#undef SCHED
}
}

__device__ __forceinline__ void p5_outproj_256(unsigned char* lds, const unsigned short* __restrict__ mix, const unsigned short* __restrict__ wt_out, const float* __restrict__ ssqa, const float* __restrict__ ssqb,
                                               const float* __restrict__ x, float* __restrict__ out, unsigned short* __restrict__ hb, float* __restrict__ hss) {
    const int vcu = (blockIdx.x & 7) * (NBLK / 8) + (blockIdx.x >> 3);
    for (int tile = vcu; tile < 64 * 4; tile += NBLK) {
        const int m0 = (tile >> 2) * 256, n0 = (tile & 3) * 256;
        f32x4_t acc[2][2][4][2];
#pragma unroll
        for (int ai = 0; ai < 2; ++ai)
#pragma unroll
            for (int bj = 0; bj < 2; ++bj)
#pragma unroll
                for (int m = 0; m < 4; ++m)
#pragma unroll
                    for (int n = 0; n < 2; ++n) acc[ai][bj][m][n] = f32x4_t{0.f, 0.f, 0.f, 0.f};
        g256::mainloop<512, 1024>(wt_out, mix, n0, m0, (unsigned short*)lds, acc);
        float rb[2][2];
        {
            const int tid = tid_(); const int lane = tid & 63, wave = __builtin_amdgcn_readfirstlane(tid >> 6), wc = wave & 3, fr = lane & 15;
#pragma unroll
            for (int bj = 0; bj < 2; ++bj)
#pragma unroll
                for (int n = 0; n < 2; ++n) {
                    const long tok = m0 + bj * 128 + wc * 32 + n * 16 + fr; float sa = 0.f, sb = 0.f;
#pragma unroll
                    for (int hh = 0; hh < 8; ++hh) { sa += ssqa[(long)hh * T_ + tok]; sb += ssqb[(long)hh * T_ + tok]; }
                    rb[bj][n] = rsqrtf(sb * (1.f / 512.f) + EPS); const float ratio = rsqrtf(sa * (1.f / 512.f) + EPS) / rb[bj][n];
#pragma unroll
                    for (int ai = 0; ai < 2; ++ai)
#pragma unroll
                        for (int m = 0; m < 4; ++m) acc[ai][bj][m][n] *= ratio;
                }
        }
        g256::mainloop<512, 1024>(wt_out + 512, mix + 512, n0, m0, (unsigned short*)lds, acc);
        const int tid = tid_(); const int lane = tid & 63, wave = __builtin_amdgcn_readfirstlane(tid >> 6), wr = wave >> 2, wc = wave & 3, fr = lane & 15, fq = lane >> 4;
#pragma unroll
        for (int bj = 0; bj < 2; ++bj)
#pragma unroll
            for (int n = 0; n < 2; ++n) {
                const long tok = m0 + bj * 128 + wc * 32 + n * 16 + fr; const float r = rb[bj][n];
                float ss = 0.f;
#pragma unroll
                for (int ai = 0; ai < 2; ++ai)
#pragma unroll
                    for (int m = 0; m < 4; ++m) {
                        const int nrow = n0 + ai * 128 + wr * 64 + m * 16 + fq * 4;
                        const float4 xv = *(const float4*)(x + tok * 1024 + nrow);
                        float4 hv; hv.x = xv.x + acc[ai][bj][m][n][0] * r; hv.y = xv.y + acc[ai][bj][m][n][1] * r; hv.z = xv.z + acc[ai][bj][m][n][2] * r; hv.w = xv.w + acc[ai][bj][m][n][3] * r;
                        *(float4*)(out + tok * 1024 + nrow) = hv;
                        uint2 pk; pk.x = cvtpk(hv.x, hv.y); pk.y = cvtpk(hv.z, hv.w);
                        *(uint2*)(hb + tok * 1024 + nrow) = pk;
                        ss += hv.x * hv.x + hv.y * hv.y + hv.z * hv.z + hv.w * hv.w;
                    }
                { auto r1 = __builtin_amdgcn_permlane16_swap(__float_as_uint(ss), __float_as_uint(ss), false, false); ss = __uint_as_float(r1[0]) + __uint_as_float(r1[1]); }
                ss = pair_sum(ss);
                if (fq == 0) { hss[tok * 16 + (n0 >> 8) * 4 + wr] = ss; hss[tok * 16 + (n0 >> 8) * 4 + 2 + wr] = 0.f; }
            }
        __syncthreads();
    }
}
__device__ __forceinline__ void p6_peerq_256(unsigned char* lds, const unsigned short* __restrict__ hb, const unsigned short* __restrict__ wt_q, const float* __restrict__ hss,
                                             unsigned short* __restrict__ pqb, float* __restrict__ pss) {
    const int vcu = (blockIdx.x & 7) * (NBLK / 8) + (blockIdx.x >> 3);
    for (int tile = vcu; tile < 64 * 8; tile += NBLK) {
        const int m0 = (tile >> 3) * 256, n0 = (tile & 7) * 256;
        f32x4_t acc[2][2][4][2];
#pragma unroll
        for (int ai = 0; ai < 2; ++ai)
#pragma unroll
            for (int bj = 0; bj < 2; ++bj)
#pragma unroll
                for (int m = 0; m < 4; ++m)
#pragma unroll
                    for (int n = 0; n < 2; ++n) acc[ai][bj][m][n] = f32x4_t{0.f, 0.f, 0.f, 0.f};
        g256::mainloop<1024>(wt_q, hb, n0, m0, (unsigned short*)lds, acc);
        const int tid = tid_(); const int lane = tid & 63, wave = __builtin_amdgcn_readfirstlane(tid >> 6), wr = wave >> 2, wc = wave & 3, fr = lane & 15, fq = lane >> 4;
#pragma unroll
        for (int bj = 0; bj < 2; ++bj)
#pragma unroll
            for (int n = 0; n < 2; ++n) {
                const long tok = m0 + bj * 128 + wc * 32 + n * 16 + fr;
                const float4* hp = (const float4*)(hss + tok * 16);
                const float4 s0 = hp[0], s1 = hp[1], s2 = hp[2], s3 = hp[3];
                const float rs = rsqrtf((s0.x + s0.y + s0.z + s0.w + s1.x + s1.y + s1.z + s1.w + s2.x + s2.y + s2.z + s2.w + s3.x + s3.y + s3.z + s3.w) * (1.f / 1024.f) + EPS);
                float ss = 0.f;
#pragma unroll
                for (int ai = 0; ai < 2; ++ai)
#pragma unroll
                    for (int m = 0; m < 4; ++m) {
                        const int nrow = n0 + ai * 128 + wr * 64 + m * 16 + fq * 4;
                        const float v0 = acc[ai][bj][m][n][0] * rs, v1 = acc[ai][bj][m][n][1] * rs, v2 = acc[ai][bj][m][n][2] * rs, v3 = acc[ai][bj][m][n][3] * rs;
                        uint2 pk; pk.x = cvtpk(v0, v1); pk.y = cvtpk(v2, v3);
                        *(uint2*)(pqb + tok * 2048 + nrow) = pk;
                        ss += v0 * v0 + v1 * v1 + v2 * v2 + v3 * v3;
                    }
                { auto r1 = __builtin_amdgcn_permlane16_swap(__float_as_uint(ss), __float_as_uint(ss), false, false); ss = __uint_as_float(r1[0]) + __uint_as_float(r1[1]); }
                ss = pair_sum(ss);
                if (fq == 0) { pss[tok * 32 + (n0 >> 8) * 4 + wr] = ss; pss[tok * 32 + (n0 >> 8) * 4 + 2 + wr] = 0.f; }
            }
        __syncthreads();
    }
}

__device__ __forceinline__ unsigned ordkey(float f) { const unsigned u = __float_as_uint(f); return (u & 0x80000000u) ? ~u : (u | 0x80000000u); }
__device__ __forceinline__ float orddec(unsigned k) { return __uint_as_float((k & 0x80000000u) ? (k & 0x7fffffffu) : ~k); }
#define CE_DESC(a, b) do { const unsigned mx_ = max(a, b), mn_ = min(a, b); a = mx_; b = mn_; } while (0)
__device__ __forceinline__ void sort16_desc(unsigned (&v)[16]) {
#pragma unroll
    for (int k = 2; k <= 16; k <<= 1)
#pragma unroll
        for (int j = k >> 1; j > 0; j >>= 1)
#pragma unroll
            for (int i = 0; i < 16; ++i) {
                const int l = i ^ j;
                if (l > i) { if ((i & k) == 0) { CE_DESC(v[i], v[l]); } else { CE_DESC(v[l], v[i]); } }
            }
}
__device__ __forceinline__ void merge16_desc(unsigned (&a)[16], const unsigned (&b)[16]) {
#pragma unroll
    for (int i = 0; i < 16; ++i) a[i] = max(a[i], b[15 - i]);
#pragma unroll
    for (int j = 8; j > 0; j >>= 1)
#pragma unroll
        for (int i = 0; i < 16; ++i) { const int l = i ^ j; if (l > i) CE_DESC(a[i], a[l]); }
}
__device__ __forceinline__ void top16_of_lanepair(unsigned (&k0)[16], unsigned (&k1)[16], unsigned (&k2)[16], unsigned (&k3)[16]) {
    sort16_desc(k0); sort16_desc(k1); sort16_desc(k2); sort16_desc(k3);
    merge16_desc(k0, k1); merge16_desc(k2, k3); merge16_desc(k0, k2);
    unsigned o[16];
#pragma unroll
    for (int i = 0; i < 16; ++i) { auto rr = __builtin_amdgcn_permlane32_swap(k0[i], k0[i], false, false); k0[i] = rr[0]; o[i] = rr[1]; }
    merge16_desc(k0, o);
}
__device__ __forceinline__ void peer_route_mfma(unsigned char* lds, const unsigned short* __restrict__ pqb, const float* __restrict__ pss, const unsigned short* __restrict__ sk16, int* __restrict__ eo, float* __restrict__ go) {
    const int tid = tid_(); const int lane = tid & 63, w = __builtin_amdgcn_readfirstlane(tid >> 6), r32 = lane & 31, hi = lane >> 5;
    const int h = blockIdx.x & 7;
    constexpr int SKP = 272;
    for (int c16 = tid; c16 < 256 * 16; c16 += 512) { const int row = c16 >> 4, ch = c16 & 15; *(uint4*)(lds + row * SKP + ch * 16) = *(const uint4*)(sk16 + ((long)h * 256 + row) * 128 + ch * 8); }
    __syncthreads();
    for (int it = 0; it < 2; ++it) {
        const long tok = (long)((blockIdx.x >> 3) * 16 + w * 2 + it) * 32 + r32;
        const float4 ps = *(const float4*)(pss + tok * 32 + h * 4);
        const float rs = rsqrtf((ps.x + ps.y + ps.z + ps.w) * (1.f / 256.f) + EPS);
        unsigned T1[16], T2[16];
#pragma unroll
        for (int c = 0; c < 2; ++c) {
            f32x16 acc[4];
#pragma unroll
            for (int mt = 0; mt < 4; ++mt)
#pragma unroll
                for (int r = 0; r < 16; ++r) acc[mt][r] = 0.f;
            const unsigned short* qrow = pqb + tok * 2048 + h * 256 + c * 128 + hi * 8;
            const unsigned char* krow = lds + (c * 128 + r32) * SKP + hi * 16;
#pragma unroll 2
            for (int ks = 0; ks < 8; ++ks) {
                const bf16x8 qf = *(const bf16x8*)(qrow + ks * 16);
#pragma unroll
                for (int mt = 0; mt < 4; ++mt) { const bf16x8 kf = *(const bf16x8*)(krow + mt * 32 * SKP + ks * 32); acc[mt] = MFMA32(kf, qf, acc[mt]); }
            }
            unsigned k0[16], k1[16], k2[16], k3[16];
#pragma unroll
            for (int r = 0; r < 16; ++r) {
                const unsigned idx = 127u - (unsigned)crow(r, hi);
                k0[r] = (ordkey(acc[0][r] * rs) & ~127u) | idx; k1[r] = (ordkey(acc[1][r] * rs) & ~127u) | (idx - 32u);
                k2[r] = (ordkey(acc[2][r] * rs) & ~127u) | (idx - 64u); k3[r] = (ordkey(acc[3][r] * rs) & ~127u) | (idx - 96u);
            }
            top16_of_lanepair(k0, k1, k2, k3);
            if (c == 0) {
#pragma unroll
                for (int i = 0; i < 16; ++i) T1[i] = k0[i];
            } else {
#pragma unroll
                for (int i = 0; i < 16; ++i) T2[i] = k0[i];
            }
        }
        float v1[16], v2[16]; unsigned p1[4] = {0u, 0u, 0u, 0u}, p2[4] = {0u, 0u, 0u, 0u};
#pragma unroll
        for (int i = 0; i < 16; ++i) {
            v1[i] = orddec(T1[i] & ~127u); v2[i] = orddec(T2[i] & ~127u);
            p1[i >> 2] |= (127u - (T1[i] & 127u)) << (8 * (i & 3)); p2[i >> 2] |= (127u - (T2[i] & 127u)) << (8 * (i & 3));
        }
        unsigned c0[16], c1[16], c2[16], c3[16];
#define CAND(a, b) ((ordkey(v1[a] + v2[b]) & ~255u) | (255u - (unsigned)((a) * 16 + (b))))
        c0[0] = CAND(0, 0); c0[1] = CAND(0, 1); c0[2] = CAND(0, 2); c0[3] = CAND(0, 3); c0[4] = CAND(0, 4); c0[5] = CAND(0, 5); c0[6] = CAND(0, 6); c0[7] = CAND(0, 7);
        c0[8] = CAND(0, 8); c0[9] = CAND(0, 9); c0[10] = CAND(0, 10); c0[11] = CAND(0, 11); c0[12] = CAND(0, 12); c0[13] = CAND(0, 13); c0[14] = CAND(0, 14); c0[15] = CAND(0, 15);
        c1[0] = CAND(1, 0); c1[1] = CAND(1, 1); c1[2] = CAND(1, 2); c1[3] = CAND(1, 3); c1[4] = CAND(1, 4); c1[5] = CAND(1, 5); c1[6] = CAND(1, 6); c1[7] = CAND(1, 7);
        c1[8] = CAND(2, 0); c1[9] = CAND(2, 1); c1[10] = CAND(2, 2); c1[11] = CAND(2, 3); c1[12] = CAND(2, 4); c1[13] = CAND(3, 0); c1[14] = CAND(3, 1); c1[15] = CAND(3, 2);
        c2[0] = CAND(3, 3); c2[1] = CAND(4, 0); c2[2] = CAND(4, 1); c2[3] = CAND(4, 2); c2[4] = CAND(5, 0); c2[5] = CAND(5, 1); c2[6] = CAND(6, 0); c2[7] = CAND(6, 1);
        c2[8] = CAND(7, 0); c2[9] = CAND(7, 1); c2[10] = CAND(8, 0); c2[11] = CAND(9, 0); c2[12] = CAND(10, 0); c2[13] = CAND(11, 0); c2[14] = CAND(12, 0); c2[15] = CAND(13, 0);
        c3[0] = CAND(14, 0); c3[1] = CAND(15, 0);
#pragma unroll
        for (int i = 2; i < 16; ++i) c3[i] = 0u;
#undef CAND
        sort16_desc(c0); sort16_desc(c1); sort16_desc(c2); sort16_desc(c3);
        merge16_desc(c0, c1); merge16_desc(c2, c3); merge16_desc(c0, c2);
        float ev[16]; int ee[16]; float l = 0.f; const float mx = orddec(c0[0] & ~255u);
#pragma unroll
        for (int i = 0; i < 16; ++i) {
            const unsigned ci = 255u - (c0[i] & 255u); const unsigned a = ci >> 4, b = ci & 15u;
            const unsigned wa = (a >> 2) == 0 ? p1[0] : ((a >> 2) == 1 ? p1[1] : ((a >> 2) == 2 ? p1[2] : p1[3]));
            const unsigned wb = (b >> 2) == 0 ? p2[0] : ((b >> 2) == 1 ? p2[1] : ((b >> 2) == 2 ? p2[2] : p2[3]));
            const unsigned i1 = (wa >> (8 * (a & 3u))) & 255u, i2 = (wb >> (8 * (b & 3u))) & 255u;
            ee[i] = (int)(i1 * 128u + i2);
            ev[i] = __expf(orddec(c0[i] & ~255u) - mx); l += ev[i];
        }
        const float inv = 1.f / l;
        if (hi == 0) {
            int4* ep = (int4*)(eo + tok * 128 + h * 16);
            ep[0] = make_int4(ee[0], ee[1], ee[2], ee[3]); ep[1] = make_int4(ee[4], ee[5], ee[6], ee[7]); ep[2] = make_int4(ee[8], ee[9], ee[10], ee[11]); ep[3] = make_int4(ee[12], ee[13], ee[14], ee[15]);
        } else {
            float4* gp = (float4*)(go + tok * 128 + h * 16);
            gp[0] = make_float4(ev[0] * inv, ev[1] * inv, ev[2] * inv, ev[3] * inv); gp[1] = make_float4(ev[4] * inv, ev[5] * inv, ev[6] * inv, ev[7] * inv);
            gp[2] = make_float4(ev[8] * inv, ev[9] * inv, ev[10] * inv, ev[11] * inv); gp[3] = make_float4(ev[12] * inv, ev[13] * inv, ev[14] * inv, ev[15] * inv);
        }
    }
}

template <int DQK>
struct FA {
    static constexpr int NDS = DQK / 16, KP = DQK * 2 + 16, KBYTES = 64 * KP, VP = 144, VBYTES = 64 * VP, STAGE = KBYTES + VBYTES;
    static constexpr int KCH = 64 * DQK / 8, NCH = KCH + 512, SLOTS = (NCH + 511) / 512;
};
constexpr float FA_THR = 8.f;
constexpr float FA_NEG = -1e30f;
struct FaRegs { uint4 g0, g1, g2; };
template <int DQK>
__device__ __forceinline__ uint4 fa_load1(const unsigned short* __restrict__ Kg, int kpitch, const unsigned short* __restrict__ Vg, int vpitch, int tid, int i) {
    int c = tid + i * 512; if (c >= FA<DQK>::NCH) c = 0;
    const int key = c / (DQK / 8), kc = c % (DQK / 8); const int c2 = c - FA<DQK>::KCH; const int d = c2 >> 3, vc = c2 & 7;
    const unsigned koff = (unsigned)(key * kpitch + kc * 8) * 2u, voff = (unsigned)(d * vpitch + vc * 8) * 2u;
#if defined(__HIP_DEVICE_COMPILE__)
    typedef unsigned u32x4_t __attribute__((ext_vector_type(4)));
    const u32x4_t v = (c < FA<DQK>::KCH) ? *(const AS1 u32x4_t*)((const AS1 char*)Kg + koff) : *(const AS1 u32x4_t*)((const AS1 char*)Vg + voff);
    return make_uint4(v.x, v.y, v.z, v.w);
#else
    (void)koff; (void)voff; return make_uint4(0u, 0u, 0u, 0u);
#endif
}
template <int DQK>
__device__ __forceinline__ void fa_store1(unsigned char* st, const uint4& g, int tid, int i) {
    const int c = tid + i * 512;
    const int key = c / (DQK / 8), kc = c % (DQK / 8); const int c2 = c - FA<DQK>::KCH; const int d = c2 >> 3, vc = c2 & 7;
    const int off = (c < FA<DQK>::KCH) ? (key * FA<DQK>::KP + kc * 16) : (FA<DQK>::KBYTES + d * FA<DQK>::VP + vc * 16);
    if (c < FA<DQK>::NCH) *(uint4*)(st + off) = g;
}
template <int DQK>
__device__ __forceinline__ void fa_load(const unsigned short* __restrict__ Kg, int kpitch, const unsigned short* __restrict__ Vg, int vpitch, FaRegs& g, int tid) {
    g.g0 = fa_load1<DQK>(Kg, kpitch, Vg, vpitch, tid, 0); g.g1 = fa_load1<DQK>(Kg, kpitch, Vg, vpitch, tid, 1);
    if (FA<DQK>::SLOTS > 2) g.g2 = fa_load1<DQK>(Kg, kpitch, Vg, vpitch, tid, 2);
}
template <int DQK>
__device__ __forceinline__ void fa_store(unsigned char* st, const FaRegs& g, int tid) {
    fa_store1<DQK>(st, g.g0, tid, 0); fa_store1<DQK>(st, g.g1, tid, 1);
    if (FA<DQK>::SLOTS > 2) fa_store1<DQK>(st, g.g2, tid, 2);
}
template <int DQK, int MODE, bool STATS_ONLY = false>
__device__ __forceinline__ void fa_tile(const unsigned char* st, const bf16x8 (&qf)[FA<DQK>::NDS], f32x16 (&o)[2], float& mref, float& l, int key0, int qpos, int lane, bool need_mask, bool colsel = true) {
    asm volatile("" : "+v"(lane));
    const int r32 = lane & 31, hi = lane >> 5;
    f32x16 s0, s1;
#pragma unroll
    for (int r = 0; r < 16; ++r) { s0[r] = 0.f; s1[r] = 0.f; }
    {
        bf16x8 k0 = *(const bf16x8*)(st + r32 * FA<DQK>::KP + hi * 16);
        bf16x8 k1 = *(const bf16x8*)(st + (32 + r32) * FA<DQK>::KP + hi * 16);
#pragma unroll
        for (int ds = 0; ds < FA<DQK>::NDS; ++ds) {
            bf16x8 n0 = k0, n1 = k1;
            if (ds + 1 < FA<DQK>::NDS) {
                n0 = *(const bf16x8*)(st + r32 * FA<DQK>::KP + (ds + 1) * 32 + hi * 16);
                n1 = *(const bf16x8*)(st + (32 + r32) * FA<DQK>::KP + (ds + 1) * 32 + hi * 16);
            }
            s0 = MFMA32(k0, qf[ds], s0); s1 = MFMA32(k1, qf[ds], s1);
            k0 = n0; k1 = n1;
            __builtin_amdgcn_sched_barrier(0);
        }
    }
    __builtin_amdgcn_sched_barrier(0);
    if (MODE != 0 && need_mask) {
#pragma unroll
        for (int r = 0; r < 16; ++r) {
            const int ka = key0 + crow(r, hi), kb = ka + 32;
            bool ma, mb;
            if (MODE == 4) { ma = 16 * ka + 31 > qpos; mb = 16 * kb + 31 > qpos; }
            else { ma = ka > qpos; mb = kb > qpos; }
            if (MODE == 2) { ma = ma || (ka <= qpos - 512); mb = mb || (kb <= qpos - 512); }
            if (ma) s0[r] = -INFINITY;
            if (mb) s1[r] = -INFINITY;
        }
    }
    float mxa = max3f(s0[0], s0[1], s0[2]), mxb = max3f(s1[0], s1[1], s1[2]);
#pragma unroll
    for (int r = 3; r < 15; r += 2) { mxa = max3f(mxa, s0[r], s0[r + 1]); mxb = max3f(mxb, s1[r], s1[r + 1]); }
    float mx = max3f(mxa, mxb, fmaxf(s0[15], s1[15]));
    if (MODE == 3) mx = colsel ? mx : -INFINITY;
    mx = pair_max(mx);
    if (__any(mx > mref + FA_THR)) {
        const float mnew = (mx > mref + FA_THR) ? mx : mref;
        const float alpha = __builtin_amdgcn_exp2f(mref - mnew);
        mref = mnew; l *= alpha;
#pragma unroll
        for (int r = 0; r < 16; ++r) { o[0][r] *= alpha; o[1][r] *= alpha; }
    }
    const float mre = (MODE == 3) ? (colsel ? mref : INFINITY) : mref;
    const f32x2_t mm = {mre, mre};
    f32x2_t ps0 = {0.f, 0.f}, ps1 = {0.f, 0.f};
#pragma unroll
    for (int r = 0; r < 16; r += 2) {
        const f32x2_t d0 = f32x2_t{s0[r], s0[r + 1]} - mm, d1 = f32x2_t{s1[r], s1[r + 1]} - mm;
        s0[r] = __builtin_amdgcn_exp2f(d0.x); s0[r + 1] = __builtin_amdgcn_exp2f(d0.y); s1[r] = __builtin_amdgcn_exp2f(d1.x); s1[r + 1] = __builtin_amdgcn_exp2f(d1.y);
        ps0 += f32x2_t{s0[r], s0[r + 1]}; ps1 += f32x2_t{s1[r], s1[r + 1]};
    }
    ps0 += ps1;
    l += ps0.x + ps0.y;
    if (STATS_ONLY) return;
    bf16x8 pk[4];
#pragma unroll
    for (int s = 0; s < 2; ++s) {
        uint4 a, b;
        a.x = cvtpk(s0[8 * s], s0[8 * s + 1]); a.y = cvtpk(s0[8 * s + 2], s0[8 * s + 3]); a.z = cvtpk(s0[8 * s + 4], s0[8 * s + 5]); a.w = cvtpk(s0[8 * s + 6], s0[8 * s + 7]);
        b.x = cvtpk(s1[8 * s], s1[8 * s + 1]); b.y = cvtpk(s1[8 * s + 2], s1[8 * s + 3]); b.z = cvtpk(s1[8 * s + 4], s1[8 * s + 5]); b.w = cvtpk(s1[8 * s + 6], s1[8 * s + 7]);
        pk[s] = __builtin_bit_cast(bf16x8, a); pk[2 + s] = __builtin_bit_cast(bf16x8, b);
    }
    const unsigned char* vt = st + FA<DQK>::KBYTES;
    __builtin_amdgcn_sched_barrier(0);
    {
        bf16x8 v0 = *(const bf16x8*)(vt + r32 * FA<DQK>::VP + hi * 16);
        bf16x8 v1 = *(const bf16x8*)(vt + (32 + r32) * FA<DQK>::VP + hi * 16);
#pragma unroll
        for (int ks = 0; ks < 4; ++ks) {
            bf16x8 n0 = v0, n1 = v1;
            if (ks + 1 < 4) {
                n0 = *(const bf16x8*)(vt + r32 * FA<DQK>::VP + (ks + 1) * 32 + hi * 16);
                n1 = *(const bf16x8*)(vt + (32 + r32) * FA<DQK>::VP + (ks + 1) * 32 + hi * 16);
            }
            o[0] = MFMA32(v0, pk[ks], o[0]); o[1] = MFMA32(v1, pk[ks], o[1]);
            v0 = n0; v1 = n1;
            __builtin_amdgcn_sched_barrier(0);
        }
    }
}
template <int DQK>
__device__ __forceinline__ void fa_qk(const unsigned char* st, const bf16x8 (&qf)[FA<DQK>::NDS], f32x16& s0, f32x16& s1, int lane) {
    const int r32 = lane & 31, hi = lane >> 5;
#pragma unroll
    for (int r = 0; r < 16; ++r) { s0[r] = 0.f; s1[r] = 0.f; }
#pragma unroll
    for (int ds = 0; ds < FA<DQK>::NDS; ++ds) {
        const bf16x8 k0 = *(const bf16x8*)(st + r32 * FA<DQK>::KP + ds * 32 + hi * 16);
        const bf16x8 k1 = *(const bf16x8*)(st + (32 + r32) * FA<DQK>::KP + ds * 32 + hi * 16);
        s0 = MFMA32(k0, qf[ds], s0); s1 = MFMA32(k1, qf[ds], s1);
    }
}
template <int DQK, int MODE>
__device__ __forceinline__ void fa_step(const unsigned char* stc, const unsigned char* stn, const bf16x8 (&qf)[FA<DQK>::NDS], f32x16& s0, f32x16& s1, f32x16& n0, f32x16& n1,
                                        f32x16 (&o)[2], float& mref, float& l, int key0, int qpos, int lane, bool need_mask, bool colsel = true) {
    const int r32 = lane & 31, hi = lane >> 5;
    if (MODE != 0 && need_mask) {
#pragma unroll
        for (int r = 0; r < 16; ++r) {
            const int ka = key0 + crow(r, hi), kb = ka + 32;
            bool ma, mb;
            if (MODE == 4) { ma = 16 * ka + 31 > qpos; mb = 16 * kb + 31 > qpos; }
            else { ma = ka > qpos; mb = kb > qpos; }
            if (MODE == 2) { ma = ma || (ka <= qpos - 512); mb = mb || (kb <= qpos - 512); }
            if (ma) s0[r] = -INFINITY;
            if (mb) s1[r] = -INFINITY;
        }
    }
    float mxa = max3f(s0[0], s0[1], s0[2]), mxb = max3f(s1[0], s1[1], s1[2]);
#pragma unroll
    for (int r = 3; r < 15; r += 2) { mxa = max3f(mxa, s0[r], s0[r + 1]); mxb = max3f(mxb, s1[r], s1[r + 1]); }
    float mx = max3f(mxa, mxb, fmaxf(s0[15], s1[15]));
    if (MODE == 3) mx = colsel ? mx : -INFINITY;
    mx = pair_max(mx);
    if (__any(mx > mref + FA_THR)) {
        const float mnew = (mx > mref + FA_THR) ? mx : mref;
        const float alpha = __builtin_amdgcn_exp2f(mref - mnew);
        mref = mnew; l *= alpha;
#pragma unroll
        for (int r = 0; r < 16; ++r) { o[0][r] *= alpha; o[1][r] *= alpha; }
    }
    const float mre = (MODE == 3) ? (colsel ? mref : INFINITY) : mref;
    const f32x2_t mm = {mre, mre};
    __builtin_amdgcn_sched_barrier(0);
#pragma unroll
    for (int r = 0; r < 16; ++r) { n0[r] = 0.f; n1[r] = 0.f; }
    f32x2_t ps = {0.f, 0.f};
    constexpr int PER = (16 + FA<DQK>::NDS - 1) / FA<DQK>::NDS;
    {
        bf16x8 k0 = *(const bf16x8*)(stn + r32 * FA<DQK>::KP + hi * 16);
        bf16x8 k1 = *(const bf16x8*)(stn + (32 + r32) * FA<DQK>::KP + hi * 16);
#pragma unroll
        for (int ds = 0; ds < FA<DQK>::NDS; ++ds) {
            bf16x8 f0 = k0, f1 = k1;
            if (ds + 1 < FA<DQK>::NDS) {
                f0 = *(const bf16x8*)(stn + r32 * FA<DQK>::KP + (ds + 1) * 32 + hi * 16);
                f1 = *(const bf16x8*)(stn + (32 + r32) * FA<DQK>::KP + (ds + 1) * 32 + hi * 16);
            }
            n0 = MFMA32(k0, qf[ds], n0); n1 = MFMA32(k1, qf[ds], n1);
#pragma unroll
            for (int j = ds * PER; j < (ds + 1) * PER && j < 16; ++j) {
                if (j < 8) { const f32x2_t d = f32x2_t{s0[2 * j], s0[2 * j + 1]} - mm; s0[2 * j] = __builtin_amdgcn_exp2f(d.x); s0[2 * j + 1] = __builtin_amdgcn_exp2f(d.y); ps += f32x2_t{s0[2 * j], s0[2 * j + 1]}; }
                else { const int q = j - 8; const f32x2_t d = f32x2_t{s1[2 * q], s1[2 * q + 1]} - mm; s1[2 * q] = __builtin_amdgcn_exp2f(d.x); s1[2 * q + 1] = __builtin_amdgcn_exp2f(d.y); ps += f32x2_t{s1[2 * q], s1[2 * q + 1]}; }
            }
            asm volatile("" : "+v"(ps));
            k0 = f0; k1 = f1;
            __builtin_amdgcn_sched_barrier(0);
        }
    }
    l += ps.x + ps.y;
    bf16x8 pk[4];
#pragma unroll
    for (int s = 0; s < 2; ++s) {
        uint4 a, b;
        a.x = cvtpk(s0[8 * s], s0[8 * s + 1]); a.y = cvtpk(s0[8 * s + 2], s0[8 * s + 3]); a.z = cvtpk(s0[8 * s + 4], s0[8 * s + 5]); a.w = cvtpk(s0[8 * s + 6], s0[8 * s + 7]);
        b.x = cvtpk(s1[8 * s], s1[8 * s + 1]); b.y = cvtpk(s1[8 * s + 2], s1[8 * s + 3]); b.z = cvtpk(s1[8 * s + 4], s1[8 * s + 5]); b.w = cvtpk(s1[8 * s + 6], s1[8 * s + 7]);
        pk[s] = __builtin_bit_cast(bf16x8, a); pk[2 + s] = __builtin_bit_cast(bf16x8, b);
    }
    const unsigned char* vt = stc + FA<DQK>::KBYTES;
    {
        bf16x8 v0 = *(const bf16x8*)(vt + r32 * FA<DQK>::VP + hi * 16);
        bf16x8 v1 = *(const bf16x8*)(vt + (32 + r32) * FA<DQK>::VP + hi * 16);
#pragma unroll
        for (int ks = 0; ks < 4; ++ks) {
            bf16x8 f0 = v0, f1 = v1;
            if (ks + 1 < 4) {
                f0 = *(const bf16x8*)(vt + r32 * FA<DQK>::VP + (ks + 1) * 32 + hi * 16);
                f1 = *(const bf16x8*)(vt + (32 + r32) * FA<DQK>::VP + (ks + 1) * 32 + hi * 16);
            }
            o[0] = MFMA32(v0, pk[ks], o[0]); o[1] = MFMA32(v1, pk[ks], o[1]);
            v0 = f0; v1 = f1;
            __builtin_amdgcn_sched_barrier(0);
        }
    }
}
__device__ __forceinline__ int vperm(int s) { const int g = (s >> 2) & 3; const int pg = (g == 1) ? 2 : ((g == 2) ? 1 : g); return (s & ~15) | (pg << 2) | (s & 3); }

constexpr float MLA_QSCALE = 0.10206207261596575f * 1.4426950408889634f;
__device__ __forceinline__ void mla_unit(unsigned char* lds, int b, int h, int qb, const unsigned short* __restrict__ Q16, const unsigned short* __restrict__ K16, const unsigned short* __restrict__ VT16,
                                         unsigned short* __restrict__ ob16, float* __restrict__ ssqb, int tid) {
    typedef FA<96> F;
    const int lane = tid & 63, wave = __builtin_amdgcn_readfirstlane(tid >> 6), r32 = lane & 31, hi = lane >> 5;
    const int q0 = qb * 256, qpos = q0 + wave * 32 + r32; const long tok = (long)b * S_ + qpos;
    bf16x8 qf[F::NDS];
#pragma unroll
    for (int ds = 0; ds < F::NDS; ++ds) qf[ds] = *(const bf16x8*)(Q16 + tok * 768 + h * 96 + ds * 16 + hi * 8);
    f32x16 o[2];
#pragma unroll
    for (int r = 0; r < 16; ++r) { o[0][r] = 0.f; o[1][r] = 0.f; }
    float mref = FA_NEG, l = 0.f;
    const unsigned short* Kb = K16 + ((long)(b * 8 + h)) * S_ * 96;
    const unsigned short* Vb = VT16 + ((long)(b * 8 + h)) * 64 * S_;
    const int nt = (q0 + 256) / 64;
    FaRegs g;
    fa_load<96>(Kb, 96, Vb, S_, g, tid); fa_store<96>(lds, g, tid);
    fa_load<96>(Kb + (long)64 * 96, 96, Vb + 64, S_, g, tid); fa_store<96>(lds + F::STAGE, g, tid);
    __syncthreads();
    const int wmin = q0 + wave * 32, wmax = wmin + 31;
    f32x16 sa0, sa1, sb0, sb1;
    fa_qk<96>(lds, qf, sa0, sa1, lane);
#define MLA_STEP(C0, C1, N0, N1, t) do { \
        const int sc_ = (t) % 3, sn_ = ((t) + 1) % 3, sw_ = ((t) + 2) % 3; \
        if ((t) + 2 < nt) fa_load<96>(Kb + (long)((t) + 2) * 64 * 96, 96, Vb + ((t) + 2) * 64, S_, g, tid); \
        const int key0 = (t) * 64; \
        if (key0 <= wmax) fa_step<96, 1>(lds + sc_ * F::STAGE, lds + sn_ * F::STAGE, qf, C0, C1, N0, N1, o, mref, l, key0, qpos, lane, key0 + 63 > wmin); \
        if ((t) + 2 < nt) fa_store<96>(lds + sw_ * F::STAGE, g, tid); \
        __syncthreads(); } while (0)
    for (int t = 0; t < nt; t += 2) {
        MLA_STEP(sa0, sa1, sb0, sb1, t);
        MLA_STEP(sb0, sb1, sa0, sa1, t + 1);
    }
#undef MLA_STEP
    l = pair_sum(l);
    const float inv = 1.f / l;
    float ss = 0.f;
#pragma unroll
    for (int dt = 0; dt < 2; ++dt)
#pragma unroll
        for (int gq = 0; gq < 4; ++gq) {
            const float v0 = o[dt][4 * gq] * inv, v1 = o[dt][4 * gq + 1] * inv, v2 = o[dt][4 * gq + 2] * inv, v3 = o[dt][4 * gq + 3] * inv;
            uint2 pk; pk.x = cvtpk(v0, v1); pk.y = cvtpk(v2, v3);
            *(uint2*)(ob16 + tok * 1024 + 512 + h * 64 + dt * 32 + 8 * gq + 4 * hi) = pk;
            ss += v0 * v0 + v1 * v1 + v2 * v2 + v3 * v3;
        }
    ss = pair_sum(ss);
    if (hi == 0) ssqb[(long)h * T_ + tok] = ss;
}
__device__ __forceinline__ void mla_phase(unsigned char* lds, const unsigned short* __restrict__ Q16, const unsigned short* __restrict__ K16, const unsigned short* __restrict__ VT16,
                                          unsigned short* __restrict__ ob16, float* __restrict__ ssqb) {
    const int tid = tid_();
    for (int i = blockIdx.x; i < 256; i += NBLK) {
        const int xcd = i & 7, slot = i >> 3;
        { const int bh = xcd * 2; mla_unit(lds, bh >> 3, bh & 7, 31 - slot, Q16, K16, VT16, ob16, ssqb, tid); }
        { const int bh = xcd * 2 + 1; mla_unit(lds, bh >> 3, bh & 7, slot, Q16, K16, VT16, ob16, ssqb, tid); }
    }
}
constexpr float NSA_QSCALE = 0.125f * 1.4426950408889634f;
constexpr int IMP_PITCH = 129;
__device__ __forceinline__ void fa_tile_cmp2(const unsigned char* st, const bf16x8 (&qf)[4], f32x16 (&o)[2], float mref, float linv, int key0, int qpos, int lane, float* imp_row) {
    typedef FA<64> F;
    asm volatile("" : "+v"(lane));
    const int r32 = lane & 31, hi = lane >> 5;
    f32x16 s0, s1;
#pragma unroll
    for (int r = 0; r < 16; ++r) { s0[r] = 0.f; s1[r] = 0.f; }
#pragma unroll
    for (int ds = 0; ds < 4; ++ds) {
        const bf16x8 k0 = *(const bf16x8*)(st + r32 * F::KP + ds * 32 + hi * 16);
        const bf16x8 k1 = *(const bf16x8*)(st + (32 + r32) * F::KP + ds * 32 + hi * 16);
        s0 = MFMA32(k0, qf[ds], s0); s1 = MFMA32(k1, qf[ds], s1);
    }
#pragma unroll
    for (int r = 0; r < 16; ++r) {
        const int ka = key0 + crow(r, hi), kb = ka + 32;
        s0[r] = (16 * ka + 31 > qpos) ? 0.f : __builtin_amdgcn_exp2f(s0[r] - mref) * linv;
        s1[r] = (16 * kb + 31 > qpos) ? 0.f : __builtin_amdgcn_exp2f(s1[r] - mref) * linv;
    }
    bf16x8 pk[4];
#pragma unroll
    for (int s = 0; s < 2; ++s) {
        uint4 a, b;
        a.x = cvtpk(s0[8 * s], s0[8 * s + 1]); a.y = cvtpk(s0[8 * s + 2], s0[8 * s + 3]); a.z = cvtpk(s0[8 * s + 4], s0[8 * s + 5]); a.w = cvtpk(s0[8 * s + 6], s0[8 * s + 7]);
        b.x = cvtpk(s1[8 * s], s1[8 * s + 1]); b.y = cvtpk(s1[8 * s + 2], s1[8 * s + 3]); b.z = cvtpk(s1[8 * s + 4], s1[8 * s + 5]); b.w = cvtpk(s1[8 * s + 6], s1[8 * s + 7]);
        pk[s] = __builtin_bit_cast(bf16x8, a); pk[2 + s] = __builtin_bit_cast(bf16x8, b);
    }
    const unsigned char* vt = st + F::KBYTES;
#pragma unroll
    for (int ks = 0; ks < 4; ++ks) {
        const bf16x8 v0 = *(const bf16x8*)(vt + r32 * F::VP + ks * 32 + hi * 16);
        const bf16x8 v1 = *(const bf16x8*)(vt + (32 + r32) * F::VP + ks * 32 + hi * 16);
        o[0] = MFMA32(v0, pk[ks], o[0]); o[1] = MFMA32(v1, pk[ks], o[1]);
    }
#pragma unroll
    for (int r = 0; r < 16; ++r) {
        s0[r] = quad_sum(s0[r]); s1[r] = quad_sum(s1[r]);
    }
    if ((lane & 3) == 0) {
#pragma unroll
        for (int g4 = 0; g4 < 4; ++g4) {
            { const int j = (key0 + 8 * g4 + 4 * hi) >> 2;
              atomicAdd(imp_row + j, s0[4 * g4] + s0[4 * g4 + 1] + s0[4 * g4 + 2] + s0[4 * g4 + 3]);
              if (j + 1 < 128) atomicAdd(imp_row + j + 1, s0[4 * g4 + 3]); }
            { const int j = (key0 + 32 + 8 * g4 + 4 * hi) >> 2;
              atomicAdd(imp_row + j, s1[4 * g4] + s1[4 * g4 + 1] + s1[4 * g4 + 2] + s1[4 * g4 + 3]);
              if (j + 1 < 128) atomicAdd(imp_row + j + 1, s1[4 * g4 + 3]); }
        }
    }
}
#define NSA_STEP_(GCUR, GNEXT, Kbase, kpitch, Vbase, vpitch, t_lo, t_hi, t_, ...) do { \
        const unsigned char* st = stg + (((t_) - (t_lo)) & 1) * FA<64>::STAGE; \
        if ((t_) + 2 <= (t_hi)) fa_load<64>((Kbase) + (long)((t_) + 2) * 64 * (kpitch), (kpitch), (Vbase) + ((t_) + 2) * 64, (vpitch), GCUR, tid); \
        const int key0 = (t_) * 64; (void)key0; \
        __VA_ARGS__ \
        if ((t_) + 1 <= (t_hi)) fa_store<64>(stg + (((t_) + 1 - (t_lo)) & 1) * FA<64>::STAGE, GNEXT, tid); \
        __syncthreads(); } while (0)
#define NSA_STREAM(Kbase, kpitch, Vbase, vpitch, t_lo, t_hi, ...) do { \
    FaRegs ga_, gb_; fa_load<64>((Kbase) + (long)(t_lo) * 64 * (kpitch), (kpitch), (Vbase) + (t_lo) * 64, (vpitch), ga_, tid); \
    if ((t_lo) + 1 <= (t_hi)) fa_load<64>((Kbase) + (long)((t_lo) + 1) * 64 * (kpitch), (kpitch), (Vbase) + ((t_lo) + 1) * 64, (vpitch), gb_, tid); \
    fa_store<64>(stg, ga_, tid); __syncthreads(); \
    for (int t_ = (t_lo); t_ <= (t_hi); t_ += 2) { \
        NSA_STEP_(ga_, gb_, Kbase, kpitch, Vbase, vpitch, t_lo, t_hi, t_, __VA_ARGS__); \
        if (t_ + 1 <= (t_hi)) { const int tt_ = t_ + 1; NSA_STEP2_(gb_, ga_, Kbase, kpitch, Vbase, vpitch, t_lo, t_hi, tt_, __VA_ARGS__); } \
    } } while (0)
#define NSA_STEP2_(GCUR, GNEXT, Kbase, kpitch, Vbase, vpitch, t_lo, t_hi, tq_, ...) do { \
        const int t_ = tq_; \
        const unsigned char* st = stg + ((t_ - (t_lo)) & 1) * FA<64>::STAGE; \
        if (t_ + 2 <= (t_hi)) fa_load<64>((Kbase) + (long)(t_ + 2) * 64 * (kpitch), (kpitch), (Vbase) + (t_ + 2) * 64, (vpitch), GCUR, tid); \
        const int key0 = t_ * 64; (void)key0; \
        __VA_ARGS__ \
        if (t_ + 1 <= (t_hi)) fa_store<64>(stg + ((t_ + 1 - (t_lo)) & 1) * FA<64>::STAGE, GNEXT, tid); \
        __syncthreads(); } while (0)

__device__ __forceinline__ void nsa_unit(unsigned char* lds, int b, int g, int qblk, const unsigned short* __restrict__ Q16A, const unsigned short* __restrict__ KC16, const unsigned short* __restrict__ VCT16,
                                         const unsigned short* __restrict__ KS16, const unsigned short* __restrict__ VST16, const unsigned short* __restrict__ KW16, const unsigned short* __restrict__ VWT16,
                                         const float* __restrict__ gates, unsigned short* __restrict__ oa16, float* __restrict__ ssqa, int tid) {
    typedef FA<64> F;
    const int lane = tid & 63, wave = __builtin_amdgcn_readfirstlane(tid >> 6), r32 = lane & 31, hi = lane >> 5;
    unsigned char* stg = lds;
    float* imp = (float*)(lds + 2 * F::STAGE);
    unsigned* selm = (unsigned*)(lds + 2 * F::STAGE + 64 * IMP_PITCH * 4);
    const int q0 = qblk * 64, cur = qblk;
    const int ql = wave * 8 + (r32 >> 2), hh = g * 4 + (r32 & 3), qpos = q0 + ql; const long tok = (long)b * S_ + qpos; const int bg = b * 2 + g;
    bf16x8 qf[4];
#pragma unroll
    for (int ds = 0; ds < 4; ++ds) qf[ds] = *(const bf16x8*)(Q16A + tok * 512 + hh * 64 + ds * 16 + hi * 8);
    for (int i = tid; i < 64 * IMP_PITCH; i += 512) imp[i] = 0.f;
    f32x16 acc[2], o[2];
#pragma unroll
    for (int r = 0; r < 16; ++r) { acc[0][r] = 0.f; acc[1][r] = 0.f; }
    const int wq_lo = q0 + wave * 8, wq_hi = wq_lo + 7;
    const int nvis_max = (q0 + 63 >= 31) ? ((q0 + 63 - 31) / 16 + 1) : 0;
    if (nvis_max > 0) {
        const int tc_hi = (nvis_max - 1) >> 6;
        const unsigned short* Kc = KC16 + (long)bg * 512 * 64; const unsigned short* Vc = VCT16 + (long)bg * 64 * 512;
        float mref = FA_NEG, l = 0.f;
        NSA_STREAM(Kc, 64, Vc, 512, 0, tc_hi, {
            if (16 * key0 + 31 <= wq_hi) fa_tile<64, 4, true>(st, qf, o, mref, l, key0, qpos, lane, 16 * (key0 + 63) + 31 > wq_lo);
        });
        l = pair_sum(l);
        const float linv = (l > 0.f) ? 1.f / l : 0.f;
#pragma unroll
        for (int r = 0; r < 16; ++r) { o[0][r] = 0.f; o[1][r] = 0.f; }
        NSA_STREAM(Kc, 64, Vc, 512, 0, tc_hi, {
            if (16 * key0 + 31 <= wq_hi) fa_tile_cmp2(st, qf, o, mref, linv, key0, qpos, lane, imp + ql * IMP_PITCH);
        });
        const float g_c = gates[tok * 24 + hh * 3];
#pragma unroll
        for (int r = 0; r < 16; ++r) { acc[0][r] += g_c * o[0][r]; acc[1][r] += g_c * o[1][r]; }
    } else { __syncthreads(); }
    if (wave < 2) {
        const int qi = wave * 32 + r32;
        int his = hi; asm volatile("" : "+v"(his));
#define IMPKEY(jj) ({ const int j_ = (jj); const float v_ = (j_ == 0 || j_ == cur) ? 1e9f : ((j_ > cur) ? -1e30f : imp[qi * IMP_PITCH + j_]); (ordkey(v_) & ~127u) | (127u - (unsigned)j_); })
        unsigned k0[16];
        {
            unsigned k1[16];
#pragma unroll
            for (int i = 0; i < 16; ++i) { k0[i] = IMPKEY(his * 64 + i); k1[i] = IMPKEY(his * 64 + 16 + i); }
            sort16_desc(k0); sort16_desc(k1); merge16_desc(k0, k1);
        }
        __builtin_amdgcn_sched_barrier(0);
        {
            unsigned k2[16], k3[16];
#pragma unroll
            for (int i = 0; i < 16; ++i) { k2[i] = IMPKEY(his * 64 + 32 + i); k3[i] = IMPKEY(his * 64 + 48 + i); }
            sort16_desc(k2); sort16_desc(k3); merge16_desc(k2, k3); merge16_desc(k0, k2);
        }
#undef IMPKEY
        {
            unsigned o2[16];
#pragma unroll
            for (int i = 0; i < 16; ++i) { auto rr = __builtin_amdgcn_permlane32_swap(k0[i], k0[i], false, false); k0[i] = rr[0]; o2[i] = rr[1]; }
            merge16_desc(k0, o2);
        }
        unsigned m0 = 0u, m1 = 0u, m2 = 0u, m3 = 0u;
#pragma unroll
        for (int i = 0; i < 16; ++i) {
            const unsigned j = 127u - (k0[i] & 127u); const unsigned bit = 1u << (j & 31u); const unsigned wsel = j >> 5;
            m0 |= (wsel == 0u) ? bit : 0u; m1 |= (wsel == 1u) ? bit : 0u; m2 |= (wsel == 2u) ? bit : 0u; m3 |= (wsel == 3u) ? bit : 0u;
        }
        if (hi == 0) { selm[qi * 4] = m0; selm[qi * 4 + 1] = m1; selm[qi * 4 + 2] = m2; selm[qi * 4 + 3] = m3; }
    }
    __syncthreads();
    unsigned sm0 = selm[ql * 4], sm1 = selm[ql * 4 + 1], sm2 = selm[ql * 4 + 2], sm3 = selm[ql * 4 + 3];
    {
        float mref = FA_NEG, l = 0.f;
#pragma unroll
        for (int r = 0; r < 16; ++r) { o[0][r] = 0.f; o[1][r] = 0.f; }
        const unsigned short* Ks = KS16 + (long)bg * S_ * 64; const unsigned short* Vs = VST16 + (long)bg * 64 * S_;
        NSA_STREAM(Ks, 64, Vs, S_, 0, cur, {
            const int jw = t_ >> 5; const unsigned wsel = (jw == 0) ? sm0 : ((jw == 1) ? sm1 : ((jw == 2) ? sm2 : sm3));
            const bool colsel = (wsel >> (t_ & 31)) & 1u;
            if (__any(colsel)) fa_tile<64, 3>(st, qf, o, mref, l, key0, qpos, lane, t_ == cur, colsel);
        });
        l = pair_sum(l);
        const float sc = gates[tok * 24 + hh * 3 + 1] / l;
#pragma unroll
        for (int r = 0; r < 16; ++r) { acc[0][r] += sc * o[0][r]; acc[1][r] += sc * o[1][r]; }
    }
    {
        float mref = FA_NEG, l = 0.f;
#pragma unroll
        for (int r = 0; r < 16; ++r) { o[0][r] = 0.f; o[1][r] = 0.f; }
        const unsigned short* Kw = KW16 + (long)bg * S_ * 64; const unsigned short* Vw = VWT16 + (long)bg * 64 * S_;
        const int tw_lo = (cur >= 8) ? cur - 8 : 0;
        NSA_STREAM(Kw, 64, Vw, S_, tw_lo, cur, {
            fa_tile<64, 2>(st, qf, o, mref, l, key0, qpos, lane, (t_ == cur) || (t_ == cur - 8));
        });
        l = pair_sum(l);
        const float sc = gates[tok * 24 + hh * 3 + 2] / l;
#pragma unroll
        for (int r = 0; r < 16; ++r) { acc[0][r] += sc * o[0][r]; acc[1][r] += sc * o[1][r]; }
    }
    float ss = 0.f;
#pragma unroll
    for (int dt = 0; dt < 2; ++dt)
#pragma unroll
        for (int gq = 0; gq < 4; ++gq) {
            const float v0 = acc[dt][4 * gq], v1 = acc[dt][4 * gq + 1], v2 = acc[dt][4 * gq + 2], v3 = acc[dt][4 * gq + 3];
            uint2 pk; pk.x = cvtpk(v0, v1); pk.y = cvtpk(v2, v3);
            *(uint2*)(oa16 + tok * 1024 + hh * 64 + dt * 32 + 8 * gq + 4 * hi) = pk;
            ss += v0 * v0 + v1 * v1 + v2 * v2 + v3 * v3;
        }
    ss = pair_sum(ss);
    if (hi == 0) ssqa[(long)hh * T_ + tok] = ss;
    __syncthreads();
}
__device__ __forceinline__ void nsa_phase(unsigned char* lds, const unsigned short* __restrict__ Q16A, const unsigned short* __restrict__ KC16, const unsigned short* __restrict__ VCT16,
                                          const unsigned short* __restrict__ KS16, const unsigned short* __restrict__ VST16, const unsigned short* __restrict__ KW16, const unsigned short* __restrict__ VWT16,
                                          const float* __restrict__ gates, unsigned short* __restrict__ oa16, float* __restrict__ ssqa) {
    const int tid = tid_();
    for (int i = blockIdx.x; i < 256; i += NBLK) {
        const int xcd = i & 7, slot = i >> 3; const int bg = xcd >> 1, pr = (xcd & 1) * 32 + slot;
        nsa_unit(lds, bg >> 1, bg & 1, 127 - pr, Q16A, KC16, VCT16, KS16, VST16, KW16, VWT16, gates, oa16, ssqa, tid);
        nsa_unit(lds, bg >> 1, bg & 1, pr, Q16A, KC16, VCT16, KS16, VST16, KW16, VWT16, gates, oa16, ssqa, tid);
    }
}
__device__ __forceinline__ int nmap_in2(int n) {
    if (n < 768) return n;
    if (n < 896) return n;
    if (n < 1024) return n - 896 + 1024;
    if (n < 1152) return n - 1024 + 896;
    if (n < 1280) return n;
    if (n < 1304) return n - 1280 + 1696;
    if (n < 1560) return n - 1304 + 1280;
    if (n < 1688) return n - 1560 + 1536;
    return n - 1688 + 1664;
}
struct XT { const float* src; unsigned short* dst; const float* glo; const float* ghi; int K, N, ksplit, tile, nmap; };
__device__ __forceinline__ XT xt_make(const float* src, int K, int N, unsigned short* dst, const float* glo, const float* ghi, int ksplit, int nmap, int tile) {
    XT d; d.src = src; d.dst = dst; d.glo = glo; d.ghi = ghi; d.K = K; d.N = N; d.ksplit = ksplit; d.tile = tile; d.nmap = nmap; return d;
}
__device__ __forceinline__ void xt_load(const XT& d, float (&v)[8], int tid) {
    if (d.tile < 0) return;
    const int tn = (d.N + 63) >> 6; const int k0 = (d.tile / tn) * 64, n0 = (d.tile % tn) * 64;
    const float* __restrict__ s = as_global(d.src);
#pragma unroll
    for (int i = 0; i < 8; ++i) {
        const int kl = (tid >> 6) + 8 * i, n = n0 + (tid & 63), k = k0 + kl;
        float x = (n < d.N) ? s[(long)k * d.N + n] : 0.f;
        if (d.glo) x *= (k < d.ksplit) ? d.glo[k] : d.ghi[k - d.ksplit];
        v[i] = x;
    }
}
__device__ __forceinline__ void xt_store(const XT& d, const float (&v)[8], float* buf, int tid) {
    if (d.tile < 0) return;
    float (*tl)[65] = (float (*)[65])buf;
    const int tn = (d.N + 63) >> 6; const int k0 = (d.tile / tn) * 64, n0 = (d.tile % tn) * 64;
#pragma unroll
    for (int i = 0; i < 8; ++i) tl[(tid >> 6) + 8 * i][tid & 63] = v[i];
    __syncthreads();
    const int nl = tid >> 3, kc = (tid & 7) * 8; const int n = n0 + nl;
    if (n < d.N) {
        uint4 o; o.x = cvtpk(tl[kc][nl], tl[kc + 1][nl]); o.y = cvtpk(tl[kc + 2][nl], tl[kc + 3][nl]); o.z = cvtpk(tl[kc + 4][nl], tl[kc + 5][nl]); o.w = cvtpk(tl[kc + 6][nl], tl[kc + 7][nl]);
        const int nn = d.nmap ? nmap_in2(n) : n;
        *(uint4*)(d.dst + (long)nn * d.K + k0 + kc) = o;
    }
}
#define XT_RUN4(ldsf_, MAKE) do { const int tid_x = tid_(); float xv0[8], xv1[8], xv2[8], xv3[8]; \
    const XT xd0 = MAKE(0), xd1 = MAKE(1), xd2 = MAKE(2), xd3 = MAKE(3); \
    xt_load(xd0, xv0, tid_x); xt_load(xd1, xv1, tid_x); xt_load(xd2, xv2, tid_x); xt_load(xd3, xv3, tid_x); \
    xt_store(xd0, xv0, (ldsf_), tid_x); xt_store(xd1, xv1, (ldsf_) + 64 * 65, tid_x); xt_store(xd2, xv2, (ldsf_), tid_x); xt_store(xd3, xv3, (ldsf_) + 64 * 65, tid_x); __syncthreads(); } while (0)
__device__ __forceinline__ void p0_xn_rope(const float* __restrict__ x, const float* __restrict__ g1, const int* __restrict__ positions, unsigned short* __restrict__ xn16, float* __restrict__ rope) {
    const int tid = tid_(); const int lane = tid & 63, w = __builtin_amdgcn_readfirstlane(tid >> 6);
    const f32x4_t* gp = (const f32x4_t*)g1; const f32x4_t ga0 = gp[lane * 2], ga1 = gp[lane * 2 + 1], gb0 = gp[128 + lane * 2], gb1 = gp[128 + lane * 2 + 1];
    for (int t0 = blockIdx.x * 8 + w; t0 < T_; t0 += 4 * NBLK * 8) {
        f32x4_t v[4][4]; int pos[4];
#pragma unroll
        for (int j = 0; j < 4; ++j) {
            const int t = t0 + j * NBLK * 8;
            const f32x4_t* xp = (const f32x4_t*)(x + (long)t * 1024);
            v[j][0] = xp[lane * 2]; v[j][1] = xp[lane * 2 + 1]; v[j][2] = xp[128 + lane * 2]; v[j][3] = xp[128 + lane * 2 + 1];
            pos[j] = positions[t];
        }
#pragma unroll
        for (int j = 0; j < 4; ++j) {
            const int t = t0 + j * NBLK * 8;
            const f32x4_t a0 = v[j][0], a1 = v[j][1], b0 = v[j][2], b1 = v[j][3];
            float ss = a0.x * a0.x + a0.y * a0.y + a0.z * a0.z + a0.w * a0.w + a1.x * a1.x + a1.y * a1.y + a1.z * a1.z + a1.w * a1.w
                     + b0.x * b0.x + b0.y * b0.y + b0.z * b0.z + b0.w * b0.w + b1.x * b1.x + b1.y * b1.y + b1.z * b1.z + b1.w * b1.w;
            ss = wsum(ss); const float rs = rsqrtf(ss * (1.f / 1024.f) + EPS);
            uint4 pa, pb;
            pa.x = cvtpk(a0.x * rs * ga0.x, a0.y * rs * ga0.y); pa.y = cvtpk(a0.z * rs * ga0.z, a0.w * rs * ga0.w); pa.z = cvtpk(a1.x * rs * ga1.x, a1.y * rs * ga1.y); pa.w = cvtpk(a1.z * rs * ga1.z, a1.w * rs * ga1.w);
            pb.x = cvtpk(b0.x * rs * gb0.x, b0.y * rs * gb0.y); pb.y = cvtpk(b0.z * rs * gb0.z, b0.w * rs * gb0.w); pb.z = cvtpk(b1.x * rs * gb1.x, b1.y * rs * gb1.y); pb.w = cvtpk(b1.z * rs * gb1.z, b1.w * rs * gb1.w);
            ((uint4*)(xn16 + (long)t * 1024))[lane] = pa; ((uint4*)(xn16 + (long)t * 1024))[64 + lane] = pb;
            if (lane < 24) {
                const float f = lane < 8 ? ROPE_F16[lane] : ROPE_F32[lane - 8];
                const float angf = (float)pos[j] * f;
                const double ang = (double)angf; const double k = rint(ang * 0.15915494309189535);
                const float r = (float)(ang - k * 6.283185307179586);
                const float c = cosf(r), sn = sinf(r);
                if (lane < 8) { rope[(long)t * 48 + lane] = c; rope[(long)t * 48 + 8 + lane] = sn; }
                else { rope[(long)t * 48 + 16 + lane - 8] = c; rope[(long)t * 48 + 32 + lane - 8] = sn; }
            }
        }
    }
}
__device__ __forceinline__ void p0_cbias(const float* __restrict__ pos, const float* __restrict__ w1k, const float* __restrict__ w1v, float* __restrict__ cbias) {
    const int tid = tid_(); const int lane = tid & 63, w = __builtin_amdgcn_readfirstlane(tid >> 6);
    for (int task = blockIdx.x * 8 + w; task < 512; task += NBLK * 8) {
        const int mat = task >> 8, n = task & 255; const float* w1 = mat ? w1v : w1k;
        float acc = 0.f;
#pragma unroll 8
        for (int i = 0; i < 32; ++i) { const int k = lane + 64 * i; acc += pos[k] * w1[(long)k * 256 + n]; }
        acc = wsum(acc);
        if (lane == 0) cbias[task] = acc;
    }
}
__device__ __forceinline__ void zero_stream(unsigned short* __restrict__ p, long n) {
    const int tid = tid_();
    for (long c = (long)blockIdx.x * 512 + tid; c < (n >> 3); c += (long)NBLK * 512) ((uint4*)p)[c] = make_uint4(0u, 0u, 0u, 0u);
}

struct P1Out {
    unsigned short *q16a, *ks16, *kw16, *vst16, *vwt16, *kcmp16, *vcmp16, *cq16, *ckv16;
    float *krr, *ssq_kr, *ssq_cq, *ssq_ckv, *gates;
    const float *rope, *q_gain, *ks_gain, *kw_gain, *k_gain;
};
__device__ __forceinline__ void norm_rope64(f32x16& a0, f32x16& a1, const float* __restrict__ gain, const float* __restrict__ rope_t, int hi, float outscale) {
    float ss = 0.f;
#pragma unroll
    for (int r = 0; r < 16; ++r) ss += a0[r] * a0[r] + a1[r] * a1[r];
    ss = pair_sum(ss);
    const float rs = rsqrtf(ss * (1.f / 64.f) + EPS);
#pragma unroll
    for (int g = 0; g < 4; ++g) {
        const float4 g0 = *(const float4*)(gain + 8 * g + 4 * hi), g1 = *(const float4*)(gain + 32 + 8 * g + 4 * hi);
        a0[4 * g] *= rs * g0.x; a0[4 * g + 1] *= rs * g0.y; a0[4 * g + 2] *= rs * g0.z; a0[4 * g + 3] *= rs * g0.w;
        a1[4 * g] *= rs * g1.x; a1[4 * g + 1] *= rs * g1.y; a1[4 * g + 2] *= rs * g1.z; a1[4 * g + 3] *= rs * g1.w;
    }
    const float4 c4 = *(const float4*)(rope_t + 4 * hi), s4 = *(const float4*)(rope_t + 8 + 4 * hi);
    const float cc[4] = {c4.x, c4.y, c4.z, c4.w}, sn[4] = {s4.x, s4.y, s4.z, s4.w};
#pragma unroll
    for (int j = 0; j < 4; ++j) { const float x1 = a0[j], x2 = a0[4 + j]; a0[j] = x1 * cc[j] - x2 * sn[j]; a0[4 + j] = x2 * cc[j] + x1 * sn[j]; }
#pragma unroll
    for (int r = 0; r < 16; ++r) { a0[r] *= outscale; a1[r] *= outscale; }
}
__device__ __forceinline__ void store_row64(unsigned short* __restrict__ dst, const f32x16& a0, const f32x16& a1, int hi) {
#pragma unroll
    for (int g = 0; g < 4; ++g) {
        uint2 p0, p1; p0.x = cvtpk(a0[4 * g], a0[4 * g + 1]); p0.y = cvtpk(a0[4 * g + 2], a0[4 * g + 3]); p1.x = cvtpk(a1[4 * g], a1[4 * g + 1]); p1.y = cvtpk(a1[4 * g + 2], a1[4 * g + 3]);
        *(uint2*)(dst + 8 * g + 4 * hi) = p0; *(uint2*)(dst + 32 + 8 * g + 4 * hi) = p1;
    }
}
__device__ __forceinline__ float ssq64(const f32x16& a0, const f32x16& a1) {
    float ss = 0.f;
#pragma unroll
    for (int r = 0; r < 16; ++r) ss += a0[r] * a0[r] + a1[r] * a1[r];
    return pair_sum(ss);
}
__device__ __forceinline__ float sum4fq(float v) {
    auto r1 = __builtin_amdgcn_permlane16_swap(__float_as_uint(v), __float_as_uint(v), false, false);
    return pair_sum(__uint_as_float(r1[0]) + __uint_as_float(r1[1]));
}
#define P1V(m, j) acc[ai][bj][m][n][j]
__device__ __forceinline__ void p1_inproj_256(unsigned char* lds, const unsigned short* __restrict__ xn16, const unsigned short* __restrict__ wt_in, const P1Out& Oin) {
    const P1Out O = Oin;
    const int tbase = (blockIdx.x & 7) * 56;
    for (int tile = tbase + (blockIdx.x >> 3); tile < tbase + 56; tile += 32) {
        const int mt = tile / 7, nt = tile % 7; const int m0 = mt * 256;
        f32x4_t acc[2][2][4][2];
#pragma unroll
        for (int ai = 0; ai < 2; ++ai)
#pragma unroll
            for (int bj = 0; bj < 2; ++bj)
#pragma unroll
                for (int m = 0; m < 4; ++m)
#pragma unroll
                    for (int n = 0; n < 2; ++n) acc[ai][bj][m][n] = f32x4_t{0.f, 0.f, 0.f, 0.f};
        if (nt == 4) g256::mainloop<1024>(xn16, wt_in, m0, nt * 256, (unsigned short*)lds, acc);
        else g256::mainloop<1024>(wt_in, xn16, nt * 256, m0, (unsigned short*)lds, acc);
        const int tid = tid_(); const int lane = tid & 63, wave = __builtin_amdgcn_readfirstlane(tid >> 6), wr = wave >> 2, wc = wave & 3, fr = lane & 15, fq = lane >> 4;
        if (nt == 4) {
#pragma unroll
            for (int bj = 0; bj < 2; ++bj)
#pragma unroll
                for (int n = 0; n < 2; ++n) {
                    const int pc = bj * 2 + (wc >> 1), d = (wc & 1) * 32 + n * 16 + fr;
                    unsigned short* vt = (pc < 2) ? O.vst16 : O.vwt16; const int g = pc & 1;
#pragma unroll
                    for (int ai = 0; ai < 2; ++ai)
#pragma unroll
                        for (int m = 0; m < 4; ++m) {
                            const int tb = m0 + ai * 128 + wr * 64 + m * 16 + fq * 4; const int b = tb / S_, s0 = tb % S_;
                            uint2 pk; pk.x = cvtpk(P1V(m, 0), P1V(m, 1)); pk.y = cvtpk(P1V(m, 2), P1V(m, 3));
                            *(uint2*)(vt + ((long)(b * 2 + g) * 64 + d) * S_ + vperm(s0)) = pk;
                        }
                }
        } else {
#pragma unroll
            for (int ai = 0; ai < 2; ++ai) {
                const int pc = ai * 2 + wr;
#pragma unroll
                for (int bj = 0; bj < 2; ++bj)
#pragma unroll
                    for (int n = 0; n < 2; ++n) {
                        const long tok = m0 + bj * 128 + wc * 32 + n * 16 + fr; const int b = (int)(tok / S_), s = (int)(tok % S_);
                        const float* rope_t = O.rope + tok * 48;
                        const bool is_q = nt < 2, is_k = nt == 3;
                        if (is_q || is_k) {
                            const float* gain = is_q ? O.q_gain : ((pc < 2) ? O.ks_gain : O.kw_gain);
                            float ss = 0.f;
#pragma unroll
                            for (int m = 0; m < 4; ++m)
#pragma unroll
                                for (int j = 0; j < 4; ++j) ss += P1V(m, j) * P1V(m, j);
                            const float rs = rsqrtf(sum4fq(ss) * (1.f / 64.f) + EPS) ;
#pragma unroll
                            for (int m = 0; m < 4; ++m) { const float4 gv = *(const float4*)(gain + m * 16 + fq * 4);
                                P1V(m, 0) *= rs * gv.x; P1V(m, 1) *= rs * gv.y; P1V(m, 2) *= rs * gv.z; P1V(m, 3) *= rs * gv.w; }
                            { const float4 c4 = *(const float4*)(rope_t + (fq & 1) * 4), s4 = *(const float4*)(rope_t + 8 + (fq & 1) * 4);
                              const float cc[4] = {c4.x, c4.y, c4.z, c4.w}, sn[4] = {s4.x, s4.y, s4.z, s4.w};
#pragma unroll
                              for (int j = 0; j < 4; ++j) {
                                  auto rr = __builtin_amdgcn_permlane32_swap(__float_as_uint(P1V(0, j)), __float_as_uint(P1V(0, j)), false, false);
                                  const float x1 = __uint_as_float(rr[0]), x2 = __uint_as_float(rr[1]);
                                  P1V(0, j) = (fq < 2) ? (x1 * cc[j] - x2 * sn[j]) : (x2 * cc[j] + x1 * sn[j]);
                              } }
                            const float osc = is_q ? NSA_QSCALE : 1.f;
                            unsigned short* dst = is_q ? (O.q16a + tok * 512 + (nt * 4 + pc) * 64) : ((pc < 2 ? O.ks16 : O.kw16) + ((long)(b * 2 + (pc & 1)) * S_ + s) * 64);
#pragma unroll
                            for (int m = 0; m < 4; ++m) { uint2 pk; pk.x = cvtpk(P1V(m, 0) * osc, P1V(m, 1) * osc); pk.y = cvtpk(P1V(m, 2) * osc, P1V(m, 3) * osc); *(uint2*)(dst + m * 16 + fq * 4) = pk; }
                        } else if (nt == 2 || nt == 5 || (nt == 6 && pc < 2)) {
                            unsigned short* dst;
                            if (nt == 2) dst = (pc < 2 ? O.kcmp16 : O.vcmp16) + ((long)(b * 2 + (pc & 1)) * S_ + s) * 64;
                            else if (nt == 5) dst = O.cq16 + tok * 256 + pc * 64;
                            else dst = O.ckv16 + tok * 128 + pc * 64;
                            float ss = 0.f;
#pragma unroll
                            for (int m = 0; m < 4; ++m) { uint2 pk; pk.x = cvtpk(P1V(m, 0), P1V(m, 1)); pk.y = cvtpk(P1V(m, 2), P1V(m, 3)); *(uint2*)(dst + m * 16 + fq * 4) = pk;
#pragma unroll
                                for (int j = 0; j < 4; ++j) ss += P1V(m, j) * P1V(m, j); }
                            if (nt != 2) { ss = sum4fq(ss); if (fq == 0) { if (nt == 5) O.ssq_cq[(long)pc * T_ + tok] = ss; else O.ssq_ckv[(long)pc * T_ + tok] = ss; } }
                        } else if (nt == 6 && pc == 2) {
                            float ss = 0.f;
#pragma unroll
                            for (int m = 0; m < 2; ++m)
#pragma unroll
                                for (int j = 0; j < 4; ++j) ss += P1V(m, j) * P1V(m, j);
                            ss = sum4fq(ss);
                            if (fq == 0) O.ssq_kr[tok] = ss;
                            {
                                const float4 g0 = *(const float4*)(O.k_gain + 64 + fq * 4), g1 = *(const float4*)(O.k_gain + 80 + fq * 4);
                                const float4 c4 = *(const float4*)(rope_t + 16 + fq * 4), s4 = *(const float4*)(rope_t + 32 + fq * 4);
                                const float ga[4] = {g0.x, g0.y, g0.z, g0.w}, gb[4] = {g1.x, g1.y, g1.z, g1.w}, cc[4] = {c4.x, c4.y, c4.z, c4.w}, sn[4] = {s4.x, s4.y, s4.z, s4.w};
                                float o1[4], o2[4];
#pragma unroll
                                for (int j = 0; j < 4; ++j) { const float x1 = P1V(0, j) * ga[j], x2 = P1V(1, j) * gb[j]; o1[j] = x1 * cc[j] - x2 * sn[j]; o2[j] = x2 * cc[j] + x1 * sn[j]; }
                                *(float4*)(O.krr + tok * 32 + fq * 4) = make_float4(o1[0], o1[1], o1[2], o1[3]);
                                *(float4*)(O.krr + tok * 32 + 16 + fq * 4) = make_float4(o2[0], o2[1], o2[2], o2[3]);
                            }
                            *(float4*)(O.gates + tok * 24 + fq * 4) = make_float4(1.f / (1.f + __expf(-P1V(2, 0))), 1.f / (1.f + __expf(-P1V(2, 1))), 1.f / (1.f + __expf(-P1V(2, 2))), 1.f / (1.f + __expf(-P1V(2, 3))));
                            if (fq < 2) *(float4*)(O.gates + tok * 24 + 16 + fq * 4) = make_float4(1.f / (1.f + __expf(-P1V(3, 0))), 1.f / (1.f + __expf(-P1V(3, 1))), 1.f / (1.f + __expf(-P1V(3, 2))), 1.f / (1.f + __expf(-P1V(3, 3))));
                        }
                    }
            }
        }
        __syncthreads();
    }
}
#undef P1V

typedef GemmShape<2, 4, 2, 2> ShBig;
typedef GemmShape<4, 2, 1, 3> ShQb;
typedef GemmShape<4, 2, 1, 4> ShKvb;
struct P2Args {
    const unsigned short *cq16, *ckv16, *wt_uq, *wt_ukv, *kcmp16, *vcmp16, *w1t_k, *w1t_v;
    const float *ssq_cq, *ssq_ckv, *ssq_kr, *krr, *rope, *q_gain, *k_gain;
    unsigned short *q16, *k16, *vt16; float* hid;
};
__device__ __forceinline__ void p2_phase(unsigned char* lds, const P2Args& A) {
    const int tid = tid_(); const int lane = tid & 63, wave = __builtin_amdgcn_readfirstlane(tid >> 6), r32 = lane & 31, hi = lane >> 5;
    const int nmine = (blockIdx.x < 128) ? 4 : 5;
    for (int it = 0; it < nmine; ++it) {
        int u;
        if (blockIdx.x < 128) { if (it == 0) u = blockIdx.x; else { const int s = blockIdx.x * 3 + (it - 1); u = (s & 1) ? 640 + (s >> 1) : 128 + (s >> 1); } }
        else { const int s = 384 + (blockIdx.x - 128) * 5 + it; u = (s & 1) ? 640 + (s >> 1) : 128 + (s >> 1); }
        if (u < 128) {
            const int mat = u >> 6, mtile = (u >> 2) & 15, ks = u & 3; const int wm = wave >> 2, wn = wave & 3;
            f32x16 acc[2][2];
#pragma unroll
            for (int mi = 0; mi < 2; ++mi)
#pragma unroll
                for (int ni = 0; ni < 2; ++ni)
#pragma unroll
                    for (int r = 0; r < 16; ++r) acc[mi][ni][r] = 0.f;
            gemm_mainloop<ShBig, 3u>((mat ? A.vcmp16 : A.kcmp16) + (long)mtile * 128 * 1024 + ks * 512, 1024, (mat ? A.w1t_v : A.w1t_k) + ks * 512, 2048, 512, lds, acc, tid);
            float* slab = A.hid + (long)(mat * 4 + ks) * 2048 * 256;
#pragma unroll
            for (int mi = 0; mi < 2; ++mi) {
                const long row = mtile * 128 + wm * 64 + mi * 32 + r32;
#pragma unroll
                for (int ni = 0; ni < 2; ++ni)
#pragma unroll
                    for (int g = 0; g < 4; ++g)
                        *(float4*)(slab + row * 256 + wn * 64 + ni * 32 + 8 * g + 4 * hi) = make_float4(acc[mi][ni][4 * g], acc[mi][ni][4 * g + 1], acc[mi][ni][4 * g + 2], acc[mi][ni][4 * g + 3]);
            }
        } else if (u < 128 + 512) {
            const int v = u - 128; const int mt = v >> 2, nt = v & 3; const int m0 = mt * 128; const int wm = wave >> 1, wn = wave & 1; const int head = nt * 2 + wn;
            f32x16 acc[1][4];
#pragma unroll
            for (int ni = 0; ni < 4; ++ni)
#pragma unroll
                for (int r = 0; r < 16; ++r) acc[0][ni][r] = 0.f;
            const long tok = m0 + wm * 32 + r32;
            const float e_c0 = A.ssq_ckv[tok], e_c1 = A.ssq_ckv[(long)T_ + tok], e_kr = A.ssq_kr[tok];
            f32x4_t e_k[4];
#pragma unroll
            for (int i = 0; i < 4; ++i) e_k[i] = ((const f32x4_t*)(A.krr + tok * 32 + hi * 16))[i];
            gemm_mainloop<ShKvb, 3u>(A.ckv16 + (long)m0 * 128, 128, A.wt_ukv + (long)nt * 256 * 128, 128, 128, lds, acc, tid);
            {
                const int b = (int)(tok / S_), s = (int)(tok % S_);
                const float rc = rsqrtf((e_c0 + e_c1) * (1.f / 128.f) + EPS);
                float ss = 0.f;
#pragma unroll
                for (int r = 0; r < 16; ++r) { acc[0][0][r] *= rc; acc[0][1][r] *= rc; ss += acc[0][0][r] * acc[0][0][r] + acc[0][1][r] * acc[0][1][r]; }
                ss = pair_sum(ss) + e_kr;
                const float rk = rsqrtf(ss * (1.f / 96.f) + EPS);
#pragma unroll
                for (int g = 0; g < 4; ++g) {
                    const float4 g0 = *(const float4*)(A.k_gain + 8 * g + 4 * hi), g1 = *(const float4*)(A.k_gain + 32 + 8 * g + 4 * hi);
                    acc[0][0][4 * g] *= rk * g0.x; acc[0][0][4 * g + 1] *= rk * g0.y; acc[0][0][4 * g + 2] *= rk * g0.z; acc[0][0][4 * g + 3] *= rk * g0.w;
                    acc[0][1][4 * g] *= rk * g1.x; acc[0][1][4 * g + 1] *= rk * g1.y; acc[0][1][4 * g + 2] *= rk * g1.z; acc[0][1][4 * g + 3] *= rk * g1.w;
                }
                unsigned short* krow = A.k16 + ((long)(b * 8 + head) * S_ + s) * 96;
                store_row64(krow, acc[0][0], acc[0][1], hi);
                const f32x4_t k0 = e_k[0], k1 = e_k[1], k2 = e_k[2], k3 = e_k[3];
                uint4 o0, o1; o0.x = cvtpk(k0.x * rk, k0.y * rk); o0.y = cvtpk(k0.z * rk, k0.w * rk); o0.z = cvtpk(k1.x * rk, k1.y * rk); o0.w = cvtpk(k1.z * rk, k1.w * rk);
                o1.x = cvtpk(k2.x * rk, k2.y * rk); o1.y = cvtpk(k2.z * rk, k2.w * rk); o1.z = cvtpk(k3.x * rk, k3.y * rk); o1.w = cvtpk(k3.z * rk, k3.w * rk);
                *(uint4*)(krow + 64 + hi * 16) = o0; *(uint4*)(krow + 64 + hi * 16 + 8) = o1;
            }
            {
#pragma unroll
                for (int ni = 2; ni < 4; ++ni)
#pragma unroll
                    for (int g4 = 0; g4 < 4; ++g4) {
                        const int tb = m0 + wm * 32 + 8 * g4 + 4 * hi; const int b = tb / S_, s0 = tb % S_; const int d = (ni - 2) * 32 + r32;
                        const f32x4_t sa = *(const f32x4_t*)(A.ssq_ckv + tb), sb = *(const f32x4_t*)(A.ssq_ckv + (long)T_ + tb);
                        const float r0 = rsqrtf((sa.x + sb.x) * (1.f / 128.f) + EPS), r1 = rsqrtf((sa.y + sb.y) * (1.f / 128.f) + EPS), r2 = rsqrtf((sa.z + sb.z) * (1.f / 128.f) + EPS), r3 = rsqrtf((sa.w + sb.w) * (1.f / 128.f) + EPS);
                        uint2 pk; pk.x = cvtpk(acc[0][ni][4 * g4] * r0, acc[0][ni][4 * g4 + 1] * r1); pk.y = cvtpk(acc[0][ni][4 * g4 + 2] * r2, acc[0][ni][4 * g4 + 3] * r3);
                        *(uint2*)(A.vt16 + ((long)(b * 8 + head) * 64 + d) * S_ + vperm(s0)) = pk;
                    }
            }
        } else {
            const int v = u - 640; const int mt = v >> 2, nt = v & 3; const int m0 = mt * 128; const int wm = wave >> 1, wn = wave & 1; const int head = nt * 2 + wn;
            f32x16 acc[1][3];
#pragma unroll
            for (int ni = 0; ni < 3; ++ni)
#pragma unroll
                for (int r = 0; r < 16; ++r) acc[0][ni][r] = 0.f;
            const long tok = m0 + wm * 32 + r32;
            const float e_q0 = A.ssq_cq[tok], e_q1 = A.ssq_cq[(long)T_ + tok], e_q2 = A.ssq_cq[2L * T_ + tok], e_q3 = A.ssq_cq[3L * T_ + tok];
            const float* rope_t = A.rope + tok * 48;
            f32x4_t e_c[2], e_s[2];
#pragma unroll
            for (int g = 0; g < 2; ++g) { e_c[g] = *(const f32x4_t*)(rope_t + 16 + 8 * g + 4 * hi); e_s[g] = *(const f32x4_t*)(rope_t + 32 + 8 * g + 4 * hi); }
            gemm_mainloop<ShQb, 7u>(A.cq16 + (long)m0 * 256, 256, A.wt_uq + (long)nt * 192 * 256, 256, 256, lds, acc, tid);
            const float rc = rsqrtf((e_q0 + e_q1 + e_q2 + e_q3) * (1.f / 256.f) + EPS);
            float ss = 0.f;
#pragma unroll
            for (int ni = 0; ni < 3; ++ni)
#pragma unroll
                for (int r = 0; r < 16; ++r) { acc[0][ni][r] *= rc; ss += acc[0][ni][r] * acc[0][ni][r]; }
            ss = pair_sum(ss);
            const float rq = rsqrtf(ss * (1.f / 96.f) + EPS);
#pragma unroll
            for (int ni = 0; ni < 3; ++ni)
#pragma unroll
                for (int g = 0; g < 4; ++g) {
                    const float4 gg = *(const float4*)(A.q_gain + ni * 32 + 8 * g + 4 * hi);
                    acc[0][ni][4 * g] *= rq * gg.x; acc[0][ni][4 * g + 1] *= rq * gg.y; acc[0][ni][4 * g + 2] *= rq * gg.z; acc[0][ni][4 * g + 3] *= rq * gg.w;
                }
#pragma unroll
            for (int g = 0; g < 2; ++g) {
                const f32x4_t c4 = e_c[g], s4 = e_s[g];
                const float cc[4] = {c4.x, c4.y, c4.z, c4.w}, sn[4] = {s4.x, s4.y, s4.z, s4.w};
#pragma unroll
                for (int j = 0; j < 4; ++j) { const float x1 = acc[0][2][4 * g + j], x2 = acc[0][2][8 + 4 * g + j]; acc[0][2][4 * g + j] = x1 * cc[j] - x2 * sn[j]; acc[0][2][8 + 4 * g + j] = x2 * cc[j] + x1 * sn[j]; }
            }
            unsigned short* qrow = A.q16 + tok * 768 + head * 96;
#pragma unroll
            for (int ni = 0; ni < 3; ++ni)
#pragma unroll
                for (int g = 0; g < 4; ++g) {
                    uint2 pk; pk.x = cvtpk(acc[0][ni][4 * g] * MLA_QSCALE, acc[0][ni][4 * g + 1] * MLA_QSCALE); pk.y = cvtpk(acc[0][ni][4 * g + 2] * MLA_QSCALE, acc[0][ni][4 * g + 3] * MLA_QSCALE);
                    *(uint2*)(qrow + ni * 32 + 8 * g + 4 * hi) = pk;
                }
        }
    }
}
__device__ __forceinline__ void p3_cmp2(unsigned char* lds, const float* __restrict__ hid, const float* __restrict__ cbias, const unsigned short* __restrict__ w2t_k, const unsigned short* __restrict__ w2t_v,
                                        const float* __restrict__ kc_gain, const float* __restrict__ rope, unsigned short* __restrict__ kc16, unsigned short* __restrict__ vct16) {
    if (blockIdx.x >= 128) return;
    const int tid = tid_(); const int lane = tid & 63, w = __builtin_amdgcn_readfirstlane(tid >> 6), r32 = lane & 31, hi = lane >> 5;
    const int task = blockIdx.x; const int mat = task >> 6, rt = task & 63; const long row = rt * 32 + r32;
    const unsigned short* w2t = mat ? w2t_v : w2t_k;
    f32x16 acc[2];
#pragma unroll
    for (int r = 0; r < 16; ++r) { acc[0][r] = 0.f; acc[1][r] = 0.f; }
    f32x4_t hv[2][10]; bf16x8 wf[2][2];
#pragma unroll
    for (int s = 0; s < 2; ++s) {
        const int k0 = (w * 2 + s) * 16 + hi * 8;
        hv[s][0] = *(const f32x4_t*)(cbias + mat * 256 + k0); hv[s][1] = *(const f32x4_t*)(cbias + mat * 256 + k0 + 4);
#pragma unroll
        for (int sp = 0; sp < 4; ++sp) {
            const float* hp = hid + ((long)(mat * 4 + sp) * 2048 + row) * 256 + k0;
            hv[s][2 + 2 * sp] = *(const f32x4_t*)hp; hv[s][3 + 2 * sp] = *(const f32x4_t*)(hp + 4);
        }
        wf[s][0] = *(const bf16x8*)(w2t + (long)r32 * 256 + k0); wf[s][1] = *(const bf16x8*)(w2t + (long)(32 + r32) * 256 + k0);
    }
#pragma unroll
    for (int s = 0; s < 2; ++s) {
        f32x4_t lo = hv[s][0], up = hv[s][1];
#pragma unroll
        for (int sp = 0; sp < 4; ++sp) { lo += hv[s][2 + 2 * sp]; up += hv[s][3 + 2 * sp]; }
        uint4 pk; pk.x = cvtpk(gelu_tanh(lo.x), gelu_tanh(lo.y)); pk.y = cvtpk(gelu_tanh(lo.z), gelu_tanh(lo.w)); pk.z = cvtpk(gelu_tanh(up.x), gelu_tanh(up.y)); pk.w = cvtpk(gelu_tanh(up.z), gelu_tanh(up.w));
        const bf16x8 hf = __builtin_bit_cast(bf16x8, pk);
        acc[0] = MFMA32(wf[s][0], hf, acc[0]); acc[1] = MFMA32(wf[s][1], hf, acc[1]);
    }
    f32x4_t* red = (f32x4_t*)lds;
#pragma unroll
    for (int q = 0; q < 8; ++q) red[(w * 8 + q) * 64 + lane] = f32x4_t{acc[q >> 2][4 * (q & 3)], acc[q >> 2][4 * (q & 3) + 1], acc[q >> 2][4 * (q & 3) + 2], acc[q >> 2][4 * (q & 3) + 3]};
    __syncthreads();
    if (w != 0) return;
#pragma unroll
    for (int q = 0; q < 8; ++q) {
        f32x4_t s = red[q * 64 + lane];
#pragma unroll
        for (int ww = 1; ww < 8; ++ww) s += red[(ww * 8 + q) * 64 + lane];
        acc[q >> 2][4 * (q & 3)] = s.x; acc[q >> 2][4 * (q & 3) + 1] = s.y; acc[q >> 2][4 * (q & 3) + 2] = s.z; acc[q >> 2][4 * (q & 3) + 3] = s.w;
    }
    const int bg = (int)(row >> 9), n = (int)(row & 511); const bool valid = n < NCMP;
    if (mat == 0) {
        if (valid) {
            const long tokp = (long)(bg >> 1) * S_ + 16 * n + 31;
            norm_rope64(acc[0], acc[1], kc_gain, rope + tokp * 48, hi, 1.f);
        } else {
#pragma unroll
            for (int r = 0; r < 16; ++r) { acc[0][r] = 0.f; acc[1][r] = 0.f; }
        }
        store_row64(kc16 + row * 64, acc[0], acc[1], hi);
    } else {
#pragma unroll
        for (int ni = 0; ni < 2; ++ni)
#pragma unroll
            for (int r = 0; r < 16; ++r) {
                const float v = valid ? acc[ni][r] : 0.f;
                const float other = __uint_as_float(__builtin_amdgcn_mov_dpp(__float_as_uint(v), 0xB1, 0xF, 0xF, true));
                if ((lane & 1) == 0) *(unsigned*)(vct16 + ((long)bg * 64 + ni * 32 + crow(r, hi)) * 512 + vperm(n)) = cvtpk(v, other);
            }
    }
}

__device__ __forceinline__ void cvt_stream(const float* __restrict__ in, unsigned short* __restrict__ out, long n, int vb = blockIdx.x, int nb = NBLK) {
    const long nchunk = n >> 3;
    const int tid = tid_();
    for (long c = (long)vb * 512 + tid; c < nchunk; c += (long)nb * 512) {
        const float4 a = ((const float4*)in)[2 * c], b = ((const float4*)in)[2 * c + 1];
        uint4 o; o.x = cvtpk(a.x, a.y); o.y = cvtpk(a.z, a.w); o.z = cvtpk(b.x, b.y); o.w = cvtpk(b.z, b.w);
        ((uint4*)out)[c] = o;
    }
}


typedef unsigned u32x3 __attribute__((ext_vector_type(3)));
typedef unsigned u32x6 __attribute__((ext_vector_type(6)));
typedef float f32x32 __attribute__((ext_vector_type(32)));
constexpr int PROW = 768;
constexpr int PU_SPLIT = 12288;
template <int NR>
__device__ __forceinline__ void cvt_rows_fp6(const float* __restrict__ in, unsigned char* __restrict__ out6, float* __restrict__ scale, int rows, int vb = blockIdx.x, int nb = NBLK) {
    const int tid = tid_(); const int lane = tid & 63, w = __builtin_amdgcn_readfirstlane(tid >> 6);
    const int stride = nb * 8;
    for (int r0 = vb * 8 + w; r0 < rows; r0 += NR * stride) {
        f32x4_t v[NR][4];
#pragma unroll
        for (int j = 0; j < NR; ++j) {
            const int r = min(r0 + j * stride, rows - 1);
            const f32x4_t* p = (const f32x4_t*)(in + (long)r * 1024 + lane * 16);
#pragma unroll
            for (int i = 0; i < 4; ++i) v[j][i] = p[i];
        }
#pragma unroll
        for (int j = 0; j < NR; ++j) {
            const int r = r0 + j * stride;
            if (r < rows) {
                float m = 0.f;
#pragma unroll
                for (int i = 0; i < 4; ++i) m = fmaxf(m, fmaxf(fmaxf(fabsf(v[j][i].x), fabsf(v[j][i].y)), fmaxf(fabsf(v[j][i].z), fabsf(v[j][i].w))));
                m = wmax(m);
                const float q = (m > 0.f) ? 7.5f / m : 1.f;
                const f32x16 ve = {v[j][0].x * q, v[j][0].z * q, v[j][1].x * q, v[j][1].z * q, v[j][2].x * q, v[j][2].z * q, v[j][3].x * q, v[j][3].z * q, 0.f, 0.f, 0.f, 0.f, 0.f, 0.f, 0.f, 0.f};
                const f32x16 vo = {v[j][0].y * q, v[j][0].w * q, v[j][1].y * q, v[j][1].w * q, v[j][2].y * q, v[j][2].w * q, v[j][3].y * q, v[j][3].w * q, 0.f, 0.f, 0.f, 0.f, 0.f, 0.f, 0.f, 0.f};
                const u32x6 pk = __builtin_amdgcn_cvt_scalef32_2xpk16_fp6_f32(ve, vo, 1.0f);
                *(u32x3*)(out6 + (long)r * PROW + lane * 12) = u32x3{pk[0], pk[1], pk[2]};
                if (lane == 0) scale[r] = (m > 0.f) ? m * (1.f / 7.5f) : 1.f;
            }
        }
    }
}
__device__ __forceinline__ f32x32 dec2_fp6(const u32x3& r0, const u32x3& r1) {
    const u32x6 pk = {r0.x, r0.y, r0.z, r1.x, r1.y, r1.z};
    return __builtin_amdgcn_cvt_scalef32_pk32_f32_fp6(pk, 1.0f);
}
__device__ __forceinline__ void peer_sweep_a(const float* __restrict__ hss, const float* __restrict__ g2, const int* __restrict__ eo, const float* __restrict__ go,
                                             const unsigned char* __restrict__ U6, const float* __restrict__ su, const float* __restrict__ sv, const float* __restrict__ h, float* __restrict__ wout) {
    const int tid = tid_(); const int lane = tid & 63, w = __builtin_amdgcn_readfirstlane(tid >> 6);
    const int kcls = ((lane >> 5) & 1) * 4 + ((lane >> 4) & 1) * 2 + ((lane >> 3) & 1);
    for (int t = blockIdx.x * 8 + w; t < T_; t += NBLK * 8) {
        float x[16];
        {
            const float4* xp = (const float4*)(h + (long)t * 1024 + lane * 16); const float4* gp = (const float4*)(g2 + lane * 16); const float4* hp = (const float4*)(hss + (long)t * 16);
            const float4 s0 = hp[0], s1 = hp[1], s2 = hp[2], s3 = hp[3];
            const float rs = rsqrtf((s0.x + s0.y + s0.z + s0.w + s1.x + s1.y + s1.z + s1.w + s2.x + s2.y + s2.z + s2.w + s3.x + s3.y + s3.z + s3.w) * (1.f / 1024.f) + EPS);
#pragma unroll
            for (int k = 0; k < 4; ++k) { const float4 hv = xp[k], gv = gp[k]; x[4 * k] = hv.x * rs * gv.x; x[4 * k + 1] = hv.y * rs * gv.y; x[4 * k + 2] = hv.z * rs * gv.z; x[4 * k + 3] = hv.w * rs * gv.w; }
        }
        const int elo = eo[(long)t * 128 + lane], ehi = eo[(long)t * 128 + 64 + lane];
        const float glo = go[(long)t * 128 + lane], ghi = go[(long)t * 128 + 64 + lane];
        for (int bt = 0; bt < 16; ++bt) {
            int e[8];
#pragma unroll
            for (int k = 0; k < 8; ++k) e[k] = __builtin_amdgcn_readlane(bt < 8 ? elo : ehi, (bt * 8 + k) & 63);
            u32x3 u[8];
#pragma unroll
            for (int k = 0; k < 8; ++k) u[k] = *(const u32x3*)(U6 + (long)e[k] * PROW + lane * 12);
            const int emine = __shfl(bt < 8 ? elo : ehi, (bt * 8 + kcls) & 63);
            const float sum = su[emine], svm = sv[emine];
            const float gk = __shfl(bt < 8 ? glo : ghi, (bt * 8 + kcls) & 63);
            float a[8];
#pragma unroll
            for (int k = 0; k < 8; k += 2) {
                const f32x32 d = dec2_fp6(u[k], u[k + 1]);
                float s0 = 0.f, s1 = 0.f;
#pragma unroll
                for (int i = 0; i < 16; ++i) { s0 = fmaf(d[i], x[i], s0); s1 = fmaf(d[16 + i], x[i], s1); }
                a[k] = s0; a[k + 1] = s1;
            }
            float b4[4], c2[2], d1;
#pragma unroll
            for (int i = 0; i < 4; ++i) {
                auto rr = __builtin_amdgcn_permlane32_swap(__float_as_uint(a[i]), __float_as_uint(a[i + 4]), false, false);
                b4[i] = __uint_as_float(rr[0]) + __uint_as_float(rr[1]);
            }
#pragma unroll
            for (int i = 0; i < 2; ++i) {
                auto rr = __builtin_amdgcn_permlane16_swap(__float_as_uint(b4[i]), __float_as_uint(b4[i + 2]), false, false);
                c2[i] = __uint_as_float(rr[0]) + __uint_as_float(rr[1]);
            }
            { const bool up = (lane & 8) != 0; const float keep = up ? c2[1] : c2[0], send = up ? c2[0] : c2[1];
              d1 = keep + __uint_as_float(__builtin_amdgcn_mov_dpp(__float_as_uint(send), 0x128, 0xF, 0xF, true)); }
            d1 = quad_sum(d1);
            d1 += __uint_as_float(__builtin_amdgcn_mov_dpp(__float_as_uint(d1), 0x141, 0xF, 0xF, true));
            const float wl = gk * gelu_tanh(d1 * sum) * svm;
            if ((lane & 7) == 0) wout[(long)t * 128 + bt * 8 + kcls] = wl;
        }
    }
}
__device__ __forceinline__ void peer_sweep_b(const int* __restrict__ eo, const float* __restrict__ win, const unsigned char* __restrict__ V6, float* out) {
    const int tid = tid_(); const int lane = tid & 63, w = __builtin_amdgcn_readfirstlane(tid >> 6);
    for (int t = blockIdx.x * 8 + w; t < T_; t += NBLK * 8) {
        float y[16];
#pragma unroll
        for (int i = 0; i < 16; ++i) y[i] = 0.f;
        const int elo = eo[(long)t * 128 + lane], ehi = eo[(long)t * 128 + 64 + lane];
        const float wlo = win[(long)t * 128 + lane], whi = win[(long)t * 128 + 64 + lane];
        for (int bt = 0; bt < 16; ++bt) {
            int e[8]; float wk[8];
#pragma unroll
            for (int k = 0; k < 8; ++k) {
                e[k] = __builtin_amdgcn_readlane(bt < 8 ? elo : ehi, (bt * 8 + k) & 63);
                wk[k] = __uint_as_float(__builtin_amdgcn_readlane(__float_as_uint(bt < 8 ? wlo : whi), (bt * 8 + k) & 63));
            }
            u32x3 v[8];
#pragma unroll
            for (int k = 0; k < 8; ++k) v[k] = *(const u32x3*)(V6 + (long)e[k] * PROW + lane * 12);
#pragma unroll
            for (int k = 0; k < 8; k += 2) {
                const f32x32 d = dec2_fp6(v[k], v[k + 1]);
#pragma unroll
                for (int i = 0; i < 16; ++i) y[i] = fmaf(wk[k + 1], d[16 + i], fmaf(wk[k], d[i], y[i]));
            }
        }
        float4* o = (float4*)(out + (long)t * 1024 + lane * 16);
#pragma unroll
        for (int k = 0; k < 4; ++k) { float4 hv = o[k]; hv.x += y[4 * k]; hv.y += y[4 * k + 1]; hv.z += y[4 * k + 2]; hv.w += y[4 * k + 3]; o[k] = hv; }
    }
}

struct Params {
    const float* x; const int* positions; const float* norm1_gain; const float* w_in;
    const float *nsa_q_gain, *nsa_kc_gain, *nsa_ks_gain, *nsa_kw_gain, *cmp_pos, *cmp_k_w1, *cmp_k_w2, *cmp_v_w1, *cmp_v_w2;
    const float *mla_q_lora_gain, *mla_w_uq, *mla_kv_lora_gain, *mla_w_ukv, *mla_q_gain, *mla_k_gain, *out_gain_a, *out_gain_b, *w_out;
    const float *norm2_gain, *peer_w_q, *peer_sub_keys, *peer_u, *peer_v;
    float* out; float* W; unsigned* bar;
};
constexpr int LDS_BYTES = 64 + 131072;
static_assert(LDS_BYTES >= 8 * 3200 * 4 + 64, "naive NSA phase needs 102,464 B");

typedef __attribute__((address_space(4))) const Params* cparams_t;
__device__ __forceinline__ cparams_t params_ptr() {
    cparams_t pp = (cparams_t)__builtin_amdgcn_kernarg_segment_ptr();
    asm volatile("" : "+s"(pp));
    return pp;
}
constexpr long M1 = 1 << 20;
constexpr long F_U8 = 0, F_V8 = 4 * M1, F_SU = 21 * M1 + 3 * M1 / 8, F_SV = F_SU + 16384,
               F_WTIN = 16 * M1, F_WTUQ = 17 * M1, F_WTUKV = 17 * M1 + M1 / 8, F_W1TK = 17 * M1 + M1 / 4, F_W1TV = 17 * M1 + M1 / 2, F_W2TK = 17 * M1 + 3 * M1 / 4,
               F_W2TV = F_W2TK + 8192, F_CBIAS = F_W2TV + 8192, F_WTOUT = 18 * M1, F_WTQ = 18 * M1 + M1 / 2, F_SK16 = 19 * M1 + M1 / 2,
               F_SSQCQ = 19 * M1 + 5 * M1 / 8, F_SSQCKV = F_SSQCQ + 4 * 16384, F_SSQKR = F_SSQCKV + 2 * 16384, F_SSQA = 19 * M1 + 3 * M1 / 4, F_SSQB = F_SSQA + 8 * 16384,
               F_ROPE = 20 * M1, F_GATES = 21 * M1, F_KRR = 21 * M1 + M1 / 2,
               F_XN16 = 22 * M1, F_MIX = 22 * M1,
               F_Q16A = 30 * M1, F_KS16 = 34 * M1, F_KW16 = 35 * M1, F_VST16 = 36 * M1, F_VWT16 = 37 * M1, F_KCMP16 = 38 * M1, F_VCMP16 = 39 * M1 + M1 / 8,
               F_CQ16 = 40 * M1 + M1 / 4, F_CKV16 = 42 * M1 + M1 / 4,
               F_Q16 = 43 * M1 + M1 / 2, F_K16 = 49 * M1 + M1 / 2, F_VT16 = 55 * M1 + M1 / 2, F_HID = 59 * M1 + M1 / 2, F_KC16 = 63 * M1 + M1 / 2, F_VCT16 = F_KC16 + M1 / 8,
               F_HB = 30 * M1, F_HSS = 38 * M1, F_PSS = 38 * M1 + M1 / 2, F_EO = 39 * M1, F_GO = 41 * M1, F_PQB = 43 * M1 + M1 / 2;
static_assert(F_SSQKR + 16384 <= F_SSQA && F_SSQB + 8 * 16384 <= F_ROPE && F_VCT16 + M1 / 8 <= 64 * M1 - 16384 && F_CKV16 + M1 <= F_Q16 && F_PQB + 16 * M1 <= F_HID, "workspace map");

#define G(x) (x)
__global__ __launch_bounds__(512, 2) void mega(Params p_unused) {
    extern __shared__ __attribute__((aligned(16))) unsigned char lds_raw[];
    float* ldsf = (float*)(lds_raw + 64);
    { const unsigned bid_ = blockIdx.x; __builtin_assume(bid_ < (unsigned)NBLK); }
    if (threadIdx.x == 0) *(uint4*)lds_raw = make_uint4(0u, 0u, 0u, 0u);
    __syncthreads();
    XcdBarrier bar = xcd_barrier_post(params_ptr()->bar, (volatile LAS unsigned*)lds_raw);
#define GRID_SYNC() xcd_barrier(bar)
#define U16P(off) ((unsigned short*)(W + (off)))
    { cparams_t p = params_ptr(); float* W = p->W;
      p0_xn_rope(p->x, p->norm1_gain, p->positions, U16P(F_XN16), W + F_ROPE); }
    { cparams_t p = params_ptr(); float* W = p->W;
#define P0_XT(j) ({ const int v_ = (int)blockIdx.x + NBLK * (j); \
        (v_ < 432) ? xt_make(p->w_in, 1024, INW, U16P(F_WTIN), nullptr, nullptr, 0, 2, v_) : \
        (v_ < 480) ? xt_make(p->mla_w_uq, 256, 768, U16P(F_WTUQ), p->mla_q_lora_gain, p->mla_q_lora_gain, 1 << 30, 0, v_ - 432) : \
        (v_ < 512) ? xt_make(p->mla_w_ukv, 128, 1024, U16P(F_WTUKV), p->mla_kv_lora_gain, p->mla_kv_lora_gain, 1 << 30, 0, v_ - 480) : \
        (v_ < 640) ? xt_make(p->cmp_k_w1, 2048, 256, U16P(F_W1TK), nullptr, nullptr, 0, 0, v_ - 512) : \
        (v_ < 768) ? xt_make(p->cmp_v_w1, 2048, 256, U16P(F_W1TV), nullptr, nullptr, 0, 0, v_ - 640) : \
        (v_ < 772) ? xt_make(p->cmp_k_w2, 256, 64, U16P(F_W2TK), nullptr, nullptr, 0, 0, v_ - 768) : \
        (v_ < 776) ? xt_make(p->cmp_v_w2, 256, 64, U16P(F_W2TV), nullptr, nullptr, 0, 0, v_ - 772) : xt_make(nullptr, 64, 64, nullptr, nullptr, nullptr, 0, 0, -1); })
      XT_RUN4(ldsf, P0_XT);
      zero_stream(U16P(F_WTIN) + (long)1720 * 1024, (long)72 * 1024); }
    { cparams_t p = params_ptr(); float* W = p->W;
      p0_cbias(p->cmp_pos, p->cmp_k_w1, p->cmp_v_w1, W + F_CBIAS); }
    GRID_SYNC();
    { cparams_t p = params_ptr(); float* W = p->W;
      P1Out O; O.q16a = U16P(F_Q16A); O.ks16 = U16P(F_KS16); O.kw16 = U16P(F_KW16); O.vst16 = U16P(F_VST16); O.vwt16 = U16P(F_VWT16); O.kcmp16 = U16P(F_KCMP16); O.vcmp16 = U16P(F_VCMP16);
      O.cq16 = U16P(F_CQ16); O.ckv16 = U16P(F_CKV16); O.krr = W + F_KRR; O.ssq_kr = W + F_SSQKR; O.ssq_cq = W + F_SSQCQ; O.ssq_ckv = W + F_SSQCKV; O.gates = W + F_GATES;
      O.rope = W + F_ROPE; O.q_gain = p->nsa_q_gain; O.ks_gain = p->nsa_ks_gain; O.kw_gain = p->nsa_kw_gain; O.k_gain = p->mla_k_gain;
      p1_inproj_256(lds_raw + 64, U16P(F_XN16), U16P(F_WTIN), O); }
    if ((blockIdx.x >> 3) >= 24) {
      cparams_t p = params_ptr(); float* W = p->W;
      cvt_rows_fp6<8>(p->peer_u, (unsigned char*)(W + F_U8), W + F_SU, PU_SPLIT, (int)(blockIdx.x & 7) * 8 + (int)(blockIdx.x >> 3) - 24, 64); }
    GRID_SYNC();
    { cparams_t p = params_ptr(); float* W = p->W;
      P2Args A; A.cq16 = U16P(F_CQ16); A.ckv16 = U16P(F_CKV16); A.wt_uq = U16P(F_WTUQ); A.wt_ukv = U16P(F_WTUKV); A.kcmp16 = U16P(F_KCMP16); A.vcmp16 = U16P(F_VCMP16); A.w1t_k = U16P(F_W1TK); A.w1t_v = U16P(F_W1TV);
      A.ssq_cq = W + F_SSQCQ; A.ssq_ckv = W + F_SSQCKV; A.ssq_kr = W + F_SSQKR; A.krr = W + F_KRR; A.rope = W + F_ROPE; A.q_gain = p->mla_q_gain; A.k_gain = p->mla_k_gain;
      A.q16 = U16P(F_Q16); A.k16 = U16P(F_K16); A.vt16 = U16P(F_VT16); A.hid = W + F_HID;
      p2_phase(lds_raw + 64, A); }
    GRID_SYNC();
    { const int vb = blockIdx.x, nb = NBLK;
      { cparams_t p = params_ptr(); float* W = p->W;
#define P3_XT(j) ({ const int v_ = vb + nb * (j); \
          (v_ < 256) ? xt_make(p->w_out, 1024, 1024, U16P(F_WTOUT), p->out_gain_a, p->out_gain_b, 512, 0, v_) : \
          (v_ < 768) ? xt_make(p->peer_w_q, 1024, 2048, U16P(F_WTQ), p->norm2_gain, p->norm2_gain, 1 << 30, 0, v_ - 256) : xt_make(nullptr, 64, 64, nullptr, nullptr, nullptr, 0, 0, -1); })
        XT_RUN4(ldsf, P3_XT); }
      { cparams_t p = params_ptr(); float* W = p->W;
        p3_cmp2(lds_raw + 64 + 36864, W + F_HID, W + F_CBIAS, U16P(F_W2TK), U16P(F_W2TV), p->nsa_kc_gain, W + F_ROPE, U16P(F_KC16), U16P(F_VCT16)); }
      { cparams_t p = params_ptr(); float* W = p->W;
        cvt_stream(p->peer_sub_keys, U16P(F_SK16), (long)8 * 2 * 128 * 128, vb, nb);
        cvt_rows_fp6<4>(p->peer_v, (unsigned char*)(W + F_V8), W + F_SV, 16384, vb, nb);
        cvt_rows_fp6<2>(p->peer_u + (long)PU_SPLIT * 1024, (unsigned char*)(W + F_U8) + (long)PU_SPLIT * PROW, W + F_SU + PU_SPLIT, 16384 - PU_SPLIT, vb, nb); }
    }
    GRID_SYNC();
    { cparams_t p = params_ptr(); float* W = p->W;
      nsa_phase(lds_raw + 64, U16P(F_Q16A), U16P(F_KC16), U16P(F_VCT16), U16P(F_KS16), U16P(F_VST16), U16P(F_KW16), U16P(F_VWT16), W + F_GATES, U16P(F_MIX), W + F_SSQA); }
    { cparams_t p = params_ptr(); float* W = p->W;
      mla_phase(lds_raw + 64, U16P(F_Q16), U16P(F_K16), U16P(F_VT16), U16P(F_MIX), W + F_SSQB); }
    GRID_SYNC();
    { cparams_t p = params_ptr(); float* W = p->W;
      p5_outproj_256(lds_raw + 64, U16P(F_MIX), U16P(F_WTOUT), W + F_SSQA, W + F_SSQB, p->x, p->out, U16P(F_HB), W + F_HSS); }
    GRID_SYNC();
    { cparams_t p = params_ptr(); float* W = p->W;
      p6_peerq_256(lds_raw + 64, U16P(F_HB), U16P(F_WTQ), W + F_HSS, U16P(F_PQB), W + F_PSS); }
    GRID_SYNC();
    { cparams_t p = params_ptr(); float* W = p->W;
      peer_route_mfma(lds_raw + 64, U16P(F_PQB), W + F_PSS, U16P(F_SK16), (int*)(W + F_EO), W + F_GO); }
    GRID_SYNC();
    { cparams_t p = params_ptr(); float* W = p->W;
      peer_sweep_a(W + F_HSS, p->norm2_gain, (const int*)(W + F_EO), W + F_GO, (const unsigned char*)(W + F_U8), W + F_SU, W + F_SV, p->out, W + F_PQB); }
    GRID_SYNC();
    { cparams_t p = params_ptr(); float* W = p->W;
      peer_sweep_b((const int*)(W + F_EO), W + F_PQB, (const unsigned char*)(W + F_V8), p->out); }
}

extern "C" void kernel_launch(void* const* d_in, const int* in_sizes, int n_in, void* d_out, int out_size, void* d_ws, size_t ws_size, hipStream_t stream) {
    (void)ws_size; (void)in_sizes; (void)n_in; (void)out_size;
    static int grid = 0;
    if (grid == 0) {
        int dev = 0, cus = 0, per_cu = 0;
        (void)hipGetDevice(&dev);
        (void)hipDeviceGetAttribute(&cus, hipDeviceAttributeMultiprocessorCount, dev);
        (void)hipFuncSetAttribute((const void*)mega, hipFuncAttributeMaxDynamicSharedMemorySize, LDS_BYTES);
        (void)hipOccupancyMaxActiveBlocksPerMultiprocessor(&per_cu, (const void*)mega, 512, LDS_BYTES);
        (void)hipGetLastError();
        if (per_cu < 1) fprintf(stderr, "kernel_launch: occupancy query reports %d blocks per CU\n", per_cu);
        if (cus != NBLK) fprintf(stderr, "kernel_launch: built for %d CUs, device reports %d\n", NBLK, cus);
        grid = NBLK;
    }
    Params p{};
    p.x = (const float*)d_in[0]; p.positions = (const int*)d_in[1]; p.norm1_gain = (const float*)d_in[2]; p.w_in = (const float*)d_in[3];
    p.nsa_q_gain = (const float*)d_in[4]; p.nsa_kc_gain = (const float*)d_in[5]; p.nsa_ks_gain = (const float*)d_in[6]; p.nsa_kw_gain = (const float*)d_in[7];
    p.cmp_pos = (const float*)d_in[8]; p.cmp_k_w1 = (const float*)d_in[9]; p.cmp_k_w2 = (const float*)d_in[10]; p.cmp_v_w1 = (const float*)d_in[11]; p.cmp_v_w2 = (const float*)d_in[12];
    p.mla_q_lora_gain = (const float*)d_in[13]; p.mla_w_uq = (const float*)d_in[14]; p.mla_kv_lora_gain = (const float*)d_in[15]; p.mla_w_ukv = (const float*)d_in[16];
    p.mla_q_gain = (const float*)d_in[17]; p.mla_k_gain = (const float*)d_in[18]; p.out_gain_a = (const float*)d_in[19]; p.out_gain_b = (const float*)d_in[20]; p.w_out = (const float*)d_in[21];
    p.norm2_gain = (const float*)d_in[22]; p.peer_w_q = (const float*)d_in[23]; p.peer_sub_keys = (const float*)d_in[24]; p.peer_u = (const float*)d_in[25]; p.peer_v = (const float*)d_in[26];
    p.out = (float*)d_out;
    p.bar = (unsigned*)d_ws;
    p.W = (float*)d_ws + 16384;
    (void)hipMemsetAsync(d_ws, 0, XCD_BAR_WORDS * sizeof(unsigned), stream);
    hipLaunchKernelGGL(mega, dim3(grid), dim3(512), LDS_BYTES, stream, p);
}
```

```cpp
#include <hip/hip_runtime.h>
#include <cmath>
#include <cstdint>
#include <cstdio>

#define XB_TMO      128
#define XB_XCNT(j)  (256  + 64 * (j))
#define XB_XSUB(j)  (1280 + 64 * (j))
#define XB_XGEN(j)  (2304 + 64 * (j))
#define XB_TOP      3328
#define XB_TOPGEN   3392
#define XCD_BAR_WORDS 3456
#define XB_SPIN_CAP (1u << 18)
#define LAS __attribute__((address_space(3)))

__device__ __forceinline__ unsigned xb_ld(unsigned* p)              { return __hip_atomic_load(p, __ATOMIC_RELAXED, __HIP_MEMORY_SCOPE_AGENT); }
__device__ __forceinline__ unsigned xb_add(unsigned* p, unsigned v) { return __hip_atomic_fetch_add(p, v, __ATOMIC_RELAXED, __HIP_MEMORY_SCOPE_AGENT); }
__device__ __forceinline__ unsigned xb_xcc_id() { return (unsigned)__builtin_amdgcn_s_getreg((3 << 11) | 20) & 0xFu; }
#define XB_SPIN(cond, bar) do { unsigned _sp = 0; while (cond) { __builtin_amdgcn_s_sleep(1); \
    if ((++_sp & 255u) == 0u) { if (xb_ld(&(bar)[XB_TMO])) break; if (_sp > XB_SPIN_CAP) { atomicAdd(&(bar)[XB_TMO], 1u); break; } } } } while (0)

struct XcdBarrier {
    unsigned* bar; unsigned x;
    volatile LAS unsigned* st;
};

__device__ __forceinline__ XcdBarrier xcd_barrier_post(unsigned* bar, volatile LAS unsigned* st) {
    XcdBarrier b; b.bar = bar; b.x = xb_xcc_id(); b.st = st;
    if (threadIdx.x == 0) (void)xb_add(&bar[XB_XCNT(b.x)], 1u);
    return b;
}
__device__ __forceinline__ void xcd_barrier_complete(unsigned* bar, unsigned x, unsigned& nloc, unsigned& nx) {
    const unsigned G = gridDim.x * gridDim.y * gridDim.z;
    unsigned sum, cnt, mine, sp = 0u;
    for (;;) {
        sum = 0u; cnt = 0u; mine = 0u;
#pragma unroll
        for (unsigned j = 0; j < 16; ++j) { const unsigned c = xb_ld(&bar[XB_XCNT(j)]); sum += c; cnt += (c > 0u) ? 1u : 0u; mine = (j == x) ? c : mine; }
        if (sum == G) break;
        __builtin_amdgcn_s_sleep(1);
        if ((++sp & 255u) == 0u) { if (xb_ld(&bar[XB_TMO])) break; if (sp > XB_SPIN_CAP) { atomicAdd(&bar[XB_TMO], 1u); break; } }
    }
    nloc = mine > 0u ? mine : 1u; nx = cnt > 0u ? cnt : 1u;
}

__device__ __forceinline__ void xcd_barrier(const XcdBarrier& b) {
    asm volatile("s_waitcnt vmcnt(0)" ::: "memory");
    __syncthreads();
    if (threadIdx.x == 0) {
        unsigned* bar = b.bar;
        __builtin_amdgcn_s_waitcnt(0);
        unsigned nloc = b.st[0], nx = b.st[1];
        if (nloc == 0u) { xcd_barrier_complete(bar, b.x, nloc, nx); b.st[0] = nloc; b.st[1] = nx; }
        const unsigned old = xb_add(&bar[XB_XSUB(b.x)], 1u);
        const unsigned gen = old / nloc;
        if (old + 1u == (gen + 1u) * nloc) {
            __builtin_amdgcn_fence(__ATOMIC_RELEASE, "agent");
            asm volatile("s_waitcnt vmcnt(0)" ::: "memory");
            const unsigned og = xb_add(&bar[XB_TOP], 1u);
            const unsigned tg = og / nx;
            if (og + 1u == (tg + 1u) * nx) xb_add(&bar[XB_TOPGEN], 1u);
            else XB_SPIN(xb_ld(&bar[XB_TOPGEN]) == tg, bar);
            __builtin_amdgcn_fence(__ATOMIC_ACQUIRE, "agent");
            xb_add(&bar[XB_XGEN(b.x)], 1u);
            asm volatile("s_waitcnt vmcnt(0)" ::: "memory");
        } else {
            XB_SPIN(xb_ld(&bar[XB_XGEN(b.x)]) == gen, bar);
            __builtin_amdgcn_fence(__ATOMIC_ACQUIRE, "agent");
            asm volatile("s_waitcnt vmcnt(0)" ::: "memory");
        }
    }
    __syncthreads();
}


#define AS1 __attribute__((address_space(1)))
constexpr int NBLK = 256;
constexpr int B_ = 2, S_ = 8192, T_ = B_ * S_, D_ = 1024, INW = 1720;
constexpr int G_ = 2, NCMP = 511;
constexpr float EPS = 1e-6f;
constexpr int C_Q = 0, C_KC = 512, C_VC = 640, C_KS = 768, C_VS = 896, C_KW = 1024, C_VW = 1152, C_GATE = 1280, C_CQ = 1304, C_CKV = 1560, C_KR = 1688;

#define WSYNC() do { __builtin_amdgcn_wave_barrier(); asm volatile("s_waitcnt lgkmcnt(0)" ::: "memory"); __builtin_amdgcn_wave_barrier(); } while (0)

__device__ __forceinline__ int tid_() { int t = threadIdx.x; asm volatile("" : "+v"(t)); return t; }
template <class T> __device__ __forceinline__ T* as_global(T* p) { return (T*)(__attribute__((address_space(1))) T*)p; }
__device__ __forceinline__ float wsum(float v) {
#pragma unroll
    for (int o = 32; o > 0; o >>= 1) v += __shfl_xor(v, o);
    return v;
}
__device__ __forceinline__ float wmax(float v) {
#pragma unroll
    for (int o = 32; o > 0; o >>= 1) v = fmaxf(v, __shfl_xor(v, o));
    return v;
}
__device__ __forceinline__ float gelu_tanh(float x) {
    const float u = 0.7978845608028654f * (x + 0.044715f * x * x * x);
    return 0.5f * x * (1.f + tanhf(u));
}

__device__ const float ROPE_F16[8] = {1.000000000e+00f, 1.939227432e-01f, 3.760603070e-02f, 7.292664610e-03f, 1.414213562e-03f, 2.742481884e-04f, 5.318296098e-05f, 1.031338616e-05f};
__device__ const float ROPE_F32[16] = {1.000000000e+00f, 4.403665960e-01f, 1.939227432e-01f, 8.539710194e-02f, 3.760603070e-02f, 1.656043902e-02f, 7.292664610e-03f, 3.211445874e-03f,
                                       1.414213562e-03f, 6.227723788e-04f, 2.742481884e-04f, 1.207697351e-04f, 5.318296098e-05f, 2.341999971e-05f, 1.031338616e-05f, 4.541670478e-06f};

typedef __attribute__((ext_vector_type(8))) short bf16x8;
typedef __attribute__((ext_vector_type(16))) float f32x16;
typedef __attribute__((ext_vector_type(2))) __bf16 bf16x2_t;
__device__ __forceinline__ unsigned cvtpk(float lo, float hi) { unsigned r; asm("v_cvt_pk_bf16_f32 %0, %1, %2" : "=v"(r) : "v"(lo), "v"(hi)); return r; }
__device__ __forceinline__ float bflo(unsigned u) { return __uint_as_float(u << 16); }
__device__ __forceinline__ float bfhi(unsigned u) { return __uint_as_float(u & 0xffff0000u); }
__device__ __forceinline__ float dot2bf(unsigned a, unsigned b, float c) { return __builtin_amdgcn_fdot2_f32_bf16(__builtin_bit_cast(bf16x2_t, a), __builtin_bit_cast(bf16x2_t, b), c, false); }

__device__ __forceinline__ float pair_max(float x) { auto rr = __builtin_amdgcn_permlane32_swap(__float_as_uint(x), __float_as_uint(x), false, false); return fmaxf(__uint_as_float(rr[0]), __uint_as_float(rr[1])); }
__device__ __forceinline__ float pair_sum(float x) { auto rr = __builtin_amdgcn_permlane32_swap(__float_as_uint(x), __float_as_uint(x), false, false); return __uint_as_float(rr[0]) + __uint_as_float(rr[1]); }
typedef float f32x2_t __attribute__((ext_vector_type(2)));
__device__ __forceinline__ float max3f(float a, float b, float c) { float r; asm("v_max3_f32 %0, %1, %2, %3" : "=v"(r) : "v"(a), "v"(b), "v"(c)); return r; }
__device__ __forceinline__ float quad_sum(float x) {
    float y = x + __uint_as_float(__builtin_amdgcn_mov_dpp(__float_as_uint(x), 0xB1, 0xF, 0xF, true));
    return y + __uint_as_float(__builtin_amdgcn_mov_dpp(__float_as_uint(y), 0x4E, 0xF, 0xF, true));
}
#define MFMA32(a, b, c) __builtin_amdgcn_mfma_f32_32x32x16_bf16(a, b, c, 0, 0, 0)
typedef unsigned u32x4 __attribute__((ext_vector_type(4)));
constexpr int LDS_PITCH = 144;
__device__ __forceinline__ int crow(int r, int hi) { return (r & 3) + 8 * (r >> 2) + 4 * hi; }

template <int WM_, int WN_, int MI_, int NI_>
struct GemmShape {
    static constexpr int WM = WM_, WN = WN_, MI = MI_, NI = NI_;
    static constexpr int BM = WM * MI * 32, BN = WN * NI * 32, ROWS = BM + BN;
    static constexpr int CHUNKS = ROWS * 8 / 512;
    static constexpr int STAGE_BYTES = ROWS * LDS_PITCH;
    static_assert(WM * WN == 8 && (ROWS * 8) % 512 == 0, "8 waves; whole chunks per thread");
};
template <class SH, unsigned TOKMASK, int CUR>
__device__ __forceinline__ void gemm_step(unsigned char* lds, const unsigned short* const (&gp)[SH::CHUNKS], const int (&lo)[SH::CHUNKS], u32x4 (&g)[2][SH::CHUNKS],
                                          f32x16 (&acc)[SH::MI][SH::NI], int kt, int nk, int aoff, int boff) {
    const unsigned char* st = lds + (kt & 1) * SH::STAGE_BYTES;
    if (kt + 2 < nk) {
#pragma unroll
        for (int i = 0; i < SH::CHUNKS; ++i) g[CUR][i] = *(const u32x4*)(gp[i] + (long)(kt + 2) * 64);
    }
#pragma unroll
    for (int ks = 0; ks < 4; ++ks) {
        bf16x8 af[SH::MI], bfr[SH::NI];
#pragma unroll
        for (int mi = 0; mi < SH::MI; ++mi) af[mi] = *(const bf16x8*)(st + aoff + mi * 32 * LDS_PITCH + ks * 32);
#pragma unroll
        for (int ni = 0; ni < SH::NI; ++ni) bfr[ni] = *(const bf16x8*)(st + boff + ni * 32 * LDS_PITCH + ks * 32);
#pragma unroll
        for (int mi = 0; mi < SH::MI; ++mi)
#pragma unroll
            for (int ni = 0; ni < SH::NI; ++ni)
                acc[mi][ni] = ((TOKMASK >> ni) & 1u) ? MFMA32(bfr[ni], af[mi], acc[mi][ni]) : MFMA32(af[mi], bfr[ni], acc[mi][ni]);
    }
    if (kt + 1 < nk) {
        unsigned char* sn = lds + ((kt + 1) & 1) * SH::STAGE_BYTES;
#pragma unroll
        for (int i = 0; i < SH::CHUNKS; ++i) *(u32x4*)(sn + lo[i]) = g[CUR ^ 1][i];
    }
    __syncthreads();
}
template <class SH, unsigned TOKMASK>
__device__ __forceinline__ void gemm_mainloop(const unsigned short* __restrict__ A0, long lda, const unsigned short* __restrict__ B0, long ldb, int K,
                                              unsigned char* lds, f32x16 (&acc)[SH::MI][SH::NI], int tid) {
    const int lane = tid & 63, wave = __builtin_amdgcn_readfirstlane(tid >> 6), r32 = lane & 31, hi = lane >> 5;
    const int wm = wave / SH::WN, wn = wave % SH::WN;
    const unsigned short* gp[SH::CHUNKS]; int lo[SH::CHUNKS];
#pragma unroll
    for (int i = 0; i < SH::CHUNKS; ++i) {
        const int c = tid + i * 512, row = c >> 3, kc = c & 7;
        gp[i] = (row < SH::BM) ? (A0 + (long)row * lda + kc * 8) : (B0 + (long)(row - SH::BM) * ldb + kc * 8);
        lo[i] = row * LDS_PITCH + kc * 16;
    }
    u32x4 g[2][SH::CHUNKS];
    const int nk = K >> 6;
#pragma unroll
    for (int i = 0; i < SH::CHUNKS; ++i) { g[0][i] = *(const u32x4*)gp[i]; g[1][i] = *(const u32x4*)(gp[i] + 64); }
#pragma unroll
    for (int i = 0; i < SH::CHUNKS; ++i) *(u32x4*)(lds + lo[i]) = g[0][i];
    __syncthreads();
    const int aoff = (wm * SH::MI * 32 + r32) * LDS_PITCH + hi * 16;
    const int boff = (SH::BM + wn * SH::NI * 32 + r32) * LDS_PITCH + hi * 16;
    for (int kt = 0; kt < nk; kt += 2) {
        gemm_step<SH, TOKMASK, 0>(lds, gp, lo, g, acc, kt, nk, aoff, boff);
        gemm_step<SH, TOKMASK, 1>(lds, gp, lo, g, acc, kt + 1, nk, aoff, boff);
    }
}

typedef __attribute__((ext_vector_type(4))) float f32x4_t;
namespace g256 {
constexpr int BK = 64, HALF = 128, HT = HALF * BK;
__device__ __forceinline__ int lds_byte(int r, int c) { const int st = (r >> 4) * 2 + (c >> 5), rr = r & 15, cc = c & 31, ob = rr * 64 + cc * 2; return st * 1024 + (ob ^ (((ob >> 9) & 1) << 5)); }
__device__ __forceinline__ void stage_rc(int b, int& R, int& C) { const int st = b / 1024, sb = b % 1024, swz = sb ^ (((sb >> 9) & 1) << 5); R = (st >> 1) * 16 + swz / 64; C = (st & 1) * 32 + (swz % 64) / 2; }
template <int K, int PITCH = K>
__device__ __forceinline__ void mainloop(const unsigned short* __restrict__ A, const unsigned short* __restrict__ Bt, int brow, int bcol, unsigned short* shm, f32x4_t (&acc)[2][2][4][2]) {
#define SA(b, h) (shm + ((b) * 2 + (h)) * HT)
#define SB(b, h) (shm + (4 + (b) * 2 + (h)) * HT)
#define STAGE_X(T, P, BASE, br, kt) do { const AS1 char* ub_ = (const AS1 char*)(BASE) + ((long)(br) * PITCH + (long)(kt) * BK) * 2;     \
    for (int i_ = 0; i_ < 2; ++i_) { const int b_ = (T) * 16 + i_ * 8192; int r_, c_; stage_rc(b_, r_, c_); \
      __builtin_amdgcn_global_load_lds((const AS1 unsigned*)(ub_ + (unsigned)(r_ * PITCH + c_) * 2u), (LAS unsigned*)((LAS char*)(P) + b_), 16, 0, 0); } } while (0)
#define STAGE(P, BASE, br, kt) STAGE_X(tx, P, BASE, br, kt)
#define LDA(dst, b, h) for (int m = 0; m < 4; ++m) for (int k = 0; k < 2; ++k) dst[m][k] = *reinterpret_cast<const bf16x8*>((char*)SA(b, h) + lds_byte(wr * 64 + m * 16 + fr, k * 32 + fq * 8))
#define LDB(dst, b, h) for (int n = 0; n < 2; ++n) for (int k = 0; k < 2; ++k) dst[n][k] = *reinterpret_cast<const bf16x8*>((char*)SB(b, h) + lds_byte(wc * 32 + n * 16 + fr, k * 32 + fq * 8))
#define MMA(ai, bj, At_, Bt_) do { __builtin_amdgcn_s_setprio(1); \
    for (int m = 0; m < 4; ++m) for (int n = 0; n < 2; ++n) for (int k = 0; k < 2; ++k) acc[ai][bj][m][n] = __builtin_amdgcn_mfma_f32_16x16x32_bf16(At_[m][k], Bt_[n][k], acc[ai][bj][m][n], 0, 0, 0); \
    __builtin_amdgcn_s_setprio(0); } while (0)
#define WAIT_V(n) asm volatile("s_waitcnt vmcnt(" #n ")" ::: "memory")
#define WAIT_L(n) asm volatile("s_waitcnt lgkmcnt(" #n ")" ::: "memory")
#define BAR __builtin_amdgcn_s_barrier()
#define SCHED __builtin_amdgcn_sched_barrier(0)
    int tx = threadIdx.x; asm volatile("" : "+v"(tx));
    int wid = tx >> 6, lane = tx & 63, wr = wid >> 2, wc = wid & 3, fr = lane & 15, fq = lane >> 4;
    bf16x8 At[4][2], B0[2][2], B1[2][2];
    const int nt = K / BK;
    STAGE(SB(0, 0), Bt, bcol, 0); STAGE(SA(0, 0), A, brow, 0);
    STAGE(SB(0, 1), Bt, bcol + HALF, 0); STAGE(SA(0, 1), A, brow + HALF, 0);
    if (wr == 1) BAR;
    WAIT_V(4); BAR;
    STAGE(SB(1, 0), Bt, bcol, 1); STAGE(SA(1, 0), A, brow, 1); STAGE(SB(1, 1), Bt, bcol + HALF, 1);
    WAIT_V(6); BAR;
    for (int t = 0; t < nt - 2; t += 2) {
        LDB(B0, 0, 0); SCHED; LDA(At, 0, 0); STAGE(SA(1, 1), A, brow + HALF, t + 1);
        WAIT_L(8); BAR; WAIT_L(0); MMA(0, 0, At, B0); BAR; SCHED;
        LDB(B1, 0, 1); STAGE(SB(0, 0), Bt, bcol, t + 2);
        BAR; WAIT_L(0); MMA(0, 1, At, B1); BAR;
        LDA(At, 0, 1); STAGE(SA(0, 0), A, brow, t + 2);
        BAR; WAIT_L(0); MMA(1, 0, At, B0); BAR; SCHED;
        STAGE(SB(0, 1), Bt, bcol + HALF, t + 2);
        WAIT_V(6); BAR; MMA(1, 1, At, B1); BAR;
        LDB(B0, 1, 0); SCHED; LDA(At, 1, 0); STAGE(SA(0, 1), A, brow + HALF, t + 2);
        WAIT_L(8); BAR; WAIT_L(0); MMA(0, 0, At, B0); BAR; SCHED;
        LDB(B1, 1, 1); STAGE(SB(1, 0), Bt, bcol, t + 3);
        BAR; WAIT_L(0); MMA(0, 1, At, B1); BAR;
        LDA(At, 1, 1); STAGE(SA(1, 0), A, brow, t + 3);
        BAR; WAIT_L(0); MMA(1, 0, At, B0); BAR; SCHED;
        STAGE(SB(1, 1), Bt, bcol + HALF, t + 3);
        WAIT_V(6); BAR; MMA(1, 1, At, B1); BAR;
    }
    int tz = threadIdx.x; asm volatile("" : "+v"(tz)); wid = tz >> 6; lane = tz & 63; wr = wid >> 2; wc = wid & 3; fr = lane & 15; fq = lane >> 4;
    { LDB(B0, 0, 0); WAIT_V(0); LDA(At, 0, 0); STAGE_X(tz, SA(1, 1), A, brow + HALF, nt - 1);
      BAR; WAIT_L(0); MMA(0, 0, At, B0); BAR;
      LDB(B1, 0, 1); BAR; WAIT_L(0); MMA(0, 1, At, B1); BAR;
      LDA(At, 0, 1); WAIT_V(4); BAR; WAIT_L(0); MMA(1, 0, At, B0); MMA(1, 1, At, B1); BAR; }
    { LDB(B0, 1, 0); LDA(At, 1, 0); WAIT_V(2); BAR; WAIT_L(0); MMA(0, 0, At, B0); BAR;
      LDB(B1, 1, 1); WAIT_V(0); BAR; WAIT_L(0); MMA(0, 1, At, B1); BAR;
      LDA(At, 1, 1); BAR; WAIT_L(0); MMA(1, 0, At, B0); MMA(1, 1, At, B1); BAR; }
    if (wr == 0) BAR;
#undef SA
#undef SB
#undef STAGE_X
#undef STAGE
#undef LDA
#undef LDB
#undef MMA
#undef WAIT_V
#undef WAIT_L
#undef BAR
#undef SCHED
}
}

__device__ __forceinline__ void p5_outproj_256(unsigned char* lds, const unsigned short* __restrict__ mix, const unsigned short* __restrict__ wt_out, const float* __restrict__ ssqa, const float* __restrict__ ssqb,
                                               const float* __restrict__ x, float* __restrict__ out, unsigned short* __restrict__ hb, float* __restrict__ hss) {
    const int vcu = (blockIdx.x & 7) * (NBLK / 8) + (blockIdx.x >> 3);
    for (int tile = vcu; tile < 64 * 4; tile += NBLK) {
        const int m0 = (tile >> 2) * 256, n0 = (tile & 3) * 256;
        f32x4_t acc[2][2][4][2];
#pragma unroll
        for (int ai = 0; ai < 2; ++ai)
#pragma unroll
            for (int bj = 0; bj < 2; ++bj)
#pragma unroll
                for (int m = 0; m < 4; ++m)
#pragma unroll
                    for (int n = 0; n < 2; ++n) acc[ai][bj][m][n] = f32x4_t{0.f, 0.f, 0.f, 0.f};
        g256::mainloop<512, 1024>(wt_out, mix, n0, m0, (unsigned short*)lds, acc);
        float rb[2][2];
        {
            const int tid = tid_(); const int lane = tid & 63, wave = __builtin_amdgcn_readfirstlane(tid >> 6), wc = wave & 3, fr = lane & 15;
#pragma unroll
            for (int bj = 0; bj < 2; ++bj)
#pragma unroll
                for (int n = 0; n < 2; ++n) {
                    const long tok = m0 + bj * 128 + wc * 32 + n * 16 + fr; float sa = 0.f, sb = 0.f;
#pragma unroll
                    for (int hh = 0; hh < 8; ++hh) { sa += ssqa[(long)hh * T_ + tok]; sb += ssqb[(long)hh * T_ + tok]; }
                    rb[bj][n] = rsqrtf(sb * (1.f / 512.f) + EPS); const float ratio = rsqrtf(sa * (1.f / 512.f) + EPS) / rb[bj][n];
#pragma unroll
                    for (int ai = 0; ai < 2; ++ai)
#pragma unroll
                        for (int m = 0; m < 4; ++m) acc[ai][bj][m][n] *= ratio;
                }
        }
        g256::mainloop<512, 1024>(wt_out + 512, mix + 512, n0, m0, (unsigned short*)lds, acc);
        const int tid = tid_(); const int lane = tid & 63, wave = __builtin_amdgcn_readfirstlane(tid >> 6), wr = wave >> 2, wc = wave & 3, fr = lane & 15, fq = lane >> 4;
#pragma unroll
        for (int bj = 0; bj < 2; ++bj)
#pragma unroll
            for (int n = 0; n < 2; ++n) {
                const long tok = m0 + bj * 128 + wc * 32 + n * 16 + fr; const float r = rb[bj][n];
                float ss = 0.f;
#pragma unroll
                for (int ai = 0; ai < 2; ++ai)
#pragma unroll
                    for (int m = 0; m < 4; ++m) {
                        const int nrow = n0 + ai * 128 + wr * 64 + m * 16 + fq * 4;
                        const float4 xv = *(const float4*)(x + tok * 1024 + nrow);
                        float4 hv; hv.x = xv.x + acc[ai][bj][m][n][0] * r; hv.y = xv.y + acc[ai][bj][m][n][1] * r; hv.z = xv.z + acc[ai][bj][m][n][2] * r; hv.w = xv.w + acc[ai][bj][m][n][3] * r;
                        *(float4*)(out + tok * 1024 + nrow) = hv;
                        uint2 pk; pk.x = cvtpk(hv.x, hv.y); pk.y = cvtpk(hv.z, hv.w);
                        *(uint2*)(hb + tok * 1024 + nrow) = pk;
                        ss += hv.x * hv.x + hv.y * hv.y + hv.z * hv.z + hv.w * hv.w;
                    }
                { auto r1 = __builtin_amdgcn_permlane16_swap(__float_as_uint(ss), __float_as_uint(ss), false, false); ss = __uint_as_float(r1[0]) + __uint_as_float(r1[1]); }
                ss = pair_sum(ss);
                if (fq == 0) { hss[tok * 16 + (n0 >> 8) * 4 + wr] = ss; hss[tok * 16 + (n0 >> 8) * 4 + 2 + wr] = 0.f; }
            }
        __syncthreads();
    }
}
__device__ __forceinline__ void p6_peerq_256(unsigned char* lds, const unsigned short* __restrict__ hb, const unsigned short* __restrict__ wt_q, const float* __restrict__ hss,
                                             unsigned short* __restrict__ pqb, float* __restrict__ pss) {
    const int vcu = (blockIdx.x & 7) * (NBLK / 8) + (blockIdx.x >> 3);
    for (int tile = vcu; tile < 64 * 8; tile += NBLK) {
        const int m0 = (tile >> 3) * 256, n0 = (tile & 7) * 256;
        f32x4_t acc[2][2][4][2];
#pragma unroll
        for (int ai = 0; ai < 2; ++ai)
#pragma unroll
            for (int bj = 0; bj < 2; ++bj)
#pragma unroll
                for (int m = 0; m < 4; ++m)
#pragma unroll
                    for (int n = 0; n < 2; ++n) acc[ai][bj][m][n] = f32x4_t{0.f, 0.f, 0.f, 0.f};
        g256::mainloop<1024>(wt_q, hb, n0, m0, (unsigned short*)lds, acc);
        const int tid = tid_(); const int lane = tid & 63, wave = __builtin_amdgcn_readfirstlane(tid >> 6), wr = wave >> 2, wc = wave & 3, fr = lane & 15, fq = lane >> 4;
#pragma unroll
        for (int bj = 0; bj < 2; ++bj)
#pragma unroll
            for (int n = 0; n < 2; ++n) {
                const long tok = m0 + bj * 128 + wc * 32 + n * 16 + fr;
                const float4* hp = (const float4*)(hss + tok * 16);
                const float4 s0 = hp[0], s1 = hp[1], s2 = hp[2], s3 = hp[3];
                const float rs = rsqrtf((s0.x + s0.y + s0.z + s0.w + s1.x + s1.y + s1.z + s1.w + s2.x + s2.y + s2.z + s2.w + s3.x + s3.y + s3.z + s3.w) * (1.f / 1024.f) + EPS);
                float ss = 0.f;
#pragma unroll
                for (int ai = 0; ai < 2; ++ai)
#pragma unroll
                    for (int m = 0; m < 4; ++m) {
                        const int nrow = n0 + ai * 128 + wr * 64 + m * 16 + fq * 4;
                        const float v0 = acc[ai][bj][m][n][0] * rs, v1 = acc[ai][bj][m][n][1] * rs, v2 = acc[ai][bj][m][n][2] * rs, v3 = acc[ai][bj][m][n][3] * rs;
                        uint2 pk; pk.x = cvtpk(v0, v1); pk.y = cvtpk(v2, v3);
                        *(uint2*)(pqb + tok * 2048 + nrow) = pk;
                        ss += v0 * v0 + v1 * v1 + v2 * v2 + v3 * v3;
                    }
                { auto r1 = __builtin_amdgcn_permlane16_swap(__float_as_uint(ss), __float_as_uint(ss), false, false); ss = __uint_as_float(r1[0]) + __uint_as_float(r1[1]); }
                ss = pair_sum(ss);
                if (fq == 0) { pss[tok * 32 + (n0 >> 8) * 4 + wr] = ss; pss[tok * 32 + (n0 >> 8) * 4 + 2 + wr] = 0.f; }
            }
        __syncthreads();
    }
}

__device__ __forceinline__ unsigned ordkey(float f) { const unsigned u = __float_as_uint(f); return u ^ ((unsigned)((int)u >> 31) | 0x80000000u); }
__device__ __forceinline__ float orddec(unsigned k) { return __uint_as_float((k & 0x80000000u) ? (k & 0x7fffffffu) : ~k); }
#define CE_DESC(a, b) do { const unsigned mx_ = max(a, b), mn_ = min(a, b); a = mx_; b = mn_; } while (0)
__device__ __forceinline__ void sort16_desc(unsigned (&v)[16]) {
#define CE2(i, j) CE_DESC(v[i], v[j])
    CE2(0, 13); CE2(1, 12); CE2(2, 15); CE2(3, 14); CE2(4, 8); CE2(5, 6); CE2(7, 11); CE2(9, 10);
    CE2(0, 5); CE2(1, 7); CE2(2, 9); CE2(3, 4); CE2(6, 13); CE2(8, 14); CE2(10, 15); CE2(11, 12);
    CE2(0, 1); CE2(2, 3); CE2(4, 5); CE2(6, 8); CE2(7, 9); CE2(10, 11); CE2(12, 13); CE2(14, 15);
    CE2(0, 2); CE2(1, 3); CE2(4, 10); CE2(5, 11); CE2(6, 7); CE2(8, 9); CE2(12, 14); CE2(13, 15);
    CE2(1, 2); CE2(3, 12); CE2(4, 6); CE2(5, 7); CE2(8, 10); CE2(9, 11); CE2(13, 14);
    CE2(1, 4); CE2(2, 6); CE2(5, 8); CE2(7, 10); CE2(9, 13); CE2(11, 14);
    CE2(2, 4); CE2(3, 6); CE2(9, 12); CE2(11, 13);
    CE2(3, 5); CE2(6, 8); CE2(7, 9); CE2(10, 12);
    CE2(3, 4); CE2(5, 6); CE2(7, 8); CE2(9, 10); CE2(11, 12);
    CE2(6, 7); CE2(8, 9);
#undef CE2
}
__device__ __forceinline__ void bitonic16_desc(unsigned (&a)[16]) {
#pragma unroll
    for (int j = 8; j > 0; j >>= 1)
#pragma unroll
        for (int i = 0; i < 16; ++i) { const int l = i ^ j; if (l > i) CE_DESC(a[i], a[l]); }
}
__device__ __forceinline__ void merge16_desc(unsigned (&a)[16], const unsigned (&b)[16]) {
#pragma unroll
    for (int i = 0; i < 16; ++i) a[i] = max(a[i], b[15 - i]);
#pragma unroll
    for (int j = 8; j > 0; j >>= 1)
#pragma unroll
        for (int i = 0; i < 16; ++i) { const int l = i ^ j; if (l > i) CE_DESC(a[i], a[l]); }
}
__device__ __forceinline__ void top16_of_lanepair(unsigned (&k0)[16], unsigned (&k1)[16], unsigned (&k2)[16], unsigned (&k3)[16]) {
    sort16_desc(k0); sort16_desc(k1); sort16_desc(k2); sort16_desc(k3);
    merge16_desc(k0, k1); merge16_desc(k2, k3); merge16_desc(k0, k2);
    unsigned o[16];
#pragma unroll
    for (int i = 0; i < 16; ++i) { auto rr = __builtin_amdgcn_permlane32_swap(k0[i], k0[i], false, false); k0[i] = rr[0]; o[i] = rr[1]; }
    merge16_desc(k0, o);
}
__device__ __forceinline__ void peer_route_mfma(unsigned char* lds, const unsigned short* __restrict__ pqb, const float* __restrict__ pss, const unsigned short* __restrict__ sk16, int* __restrict__ eo, float* __restrict__ go) {
    const int tid = tid_(); const int lane = tid & 63, w = __builtin_amdgcn_readfirstlane(tid >> 6), r32 = lane & 31, hi = lane >> 5;
    const int h = blockIdx.x & 7;
    constexpr int SKP = 272;
    for (int c16 = tid; c16 < 256 * 16; c16 += 512) { const int row = c16 >> 4, ch = c16 & 15; *(uint4*)(lds + row * SKP + ch * 16) = *(const uint4*)(sk16 + ((long)h * 256 + row) * 128 + ch * 8); }
    __syncthreads();
    for (int it = 0; it < 2; ++it) {
        const long tok = (long)((blockIdx.x >> 3) * 16 + w * 2 + it) * 32 + r32;
        const float4 ps = *(const float4*)(pss + tok * 32 + h * 4);
        const float rs = rsqrtf((ps.x + ps.y + ps.z + ps.w) * (1.f / 256.f) + EPS);
        unsigned T1[16], T2[16];
#pragma unroll
        for (int c = 0; c < 2; ++c) {
            f32x16 acc[4];
#pragma unroll
            for (int mt = 0; mt < 4; ++mt)
#pragma unroll
                for (int r = 0; r < 16; ++r) acc[mt][r] = 0.f;
            const unsigned short* qrow = pqb + tok * 2048 + h * 256 + c * 128 + hi * 8;
            const unsigned char* krow = lds + (c * 128 + r32) * SKP + hi * 16;
#pragma unroll 2
            for (int ks = 0; ks < 8; ++ks) {
                const bf16x8 qf = *(const bf16x8*)(qrow + ks * 16);
#pragma unroll
                for (int mt = 0; mt < 4; ++mt) { const bf16x8 kf = *(const bf16x8*)(krow + mt * 32 * SKP + ks * 32); acc[mt] = MFMA32(kf, qf, acc[mt]); }
            }
            unsigned k0[16], k1[16], k2[16], k3[16];
#pragma unroll
            for (int r = 0; r < 16; ++r) {
                const unsigned idx = 127u - (unsigned)crow(r, hi);
                k0[r] = (ordkey(acc[0][r]) & ~127u) | idx; k1[r] = (ordkey(acc[1][r]) & ~127u) | (idx - 32u);
                k2[r] = (ordkey(acc[2][r]) & ~127u) | (idx - 64u); k3[r] = (ordkey(acc[3][r]) & ~127u) | (idx - 96u);
            }
            top16_of_lanepair(k0, k1, k2, k3);
            if (c == 0) {
#pragma unroll
                for (int i = 0; i < 16; ++i) T1[i] = k0[i];
            } else {
#pragma unroll
                for (int i = 0; i < 16; ++i) T2[i] = k0[i];
            }
        }
        float v1[16], v2[16]; unsigned p1[4] = {0u, 0u, 0u, 0u}, p2[4] = {0u, 0u, 0u, 0u};
#pragma unroll
        for (int i = 0; i < 16; ++i) {
            v1[i] = orddec(T1[i] & ~127u) * rs; v2[i] = orddec(T2[i] & ~127u) * rs;
            p1[i >> 2] |= (127u - (T1[i] & 127u)) << (8 * (i & 3)); p2[i >> 2] |= (127u - (T2[i] & 127u)) << (8 * (i & 3));
        }
        unsigned c0[16], c1[16], c2[16];
#define CAND(a, b) ((ordkey(v1[a] + v2[b]) & ~255u) | (255u - (unsigned)((a) * 16 + (b))))
        c0[0] = CAND(0, 0); c0[1] = CAND(0, 1); c0[2] = CAND(0, 2); c0[3] = CAND(0, 3); c0[4] = CAND(0, 4); c0[5] = CAND(0, 5); c0[6] = CAND(0, 6); c0[7] = CAND(0, 7);
        c0[8] = CAND(0, 8); c0[9] = CAND(0, 9); c0[10] = CAND(0, 10); c0[11] = CAND(0, 11); c0[12] = CAND(0, 12); c0[13] = CAND(0, 13); c0[14] = CAND(0, 14); c0[15] = CAND(0, 15);
        c1[0] = CAND(1, 0); c1[1] = CAND(1, 1); c1[2] = CAND(1, 2); c1[3] = CAND(1, 3); c1[4] = CAND(1, 4); c1[5] = CAND(1, 5); c1[6] = CAND(1, 6); c1[7] = CAND(1, 7);
        c1[8] = CAND(15, 0); c1[9] = CAND(14, 0); c1[10] = CAND(13, 0); c1[11] = CAND(12, 0); c1[12] = CAND(11, 0); c1[13] = CAND(10, 0); c1[14] = CAND(9, 0); c1[15] = CAND(8, 0);
        c2[0] = CAND(2, 0); c2[1] = CAND(2, 1); c2[2] = CAND(2, 2); c2[3] = CAND(2, 3); c2[4] = CAND(2, 4); c2[5] = CAND(3, 0); c2[6] = CAND(3, 1); c2[7] = CAND(3, 2);
        c2[8] = CAND(3, 3); c2[9] = CAND(4, 0); c2[10] = CAND(4, 1); c2[11] = CAND(4, 2); c2[12] = CAND(5, 0); c2[13] = CAND(5, 1); c2[14] = CAND(6, 0); c2[15] = CAND(6, 1);
        const unsigned c70 = CAND(7, 0), c71 = CAND(7, 1);
#undef CAND
        bitonic16_desc(c1); sort16_desc(c2);
        c2[15] = max(c2[15], c70); c2[14] = max(c2[14], c71); bitonic16_desc(c2);
        merge16_desc(c0, c1); merge16_desc(c0, c2);
        float ev[16]; int ee[16]; float l = 0.f; const float mx = orddec(c0[0] & ~255u);
#pragma unroll
        for (int i = 0; i < 16; ++i) {
            const unsigned ci = 255u - (c0[i] & 255u); const unsigned a = ci >> 4, b = ci & 15u;
            const unsigned wa = (a >> 2) == 0 ? p1[0] : ((a >> 2) == 1 ? p1[1] : ((a >> 2) == 2 ? p1[2] : p1[3]));
            const unsigned wb = (b >> 2) == 0 ? p2[0] : ((b >> 2) == 1 ? p2[1] : ((b >> 2) == 2 ? p2[2] : p2[3]));
            const unsigned i1 = (wa >> (8 * (a & 3u))) & 255u, i2 = (wb >> (8 * (b & 3u))) & 255u;
            ee[i] = (int)(i1 * 128u + i2);
            ev[i] = __expf(orddec(c0[i] & ~255u) - mx); l += ev[i];
        }
        const float inv = 1.f / l;
        if (hi == 0) {
            int4* ep = (int4*)(eo + tok * 128 + h * 16);
            ep[0] = make_int4(ee[0], ee[1], ee[2], ee[3]); ep[1] = make_int4(ee[4], ee[5], ee[6], ee[7]); ep[2] = make_int4(ee[8], ee[9], ee[10], ee[11]); ep[3] = make_int4(ee[12], ee[13], ee[14], ee[15]);
        } else {
            float4* gp = (float4*)(go + tok * 128 + h * 16);
            gp[0] = make_float4(ev[0] * inv, ev[1] * inv, ev[2] * inv, ev[3] * inv); gp[1] = make_float4(ev[4] * inv, ev[5] * inv, ev[6] * inv, ev[7] * inv);
            gp[2] = make_float4(ev[8] * inv, ev[9] * inv, ev[10] * inv, ev[11] * inv); gp[3] = make_float4(ev[12] * inv, ev[13] * inv, ev[14] * inv, ev[15] * inv);
        }
    }
}

template <int DQK>
struct FA {
    static constexpr int NDS = DQK / 16, KP = DQK * 2 + 16, KBYTES = 64 * KP, VP = 144, VBYTES = 64 * VP, STAGE = KBYTES + VBYTES;
    static constexpr int KCH = 64 * DQK / 8, NCH = KCH + 512, SLOTS = (NCH + 511) / 512;
};
constexpr float FA_THR = 8.f;
constexpr float FA_NEG = -1e30f;
struct FaRegs { uint4 g0, g1, g2; };
template <int DQK>
__device__ __forceinline__ uint4 fa_load1(const unsigned short* __restrict__ Kg, int kpitch, const unsigned short* __restrict__ Vg, int vpitch, int tid, int i) {
    int c = tid + i * 512; if (c >= FA<DQK>::NCH) c = 0;
    const int key = c / (DQK / 8), kc = c % (DQK / 8); const int c2 = c - FA<DQK>::KCH; const int d = c2 >> 3, vc = c2 & 7;
    const unsigned koff = (unsigned)(key * kpitch + kc * 8) * 2u, voff = (unsigned)(d * vpitch + vc * 8) * 2u;
#if defined(__HIP_DEVICE_COMPILE__)
    typedef unsigned u32x4_t __attribute__((ext_vector_type(4)));
    const u32x4_t v = (c < FA<DQK>::KCH) ? *(const AS1 u32x4_t*)((const AS1 char*)Kg + koff) : *(const AS1 u32x4_t*)((const AS1 char*)Vg + voff);
    return make_uint4(v.x, v.y, v.z, v.w);
#else
    (void)koff; (void)voff; return make_uint4(0u, 0u, 0u, 0u);
#endif
}
template <int DQK>
__device__ __forceinline__ void fa_store1(unsigned char* st, const uint4& g, int tid, int i) {
    const int c = tid + i * 512;
    const int key = c / (DQK / 8), kc = c % (DQK / 8); const int c2 = c - FA<DQK>::KCH; const int d = c2 >> 3, vc = c2 & 7;
    const int off = (c < FA<DQK>::KCH) ? (key * FA<DQK>::KP + kc * 16) : (FA<DQK>::KBYTES + d * FA<DQK>::VP + vc * 16);
    if (c < FA<DQK>::NCH) *(uint4*)(st + off) = g;
}
template <int DQK>
__device__ __forceinline__ void fa_load(const unsigned short* __restrict__ Kg, int kpitch, const unsigned short* __restrict__ Vg, int vpitch, FaRegs& g, int tid) {
    g.g0 = fa_load1<DQK>(Kg, kpitch, Vg, vpitch, tid, 0); g.g1 = fa_load1<DQK>(Kg, kpitch, Vg, vpitch, tid, 1);
    if (FA<DQK>::SLOTS > 2) g.g2 = fa_load1<DQK>(Kg, kpitch, Vg, vpitch, tid, 2);
}
template <int DQK>
__device__ __forceinline__ void fa_store(unsigned char* st, const FaRegs& g, int tid) {
    fa_store1<DQK>(st, g.g0, tid, 0); fa_store1<DQK>(st, g.g1, tid, 1);
    if (FA<DQK>::SLOTS > 2) fa_store1<DQK>(st, g.g2, tid, 2);
}
template <int DQK, int MODE, bool STATS_ONLY = false>
__device__ __forceinline__ void fa_tile(const unsigned char* st, const bf16x8 (&qf)[FA<DQK>::NDS], f32x16 (&o)[2], float& mref, float& l, int key0, int qpos, int lane, bool need_mask, bool colsel = true) {
    asm volatile("" : "+v"(lane));
    const int r32 = lane & 31, hi = lane >> 5;
    f32x16 s0, s1;
#pragma unroll
    for (int r = 0; r < 16; ++r) { s0[r] = 0.f; s1[r] = 0.f; }
    {
        bf16x8 k0 = *(const bf16x8*)(st + r32 * FA<DQK>::KP + hi * 16);
        bf16x8 k1 = *(const bf16x8*)(st + (32 + r32) * FA<DQK>::KP + hi * 16);
#pragma unroll
        for (int ds = 0; ds < FA<DQK>::NDS; ++ds) {
            bf16x8 n0 = k0, n1 = k1;
            if (ds + 1 < FA<DQK>::NDS) {
                n0 = *(const bf16x8*)(st + r32 * FA<DQK>::KP + (ds + 1) * 32 + hi * 16);
                n1 = *(const bf16x8*)(st + (32 + r32) * FA<DQK>::KP + (ds + 1) * 32 + hi * 16);
            }
            s0 = MFMA32(k0, qf[ds], s0); s1 = MFMA32(k1, qf[ds], s1);
            k0 = n0; k1 = n1;
            __builtin_amdgcn_sched_barrier(0);
        }
    }
    __builtin_amdgcn_sched_barrier(0);
    if (MODE != 0 && need_mask) {
#pragma unroll
        for (int r = 0; r < 16; ++r) {
            const int ka = key0 + crow(r, hi), kb = ka + 32;
            bool ma, mb;
            if (MODE == 4) { ma = 16 * ka + 31 > qpos; mb = 16 * kb + 31 > qpos; }
            else { ma = ka > qpos; mb = kb > qpos; }
            if (MODE == 2) { ma = ma || (ka <= qpos - 512); mb = mb || (kb <= qpos - 512); }
            if (ma) s0[r] = -INFINITY;
            if (mb) s1[r] = -INFINITY;
        }
    }
    float mxa = max3f(s0[0], s0[1], s0[2]), mxb = max3f(s1[0], s1[1], s1[2]);
#pragma unroll
    for (int r = 3; r < 15; r += 2) { mxa = max3f(mxa, s0[r], s0[r + 1]); mxb = max3f(mxb, s1[r], s1[r + 1]); }
    float mx = max3f(mxa, mxb, fmaxf(s0[15], s1[15]));
    if (MODE == 3) mx = colsel ? mx : -INFINITY;
    mx = pair_max(mx);
    if (__any(mx > mref + FA_THR)) {
        const float mnew = (mx > mref + FA_THR) ? mx : mref;
        const float alpha = __builtin_amdgcn_exp2f(mref - mnew);
        mref = mnew; l *= alpha;
#pragma unroll
        for (int r = 0; r < 16; ++r) { o[0][r] *= alpha; o[1][r] *= alpha; }
    }
    const float mre = (MODE == 3) ? (colsel ? mref : INFINITY) : mref;
    const f32x2_t mm = {mre, mre};
    f32x2_t ps0 = {0.f, 0.f}, ps1 = {0.f, 0.f};
#pragma unroll
    for (int r = 0; r < 16; r += 2) {
        const f32x2_t d0 = f32x2_t{s0[r], s0[r + 1]} - mm, d1 = f32x2_t{s1[r], s1[r + 1]} - mm;
        s0[r] = __builtin_amdgcn_exp2f(d0.x); s0[r + 1] = __builtin_amdgcn_exp2f(d0.y); s1[r] = __builtin_amdgcn_exp2f(d1.x); s1[r + 1] = __builtin_amdgcn_exp2f(d1.y);
        ps0 += f32x2_t{s0[r], s0[r + 1]}; ps1 += f32x2_t{s1[r], s1[r + 1]};
    }
    ps0 += ps1;
    l += ps0.x + ps0.y;
    if (STATS_ONLY) return;
    bf16x8 pk[4];
#pragma unroll
    for (int s = 0; s < 2; ++s) {
        uint4 a, b;
        a.x = cvtpk(s0[8 * s], s0[8 * s + 1]); a.y = cvtpk(s0[8 * s + 2], s0[8 * s + 3]); a.z = cvtpk(s0[8 * s + 4], s0[8 * s + 5]); a.w = cvtpk(s0[8 * s + 6], s0[8 * s + 7]);
        b.x = cvtpk(s1[8 * s], s1[8 * s + 1]); b.y = cvtpk(s1[8 * s + 2], s1[8 * s + 3]); b.z = cvtpk(s1[8 * s + 4], s1[8 * s + 5]); b.w = cvtpk(s1[8 * s + 6], s1[8 * s + 7]);
        pk[s] = __builtin_bit_cast(bf16x8, a); pk[2 + s] = __builtin_bit_cast(bf16x8, b);
    }
    const unsigned char* vt = st + FA<DQK>::KBYTES;
    __builtin_amdgcn_sched_barrier(0);
    {
        bf16x8 v0 = *(const bf16x8*)(vt + r32 * FA<DQK>::VP + hi * 16);
        bf16x8 v1 = *(const bf16x8*)(vt + (32 + r32) * FA<DQK>::VP + hi * 16);
#pragma unroll
        for (int ks = 0; ks < 4; ++ks) {
            bf16x8 n0 = v0, n1 = v1;
            if (ks + 1 < 4) {
                n0 = *(const bf16x8*)(vt + r32 * FA<DQK>::VP + (ks + 1) * 32 + hi * 16);
                n1 = *(const bf16x8*)(vt + (32 + r32) * FA<DQK>::VP + (ks + 1) * 32 + hi * 16);
            }
            o[0] = MFMA32(v0, pk[ks], o[0]); o[1] = MFMA32(v1, pk[ks], o[1]);
            v0 = n0; v1 = n1;
            __builtin_amdgcn_sched_barrier(0);
        }
    }
}
template <int DQK>
__device__ __forceinline__ void fa_qk(const unsigned char* st, const bf16x8 (&qf)[FA<DQK>::NDS], f32x16& s0, f32x16& s1, int lane) {
    const int r32 = lane & 31, hi = lane >> 5;
#pragma unroll
    for (int r = 0; r < 16; ++r) { s0[r] = 0.f; s1[r] = 0.f; }
#pragma unroll
    for (int ds = 0; ds < FA<DQK>::NDS; ++ds) {
        const bf16x8 k0 = *(const bf16x8*)(st + r32 * FA<DQK>::KP + ds * 32 + hi * 16);
        const bf16x8 k1 = *(const bf16x8*)(st + (32 + r32) * FA<DQK>::KP + ds * 32 + hi * 16);
        s0 = MFMA32(k0, qf[ds], s0); s1 = MFMA32(k1, qf[ds], s1);
    }
}
template <int DQK, int MODE>
__device__ __forceinline__ void fa_step(const unsigned char* stc, const unsigned char* stn, const bf16x8 (&qf)[FA<DQK>::NDS], f32x16& s0, f32x16& s1, f32x16& n0, f32x16& n1,
                                        f32x16 (&o)[2], float& mref, float& l, int key0, int qpos, int lane, bool need_mask, bool colsel = true) {
    const int r32 = lane & 31, hi = lane >> 5;
    if (MODE != 0 && need_mask) {
#pragma unroll
        for (int r = 0; r < 16; ++r) {
            const int ka = key0 + crow(r, hi), kb = ka + 32;
            bool ma, mb;
            if (MODE == 4) { ma = 16 * ka + 31 > qpos; mb = 16 * kb + 31 > qpos; }
            else { ma = ka > qpos; mb = kb > qpos; }
            if (MODE == 2) { ma = ma || (ka <= qpos - 512); mb = mb || (kb <= qpos - 512); }
            if (ma) s0[r] = -INFINITY;
            if (mb) s1[r] = -INFINITY;
        }
    }
    float mxa = max3f(s0[0], s0[1], s0[2]), mxb = max3f(s1[0], s1[1], s1[2]);
#pragma unroll
    for (int r = 3; r < 15; r += 2) { mxa = max3f(mxa, s0[r], s0[r + 1]); mxb = max3f(mxb, s1[r], s1[r + 1]); }
    float mx = max3f(mxa, mxb, fmaxf(s0[15], s1[15]));
    if (MODE == 3) mx = colsel ? mx : -INFINITY;
    mx = pair_max(mx);
    if (__any(mx > mref + FA_THR)) {
        const float mnew = (mx > mref + FA_THR) ? mx : mref;
        const float alpha = __builtin_amdgcn_exp2f(mref - mnew);
        mref = mnew; l *= alpha;
#pragma unroll
        for (int r = 0; r < 16; ++r) { o[0][r] *= alpha; o[1][r] *= alpha; }
    }
    const float mre = (MODE == 3) ? (colsel ? mref : INFINITY) : mref;
    const f32x2_t mm = {mre, mre};
    __builtin_amdgcn_sched_barrier(0);
#pragma unroll
    for (int r = 0; r < 16; ++r) { n0[r] = 0.f; n1[r] = 0.f; }
    f32x2_t ps = {0.f, 0.f};
    constexpr int PER = (16 + FA<DQK>::NDS - 1) / FA<DQK>::NDS;
    {
        bf16x8 k0 = *(const bf16x8*)(stn + r32 * FA<DQK>::KP + hi * 16);
        bf16x8 k1 = *(const bf16x8*)(stn + (32 + r32) * FA<DQK>::KP + hi * 16);
#pragma unroll
        for (int ds = 0; ds < FA<DQK>::NDS; ++ds) {
            bf16x8 f0 = k0, f1 = k1;
            if (ds + 1 < FA<DQK>::NDS) {
                f0 = *(const bf16x8*)(stn + r32 * FA<DQK>::KP + (ds + 1) * 32 + hi * 16);
                f1 = *(const bf16x8*)(stn + (32 + r32) * FA<DQK>::KP + (ds + 1) * 32 + hi * 16);
            }
            n0 = MFMA32(k0, qf[ds], n0); n1 = MFMA32(k1, qf[ds], n1);
#pragma unroll
            for (int j = ds * PER; j < (ds + 1) * PER && j < 16; ++j) {
                if (j < 8) { const f32x2_t d = f32x2_t{s0[2 * j], s0[2 * j + 1]} - mm; s0[2 * j] = __builtin_amdgcn_exp2f(d.x); s0[2 * j + 1] = __builtin_amdgcn_exp2f(d.y); ps += f32x2_t{s0[2 * j], s0[2 * j + 1]}; }
                else { const int q = j - 8; const f32x2_t d = f32x2_t{s1[2 * q], s1[2 * q + 1]} - mm; s1[2 * q] = __builtin_amdgcn_exp2f(d.x); s1[2 * q + 1] = __builtin_amdgcn_exp2f(d.y); ps += f32x2_t{s1[2 * q], s1[2 * q + 1]}; }
            }
            asm volatile("" : "+v"(ps));
            k0 = f0; k1 = f1;
            __builtin_amdgcn_sched_barrier(0);
        }
    }
    l += ps.x + ps.y;
    bf16x8 pk[4];
#pragma unroll
    for (int s = 0; s < 2; ++s) {
        uint4 a, b;
        a.x = cvtpk(s0[8 * s], s0[8 * s + 1]); a.y = cvtpk(s0[8 * s + 2], s0[8 * s + 3]); a.z = cvtpk(s0[8 * s + 4], s0[8 * s + 5]); a.w = cvtpk(s0[8 * s + 6], s0[8 * s + 7]);
        b.x = cvtpk(s1[8 * s], s1[8 * s + 1]); b.y = cvtpk(s1[8 * s + 2], s1[8 * s + 3]); b.z = cvtpk(s1[8 * s + 4], s1[8 * s + 5]); b.w = cvtpk(s1[8 * s + 6], s1[8 * s + 7]);
        pk[s] = __builtin_bit_cast(bf16x8, a); pk[2 + s] = __builtin_bit_cast(bf16x8, b);
    }
    const unsigned char* vt = stc + FA<DQK>::KBYTES;
    {
        bf16x8 v0 = *(const bf16x8*)(vt + r32 * FA<DQK>::VP + hi * 16);
        bf16x8 v1 = *(const bf16x8*)(vt + (32 + r32) * FA<DQK>::VP + hi * 16);
#pragma unroll
        for (int ks = 0; ks < 4; ++ks) {
            bf16x8 f0 = v0, f1 = v1;
            if (ks + 1 < 4) {
                f0 = *(const bf16x8*)(vt + r32 * FA<DQK>::VP + (ks + 1) * 32 + hi * 16);
                f1 = *(const bf16x8*)(vt + (32 + r32) * FA<DQK>::VP + (ks + 1) * 32 + hi * 16);
            }
            o[0] = MFMA32(v0, pk[ks], o[0]); o[1] = MFMA32(v1, pk[ks], o[1]);
            v0 = f0; v1 = f1;
            __builtin_amdgcn_sched_barrier(0);
        }
    }
}
__device__ __forceinline__ int vperm(int s) { const int g = (s >> 2) & 3; const int pg = (g == 1) ? 2 : ((g == 2) ? 1 : g); return (s & ~15) | (pg << 2) | (s & 3); }

constexpr float MLA_QSCALE = 0.10206207261596575f * 1.4426950408889634f;
__device__ __forceinline__ void mla_unit(unsigned char* lds, int b, int h, int qb, const unsigned short* __restrict__ Q16, const unsigned short* __restrict__ K16, const unsigned short* __restrict__ VT16,
                                         unsigned short* __restrict__ ob16, float* __restrict__ ssqb, int tid) {
    typedef FA<96> F;
    const int lane = tid & 63, wave = __builtin_amdgcn_readfirstlane(tid >> 6), r32 = lane & 31, hi = lane >> 5;
    const int q0 = qb * 256, qpos = q0 + wave * 32 + r32; const long tok = (long)b * S_ + qpos;
    bf16x8 qf[F::NDS];
#pragma unroll
    for (int ds = 0; ds < F::NDS; ++ds) qf[ds] = *(const bf16x8*)(Q16 + tok * 768 + h * 96 + ds * 16 + hi * 8);
    f32x16 o[2];
#pragma unroll
    for (int r = 0; r < 16; ++r) { o[0][r] = 0.f; o[1][r] = 0.f; }
    float mref = FA_NEG, l = 0.f;
    const unsigned short* Kb = K16 + ((long)(b * 8 + h)) * S_ * 96;
    const unsigned short* Vb = VT16 + ((long)(b * 8 + h)) * 64 * S_;
    const int nt = (q0 + 256) / 64;
    FaRegs g;
    fa_load<96>(Kb, 96, Vb, S_, g, tid); fa_store<96>(lds, g, tid);
    fa_load<96>(Kb + (long)64 * 96, 96, Vb + 64, S_, g, tid); fa_store<96>(lds + F::STAGE, g, tid);
    __syncthreads();
    const int wmin = q0 + wave * 32, wmax = wmin + 31;
    f32x16 sa0, sa1, sb0, sb1;
    fa_qk<96>(lds, qf, sa0, sa1, lane);
#define MLA_STEP(C0, C1, N0, N1, t) do { \
        const int sc_ = (t) % 3, sn_ = ((t) + 1) % 3, sw_ = ((t) + 2) % 3; \
        if ((t) + 2 < nt) fa_load<96>(Kb + (long)((t) + 2) * 64 * 96, 96, Vb + ((t) + 2) * 64, S_, g, tid); \
        const int key0 = (t) * 64; \
        if (key0 <= wmax) fa_step<96, 1>(lds + sc_ * F::STAGE, lds + sn_ * F::STAGE, qf, C0, C1, N0, N1, o, mref, l, key0, qpos, lane, key0 + 63 > wmin); \
        if ((t) + 2 < nt) fa_store<96>(lds + sw_ * F::STAGE, g, tid); \
        __syncthreads(); } while (0)
    for (int t = 0; t < nt; t += 2) {
        MLA_STEP(sa0, sa1, sb0, sb1, t);
        MLA_STEP(sb0, sb1, sa0, sa1, t + 1);
    }
#undef MLA_STEP
    l = pair_sum(l);
    const float inv = 1.f / l;
    float ss = 0.f;
#pragma unroll
    for (int dt = 0; dt < 2; ++dt)
#pragma unroll
        for (int gq = 0; gq < 4; ++gq) {
            const float v0 = o[dt][4 * gq] * inv, v1 = o[dt][4 * gq + 1] * inv, v2 = o[dt][4 * gq + 2] * inv, v3 = o[dt][4 * gq + 3] * inv;
            uint2 pk; pk.x = cvtpk(v0, v1); pk.y = cvtpk(v2, v3);
            *(uint2*)(ob16 + tok * 1024 + 512 + h * 64 + dt * 32 + 8 * gq + 4 * hi) = pk;
            ss += v0 * v0 + v1 * v1 + v2 * v2 + v3 * v3;
        }
    ss = pair_sum(ss);
    if (hi == 0) ssqb[(long)h * T_ + tok] = ss;
}
__device__ __forceinline__ void mla_phase(unsigned char* lds, const unsigned short* __restrict__ Q16, const unsigned short* __restrict__ K16, const unsigned short* __restrict__ VT16,
                                          unsigned short* __restrict__ ob16, float* __restrict__ ssqb) {
    const int tid = tid_();
    for (int i = blockIdx.x; i < 256; i += NBLK) {
        const int xcd = i & 7, slot = i >> 3;
        { const int bh = xcd * 2; mla_unit(lds, bh >> 3, bh & 7, 31 - slot, Q16, K16, VT16, ob16, ssqb, tid); }
        { const int bh = xcd * 2 + 1; mla_unit(lds, bh >> 3, bh & 7, slot, Q16, K16, VT16, ob16, ssqb, tid); }
    }
}
constexpr float NSA_QSCALE = 0.125f * 1.4426950408889634f;
constexpr int IMP_PITCH = 129;
__device__ __forceinline__ void fa_tile_cmp2(const unsigned char* st, const bf16x8 (&qf)[4], f32x16 (&o)[2], float mref, float linv, int key0, int qpos, int lane, float* imp_row, bool need_mask) {
    typedef FA<64> F;
    asm volatile("" : "+v"(lane));
    const int r32 = lane & 31, hi = lane >> 5;
    f32x16 s0, s1;
#pragma unroll
    for (int r = 0; r < 16; ++r) { s0[r] = 0.f; s1[r] = 0.f; }
#pragma unroll
    for (int ds = 0; ds < 4; ++ds) {
        const bf16x8 k0 = *(const bf16x8*)(st + r32 * F::KP + ds * 32 + hi * 16);
        const bf16x8 k1 = *(const bf16x8*)(st + (32 + r32) * F::KP + ds * 32 + hi * 16);
        s0 = MFMA32(k0, qf[ds], s0); s1 = MFMA32(k1, qf[ds], s1);
    }
    {
        const f32x2_t mm = {mref, mref}, ll = {linv, linv};
#pragma unroll
        for (int r = 0; r < 16; r += 2) {
            const f32x2_t d0 = f32x2_t{s0[r], s0[r + 1]} - mm, d1 = f32x2_t{s1[r], s1[r + 1]} - mm;
            const f32x2_t p0 = f32x2_t{__builtin_amdgcn_exp2f(d0.x), __builtin_amdgcn_exp2f(d0.y)} * ll, p1 = f32x2_t{__builtin_amdgcn_exp2f(d1.x), __builtin_amdgcn_exp2f(d1.y)} * ll;
            s0[r] = p0.x; s0[r + 1] = p0.y; s1[r] = p1.x; s1[r + 1] = p1.y;
        }
    }
    if (need_mask) {
#pragma unroll
        for (int r = 0; r < 16; ++r) {
            const int ka = key0 + crow(r, hi), kb = ka + 32;
            if (16 * ka + 31 > qpos) s0[r] = 0.f;
            if (16 * kb + 31 > qpos) s1[r] = 0.f;
        }
    }
    bf16x8 pk[4];
#pragma unroll
    for (int s = 0; s < 2; ++s) {
        uint4 a, b;
        a.x = cvtpk(s0[8 * s], s0[8 * s + 1]); a.y = cvtpk(s0[8 * s + 2], s0[8 * s + 3]); a.z = cvtpk(s0[8 * s + 4], s0[8 * s + 5]); a.w = cvtpk(s0[8 * s + 6], s0[8 * s + 7]);
        b.x = cvtpk(s1[8 * s], s1[8 * s + 1]); b.y = cvtpk(s1[8 * s + 2], s1[8 * s + 3]); b.z = cvtpk(s1[8 * s + 4], s1[8 * s + 5]); b.w = cvtpk(s1[8 * s + 6], s1[8 * s + 7]);
        pk[s] = __builtin_bit_cast(bf16x8, a); pk[2 + s] = __builtin_bit_cast(bf16x8, b);
    }
    const unsigned char* vt = st + F::KBYTES;
#pragma unroll
    for (int ks = 0; ks < 4; ++ks) {
        const bf16x8 v0 = *(const bf16x8*)(vt + r32 * F::VP + ks * 32 + hi * 16);
        const bf16x8 v1 = *(const bf16x8*)(vt + (32 + r32) * F::VP + ks * 32 + hi * 16);
        o[0] = MFMA32(v0, pk[ks], o[0]); o[1] = MFMA32(v1, pk[ks], o[1]);
    }
#pragma unroll
    for (int g4 = 0; g4 < 4; ++g4) {
        const float qa = quad_sum(s0[4 * g4] + s0[4 * g4 + 1] + s0[4 * g4 + 2] + s0[4 * g4 + 3]), la = quad_sum(s0[4 * g4 + 3]);
        const float qb = quad_sum(s1[4 * g4] + s1[4 * g4 + 1] + s1[4 * g4 + 2] + s1[4 * g4 + 3]), lb = quad_sum(s1[4 * g4 + 3]);
        if ((lane & 3) == 0) {
            { const int j = (key0 + 8 * g4 + 4 * hi) >> 2;
              atomicAdd(imp_row + j, qa);
              if (j + 1 < 128) atomicAdd(imp_row + j + 1, la); }
            { const int j = (key0 + 32 + 8 * g4 + 4 * hi) >> 2;
              atomicAdd(imp_row + j, qb);
              if (j + 1 < 128) atomicAdd(imp_row + j + 1, lb); }
        }
    }
}
#define NSA_STEP_(GCUR, GNEXT, Kbase, kpitch, Vbase, vpitch, t_lo, t_hi, t_, ...) do { \
        const unsigned char* st = stg + (((t_) - (t_lo)) & 1) * FA<64>::STAGE; \
        if ((t_) + 2 <= (t_hi)) fa_load<64>((Kbase) + (long)((t_) + 2) * 64 * (kpitch), (kpitch), (Vbase) + ((t_) + 2) * 64, (vpitch), GCUR, tid); \
        const int key0 = (t_) * 64; (void)key0; \
        __VA_ARGS__ \
        if ((t_) + 1 <= (t_hi)) fa_store<64>(stg + (((t_) + 1 - (t_lo)) & 1) * FA<64>::STAGE, GNEXT, tid); \
        __syncthreads(); } while (0)
#define NSA_STREAM(Kbase, kpitch, Vbase, vpitch, t_lo, t_hi, ...) do { \
    FaRegs ga_, gb_; fa_load<64>((Kbase) + (long)(t_lo) * 64 * (kpitch), (kpitch), (Vbase) + (t_lo) * 64, (vpitch), ga_, tid); \
    if ((t_lo) + 1 <= (t_hi)) fa_load<64>((Kbase) + (long)((t_lo) + 1) * 64 * (kpitch), (kpitch), (Vbase) + ((t_lo) + 1) * 64, (vpitch), gb_, tid); \
    fa_store<64>(stg, ga_, tid); __syncthreads(); \
    for (int t_ = (t_lo); t_ <= (t_hi); t_ += 2) { \
        NSA_STEP_(ga_, gb_, Kbase, kpitch, Vbase, vpitch, t_lo, t_hi, t_, __VA_ARGS__); \
        if (t_ + 1 <= (t_hi)) { const int tt_ = t_ + 1; NSA_STEP2_(gb_, ga_, Kbase, kpitch, Vbase, vpitch, t_lo, t_hi, tt_, __VA_ARGS__); } \
    } } while (0)
#define NSA_STEP2_(GCUR, GNEXT, Kbase, kpitch, Vbase, vpitch, t_lo, t_hi, tq_, ...) do { \
        const int t_ = tq_; \
        const unsigned char* st = stg + ((t_ - (t_lo)) & 1) * FA<64>::STAGE; \
        if (t_ + 2 <= (t_hi)) fa_load<64>((Kbase) + (long)(t_ + 2) * 64 * (kpitch), (kpitch), (Vbase) + (t_ + 2) * 64, (vpitch), GCUR, tid); \
        const int key0 = t_ * 64; (void)key0; \
        __VA_ARGS__ \
        if (t_ + 1 <= (t_hi)) fa_store<64>(stg + ((t_ + 1 - (t_lo)) & 1) * FA<64>::STAGE, GNEXT, tid); \
        __syncthreads(); } while (0)

__device__ __forceinline__ void nsa_unit(unsigned char* lds, int b, int g, int qblk, const unsigned short* __restrict__ Q16A, const unsigned short* __restrict__ KC16, const unsigned short* __restrict__ VCT16,
                                         const unsigned short* __restrict__ KS16, const unsigned short* __restrict__ VST16, const unsigned short* __restrict__ KW16, const unsigned short* __restrict__ VWT16,
                                         const float* __restrict__ gates, unsigned short* __restrict__ oa16, float* __restrict__ ssqa, int tid) {
    typedef FA<64> F;
    const int lane = tid & 63, wave = __builtin_amdgcn_readfirstlane(tid >> 6), r32 = lane & 31, hi = lane >> 5;
    unsigned char* stg = lds;
    float* imp = (float*)(lds + 2 * F::STAGE);
    unsigned* selm = (unsigned*)(lds + 2 * F::STAGE + 64 * IMP_PITCH * 4);
    const int q0 = qblk * 64, cur = qblk;
    const int ql = wave * 8 + (r32 >> 2), hh = g * 4 + (r32 & 3), qpos = q0 + ql; const long tok = (long)b * S_ + qpos; const int bg = b * 2 + g;
    bf16x8 qf[4];
#pragma unroll
    for (int ds = 0; ds < 4; ++ds) qf[ds] = *(const bf16x8*)(Q16A + tok * 512 + hh * 64 + ds * 16 + hi * 8);
    for (int i = tid; i < 64 * IMP_PITCH; i += 512) imp[i] = 0.f;
    f32x16 acc[2], o[2];
#pragma unroll
    for (int r = 0; r < 16; ++r) { acc[0][r] = 0.f; acc[1][r] = 0.f; }
    const int wq_lo = q0 + wave * 8, wq_hi = wq_lo + 7;
    const int nvis_max = (q0 + 63 >= 31) ? ((q0 + 63 - 31) / 16 + 1) : 0;
    if (nvis_max > 0) {
        const int tc_hi = (nvis_max - 1) >> 6;
        const unsigned short* Kc = KC16 + (long)bg * 512 * 64; const unsigned short* Vc = VCT16 + (long)bg * 64 * 512;
        float mref = FA_NEG, l = 0.f;
        NSA_STREAM(Kc, 64, Vc, 512, 0, tc_hi, {
            if (16 * key0 + 31 <= wq_hi) fa_tile<64, 4, true>(st, qf, o, mref, l, key0, qpos, lane, 16 * (key0 + 63) + 31 > wq_lo);
        });
        l = pair_sum(l);
        const float linv = (l > 0.f) ? 1.f / l : 0.f;
#pragma unroll
        for (int r = 0; r < 16; ++r) { o[0][r] = 0.f; o[1][r] = 0.f; }
        NSA_STREAM(Kc, 64, Vc, 512, 0, tc_hi, {
            if (16 * key0 + 31 <= wq_hi) fa_tile_cmp2(st, qf, o, mref, linv, key0, qpos, lane, imp + ql * IMP_PITCH, 16 * (key0 + 63) + 31 > wq_lo);
        });
        const float g_c = gates[tok * 24 + hh * 3];
#pragma unroll
        for (int r = 0; r < 16; ++r) { acc[0][r] += g_c * o[0][r]; acc[1][r] += g_c * o[1][r]; }
    } else { __syncthreads(); }
    if (wave < 2) {
        const int qi = wave * 32 + r32;
        int his = hi; asm volatile("" : "+v"(his));
#define IMPKEY(jj) ({ const int j_ = (jj); const float v_ = (j_ == 0 || j_ == cur) ? 1e9f : ((j_ > cur) ? -1e30f : imp[qi * IMP_PITCH + j_]); (ordkey(v_) & ~127u) | (127u - (unsigned)j_); })
        unsigned k0[16];
        {
            unsigned k1[16];
#pragma unroll
            for (int i = 0; i < 16; ++i) { k0[i] = IMPKEY(his * 64 + i); k1[i] = IMPKEY(his * 64 + 16 + i); }
            sort16_desc(k0); sort16_desc(k1); merge16_desc(k0, k1);
        }
        __builtin_amdgcn_sched_barrier(0);
        {
            unsigned k2[16], k3[16];
#pragma unroll
            for (int i = 0; i < 16; ++i) { k2[i] = IMPKEY(his * 64 + 32 + i); k3[i] = IMPKEY(his * 64 + 48 + i); }
            sort16_desc(k2); sort16_desc(k3); merge16_desc(k2, k3); merge16_desc(k0, k2);
        }
#undef IMPKEY
        {
            unsigned o2[16];
#pragma unroll
            for (int i = 0; i < 16; ++i) { auto rr = __builtin_amdgcn_permlane32_swap(k0[i], k0[i], false, false); k0[i] = rr[0]; o2[i] = rr[1]; }
            merge16_desc(k0, o2);
        }
        unsigned m0 = 0u, m1 = 0u, m2 = 0u, m3 = 0u;
#pragma unroll
        for (int i = 0; i < 16; ++i) {
            const unsigned j = 127u - (k0[i] & 127u); const unsigned bit = 1u << (j & 31u); const unsigned wsel = j >> 5;
            m0 |= (wsel == 0u) ? bit : 0u; m1 |= (wsel == 1u) ? bit : 0u; m2 |= (wsel == 2u) ? bit : 0u; m3 |= (wsel == 3u) ? bit : 0u;
        }
        if (hi == 0) { selm[qi * 4] = m0; selm[qi * 4 + 1] = m1; selm[qi * 4 + 2] = m2; selm[qi * 4 + 3] = m3; }
    }
    __syncthreads();
    unsigned sm0 = selm[ql * 4], sm1 = selm[ql * 4 + 1], sm2 = selm[ql * 4 + 2], sm3 = selm[ql * 4 + 3];
    {
        float mref = FA_NEG, l = 0.f;
#pragma unroll
        for (int r = 0; r < 16; ++r) { o[0][r] = 0.f; o[1][r] = 0.f; }
        const unsigned short* Ks = KS16 + (long)bg * S_ * 64; const unsigned short* Vs = VST16 + (long)bg * 64 * S_;
        NSA_STREAM(Ks, 64, Vs, S_, 0, cur, {
            const int jw = t_ >> 5; const unsigned wsel = (jw == 0) ? sm0 : ((jw == 1) ? sm1 : ((jw == 2) ? sm2 : sm3));
            const bool colsel = (wsel >> (t_ & 31)) & 1u;
            if (__any(colsel)) fa_tile<64, 3>(st, qf, o, mref, l, key0, qpos, lane, t_ == cur, colsel);
        });
        l = pair_sum(l);
        const float sc = gates[tok * 24 + hh * 3 + 1] / l;
#pragma unroll
        for (int r = 0; r < 16; ++r) { acc[0][r] += sc * o[0][r]; acc[1][r] += sc * o[1][r]; }
    }
    {
        float mref = FA_NEG, l = 0.f;
#pragma unroll
        for (int r = 0; r < 16; ++r) { o[0][r] = 0.f; o[1][r] = 0.f; }
        const unsigned short* Kw = KW16 + (long)bg * S_ * 64; const unsigned short* Vw = VWT16 + (long)bg * 64 * S_;
        const int tw_lo = (cur >= 8) ? cur - 8 : 0;
        NSA_STREAM(Kw, 64, Vw, S_, tw_lo, cur, {
            fa_tile<64, 2>(st, qf, o, mref, l, key0, qpos, lane, (t_ == cur) || (t_ == cur - 8));
        });
        l = pair_sum(l);
        const float sc = gates[tok * 24 + hh * 3 + 2] / l;
#pragma unroll
        for (int r = 0; r < 16; ++r) { acc[0][r] += sc * o[0][r]; acc[1][r] += sc * o[1][r]; }
    }
    float ss = 0.f;
#pragma unroll
    for (int dt = 0; dt < 2; ++dt)
#pragma unroll
        for (int gq = 0; gq < 4; ++gq) {
            const float v0 = acc[dt][4 * gq], v1 = acc[dt][4 * gq + 1], v2 = acc[dt][4 * gq + 2], v3 = acc[dt][4 * gq + 3];
            uint2 pk; pk.x = cvtpk(v0, v1); pk.y = cvtpk(v2, v3);
            *(uint2*)(oa16 + tok * 1024 + hh * 64 + dt * 32 + 8 * gq + 4 * hi) = pk;
            ss += v0 * v0 + v1 * v1 + v2 * v2 + v3 * v3;
        }
    ss = pair_sum(ss);
    if (hi == 0) ssqa[(long)hh * T_ + tok] = ss;
    __syncthreads();
}
__device__ __forceinline__ void nsa_phase(unsigned char* lds, const unsigned short* __restrict__ Q16A, const unsigned short* __restrict__ KC16, const unsigned short* __restrict__ VCT16,
                                          const unsigned short* __restrict__ KS16, const unsigned short* __restrict__ VST16, const unsigned short* __restrict__ KW16, const unsigned short* __restrict__ VWT16,
                                          const float* __restrict__ gates, unsigned short* __restrict__ oa16, float* __restrict__ ssqa) {
    const int tid = tid_();
    for (int i = blockIdx.x; i < 256; i += NBLK) {
        const int xcd = i & 7, slot = i >> 3; const int bg = xcd >> 1, pr = (xcd & 1) * 32 + slot;
        nsa_unit(lds, bg >> 1, bg & 1, 127 - pr, Q16A, KC16, VCT16, KS16, VST16, KW16, VWT16, gates, oa16, ssqa, tid);
        nsa_unit(lds, bg >> 1, bg & 1, pr, Q16A, KC16, VCT16, KS16, VST16, KW16, VWT16, gates, oa16, ssqa, tid);
    }
}
__device__ __forceinline__ int nmap_in2(int n) {
    if (n < 768) return n;
    if (n < 896) return n;
    if (n < 1024) return n - 896 + 1024;
    if (n < 1152) return n - 1024 + 896;
    if (n < 1280) return n;
    if (n < 1304) return n - 1280 + 1696;
    if (n < 1560) return n - 1304 + 1280;
    if (n < 1688) return n - 1560 + 1536;
    return n - 1688 + 1664;
}
struct XT { const float* src; unsigned short* dst; const float* glo; const float* ghi; int K, N, ksplit, tile, nmap; };
__device__ __forceinline__ XT xt_make(const float* src, int K, int N, unsigned short* dst, const float* glo, const float* ghi, int ksplit, int nmap, int tile) {
    XT d; d.src = src; d.dst = dst; d.glo = glo; d.ghi = ghi; d.K = K; d.N = N; d.ksplit = ksplit; d.tile = tile; d.nmap = nmap; return d;
}
__device__ __forceinline__ void xt_load(const XT& d, float (&v)[8], int tid) {
    if (d.tile < 0) return;
    const int tn = (d.N + 63) >> 6; const int k0 = (d.tile / tn) * 64, n0 = (d.tile % tn) * 64;
    const float* __restrict__ s = as_global(d.src);
#pragma unroll
    for (int i = 0; i < 8; ++i) {
        const int kl = (tid >> 6) + 8 * i, n = n0 + (tid & 63), k = k0 + kl;
        float x = (n < d.N) ? s[(long)k * d.N + n] : 0.f;
        if (d.glo) x *= (k < d.ksplit) ? d.glo[k] : d.ghi[k - d.ksplit];
        v[i] = x;
    }
}
__device__ __forceinline__ void xt_store(const XT& d, const float (&v)[8], float* buf, int tid) {
    if (d.tile < 0) return;
    float (*tl)[65] = (float (*)[65])buf;
    const int tn = (d.N + 63) >> 6; const int k0 = (d.tile / tn) * 64, n0 = (d.tile % tn) * 64;
#pragma unroll
    for (int i = 0; i < 8; ++i) tl[(tid >> 6) + 8 * i][tid & 63] = v[i];
    __syncthreads();
    const int nl = tid >> 3, kc = (tid & 7) * 8; const int n = n0 + nl;
    if (n < d.N) {
        uint4 o; o.x = cvtpk(tl[kc][nl], tl[kc + 1][nl]); o.y = cvtpk(tl[kc + 2][nl], tl[kc + 3][nl]); o.z = cvtpk(tl[kc + 4][nl], tl[kc + 5][nl]); o.w = cvtpk(tl[kc + 6][nl], tl[kc + 7][nl]);
        const int nn = d.nmap ? nmap_in2(n) : n;
        *(uint4*)(d.dst + (long)nn * d.K + k0 + kc) = o;
    }
}
#define XT_RUN4(ldsf_, MAKE) do { const int tid_x = tid_(); float xv0[8], xv1[8], xv2[8], xv3[8]; \
    const XT xd0 = MAKE(0), xd1 = MAKE(1), xd2 = MAKE(2), xd3 = MAKE(3); \
    xt_load(xd0, xv0, tid_x); xt_load(xd1, xv1, tid_x); xt_load(xd2, xv2, tid_x); xt_load(xd3, xv3, tid_x); \
    xt_store(xd0, xv0, (ldsf_), tid_x); xt_store(xd1, xv1, (ldsf_) + 64 * 65, tid_x); xt_store(xd2, xv2, (ldsf_), tid_x); xt_store(xd3, xv3, (ldsf_) + 64 * 65, tid_x); __syncthreads(); } while (0)
__device__ __forceinline__ void p0_xn_rope(const float* __restrict__ x, const float* __restrict__ g1, const int* __restrict__ positions, unsigned short* __restrict__ xn16, float* __restrict__ rope) {
    const int tid = tid_(); const int lane = tid & 63, w = __builtin_amdgcn_readfirstlane(tid >> 6);
    const f32x4_t* gp = (const f32x4_t*)g1; const f32x4_t ga0 = gp[lane * 2], ga1 = gp[lane * 2 + 1], gb0 = gp[128 + lane * 2], gb1 = gp[128 + lane * 2 + 1];
    for (int t0 = blockIdx.x * 8 + w; t0 < T_; t0 += 4 * NBLK * 8) {
        f32x4_t v[4][4]; int pos[4];
#pragma unroll
        for (int j = 0; j < 4; ++j) {
            const int t = t0 + j * NBLK * 8;
            const f32x4_t* xp = (const f32x4_t*)(x + (long)t * 1024);
            v[j][0] = xp[lane * 2]; v[j][1] = xp[lane * 2 + 1]; v[j][2] = xp[128 + lane * 2]; v[j][3] = xp[128 + lane * 2 + 1];
            pos[j] = positions[t];
        }
#pragma unroll
        for (int j = 0; j < 4; ++j) {
            const int t = t0 + j * NBLK * 8;
            const f32x4_t a0 = v[j][0], a1 = v[j][1], b0 = v[j][2], b1 = v[j][3];
            float ss = a0.x * a0.x + a0.y * a0.y + a0.z * a0.z + a0.w * a0.w + a1.x * a1.x + a1.y * a1.y + a1.z * a1.z + a1.w * a1.w
                     + b0.x * b0.x + b0.y * b0.y + b0.z * b0.z + b0.w * b0.w + b1.x * b1.x + b1.y * b1.y + b1.z * b1.z + b1.w * b1.w;
            ss = wsum(ss); const float rs = rsqrtf(ss * (1.f / 1024.f) + EPS);
            uint4 pa, pb;
            pa.x = cvtpk(a0.x * rs * ga0.x, a0.y * rs * ga0.y); pa.y = cvtpk(a0.z * rs * ga0.z, a0.w * rs * ga0.w); pa.z = cvtpk(a1.x * rs * ga1.x, a1.y * rs * ga1.y); pa.w = cvtpk(a1.z * rs * ga1.z, a1.w * rs * ga1.w);
            pb.x = cvtpk(b0.x * rs * gb0.x, b0.y * rs * gb0.y); pb.y = cvtpk(b0.z * rs * gb0.z, b0.w * rs * gb0.w); pb.z = cvtpk(b1.x * rs * gb1.x, b1.y * rs * gb1.y); pb.w = cvtpk(b1.z * rs * gb1.z, b1.w * rs * gb1.w);
            ((uint4*)(xn16 + (long)t * 1024))[lane] = pa; ((uint4*)(xn16 + (long)t * 1024))[64 + lane] = pb;
            if (lane < 24) {
                const float f = lane < 8 ? ROPE_F16[lane] : ROPE_F32[lane - 8];
                const float angf = (float)pos[j] * f;
                const double ang = (double)angf; const double k = rint(ang * 0.15915494309189535);
                const float r = (float)(ang - k * 6.283185307179586);
                const float c = cosf(r), sn = sinf(r);
                if (lane < 8) { rope[(long)t * 48 + lane] = c; rope[(long)t * 48 + 8 + lane] = sn; }
                else { rope[(long)t * 48 + 16 + lane - 8] = c; rope[(long)t * 48 + 32 + lane - 8] = sn; }
            }
        }
    }
}
__device__ __forceinline__ void p0_cbias(const float* __restrict__ pos, const float* __restrict__ w1k, const float* __restrict__ w1v, float* __restrict__ cbias) {
    const int tid = tid_(); const int lane = tid & 63, w = __builtin_amdgcn_readfirstlane(tid >> 6);
    for (int task = blockIdx.x * 8 + w; task < 512; task += NBLK * 8) {
        const int mat = task >> 8, n = task & 255; const float* w1 = mat ? w1v : w1k;
        float acc = 0.f;
#pragma unroll 8
        for (int i = 0; i < 32; ++i) { const int k = lane + 64 * i; acc += pos[k] * w1[(long)k * 256 + n]; }
        acc = wsum(acc);
        if (lane == 0) cbias[task] = acc;
    }
}
__device__ __forceinline__ void zero_stream(unsigned short* __restrict__ p, long n) {
    const int tid = tid_();
    for (long c = (long)blockIdx.x * 512 + tid; c < (n >> 3); c += (long)NBLK * 512) ((uint4*)p)[c] = make_uint4(0u, 0u, 0u, 0u);
}

struct P1Out {
    unsigned short *q16a, *ks16, *kw16, *vst16, *vwt16, *kcmp16, *vcmp16, *cq16, *ckv16;
    float *krr, *ssq_kr, *ssq_cq, *ssq_ckv, *gates;
    const float *rope, *q_gain, *ks_gain, *kw_gain, *k_gain;
};
__device__ __forceinline__ void norm_rope64(f32x16& a0, f32x16& a1, const float* __restrict__ gain, const float* __restrict__ rope_t, int hi, float outscale) {
    float ss = 0.f;
#pragma unroll
    for (int r = 0; r < 16; ++r) ss += a0[r] * a0[r] + a1[r] * a1[r];
    ss = pair_sum(ss);
    const float rs = rsqrtf(ss * (1.f / 64.f) + EPS);
#pragma unroll
    for (int g = 0; g < 4; ++g) {
        const float4 g0 = *(const float4*)(gain + 8 * g + 4 * hi), g1 = *(const float4*)(gain + 32 + 8 * g + 4 * hi);
        a0[4 * g] *= rs * g0.x; a0[4 * g + 1] *= rs * g0.y; a0[4 * g + 2] *= rs * g0.z; a0[4 * g + 3] *= rs * g0.w;
        a1[4 * g] *= rs * g1.x; a1[4 * g + 1] *= rs * g1.y; a1[4 * g + 2] *= rs * g1.z; a1[4 * g + 3] *= rs * g1.w;
    }
    const float4 c4 = *(const float4*)(rope_t + 4 * hi), s4 = *(const float4*)(rope_t + 8 + 4 * hi);
    const float cc[4] = {c4.x, c4.y, c4.z, c4.w}, sn[4] = {s4.x, s4.y, s4.z, s4.w};
#pragma unroll
    for (int j = 0; j < 4; ++j) { const float x1 = a0[j], x2 = a0[4 + j]; a0[j] = x1 * cc[j] - x2 * sn[j]; a0[4 + j] = x2 * cc[j] + x1 * sn[j]; }
#pragma unroll
    for (int r = 0; r < 16; ++r) { a0[r] *= outscale; a1[r] *= outscale; }
}
__device__ __forceinline__ void store_row64(unsigned short* __restrict__ dst, const f32x16& a0, const f32x16& a1, int hi) {
#pragma unroll
    for (int g = 0; g < 4; ++g) {
        uint2 p0, p1; p0.x = cvtpk(a0[4 * g], a0[4 * g + 1]); p0.y = cvtpk(a0[4 * g + 2], a0[4 * g + 3]); p1.x = cvtpk(a1[4 * g], a1[4 * g + 1]); p1.y = cvtpk(a1[4 * g + 2], a1[4 * g + 3]);
        *(uint2*)(dst + 8 * g + 4 * hi) = p0; *(uint2*)(dst + 32 + 8 * g + 4 * hi) = p1;
    }
}
__device__ __forceinline__ float ssq64(const f32x16& a0, const f32x16& a1) {
    float ss = 0.f;
#pragma unroll
    for (int r = 0; r < 16; ++r) ss += a0[r] * a0[r] + a1[r] * a1[r];
    return pair_sum(ss);
}
__device__ __forceinline__ float sum4fq(float v) {
    auto r1 = __builtin_amdgcn_permlane16_swap(__float_as_uint(v), __float_as_uint(v), false, false);
    return pair_sum(__uint_as_float(r1[0]) + __uint_as_float(r1[1]));
}
#define P1V(m, j) acc[ai][bj][m][n][j]
__device__ __forceinline__ void p1_inproj_256(unsigned char* lds, const unsigned short* __restrict__ xn16, const unsigned short* __restrict__ wt_in, const P1Out& Oin) {
    const P1Out O = Oin;
    const int tbase = (blockIdx.x & 7) * 56;
    for (int tile = tbase + (blockIdx.x >> 3); tile < tbase + 56; tile += 32) {
        const int mt = tile / 7, nt = tile % 7; const int m0 = mt * 256;
        f32x4_t acc[2][2][4][2];
#pragma unroll
        for (int ai = 0; ai < 2; ++ai)
#pragma unroll
            for (int bj = 0; bj < 2; ++bj)
#pragma unroll
                for (int m = 0; m < 4; ++m)
#pragma unroll
                    for (int n = 0; n < 2; ++n) acc[ai][bj][m][n] = f32x4_t{0.f, 0.f, 0.f, 0.f};
        if (nt == 4) g256::mainloop<1024>(xn16, wt_in, m0, nt * 256, (unsigned short*)lds, acc);
        else g256::mainloop<1024>(wt_in, xn16, nt * 256, m0, (unsigned short*)lds, acc);
        const int tid = tid_(); const int lane = tid & 63, wave = __builtin_amdgcn_readfirstlane(tid >> 6), wr = wave >> 2, wc = wave & 3, fr = lane & 15, fq = lane >> 4;
        if (nt == 4) {
#pragma unroll
            for (int bj = 0; bj < 2; ++bj)
#pragma unroll
                for (int n = 0; n < 2; ++n) {
                    const int pc = bj * 2 + (wc >> 1), d = (wc & 1) * 32 + n * 16 + fr;
                    unsigned short* vt = (pc < 2) ? O.vst16 : O.vwt16; const int g = pc & 1;
#pragma unroll
                    for (int ai = 0; ai < 2; ++ai)
#pragma unroll
                        for (int m = 0; m < 4; ++m) {
                            const int tb = m0 + ai * 128 + wr * 64 + m * 16 + fq * 4; const int b = tb / S_, s0 = tb % S_;
                            uint2 pk; pk.x = cvtpk(P1V(m, 0), P1V(m, 1)); pk.y = cvtpk(P1V(m, 2), P1V(m, 3));
                            *(uint2*)(vt + ((long)(b * 2 + g) * 64 + d) * S_ + vperm(s0)) = pk;
                        }
                }
        } else {
#pragma unroll
            for (int ai = 0; ai < 2; ++ai) {
                const int pc = ai * 2 + wr;
#pragma unroll
                for (int bj = 0; bj < 2; ++bj)
#pragma unroll
                    for (int n = 0; n < 2; ++n) {
                        const long tok = m0 + bj * 128 + wc * 32 + n * 16 + fr; const int b = (int)(tok / S_), s = (int)(tok % S_);
                        const float* rope_t = O.rope + tok * 48;
                        const bool is_q = nt < 2, is_k = nt == 3;
                        if (is_q || is_k) {
                            const float* gain = is_q ? O.q_gain : ((pc < 2) ? O.ks_gain : O.kw_gain);
                            float ss = 0.f;
#pragma unroll
                            for (int m = 0; m < 4; ++m)
#pragma unroll
                                for (int j = 0; j < 4; ++j) ss += P1V(m, j) * P1V(m, j);
                            const float rs = rsqrtf(sum4fq(ss) * (1.f / 64.f) + EPS) ;
#pragma unroll
                            for (int m = 0; m < 4; ++m) { const float4 gv = *(const float4*)(gain + m * 16 + fq * 4);
                                P1V(m, 0) *= rs * gv.x; P1V(m, 1) *= rs * gv.y; P1V(m, 2) *= rs * gv.z; P1V(m, 3) *= rs * gv.w; }
                            { const float4 c4 = *(const float4*)(rope_t + (fq & 1) * 4), s4 = *(const float4*)(rope_t + 8 + (fq & 1) * 4);
                              const float cc[4] = {c4.x, c4.y, c4.z, c4.w}, sn[4] = {s4.x, s4.y, s4.z, s4.w};
#pragma unroll
                              for (int j = 0; j < 4; ++j) {
                                  auto rr = __builtin_amdgcn_permlane32_swap(__float_as_uint(P1V(0, j)), __float_as_uint(P1V(0, j)), false, false);
                                  const float x1 = __uint_as_float(rr[0]), x2 = __uint_as_float(rr[1]);
                                  P1V(0, j) = (fq < 2) ? (x1 * cc[j] - x2 * sn[j]) : (x2 * cc[j] + x1 * sn[j]);
                              } }
                            const float osc = is_q ? NSA_QSCALE : 1.f;
                            unsigned short* dst = is_q ? (O.q16a + tok * 512 + (nt * 4 + pc) * 64) : ((pc < 2 ? O.ks16 : O.kw16) + ((long)(b * 2 + (pc & 1)) * S_ + s) * 64);
#pragma unroll
                            for (int m = 0; m < 4; ++m) { uint2 pk; pk.x = cvtpk(P1V(m, 0) * osc, P1V(m, 1) * osc); pk.y = cvtpk(P1V(m, 2) * osc, P1V(m, 3) * osc); *(uint2*)(dst + m * 16 + fq * 4) = pk; }
                        } else if (nt == 2 || nt == 5 || (nt == 6 && pc < 2)) {
                            unsigned short* dst;
                            if (nt == 2) dst = (pc < 2 ? O.kcmp16 : O.vcmp16) + ((long)(b * 2 + (pc & 1)) * S_ + s) * 64;
                            else if (nt == 5) dst = O.cq16 + tok * 256 + pc * 64;
                            else dst = O.ckv16 + tok * 128 + pc * 64;
                            float ss = 0.f;
#pragma unroll
                            for (int m = 0; m < 4; ++m) { uint2 pk; pk.x = cvtpk(P1V(m, 0), P1V(m, 1)); pk.y = cvtpk(P1V(m, 2), P1V(m, 3)); *(uint2*)(dst + m * 16 + fq * 4) = pk;
#pragma unroll
                                for (int j = 0; j < 4; ++j) ss += P1V(m, j) * P1V(m, j); }
                            if (nt != 2) { ss = sum4fq(ss); if (fq == 0) { if (nt == 5) O.ssq_cq[(long)pc * T_ + tok] = ss; else O.ssq_ckv[(long)pc * T_ + tok] = ss; } }
                        } else if (nt == 6 && pc == 2) {
                            float ss = 0.f;
#pragma unroll
                            for (int m = 0; m < 2; ++m)
#pragma unroll
                                for (int j = 0; j < 4; ++j) ss += P1V(m, j) * P1V(m, j);
                            ss = sum4fq(ss);
                            if (fq == 0) O.ssq_kr[tok] = ss;
                            {
                                const float4 g0 = *(const float4*)(O.k_gain + 64 + fq * 4), g1 = *(const float4*)(O.k_gain + 80 + fq * 4);
                                const float4 c4 = *(const float4*)(rope_t + 16 + fq * 4), s4 = *(const float4*)(rope_t + 32 + fq * 4);
                                const float ga[4] = {g0.x, g0.y, g0.z, g0.w}, gb[4] = {g1.x, g1.y, g1.z, g1.w}, cc[4] = {c4.x, c4.y, c4.z, c4.w}, sn[4] = {s4.x, s4.y, s4.z, s4.w};
                                float o1[4], o2[4];
#pragma unroll
                                for (int j = 0; j < 4; ++j) { const float x1 = P1V(0, j) * ga[j], x2 = P1V(1, j) * gb[j]; o1[j] = x1 * cc[j] - x2 * sn[j]; o2[j] = x2 * cc[j] + x1 * sn[j]; }
                                *(float4*)(O.krr + tok * 32 + fq * 4) = make_float4(o1[0], o1[1], o1[2], o1[3]);
                                *(float4*)(O.krr + tok * 32 + 16 + fq * 4) = make_float4(o2[0], o2[1], o2[2], o2[3]);
                            }
                            *(float4*)(O.gates + tok * 24 + fq * 4) = make_float4(1.f / (1.f + __expf(-P1V(2, 0))), 1.f / (1.f + __expf(-P1V(2, 1))), 1.f / (1.f + __expf(-P1V(2, 2))), 1.f / (1.f + __expf(-P1V(2, 3))));
                            if (fq < 2) *(float4*)(O.gates + tok * 24 + 16 + fq * 4) = make_float4(1.f / (1.f + __expf(-P1V(3, 0))), 1.f / (1.f + __expf(-P1V(3, 1))), 1.f / (1.f + __expf(-P1V(3, 2))), 1.f / (1.f + __expf(-P1V(3, 3))));
                        }
                    }
            }
        }
        __syncthreads();
    }
}
#undef P1V

typedef GemmShape<2, 4, 2, 2> ShBig;
typedef GemmShape<4, 2, 1, 3> ShQb;
typedef GemmShape<4, 2, 1, 4> ShKvb;
struct P2Args {
    const unsigned short *cq16, *ckv16, *wt_uq, *wt_ukv, *kcmp16, *vcmp16, *w1t_k, *w1t_v;
    const float *ssq_cq, *ssq_ckv, *ssq_kr, *krr, *rope, *q_gain, *k_gain;
    unsigned short *q16, *k16, *vt16; float* hid;
};
__device__ __forceinline__ void p2_phase(unsigned char* lds, const P2Args& A) {
    const int tid = tid_(); const int lane = tid & 63, wave = __builtin_amdgcn_readfirstlane(tid >> 6), r32 = lane & 31, hi = lane >> 5;
    const int nmine = (blockIdx.x < 128) ? 4 : 5;
    for (int it = 0; it < nmine; ++it) {
        int u;
        if (blockIdx.x < 128) { if (it == 0) u = blockIdx.x; else { const int s = blockIdx.x * 3 + (it - 1); u = (s & 1) ? 640 + (s >> 1) : 128 + (s >> 1); } }
        else { const int s = 384 + (blockIdx.x - 128) * 5 + it; u = (s & 1) ? 640 + (s >> 1) : 128 + (s >> 1); }
        if (u < 128) {
            const int mat = u >> 6, mtile = (u >> 2) & 15, ks = u & 3; const int wm = wave >> 2, wn = wave & 3;
            f32x16 acc[2][2];
#pragma unroll
            for (int mi = 0; mi < 2; ++mi)
#pragma unroll
                for (int ni = 0; ni < 2; ++ni)
#pragma unroll
                    for (int r = 0; r < 16; ++r) acc[mi][ni][r] = 0.f;
            gemm_mainloop<ShBig, 3u>((mat ? A.vcmp16 : A.kcmp16) + (long)mtile * 128 * 1024 + ks * 512, 1024, (mat ? A.w1t_v : A.w1t_k) + ks * 512, 2048, 512, lds, acc, tid);
            float* slab = A.hid + (long)(mat * 4 + ks) * 2048 * 256;
#pragma unroll
            for (int mi = 0; mi < 2; ++mi) {
                const long row = mtile * 128 + wm * 64 + mi * 32 + r32;
#pragma unroll
                for (int ni = 0; ni < 2; ++ni)
#pragma unroll
                    for (int g = 0; g < 4; ++g)
                        *(float4*)(slab + row * 256 + wn * 64 + ni * 32 + 8 * g + 4 * hi) = make_float4(acc[mi][ni][4 * g], acc[mi][ni][4 * g + 1], acc[mi][ni][4 * g + 2], acc[mi][ni][4 * g + 3]);
            }
        } else if (u < 128 + 512) {
            const int v = u - 128; const int mt = v >> 2, nt = v & 3; const int m0 = mt * 128; const int wm = wave >> 1, wn = wave & 1; const int head = nt * 2 + wn;
            f32x16 acc[1][4];
#pragma unroll
            for (int ni = 0; ni < 4; ++ni)
#pragma unroll
                for (int r = 0; r < 16; ++r) acc[0][ni][r] = 0.f;
            const long tok = m0 + wm * 32 + r32;
            const float e_c0 = A.ssq_ckv[tok], e_c1 = A.ssq_ckv[(long)T_ + tok], e_kr = A.ssq_kr[tok];
            f32x4_t e_k[4];
#pragma unroll
            for (int i = 0; i < 4; ++i) e_k[i] = ((const f32x4_t*)(A.krr + tok * 32 + hi * 16))[i];
            gemm_mainloop<ShKvb, 3u>(A.ckv16 + (long)m0 * 128, 128, A.wt_ukv + (long)nt * 256 * 128, 128, 128, lds, acc, tid);
            {
                const int b = (int)(tok / S_), s = (int)(tok % S_);
                const float rc = rsqrtf((e_c0 + e_c1) * (1.f / 128.f) + EPS);
                float ss = 0.f;
#pragma unroll
                for (int r = 0; r < 16; ++r) { acc[0][0][r] *= rc; acc[0][1][r] *= rc; ss += acc[0][0][r] * acc[0][0][r] + acc[0][1][r] * acc[0][1][r]; }
                ss = pair_sum(ss) + e_kr;
                const float rk = rsqrtf(ss * (1.f / 96.f) + EPS);
#pragma unroll
                for (int g = 0; g < 4; ++g) {
                    const float4 g0 = *(const float4*)(A.k_gain + 8 * g + 4 * hi), g1 = *(const float4*)(A.k_gain + 32 + 8 * g + 4 * hi);
                    acc[0][0][4 * g] *= rk * g0.x; acc[0][0][4 * g + 1] *= rk * g0.y; acc[0][0][4 * g + 2] *= rk * g0.z; acc[0][0][4 * g + 3] *= rk * g0.w;
                    acc[0][1][4 * g] *= rk * g1.x; acc[0][1][4 * g + 1] *= rk * g1.y; acc[0][1][4 * g + 2] *= rk * g1.z; acc[0][1][4 * g + 3] *= rk * g1.w;
                }
                unsigned short* krow = A.k16 + ((long)(b * 8 + head) * S_ + s) * 96;
                store_row64(krow, acc[0][0], acc[0][1], hi);
                const f32x4_t k0 = e_k[0], k1 = e_k[1], k2 = e_k[2], k3 = e_k[3];
                uint4 o0, o1; o0.x = cvtpk(k0.x * rk, k0.y * rk); o0.y = cvtpk(k0.z * rk, k0.w * rk); o0.z = cvtpk(k1.x * rk, k1.y * rk); o0.w = cvtpk(k1.z * rk, k1.w * rk);
                o1.x = cvtpk(k2.x * rk, k2.y * rk); o1.y = cvtpk(k2.z * rk, k2.w * rk); o1.z = cvtpk(k3.x * rk, k3.y * rk); o1.w = cvtpk(k3.z * rk, k3.w * rk);
                *(uint4*)(krow + 64 + hi * 16) = o0; *(uint4*)(krow + 64 + hi * 16 + 8) = o1;
            }
            {
#pragma unroll
                for (int ni = 2; ni < 4; ++ni)
#pragma unroll
                    for (int g4 = 0; g4 < 4; ++g4) {
                        const int tb = m0 + wm * 32 + 8 * g4 + 4 * hi; const int b = tb / S_, s0 = tb % S_; const int d = (ni - 2) * 32 + r32;
                        const f32x4_t sa = *(const f32x4_t*)(A.ssq_ckv + tb), sb = *(const f32x4_t*)(A.ssq_ckv + (long)T_ + tb);
                        const float r0 = rsqrtf((sa.x + sb.x) * (1.f / 128.f) + EPS), r1 = rsqrtf((sa.y + sb.y) * (1.f / 128.f) + EPS), r2 = rsqrtf((sa.z + sb.z) * (1.f / 128.f) + EPS), r3 = rsqrtf((sa.w + sb.w) * (1.f / 128.f) + EPS);
                        uint2 pk; pk.x = cvtpk(acc[0][ni][4 * g4] * r0, acc[0][ni][4 * g4 + 1] * r1); pk.y = cvtpk(acc[0][ni][4 * g4 + 2] * r2, acc[0][ni][4 * g4 + 3] * r3);
                        *(uint2*)(A.vt16 + ((long)(b * 8 + head) * 64 + d) * S_ + vperm(s0)) = pk;
                    }
            }
        } else {
            const int v = u - 640; const int mt = v >> 2, nt = v & 3; const int m0 = mt * 128; const int wm = wave >> 1, wn = wave & 1; const int head = nt * 2 + wn;
            f32x16 acc[1][3];
#pragma unroll
            for (int ni = 0; ni < 3; ++ni)
#pragma unroll
                for (int r = 0; r < 16; ++r) acc[0][ni][r] = 0.f;
            const long tok = m0 + wm * 32 + r32;
            const float e_q0 = A.ssq_cq[tok], e_q1 = A.ssq_cq[(long)T_ + tok], e_q2 = A.ssq_cq[2L * T_ + tok], e_q3 = A.ssq_cq[3L * T_ + tok];
            const float* rope_t = A.rope + tok * 48;
            f32x4_t e_c[2], e_s[2];
#pragma unroll
            for (int g = 0; g < 2; ++g) { e_c[g] = *(const f32x4_t*)(rope_t + 16 + 8 * g + 4 * hi); e_s[g] = *(const f32x4_t*)(rope_t + 32 + 8 * g + 4 * hi); }
            gemm_mainloop<ShQb, 7u>(A.cq16 + (long)m0 * 256, 256, A.wt_uq + (long)nt * 192 * 256, 256, 256, lds, acc, tid);
            const float rc = rsqrtf((e_q0 + e_q1 + e_q2 + e_q3) * (1.f / 256.f) + EPS);
            float ss = 0.f;
#pragma unroll
            for (int ni = 0; ni < 3; ++ni)
#pragma unroll
                for (int r = 0; r < 16; ++r) { acc[0][ni][r] *= rc; ss += acc[0][ni][r] * acc[0][ni][r]; }
            ss = pair_sum(ss);
            const float rq = rsqrtf(ss * (1.f / 96.f) + EPS);
#pragma unroll
            for (int ni = 0; ni < 3; ++ni)
#pragma unroll
                for (int g = 0; g < 4; ++g) {
                    const float4 gg = *(const float4*)(A.q_gain + ni * 32 + 8 * g + 4 * hi);
                    acc[0][ni][4 * g] *= rq * gg.x; acc[0][ni][4 * g + 1] *= rq * gg.y; acc[0][ni][4 * g + 2] *= rq * gg.z; acc[0][ni][4 * g + 3] *= rq * gg.w;
                }
#pragma unroll
            for (int g = 0; g < 2; ++g) {
                const f32x4_t c4 = e_c[g], s4 = e_s[g];
                const float cc[4] = {c4.x, c4.y, c4.z, c4.w}, sn[4] = {s4.x, s4.y, s4.z, s4.w};
#pragma unroll
                for (int j = 0; j < 4; ++j) { const float x1 = acc[0][2][4 * g + j], x2 = acc[0][2][8 + 4 * g + j]; acc[0][2][4 * g + j] = x1 * cc[j] - x2 * sn[j]; acc[0][2][8 + 4 * g + j] = x2 * cc[j] + x1 * sn[j]; }
            }
            unsigned short* qrow = A.q16 + tok * 768 + head * 96;
#pragma unroll
            for (int ni = 0; ni < 3; ++ni)
#pragma unroll
                for (int g = 0; g < 4; ++g) {
                    uint2 pk; pk.x = cvtpk(acc[0][ni][4 * g] * MLA_QSCALE, acc[0][ni][4 * g + 1] * MLA_QSCALE); pk.y = cvtpk(acc[0][ni][4 * g + 2] * MLA_QSCALE, acc[0][ni][4 * g + 3] * MLA_QSCALE);
                    *(uint2*)(qrow + ni * 32 + 8 * g + 4 * hi) = pk;
                }
        }
    }
}
__device__ __forceinline__ void p3_cmp2(unsigned char* lds, const float* __restrict__ hid, const float* __restrict__ cbias, const unsigned short* __restrict__ w2t_k, const unsigned short* __restrict__ w2t_v,
                                        const float* __restrict__ kc_gain, const float* __restrict__ rope, unsigned short* __restrict__ kc16, unsigned short* __restrict__ vct16) {
    if (blockIdx.x >= 128) return;
    const int tid = tid_(); const int lane = tid & 63, w = __builtin_amdgcn_readfirstlane(tid >> 6), r32 = lane & 31, hi = lane >> 5;
    const int task = blockIdx.x; const int mat = task >> 6, rt = task & 63; const long row = rt * 32 + r32;
    const unsigned short* w2t = mat ? w2t_v : w2t_k;
    f32x16 acc[2];
#pragma unroll
    for (int r = 0; r < 16; ++r) { acc[0][r] = 0.f; acc[1][r] = 0.f; }
    f32x4_t hv[2][10]; bf16x8 wf[2][2];
#pragma unroll
    for (int s = 0; s < 2; ++s) {
        const int k0 = (w * 2 + s) * 16 + hi * 8;
        hv[s][0] = *(const f32x4_t*)(cbias + mat * 256 + k0); hv[s][1] = *(const f32x4_t*)(cbias + mat * 256 + k0 + 4);
#pragma unroll
        for (int sp = 0; sp < 4; ++sp) {
            const float* hp = hid + ((long)(mat * 4 + sp) * 2048 + row) * 256 + k0;
            hv[s][2 + 2 * sp] = *(const f32x4_t*)hp; hv[s][3 + 2 * sp] = *(const f32x4_t*)(hp + 4);
        }
        wf[s][0] = *(const bf16x8*)(w2t + (long)r32 * 256 + k0); wf[s][1] = *(const bf16x8*)(w2t + (long)(32 + r32) * 256 + k0);
    }
#pragma unroll
    for (int s = 0; s < 2; ++s) {
        f32x4_t lo = hv[s][0], up = hv[s][1];
#pragma unroll
        for (int sp = 0; sp < 4; ++sp) { lo += hv[s][2 + 2 * sp]; up += hv[s][3 + 2 * sp]; }
        uint4 pk; pk.x = cvtpk(gelu_tanh(lo.x), gelu_tanh(lo.y)); pk.y = cvtpk(gelu_tanh(lo.z), gelu_tanh(lo.w)); pk.z = cvtpk(gelu_tanh(up.x), gelu_tanh(up.y)); pk.w = cvtpk(gelu_tanh(up.z), gelu_tanh(up.w));
        const bf16x8 hf = __builtin_bit_cast(bf16x8, pk);
        acc[0] = MFMA32(wf[s][0], hf, acc[0]); acc[1] = MFMA32(wf[s][1], hf, acc[1]);
    }
    f32x4_t* red = (f32x4_t*)lds;
#pragma unroll
    for (int q = 0; q < 8; ++q) red[(w * 8 + q) * 64 + lane] = f32x4_t{acc[q >> 2][4 * (q & 3)], acc[q >> 2][4 * (q & 3) + 1], acc[q >> 2][4 * (q & 3) + 2], acc[q >> 2][4 * (q & 3) + 3]};
    __syncthreads();
    if (w != 0) return;
#pragma unroll
    for (int q = 0; q < 8; ++q) {
        f32x4_t s = red[q * 64 + lane];
#pragma unroll
        for (int ww = 1; ww < 8; ++ww) s += red[(ww * 8 + q) * 64 + lane];
        acc[q >> 2][4 * (q & 3)] = s.x; acc[q >> 2][4 * (q & 3) + 1] = s.y; acc[q >> 2][4 * (q & 3) + 2] = s.z; acc[q >> 2][4 * (q & 3) + 3] = s.w;
    }
    const int bg = (int)(row >> 9), n = (int)(row & 511); const bool valid = n < NCMP;
    if (mat == 0) {
        if (valid) {
            const long tokp = (long)(bg >> 1) * S_ + 16 * n + 31;
            norm_rope64(acc[0], acc[1], kc_gain, rope + tokp * 48, hi, 1.f);
        } else {
#pragma unroll
            for (int r = 0; r < 16; ++r) { acc[0][r] = 0.f; acc[1][r] = 0.f; }
        }
        store_row64(kc16 + row * 64, acc[0], acc[1], hi);
    } else {
#pragma unroll
        for (int ni = 0; ni < 2; ++ni)
#pragma unroll
            for (int r = 0; r < 16; ++r) {
                const float v = valid ? acc[ni][r] : 0.f;
                const float other = __uint_as_float(__builtin_amdgcn_mov_dpp(__float_as_uint(v), 0xB1, 0xF, 0xF, true));
                if ((lane & 1) == 0) *(unsigned*)(vct16 + ((long)bg * 64 + ni * 32 + crow(r, hi)) * 512 + vperm(n)) = cvtpk(v, other);
            }
    }
}

__device__ __forceinline__ void cvt_stream(const float* __restrict__ in, unsigned short* __restrict__ out, long n, int vb = blockIdx.x, int nb = NBLK) {
    const long nchunk = n >> 3;
    const int tid = tid_();
    for (long c = (long)vb * 512 + tid; c < nchunk; c += (long)nb * 512) {
        const float4 a = ((const float4*)in)[2 * c], b = ((const float4*)in)[2 * c + 1];
        uint4 o; o.x = cvtpk(a.x, a.y); o.y = cvtpk(a.z, a.w); o.z = cvtpk(b.x, b.y); o.w = cvtpk(b.z, b.w);
        ((uint4*)out)[c] = o;
    }
}


typedef unsigned u32x3 __attribute__((ext_vector_type(3)));
typedef unsigned u32x6 __attribute__((ext_vector_type(6)));
typedef float f32x32 __attribute__((ext_vector_type(32)));
constexpr int PROW = 768;
constexpr int PU_SPLIT = 12288;
template <int NR>
__device__ __forceinline__ void cvt_rows_fp6(const float* __restrict__ in, unsigned char* __restrict__ out6, float* __restrict__ scale, int rows, int vb = blockIdx.x, int nb = NBLK) {
    const int tid = tid_(); const int lane = tid & 63, w = __builtin_amdgcn_readfirstlane(tid >> 6);
    const int stride = nb * 8;
    for (int r0 = vb * 8 + w; r0 < rows; r0 += NR * stride) {
        f32x4_t v[NR][4];
#pragma unroll
        for (int j = 0; j < NR; ++j) {
            const int r = min(r0 + j * stride, rows - 1);
            const f32x4_t* p = (const f32x4_t*)(in + (long)r * 1024 + lane * 16);
#pragma unroll
            for (int i = 0; i < 4; ++i) v[j][i] = p[i];
        }
#pragma unroll
        for (int j = 0; j < NR; ++j) {
            const int r = r0 + j * stride;
            if (r < rows) {
                float m = 0.f;
#pragma unroll
                for (int i = 0; i < 4; ++i) m = fmaxf(m, fmaxf(fmaxf(fabsf(v[j][i].x), fabsf(v[j][i].y)), fmaxf(fabsf(v[j][i].z), fabsf(v[j][i].w))));
                m = wmax(m);
                const float q = (m > 0.f) ? 7.5f / m : 1.f;
                const f32x16 ve = {v[j][0].x * q, v[j][0].z * q, v[j][1].x * q, v[j][1].z * q, v[j][2].x * q, v[j][2].z * q, v[j][3].x * q, v[j][3].z * q, 0.f, 0.f, 0.f, 0.f, 0.f, 0.f, 0.f, 0.f};
                const f32x16 vo = {v[j][0].y * q, v[j][0].w * q, v[j][1].y * q, v[j][1].w * q, v[j][2].y * q, v[j][2].w * q, v[j][3].y * q, v[j][3].w * q, 0.f, 0.f, 0.f, 0.f, 0.f, 0.f, 0.f, 0.f};
                const u32x6 pk = __builtin_amdgcn_cvt_scalef32_2xpk16_fp6_f32(ve, vo, 1.0f);
                *(u32x3*)(out6 + (long)r * PROW + lane * 12) = u32x3{pk[0], pk[1], pk[2]};
                if (lane == 0) scale[r] = (m > 0.f) ? m * (1.f / 7.5f) : 1.f;
            }
        }
    }
}
__device__ __forceinline__ f32x32 dec2_fp6(const u32x3& r0, const u32x3& r1) {
    const u32x6 pk = {r0.x, r0.y, r0.z, r1.x, r1.y, r1.z};
    return __builtin_amdgcn_cvt_scalef32_pk32_f32_fp6(pk, 1.0f);
}
__device__ __forceinline__ void peer_sweep_a(const float* __restrict__ hss, const float* __restrict__ g2, const int* __restrict__ eo, const float* __restrict__ go,
                                             const unsigned char* __restrict__ U6, const float* __restrict__ su, const float* __restrict__ sv, const float* __restrict__ h, float* __restrict__ wout) {
    const int tid = tid_(); const int lane = tid & 63, w = __builtin_amdgcn_readfirstlane(tid >> 6);
    const int kcls = ((lane >> 5) & 1) * 4 + ((lane >> 4) & 1) * 2 + ((lane >> 3) & 1);
    for (int t = blockIdx.x * 8 + w; t < T_; t += NBLK * 8) {
        float x[16];
        {
            const float4* xp = (const float4*)(h + (long)t * 1024 + lane * 16); const float4* gp = (const float4*)(g2 + lane * 16); const float4* hp = (const float4*)(hss + (long)t * 16);
            const float4 s0 = hp[0], s1 = hp[1], s2 = hp[2], s3 = hp[3];
            const float rs = rsqrtf((s0.x + s0.y + s0.z + s0.w + s1.x + s1.y + s1.z + s1.w + s2.x + s2.y + s2.z + s2.w + s3.x + s3.y + s3.z + s3.w) * (1.f / 1024.f) + EPS);
#pragma unroll
            for (int k = 0; k < 4; ++k) { const float4 hv = xp[k], gv = gp[k]; x[4 * k] = hv.x * rs * gv.x; x[4 * k + 1] = hv.y * rs * gv.y; x[4 * k + 2] = hv.z * rs * gv.z; x[4 * k + 3] = hv.w * rs * gv.w; }
        }
        const int elo = eo[(long)t * 128 + lane], ehi = eo[(long)t * 128 + 64 + lane];
        const float glo = go[(long)t * 128 + lane], ghi = go[(long)t * 128 + 64 + lane];
        for (int bt = 0; bt < 16; ++bt) {
            int e[8];
#pragma unroll
            for (int k = 0; k < 8; ++k) e[k] = __builtin_amdgcn_readlane(bt < 8 ? elo : ehi, (bt * 8 + k) & 63);
            u32x3 u[8];
#pragma unroll
            for (int k = 0; k < 8; ++k) u[k] = *(const u32x3*)(U6 + (long)e[k] * PROW + lane * 12);
            const int emine = __shfl(bt < 8 ? elo : ehi, (bt * 8 + kcls) & 63);
            const float sum = su[emine], svm = sv[emine];
            const float gk = __shfl(bt < 8 ? glo : ghi, (bt * 8 + kcls) & 63);
            float a[8];
#pragma unroll
            for (int k = 0; k < 8; k += 2) {
                const f32x32 d = dec2_fp6(u[k], u[k + 1]);
                float s0 = 0.f, s1 = 0.f;
#pragma unroll
                for (int i = 0; i < 16; ++i) { s0 = fmaf(d[i], x[i], s0); s1 = fmaf(d[16 + i], x[i], s1); }
                a[k] = s0; a[k + 1] = s1;
            }
            float b4[4], c2[2], d1;
#pragma unroll
            for (int i = 0; i < 4; ++i) {
                auto rr = __builtin_amdgcn_permlane32_swap(__float_as_uint(a[i]), __float_as_uint(a[i + 4]), false, false);
                b4[i] = __uint_as_float(rr[0]) + __uint_as_float(rr[1]);
            }
#pragma unroll
            for (int i = 0; i < 2; ++i) {
                auto rr = __builtin_amdgcn_permlane16_swap(__float_as_uint(b4[i]), __float_as_uint(b4[i + 2]), false, false);
                c2[i] = __uint_as_float(rr[0]) + __uint_as_float(rr[1]);
            }
            { const bool up = (lane & 8) != 0; const float keep = up ? c2[1] : c2[0], send = up ? c2[0] : c2[1];
              d1 = keep + __uint_as_float(__builtin_amdgcn_mov_dpp(__float_as_uint(send), 0x128, 0xF, 0xF, true)); }
            d1 = quad_sum(d1);
            d1 += __uint_as_float(__builtin_amdgcn_mov_dpp(__float_as_uint(d1), 0x141, 0xF, 0xF, true));
            const float wl = gk * gelu_tanh(d1 * sum) * svm;
            if ((lane & 7) == 0) wout[(long)t * 128 + bt * 8 + kcls] = wl;
        }
    }
}
__device__ __forceinline__ void peer_sweep_b(const int* __restrict__ eo, const float* __restrict__ win, const unsigned char* __restrict__ V6, float* out) {
    const int tid = tid_(); const int lane = tid & 63, w = __builtin_amdgcn_readfirstlane(tid >> 6);
    for (int t = blockIdx.x * 8 + w; t < T_; t += NBLK * 8) {
        float y[16];
#pragma unroll
        for (int i = 0; i < 16; ++i) y[i] = 0.f;
        const int elo = eo[(long)t * 128 + lane], ehi = eo[(long)t * 128 + 64 + lane];
        const float wlo = win[(long)t * 128 + lane], whi = win[(long)t * 128 + 64 + lane];
        for (int bt = 0; bt < 16; ++bt) {
            int e[8]; float wk[8];
#pragma unroll
            for (int k = 0; k < 8; ++k) {
                e[k] = __builtin_amdgcn_readlane(bt < 8 ? elo : ehi, (bt * 8 + k) & 63);
                wk[k] = __uint_as_float(__builtin_amdgcn_readlane(__float_as_uint(bt < 8 ? wlo : whi), (bt * 8 + k) & 63));
            }
            u32x3 v[8];
#pragma unroll
            for (int k = 0; k < 8; ++k) v[k] = *(const u32x3*)(V6 + (long)e[k] * PROW + lane * 12);
#pragma unroll
            for (int k = 0; k < 8; k += 2) {
                const f32x32 d = dec2_fp6(v[k], v[k + 1]);
#pragma unroll
                for (int i = 0; i < 16; ++i) y[i] = fmaf(wk[k + 1], d[16 + i], fmaf(wk[k], d[i], y[i]));
            }
        }
        float4* o = (float4*)(out + (long)t * 1024 + lane * 16);
#pragma unroll
        for (int k = 0; k < 4; ++k) { float4 hv = o[k]; hv.x += y[4 * k]; hv.y += y[4 * k + 1]; hv.z += y[4 * k + 2]; hv.w += y[4 * k + 3]; o[k] = hv; }
    }
}

struct Params {
    const float* x; const int* positions; const float* norm1_gain; const float* w_in;
    const float *nsa_q_gain, *nsa_kc_gain, *nsa_ks_gain, *nsa_kw_gain, *cmp_pos, *cmp_k_w1, *cmp_k_w2, *cmp_v_w1, *cmp_v_w2;
    const float *mla_q_lora_gain, *mla_w_uq, *mla_kv_lora_gain, *mla_w_ukv, *mla_q_gain, *mla_k_gain, *out_gain_a, *out_gain_b, *w_out;
    const float *norm2_gain, *peer_w_q, *peer_sub_keys, *peer_u, *peer_v;
    float* out; float* W; unsigned* bar;
};
constexpr int LDS_BYTES = 64 + 131072;
static_assert(LDS_BYTES >= 8 * 3200 * 4 + 64, "naive NSA phase needs 102,464 B");

typedef __attribute__((address_space(4))) const Params* cparams_t;
__device__ __forceinline__ cparams_t params_ptr() {
    cparams_t pp = (cparams_t)__builtin_amdgcn_kernarg_segment_ptr();
    asm volatile("" : "+s"(pp));
    return pp;
}
constexpr long M1 = 1 << 20;
constexpr long F_U8 = 0, F_V8 = 4 * M1, F_SU = 21 * M1 + 3 * M1 / 8, F_SV = F_SU + 16384,
               F_WTIN = 16 * M1, F_WTUQ = 17 * M1, F_WTUKV = 17 * M1 + M1 / 8, F_W1TK = 17 * M1 + M1 / 4, F_W1TV = 17 * M1 + M1 / 2, F_W2TK = 17 * M1 + 3 * M1 / 4,
               F_W2TV = F_W2TK + 8192, F_CBIAS = F_W2TV + 8192, F_WTOUT = 18 * M1, F_WTQ = 18 * M1 + M1 / 2, F_SK16 = 19 * M1 + M1 / 2,
               F_SSQCQ = 19 * M1 + 5 * M1 / 8, F_SSQCKV = F_SSQCQ + 4 * 16384, F_SSQKR = F_SSQCKV + 2 * 16384, F_SSQA = 19 * M1 + 3 * M1 / 4, F_SSQB = F_SSQA + 8 * 16384,
               F_ROPE = 20 * M1, F_GATES = 21 * M1, F_KRR = 21 * M1 + M1 / 2,
               F_XN16 = 22 * M1, F_MIX = 22 * M1,
               F_Q16A = 30 * M1, F_KS16 = 34 * M1, F_KW16 = 35 * M1, F_VST16 = 36 * M1, F_VWT16 = 37 * M1, F_KCMP16 = 38 * M1, F_VCMP16 = 39 * M1 + M1 / 8,
               F_CQ16 = 40 * M1 + M1 / 4, F_CKV16 = 42 * M1 + M1 / 4,
               F_Q16 = 43 * M1 + M1 / 2, F_K16 = 49 * M1 + M1 / 2, F_VT16 = 55 * M1 + M1 / 2, F_HID = 59 * M1 + M1 / 2, F_KC16 = 63 * M1 + M1 / 2, F_VCT16 = F_KC16 + M1 / 8,
               F_HB = 30 * M1, F_HSS = 38 * M1, F_PSS = 38 * M1 + M1 / 2, F_EO = 39 * M1, F_GO = 41 * M1, F_PQB = 43 * M1 + M1 / 2;
static_assert(F_SSQKR + 16384 <= F_SSQA && F_SSQB + 8 * 16384 <= F_ROPE && F_VCT16 + M1 / 8 <= 64 * M1 - 16384 && F_CKV16 + M1 <= F_Q16 && F_PQB + 16 * M1 <= F_HID, "workspace map");

#define G(x) (x)
__global__ __launch_bounds__(512, 2) void mega(Params p_unused) {
    extern __shared__ __attribute__((aligned(16))) unsigned char lds_raw[];
    float* ldsf = (float*)(lds_raw + 64);
    { const unsigned bid_ = blockIdx.x; __builtin_assume(bid_ < (unsigned)NBLK); }
    if (threadIdx.x == 0) *(uint4*)lds_raw = make_uint4(0u, 0u, 0u, 0u);
    __syncthreads();
    XcdBarrier bar = xcd_barrier_post(params_ptr()->bar, (volatile LAS unsigned*)lds_raw);
#define GRID_SYNC() xcd_barrier(bar)
#define U16P(off) ((unsigned short*)(W + (off)))
    { cparams_t p = params_ptr(); float* W = p->W;
      p0_xn_rope(p->x, p->norm1_gain, p->positions, U16P(F_XN16), W + F_ROPE); }
    { cparams_t p = params_ptr(); float* W = p->W;
#define P0_XT(j) ({ const int v_ = (int)blockIdx.x + NBLK * (j); \
        (v_ < 432) ? xt_make(p->w_in, 1024, INW, U16P(F_WTIN), nullptr, nullptr, 0, 2, v_) : \
        (v_ < 480) ? xt_make(p->mla_w_uq, 256, 768, U16P(F_WTUQ), p->mla_q_lora_gain, p->mla_q_lora_gain, 1 << 30, 0, v_ - 432) : \
        (v_ < 512) ? xt_make(p->mla_w_ukv, 128, 1024, U16P(F_WTUKV), p->mla_kv_lora_gain, p->mla_kv_lora_gain, 1 << 30, 0, v_ - 480) : \
        (v_ < 640) ? xt_make(p->cmp_k_w1, 2048, 256, U16P(F_W1TK), nullptr, nullptr, 0, 0, v_ - 512) : \
        (v_ < 768) ? xt_make(p->cmp_v_w1, 2048, 256, U16P(F_W1TV), nullptr, nullptr, 0, 0, v_ - 640) : \
        (v_ < 772) ? xt_make(p->cmp_k_w2, 256, 64, U16P(F_W2TK), nullptr, nullptr, 0, 0, v_ - 768) : \
        (v_ < 776) ? xt_make(p->cmp_v_w2, 256, 64, U16P(F_W2TV), nullptr, nullptr, 0, 0, v_ - 772) : xt_make(nullptr, 64, 64, nullptr, nullptr, nullptr, 0, 0, -1); })
      XT_RUN4(ldsf, P0_XT);
      zero_stream(U16P(F_WTIN) + (long)1720 * 1024, (long)72 * 1024); }
    { cparams_t p = params_ptr(); float* W = p->W;
      p0_cbias(p->cmp_pos, p->cmp_k_w1, p->cmp_v_w1, W + F_CBIAS); }
    GRID_SYNC();
    { cparams_t p = params_ptr(); float* W = p->W;
      P1Out O; O.q16a = U16P(F_Q16A); O.ks16 = U16P(F_KS16); O.kw16 = U16P(F_KW16); O.vst16 = U16P(F_VST16); O.vwt16 = U16P(F_VWT16); O.kcmp16 = U16P(F_KCMP16); O.vcmp16 = U16P(F_VCMP16);
      O.cq16 = U16P(F_CQ16); O.ckv16 = U16P(F_CKV16); O.krr = W + F_KRR; O.ssq_kr = W + F_SSQKR; O.ssq_cq = W + F_SSQCQ; O.ssq_ckv = W + F_SSQCKV; O.gates = W + F_GATES;
      O.rope = W + F_ROPE; O.q_gain = p->nsa_q_gain; O.ks_gain = p->nsa_ks_gain; O.kw_gain = p->nsa_kw_gain; O.k_gain = p->mla_k_gain;
      p1_inproj_256(lds_raw + 64, U16P(F_XN16), U16P(F_WTIN), O); }
    if ((blockIdx.x >> 3) >= 24) {
      cparams_t p = params_ptr(); float* W = p->W;
      cvt_rows_fp6<8>(p->peer_u, (unsigned char*)(W + F_U8), W + F_SU, PU_SPLIT, (int)(blockIdx.x & 7) * 8 + (int)(blockIdx.x >> 3) - 24, 64); }
    GRID_SYNC();
    { cparams_t p = params_ptr(); float* W = p->W;
      P2Args A; A.cq16 = U16P(F_CQ16); A.ckv16 = U16P(F_CKV16); A.wt_uq = U16P(F_WTUQ); A.wt_ukv = U16P(F_WTUKV); A.kcmp16 = U16P(F_KCMP16); A.vcmp16 = U16P(F_VCMP16); A.w1t_k = U16P(F_W1TK); A.w1t_v = U16P(F_W1TV);
      A.ssq_cq = W + F_SSQCQ; A.ssq_ckv = W + F_SSQCKV; A.ssq_kr = W + F_SSQKR; A.krr = W + F_KRR; A.rope = W + F_ROPE; A.q_gain = p->mla_q_gain; A.k_gain = p->mla_k_gain;
      A.q16 = U16P(F_Q16); A.k16 = U16P(F_K16); A.vt16 = U16P(F_VT16); A.hid = W + F_HID;
      p2_phase(lds_raw + 64, A); }
    GRID_SYNC();
    { const int vb = blockIdx.x, nb = NBLK;
      { cparams_t p = params_ptr(); float* W = p->W;
#define P3_XT(j) ({ const int v_ = vb + nb * (j); \
          (v_ < 256) ? xt_make(p->w_out, 1024, 1024, U16P(F_WTOUT), p->out_gain_a, p->out_gain_b, 512, 0, v_) : \
          (v_ < 768) ? xt_make(p->peer_w_q, 1024, 2048, U16P(F_WTQ), p->norm2_gain, p->norm2_gain, 1 << 30, 0, v_ - 256) : xt_make(nullptr, 64, 64, nullptr, nullptr, nullptr, 0, 0, -1); })
        XT_RUN4(ldsf, P3_XT); }
      { cparams_t p = params_ptr(); float* W = p->W;
        p3_cmp2(lds_raw + 64 + 36864, W + F_HID, W + F_CBIAS, U16P(F_W2TK), U16P(F_W2TV), p->nsa_kc_gain, W + F_ROPE, U16P(F_KC16), U16P(F_VCT16)); }
      { cparams_t p = params_ptr(); float* W = p->W;
        cvt_stream(p->peer_sub_keys, U16P(F_SK16), (long)8 * 2 * 128 * 128, vb, nb);
        cvt_rows_fp6<4>(p->peer_v, (unsigned char*)(W + F_V8), W + F_SV, 16384, vb, nb);
        cvt_rows_fp6<2>(p->peer_u + (long)PU_SPLIT * 1024, (unsigned char*)(W + F_U8) + (long)PU_SPLIT * PROW, W + F_SU + PU_SPLIT, 16384 - PU_SPLIT, vb, nb); }
    }
    GRID_SYNC();
    { cparams_t p = params_ptr(); float* W = p->W;
      nsa_phase(lds_raw + 64, U16P(F_Q16A), U16P(F_KC16), U16P(F_VCT16), U16P(F_KS16), U16P(F_VST16), U16P(F_KW16), U16P(F_VWT16), W + F_GATES, U16P(F_MIX), W + F_SSQA); }
    { cparams_t p = params_ptr(); float* W = p->W;
      mla_phase(lds_raw + 64, U16P(F_Q16), U16P(F_K16), U16P(F_VT16), U16P(F_MIX), W + F_SSQB); }
    GRID_SYNC();
    { cparams_t p = params_ptr(); float* W = p->W;
      p5_outproj_256(lds_raw + 64, U16P(F_MIX), U16P(F_WTOUT), W + F_SSQA, W + F_SSQB, p->x, p->out, U16P(F_HB), W + F_HSS); }
    GRID_SYNC();
    { cparams_t p = params_ptr(); float* W = p->W;
      p6_peerq_256(lds_raw + 64, U16P(F_HB), U16P(F_WTQ), W + F_HSS, U16P(F_PQB), W + F_PSS); }
    GRID_SYNC();
    { cparams_t p = params_ptr(); float* W = p->W;
      peer_route_mfma(lds_raw + 64, U16P(F_PQB), W + F_PSS, U16P(F_SK16), (int*)(W + F_EO), W + F_GO); }
    GRID_SYNC();
    { cparams_t p = params_ptr(); float* W = p->W;
      peer_sweep_a(W + F_HSS, p->norm2_gain, (const int*)(W + F_EO), W + F_GO, (const unsigned char*)(W + F_U8), W + F_SU, W + F_SV, p->out, W + F_PQB); }
    GRID_SYNC();
    { cparams_t p = params_ptr(); float* W = p->W;
      peer_sweep_b((const int*)(W + F_EO), W + F_PQB, (const unsigned char*)(W + F_V8), p->out); }
}

extern "C" void kernel_launch(void* const* d_in, const int* in_sizes, int n_in, void* d_out, int out_size, void* d_ws, size_t ws_size, hipStream_t stream) {
    (void)ws_size; (void)in_sizes; (void)n_in; (void)out_size;
    static int grid = 0;
    if (grid == 0) {
        int dev = 0, cus = 0, per_cu = 0;
        (void)hipGetDevice(&dev);
        (void)hipDeviceGetAttribute(&cus, hipDeviceAttributeMultiprocessorCount, dev);
        (void)hipFuncSetAttribute((const void*)mega, hipFuncAttributeMaxDynamicSharedMemorySize, LDS_BYTES);
        (void)hipOccupancyMaxActiveBlocksPerMultiprocessor(&per_cu, (const void*)mega, 512, LDS_BYTES);
        (void)hipGetLastError();
        if (per_cu < 1) fprintf(stderr, "kernel_launch: occupancy query reports %d blocks per CU\n", per_cu);
        if (cus != NBLK) fprintf(stderr, "kernel_launch: built for %d CUs, device reports %d\n", NBLK, cus);
        grid = NBLK;
    }
    Params p{};
    p.x = (const float*)d_in[0]; p.positions = (const int*)d_in[1]; p.norm1_gain = (const float*)d_in[2]; p.w_in = (const float*)d_in[3];
    p.nsa_q_gain = (const float*)d_in[4]; p.nsa_kc_gain = (const float*)d_in[5]; p.nsa_ks_gain = (const float*)d_in[6]; p.nsa_kw_gain = (const float*)d_in[7];
    p.cmp_pos = (const float*)d_in[8]; p.cmp_k_w1 = (const float*)d_in[9]; p.cmp_k_w2 = (const float*)d_in[10]; p.cmp_v_w1 = (const float*)d_in[11]; p.cmp_v_w2 = (const float*)d_in[12];
    p.mla_q_lora_gain = (const float*)d_in[13]; p.mla_w_uq = (const float*)d_in[14]; p.mla_kv_lora_gain = (const float*)d_in[15]; p.mla_w_ukv = (const float*)d_in[16];
    p.mla_q_gain = (const float*)d_in[17]; p.mla_k_gain = (const float*)d_in[18]; p.out_gain_a = (const float*)d_in[19]; p.out_gain_b = (const float*)d_in[20]; p.w_out = (const float*)d_in[21];
    p.norm2_gain = (const float*)d_in[22]; p.peer_w_q = (const float*)d_in[23]; p.peer_sub_keys = (const float*)d_in[24]; p.peer_u = (const float*)d_in[25]; p.peer_v = (const float*)d_in[26];
    p.out = (float*)d_out;
    p.bar = (unsigned*)d_ws;
    p.W = (float*)d_ws + 16384;
    (void)hipMemsetAsync(d_ws, 0, XCD_BAR_WORDS * sizeof(unsigned), stream);
    hipLaunchKernelGGL(mega, dim3(grid), dim3(512), LDS_BYTES, stream, p);
}
```

```cpp
#include <hip/hip_runtime.h>
#include <cmath>
#include <cstdint>
#include <cstdio>

#define XB_TMO      128
#define XB_XCNT(j)  (256  + 64 * (j))
#define XB_XSUB(j)  (1280 + 64 * (j))
#define XB_XGEN(j)  (2304 + 64 * (j))
#define XB_TOP      3328
#define XB_TOPGEN   3392
#define XCD_BAR_WORDS 3456
#define XB_SPIN_CAP (1u << 18)
#define LAS __attribute__((address_space(3)))

__device__ __forceinline__ unsigned xb_ld(unsigned* p)              { return __hip_atomic_load(p, __ATOMIC_RELAXED, __HIP_MEMORY_SCOPE_AGENT); }
__device__ __forceinline__ unsigned xb_add(unsigned* p, unsigned v) { return __hip_atomic_fetch_add(p, v, __ATOMIC_RELAXED, __HIP_MEMORY_SCOPE_AGENT); }
__device__ __forceinline__ unsigned xb_xcc_id() { return (unsigned)__builtin_amdgcn_s_getreg((3 << 11) | 20) & 0xFu; }
#define XB_SPIN(cond, bar) do { unsigned _sp = 0; while (cond) { __builtin_amdgcn_s_sleep(1); \
    if ((++_sp & 255u) == 0u) { if (xb_ld(&(bar)[XB_TMO])) break; if (_sp > XB_SPIN_CAP) { atomicAdd(&(bar)[XB_TMO], 1u); break; } } } } while (0)

struct XcdBarrier {
    unsigned* bar; unsigned x;
    volatile LAS unsigned* st;
};

__device__ __forceinline__ XcdBarrier xcd_barrier_post(unsigned* bar, volatile LAS unsigned* st) {
    XcdBarrier b; b.bar = bar; b.x = xb_xcc_id(); b.st = st;
    if (threadIdx.x == 0) (void)xb_add(&bar[XB_XCNT(b.x)], 1u);
    return b;
}
__device__ __forceinline__ void xcd_barrier_complete(unsigned* bar, unsigned x, unsigned& nloc, unsigned& nx) {
    const unsigned G = gridDim.x * gridDim.y * gridDim.z;
    unsigned sum, cnt, mine, sp = 0u;
    for (;;) {
        sum = 0u; cnt = 0u; mine = 0u;
#pragma unroll
        for (unsigned j = 0; j < 16; ++j) { const unsigned c = xb_ld(&bar[XB_XCNT(j)]); sum += c; cnt += (c > 0u) ? 1u : 0u; mine = (j == x) ? c : mine; }
        if (sum == G) break;
        __builtin_amdgcn_s_sleep(1);
        if ((++sp & 255u) == 0u) { if (xb_ld(&bar[XB_TMO])) break; if (sp > XB_SPIN_CAP) { atomicAdd(&bar[XB_TMO], 1u); break; } }
    }
    nloc = mine > 0u ? mine : 1u; nx = cnt > 0u ? cnt : 1u;
}

__device__ __forceinline__ void xcd_barrier(const XcdBarrier& b) {
    asm volatile("s_waitcnt vmcnt(0)" ::: "memory");
    __syncthreads();
    if (threadIdx.x == 0) {
        unsigned* bar = b.bar;
        __builtin_amdgcn_s_waitcnt(0);
        unsigned nloc = b.st[0], nx = b.st[1];
        if (nloc == 0u) { xcd_barrier_complete(bar, b.x, nloc, nx); b.st[0] = nloc; b.st[1] = nx; }
        const unsigned old = xb_add(&bar[XB_XSUB(b.x)], 1u);
        const unsigned gen = old / nloc;
        if (old + 1u == (gen + 1u) * nloc) {
            __builtin_amdgcn_fence(__ATOMIC_RELEASE, "agent");
            asm volatile("s_waitcnt vmcnt(0)" ::: "memory");
            const unsigned og = xb_add(&bar[XB_TOP], 1u);
            const unsigned tg = og / nx;
            if (og + 1u == (tg + 1u) * nx) xb_add(&bar[XB_TOPGEN], 1u);
            else XB_SPIN(xb_ld(&bar[XB_TOPGEN]) == tg, bar);
            __builtin_amdgcn_fence(__ATOMIC_ACQUIRE, "agent");
            xb_add(&bar[XB_XGEN(b.x)], 1u);
            asm volatile("s_waitcnt vmcnt(0)" ::: "memory");
        } else {
            XB_SPIN(xb_ld(&bar[XB_XGEN(b.x)]) == gen, bar);
            __builtin_amdgcn_fence(__ATOMIC_ACQUIRE, "agent");
            asm volatile("s_waitcnt vmcnt(0)" ::: "memory");
        }
    }
    __syncthreads();
}


#define AS1 __attribute__((address_space(1)))
constexpr int NBLK = 256;
constexpr int B_ = 2, S_ = 8192, T_ = B_ * S_, D_ = 1024, INW = 1720;
constexpr int G_ = 2, NCMP = 511;
constexpr float EPS = 1e-6f;
constexpr int C_Q = 0, C_KC = 512, C_VC = 640, C_KS = 768, C_VS = 896, C_KW = 1024, C_VW = 1152, C_GATE = 1280, C_CQ = 1304, C_CKV = 1560, C_KR = 1688;

#define WSYNC() do { __builtin_amdgcn_wave_barrier(); asm volatile("s_waitcnt lgkmcnt(0)" ::: "memory"); __builtin_amdgcn_wave_barrier(); } while (0)

__device__ __forceinline__ int tid_() { int t = threadIdx.x; asm volatile("" : "+v"(t)); return t; }
template <class T> __device__ __forceinline__ T* as_global(T* p) { return (T*)(__attribute__((address_space(1))) T*)p; }
__device__ __forceinline__ float wsum(float v) {
#pragma unroll
    for (int o = 32; o > 0; o >>= 1) v += __shfl_xor(v, o);
    return v;
}
__device__ __forceinline__ float wmax(float v) {
#pragma unroll
    for (int o = 32; o > 0; o >>= 1) v = fmaxf(v, __shfl_xor(v, o));
    return v;
}
__device__ __forceinline__ float gelu_tanh(float x) {
    const float u = 0.7978845608028654f * (x + 0.044715f * x * x * x);
    return 0.5f * x * (1.f + tanhf(u));
}

__device__ const float ROPE_F16[8] = {1.000000000e+00f, 1.939227432e-01f, 3.760603070e-02f, 7.292664610e-03f, 1.414213562e-03f, 2.742481884e-04f, 5.318296098e-05f, 1.031338616e-05f};
__device__ const float ROPE_F32[16] = {1.000000000e+00f, 4.403665960e-01f, 1.939227432e-01f, 8.539710194e-02f, 3.760603070e-02f, 1.656043902e-02f, 7.292664610e-03f, 3.211445874e-03f,
                                       1.414213562e-03f, 6.227723788e-04f, 2.742481884e-04f, 1.207697351e-04f, 5.318296098e-05f, 2.341999971e-05f, 1.031338616e-05f, 4.541670478e-06f};

typedef __attribute__((ext_vector_type(8))) short bf16x8;
typedef __attribute__((ext_vector_type(16))) float f32x16;
typedef __attribute__((ext_vector_type(2))) __bf16 bf16x2_t;
__device__ __forceinline__ unsigned cvtpk(float lo, float hi) { unsigned r; asm("v_cvt_pk_bf16_f32 %0, %1, %2" : "=v"(r) : "v"(lo), "v"(hi)); return r; }
__device__ __forceinline__ float bflo(unsigned u) { return __uint_as_float(u << 16); }
__device__ __forceinline__ float bfhi(unsigned u) { return __uint_as_float(u & 0xffff0000u); }
__device__ __forceinline__ float dot2bf(unsigned a, unsigned b, float c) { return __builtin_amdgcn_fdot2_f32_bf16(__builtin_bit_cast(bf16x2_t, a), __builtin_bit_cast(bf16x2_t, b), c, false); }

__device__ __forceinline__ float pair_max(float x) { auto rr = __builtin_amdgcn_permlane32_swap(__float_as_uint(x), __float_as_uint(x), false, false); return fmaxf(__uint_as_float(rr[0]), __uint_as_float(rr[1])); }
__device__ __forceinline__ float pair_sum(float x) { auto rr = __builtin_amdgcn_permlane32_swap(__float_as_uint(x), __float_as_uint(x), false, false); return __uint_as_float(rr[0]) + __uint_as_float(rr[1]); }
typedef float f32x2_t __attribute__((ext_vector_type(2)));
__device__ __forceinline__ float max3f(float a, float b, float c) { float r; asm("v_max3_f32 %0, %1, %2, %3" : "=v"(r) : "v"(a), "v"(b), "v"(c)); return r; }
__device__ __forceinline__ float quad_sum(float x) {
    float y = x + __uint_as_float(__builtin_amdgcn_mov_dpp(__float_as_uint(x), 0xB1, 0xF, 0xF, true));
    return y + __uint_as_float(__builtin_amdgcn_mov_dpp(__float_as_uint(y), 0x4E, 0xF, 0xF, true));
}
#define MFMA32(a, b, c) __builtin_amdgcn_mfma_f32_32x32x16_bf16(a, b, c, 0, 0, 0)
typedef unsigned u32x4 __attribute__((ext_vector_type(4)));
constexpr int LDS_PITCH = 144;
__device__ __forceinline__ int crow(int r, int hi) { return (r & 3) + 8 * (r >> 2) + 4 * hi; }

template <int WM_, int WN_, int MI_, int NI_>
struct GemmShape {
    static constexpr int WM = WM_, WN = WN_, MI = MI_, NI = NI_;
    static constexpr int BM = WM * MI * 32, BN = WN * NI * 32, ROWS = BM + BN;
    static constexpr int CHUNKS = ROWS * 8 / 512;
    static constexpr int STAGE_BYTES = ROWS * LDS_PITCH;
    static_assert(WM * WN == 8 && (ROWS * 8) % 512 == 0, "8 waves; whole chunks per thread");
};
template <class SH, unsigned TOKMASK, int CUR>
__device__ __forceinline__ void gemm_step(unsigned char* lds, const unsigned short* const (&gp)[SH::CHUNKS], const int (&lo)[SH::CHUNKS], u32x4 (&g)[2][SH::CHUNKS],
                                          f32x16 (&acc)[SH::MI][SH::NI], int kt, int nk, int aoff, int boff) {
    const unsigned char* st = lds + (kt & 1) * SH::STAGE_BYTES;
    if (kt + 2 < nk) {
#pragma unroll
        for (int i = 0; i < SH::CHUNKS; ++i) g[CUR][i] = *(const u32x4*)(gp[i] + (long)(kt + 2) * 64);
    }
#pragma unroll
    for (int ks = 0; ks < 4; ++ks) {
        bf16x8 af[SH::MI], bfr[SH::NI];
#pragma unroll
        for (int mi = 0; mi < SH::MI; ++mi) af[mi] = *(const bf16x8*)(st + aoff + mi * 32 * LDS_PITCH + ks * 32);
#pragma unroll
        for (int ni = 0; ni < SH::NI; ++ni) bfr[ni] = *(const bf16x8*)(st + boff + ni * 32 * LDS_PITCH + ks * 32);
#pragma unroll
        for (int mi = 0; mi < SH::MI; ++mi)
#pragma unroll
            for (int ni = 0; ni < SH::NI; ++ni)
                acc[mi][ni] = ((TOKMASK >> ni) & 1u) ? MFMA32(bfr[ni], af[mi], acc[mi][ni]) : MFMA32(af[mi], bfr[ni], acc[mi][ni]);
    }
    if (kt + 1 < nk) {
        unsigned char* sn = lds + ((kt + 1) & 1) * SH::STAGE_BYTES;
#pragma unroll
        for (int i = 0; i < SH::CHUNKS; ++i) *(u32x4*)(sn + lo[i]) = g[CUR ^ 1][i];
    }
    __syncthreads();
}
template <class SH, unsigned TOKMASK>
__device__ __forceinline__ void gemm_mainloop(const unsigned short* __restrict__ A0, long lda, const unsigned short* __restrict__ B0, long ldb, int K,
                                              unsigned char* lds, f32x16 (&acc)[SH::MI][SH::NI], int tid) {
    const int lane = tid & 63, wave = __builtin_amdgcn_readfirstlane(tid >> 6), r32 = lane & 31, hi = lane >> 5;
    const int wm = wave / SH::WN, wn = wave % SH::WN;
    const unsigned short* gp[SH::CHUNKS]; int lo[SH::CHUNKS];
#pragma unroll
    for (int i = 0; i < SH::CHUNKS; ++i) {
        const int c = tid + i * 512, row = c >> 3, kc = c & 7;
        gp[i] = (row < SH::BM) ? (A0 + (long)row * lda + kc * 8) : (B0 + (long)(row - SH::BM) * ldb + kc * 8);
        lo[i] = row * LDS_PITCH + kc * 16;
    }
    u32x4 g[2][SH::CHUNKS];
    const int nk = K >> 6;
#pragma unroll
    for (int i = 0; i < SH::CHUNKS; ++i) { g[0][i] = *(const u32x4*)gp[i]; g[1][i] = *(const u32x4*)(gp[i] + 64); }
#pragma unroll
    for (int i = 0; i < SH::CHUNKS; ++i) *(u32x4*)(lds + lo[i]) = g[0][i];
    __syncthreads();
    const int aoff = (wm * SH::MI * 32 + r32) * LDS_PITCH + hi * 16;
    const int boff = (SH::BM + wn * SH::NI * 32 + r32) * LDS_PITCH + hi * 16;
    for (int kt = 0; kt < nk; kt += 2) {
        gemm_step<SH, TOKMASK, 0>(lds, gp, lo, g, acc, kt, nk, aoff, boff);
        gemm_step<SH, TOKMASK, 1>(lds, gp, lo, g, acc, kt + 1, nk, aoff, boff);
    }
}

typedef __attribute__((ext_vector_type(4))) float f32x4_t;
namespace g256 {
constexpr int BK = 64, HALF = 128, HT = HALF * BK;
__device__ __forceinline__ int lds_byte(int r, int c) { const int st = (r >> 4) * 2 + (c >> 5), rr = r & 15, cc = c & 31, ob = rr * 64 + cc * 2; return st * 1024 + (ob ^ (((ob >> 9) & 1) << 5)); }
__device__ __forceinline__ void stage_rc(int b, int& R, int& C) { const int st = b / 1024, sb = b % 1024, swz = sb ^ (((sb >> 9) & 1) << 5); R = (st >> 1) * 16 + swz / 64; C = (st & 1) * 32 + (swz % 64) / 2; }
template <int K, int PITCH = K>
__device__ __forceinline__ void mainloop(const unsigned short* __restrict__ A, const unsigned short* __restrict__ Bt, int brow, int bcol, unsigned short* shm, f32x4_t (&acc)[2][2][4][2]) {
#define SA(b, h) (shm + ((b) * 2 + (h)) * HT)
#define SB(b, h) (shm + (4 + (b) * 2 + (h)) * HT)
#define STAGE_X(T, P, BASE, br, kt) do { const AS1 char* ub_ = (const AS1 char*)(BASE) + ((long)(br) * PITCH + (long)(kt) * BK) * 2;     \
    for (int i_ = 0; i_ < 2; ++i_) { const int b_ = (T) * 16 + i_ * 8192; int r_, c_; stage_rc(b_, r_, c_); \
      __builtin_amdgcn_global_load_lds((const AS1 unsigned*)(ub_ + (unsigned)(r_ * PITCH + c_) * 2u), (LAS unsigned*)((LAS char*)(P) + b_), 16, 0, 0); } } while (0)
#define STAGE(P, BASE, br, kt) STAGE_X(tx, P, BASE, br, kt)
#define LDA(dst, b, h) for (int m = 0; m < 4; ++m) for (int k = 0; k < 2; ++k) dst[m][k] = *reinterpret_cast<const bf16x8*>((char*)SA(b, h) + lds_byte(wr * 64 + m * 16 + fr, k * 32 + fq * 8))
#define LDB(dst, b, h) for (int n = 0; n < 2; ++n) for (int k = 0; k < 2; ++k) dst[n][k] = *reinterpret_cast<const bf16x8*>((char*)SB(b, h) + lds_byte(wc * 32 + n * 16 + fr, k * 32 + fq * 8))
#define MMA(ai, bj, At_, Bt_) do { __builtin_amdgcn_s_setprio(1); \
    for (int m = 0; m < 4; ++m) for (int n = 0; n < 2; ++n) for (int k = 0; k < 2; ++k) acc[ai][bj][m][n] = __builtin_amdgcn_mfma_f32_16x16x32_bf16(At_[m][k], Bt_[n][k], acc[ai][bj][m][n], 0, 0, 0); \
    __builtin_amdgcn_s_setprio(0); } while (0)
#define WAIT_V(n) asm volatile("s_waitcnt vmcnt(" #n ")" ::: "memory")
#define WAIT_L(n) asm volatile("s_waitcnt lgkmcnt(" #n ")" ::: "memory")
#define BAR __builtin_amdgcn_s_barrier()
#define SCHED __builtin_amdgcn_sched_barrier(0)
    int tx = threadIdx.x; asm volatile("" : "+v"(tx));
    int wid = tx >> 6, lane = tx & 63, wr = wid >> 2, wc = wid & 3, fr = lane & 15, fq = lane >> 4;
    bf16x8 At[4][2], B0[2][2], B1[2][2];
    const int nt = K / BK;
    STAGE(SB(0, 0), Bt, bcol, 0); STAGE(SA(0, 0), A, brow, 0);
    STAGE(SB(0, 1), Bt, bcol + HALF, 0); STAGE(SA(0, 1), A, brow + HALF, 0);
    if (wr == 1) BAR;
    WAIT_V(4); BAR;
    STAGE(SB(1, 0), Bt, bcol, 1); STAGE(SA(1, 0), A, brow, 1); STAGE(SB(1, 1), Bt, bcol + HALF, 1);
    WAIT_V(6); BAR;
    for (int t = 0; t < nt - 2; t += 2) {
        LDB(B0, 0, 0); SCHED; LDA(At, 0, 0); STAGE(SA(1, 1), A, brow + HALF, t + 1);
        WAIT_L(8); BAR; WAIT_L(0); MMA(0, 0, At, B0); BAR; SCHED;
        LDB(B1, 0, 1); STAGE(SB(0, 0), Bt, bcol, t + 2);
        BAR; WAIT_L(0); MMA(0, 1, At, B1); BAR;
        LDA(At, 0, 1); STAGE(SA(0, 0), A, brow, t + 2);
        BAR; WAIT_L(0); MMA(1, 0, At, B0); BAR; SCHED;
        STAGE(SB(0, 1), Bt, bcol + HALF, t + 2);
        WAIT_V(6); BAR; MMA(1, 1, At, B1); BAR;
        LDB(B0, 1, 0); SCHED; LDA(At, 1, 0); STAGE(SA(0, 1), A, brow + HALF, t + 2);
        WAIT_L(8); BAR; WAIT_L(0); MMA(0, 0, At, B0); BAR; SCHED;
        LDB(B1, 1, 1); STAGE(SB(1, 0), Bt, bcol, t + 3);
        BAR; WAIT_L(0); MMA(0, 1, At, B1); BAR;
        LDA(At, 1, 1); STAGE(SA(1, 0), A, brow, t + 3);
        BAR; WAIT_L(0); MMA(1, 0, At, B0); BAR; SCHED;
        STAGE(SB(1, 1), Bt, bcol + HALF, t + 3);
        WAIT_V(6); BAR; MMA(1, 1, At, B1); BAR;
    }
    int tz = threadIdx.x; asm volatile("" : "+v"(tz)); wid = tz >> 6; lane = tz & 63; wr = wid >> 2; wc = wid & 3; fr = lane & 15; fq = lane >> 4;
    { LDB(B0, 0, 0); WAIT_V(0); LDA(At, 0, 0); STAGE_X(tz, SA(1, 1), A, brow + HALF, nt - 1);
      BAR; WAIT_L(0); MMA(0, 0, At, B0); BAR;
      LDB(B1, 0, 1); BAR; WAIT_L(0); MMA(0, 1, At, B1); BAR;
      LDA(At, 0, 1); WAIT_V(4); BAR; WAIT_L(0); MMA(1, 0, At, B0); MMA(1, 1, At, B1); BAR; }
    { LDB(B0, 1, 0); LDA(At, 1, 0); WAIT_V(2); BAR; WAIT_L(0); MMA(0, 0, At, B0); BAR;
      LDB(B1, 1, 1); WAIT_V(0); BAR; WAIT_L(0); MMA(0, 1, At, B1); BAR;
      LDA(At, 1, 1); BAR; WAIT_L(0); MMA(1, 0, At, B0); MMA(1, 1, At, B1); BAR; }
    if (wr == 0) BAR;
#undef SA
#undef SB
#undef STAGE_X
#undef STAGE
#undef LDA
#undef LDB
#undef MMA
#undef WAIT_V
#undef WAIT_L
#undef BAR
#undef SCHED
}
}

__device__ __forceinline__ void p5_outproj_256(unsigned char* lds, const unsigned short* __restrict__ mix, const unsigned short* __restrict__ wt_out, const float* __restrict__ ssqa, const float* __restrict__ ssqb,
                                               const float* __restrict__ x, float* __restrict__ out, unsigned short* __restrict__ hb, float* __restrict__ hss) {
    const int vcu = (blockIdx.x & 7) * (NBLK / 8) + (blockIdx.x >> 3);
    for (int tile = vcu; tile < 64 * 4; tile += NBLK) {
        const int m0 = (tile >> 2) * 256, n0 = (tile & 3) * 256;
        f32x4_t acc[2][2][4][2];
#pragma unroll
        for (int ai = 0; ai < 2; ++ai)
#pragma unroll
            for (int bj = 0; bj < 2; ++bj)
#pragma unroll
                for (int m = 0; m < 4; ++m)
#pragma unroll
                    for (int n = 0; n < 2; ++n) acc[ai][bj][m][n] = f32x4_t{0.f, 0.f, 0.f, 0.f};
        g256::mainloop<512, 1024>(wt_out, mix, n0, m0, (unsigned short*)lds, acc);
        float rb[2][2];
        {
            const int tid = tid_(); const int lane = tid & 63, wave = __builtin_amdgcn_readfirstlane(tid >> 6), wc = wave & 3, fr = lane & 15;
#pragma unroll
            for (int bj = 0; bj < 2; ++bj)
#pragma unroll
                for (int n = 0; n < 2; ++n) {
                    const long tok = m0 + bj * 128 + wc * 32 + n * 16 + fr; float sa = 0.f, sb = 0.f;
#pragma unroll
                    for (int hh = 0; hh < 8; ++hh) { sa += ssqa[(long)hh * T_ + tok]; sb += ssqb[(long)hh * T_ + tok]; }
                    rb[bj][n] = rsqrtf(sb * (1.f / 512.f) + EPS); const float ratio = rsqrtf(sa * (1.f / 512.f) + EPS) / rb[bj][n];
#pragma unroll
                    for (int ai = 0; ai < 2; ++ai)
#pragma unroll
                        for (int m = 0; m < 4; ++m) acc[ai][bj][m][n] *= ratio;
                }
        }
        g256::mainloop<512, 1024>(wt_out + 512, mix + 512, n0, m0, (unsigned short*)lds, acc);
        const int tid = tid_(); const int lane = tid & 63, wave = __builtin_amdgcn_readfirstlane(tid >> 6), wr = wave >> 2, wc = wave & 3, fr = lane & 15, fq = lane >> 4;
#pragma unroll
        for (int bj = 0; bj < 2; ++bj)
#pragma unroll
            for (int n = 0; n < 2; ++n) {
                const long tok = m0 + bj * 128 + wc * 32 + n * 16 + fr; const float r = rb[bj][n];
                float ss = 0.f;
#pragma unroll
                for (int ai = 0; ai < 2; ++ai)
#pragma unroll
                    for (int m = 0; m < 4; ++m) {
                        const int nrow = n0 + ai * 128 + wr * 64 + m * 16 + fq * 4;
                        const float4 xv = *(const float4*)(x + tok * 1024 + nrow);
                        float4 hv; hv.x = xv.x + acc[ai][bj][m][n][0] * r; hv.y = xv.y + acc[ai][bj][m][n][1] * r; hv.z = xv.z + acc[ai][bj][m][n][2] * r; hv.w = xv.w + acc[ai][bj][m][n][3] * r;
                        *(float4*)(out + tok * 1024 + nrow) = hv;
                        uint2 pk; pk.x = cvtpk(hv.x, hv.y); pk.y = cvtpk(hv.z, hv.w);
                        *(uint2*)(hb + tok * 1024 + nrow) = pk;
                        ss += hv.x * hv.x + hv.y * hv.y + hv.z * hv.z + hv.w * hv.w;
                    }
                { auto r1 = __builtin_amdgcn_permlane16_swap(__float_as_uint(ss), __float_as_uint(ss), false, false); ss = __uint_as_float(r1[0]) + __uint_as_float(r1[1]); }
                ss = pair_sum(ss);
                if (fq == 0) { hss[tok * 16 + (n0 >> 8) * 4 + wr] = ss; hss[tok * 16 + (n0 >> 8) * 4 + 2 + wr] = 0.f; }
            }
        __syncthreads();
    }
}
__device__ __forceinline__ void p6_peerq_256(unsigned char* lds, const unsigned short* __restrict__ hb, const unsigned short* __restrict__ wt_q, const float* __restrict__ hss,
                                             unsigned short* __restrict__ pqb, float* __restrict__ pss) {
    const int vcu = (blockIdx.x & 7) * (NBLK / 8) + (blockIdx.x >> 3);
    for (int tile = vcu; tile < 64 * 8; tile += NBLK) {
        const int m0 = (tile >> 3) * 256, n0 = (tile & 7) * 256;
        f32x4_t acc[2][2][4][2];
#pragma unroll
        for (int ai = 0; ai < 2; ++ai)
#pragma unroll
            for (int bj = 0; bj < 2; ++bj)
#pragma unroll
                for (int m = 0; m < 4; ++m)
#pragma unroll
                    for (int n = 0; n < 2; ++n) acc[ai][bj][m][n] = f32x4_t{0.f, 0.f, 0.f, 0.f};
        g256::mainloop<1024>(wt_q, hb, n0, m0, (unsigned short*)lds, acc);
        const int tid = tid_(); const int lane = tid & 63, wave = __builtin_amdgcn_readfirstlane(tid >> 6), wr = wave >> 2, wc = wave & 3, fr = lane & 15, fq = lane >> 4;
#pragma unroll
        for (int bj = 0; bj < 2; ++bj)
#pragma unroll
            for (int n = 0; n < 2; ++n) {
                const long tok = m0 + bj * 128 + wc * 32 + n * 16 + fr;
                const float4* hp = (const float4*)(hss + tok * 16);
                const float4 s0 = hp[0], s1 = hp[1], s2 = hp[2], s3 = hp[3];
                const float rs = rsqrtf((s0.x + s0.y + s0.z + s0.w + s1.x + s1.y + s1.z + s1.w + s2.x + s2.y + s2.z + s2.w + s3.x + s3.y + s3.z + s3.w) * (1.f / 1024.f) + EPS);
                float ss = 0.f;
#pragma unroll
                for (int ai = 0; ai < 2; ++ai)
#pragma unroll
                    for (int m = 0; m < 4; ++m) {
                        const int nrow = n0 + ai * 128 + wr * 64 + m * 16 + fq * 4;
                        const float v0 = acc[ai][bj][m][n][0] * rs, v1 = acc[ai][bj][m][n][1] * rs, v2 = acc[ai][bj][m][n][2] * rs, v3 = acc[ai][bj][m][n][3] * rs;
                        uint2 pk; pk.x = cvtpk(v0, v1); pk.y = cvtpk(v2, v3);
                        *(uint2*)(pqb + tok * 2048 + nrow) = pk;
                        ss += v0 * v0 + v1 * v1 + v2 * v2 + v3 * v3;
                    }
                { auto r1 = __builtin_amdgcn_permlane16_swap(__float_as_uint(ss), __float_as_uint(ss), false, false); ss = __uint_as_float(r1[0]) + __uint_as_float(r1[1]); }
                ss = pair_sum(ss);
                if (fq == 0) { pss[tok * 32 + (n0 >> 8) * 4 + wr] = ss; pss[tok * 32 + (n0 >> 8) * 4 + 2 + wr] = 0.f; }
            }
        __syncthreads();
    }
}

__device__ __forceinline__ unsigned ordkey(float f) { const unsigned u = __float_as_uint(f); return u ^ ((unsigned)((int)u >> 31) | 0x80000000u); }
__device__ __forceinline__ float orddec(unsigned k) { return __uint_as_float((k & 0x80000000u) ? (k & 0x7fffffffu) : ~k); }
#define CE_DESC(a, b) do { const unsigned mx_ = max(a, b), mn_ = min(a, b); a = mx_; b = mn_; } while (0)
__device__ __forceinline__ void sort16_desc(unsigned (&v)[16]) {
#define CE2(i, j) CE_DESC(v[i], v[j])
    CE2(0, 13); CE2(1, 12); CE2(2, 15); CE2(3, 14); CE2(4, 8); CE2(5, 6); CE2(7, 11); CE2(9, 10);
    CE2(0, 5); CE2(1, 7); CE2(2, 9); CE2(3, 4); CE2(6, 13); CE2(8, 14); CE2(10, 15); CE2(11, 12);
    CE2(0, 1); CE2(2, 3); CE2(4, 5); CE2(6, 8); CE2(7, 9); CE2(10, 11); CE2(12, 13); CE2(14, 15);
    CE2(0, 2); CE2(1, 3); CE2(4, 10); CE2(5, 11); CE2(6, 7); CE2(8, 9); CE2(12, 14); CE2(13, 15);
    CE2(1, 2); CE2(3, 12); CE2(4, 6); CE2(5, 7); CE2(8, 10); CE2(9, 11); CE2(13, 14);
    CE2(1, 4); CE2(2, 6); CE2(5, 8); CE2(7, 10); CE2(9, 13); CE2(11, 14);
    CE2(2, 4); CE2(3, 6); CE2(9, 12); CE2(11, 13);
    CE2(3, 5); CE2(6, 8); CE2(7, 9); CE2(10, 12);
    CE2(3, 4); CE2(5, 6); CE2(7, 8); CE2(9, 10); CE2(11, 12);
    CE2(6, 7); CE2(8, 9);
#undef CE2
}
__device__ __forceinline__ void bitonic16_desc(unsigned (&a)[16]) {
#pragma unroll
    for (int j = 8; j > 0; j >>= 1)
#pragma unroll
        for (int i = 0; i < 16; ++i) { const int l = i ^ j; if (l > i) CE_DESC(a[i], a[l]); }
}
__device__ __forceinline__ void merge16_desc(unsigned (&a)[16], const unsigned (&b)[16]) {
#pragma unroll
    for (int i = 0; i < 16; ++i) a[i] = max(a[i], b[15 - i]);
#pragma unroll
    for (int j = 8; j > 0; j >>= 1)
#pragma unroll
        for (int i = 0; i < 16; ++i) { const int l = i ^ j; if (l > i) CE_DESC(a[i], a[l]); }
}
__device__ __forceinline__ void top16_of_lanepair(unsigned (&k0)[16], unsigned (&k1)[16], unsigned (&k2)[16], unsigned (&k3)[16]) {
    sort16_desc(k0); sort16_desc(k1); sort16_desc(k2); sort16_desc(k3);
    merge16_desc(k0, k1); merge16_desc(k2, k3); merge16_desc(k0, k2);
    unsigned o[16];
#pragma unroll
    for (int i = 0; i < 16; ++i) { auto rr = __builtin_amdgcn_permlane32_swap(k0[i], k0[i], false, false); k0[i] = rr[0]; o[i] = rr[1]; }
    merge16_desc(k0, o);
}
__device__ __forceinline__ void peer_route_mfma(unsigned char* lds, const unsigned short* __restrict__ pqb, const float* __restrict__ pss, const unsigned short* __restrict__ sk16, int* __restrict__ eo, float* __restrict__ go) {
    const int tid = tid_(); const int lane = tid & 63, w = __builtin_amdgcn_readfirstlane(tid >> 6), r32 = lane & 31, hi = lane >> 5;
    const int h = blockIdx.x & 7;
    constexpr int SKP = 272;
    for (int c16 = tid; c16 < 256 * 16; c16 += 512) { const int row = c16 >> 4, ch = c16 & 15; *(uint4*)(lds + row * SKP + ch * 16) = *(const uint4*)(sk16 + ((long)h * 256 + row) * 128 + ch * 8); }
    __syncthreads();
    for (int it = 0; it < 2; ++it) {
        const long tok = (long)((blockIdx.x >> 3) * 16 + w * 2 + it) * 32 + r32;
        const float4 ps = *(const float4*)(pss + tok * 32 + h * 4);
        const float rs = rsqrtf((ps.x + ps.y + ps.z + ps.w) * (1.f / 256.f) + EPS);
        unsigned T1[16], T2[16];
#pragma unroll
        for (int c = 0; c < 2; ++c) {
            f32x16 acc[4];
#pragma unroll
            for (int mt = 0; mt < 4; ++mt)
#pragma unroll
                for (int r = 0; r < 16; ++r) acc[mt][r] = 0.f;
            const unsigned short* qrow = pqb + tok * 2048 + h * 256 + c * 128 + hi * 8;
            const unsigned char* krow = lds + (c * 128 + r32) * SKP + hi * 16;
#pragma unroll 2
            for (int ks = 0; ks < 8; ++ks) {
                const bf16x8 qf = *(const bf16x8*)(qrow + ks * 16);
#pragma unroll
                for (int mt = 0; mt < 4; ++mt) { const bf16x8 kf = *(const bf16x8*)(krow + mt * 32 * SKP + ks * 32); acc[mt] = MFMA32(kf, qf, acc[mt]); }
            }
            unsigned k0[16], k1[16], k2[16], k3[16];
#pragma unroll
            for (int r = 0; r < 16; ++r) {
                const unsigned idx = 127u - (unsigned)crow(r, hi);
                k0[r] = (ordkey(acc[0][r]) & ~127u) | idx; k1[r] = (ordkey(acc[1][r]) & ~127u) | (idx - 32u);
                k2[r] = (ordkey(acc[2][r]) & ~127u) | (idx - 64u); k3[r] = (ordkey(acc[3][r]) & ~127u) | (idx - 96u);
            }
            top16_of_lanepair(k0, k1, k2, k3);
            if (c == 0) {
#pragma unroll
                for (int i = 0; i < 16; ++i) T1[i] = k0[i];
            } else {
#pragma unroll
                for (int i = 0; i < 16; ++i) T2[i] = k0[i];
            }
        }
        float v1[16], v2[16]; unsigned p1[4] = {0u, 0u, 0u, 0u}, p2[4] = {0u, 0u, 0u, 0u};
#pragma unroll
        for (int i = 0; i < 16; ++i) {
            v1[i] = orddec(T1[i] & ~127u) * rs; v2[i] = orddec(T2[i] & ~127u) * rs;
            p1[i >> 2] |= (127u - (T1[i] & 127u)) << (8 * (i & 3)); p2[i >> 2] |= (127u - (T2[i] & 127u)) << (8 * (i & 3));
        }
        unsigned c0[16], c1[16], c2[16];
#define CAND(a, b) ((ordkey(v1[a] + v2[b]) & ~255u) | (255u - (unsigned)((a) * 16 + (b))))
        c0[0] = CAND(0, 0); c0[1] = CAND(0, 1); c0[2] = CAND(0, 2); c0[3] = CAND(0, 3); c0[4] = CAND(0, 4); c0[5] = CAND(0, 5); c0[6] = CAND(0, 6); c0[7] = CAND(0, 7);
        c0[8] = CAND(0, 8); c0[9] = CAND(0, 9); c0[10] = CAND(0, 10); c0[11] = CAND(0, 11); c0[12] = CAND(0, 12); c0[13] = CAND(0, 13); c0[14] = CAND(0, 14); c0[15] = CAND(0, 15);
        c1[0] = CAND(1, 0); c1[1] = CAND(1, 1); c1[2] = CAND(1, 2); c1[3] = CAND(1, 3); c1[4] = CAND(1, 4); c1[5] = CAND(1, 5); c1[6] = CAND(1, 6); c1[7] = CAND(1, 7);
        c1[8] = CAND(15, 0); c1[9] = CAND(14, 0); c1[10] = CAND(13, 0); c1[11] = CAND(12, 0); c1[12] = CAND(11, 0); c1[13] = CAND(10, 0); c1[14] = CAND(9, 0); c1[15] = CAND(8, 0);
        c2[0] = CAND(2, 0); c2[1] = CAND(2, 1); c2[2] = CAND(2, 2); c2[3] = CAND(2, 3); c2[4] = CAND(2, 4); c2[5] = CAND(3, 0); c2[6] = CAND(3, 1); c2[7] = CAND(3, 2);
        c2[8] = CAND(3, 3); c2[9] = CAND(4, 0); c2[10] = CAND(4, 1); c2[11] = CAND(4, 2); c2[12] = CAND(5, 0); c2[13] = CAND(5, 1); c2[14] = CAND(6, 0); c2[15] = CAND(6, 1);
        const unsigned c70 = CAND(7, 0), c71 = CAND(7, 1);
#undef CAND
        bitonic16_desc(c1); sort16_desc(c2);
        c2[15] = max(c2[15], c70); c2[14] = max(c2[14], c71); bitonic16_desc(c2);
        merge16_desc(c0, c1); merge16_desc(c0, c2);
        float ev[16]; int ee[16]; float l = 0.f; const float mx = orddec(c0[0] & ~255u);
#pragma unroll
        for (int i = 0; i < 16; ++i) {
            const unsigned ci = 255u - (c0[i] & 255u); const unsigned a = ci >> 4, b = ci & 15u;
            const unsigned wa = (a >> 2) == 0 ? p1[0] : ((a >> 2) == 1 ? p1[1] : ((a >> 2) == 2 ? p1[2] : p1[3]));
            const unsigned wb = (b >> 2) == 0 ? p2[0] : ((b >> 2) == 1 ? p2[1] : ((b >> 2) == 2 ? p2[2] : p2[3]));
            const unsigned i1 = (wa >> (8 * (a & 3u))) & 255u, i2 = (wb >> (8 * (b & 3u))) & 255u;
            ee[i] = (int)(i1 * 128u + i2);
            ev[i] = __expf(orddec(c0[i] & ~255u) - mx); l += ev[i];
        }
        const float inv = 1.f / l;
        if (hi == 0) {
            int4* ep = (int4*)(eo + tok * 128 + h * 16);
            ep[0] = make_int4(ee[0], ee[1], ee[2], ee[3]); ep[1] = make_int4(ee[4], ee[5], ee[6], ee[7]); ep[2] = make_int4(ee[8], ee[9], ee[10], ee[11]); ep[3] = make_int4(ee[12], ee[13], ee[14], ee[15]);
        } else {
            float4* gp = (float4*)(go + tok * 128 + h * 16);
            gp[0] = make_float4(ev[0] * inv, ev[1] * inv, ev[2] * inv, ev[3] * inv); gp[1] = make_float4(ev[4] * inv, ev[5] * inv, ev[6] * inv, ev[7] * inv);
            gp[2] = make_float4(ev[8] * inv, ev[9] * inv, ev[10] * inv, ev[11] * inv); gp[3] = make_float4(ev[12] * inv, ev[13] * inv, ev[14] * inv, ev[15] * inv);
        }
    }
}

template <int DQK>
struct FA {
    static constexpr int NDS = DQK / 16, KP = DQK * 2 + 16, KBYTES = 64 * KP, VP = 144, VBYTES = 64 * VP, STAGE = KBYTES + VBYTES;
    static constexpr int KCH = 64 * DQK / 8, NCH = KCH + 512, SLOTS = (NCH + 511) / 512;
};
constexpr float FA_THR = 8.f;
constexpr float FA_NEG = -1e30f;
struct FaRegs { uint4 g0, g1, g2; };
template <int DQK>
__device__ __forceinline__ uint4 fa_load1(const unsigned short* __restrict__ Kg, int kpitch, const unsigned short* __restrict__ Vg, int vpitch, int tid, int i) {
    int c = tid + i * 512; if (c >= FA<DQK>::NCH) c = 0;
    const int key = c / (DQK / 8), kc = c % (DQK / 8); const int c2 = c - FA<DQK>::KCH; const int d = c2 >> 3, vc = c2 & 7;
    const unsigned koff = (unsigned)(key * kpitch + kc * 8) * 2u, voff = (unsigned)(d * vpitch + vc * 8) * 2u;
#if defined(__HIP_DEVICE_COMPILE__)
    typedef unsigned u32x4_t __attribute__((ext_vector_type(4)));
    const u32x4_t v = (c < FA<DQK>::KCH) ? *(const AS1 u32x4_t*)((const AS1 char*)Kg + koff) : *(const AS1 u32x4_t*)((const AS1 char*)Vg + voff);
    return make_uint4(v.x, v.y, v.z, v.w);
#else
    (void)koff; (void)voff; return make_uint4(0u, 0u, 0u, 0u);
#endif
}
template <int DQK>
__device__ __forceinline__ void fa_store1(unsigned char* st, const uint4& g, int tid, int i) {
    const int c = tid + i * 512;
    const int key = c / (DQK / 8), kc = c % (DQK / 8); const int c2 = c - FA<DQK>::KCH; const int d = c2 >> 3, vc = c2 & 7;
    const int off = (c < FA<DQK>::KCH) ? (key * FA<DQK>::KP + kc * 16) : (FA<DQK>::KBYTES + d * FA<DQK>::VP + vc * 16);
    if (c < FA<DQK>::NCH) *(uint4*)(st + off) = g;
}
template <int DQK>
__device__ __forceinline__ void fa_load(const unsigned short* __restrict__ Kg, int kpitch, const unsigned short* __restrict__ Vg, int vpitch, FaRegs& g, int tid) {
    g.g0 = fa_load1<DQK>(Kg, kpitch, Vg, vpitch, tid, 0); g.g1 = fa_load1<DQK>(Kg, kpitch, Vg, vpitch, tid, 1);
    if (FA<DQK>::SLOTS > 2) g.g2 = fa_load1<DQK>(Kg, kpitch, Vg, vpitch, tid, 2);
}
template <int DQK>
__device__ __forceinline__ void fa_store(unsigned char* st, const FaRegs& g, int tid) {
    fa_store1<DQK>(st, g.g0, tid, 0); fa_store1<DQK>(st, g.g1, tid, 1);
    if (FA<DQK>::SLOTS > 2) fa_store1<DQK>(st, g.g2, tid, 2);
}
template <int DQK, int MODE, bool STATS_ONLY = false>
__device__ __forceinline__ void fa_tile(const unsigned char* st, const bf16x8 (&qf)[FA<DQK>::NDS], f32x16 (&o)[2], float& mref, float& l, int key0, int qpos, int lane, bool need_mask, bool colsel = true) {
    asm volatile("" : "+v"(lane));
    const int r32 = lane & 31, hi = lane >> 5;
    f32x16 s0, s1;
#pragma unroll
    for (int r = 0; r < 16; ++r) { s0[r] = 0.f; s1[r] = 0.f; }
    {
        bf16x8 k0 = *(const bf16x8*)(st + r32 * FA<DQK>::KP + hi * 16);
        bf16x8 k1 = *(const bf16x8*)(st + (32 + r32) * FA<DQK>::KP + hi * 16);
#pragma unroll
        for (int ds = 0; ds < FA<DQK>::NDS; ++ds) {
            bf16x8 n0 = k0, n1 = k1;
            if (ds + 1 < FA<DQK>::NDS) {
                n0 = *(const bf16x8*)(st + r32 * FA<DQK>::KP + (ds + 1) * 32 + hi * 16);
                n1 = *(const bf16x8*)(st + (32 + r32) * FA<DQK>::KP + (ds + 1) * 32 + hi * 16);
            }
            s0 = MFMA32(k0, qf[ds], s0); s1 = MFMA32(k1, qf[ds], s1);
            k0 = n0; k1 = n1;
            __builtin_amdgcn_sched_barrier(0);
        }
    }
    __builtin_amdgcn_sched_barrier(0);
    if (MODE != 0 && need_mask) {
#pragma unroll
        for (int r = 0; r < 16; ++r) {
            const int ka = key0 + crow(r, hi), kb = ka + 32;
            bool ma, mb;
            if (MODE == 4) { ma = 16 * ka + 31 > qpos; mb = 16 * kb + 31 > qpos; }
            else { ma = ka > qpos; mb = kb > qpos; }
            if (MODE == 2) { ma = ma || (ka <= qpos - 512); mb = mb || (kb <= qpos - 512); }
            if (ma) s0[r] = -INFINITY;
            if (mb) s1[r] = -INFINITY;
        }
    }
    float mxa = max3f(s0[0], s0[1], s0[2]), mxb = max3f(s1[0], s1[1], s1[2]);
#pragma unroll
    for (int r = 3; r < 15; r += 2) { mxa = max3f(mxa, s0[r], s0[r + 1]); mxb = max3f(mxb, s1[r], s1[r + 1]); }
    float mx = max3f(mxa, mxb, fmaxf(s0[15], s1[15]));
    if (MODE == 3) mx = colsel ? mx : -INFINITY;
    mx = pair_max(mx);
    if (__any(mx > mref + FA_THR)) {
        const float mnew = (mx > mref + FA_THR) ? mx : mref;
        const float alpha = __builtin_amdgcn_exp2f(mref - mnew);
        mref = mnew; l *= alpha;
#pragma unroll
        for (int r = 0; r < 16; ++r) { o[0][r] *= alpha; o[1][r] *= alpha; }
    }
    const float mre = (MODE == 3) ? (colsel ? mref : INFINITY) : mref;
    const f32x2_t mm = {mre, mre};
    f32x2_t ps0 = {0.f, 0.f}, ps1 = {0.f, 0.f};
#pragma unroll
    for (int r = 0; r < 16; r += 2) {
        const f32x2_t d0 = f32x2_t{s0[r], s0[r + 1]} - mm, d1 = f32x2_t{s1[r], s1[r + 1]} - mm;
        s0[r] = __builtin_amdgcn_exp2f(d0.x); s0[r + 1] = __builtin_amdgcn_exp2f(d0.y); s1[r] = __builtin_amdgcn_exp2f(d1.x); s1[r + 1] = __builtin_amdgcn_exp2f(d1.y);
        ps0 += f32x2_t{s0[r], s0[r + 1]}; ps1 += f32x2_t{s1[r], s1[r + 1]};
    }
    ps0 += ps1;
    l += ps0.x + ps0.y;
    if (STATS_ONLY) return;
    bf16x8 pk[4];
#pragma unroll
    for (int s = 0; s < 2; ++s) {
        uint4 a, b;
        a.x = cvtpk(s0[8 * s], s0[8 * s + 1]); a.y = cvtpk(s0[8 * s + 2], s0[8 * s + 3]); a.z = cvtpk(s0[8 * s + 4], s0[8 * s + 5]); a.w = cvtpk(s0[8 * s + 6], s0[8 * s + 7]);
        b.x = cvtpk(s1[8 * s], s1[8 * s + 1]); b.y = cvtpk(s1[8 * s + 2], s1[8 * s + 3]); b.z = cvtpk(s1[8 * s + 4], s1[8 * s + 5]); b.w = cvtpk(s1[8 * s + 6], s1[8 * s + 7]);
        pk[s] = __builtin_bit_cast(bf16x8, a); pk[2 + s] = __builtin_bit_cast(bf16x8, b);
    }
    const unsigned char* vt = st + FA<DQK>::KBYTES;
    __builtin_amdgcn_sched_barrier(0);
    {
        bf16x8 v0 = *(const bf16x8*)(vt + r32 * FA<DQK>::VP + hi * 16);
        bf16x8 v1 = *(const bf16x8*)(vt + (32 + r32) * FA<DQK>::VP + hi * 16);
#pragma unroll
        for (int ks = 0; ks < 4; ++ks) {
            bf16x8 n0 = v0, n1 = v1;
            if (ks + 1 < 4) {
                n0 = *(const bf16x8*)(vt + r32 * FA<DQK>::VP + (ks + 1) * 32 + hi * 16);
                n1 = *(const bf16x8*)(vt + (32 + r32) * FA<DQK>::VP + (ks + 1) * 32 + hi * 16);
            }
            o[0] = MFMA32(v0, pk[ks], o[0]); o[1] = MFMA32(v1, pk[ks], o[1]);
            v0 = n0; v1 = n1;
            __builtin_amdgcn_sched_barrier(0);
        }
    }
}
template <int DQK>
__device__ __forceinline__ void fa_qk(const unsigned char* st, const bf16x8 (&qf)[FA<DQK>::NDS], f32x16& s0, f32x16& s1, int lane) {
    const int r32 = lane & 31, hi = lane >> 5;
#pragma unroll
    for (int r = 0; r < 16; ++r) { s0[r] = 0.f; s1[r] = 0.f; }
#pragma unroll
    for (int ds = 0; ds < FA<DQK>::NDS; ++ds) {
        const bf16x8 k0 = *(const bf16x8*)(st + r32 * FA<DQK>::KP + ds * 32 + hi * 16);
        const bf16x8 k1 = *(const bf16x8*)(st + (32 + r32) * FA<DQK>::KP + ds * 32 + hi * 16);
        s0 = MFMA32(k0, qf[ds], s0); s1 = MFMA32(k1, qf[ds], s1);
    }
}
template <int DQK, int MODE>
__device__ __forceinline__ void fa_step(const unsigned char* stc, const unsigned char* stn, const bf16x8 (&qf)[FA<DQK>::NDS], f32x16& s0, f32x16& s1, f32x16& n0, f32x16& n1,
                                        f32x16 (&o)[2], float& mref, float& l, int key0, int qpos, int lane, bool need_mask, bool colsel = true) {
    const int r32 = lane & 31, hi = lane >> 5;
    if (MODE != 0 && need_mask) {
#pragma unroll
        for (int r = 0; r < 16; ++r) {
            const int ka = key0 + crow(r, hi), kb = ka + 32;
            bool ma, mb;
            if (MODE == 4) { ma = 16 * ka + 31 > qpos; mb = 16 * kb + 31 > qpos; }
            else { ma = ka > qpos; mb = kb > qpos; }
            if (MODE == 2) { ma = ma || (ka <= qpos - 512); mb = mb || (kb <= qpos - 512); }
            if (ma) s0[r] = -INFINITY;
            if (mb) s1[r] = -INFINITY;
        }
    }
    float mxa = max3f(s0[0], s0[1], s0[2]), mxb = max3f(s1[0], s1[1], s1[2]);
#pragma unroll
    for (int r = 3; r < 15; r += 2) { mxa = max3f(mxa, s0[r], s0[r + 1]); mxb = max3f(mxb, s1[r], s1[r + 1]); }
    float mx = max3f(mxa, mxb, fmaxf(s0[15], s1[15]));
    if (MODE == 3) mx = colsel ? mx : -INFINITY;
    mx = pair_max(mx);
    if (__any(mx > mref + FA_THR)) {
        const float mnew = (mx > mref + FA_THR) ? mx : mref;
        const float alpha = __builtin_amdgcn_exp2f(mref - mnew);
        mref = mnew; l *= alpha;
#pragma unroll
        for (int r = 0; r < 16; ++r) { o[0][r] *= alpha; o[1][r] *= alpha; }
    }
    const float mre = (MODE == 3) ? (colsel ? mref : INFINITY) : mref;
    const f32x2_t mm = {mre, mre};
    __builtin_amdgcn_sched_barrier(0);
#pragma unroll
    for (int r = 0; r < 16; ++r) { n0[r] = 0.f; n1[r] = 0.f; }
    f32x2_t ps = {0.f, 0.f};
    constexpr int PER = (16 + FA<DQK>::NDS - 1) / FA<DQK>::NDS;
    {
        bf16x8 k0 = *(const bf16x8*)(stn + r32 * FA<DQK>::KP + hi * 16);
        bf16x8 k1 = *(const bf16x8*)(stn + (32 + r32) * FA<DQK>::KP + hi * 16);
#pragma unroll
        for (int ds = 0; ds < FA<DQK>::NDS; ++ds) {
            bf16x8 f0 = k0, f1 = k1;
            if (ds + 1 < FA<DQK>::NDS) {
                f0 = *(const bf16x8*)(stn + r32 * FA<DQK>::KP + (ds + 1) * 32 + hi * 16);
                f1 = *(const bf16x8*)(stn + (32 + r32) * FA<DQK>::KP + (ds + 1) * 32 + hi * 16);
            }
            n0 = MFMA32(k0, qf[ds], n0); n1 = MFMA32(k1, qf[ds], n1);
#pragma unroll
            for (int j = ds * PER; j < (ds + 1) * PER && j < 16; ++j) {
                if (j < 8) { const f32x2_t d = f32x2_t{s0[2 * j], s0[2 * j + 1]} - mm; s0[2 * j] = __builtin_amdgcn_exp2f(d.x); s0[2 * j + 1] = __builtin_amdgcn_exp2f(d.y); ps += f32x2_t{s0[2 * j], s0[2 * j + 1]}; }
                else { const int q = j - 8; const f32x2_t d = f32x2_t{s1[2 * q], s1[2 * q + 1]} - mm; s1[2 * q] = __builtin_amdgcn_exp2f(d.x); s1[2 * q + 1] = __builtin_amdgcn_exp2f(d.y); ps += f32x2_t{s1[2 * q], s1[2 * q + 1]}; }
            }
            asm volatile("" : "+v"(ps));
            k0 = f0; k1 = f1;
            __builtin_amdgcn_sched_barrier(0);
        }
    }
    l += ps.x + ps.y;
    bf16x8 pk[4];
#pragma unroll
    for (int s = 0; s < 2; ++s) {
        uint4 a, b;
        a.x = cvtpk(s0[8 * s], s0[8 * s + 1]); a.y = cvtpk(s0[8 * s + 2], s0[8 * s + 3]); a.z = cvtpk(s0[8 * s + 4], s0[8 * s + 5]); a.w = cvtpk(s0[8 * s + 6], s0[8 * s + 7]);
        b.x = cvtpk(s1[8 * s], s1[8 * s + 1]); b.y = cvtpk(s1[8 * s + 2], s1[8 * s + 3]); b.z = cvtpk(s1[8 * s + 4], s1[8 * s + 5]); b.w = cvtpk(s1[8 * s + 6], s1[8 * s + 7]);
        pk[s] = __builtin_bit_cast(bf16x8, a); pk[2 + s] = __builtin_bit_cast(bf16x8, b);
    }
    const unsigned char* vt = stc + FA<DQK>::KBYTES;
    {
        bf16x8 v0 = *(const bf16x8*)(vt + r32 * FA<DQK>::VP + hi * 16);
        bf16x8 v1 = *(const bf16x8*)(vt + (32 + r32) * FA<DQK>::VP + hi * 16);
#pragma unroll
        for (int ks = 0; ks < 4; ++ks) {
            bf16x8 f0 = v0, f1 = v1;
            if (ks + 1 < 4) {
                f0 = *(const bf16x8*)(vt + r32 * FA<DQK>::VP + (ks + 1) * 32 + hi * 16);
                f1 = *(const bf16x8*)(vt + (32 + r32) * FA<DQK>::VP + (ks + 1) * 32 + hi * 16);
            }
            o[0] = MFMA32(v0, pk[ks], o[0]); o[1] = MFMA32(v1, pk[ks], o[1]);
            v0 = f0; v1 = f1;
            __builtin_amdgcn_sched_barrier(0);
        }
    }
}
__device__ __forceinline__ int vperm(int s) { const int g = (s >> 2) & 3; const int pg = (g == 1) ? 2 : ((g == 2) ? 1 : g); return (s & ~15) | (pg << 2) | (s & 3); }

constexpr float MLA_QSCALE = 0.10206207261596575f * 1.4426950408889634f;
__device__ __forceinline__ void mla_unit(unsigned char* lds, int b, int h, int qb, const unsigned short* __restrict__ Q16, const unsigned short* __restrict__ K16, const unsigned short* __restrict__ VT16,
                                         unsigned short* __restrict__ ob16, float* __restrict__ ssqb, int tid) {
    typedef FA<96> F;
    const int lane = tid & 63, wave = __builtin_amdgcn_readfirstlane(tid >> 6), r32 = lane & 31, hi = lane >> 5;
    const int q0 = qb * 256, qpos = q0 + wave * 32 + r32; const long tok = (long)b * S_ + qpos;
    bf16x8 qf[F::NDS];
#pragma unroll
    for (int ds = 0; ds < F::NDS; ++ds) qf[ds] = *(const bf16x8*)(Q16 + tok * 768 + h * 96 + ds * 16 + hi * 8);
    f32x16 o[2];
#pragma unroll
    for (int r = 0; r < 16; ++r) { o[0][r] = 0.f; o[1][r] = 0.f; }
    float mref = FA_NEG, l = 0.f;
    const unsigned short* Kb = K16 + ((long)(b * 8 + h)) * S_ * 96;
    const unsigned short* Vb = VT16 + ((long)(b * 8 + h)) * 64 * S_;
    const int nt = (q0 + 256) / 64;
    FaRegs g;
    fa_load<96>(Kb, 96, Vb, S_, g, tid); fa_store<96>(lds, g, tid);
    fa_load<96>(Kb + (long)64 * 96, 96, Vb + 64, S_, g, tid); fa_store<96>(lds + F::STAGE, g, tid);
    __syncthreads();
    const int wmin = q0 + wave * 32, wmax = wmin + 31;
    f32x16 sa0, sa1, sb0, sb1;
    fa_qk<96>(lds, qf, sa0, sa1, lane);
#define MLA_STEP(C0, C1, N0, N1, t) do { \
        const int sc_ = (t) % 3, sn_ = ((t) + 1) % 3, sw_ = ((t) + 2) % 3; \
        if ((t) + 2 < nt) fa_load<96>(Kb + (long)((t) + 2) * 64 * 96, 96, Vb + ((t) + 2) * 64, S_, g, tid); \
        const int key0 = (t) * 64; \
        if (key0 <= wmax) fa_step<96, 1>(lds + sc_ * F::STAGE, lds + sn_ * F::STAGE, qf, C0, C1, N0, N1, o, mref, l, key0, qpos, lane, key0 + 63 > wmin); \
        if ((t) + 2 < nt) fa_store<96>(lds + sw_ * F::STAGE, g, tid); \
        __syncthreads(); } while (0)
    for (int t = 0; t < nt; t += 2) {
        MLA_STEP(sa0, sa1, sb0, sb1, t);
        MLA_STEP(sb0, sb1, sa0, sa1, t + 1);
    }
#undef MLA_STEP
    l = pair_sum(l);
    const float inv = 1.f / l;
    float ss = 0.f;
#pragma unroll
    for (int dt = 0; dt < 2; ++dt)
#pragma unroll
        for (int gq = 0; gq < 4; ++gq) {
            const float v0 = o[dt][4 * gq] * inv, v1 = o[dt][4 * gq + 1] * inv, v2 = o[dt][4 * gq + 2] * inv, v3 = o[dt][4 * gq + 3] * inv;
            uint2 pk; pk.x = cvtpk(v0, v1); pk.y = cvtpk(v2, v3);
            *(uint2*)(ob16 + tok * 1024 + 512 + h * 64 + dt * 32 + 8 * gq + 4 * hi) = pk;
            ss += v0 * v0 + v1 * v1 + v2 * v2 + v3 * v3;
        }
    ss = pair_sum(ss);
    if (hi == 0) ssqb[(long)h * T_ + tok] = ss;
}
namespace m128 {
constexpr int KP = 208, VP = 272, KBYTES = 128 * KP, VBYTES = 64 * VP, STAGE = KBYTES + VBYTES;
struct Regs { u32x4 g[5]; };
__device__ __forceinline__ void load(const unsigned short* __restrict__ Kg, const unsigned short* __restrict__ Vg, Regs& R, int tid) {
#pragma unroll
    for (int i = 0; i < 5; ++i) {
        const int c = tid + i * 512;
        if (i < 3) { const int key = c / 12, kc = c % 12; R.g[i] = *(const AS1 u32x4*)((const AS1 char*)Kg + (unsigned)(key * 96 + kc * 8) * 2u); }
        else { const int c2 = c - 1536; const int d = c2 >> 4, vc = c2 & 15; R.g[i] = *(const AS1 u32x4*)((const AS1 char*)Vg + (unsigned)(d * S_ + vc * 8) * 2u); }
    }
}
__device__ __forceinline__ void store(unsigned char* st, const Regs& R, int tid) {
#pragma unroll
    for (int i = 0; i < 5; ++i) {
        const int c = tid + i * 512;
        if (i < 3) { const int key = c / 12, kc = c % 12; *(u32x4*)(st + key * KP + kc * 16) = R.g[i]; }
        else { const int c2 = c - 1536; const int d = c2 >> 4, vc = c2 & 15; *(u32x4*)(st + KBYTES + d * VP + vc * 16) = R.g[i]; }
    }
}
__device__ __forceinline__ void tile(const unsigned char* st, const bf16x8 (&qf)[6], f32x16 (&o)[2], float& mref, float& l, int key0, int qpos, int lane, bool need_mask) {
    asm volatile("" : "+v"(lane));
    const int r32 = lane & 31, hi = lane >> 5;
    f32x16 s[4];
#pragma unroll
    for (int kb = 0; kb < 4; ++kb)
#pragma unroll
        for (int r = 0; r < 16; ++r) s[kb][r] = 0.f;
#pragma unroll
    for (int half = 0; half < 2; ++half) {
        const unsigned char* kb0 = st + ((2 * half) * 32 + r32) * KP + hi * 16, * kb1 = kb0 + 32 * KP;
        bf16x8 k0 = *(const bf16x8*)kb0, k1 = *(const bf16x8*)kb1;
#pragma unroll
        for (int ds = 0; ds < 6; ++ds) {
            bf16x8 n0 = k0, n1 = k1;
            if (ds + 1 < 6) { n0 = *(const bf16x8*)(kb0 + (ds + 1) * 32); n1 = *(const bf16x8*)(kb1 + (ds + 1) * 32); }
            s[2 * half] = MFMA32(k0, qf[ds], s[2 * half]); s[2 * half + 1] = MFMA32(k1, qf[ds], s[2 * half + 1]);
            k0 = n0; k1 = n1;
            __builtin_amdgcn_sched_barrier(0);
        }
    }
    if (need_mask) {
#pragma unroll
        for (int kb = 0; kb < 4; ++kb)
#pragma unroll
            for (int r = 0; r < 16; ++r) if (key0 + kb * 32 + crow(r, hi) > qpos) s[kb][r] = -INFINITY;
    }
    float mxa = max3f(s[0][0], s[0][1], s[0][2]), mxb = max3f(s[1][0], s[1][1], s[1][2]), mxc = max3f(s[2][0], s[2][1], s[2][2]), mxd = max3f(s[3][0], s[3][1], s[3][2]);
#pragma unroll
    for (int r = 3; r < 15; r += 2) { mxa = max3f(mxa, s[0][r], s[0][r + 1]); mxb = max3f(mxb, s[1][r], s[1][r + 1]); mxc = max3f(mxc, s[2][r], s[2][r + 1]); mxd = max3f(mxd, s[3][r], s[3][r + 1]); }
    float mx = max3f(max3f(mxa, mxb, s[0][15]), max3f(mxc, mxd, s[1][15]), fmaxf(s[2][15], s[3][15]));
    mx = pair_max(mx);
    if (__any(mx > mref + FA_THR)) {
        const float mnew = (mx > mref + FA_THR) ? mx : mref;
        const float alpha = __builtin_amdgcn_exp2f(mref - mnew);
        mref = mnew; l *= alpha;
#pragma unroll
        for (int r = 0; r < 16; ++r) { o[0][r] *= alpha; o[1][r] *= alpha; }
    }
    const f32x2_t mm = {mref, mref};
    f32x2_t ps0 = {0.f, 0.f}, ps1 = {0.f, 0.f};
    bf16x8 pk[8];
#pragma unroll
    for (int kb = 0; kb < 4; ++kb) {
        unsigned pw[8];
#pragma unroll
        for (int r = 0; r < 16; r += 2) {
            const f32x2_t d = f32x2_t{s[kb][r], s[kb][r + 1]} - mm;
            const f32x2_t e = {__builtin_amdgcn_exp2f(d.x), __builtin_amdgcn_exp2f(d.y)};
            if (r & 2) ps1 += e; else ps0 += e;
            pw[r >> 1] = cvtpk(e.x, e.y);
        }
        pk[2 * kb] = __builtin_bit_cast(bf16x8, u32x4{pw[0], pw[1], pw[2], pw[3]});
        pk[2 * kb + 1] = __builtin_bit_cast(bf16x8, u32x4{pw[4], pw[5], pw[6], pw[7]});
    }
    ps0 += ps1; l += ps0.x + ps0.y;
    const unsigned char* vt = st + KBYTES + r32 * VP + hi * 16;
    __builtin_amdgcn_sched_barrier(0);
    {
        bf16x8 v0 = *(const bf16x8*)vt, v1 = *(const bf16x8*)(vt + 32 * VP);
#pragma unroll
        for (int ks = 0; ks < 8; ++ks) {
            bf16x8 n0 = v0, n1 = v1;
            if (ks + 1 < 8) { n0 = *(const bf16x8*)(vt + (ks + 1) * 32); n1 = *(const bf16x8*)(vt + 32 * VP + (ks + 1) * 32); }
            o[0] = MFMA32(v0, pk[ks], o[0]); o[1] = MFMA32(v1, pk[ks], o[1]);
            v0 = n0; v1 = n1;
            __builtin_amdgcn_sched_barrier(0);
        }
    }
}
}
__device__ __forceinline__ void mla_unit128(unsigned char* lds, int b, int h, int qb, const unsigned short* __restrict__ Q16, const unsigned short* __restrict__ K16, const unsigned short* __restrict__ VT16,
                                            unsigned short* __restrict__ ob16, float* __restrict__ ssqb, int tid) {
    const int lane = tid & 63, wave = __builtin_amdgcn_readfirstlane(tid >> 6), r32 = lane & 31, hi = lane >> 5;
    const int q0 = qb * 256, qpos = q0 + wave * 32 + r32; const long tok = (long)b * S_ + qpos;
    bf16x8 qf[6];
#pragma unroll
    for (int ds = 0; ds < 6; ++ds) qf[ds] = *(const bf16x8*)(Q16 + tok * 768 + h * 96 + ds * 16 + hi * 8);
    f32x16 o[2];
#pragma unroll
    for (int r = 0; r < 16; ++r) { o[0][r] = 0.f; o[1][r] = 0.f; }
    float mref = FA_NEG, l = 0.f;
    const unsigned short* Kb = K16 + ((long)(b * 8 + h)) * S_ * 96;
    const unsigned short* Vb = VT16 + ((long)(b * 8 + h)) * 64 * S_;
    const int nt = (q0 + 256) / 128;
    m128::Regs g;
    m128::load(Kb, Vb, g, tid); m128::store(lds, g, tid);
    m128::load(Kb + (long)128 * 96, Vb + 128, g, tid);
    __syncthreads();
    const int wmin = q0 + wave * 32, wmax = wmin + 31;
    int sc = 0;
    for (int t = 0; t < nt; ++t) {
        const int sn = (sc == 2) ? 0 : sc + 1;
        const int key0 = t * 128;
        if (key0 <= wmax) m128::tile(lds + sc * m128::STAGE, qf, o, mref, l, key0, qpos, lane, key0 + 127 > wmin);
        if (t + 1 < nt) m128::store(lds + sn * m128::STAGE, g, tid);
        if (t + 2 < nt) m128::load(Kb + (long)(t + 2) * 128 * 96, Vb + (t + 2) * 128, g, tid);
        __syncthreads();
        sc = sn;
    }
    l = pair_sum(l);
    const float inv = 1.f / l;
    float ss = 0.f;
#pragma unroll
    for (int dt = 0; dt < 2; ++dt)
#pragma unroll
        for (int gq = 0; gq < 4; ++gq) {
            const float v0 = o[dt][4 * gq] * inv, v1 = o[dt][4 * gq + 1] * inv, v2 = o[dt][4 * gq + 2] * inv, v3 = o[dt][4 * gq + 3] * inv;
            uint2 pk2; pk2.x = cvtpk(v0, v1); pk2.y = cvtpk(v2, v3);
            *(uint2*)(ob16 + tok * 1024 + 512 + h * 64 + dt * 32 + 8 * gq + 4 * hi) = pk2;
            ss += v0 * v0 + v1 * v1 + v2 * v2 + v3 * v3;
        }
    ss = pair_sum(ss);
    if (hi == 0) ssqb[(long)h * T_ + tok] = ss;
}
__device__ __forceinline__ void mla_phase(unsigned char* lds, const unsigned short* __restrict__ Q16, const unsigned short* __restrict__ K16, const unsigned short* __restrict__ VT16,
                                          unsigned short* __restrict__ ob16, float* __restrict__ ssqb) {
    const int tid = tid_();
    for (int i = blockIdx.x; i < 256; i += NBLK) {
        const int xcd = i & 7, slot = i >> 3;
        { const int bh = xcd * 2; mla_unit128(lds, bh >> 3, bh & 7, 31 - slot, Q16, K16, VT16, ob16, ssqb, tid); }
        { const int bh = xcd * 2 + 1; mla_unit128(lds, bh >> 3, bh & 7, slot, Q16, K16, VT16, ob16, ssqb, tid); }
    }
}
constexpr float NSA_QSCALE = 0.125f * 1.4426950408889634f;
constexpr int IMP_PITCH = 129;
__device__ __forceinline__ void fa_tile_cmp2(const unsigned char* st, const bf16x8 (&qf)[4], f32x16 (&o)[2], float mref, float linv, int key0, int qpos, int lane, float* imp_row, bool need_mask) {
    typedef FA<64> F;
    asm volatile("" : "+v"(lane));
    const int r32 = lane & 31, hi = lane >> 5;
    f32x16 s0, s1;
#pragma unroll
    for (int r = 0; r < 16; ++r) { s0[r] = 0.f; s1[r] = 0.f; }
#pragma unroll
    for (int ds = 0; ds < 4; ++ds) {
        const bf16x8 k0 = *(const bf16x8*)(st + r32 * F::KP + ds * 32 + hi * 16);
        const bf16x8 k1 = *(const bf16x8*)(st + (32 + r32) * F::KP + ds * 32 + hi * 16);
        s0 = MFMA32(k0, qf[ds], s0); s1 = MFMA32(k1, qf[ds], s1);
    }
    {
        const f32x2_t mm = {mref, mref}, ll = {linv, linv};
#pragma unroll
        for (int r = 0; r < 16; r += 2) {
            const f32x2_t d0 = f32x2_t{s0[r], s0[r + 1]} - mm, d1 = f32x2_t{s1[r], s1[r + 1]} - mm;
            const f32x2_t p0 = f32x2_t{__builtin_amdgcn_exp2f(d0.x), __builtin_amdgcn_exp2f(d0.y)} * ll, p1 = f32x2_t{__builtin_amdgcn_exp2f(d1.x), __builtin_amdgcn_exp2f(d1.y)} * ll;
            s0[r] = p0.x; s0[r + 1] = p0.y; s1[r] = p1.x; s1[r + 1] = p1.y;
        }
    }
    if (need_mask) {
#pragma unroll
        for (int r = 0; r < 16; ++r) {
            const int ka = key0 + crow(r, hi), kb = ka + 32;
            if (16 * ka + 31 > qpos) s0[r] = 0.f;
            if (16 * kb + 31 > qpos) s1[r] = 0.f;
        }
    }
    bf16x8 pk[4];
#pragma unroll
    for (int s = 0; s < 2; ++s) {
        uint4 a, b;
        a.x = cvtpk(s0[8 * s], s0[8 * s + 1]); a.y = cvtpk(s0[8 * s + 2], s0[8 * s + 3]); a.z = cvtpk(s0[8 * s + 4], s0[8 * s + 5]); a.w = cvtpk(s0[8 * s + 6], s0[8 * s + 7]);
        b.x = cvtpk(s1[8 * s], s1[8 * s + 1]); b.y = cvtpk(s1[8 * s + 2], s1[8 * s + 3]); b.z = cvtpk(s1[8 * s + 4], s1[8 * s + 5]); b.w = cvtpk(s1[8 * s + 6], s1[8 * s + 7]);
        pk[s] = __builtin_bit_cast(bf16x8, a); pk[2 + s] = __builtin_bit_cast(bf16x8, b);
    }
    const unsigned char* vt = st + F::KBYTES;
#pragma unroll
    for (int ks = 0; ks < 4; ++ks) {
        const bf16x8 v0 = *(const bf16x8*)(vt + r32 * F::VP + ks * 32 + hi * 16);
        const bf16x8 v1 = *(const bf16x8*)(vt + (32 + r32) * F::VP + ks * 32 + hi * 16);
        o[0] = MFMA32(v0, pk[ks], o[0]); o[1] = MFMA32(v1, pk[ks], o[1]);
    }
#pragma unroll
    for (int g4 = 0; g4 < 4; ++g4) {
        const float qa = quad_sum(s0[4 * g4] + s0[4 * g4 + 1] + s0[4 * g4 + 2] + s0[4 * g4 + 3]), la = quad_sum(s0[4 * g4 + 3]);
        const float qb = quad_sum(s1[4 * g4] + s1[4 * g4 + 1] + s1[4 * g4 + 2] + s1[4 * g4 + 3]), lb = quad_sum(s1[4 * g4 + 3]);
        if ((lane & 3) == 0) {
            { const int j = (key0 + 8 * g4 + 4 * hi) >> 2;
              atomicAdd(imp_row + j, qa);
              if (j + 1 < 128) atomicAdd(imp_row + j + 1, la); }
            { const int j = (key0 + 32 + 8 * g4 + 4 * hi) >> 2;
              atomicAdd(imp_row + j, qb);
              if (j + 1 < 128) atomicAdd(imp_row + j + 1, lb); }
        }
    }
}
#define NSA_STEP_(GCUR, GNEXT, Kbase, kpitch, Vbase, vpitch, t_lo, t_hi, t_, ...) do { \
        const unsigned char* st = stg + (((t_) - (t_lo)) & 1) * FA<64>::STAGE; \
        if ((t_) + 2 <= (t_hi)) fa_load<64>((Kbase) + (long)((t_) + 2) * 64 * (kpitch), (kpitch), (Vbase) + ((t_) + 2) * 64, (vpitch), GCUR, tid); \
        const int key0 = (t_) * 64; (void)key0; \
        __VA_ARGS__ \
        if ((t_) + 1 <= (t_hi)) fa_store<64>(stg + (((t_) + 1 - (t_lo)) & 1) * FA<64>::STAGE, GNEXT, tid); \
        __syncthreads(); } while (0)
#define NSA_STREAM(Kbase, kpitch, Vbase, vpitch, t_lo, t_hi, ...) do { \
    FaRegs ga_, gb_; fa_load<64>((Kbase) + (long)(t_lo) * 64 * (kpitch), (kpitch), (Vbase) + (t_lo) * 64, (vpitch), ga_, tid); \
    if ((t_lo) + 1 <= (t_hi)) fa_load<64>((Kbase) + (long)((t_lo) + 1) * 64 * (kpitch), (kpitch), (Vbase) + ((t_lo) + 1) * 64, (vpitch), gb_, tid); \
    fa_store<64>(stg, ga_, tid); __syncthreads(); \
    for (int t_ = (t_lo); t_ <= (t_hi); t_ += 2) { \
        NSA_STEP_(ga_, gb_, Kbase, kpitch, Vbase, vpitch, t_lo, t_hi, t_, __VA_ARGS__); \
        if (t_ + 1 <= (t_hi)) { const int tt_ = t_ + 1; NSA_STEP2_(gb_, ga_, Kbase, kpitch, Vbase, vpitch, t_lo, t_hi, tt_, __VA_ARGS__); } \
    } } while (0)
#define NSA_STEP2_(GCUR, GNEXT, Kbase, kpitch, Vbase, vpitch, t_lo, t_hi, tq_, ...) do { \
        const int t_ = tq_; \
        const unsigned char* st = stg + ((t_ - (t_lo)) & 1) * FA<64>::STAGE; \
        if (t_ + 2 <= (t_hi)) fa_load<64>((Kbase) + (long)(t_ + 2) * 64 * (kpitch), (kpitch), (Vbase) + (t_ + 2) * 64, (vpitch), GCUR, tid); \
        const int key0 = t_ * 64; (void)key0; \
        __VA_ARGS__ \
        if (t_ + 1 <= (t_hi)) fa_store<64>(stg + ((t_ + 1 - (t_lo)) & 1) * FA<64>::STAGE, GNEXT, tid); \
        __syncthreads(); } while (0)

__device__ __forceinline__ void nsa_unit(unsigned char* lds, int b, int g, int qblk, const unsigned short* __restrict__ Q16A, const unsigned short* __restrict__ KC16, const unsigned short* __restrict__ VCT16,
                                         const unsigned short* __restrict__ KS16, const unsigned short* __restrict__ VST16, const unsigned short* __restrict__ KW16, const unsigned short* __restrict__ VWT16,
                                         const float* __restrict__ gates, unsigned short* __restrict__ oa16, float* __restrict__ ssqa, int tid) {
    typedef FA<64> F;
    const int lane = tid & 63, wave = __builtin_amdgcn_readfirstlane(tid >> 6), r32 = lane & 31, hi = lane >> 5;
    unsigned char* stg = lds;
    float* imp = (float*)(lds + 2 * F::STAGE);
    unsigned* selm = (unsigned*)(lds + 2 * F::STAGE + 64 * IMP_PITCH * 4);
    const int q0 = qblk * 64, cur = qblk;
    const int ql = wave * 8 + (r32 >> 2), hh = g * 4 + (r32 & 3), qpos = q0 + ql; const long tok = (long)b * S_ + qpos; const int bg = b * 2 + g;
    bf16x8 qf[4];
#pragma unroll
    for (int ds = 0; ds < 4; ++ds) qf[ds] = *(const bf16x8*)(Q16A + tok * 512 + hh * 64 + ds * 16 + hi * 8);
    for (int i = tid; i < 64 * IMP_PITCH; i += 512) imp[i] = 0.f;
    f32x16 acc[2], o[2];
#pragma unroll
    for (int r = 0; r < 16; ++r) { acc[0][r] = 0.f; acc[1][r] = 0.f; }
    const int wq_lo = q0 + wave * 8, wq_hi = wq_lo + 7;
    const int nvis_max = (q0 + 63 >= 31) ? ((q0 + 63 - 31) / 16 + 1) : 0;
    if (nvis_max > 0) {
        const int tc_hi = (nvis_max - 1) >> 6;
        const unsigned short* Kc = KC16 + (long)bg * 512 * 64; const unsigned short* Vc = VCT16 + (long)bg * 64 * 512;
        float mref = FA_NEG, l = 0.f;
        NSA_STREAM(Kc, 64, Vc, 512, 0, tc_hi, {
            if (16 * key0 + 31 <= wq_hi) fa_tile<64, 4, true>(st, qf, o, mref, l, key0, qpos, lane, 16 * (key0 + 63) + 31 > wq_lo);
        });
        l = pair_sum(l);
        const float linv = (l > 0.f) ? 1.f / l : 0.f;
#pragma unroll
        for (int r = 0; r < 16; ++r) { o[0][r] = 0.f; o[1][r] = 0.f; }
        NSA_STREAM(Kc, 64, Vc, 512, 0, tc_hi, {
            if (16 * key0 + 31 <= wq_hi) fa_tile_cmp2(st, qf, o, mref, linv, key0, qpos, lane, imp + ql * IMP_PITCH, 16 * (key0 + 63) + 31 > wq_lo);
        });
        const float g_c = gates[tok * 24 + hh * 3];
#pragma unroll
        for (int r = 0; r < 16; ++r) { acc[0][r] += g_c * o[0][r]; acc[1][r] += g_c * o[1][r]; }
    } else { __syncthreads(); }
    if (wave < 2) {
        const int qi = wave * 32 + r32;
        int his = hi; asm volatile("" : "+v"(his));
#define IMPKEY(jj) ({ const int j_ = (jj); const float v_ = (j_ == 0 || j_ == cur) ? 1e9f : ((j_ > cur) ? -1e30f : imp[qi * IMP_PITCH + j_]); (ordkey(v_) & ~127u) | (127u - (unsigned)j_); })
        unsigned k0[16];
        {
            unsigned k1[16];
#pragma unroll
            for (int i = 0; i < 16; ++i) { k0[i] = IMPKEY(his * 64 + i); k1[i] = IMPKEY(his * 64 + 16 + i); }
            sort16_desc(k0); sort16_desc(k1); merge16_desc(k0, k1);
        }
        __builtin_amdgcn_sched_barrier(0);
        {
            unsigned k2[16], k3[16];
#pragma unroll
            for (int i = 0; i < 16; ++i) { k2[i] = IMPKEY(his * 64 + 32 + i); k3[i] = IMPKEY(his * 64 + 48 + i); }
            sort16_desc(k2); sort16_desc(k3); merge16_desc(k2, k3); merge16_desc(k0, k2);
        }
#undef IMPKEY
        {
            unsigned o2[16];
#pragma unroll
            for (int i = 0; i < 16; ++i) { auto rr = __builtin_amdgcn_permlane32_swap(k0[i], k0[i], false, false); k0[i] = rr[0]; o2[i] = rr[1]; }
            merge16_desc(k0, o2);
        }
        unsigned m0 = 0u, m1 = 0u, m2 = 0u, m3 = 0u;
#pragma unroll
        for (int i = 0; i < 16; ++i) {
            const unsigned j = 127u - (k0[i] & 127u); const unsigned bit = 1u << (j & 31u); const unsigned wsel = j >> 5;
            m0 |= (wsel == 0u) ? bit : 0u; m1 |= (wsel == 1u) ? bit : 0u; m2 |= (wsel == 2u) ? bit : 0u; m3 |= (wsel == 3u) ? bit : 0u;
        }
        if (hi == 0) { selm[qi * 4] = m0; selm[qi * 4 + 1] = m1; selm[qi * 4 + 2] = m2; selm[qi * 4 + 3] = m3; }
    }
    __syncthreads();
    unsigned sm0 = selm[ql * 4], sm1 = selm[ql * 4 + 1], sm2 = selm[ql * 4 + 2], sm3 = selm[ql * 4 + 3];
    {
        float mref = FA_NEG, l = 0.f;
#pragma unroll
        for (int r = 0; r < 16; ++r) { o[0][r] = 0.f; o[1][r] = 0.f; }
        const unsigned short* Ks = KS16 + (long)bg * S_ * 64; const unsigned short* Vs = VST16 + (long)bg * 64 * S_;
        NSA_STREAM(Ks, 64, Vs, S_, 0, cur, {
            const int jw = t_ >> 5; const unsigned wsel = (jw == 0) ? sm0 : ((jw == 1) ? sm1 : ((jw == 2) ? sm2 : sm3));
            const bool colsel = (wsel >> (t_ & 31)) & 1u;
            if (__any(colsel)) fa_tile<64, 3>(st, qf, o, mref, l, key0, qpos, lane, t_ == cur, colsel);
        });
        l = pair_sum(l);
        const float sc = gates[tok * 24 + hh * 3 + 1] / l;
#pragma unroll
        for (int r = 0; r < 16; ++r) { acc[0][r] += sc * o[0][r]; acc[1][r] += sc * o[1][r]; }
    }
    {
        float mref = FA_NEG, l = 0.f;
#pragma unroll
        for (int r = 0; r < 16; ++r) { o[0][r] = 0.f; o[1][r] = 0.f; }
        const unsigned short* Kw = KW16 + (long)bg * S_ * 64; const unsigned short* Vw = VWT16 + (long)bg * 64 * S_;
        const int tw_lo = (cur >= 8) ? cur - 8 : 0;
        NSA_STREAM(Kw, 64, Vw, S_, tw_lo, cur, {
            fa_tile<64, 2>(st, qf, o, mref, l, key0, qpos, lane, (t_ == cur) || (t_ == cur - 8));
        });
        l = pair_sum(l);
        const float sc = gates[tok * 24 + hh * 3 + 2] / l;
#pragma unroll
        for (int r = 0; r < 16; ++r) { acc[0][r] += sc * o[0][r]; acc[1][r] += sc * o[1][r]; }
    }
    float ss = 0.f;
#pragma unroll
    for (int dt = 0; dt < 2; ++dt)
#pragma unroll
        for (int gq = 0; gq < 4; ++gq) {
            const float v0 = acc[dt][4 * gq], v1 = acc[dt][4 * gq + 1], v2 = acc[dt][4 * gq + 2], v3 = acc[dt][4 * gq + 3];
            uint2 pk; pk.x = cvtpk(v0, v1); pk.y = cvtpk(v2, v3);
            *(uint2*)(oa16 + tok * 1024 + hh * 64 + dt * 32 + 8 * gq + 4 * hi) = pk;
            ss += v0 * v0 + v1 * v1 + v2 * v2 + v3 * v3;
        }
    ss = pair_sum(ss);
    if (hi == 0) ssqa[(long)hh * T_ + tok] = ss;
    __syncthreads();
}
__device__ __forceinline__ void nsa_phase(unsigned char* lds, const unsigned short* __restrict__ Q16A, const unsigned short* __restrict__ KC16, const unsigned short* __restrict__ VCT16,
                                          const unsigned short* __restrict__ KS16, const unsigned short* __restrict__ VST16, const unsigned short* __restrict__ KW16, const unsigned short* __restrict__ VWT16,
                                          const float* __restrict__ gates, unsigned short* __restrict__ oa16, float* __restrict__ ssqa) {
    const int tid = tid_();
    for (int i = blockIdx.x; i < 256; i += NBLK) {
        const int xcd = i & 7, slot = i >> 3; const int bg = xcd >> 1, pr = (xcd & 1) * 32 + slot;
        nsa_unit(lds, bg >> 1, bg & 1, 127 - pr, Q16A, KC16, VCT16, KS16, VST16, KW16, VWT16, gates, oa16, ssqa, tid);
        nsa_unit(lds, bg >> 1, bg & 1, pr, Q16A, KC16, VCT16, KS16, VST16, KW16, VWT16, gates, oa16, ssqa, tid);
    }
}
__device__ __forceinline__ int nmap_in2(int n) {
    if (n < 768) return n;
    if (n < 896) return n;
    if (n < 1024) return n - 896 + 1024;
    if (n < 1152) return n - 1024 + 896;
    if (n < 1280) return n;
    if (n < 1304) return n - 1280 + 1696;
    if (n < 1560) return n - 1304 + 1280;
    if (n < 1688) return n - 1560 + 1536;
    return n - 1688 + 1664;
}
struct XT { const float* src; unsigned short* dst; const float* glo; const float* ghi; int K, N, ksplit, tile, nmap; };
__device__ __forceinline__ XT xt_make(const float* src, int K, int N, unsigned short* dst, const float* glo, const float* ghi, int ksplit, int nmap, int tile) {
    XT d; d.src = src; d.dst = dst; d.glo = glo; d.ghi = ghi; d.K = K; d.N = N; d.ksplit = ksplit; d.tile = tile; d.nmap = nmap; return d;
}
__device__ __forceinline__ void xt_load(const XT& d, float (&v)[8], int tid) {
    if (d.tile < 0) return;
    const int tn = (d.N + 63) >> 6; const int k0 = (d.tile / tn) * 64, n0 = (d.tile % tn) * 64;
    const float* __restrict__ s = as_global(d.src);
#pragma unroll
    for (int i = 0; i < 8; ++i) {
        const int kl = (tid >> 6) + 8 * i, n = n0 + (tid & 63), k = k0 + kl;
        float x = (n < d.N) ? s[(long)k * d.N + n] : 0.f;
        if (d.glo) x *= (k < d.ksplit) ? d.glo[k] : d.ghi[k - d.ksplit];
        v[i] = x;
    }
}
__device__ __forceinline__ void xt_store(const XT& d, const float (&v)[8], float* buf, int tid) {
    if (d.tile < 0) return;
    float (*tl)[65] = (float (*)[65])buf;
    const int tn = (d.N + 63) >> 6; const int k0 = (d.tile / tn) * 64, n0 = (d.tile % tn) * 64;
#pragma unroll
    for (int i = 0; i < 8; ++i) tl[(tid >> 6) + 8 * i][tid & 63] = v[i];
    __syncthreads();
    const int nl = tid >> 3, kc = (tid & 7) * 8; const int n = n0 + nl;
    if (n < d.N) {
        uint4 o; o.x = cvtpk(tl[kc][nl], tl[kc + 1][nl]); o.y = cvtpk(tl[kc + 2][nl], tl[kc + 3][nl]); o.z = cvtpk(tl[kc + 4][nl], tl[kc + 5][nl]); o.w = cvtpk(tl[kc + 6][nl], tl[kc + 7][nl]);
        const int nn = d.nmap ? nmap_in2(n) : n;
        *(uint4*)(d.dst + (long)nn * d.K + k0 + kc) = o;
    }
}
#define XT_RUN4(ldsf_, MAKE) do { const int tid_x = tid_(); float xv0[8], xv1[8], xv2[8], xv3[8]; \
    const XT xd0 = MAKE(0), xd1 = MAKE(1), xd2 = MAKE(2), xd3 = MAKE(3); \
    xt_load(xd0, xv0, tid_x); xt_load(xd1, xv1, tid_x); xt_load(xd2, xv2, tid_x); xt_load(xd3, xv3, tid_x); \
    xt_store(xd0, xv0, (ldsf_), tid_x); xt_store(xd1, xv1, (ldsf_) + 64 * 65, tid_x); xt_store(xd2, xv2, (ldsf_), tid_x); xt_store(xd3, xv3, (ldsf_) + 64 * 65, tid_x); __syncthreads(); } while (0)
__device__ __forceinline__ void p0_xn_rope(const float* __restrict__ x, const float* __restrict__ g1, const int* __restrict__ positions, unsigned short* __restrict__ xn16, float* __restrict__ rope) {
    const int tid = tid_(); const int lane = tid & 63, w = __builtin_amdgcn_readfirstlane(tid >> 6);
    const f32x4_t* gp = (const f32x4_t*)g1; const f32x4_t ga0 = gp[lane * 2], ga1 = gp[lane * 2 + 1], gb0 = gp[128 + lane * 2], gb1 = gp[128 + lane * 2 + 1];
    for (int t0 = blockIdx.x * 8 + w; t0 < T_; t0 += 4 * NBLK * 8) {
        f32x4_t v[4][4]; int pos[4];
#pragma unroll
        for (int j = 0; j < 4; ++j) {
            const int t = t0 + j * NBLK * 8;
            const f32x4_t* xp = (const f32x4_t*)(x + (long)t * 1024);
            v[j][0] = xp[lane * 2]; v[j][1] = xp[lane * 2 + 1]; v[j][2] = xp[128 + lane * 2]; v[j][3] = xp[128 + lane * 2 + 1];
            pos[j] = positions[t];
        }
#pragma unroll
        for (int j = 0; j < 4; ++j) {
            const int t = t0 + j * NBLK * 8;
            const f32x4_t a0 = v[j][0], a1 = v[j][1], b0 = v[j][2], b1 = v[j][3];
            float ss = a0.x * a0.x + a0.y * a0.y + a0.z * a0.z + a0.w * a0.w + a1.x * a1.x + a1.y * a1.y + a1.z * a1.z + a1.w * a1.w
                     + b0.x * b0.x + b0.y * b0.y + b0.z * b0.z + b0.w * b0.w + b1.x * b1.x + b1.y * b1.y + b1.z * b1.z + b1.w * b1.w;
            ss = wsum(ss); const float rs = rsqrtf(ss * (1.f / 1024.f) + EPS);
            uint4 pa, pb;
            pa.x = cvtpk(a0.x * rs * ga0.x, a0.y * rs * ga0.y); pa.y = cvtpk(a0.z * rs * ga0.z, a0.w * rs * ga0.w); pa.z = cvtpk(a1.x * rs * ga1.x, a1.y * rs * ga1.y); pa.w = cvtpk(a1.z * rs * ga1.z, a1.w * rs * ga1.w);
            pb.x = cvtpk(b0.x * rs * gb0.x, b0.y * rs * gb0.y); pb.y = cvtpk(b0.z * rs * gb0.z, b0.w * rs * gb0.w); pb.z = cvtpk(b1.x * rs * gb1.x, b1.y * rs * gb1.y); pb.w = cvtpk(b1.z * rs * gb1.z, b1.w * rs * gb1.w);
            ((uint4*)(xn16 + (long)t * 1024))[lane] = pa; ((uint4*)(xn16 + (long)t * 1024))[64 + lane] = pb;
            if (lane < 24) {
                const float f = lane < 8 ? ROPE_F16[lane] : ROPE_F32[lane - 8];
                const float angf = (float)pos[j] * f;
                const double ang = (double)angf; const double k = rint(ang * 0.15915494309189535);
                const float r = (float)(ang - k * 6.283185307179586);
                const float c = cosf(r), sn = sinf(r);
                if (lane < 8) { rope[(long)t * 48 + lane] = c; rope[(long)t * 48 + 8 + lane] = sn; }
                else { rope[(long)t * 48 + 16 + lane - 8] = c; rope[(long)t * 48 + 32 + lane - 8] = sn; }
            }
        }
    }
}
__device__ __forceinline__ void p0_cbias(const float* __restrict__ pos, const float* __restrict__ w1k, const float* __restrict__ w1v, float* __restrict__ cbias) {
    const int tid = tid_(); const int lane = tid & 63, w = __builtin_amdgcn_readfirstlane(tid >> 6);
    for (int task = blockIdx.x * 8 + w; task < 512; task += NBLK * 8) {
        const int mat = task >> 8, n = task & 255; const float* w1 = mat ? w1v : w1k;
        float acc = 0.f;
#pragma unroll 8
        for (int i = 0; i < 32; ++i) { const int k = lane + 64 * i; acc += pos[k] * w1[(long)k * 256 + n]; }
        acc = wsum(acc);
        if (lane == 0) cbias[task] = acc;
    }
}
__device__ __forceinline__ void zero_stream(unsigned short* __restrict__ p, long n) {
    const int tid = tid_();
    for (long c = (long)blockIdx.x * 512 + tid; c < (n >> 3); c += (long)NBLK * 512) ((uint4*)p)[c] = make_uint4(0u, 0u, 0u, 0u);
}

struct P1Out {
    unsigned short *q16a, *ks16, *kw16, *vst16, *vwt16, *kcmp16, *vcmp16, *cq16, *ckv16;
    float *krr, *ssq_kr, *ssq_cq, *ssq_ckv, *gates;
    const float *rope, *q_gain, *ks_gain, *kw_gain, *k_gain;
};
__device__ __forceinline__ void norm_rope64(f32x16& a0, f32x16& a1, const float* __restrict__ gain, const float* __restrict__ rope_t, int hi, float outscale) {
    float ss = 0.f;
#pragma unroll
    for (int r = 0; r < 16; ++r) ss += a0[r] * a0[r] + a1[r] * a1[r];
    ss = pair_sum(ss);
    const float rs = rsqrtf(ss * (1.f / 64.f) + EPS);
#pragma unroll
    for (int g = 0; g < 4; ++g) {
        const float4 g0 = *(const float4*)(gain + 8 * g + 4 * hi), g1 = *(const float4*)(gain + 32 + 8 * g + 4 * hi);
        a0[4 * g] *= rs * g0.x; a0[4 * g + 1] *= rs * g0.y; a0[4 * g + 2] *= rs * g0.z; a0[4 * g + 3] *= rs * g0.w;
        a1[4 * g] *= rs * g1.x; a1[4 * g + 1] *= rs * g1.y; a1[4 * g + 2] *= rs * g1.z; a1[4 * g + 3] *= rs * g1.w;
    }
    const float4 c4 = *(const float4*)(rope_t + 4 * hi), s4 = *(const float4*)(rope_t + 8 + 4 * hi);
    const float cc[4] = {c4.x, c4.y, c4.z, c4.w}, sn[4] = {s4.x, s4.y, s4.z, s4.w};
#pragma unroll
    for (int j = 0; j < 4; ++j) { const float x1 = a0[j], x2 = a0[4 + j]; a0[j] = x1 * cc[j] - x2 * sn[j]; a0[4 + j] = x2 * cc[j] + x1 * sn[j]; }
#pragma unroll
    for (int r = 0; r < 16; ++r) { a0[r] *= outscale; a1[r] *= outscale; }
}
__device__ __forceinline__ void store_row64(unsigned short* __restrict__ dst, const f32x16& a0, const f32x16& a1, int hi) {
#pragma unroll
    for (int g = 0; g < 4; ++g) {
        uint2 p0, p1; p0.x = cvtpk(a0[4 * g], a0[4 * g + 1]); p0.y = cvtpk(a0[4 * g + 2], a0[4 * g + 3]); p1.x = cvtpk(a1[4 * g], a1[4 * g + 1]); p1.y = cvtpk(a1[4 * g + 2], a1[4 * g + 3]);
        *(uint2*)(dst + 8 * g + 4 * hi) = p0; *(uint2*)(dst + 32 + 8 * g + 4 * hi) = p1;
    }
}
__device__ __forceinline__ float ssq64(const f32x16& a0, const f32x16& a1) {
    float ss = 0.f;
#pragma unroll
    for (int r = 0; r < 16; ++r) ss += a0[r] * a0[r] + a1[r] * a1[r];
    return pair_sum(ss);
}
__device__ __forceinline__ float sum4fq(float v) {
    auto r1 = __builtin_amdgcn_permlane16_swap(__float_as_uint(v), __float_as_uint(v), false, false);
    return pair_sum(__uint_as_float(r1[0]) + __uint_as_float(r1[1]));
}
#define P1V(m, j) acc[ai][bj][m][n][j]
__device__ __forceinline__ void p1_inproj_256(unsigned char* lds, const unsigned short* __restrict__ xn16, const unsigned short* __restrict__ wt_in, const P1Out& Oin) {
    const P1Out O = Oin;
    const int tbase = (blockIdx.x & 7) * 56;
    for (int tile = tbase + (blockIdx.x >> 3); tile < tbase + 56; tile += 32) {
        const int mt = tile / 7, nt = tile % 7; const int m0 = mt * 256;
        f32x4_t acc[2][2][4][2];
#pragma unroll
        for (int ai = 0; ai < 2; ++ai)
#pragma unroll
            for (int bj = 0; bj < 2; ++bj)
#pragma unroll
                for (int m = 0; m < 4; ++m)
#pragma unroll
                    for (int n = 0; n < 2; ++n) acc[ai][bj][m][n] = f32x4_t{0.f, 0.f, 0.f, 0.f};
        if (nt == 4) g256::mainloop<1024>(xn16, wt_in, m0, nt * 256, (unsigned short*)lds, acc);
        else g256::mainloop<1024>(wt_in, xn16, nt * 256, m0, (unsigned short*)lds, acc);
        const int tid = tid_(); const int lane = tid & 63, wave = __builtin_amdgcn_readfirstlane(tid >> 6), wr = wave >> 2, wc = wave & 3, fr = lane & 15, fq = lane >> 4;
        if (nt == 4) {
#pragma unroll
            for (int bj = 0; bj < 2; ++bj)
#pragma unroll
                for (int n = 0; n < 2; ++n) {
                    const int pc = bj * 2 + (wc >> 1), d = (wc & 1) * 32 + n * 16 + fr;
                    unsigned short* vt = (pc < 2) ? O.vst16 : O.vwt16; const int g = pc & 1;
#pragma unroll
                    for (int ai = 0; ai < 2; ++ai)
#pragma unroll
                        for (int m = 0; m < 4; ++m) {
                            const int tb = m0 + ai * 128 + wr * 64 + m * 16 + fq * 4; const int b = tb / S_, s0 = tb % S_;
                            uint2 pk; pk.x = cvtpk(P1V(m, 0), P1V(m, 1)); pk.y = cvtpk(P1V(m, 2), P1V(m, 3));
                            *(uint2*)(vt + ((long)(b * 2 + g) * 64 + d) * S_ + vperm(s0)) = pk;
                        }
                }
        } else {
#pragma unroll
            for (int ai = 0; ai < 2; ++ai) {
                const int pc = ai * 2 + wr;
#pragma unroll
                for (int bj = 0; bj < 2; ++bj)
#pragma unroll
                    for (int n = 0; n < 2; ++n) {
                        const long tok = m0 + bj * 128 + wc * 32 + n * 16 + fr; const int b = (int)(tok / S_), s = (int)(tok % S_);
                        const float* rope_t = O.rope + tok * 48;
                        const bool is_q = nt < 2, is_k = nt == 3;
                        if (is_q || is_k) {
                            const float* gain = is_q ? O.q_gain : ((pc < 2) ? O.ks_gain : O.kw_gain);
                            float ss = 0.f;
#pragma unroll
                            for (int m = 0; m < 4; ++m)
#pragma unroll
                                for (int j = 0; j < 4; ++j) ss += P1V(m, j) * P1V(m, j);
                            const float rs = rsqrtf(sum4fq(ss) * (1.f / 64.f) + EPS) ;
#pragma unroll
                            for (int m = 0; m < 4; ++m) { const float4 gv = *(const float4*)(gain + m * 16 + fq * 4);
                                P1V(m, 0) *= rs * gv.x; P1V(m, 1) *= rs * gv.y; P1V(m, 2) *= rs * gv.z; P1V(m, 3) *= rs * gv.w; }
                            { const float4 c4 = *(const float4*)(rope_t + (fq & 1) * 4), s4 = *(const float4*)(rope_t + 8 + (fq & 1) * 4);
                              const float cc[4] = {c4.x, c4.y, c4.z, c4.w}, sn[4] = {s4.x, s4.y, s4.z, s4.w};
#pragma unroll
                              for (int j = 0; j < 4; ++j) {
                                  auto rr = __builtin_amdgcn_permlane32_swap(__float_as_uint(P1V(0, j)), __float_as_uint(P1V(0, j)), false, false);
                                  const float x1 = __uint_as_float(rr[0]), x2 = __uint_as_float(rr[1]);
                                  P1V(0, j) = (fq < 2) ? (x1 * cc[j] - x2 * sn[j]) : (x2 * cc[j] + x1 * sn[j]);
                              } }
                            const float osc = is_q ? NSA_QSCALE : 1.f;
                            unsigned short* dst = is_q ? (O.q16a + tok * 512 + (nt * 4 + pc) * 64) : ((pc < 2 ? O.ks16 : O.kw16) + ((long)(b * 2 + (pc & 1)) * S_ + s) * 64);
#pragma unroll
                            for (int m = 0; m < 4; ++m) { uint2 pk; pk.x = cvtpk(P1V(m, 0) * osc, P1V(m, 1) * osc); pk.y = cvtpk(P1V(m, 2) * osc, P1V(m, 3) * osc); *(uint2*)(dst + m * 16 + fq * 4) = pk; }
                        } else if (nt == 2 || nt == 5 || (nt == 6 && pc < 2)) {
                            unsigned short* dst;
                            if (nt == 2) dst = (pc < 2 ? O.kcmp16 : O.vcmp16) + ((long)(b * 2 + (pc & 1)) * S_ + s) * 64;
                            else if (nt == 5) dst = O.cq16 + tok * 256 + pc * 64;
                            else dst = O.ckv16 + tok * 128 + pc * 64;
                            float ss = 0.f;
#pragma unroll
                            for (int m = 0; m < 4; ++m) { uint2 pk; pk.x = cvtpk(P1V(m, 0), P1V(m, 1)); pk.y = cvtpk(P1V(m, 2), P1V(m, 3)); *(uint2*)(dst + m * 16 + fq * 4) = pk;
#pragma unroll
                                for (int j = 0; j < 4; ++j) ss += P1V(m, j) * P1V(m, j); }
                            if (nt != 2) { ss = sum4fq(ss); if (fq == 0) { if (nt == 5) O.ssq_cq[(long)pc * T_ + tok] = ss; else O.ssq_ckv[(long)pc * T_ + tok] = ss; } }
                        } else if (nt == 6 && pc == 2) {
                            float ss = 0.f;
#pragma unroll
                            for (int m = 0; m < 2; ++m)
#pragma unroll
                                for (int j = 0; j < 4; ++j) ss += P1V(m, j) * P1V(m, j);
                            ss = sum4fq(ss);
                            if (fq == 0) O.ssq_kr[tok] = ss;
                            {
                                const float4 g0 = *(const float4*)(O.k_gain + 64 + fq * 4), g1 = *(const float4*)(O.k_gain + 80 + fq * 4);
                                const float4 c4 = *(const float4*)(rope_t + 16 + fq * 4), s4 = *(const float4*)(rope_t + 32 + fq * 4);
                                const float ga[4] = {g0.x, g0.y, g0.z, g0.w}, gb[4] = {g1.x, g1.y, g1.z, g1.w}, cc[4] = {c4.x, c4.y, c4.z, c4.w}, sn[4] = {s4.x, s4.y, s4.z, s4.w};
                                float o1[4], o2[4];
#pragma unroll
                                for (int j = 0; j < 4; ++j) { const float x1 = P1V(0, j) * ga[j], x2 = P1V(1, j) * gb[j]; o1[j] = x1 * cc[j] - x2 * sn[j]; o2[j] = x2 * cc[j] + x1 * sn[j]; }
                                *(float4*)(O.krr + tok * 32 + fq * 4) = make_float4(o1[0], o1[1], o1[2], o1[3]);
                                *(float4*)(O.krr + tok * 32 + 16 + fq * 4) = make_float4(o2[0], o2[1], o2[2], o2[3]);
                            }
                            *(float4*)(O.gates + tok * 24 + fq * 4) = make_float4(1.f / (1.f + __expf(-P1V(2, 0))), 1.f / (1.f + __expf(-P1V(2, 1))), 1.f / (1.f + __expf(-P1V(2, 2))), 1.f / (1.f + __expf(-P1V(2, 3))));
                            if (fq < 2) *(float4*)(O.gates + tok * 24 + 16 + fq * 4) = make_float4(1.f / (1.f + __expf(-P1V(3, 0))), 1.f / (1.f + __expf(-P1V(3, 1))), 1.f / (1.f + __expf(-P1V(3, 2))), 1.f / (1.f + __expf(-P1V(3, 3))));
                        }
                    }
            }
        }
        __syncthreads();
    }
}
#undef P1V

typedef GemmShape<2, 4, 2, 2> ShBig;
typedef GemmShape<4, 2, 1, 3> ShQb;
typedef GemmShape<4, 2, 1, 4> ShKvb;
struct P2Args {
    const unsigned short *cq16, *ckv16, *wt_uq, *wt_ukv, *kcmp16, *vcmp16, *w1t_k, *w1t_v;
    const float *ssq_cq, *ssq_ckv, *ssq_kr, *krr, *rope, *q_gain, *k_gain;
    unsigned short *q16, *k16, *vt16; float* hid;
};
__device__ __forceinline__ void p2_phase(unsigned char* lds, const P2Args& A) {
    const int tid = tid_(); const int lane = tid & 63, wave = __builtin_amdgcn_readfirstlane(tid >> 6), r32 = lane & 31, hi = lane >> 5;
    const int nmine = (blockIdx.x < 128) ? 4 : 5;
    for (int it = 0; it < nmine; ++it) {
        int u;
        if (blockIdx.x < 128) { if (it == 0) u = blockIdx.x; else { const int s = blockIdx.x * 3 + (it - 1); u = (s & 1) ? 640 + (s >> 1) : 128 + (s >> 1); } }
        else { const int s = 384 + (blockIdx.x - 128) * 5 + it; u = (s & 1) ? 640 + (s >> 1) : 128 + (s >> 1); }
        if (u < 128) {
            const int mat = u >> 6, mtile = (u >> 2) & 15, ks = u & 3; const int wm = wave >> 2, wn = wave & 3;
            f32x16 acc[2][2];
#pragma unroll
            for (int mi = 0; mi < 2; ++mi)
#pragma unroll
                for (int ni = 0; ni < 2; ++ni)
#pragma unroll
                    for (int r = 0; r < 16; ++r) acc[mi][ni][r] = 0.f;
            gemm_mainloop<ShBig, 3u>((mat ? A.vcmp16 : A.kcmp16) + (long)mtile * 128 * 1024 + ks * 512, 1024, (mat ? A.w1t_v : A.w1t_k) + ks * 512, 2048, 512, lds, acc, tid);
            float* slab = A.hid + (long)(mat * 4 + ks) * 2048 * 256;
#pragma unroll
            for (int mi = 0; mi < 2; ++mi) {
                const long row = mtile * 128 + wm * 64 + mi * 32 + r32;
#pragma unroll
                for (int ni = 0; ni < 2; ++ni)
#pragma unroll
                    for (int g = 0; g < 4; ++g)
                        *(float4*)(slab + row * 256 + wn * 64 + ni * 32 + 8 * g + 4 * hi) = make_float4(acc[mi][ni][4 * g], acc[mi][ni][4 * g + 1], acc[mi][ni][4 * g + 2], acc[mi][ni][4 * g + 3]);
            }
        } else if (u < 128 + 512) {
            const int v = u - 128; const int mt = v >> 2, nt = v & 3; const int m0 = mt * 128; const int wm = wave >> 1, wn = wave & 1; const int head = nt * 2 + wn;
            f32x16 acc[1][4];
#pragma unroll
            for (int ni = 0; ni < 4; ++ni)
#pragma unroll
                for (int r = 0; r < 16; ++r) acc[0][ni][r] = 0.f;
            const long tok = m0 + wm * 32 + r32;
            const float e_c0 = A.ssq_ckv[tok], e_c1 = A.ssq_ckv[(long)T_ + tok], e_kr = A.ssq_kr[tok];
            f32x4_t e_k[4];
#pragma unroll
            for (int i = 0; i < 4; ++i) e_k[i] = ((const f32x4_t*)(A.krr + tok * 32 + hi * 16))[i];
            gemm_mainloop<ShKvb, 3u>(A.ckv16 + (long)m0 * 128, 128, A.wt_ukv + (long)nt * 256 * 128, 128, 128, lds, acc, tid);
            {
                const int b = (int)(tok / S_), s = (int)(tok % S_);
                const float rc = rsqrtf((e_c0 + e_c1) * (1.f / 128.f) + EPS);
                float ss = 0.f;
#pragma unroll
                for (int r = 0; r < 16; ++r) { acc[0][0][r] *= rc; acc[0][1][r] *= rc; ss += acc[0][0][r] * acc[0][0][r] + acc[0][1][r] * acc[0][1][r]; }
                ss = pair_sum(ss) + e_kr;
                const float rk = rsqrtf(ss * (1.f / 96.f) + EPS);
#pragma unroll
                for (int g = 0; g < 4; ++g) {
                    const float4 g0 = *(const float4*)(A.k_gain + 8 * g + 4 * hi), g1 = *(const float4*)(A.k_gain + 32 + 8 * g + 4 * hi);
                    acc[0][0][4 * g] *= rk * g0.x; acc[0][0][4 * g + 1] *= rk * g0.y; acc[0][0][4 * g + 2] *= rk * g0.z; acc[0][0][4 * g + 3] *= rk * g0.w;
                    acc[0][1][4 * g] *= rk * g1.x; acc[0][1][4 * g + 1] *= rk * g1.y; acc[0][1][4 * g + 2] *= rk * g1.z; acc[0][1][4 * g + 3] *= rk * g1.w;
                }
                unsigned short* krow = A.k16 + ((long)(b * 8 + head) * S_ + s) * 96;
                store_row64(krow, acc[0][0], acc[0][1], hi);
                const f32x4_t k0 = e_k[0], k1 = e_k[1], k2 = e_k[2], k3 = e_k[3];
                uint4 o0, o1; o0.x = cvtpk(k0.x * rk, k0.y * rk); o0.y = cvtpk(k0.z * rk, k0.w * rk); o0.z = cvtpk(k1.x * rk, k1.y * rk); o0.w = cvtpk(k1.z * rk, k1.w * rk);
                o1.x = cvtpk(k2.x * rk, k2.y * rk); o1.y = cvtpk(k2.z * rk, k2.w * rk); o1.z = cvtpk(k3.x * rk, k3.y * rk); o1.w = cvtpk(k3.z * rk, k3.w * rk);
                *(uint4*)(krow + 64 + hi * 16) = o0; *(uint4*)(krow + 64 + hi * 16 + 8) = o1;
            }
            {
#pragma unroll
                for (int ni = 2; ni < 4; ++ni)
#pragma unroll
                    for (int g4 = 0; g4 < 4; ++g4) {
                        const int tb = m0 + wm * 32 + 8 * g4 + 4 * hi; const int b = tb / S_, s0 = tb % S_; const int d = (ni - 2) * 32 + r32;
                        const f32x4_t sa = *(const f32x4_t*)(A.ssq_ckv + tb), sb = *(const f32x4_t*)(A.ssq_ckv + (long)T_ + tb);
                        const float r0 = rsqrtf((sa.x + sb.x) * (1.f / 128.f) + EPS), r1 = rsqrtf((sa.y + sb.y) * (1.f / 128.f) + EPS), r2 = rsqrtf((sa.z + sb.z) * (1.f / 128.f) + EPS), r3 = rsqrtf((sa.w + sb.w) * (1.f / 128.f) + EPS);
                        uint2 pk; pk.x = cvtpk(acc[0][ni][4 * g4] * r0, acc[0][ni][4 * g4 + 1] * r1); pk.y = cvtpk(acc[0][ni][4 * g4 + 2] * r2, acc[0][ni][4 * g4 + 3] * r3);
                        *(uint2*)(A.vt16 + ((long)(b * 8 + head) * 64 + d) * S_ + vperm(s0)) = pk;
                    }
            }
        } else {
            const int v = u - 640; const int mt = v >> 2, nt = v & 3; const int m0 = mt * 128; const int wm = wave >> 1, wn = wave & 1; const int head = nt * 2 + wn;
            f32x16 acc[1][3];
#pragma unroll
            for (int ni = 0; ni < 3; ++ni)
#pragma unroll
                for (int r = 0; r < 16; ++r) acc[0][ni][r] = 0.f;
            const long tok = m0 + wm * 32 + r32;
            const float e_q0 = A.ssq_cq[tok], e_q1 = A.ssq_cq[(long)T_ + tok], e_q2 = A.ssq_cq[2L * T_ + tok], e_q3 = A.ssq_cq[3L * T_ + tok];
            const float* rope_t = A.rope + tok * 48;
            f32x4_t e_c[2], e_s[2];
#pragma unroll
            for (int g = 0; g < 2; ++g) { e_c[g] = *(const f32x4_t*)(rope_t + 16 + 8 * g + 4 * hi); e_s[g] = *(const f32x4_t*)(rope_t + 32 + 8 * g + 4 * hi); }
            gemm_mainloop<ShQb, 7u>(A.cq16 + (long)m0 * 256, 256, A.wt_uq + (long)nt * 192 * 256, 256, 256, lds, acc, tid);
            const float rc = rsqrtf((e_q0 + e_q1 + e_q2 + e_q3) * (1.f / 256.f) + EPS);
            float ss = 0.f;
#pragma unroll
            for (int ni = 0; ni < 3; ++ni)
#pragma unroll
                for (int r = 0; r < 16; ++r) { acc[0][ni][r] *= rc; ss += acc[0][ni][r] * acc[0][ni][r]; }
            ss = pair_sum(ss);
            const float rq = rsqrtf(ss * (1.f / 96.f) + EPS);
#pragma unroll
            for (int ni = 0; ni < 3; ++ni)
#pragma unroll
                for (int g = 0; g < 4; ++g) {
                    const float4 gg = *(const float4*)(A.q_gain + ni * 32 + 8 * g + 4 * hi);
                    acc[0][ni][4 * g] *= rq * gg.x; acc[0][ni][4 * g + 1] *= rq * gg.y; acc[0][ni][4 * g + 2] *= rq * gg.z; acc[0][ni][4 * g + 3] *= rq * gg.w;
                }
#pragma unroll
            for (int g = 0; g < 2; ++g) {
                const f32x4_t c4 = e_c[g], s4 = e_s[g];
                const float cc[4] = {c4.x, c4.y, c4.z, c4.w}, sn[4] = {s4.x, s4.y, s4.z, s4.w};
#pragma unroll
                for (int j = 0; j < 4; ++j) { const float x1 = acc[0][2][4 * g + j], x2 = acc[0][2][8 + 4 * g + j]; acc[0][2][4 * g + j] = x1 * cc[j] - x2 * sn[j]; acc[0][2][8 + 4 * g + j] = x2 * cc[j] + x1 * sn[j]; }
            }
            unsigned short* qrow = A.q16 + tok * 768 + head * 96;
#pragma unroll
            for (int ni = 0; ni < 3; ++ni)
#pragma unroll
                for (int g = 0; g < 4; ++g) {
                    uint2 pk; pk.x = cvtpk(acc[0][ni][4 * g] * MLA_QSCALE, acc[0][ni][4 * g + 1] * MLA_QSCALE); pk.y = cvtpk(acc[0][ni][4 * g + 2] * MLA_QSCALE, acc[0][ni][4 * g + 3] * MLA_QSCALE);
                    *(uint2*)(qrow + ni * 32 + 8 * g + 4 * hi) = pk;
                }
        }
    }
}
__device__ __forceinline__ void p3_cmp2(unsigned char* lds, const float* __restrict__ hid, const float* __restrict__ cbias, const unsigned short* __restrict__ w2t_k, const unsigned short* __restrict__ w2t_v,
                                        const float* __restrict__ kc_gain, const float* __restrict__ rope, unsigned short* __restrict__ kc16, unsigned short* __restrict__ vct16) {
    if (blockIdx.x >= 128) return;
    const int tid = tid_(); const int lane = tid & 63, w = __builtin_amdgcn_readfirstlane(tid >> 6), r32 = lane & 31, hi = lane >> 5;
    const int task = blockIdx.x; const int mat = task >> 6, rt = task & 63; const long row = rt * 32 + r32;
    const unsigned short* w2t = mat ? w2t_v : w2t_k;
    f32x16 acc[2];
#pragma unroll
    for (int r = 0; r < 16; ++r) { acc[0][r] = 0.f; acc[1][r] = 0.f; }
    f32x4_t hv[2][10]; bf16x8 wf[2][2];
#pragma unroll
    for (int s = 0; s < 2; ++s) {
        const int k0 = (w * 2 + s) * 16 + hi * 8;
        hv[s][0] = *(const f32x4_t*)(cbias + mat * 256 + k0); hv[s][1] = *(const f32x4_t*)(cbias + mat * 256 + k0 + 4);
#pragma unroll
        for (int sp = 0; sp < 4; ++sp) {
            const float* hp = hid + ((long)(mat * 4 + sp) * 2048 + row) * 256 + k0;
            hv[s][2 + 2 * sp] = *(const f32x4_t*)hp; hv[s][3 + 2 * sp] = *(const f32x4_t*)(hp + 4);
        }
        wf[s][0] = *(const bf16x8*)(w2t + (long)r32 * 256 + k0); wf[s][1] = *(const bf16x8*)(w2t + (long)(32 + r32) * 256 + k0);
    }
#pragma unroll
    for (int s = 0; s < 2; ++s) {
        f32x4_t lo = hv[s][0], up = hv[s][1];
#pragma unroll
        for (int sp = 0; sp < 4; ++sp) { lo += hv[s][2 + 2 * sp]; up += hv[s][3 + 2 * sp]; }
        uint4 pk; pk.x = cvtpk(gelu_tanh(lo.x), gelu_tanh(lo.y)); pk.y = cvtpk(gelu_tanh(lo.z), gelu_tanh(lo.w)); pk.z = cvtpk(gelu_tanh(up.x), gelu_tanh(up.y)); pk.w = cvtpk(gelu_tanh(up.z), gelu_tanh(up.w));
        const bf16x8 hf = __builtin_bit_cast(bf16x8, pk);
        acc[0] = MFMA32(wf[s][0], hf, acc[0]); acc[1] = MFMA32(wf[s][1], hf, acc[1]);
    }
    f32x4_t* red = (f32x4_t*)lds;
#pragma unroll
    for (int q = 0; q < 8; ++q) red[(w * 8 + q) * 64 + lane] = f32x4_t{acc[q >> 2][4 * (q & 3)], acc[q >> 2][4 * (q & 3) + 1], acc[q >> 2][4 * (q & 3) + 2], acc[q >> 2][4 * (q & 3) + 3]};
    __syncthreads();
    if (w != 0) return;
#pragma unroll
    for (int q = 0; q < 8; ++q) {
        f32x4_t s = red[q * 64 + lane];
#pragma unroll
        for (int ww = 1; ww < 8; ++ww) s += red[(ww * 8 + q) * 64 + lane];
        acc[q >> 2][4 * (q & 3)] = s.x; acc[q >> 2][4 * (q & 3) + 1] = s.y; acc[q >> 2][4 * (q & 3) + 2] = s.z; acc[q >> 2][4 * (q & 3) + 3] = s.w;
    }
    const int bg = (int)(row >> 9), n = (int)(row & 511); const bool valid = n < NCMP;
    if (mat == 0) {
        if (valid) {
            const long tokp = (long)(bg >> 1) * S_ + 16 * n + 31;
            norm_rope64(acc[0], acc[1], kc_gain, rope + tokp * 48, hi, 1.f);
        } else {
#pragma unroll
            for (int r = 0; r < 16; ++r) { acc[0][r] = 0.f; acc[1][r] = 0.f; }
        }
        store_row64(kc16 + row * 64, acc[0], acc[1], hi);
    } else {
#pragma unroll
        for (int ni = 0; ni < 2; ++ni)
#pragma unroll
            for (int r = 0; r < 16; ++r) {
                const float v = valid ? acc[ni][r] : 0.f;
                const float other = __uint_as_float(__builtin_amdgcn_mov_dpp(__float_as_uint(v), 0xB1, 0xF, 0xF, true));
                if ((lane & 1) == 0) *(unsigned*)(vct16 + ((long)bg * 64 + ni * 32 + crow(r, hi)) * 512 + vperm(n)) = cvtpk(v, other);
            }
    }
}

__device__ __forceinline__ void cvt_stream(const float* __restrict__ in, unsigned short* __restrict__ out, long n, int vb = blockIdx.x, int nb = NBLK) {
    const long nchunk = n >> 3;
    const int tid = tid_();
    for (long c = (long)vb * 512 + tid; c < nchunk; c += (long)nb * 512) {
        const float4 a = ((const float4*)in)[2 * c], b = ((const float4*)in)[2 * c + 1];
        uint4 o; o.x = cvtpk(a.x, a.y); o.y = cvtpk(a.z, a.w); o.z = cvtpk(b.x, b.y); o.w = cvtpk(b.z, b.w);
        ((uint4*)out)[c] = o;
    }
}


typedef unsigned u32x3 __attribute__((ext_vector_type(3)));
typedef unsigned u32x6 __attribute__((ext_vector_type(6)));
typedef float f32x32 __attribute__((ext_vector_type(32)));
constexpr int PROW = 768;
constexpr int PU_SPLIT = 12288;
template <int NR>
__device__ __forceinline__ void cvt_rows_fp6(const float* __restrict__ in, unsigned char* __restrict__ out6, float* __restrict__ scale, int rows, int vb = blockIdx.x, int nb = NBLK) {
    const int tid = tid_(); const int lane = tid & 63, w = __builtin_amdgcn_readfirstlane(tid >> 6);
    const int stride = nb * 8;
    for (int r0 = vb * 8 + w; r0 < rows; r0 += NR * stride) {
        f32x4_t v[NR][4];
#pragma unroll
        for (int j = 0; j < NR; ++j) {
            const int r = min(r0 + j * stride, rows - 1);
            const f32x4_t* p = (const f32x4_t*)(in + (long)r * 1024 + lane * 16);
#pragma unroll
            for (int i = 0; i < 4; ++i) v[j][i] = p[i];
        }
#pragma unroll
        for (int j = 0; j < NR; ++j) {
            const int r = r0 + j * stride;
            if (r < rows) {
                float m = 0.f;
#pragma unroll
                for (int i = 0; i < 4; ++i) m = fmaxf(m, fmaxf(fmaxf(fabsf(v[j][i].x), fabsf(v[j][i].y)), fmaxf(fabsf(v[j][i].z), fabsf(v[j][i].w))));
                m = wmax(m);
                const float q = (m > 0.f) ? 7.5f / m : 1.f;
                const f32x16 ve = {v[j][0].x * q, v[j][0].z * q, v[j][1].x * q, v[j][1].z * q, v[j][2].x * q, v[j][2].z * q, v[j][3].x * q, v[j][3].z * q, 0.f, 0.f, 0.f, 0.f, 0.f, 0.f, 0.f, 0.f};
                const f32x16 vo = {v[j][0].y * q, v[j][0].w * q, v[j][1].y * q, v[j][1].w * q, v[j][2].y * q, v[j][2].w * q, v[j][3].y * q, v[j][3].w * q, 0.f, 0.f, 0.f, 0.f, 0.f, 0.f, 0.f, 0.f};
                const u32x6 pk = __builtin_amdgcn_cvt_scalef32_2xpk16_fp6_f32(ve, vo, 1.0f);
                *(u32x3*)(out6 + (long)r * PROW + lane * 12) = u32x3{pk[0], pk[1], pk[2]};
                if (lane == 0) scale[r] = (m > 0.f) ? m * (1.f / 7.5f) : 1.f;
            }
        }
    }
}
__device__ __forceinline__ f32x32 dec2_fp6(const u32x3& r0, const u32x3& r1) {
    const u32x6 pk = {r0.x, r0.y, r0.z, r1.x, r1.y, r1.z};
    return __builtin_amdgcn_cvt_scalef32_pk32_f32_fp6(pk, 1.0f);
}
__device__ __forceinline__ void peer_sweep_a(const float* __restrict__ hss, const float* __restrict__ g2, const int* __restrict__ eo, const float* __restrict__ go,
                                             const unsigned char* __restrict__ U6, const float* __restrict__ su, const float* __restrict__ sv, const float* __restrict__ h, float* __restrict__ wout) {
    const int tid = tid_(); const int lane = tid & 63, w = __builtin_amdgcn_readfirstlane(tid >> 6);
    const int kcls = ((lane >> 5) & 1) * 4 + ((lane >> 4) & 1) * 2 + ((lane >> 3) & 1);
    for (int t = blockIdx.x * 8 + w; t < T_; t += NBLK * 8) {
        float x[16];
        {
            const float4* xp = (const float4*)(h + (long)t * 1024 + lane * 16); const float4* gp = (const float4*)(g2 + lane * 16); const float4* hp = (const float4*)(hss + (long)t * 16);
            const float4 s0 = hp[0], s1 = hp[1], s2 = hp[2], s3 = hp[3];
            const float rs = rsqrtf((s0.x + s0.y + s0.z + s0.w + s1.x + s1.y + s1.z + s1.w + s2.x + s2.y + s2.z + s2.w + s3.x + s3.y + s3.z + s3.w) * (1.f / 1024.f) + EPS);
#pragma unroll
            for (int k = 0; k < 4; ++k) { const float4 hv = xp[k], gv = gp[k]; x[4 * k] = hv.x * rs * gv.x; x[4 * k + 1] = hv.y * rs * gv.y; x[4 * k + 2] = hv.z * rs * gv.z; x[4 * k + 3] = hv.w * rs * gv.w; }
        }
        const int elo = eo[(long)t * 128 + lane], ehi = eo[(long)t * 128 + 64 + lane];
        const float glo = go[(long)t * 128 + lane], ghi = go[(long)t * 128 + 64 + lane];
        for (int bt = 0; bt < 16; ++bt) {
            int e[8];
#pragma unroll
            for (int k = 0; k < 8; ++k) e[k] = __builtin_amdgcn_readlane(bt < 8 ? elo : ehi, (bt * 8 + k) & 63);
            u32x3 u[8];
#pragma unroll
            for (int k = 0; k < 8; ++k) u[k] = *(const u32x3*)(U6 + (long)e[k] * PROW + lane * 12);
            const int emine = __shfl(bt < 8 ? elo : ehi, (bt * 8 + kcls) & 63);
            const float sum = su[emine], svm = sv[emine];
            const float gk = __shfl(bt < 8 ? glo : ghi, (bt * 8 + kcls) & 63);
            float a[8];
#pragma unroll
            for (int k = 0; k < 8; k += 2) {
                const f32x32 d = dec2_fp6(u[k], u[k + 1]);
                float s0 = 0.f, s1 = 0.f;
#pragma unroll
                for (int i = 0; i < 16; ++i) { s0 = fmaf(d[i], x[i], s0); s1 = fmaf(d[16 + i], x[i], s1); }
                a[k] = s0; a[k + 1] = s1;
            }
            float b4[4], c2[2], d1;
#pragma unroll
            for (int i = 0; i < 4; ++i) {
                auto rr = __builtin_amdgcn_permlane32_swap(__float_as_uint(a[i]), __float_as_uint(a[i + 4]), false, false);
                b4[i] = __uint_as_float(rr[0]) + __uint_as_float(rr[1]);
            }
#pragma unroll
            for (int i = 0; i < 2; ++i) {
                auto rr = __builtin_amdgcn_permlane16_swap(__float_as_uint(b4[i]), __float_as_uint(b4[i + 2]), false, false);
                c2[i] = __uint_as_float(rr[0]) + __uint_as_float(rr[1]);
            }
            { const bool up = (lane & 8) != 0; const float keep = up ? c2[1] : c2[0], send = up ? c2[0] : c2[1];
              d1 = keep + __uint_as_float(__builtin_amdgcn_mov_dpp(__float_as_uint(send), 0x128, 0xF, 0xF, true)); }
            d1 = quad_sum(d1);
            d1 += __uint_as_float(__builtin_amdgcn_mov_dpp(__float_as_uint(d1), 0x141, 0xF, 0xF, true));
            const float wl = gk * gelu_tanh(d1 * sum) * svm;
            if ((lane & 7) == 0) wout[(long)t * 128 + bt * 8 + kcls] = wl;
        }
    }
}
__device__ __forceinline__ void peer_sweep_b(const int* __restrict__ eo, const float* __restrict__ win, const unsigned char* __restrict__ V6, float* out) {
    const int tid = tid_(); const int lane = tid & 63, w = __builtin_amdgcn_readfirstlane(tid >> 6);
    for (int t = blockIdx.x * 8 + w; t < T_; t += NBLK * 8) {
        float y[16];
#pragma unroll
        for (int i = 0; i < 16; ++i) y[i] = 0.f;
        const int elo = eo[(long)t * 128 + lane], ehi = eo[(long)t * 128 + 64 + lane];
        const float wlo = win[(long)t * 128 + lane], whi = win[(long)t * 128 + 64 + lane];
        for (int bt = 0; bt < 16; ++bt) {
            int e[8]; float wk[8];
#pragma unroll
            for (int k = 0; k < 8; ++k) {
                e[k] = __builtin_amdgcn_readlane(bt < 8 ? elo : ehi, (bt * 8 + k) & 63);
                wk[k] = __uint_as_float(__builtin_amdgcn_readlane(__float_as_uint(bt < 8 ? wlo : whi), (bt * 8 + k) & 63));
            }
            u32x3 v[8];
#pragma unroll
            for (int k = 0; k < 8; ++k) v[k] = *(const u32x3*)(V6 + (long)e[k] * PROW + lane * 12);
#pragma unroll
            for (int k = 0; k < 8; k += 2) {
                const f32x32 d = dec2_fp6(v[k], v[k + 1]);
#pragma unroll
                for (int i = 0; i < 16; ++i) y[i] = fmaf(wk[k + 1], d[16 + i], fmaf(wk[k], d[i], y[i]));
            }
        }
        float4* o = (float4*)(out + (long)t * 1024 + lane * 16);
#pragma unroll
        for (int k = 0; k < 4; ++k) { float4 hv = o[k]; hv.x += y[4 * k]; hv.y += y[4 * k + 1]; hv.z += y[4 * k + 2]; hv.w += y[4 * k + 3]; o[k] = hv; }
    }
}

struct Params {
    const float* x; const int* positions; const float* norm1_gain; const float* w_in;
    const float *nsa_q_gain, *nsa_kc_gain, *nsa_ks_gain, *nsa_kw_gain, *cmp_pos, *cmp_k_w1, *cmp_k_w2, *cmp_v_w1, *cmp_v_w2;
    const float *mla_q_lora_gain, *mla_w_uq, *mla_kv_lora_gain, *mla_w_ukv, *mla_q_gain, *mla_k_gain, *out_gain_a, *out_gain_b, *w_out;
    const float *norm2_gain, *peer_w_q, *peer_sub_keys, *peer_u, *peer_v;
    float* out; float* W; unsigned* bar;
};
constexpr int LDS_BYTES = 64 + 3 * 44032;
static_assert(LDS_BYTES >= 8 * 3200 * 4 + 64, "naive NSA phase needs 102,464 B");

typedef __attribute__((address_space(4))) const Params* cparams_t;
__device__ __forceinline__ cparams_t params_ptr() {
    cparams_t pp = (cparams_t)__builtin_amdgcn_kernarg_segment_ptr();
    asm volatile("" : "+s"(pp));
    return pp;
}
constexpr long M1 = 1 << 20;
constexpr long F_U8 = 0, F_V8 = 4 * M1, F_SU = 21 * M1 + 3 * M1 / 8, F_SV = F_SU + 16384,
               F_WTIN = 16 * M1, F_WTUQ = 17 * M1, F_WTUKV = 17 * M1 + M1 / 8, F_W1TK = 17 * M1 + M1 / 4, F_W1TV = 17 * M1 + M1 / 2, F_W2TK = 17 * M1 + 3 * M1 / 4,
               F_W2TV = F_W2TK + 8192, F_CBIAS = F_W2TV + 8192, F_WTOUT = 18 * M1, F_WTQ = 18 * M1 + M1 / 2, F_SK16 = 19 * M1 + M1 / 2,
               F_SSQCQ = 19 * M1 + 5 * M1 / 8, F_SSQCKV = F_SSQCQ + 4 * 16384, F_SSQKR = F_SSQCKV + 2 * 16384, F_SSQA = 19 * M1 + 3 * M1 / 4, F_SSQB = F_SSQA + 8 * 16384,
               F_ROPE = 20 * M1, F_GATES = 21 * M1, F_KRR = 21 * M1 + M1 / 2,
               F_XN16 = 22 * M1, F_MIX = 22 * M1,
               F_Q16A = 30 * M1, F_KS16 = 34 * M1, F_KW16 = 35 * M1, F_VST16 = 36 * M1, F_VWT16 = 37 * M1, F_KCMP16 = 38 * M1, F_VCMP16 = 39 * M1 + M1 / 8,
               F_CQ16 = 40 * M1 + M1 / 4, F_CKV16 = 42 * M1 + M1 / 4,
               F_Q16 = 43 * M1 + M1 / 2, F_K16 = 49 * M1 + M1 / 2, F_VT16 = 55 * M1 + M1 / 2, F_HID = 59 * M1 + M1 / 2, F_KC16 = 63 * M1 + M1 / 2, F_VCT16 = F_KC16 + M1 / 8,
               F_HB = 30 * M1, F_HSS = 38 * M1, F_PSS = 38 * M1 + M1 / 2, F_EO = 39 * M1, F_GO = 41 * M1, F_PQB = 43 * M1 + M1 / 2;
static_assert(F_SSQKR + 16384 <= F_SSQA && F_SSQB + 8 * 16384 <= F_ROPE && F_VCT16 + M1 / 8 <= 64 * M1 - 16384 && F_CKV16 + M1 <= F_Q16 && F_PQB + 16 * M1 <= F_HID, "workspace map");

#define G(x) (x)
__global__ __launch_bounds__(512, 2) void mega(Params p_unused) {
    extern __shared__ __attribute__((aligned(16))) unsigned char lds_raw[];
    float* ldsf = (float*)(lds_raw + 64);
    { const unsigned bid_ = blockIdx.x; __builtin_assume(bid_ < (unsigned)NBLK); }
    if (threadIdx.x == 0) *(uint4*)lds_raw = make_uint4(0u, 0u, 0u, 0u);
    __syncthreads();
    XcdBarrier bar = xcd_barrier_post(params_ptr()->bar, (volatile LAS unsigned*)lds_raw);
#define GRID_SYNC() xcd_barrier(bar)
#define U16P(off) ((unsigned short*)(W + (off)))
    { cparams_t p = params_ptr(); float* W = p->W;
      p0_xn_rope(p->x, p->norm1_gain, p->positions, U16P(F_XN16), W + F_ROPE); }
    { cparams_t p = params_ptr(); float* W = p->W;
#define P0_XT(j) ({ const int v_ = (int)blockIdx.x + NBLK * (j); \
        (v_ < 432) ? xt_make(p->w_in, 1024, INW, U16P(F_WTIN), nullptr, nullptr, 0, 2, v_) : \
        (v_ < 480) ? xt_make(p->mla_w_uq, 256, 768, U16P(F_WTUQ), p->mla_q_lora_gain, p->mla_q_lora_gain, 1 << 30, 0, v_ - 432) : \
        (v_ < 512) ? xt_make(p->mla_w_ukv, 128, 1024, U16P(F_WTUKV), p->mla_kv_lora_gain, p->mla_kv_lora_gain, 1 << 30, 0, v_ - 480) : \
        (v_ < 640) ? xt_make(p->cmp_k_w1, 2048, 256, U16P(F_W1TK), nullptr, nullptr, 0, 0, v_ - 512) : \
        (v_ < 768) ? xt_make(p->cmp_v_w1, 2048, 256, U16P(F_W1TV), nullptr, nullptr, 0, 0, v_ - 640) : \
        (v_ < 772) ? xt_make(p->cmp_k_w2, 256, 64, U16P(F_W2TK), nullptr, nullptr, 0, 0, v_ - 768) : \
        (v_ < 776) ? xt_make(p->cmp_v_w2, 256, 64, U16P(F_W2TV), nullptr, nullptr, 0, 0, v_ - 772) : xt_make(nullptr, 64, 64, nullptr, nullptr, nullptr, 0, 0, -1); })
      XT_RUN4(ldsf, P0_XT);
      zero_stream(U16P(F_WTIN) + (long)1720 * 1024, (long)72 * 1024); }
    { cparams_t p = params_ptr(); float* W = p->W;
      p0_cbias(p->cmp_pos, p->cmp_k_w1, p->cmp_v_w1, W + F_CBIAS); }
    GRID_SYNC();
    { cparams_t p = params_ptr(); float* W = p->W;
      P1Out O; O.q16a = U16P(F_Q16A); O.ks16 = U16P(F_KS16); O.kw16 = U16P(F_KW16); O.vst16 = U16P(F_VST16); O.vwt16 = U16P(F_VWT16); O.kcmp16 = U16P(F_KCMP16); O.vcmp16 = U16P(F_VCMP16);
      O.cq16 = U16P(F_CQ16); O.ckv16 = U16P(F_CKV16); O.krr = W + F_KRR; O.ssq_kr = W + F_SSQKR; O.ssq_cq = W + F_SSQCQ; O.ssq_ckv = W + F_SSQCKV; O.gates = W + F_GATES;
      O.rope = W + F_ROPE; O.q_gain = p->nsa_q_gain; O.ks_gain = p->nsa_ks_gain; O.kw_gain = p->nsa_kw_gain; O.k_gain = p->mla_k_gain;
      p1_inproj_256(lds_raw + 64, U16P(F_XN16), U16P(F_WTIN), O); }
    if ((blockIdx.x >> 3) >= 24) {
      cparams_t p = params_ptr(); float* W = p->W;
      cvt_rows_fp6<8>(p->peer_u, (unsigned char*)(W + F_U8), W + F_SU, PU_SPLIT, (int)(blockIdx.x & 7) * 8 + (int)(blockIdx.x >> 3) - 24, 64); }
    GRID_SYNC();
    { cparams_t p = params_ptr(); float* W = p->W;
      P2Args A; A.cq16 = U16P(F_CQ16); A.ckv16 = U16P(F_CKV16); A.wt_uq = U16P(F_WTUQ); A.wt_ukv = U16P(F_WTUKV); A.kcmp16 = U16P(F_KCMP16); A.vcmp16 = U16P(F_VCMP16); A.w1t_k = U16P(F_W1TK); A.w1t_v = U16P(F_W1TV);
      A.ssq_cq = W + F_SSQCQ; A.ssq_ckv = W + F_SSQCKV; A.ssq_kr = W + F_SSQKR; A.krr = W + F_KRR; A.rope = W + F_ROPE; A.q_gain = p->mla_q_gain; A.k_gain = p->mla_k_gain;
      A.q16 = U16P(F_Q16); A.k16 = U16P(F_K16); A.vt16 = U16P(F_VT16); A.hid = W + F_HID;
      p2_phase(lds_raw + 64, A); }
    GRID_SYNC();
    { const int vb = blockIdx.x, nb = NBLK;
      { cparams_t p = params_ptr(); float* W = p->W;
#define P3_XT(j) ({ const int v_ = vb + nb * (j); \
          (v_ < 256) ? xt_make(p->w_out, 1024, 1024, U16P(F_WTOUT), p->out_gain_a, p->out_gain_b, 512, 0, v_) : \
          (v_ < 768) ? xt_make(p->peer_w_q, 1024, 2048, U16P(F_WTQ), p->norm2_gain, p->norm2_gain, 1 << 30, 0, v_ - 256) : xt_make(nullptr, 64, 64, nullptr, nullptr, nullptr, 0, 0, -1); })
        XT_RUN4(ldsf, P3_XT); }
      { cparams_t p = params_ptr(); float* W = p->W;
        p3_cmp2(lds_raw + 64 + 36864, W + F_HID, W + F_CBIAS, U16P(F_W2TK), U16P(F_W2TV), p->nsa_kc_gain, W + F_ROPE, U16P(F_KC16), U16P(F_VCT16)); }
      { cparams_t p = params_ptr(); float* W = p->W;
        cvt_stream(p->peer_sub_keys, U16P(F_SK16), (long)8 * 2 * 128 * 128, vb, nb);
        cvt_rows_fp6<4>(p->peer_v, (unsigned char*)(W + F_V8), W + F_SV, 16384, vb, nb);
        cvt_rows_fp6<2>(p->peer_u + (long)PU_SPLIT * 1024, (unsigned char*)(W + F_U8) + (long)PU_SPLIT * PROW, W + F_SU + PU_SPLIT, 16384 - PU_SPLIT, vb, nb); }
    }
    GRID_SYNC();
    { cparams_t p = params_ptr(); float* W = p->W;
      nsa_phase(lds_raw + 64, U16P(F_Q16A), U16P(F_KC16), U16P(F_VCT16), U16P(F_KS16), U16P(F_VST16), U16P(F_KW16), U16P(F_VWT16), W + F_GATES, U16P(F_MIX), W + F_SSQA); }
    { cparams_t p = params_ptr(); float* W = p->W;
      mla_phase(lds_raw + 64, U16P(F_Q16), U16P(F_K16), U16P(F_VT16), U16P(F_MIX), W + F_SSQB); }
    GRID_SYNC();
    { cparams_t p = params_ptr(); float* W = p->W;
      p5_outproj_256(lds_raw + 64, U16P(F_MIX), U16P(F_WTOUT), W + F_SSQA, W + F_SSQB, p->x, p->out, U16P(F_HB), W + F_HSS); }
    GRID_SYNC();
    { cparams_t p = params_ptr(); float* W = p->W;
      p6_peerq_256(lds_raw + 64, U16P(F_HB), U16P(F_WTQ), W + F_HSS, U16P(F_PQB), W + F_PSS); }
    GRID_SYNC();
    { cparams_t p = params_ptr(); float* W = p->W;
      peer_route_mfma(lds_raw + 64, U16P(F_PQB), W + F_PSS, U16P(F_SK16), (int*)(W + F_EO), W + F_GO); }
    GRID_SYNC();
    { cparams_t p = params_ptr(); float* W = p->W;
      peer_sweep_a(W + F_HSS, p->norm2_gain, (const int*)(W + F_EO), W + F_GO, (const unsigned char*)(W + F_U8), W + F_SU, W + F_SV, p->out, W + F_PQB); }
    GRID_SYNC();
    { cparams_t p = params_ptr(); float* W = p->W;
      peer_sweep_b((const int*)(W + F_EO), W + F_PQB, (const unsigned char*)(W + F_V8), p->out); }
}

extern "C" void kernel_launch(void* const* d_in, const int* in_sizes, int n_in, void* d_out, int out_size, void* d_ws, size_t ws_size, hipStream_t stream) {
    (void)ws_size; (void)in_sizes; (void)n_in; (void)out_size;
    static int grid = 0;
    if (grid == 0) {
        int dev = 0, cus = 0, per_cu = 0;
        (void)hipGetDevice(&dev);
        (void)hipDeviceGetAttribute(&cus, hipDeviceAttributeMultiprocessorCount, dev);
        (void)hipFuncSetAttribute((const void*)mega, hipFuncAttributeMaxDynamicSharedMemorySize, LDS_BYTES);
        (void)hipOccupancyMaxActiveBlocksPerMultiprocessor(&per_cu, (const void*)mega, 512, LDS_BYTES);
        (void)hipGetLastError();
        if (per_cu < 1) fprintf(stderr, "kernel_launch: occupancy query reports %d blocks per CU\n", per_cu);
        if (cus != NBLK) fprintf(stderr, "kernel_launch: built for %d CUs, device reports %d\n", NBLK, cus);
        grid = NBLK;
    }
    Params p{};
    p.x = (const float*)d_in[0]; p.positions = (const int*)d_in[1]; p.norm1_gain = (const float*)d_in[2]; p.w_in = (const float*)d_in[3];
    p.nsa_q_gain = (const float*)d_in[4]; p.nsa_kc_gain = (const float*)d_in[5]; p.nsa_ks_gain = (const float*)d_in[6]; p.nsa_kw_gain = (const float*)d_in[7];
    p.cmp_pos = (const float*)d_in[8]; p.cmp_k_w1 = (const float*)d_in[9]; p.cmp_k_w2 = (const float*)d_in[10]; p.cmp_v_w1 = (const float*)d_in[11]; p.cmp_v_w2 = (const float*)d_in[12];
    p.mla_q_lora_gain = (const float*)d_in[13]; p.mla_w_uq = (const float*)d_in[14]; p.mla_kv_lora_gain = (const float*)d_in[15]; p.mla_w_ukv = (const float*)d_in[16];
    p.mla_q_gain = (const float*)d_in[17]; p.mla_k_gain = (const float*)d_in[18]; p.out_gain_a = (const float*)d_in[19]; p.out_gain_b = (const float*)d_in[20]; p.w_out = (const float*)d_in[21];
    p.norm2_gain = (const float*)d_in[22]; p.peer_w_q = (const float*)d_in[23]; p.peer_sub_keys = (const float*)d_in[24]; p.peer_u = (const float*)d_in[25]; p.peer_v = (const float*)d_in[26];
    p.out = (float*)d_out;
    p.bar = (unsigned*)d_ws;
    p.W = (float*)d_ws + 16384;
    (void)hipMemsetAsync(d_ws, 0, XCD_BAR_WORDS * sizeof(unsigned), stream);
    hipLaunchKernelGGL(mega, dim3(grid), dim3(512), LDS_BYTES, stream, p);
}
```

```cpp
#include <hip/hip_runtime.h>
#include <cmath>
#include <cstdint>
#include <cstdio>

#define XB_TMO      128
#define XB_XCNT(j)  (256  + 64 * (j))
#define XB_XSUB(j)  (1280 + 64 * (j))
#define XB_XGEN(j)  (2304 + 64 * (j))
#define XB_TOP      3328
#define XB_TOPGEN   3392
#define XCD_BAR_WORDS 3456
#define XB_SPIN_CAP (1u << 18)
#define LAS __attribute__((address_space(3)))

__device__ __forceinline__ unsigned xb_ld(unsigned* p)              { return __hip_atomic_load(p, __ATOMIC_RELAXED, __HIP_MEMORY_SCOPE_AGENT); }
__device__ __forceinline__ unsigned xb_add(unsigned* p, unsigned v) { return __hip_atomic_fetch_add(p, v, __ATOMIC_RELAXED, __HIP_MEMORY_SCOPE_AGENT); }
__device__ __forceinline__ unsigned xb_xcc_id() { return (unsigned)__builtin_amdgcn_s_getreg((3 << 11) | 20) & 0xFu; }
#define XB_SPIN(cond, bar) do { unsigned _sp = 0; while (cond) { __builtin_amdgcn_s_sleep(1); \
    if ((++_sp & 255u) == 0u) { if (xb_ld(&(bar)[XB_TMO])) break; if (_sp > XB_SPIN_CAP) { atomicAdd(&(bar)[XB_TMO], 1u); break; } } } } while (0)

struct XcdBarrier {
    unsigned* bar; unsigned x;
    volatile LAS unsigned* st;
};

__device__ __forceinline__ XcdBarrier xcd_barrier_post(unsigned* bar, volatile LAS unsigned* st) {
    XcdBarrier b; b.bar = bar; b.x = xb_xcc_id(); b.st = st;
    if (threadIdx.x == 0) (void)xb_add(&bar[XB_XCNT(b.x)], 1u);
    return b;
}
__device__ __forceinline__ void xcd_barrier_complete(unsigned* bar, unsigned x, unsigned& nloc, unsigned& nx) {
    const unsigned G = gridDim.x * gridDim.y * gridDim.z;
    unsigned sum, cnt, mine, sp = 0u;
    for (;;) {
        sum = 0u; cnt = 0u; mine = 0u;
#pragma unroll
        for (unsigned j = 0; j < 16; ++j) { const unsigned c = xb_ld(&bar[XB_XCNT(j)]); sum += c; cnt += (c > 0u) ? 1u : 0u; mine = (j == x) ? c : mine; }
        if (sum == G) break;
        __builtin_amdgcn_s_sleep(1);
        if ((++sp & 255u) == 0u) { if (xb_ld(&bar[XB_TMO])) break; if (sp > XB_SPIN_CAP) { atomicAdd(&bar[XB_TMO], 1u); break; } }
    }
    nloc = mine > 0u ? mine : 1u; nx = cnt > 0u ? cnt : 1u;
}

__device__ __forceinline__ void xcd_barrier(const XcdBarrier& b) {
    asm volatile("s_waitcnt vmcnt(0)" ::: "memory");
    __syncthreads();
    if (threadIdx.x == 0) {
        unsigned* bar = b.bar;
        __builtin_amdgcn_s_waitcnt(0);
        unsigned nloc = b.st[0], nx = b.st[1];
        if (nloc == 0u) { xcd_barrier_complete(bar, b.x, nloc, nx); b.st[0] = nloc; b.st[1] = nx; }
        const unsigned old = xb_add(&bar[XB_XSUB(b.x)], 1u);
        const unsigned gen = old / nloc;
        if (old + 1u == (gen + 1u) * nloc) {
            __builtin_amdgcn_fence(__ATOMIC_RELEASE, "agent");
            asm volatile("s_waitcnt vmcnt(0)" ::: "memory");
            const unsigned og = xb_add(&bar[XB_TOP], 1u);
            const unsigned tg = og / nx;
            if (og + 1u == (tg + 1u) * nx) xb_add(&bar[XB_TOPGEN], 1u);
            else XB_SPIN(xb_ld(&bar[XB_TOPGEN]) == tg, bar);
            __builtin_amdgcn_fence(__ATOMIC_ACQUIRE, "agent");
            xb_add(&bar[XB_XGEN(b.x)], 1u);
            asm volatile("s_waitcnt vmcnt(0)" ::: "memory");
        } else {
            XB_SPIN(xb_ld(&bar[XB_XGEN(b.x)]) == gen, bar);
            __builtin_amdgcn_fence(__ATOMIC_ACQUIRE, "agent");
            asm volatile("s_waitcnt vmcnt(0)" ::: "memory");
        }
    }
    __syncthreads();
}


#define AS1 __attribute__((address_space(1)))
constexpr int NBLK = 256;
constexpr int B_ = 2, S_ = 8192, T_ = B_ * S_, D_ = 1024, INW = 1720;
constexpr int G_ = 2, NCMP = 511;
constexpr float EPS = 1e-6f;
constexpr int C_Q = 0, C_KC = 512, C_VC = 640, C_KS = 768, C_VS = 896, C_KW = 1024, C_VW = 1152, C_GATE = 1280, C_CQ = 1304, C_CKV = 1560, C_KR = 1688;

#define WSYNC() do { __builtin_amdgcn_wave_barrier(); asm volatile("s_waitcnt lgkmcnt(0)" ::: "memory"); __builtin_amdgcn_wave_barrier(); } while (0)

__device__ __forceinline__ int tid_() { int t = threadIdx.x; asm volatile("" : "+v"(t)); return t; }
template <class T> __device__ __forceinline__ T* as_global(T* p) { return (T*)(__attribute__((address_space(1))) T*)p; }
__device__ __forceinline__ float wsum(float v) {
#pragma unroll
    for (int o = 32; o > 0; o >>= 1) v += __shfl_xor(v, o);
    return v;
}
__device__ __forceinline__ float wmax(float v) {
#pragma unroll
    for (int o = 32; o > 0; o >>= 1) v = fmaxf(v, __shfl_xor(v, o));
    return v;
}
__device__ __forceinline__ float gelu_tanh(float x) {
    const float u = 0.7978845608028654f * (x + 0.044715f * x * x * x);
    return 0.5f * x * (1.f + tanhf(u));
}

__device__ const float ROPE_F16[8] = {1.000000000e+00f, 1.939227432e-01f, 3.760603070e-02f, 7.292664610e-03f, 1.414213562e-03f, 2.742481884e-04f, 5.318296098e-05f, 1.031338616e-05f};
__device__ const float ROPE_F32[16] = {1.000000000e+00f, 4.403665960e-01f, 1.939227432e-01f, 8.539710194e-02f, 3.760603070e-02f, 1.656043902e-02f, 7.292664610e-03f, 3.211445874e-03f,
                                       1.414213562e-03f, 6.227723788e-04f, 2.742481884e-04f, 1.207697351e-04f, 5.318296098e-05f, 2.341999971e-05f, 1.031338616e-05f, 4.541670478e-06f};

typedef __attribute__((ext_vector_type(8))) short bf16x8;
typedef __attribute__((ext_vector_type(16))) float f32x16;
typedef __attribute__((ext_vector_type(2))) __bf16 bf16x2_t;
__device__ __forceinline__ unsigned cvtpk(float lo, float hi) { unsigned r; asm("v_cvt_pk_bf16_f32 %0, %1, %2" : "=v"(r) : "v"(lo), "v"(hi)); return r; }
__device__ __forceinline__ float bflo(unsigned u) { return __uint_as_float(u << 16); }
__device__ __forceinline__ float bfhi(unsigned u) { return __uint_as_float(u & 0xffff0000u); }
__device__ __forceinline__ float dot2bf(unsigned a, unsigned b, float c) { return __builtin_amdgcn_fdot2_f32_bf16(__builtin_bit_cast(bf16x2_t, a), __builtin_bit_cast(bf16x2_t, b), c, false); }

__device__ __forceinline__ float pair_max(float x) { auto rr = __builtin_amdgcn_permlane32_swap(__float_as_uint(x), __float_as_uint(x), false, false); return fmaxf(__uint_as_float(rr[0]), __uint_as_float(rr[1])); }
__device__ __forceinline__ float pair_sum(float x) { auto rr = __builtin_amdgcn_permlane32_swap(__float_as_uint(x), __float_as_uint(x), false, false); return __uint_as_float(rr[0]) + __uint_as_float(rr[1]); }
typedef float f32x2_t __attribute__((ext_vector_type(2)));
__device__ __forceinline__ float max3f(float a, float b, float c) { float r; asm("v_max3_f32 %0, %1, %2, %3" : "=v"(r) : "v"(a), "v"(b), "v"(c)); return r; }
__device__ __forceinline__ float quad_sum(float x) {
    float y = x + __uint_as_float(__builtin_amdgcn_mov_dpp(__float_as_uint(x), 0xB1, 0xF, 0xF, true));
    return y + __uint_as_float(__builtin_amdgcn_mov_dpp(__float_as_uint(y), 0x4E, 0xF, 0xF, true));
}
#define MFMA32(a, b, c) __builtin_amdgcn_mfma_f32_32x32x16_bf16(a, b, c, 0, 0, 0)
typedef unsigned u32x4 __attribute__((ext_vector_type(4)));
constexpr int LDS_PITCH = 144;
__device__ __forceinline__ int crow(int r, int hi) { return (r & 3) + 8 * (r >> 2) + 4 * hi; }

template <int WM_, int WN_, int MI_, int NI_>
struct GemmShape {
    static constexpr int WM = WM_, WN = WN_, MI = MI_, NI = NI_;
    static constexpr int BM = WM * MI * 32, BN = WN * NI * 32, ROWS = BM + BN;
    static constexpr int CHUNKS = ROWS * 8 / 512;
    static constexpr int STAGE_BYTES = ROWS * LDS_PITCH;
    static_assert(WM * WN == 8 && (ROWS * 8) % 512 == 0, "8 waves; whole chunks per thread");
};
template <class SH, unsigned TOKMASK, int CUR>
__device__ __forceinline__ void gemm_step(unsigned char* lds, const unsigned short* const (&gp)[SH::CHUNKS], const int (&lo)[SH::CHUNKS], u32x4 (&g)[2][SH::CHUNKS],
                                          f32x16 (&acc)[SH::MI][SH::NI], int kt, int nk, int aoff, int boff) {
    const unsigned char* st = lds + (kt & 1) * SH::STAGE_BYTES;
    if (kt + 2 < nk) {
#pragma unroll
        for (int i = 0; i < SH::CHUNKS; ++i) g[CUR][i] = *(const u32x4*)(gp[i] + (long)(kt + 2) * 64);
    }
#pragma unroll
    for (int ks = 0; ks < 4; ++ks) {
        bf16x8 af[SH::MI], bfr[SH::NI];
#pragma unroll
        for (int mi = 0; mi < SH::MI; ++mi) af[mi] = *(const bf16x8*)(st + aoff + mi * 32 * LDS_PITCH + ks * 32);
#pragma unroll
        for (int ni = 0; ni < SH::NI; ++ni) bfr[ni] = *(const bf16x8*)(st + boff + ni * 32 * LDS_PITCH + ks * 32);
#pragma unroll
        for (int mi = 0; mi < SH::MI; ++mi)
#pragma unroll
            for (int ni = 0; ni < SH::NI; ++ni)
                acc[mi][ni] = ((TOKMASK >> ni) & 1u) ? MFMA32(bfr[ni], af[mi], acc[mi][ni]) : MFMA32(af[mi], bfr[ni], acc[mi][ni]);
    }
    if (kt + 1 < nk) {
        unsigned char* sn = lds + ((kt + 1) & 1) * SH::STAGE_BYTES;
#pragma unroll
        for (int i = 0; i < SH::CHUNKS; ++i) *(u32x4*)(sn + lo[i]) = g[CUR ^ 1][i];
    }
    __syncthreads();
}
template <class SH, unsigned TOKMASK>
__device__ __forceinline__ void gemm_mainloop(const unsigned short* __restrict__ A0, long lda, const unsigned short* __restrict__ B0, long ldb, int K,
                                              unsigned char* lds, f32x16 (&acc)[SH::MI][SH::NI], int tid) {
    const int lane = tid & 63, wave = __builtin_amdgcn_readfirstlane(tid >> 6), r32 = lane & 31, hi = lane >> 5;
    const int wm = wave / SH::WN, wn = wave % SH::WN;
    const unsigned short* gp[SH::CHUNKS]; int lo[SH::CHUNKS];
#pragma unroll
    for (int i = 0; i < SH::CHUNKS; ++i) {
        const int c = tid + i * 512, row = c >> 3, kc = c & 7;
        gp[i] = (row < SH::BM) ? (A0 + (long)row * lda + kc * 8) : (B0 + (long)(row - SH::BM) * ldb + kc * 8);
        lo[i] = row * LDS_PITCH + kc * 16;
    }
    u32x4 g[2][SH::CHUNKS];
    const int nk = K >> 6;
#pragma unroll
    for (int i = 0; i < SH::CHUNKS; ++i) { g[0][i] = *(const u32x4*)gp[i]; g[1][i] = *(const u32x4*)(gp[i] + 64); }
#pragma unroll
    for (int i = 0; i < SH::CHUNKS; ++i) *(u32x4*)(lds + lo[i]) = g[0][i];
    __syncthreads();
    const int aoff = (wm * SH::MI * 32 + r32) * LDS_PITCH + hi * 16;
    const int boff = (SH::BM + wn * SH::NI * 32 + r32) * LDS_PITCH + hi * 16;
    for (int kt = 0; kt < nk; kt += 2) {
        gemm_step<SH, TOKMASK, 0>(lds, gp, lo, g, acc, kt, nk, aoff, boff);
        gemm_step<SH, TOKMASK, 1>(lds, gp, lo, g, acc, kt + 1, nk, aoff, boff);
    }
}

typedef __attribute__((ext_vector_type(4))) float f32x4_t;
namespace g256 {
constexpr int BK = 64, HALF = 128, HT = HALF * BK;
__device__ __forceinline__ int lds_byte(int r, int c) { const int st = (r >> 4) * 2 + (c >> 5), rr = r & 15, cc = c & 31, ob = rr * 64 + cc * 2; return st * 1024 + (ob ^ (((ob >> 9) & 1) << 5)); }
__device__ __forceinline__ void stage_rc(int b, int& R, int& C) { const int st = b / 1024, sb = b % 1024, swz = sb ^ (((sb >> 9) & 1) << 5); R = (st >> 1) * 16 + swz / 64; C = (st & 1) * 32 + (swz % 64) / 2; }
template <int K, int PITCH = K>
__device__ __forceinline__ void mainloop(const unsigned short* __restrict__ A, const unsigned short* __restrict__ Bt, int brow, int bcol, unsigned short* shm, f32x4_t (&acc)[2][2][4][2]) {
#define SA(b, h) (shm + ((b) * 2 + (h)) * HT)
#define SB(b, h) (shm + (4 + (b) * 2 + (h)) * HT)
#define STAGE_X(T, P, BASE, br, kt) do { const AS1 char* ub_ = (const AS1 char*)(BASE) + ((long)(br) * PITCH + (long)(kt) * BK) * 2;     \
    for (int i_ = 0; i_ < 2; ++i_) { const int b_ = (T) * 16 + i_ * 8192; int r_, c_; stage_rc(b_, r_, c_); \
      __builtin_amdgcn_global_load_lds((const AS1 unsigned*)(ub_ + (unsigned)(r_ * PITCH + c_) * 2u), (LAS unsigned*)((LAS char*)(P) + b_), 16, 0, 0); } } while (0)
#define STAGE(P, BASE, br, kt) STAGE_X(tx, P, BASE, br, kt)
#define LDA(dst, b, h) for (int m = 0; m < 4; ++m) for (int k = 0; k < 2; ++k) dst[m][k] = *reinterpret_cast<const bf16x8*>((char*)SA(b, h) + lds_byte(wr * 64 + m * 16 + fr, k * 32 + fq * 8))
#define LDB(dst, b, h) for (int n = 0; n < 2; ++n) for (int k = 0; k < 2; ++k) dst[n][k] = *reinterpret_cast<const bf16x8*>((char*)SB(b, h) + lds_byte(wc * 32 + n * 16 + fr, k * 32 + fq * 8))
#define MMA(ai, bj, At_, Bt_) do { __builtin_amdgcn_s_setprio(1); \
    for (int m = 0; m < 4; ++m) for (int n = 0; n < 2; ++n) for (int k = 0; k < 2; ++k) acc[ai][bj][m][n] = __builtin_amdgcn_mfma_f32_16x16x32_bf16(At_[m][k], Bt_[n][k], acc[ai][bj][m][n], 0, 0, 0); \
    __builtin_amdgcn_s_setprio(0); } while (0)
#define WAIT_V(n) asm volatile("s_waitcnt vmcnt(" #n ")" ::: "memory")
#define WAIT_L(n) asm volatile("s_waitcnt lgkmcnt(" #n ")" ::: "memory")
#define BAR __builtin_amdgcn_s_barrier()
#define SCHED __builtin_amdgcn_sched_barrier(0)
    int tx = threadIdx.x; asm volatile("" : "+v"(tx));
    int wid = tx >> 6, lane = tx & 63, wr = wid >> 2, wc = wid & 3, fr = lane & 15, fq = lane >> 4;
    bf16x8 At[4][2], B0[2][2], B1[2][2];
    const int nt = K / BK;
    STAGE(SB(0, 0), Bt, bcol, 0); STAGE(SA(0, 0), A, brow, 0);
    STAGE(SB(0, 1), Bt, bcol + HALF, 0); STAGE(SA(0, 1), A, brow + HALF, 0);
    if (wr == 1) BAR;
    WAIT_V(4); BAR;
    STAGE(SB(1, 0), Bt, bcol, 1); STAGE(SA(1, 0), A, brow, 1); STAGE(SB(1, 1), Bt, bcol + HALF, 1);
    WAIT_V(6); BAR;
    for (int t = 0; t < nt - 2; t += 2) {
        LDB(B0, 0, 0); SCHED; LDA(At, 0, 0); STAGE(SA(1, 1), A, brow + HALF, t + 1);
        WAIT_L(8); BAR; WAIT_L(0); MMA(0, 0, At, B0); BAR; SCHED;
        LDB(B1, 0, 1); STAGE(SB(0, 0), Bt, bcol, t + 2);
        BAR; WAIT_L(0); MMA(0, 1, At, B1); BAR;
        LDA(At, 0, 1); STAGE(SA(0, 0), A, brow, t + 2);
        BAR; WAIT_L(0); MMA(1, 0, At, B0); BAR; SCHED;
        STAGE(SB(0, 1), Bt, bcol + HALF, t + 2);
        WAIT_V(6); BAR; MMA(1, 1, At, B1); BAR;
        LDB(B0, 1, 0); SCHED; LDA(At, 1, 0); STAGE(SA(0, 1), A, brow + HALF, t + 2);
        WAIT_L(8); BAR; WAIT_L(0); MMA(0, 0, At, B0); BAR; SCHED;
        LDB(B1, 1, 1); STAGE(SB(1, 0), Bt, bcol, t + 3);
        BAR; WAIT_L(0); MMA(0, 1, At, B1); BAR;
        LDA(At, 1, 1); STAGE(SA(1, 0), A, brow, t + 3);
        BAR; WAIT_L(0); MMA(1, 0, At, B0); BAR; SCHED;
        STAGE(SB(1, 1), Bt, bcol + HALF, t + 3);
        WAIT_V(6); BAR; MMA(1, 1, At, B1); BAR;
    }
    int tz = threadIdx.x; asm volatile("" : "+v"(tz)); wid = tz >> 6; lane = tz & 63; wr = wid >> 2; wc = wid & 3; fr = lane & 15; fq = lane >> 4;
    { LDB(B0, 0, 0); WAIT_V(0); LDA(At, 0, 0); STAGE_X(tz, SA(1, 1), A, brow + HALF, nt - 1);
      BAR; WAIT_L(0); MMA(0, 0, At, B0); BAR;
      LDB(B1, 0, 1); BAR; WAIT_L(0); MMA(0, 1, At, B1); BAR;
      LDA(At, 0, 1); WAIT_V(4); BAR; WAIT_L(0); MMA(1, 0, At, B0); MMA(1, 1, At, B1); BAR; }
    { LDB(B0, 1, 0); LDA(At, 1, 0); WAIT_V(2); BAR; WAIT_L(0); MMA(0, 0, At, B0); BAR;
      LDB(B1, 1, 1); WAIT_V(0); BAR; WAIT_L(0); MMA(0, 1, At, B1); BAR;
      LDA(At, 1, 1); BAR; WAIT_L(0); MMA(1, 0, At, B0); MMA(1, 1, At, B1); BAR; }
    if (wr == 0) BAR;
#undef SA
#undef SB
#undef STAGE_X
#undef STAGE
#undef LDA
#undef LDB
#undef MMA
#undef WAIT_V
#undef WAIT_L
#undef BAR
#undef SCHED
}
}

__device__ __forceinline__ void p5_outproj_256(unsigned char* lds, const unsigned short* __restrict__ mix, const unsigned short* __restrict__ wt_out, const float* __restrict__ ssqa, const float* __restrict__ ssqb,
                                               const float* __restrict__ x, float* __restrict__ out, unsigned short* __restrict__ hb, float* __restrict__ hss) {
    const int vcu = (blockIdx.x & 7) * (NBLK / 8) + (blockIdx.x >> 3);
    for (int tile = vcu; tile < 64 * 4; tile += NBLK) {
        const int m0 = (tile >> 2) * 256, n0 = (tile & 3) * 256;
        f32x4_t acc[2][2][4][2];
#pragma unroll
        for (int ai = 0; ai < 2; ++ai)
#pragma unroll
            for (int bj = 0; bj < 2; ++bj)
#pragma unroll
                for (int m = 0; m < 4; ++m)
#pragma unroll
                    for (int n = 0; n < 2; ++n) acc[ai][bj][m][n] = f32x4_t{0.f, 0.f, 0.f, 0.f};
        g256::mainloop<512, 1024>(wt_out, mix, n0, m0, (unsigned short*)lds, acc);
        float rb[2][2];
        {
            const int tid = tid_(); const int lane = tid & 63, wave = __builtin_amdgcn_readfirstlane(tid >> 6), wc = wave & 3, fr = lane & 15;
#pragma unroll
            for (int bj = 0; bj < 2; ++bj)
#pragma unroll
                for (int n = 0; n < 2; ++n) {
                    const long tok = m0 + bj * 128 + wc * 32 + n * 16 + fr; float sa = 0.f, sb = 0.f;
#pragma unroll
                    for (int hh = 0; hh < 8; ++hh) { sa += ssqa[(long)hh * T_ + tok]; sb += ssqb[(long)hh * T_ + tok]; }
                    rb[bj][n] = rsqrtf(sb * (1.f / 512.f) + EPS); const float ratio = rsqrtf(sa * (1.f / 512.f) + EPS) / rb[bj][n];
#pragma unroll
                    for (int ai = 0; ai < 2; ++ai)
#pragma unroll
                        for (int m = 0; m < 4; ++m) acc[ai][bj][m][n] *= ratio;
                }
        }
        g256::mainloop<512, 1024>(wt_out + 512, mix + 512, n0, m0, (unsigned short*)lds, acc);
        const int tid = tid_(); const int lane = tid & 63, wave = __builtin_amdgcn_readfirstlane(tid >> 6), wr = wave >> 2, wc = wave & 3, fr = lane & 15, fq = lane >> 4;
#pragma unroll
        for (int bj = 0; bj < 2; ++bj)
#pragma unroll
            for (int n = 0; n < 2; ++n) {
                const long tok = m0 + bj * 128 + wc * 32 + n * 16 + fr; const float r = rb[bj][n];
                float ss = 0.f;
#pragma unroll
                for (int ai = 0; ai < 2; ++ai)
#pragma unroll
                    for (int m = 0; m < 4; ++m) {
                        const int nrow = n0 + ai * 128 + wr * 64 + m * 16 + fq * 4;
                        const float4 xv = *(const float4*)(x + tok * 1024 + nrow);
                        float4 hv; hv.x = xv.x + acc[ai][bj][m][n][0] * r; hv.y = xv.y + acc[ai][bj][m][n][1] * r; hv.z = xv.z + acc[ai][bj][m][n][2] * r; hv.w = xv.w + acc[ai][bj][m][n][3] * r;
                        *(float4*)(out + tok * 1024 + nrow) = hv;
                        uint2 pk; pk.x = cvtpk(hv.x, hv.y); pk.y = cvtpk(hv.z, hv.w);
                        *(uint2*)(hb + tok * 1024 + nrow) = pk;
                        ss += hv.x * hv.x + hv.y * hv.y + hv.z * hv.z + hv.w * hv.w;
                    }
                { auto r1 = __builtin_amdgcn_permlane16_swap(__float_as_uint(ss), __float_as_uint(ss), false, false); ss = __uint_as_float(r1[0]) + __uint_as_float(r1[1]); }
                ss = pair_sum(ss);
                if (fq == 0) { hss[tok * 16 + (n0 >> 8) * 4 + wr] = ss; hss[tok * 16 + (n0 >> 8) * 4 + 2 + wr] = 0.f; }
            }
        __syncthreads();
    }
}
constexpr int P6_OP = 528;
__device__ __forceinline__ void p6_peerq_256(unsigned char* lds, const unsigned short* __restrict__ hb, const unsigned short* __restrict__ wt_q, const float* __restrict__ hss,
                                             unsigned short* __restrict__ pqb, float* __restrict__ pss) {
    const int vcu = (blockIdx.x & 7) * (NBLK / 8) + (blockIdx.x >> 3);
    for (int tile = vcu; tile < 64 * 8; tile += NBLK) {
        const int m0 = (tile >> 3) * 256, n0 = (tile & 7) * 256;
        f32x4_t acc[2][2][4][2];
#pragma unroll
        for (int ai = 0; ai < 2; ++ai)
#pragma unroll
            for (int bj = 0; bj < 2; ++bj)
#pragma unroll
                for (int m = 0; m < 4; ++m)
#pragma unroll
                    for (int n = 0; n < 2; ++n) acc[ai][bj][m][n] = f32x4_t{0.f, 0.f, 0.f, 0.f};
        g256::mainloop<1024>(wt_q, hb, n0, m0, (unsigned short*)lds, acc);
        const int tid = tid_(); const int lane = tid & 63, wave = __builtin_amdgcn_readfirstlane(tid >> 6), wr = wave >> 2, wc = wave & 3, fr = lane & 15, fq = lane >> 4;
#pragma unroll
        for (int bj = 0; bj < 2; ++bj)
#pragma unroll
            for (int n = 0; n < 2; ++n) {
                const long tok = m0 + bj * 128 + wc * 32 + n * 16 + fr;
                const float4* hp = (const float4*)(hss + tok * 16);
                const float4 s0 = hp[0], s1 = hp[1], s2 = hp[2], s3 = hp[3];
                const float rs = rsqrtf((s0.x + s0.y + s0.z + s0.w + s1.x + s1.y + s1.z + s1.w + s2.x + s2.y + s2.z + s2.w + s3.x + s3.y + s3.z + s3.w) * (1.f / 1024.f) + EPS);
                float ss = 0.f;
#pragma unroll
                for (int ai = 0; ai < 2; ++ai)
#pragma unroll
                    for (int m = 0; m < 4; ++m) {
                        const int nrow = n0 + ai * 128 + wr * 64 + m * 16 + fq * 4;
                        const float v0 = acc[ai][bj][m][n][0] * rs, v1 = acc[ai][bj][m][n][1] * rs, v2 = acc[ai][bj][m][n][2] * rs, v3 = acc[ai][bj][m][n][3] * rs;
                        uint2 pk; pk.x = cvtpk(v0, v1); pk.y = cvtpk(v2, v3);
                        *(uint2*)(lds + (bj * 128 + wc * 32 + n * 16 + fr) * P6_OP + (ai * 128 + wr * 64 + m * 16 + fq * 4) * 2) = pk;
                        ss += v0 * v0 + v1 * v1 + v2 * v2 + v3 * v3;
                    }
                { auto r1 = __builtin_amdgcn_permlane16_swap(__float_as_uint(ss), __float_as_uint(ss), false, false); ss = __uint_as_float(r1[0]) + __uint_as_float(r1[1]); }
                ss = pair_sum(ss);
                if (fq == 0) { pss[tok * 32 + (n0 >> 8) * 4 + wr] = ss; pss[tok * 32 + (n0 >> 8) * 4 + 2 + wr] = 0.f; }
            }
        __syncthreads();
#pragma unroll
        for (int i = 0; i < 16; ++i) {
            const int c = tid + i * 512, row = c >> 5, cc = c & 31;
            *(uint4*)(pqb + (long)(m0 + row) * 2048 + n0 + cc * 8) = *(const uint4*)(lds + row * P6_OP + cc * 16);
        }
        __syncthreads();
    }
}

__device__ __forceinline__ unsigned ordkey(float f) { const unsigned u = __float_as_uint(f); return u ^ ((unsigned)((int)u >> 31) | 0x80000000u); }
__device__ __forceinline__ float orddec(unsigned k) { return __uint_as_float((k & 0x80000000u) ? (k & 0x7fffffffu) : ~k); }
#define CE_DESC(a, b) do { const unsigned mx_ = max(a, b), mn_ = min(a, b); a = mx_; b = mn_; } while (0)
__device__ __forceinline__ void sort16_desc(unsigned (&v)[16]) {
#define CE2(i, j) CE_DESC(v[i], v[j])
    CE2(0, 13); CE2(1, 12); CE2(2, 15); CE2(3, 14); CE2(4, 8); CE2(5, 6); CE2(7, 11); CE2(9, 10);
    CE2(0, 5); CE2(1, 7); CE2(2, 9); CE2(3, 4); CE2(6, 13); CE2(8, 14); CE2(10, 15); CE2(11, 12);
    CE2(0, 1); CE2(2, 3); CE2(4, 5); CE2(6, 8); CE2(7, 9); CE2(10, 11); CE2(12, 13); CE2(14, 15);
    CE2(0, 2); CE2(1, 3); CE2(4, 10); CE2(5, 11); CE2(6, 7); CE2(8, 9); CE2(12, 14); CE2(13, 15);
    CE2(1, 2); CE2(3, 12); CE2(4, 6); CE2(5, 7); CE2(8, 10); CE2(9, 11); CE2(13, 14);
    CE2(1, 4); CE2(2, 6); CE2(5, 8); CE2(7, 10); CE2(9, 13); CE2(11, 14);
    CE2(2, 4); CE2(3, 6); CE2(9, 12); CE2(11, 13);
    CE2(3, 5); CE2(6, 8); CE2(7, 9); CE2(10, 12);
    CE2(3, 4); CE2(5, 6); CE2(7, 8); CE2(9, 10); CE2(11, 12);
    CE2(6, 7); CE2(8, 9);
#undef CE2
}
__device__ __forceinline__ void bitonic16_desc(unsigned (&a)[16]) {
#pragma unroll
    for (int j = 8; j > 0; j >>= 1)
#pragma unroll
        for (int i = 0; i < 16; ++i) { const int l = i ^ j; if (l > i) CE_DESC(a[i], a[l]); }
}
__device__ __forceinline__ void merge16_desc(unsigned (&a)[16], const unsigned (&b)[16]) {
#pragma unroll
    for (int i = 0; i < 16; ++i) a[i] = max(a[i], b[15 - i]);
#pragma unroll
    for (int j = 8; j > 0; j >>= 1)
#pragma unroll
        for (int i = 0; i < 16; ++i) { const int l = i ^ j; if (l > i) CE_DESC(a[i], a[l]); }
}
__device__ __forceinline__ void top16_of_lanepair(unsigned (&k0)[16], unsigned (&k1)[16], unsigned (&k2)[16], unsigned (&k3)[16]) {
    sort16_desc(k0); sort16_desc(k1); sort16_desc(k2); sort16_desc(k3);
    merge16_desc(k0, k1); merge16_desc(k2, k3); merge16_desc(k0, k2);
    unsigned o[16];
#pragma unroll
    for (int i = 0; i < 16; ++i) { auto rr = __builtin_amdgcn_permlane32_swap(k0[i], k0[i], false, false); k0[i] = rr[0]; o[i] = rr[1]; }
    merge16_desc(k0, o);
}
__device__ __forceinline__ void peer_route_mfma(unsigned char* lds, const unsigned short* __restrict__ pqb, const float* __restrict__ pss, const unsigned short* __restrict__ sk16, int* __restrict__ eo, float* __restrict__ go) {
    const int tid = tid_(); const int lane = tid & 63, w = __builtin_amdgcn_readfirstlane(tid >> 6), r32 = lane & 31, hi = lane >> 5;
    const int h = blockIdx.x & 7;
    constexpr int SKP = 272;
    for (int c16 = tid; c16 < 256 * 16; c16 += 512) { const int row = c16 >> 4, ch = c16 & 15; *(uint4*)(lds + row * SKP + ch * 16) = *(const uint4*)(sk16 + ((long)h * 256 + row) * 128 + ch * 8); }
    __syncthreads();
    for (int it = 0; it < 2; ++it) {
        const long tok = (long)((blockIdx.x >> 3) * 16 + w * 2 + it) * 32 + r32;
        const float4 ps = *(const float4*)(pss + tok * 32 + h * 4);
        const float rs = rsqrtf((ps.x + ps.y + ps.z + ps.w) * (1.f / 256.f) + EPS);
        unsigned T1[16], T2[16];
#pragma unroll
        for (int c = 0; c < 2; ++c) {
            f32x16 acc[4];
#pragma unroll
            for (int mt = 0; mt < 4; ++mt)
#pragma unroll
                for (int r = 0; r < 16; ++r) acc[mt][r] = 0.f;
            const unsigned short* qrow = pqb + tok * 2048 + h * 256 + c * 128 + hi * 8;
            const unsigned char* krow = lds + (c * 128 + r32) * SKP + hi * 16;
#pragma unroll 2
            for (int ks = 0; ks < 8; ++ks) {
                const bf16x8 qf = *(const bf16x8*)(qrow + ks * 16);
#pragma unroll
                for (int mt = 0; mt < 4; ++mt) { const bf16x8 kf = *(const bf16x8*)(krow + mt * 32 * SKP + ks * 32); acc[mt] = MFMA32(kf, qf, acc[mt]); }
            }
            unsigned k0[16], k1[16], k2[16], k3[16];
#pragma unroll
            for (int r = 0; r < 16; ++r) {
                const unsigned idx = 127u - (unsigned)crow(r, hi);
                k0[r] = (ordkey(acc[0][r]) & ~127u) | idx; k1[r] = (ordkey(acc[1][r]) & ~127u) | (idx - 32u);
                k2[r] = (ordkey(acc[2][r]) & ~127u) | (idx - 64u); k3[r] = (ordkey(acc[3][r]) & ~127u) | (idx - 96u);
            }
            top16_of_lanepair(k0, k1, k2, k3);
            if (c == 0) {
#pragma unroll
                for (int i = 0; i < 16; ++i) T1[i] = k0[i];
            } else {
#pragma unroll
                for (int i = 0; i < 16; ++i) T2[i] = k0[i];
            }
        }
        float v1[16], v2[16]; unsigned p1[4] = {0u, 0u, 0u, 0u}, p2[4] = {0u, 0u, 0u, 0u};
#pragma unroll
        for (int i = 0; i < 16; ++i) {
            v1[i] = orddec(T1[i] & ~127u) * rs; v2[i] = orddec(T2[i] & ~127u) * rs;
            p1[i >> 2] |= (127u - (T1[i] & 127u)) << (8 * (i & 3)); p2[i >> 2] |= (127u - (T2[i] & 127u)) << (8 * (i & 3));
        }
        unsigned c0[16], c1[16], c2[16];
#define CAND(a, b) ((ordkey(v1[a] + v2[b]) & ~255u) | (255u - (unsigned)((a) * 16 + (b))))
        c0[0] = CAND(0, 0); c0[1] = CAND(0, 1); c0[2] = CAND(0, 2); c0[3] = CAND(0, 3); c0[4] = CAND(0, 4); c0[5] = CAND(0, 5); c0[6] = CAND(0, 6); c0[7] = CAND(0, 7);
        c0[8] = CAND(0, 8); c0[9] = CAND(0, 9); c0[10] = CAND(0, 10); c0[11] = CAND(0, 11); c0[12] = CAND(0, 12); c0[13] = CAND(0, 13); c0[14] = CAND(0, 14); c0[15] = CAND(0, 15);
        c1[0] = CAND(1, 0); c1[1] = CAND(1, 1); c1[2] = CAND(1, 2); c1[3] = CAND(1, 3); c1[4] = CAND(1, 4); c1[5] = CAND(1, 5); c1[6] = CAND(1, 6); c1[7] = CAND(1, 7);
        c1[8] = CAND(15, 0); c1[9] = CAND(14, 0); c1[10] = CAND(13, 0); c1[11] = CAND(12, 0); c1[12] = CAND(11, 0); c1[13] = CAND(10, 0); c1[14] = CAND(9, 0); c1[15] = CAND(8, 0);
        c2[0] = CAND(2, 0); c2[1] = CAND(2, 1); c2[2] = CAND(2, 2); c2[3] = CAND(2, 3); c2[4] = CAND(2, 4); c2[5] = CAND(3, 0); c2[6] = CAND(3, 1); c2[7] = CAND(3, 2);
        c2[8] = CAND(3, 3); c2[9] = CAND(4, 0); c2[10] = CAND(4, 1); c2[11] = CAND(4, 2); c2[12] = CAND(5, 0); c2[13] = CAND(5, 1); c2[14] = CAND(6, 0); c2[15] = CAND(6, 1);
        const unsigned c70 = CAND(7, 0), c71 = CAND(7, 1);
#undef CAND
        bitonic16_desc(c1); sort16_desc(c2);
        c2[15] = max(c2[15], c70); c2[14] = max(c2[14], c71); bitonic16_desc(c2);
        merge16_desc(c0, c1); merge16_desc(c0, c2);
        float ev[16]; int ee[16]; float l = 0.f; const float mx = orddec(c0[0] & ~255u);
#pragma unroll
        for (int i = 0; i < 16; ++i) {
            const unsigned ci = 255u - (c0[i] & 255u); const unsigned a = ci >> 4, b = ci & 15u;
            const unsigned wa = (a >> 2) == 0 ? p1[0] : ((a >> 2) == 1 ? p1[1] : ((a >> 2) == 2 ? p1[2] : p1[3]));
            const unsigned wb = (b >> 2) == 0 ? p2[0] : ((b >> 2) == 1 ? p2[1] : ((b >> 2) == 2 ? p2[2] : p2[3]));
            const unsigned i1 = (wa >> (8 * (a & 3u))) & 255u, i2 = (wb >> (8 * (b & 3u))) & 255u;
            ee[i] = (int)(i1 * 128u + i2);
            ev[i] = __expf(orddec(c0[i] & ~255u) - mx); l += ev[i];
        }
        const float inv = 1.f / l;
        if (hi == 0) {
            int4* ep = (int4*)(eo + tok * 128 + h * 16);
            ep[0] = make_int4(ee[0], ee[1], ee[2], ee[3]); ep[1] = make_int4(ee[4], ee[5], ee[6], ee[7]); ep[2] = make_int4(ee[8], ee[9], ee[10], ee[11]); ep[3] = make_int4(ee[12], ee[13], ee[14], ee[15]);
        } else {
            float4* gp = (float4*)(go + tok * 128 + h * 16);
            gp[0] = make_float4(ev[0] * inv, ev[1] * inv, ev[2] * inv, ev[3] * inv); gp[1] = make_float4(ev[4] * inv, ev[5] * inv, ev[6] * inv, ev[7] * inv);
            gp[2] = make_float4(ev[8] * inv, ev[9] * inv, ev[10] * inv, ev[11] * inv); gp[3] = make_float4(ev[12] * inv, ev[13] * inv, ev[14] * inv, ev[15] * inv);
        }
    }
}

template <int DQK>
struct FA {
    static constexpr int NDS = DQK / 16, KP = DQK * 2 + 16, KBYTES = 64 * KP, VP = 144, VBYTES = 64 * VP, STAGE = KBYTES + VBYTES;
    static constexpr int KCH = 64 * DQK / 8, NCH = KCH + 512, SLOTS = (NCH + 511) / 512;
};
constexpr float FA_THR = 8.f;
constexpr float FA_NEG = -1e30f;
struct FaRegs { uint4 g0, g1, g2; };
template <int DQK>
__device__ __forceinline__ uint4 fa_load1(const unsigned short* __restrict__ Kg, int kpitch, const unsigned short* __restrict__ Vg, int vpitch, int tid, int i) {
    int c = tid + i * 512; if (c >= FA<DQK>::NCH) c = 0;
    const int key = c / (DQK / 8), kc = c % (DQK / 8); const int c2 = c - FA<DQK>::KCH; const int d = c2 >> 3, vc = c2 & 7;
    const unsigned koff = (unsigned)(key * kpitch + kc * 8) * 2u, voff = (unsigned)(d * vpitch + vc * 8) * 2u;
#if defined(__HIP_DEVICE_COMPILE__)
    typedef unsigned u32x4_t __attribute__((ext_vector_type(4)));
    const u32x4_t v = (c < FA<DQK>::KCH) ? *(const AS1 u32x4_t*)((const AS1 char*)Kg + koff) : *(const AS1 u32x4_t*)((const AS1 char*)Vg + voff);
    return make_uint4(v.x, v.y, v.z, v.w);
#else
    (void)koff; (void)voff; return make_uint4(0u, 0u, 0u, 0u);
#endif
}
template <int DQK>
__device__ __forceinline__ void fa_store1(unsigned char* st, const uint4& g, int tid, int i) {
    const int c = tid + i * 512;
    const int key = c / (DQK / 8), kc = c % (DQK / 8); const int c2 = c - FA<DQK>::KCH; const int d = c2 >> 3, vc = c2 & 7;
    const int off = (c < FA<DQK>::KCH) ? (key * FA<DQK>::KP + kc * 16) : (FA<DQK>::KBYTES + d * FA<DQK>::VP + vc * 16);
    if (c < FA<DQK>::NCH) *(uint4*)(st + off) = g;
}
template <int DQK>
__device__ __forceinline__ void fa_load(const unsigned short* __restrict__ Kg, int kpitch, const unsigned short* __restrict__ Vg, int vpitch, FaRegs& g, int tid) {
    g.g0 = fa_load1<DQK>(Kg, kpitch, Vg, vpitch, tid, 0); g.g1 = fa_load1<DQK>(Kg, kpitch, Vg, vpitch, tid, 1);
    if (FA<DQK>::SLOTS > 2) g.g2 = fa_load1<DQK>(Kg, kpitch, Vg, vpitch, tid, 2);
}
template <int DQK>
__device__ __forceinline__ void fa_store(unsigned char* st, const FaRegs& g, int tid) {
    fa_store1<DQK>(st, g.g0, tid, 0); fa_store1<DQK>(st, g.g1, tid, 1);
    if (FA<DQK>::SLOTS > 2) fa_store1<DQK>(st, g.g2, tid, 2);
}
template <int DQK, int MODE, bool STATS_ONLY = false>
__device__ __forceinline__ void fa_tile(const unsigned char* st, const bf16x8 (&qf)[FA<DQK>::NDS], f32x16 (&o)[2], float& mref, float& l, int key0, int qpos, int lane, bool need_mask, bool colsel = true) {
    asm volatile("" : "+v"(lane));
    const int r32 = lane & 31, hi = lane >> 5;
    f32x16 s0, s1;
#pragma unroll
    for (int r = 0; r < 16; ++r) { s0[r] = 0.f; s1[r] = 0.f; }
    {
        bf16x8 k0 = *(const bf16x8*)(st + r32 * FA<DQK>::KP + hi * 16);
        bf16x8 k1 = *(const bf16x8*)(st + (32 + r32) * FA<DQK>::KP + hi * 16);
#pragma unroll
        for (int ds = 0; ds < FA<DQK>::NDS; ++ds) {
            bf16x8 n0 = k0, n1 = k1;
            if (ds + 1 < FA<DQK>::NDS) {
                n0 = *(const bf16x8*)(st + r32 * FA<DQK>::KP + (ds + 1) * 32 + hi * 16);
                n1 = *(const bf16x8*)(st + (32 + r32) * FA<DQK>::KP + (ds + 1) * 32 + hi * 16);
            }
            s0 = MFMA32(k0, qf[ds], s0); s1 = MFMA32(k1, qf[ds], s1);
            k0 = n0; k1 = n1;
            __builtin_amdgcn_sched_barrier(0);
        }
    }
    __builtin_amdgcn_sched_barrier(0);
    if (MODE != 0 && need_mask) {
#pragma unroll
        for (int r = 0; r < 16; ++r) {
            const int ka = key0 + crow(r, hi), kb = ka + 32;
            bool ma, mb;
            if (MODE == 4) { ma = 16 * ka + 31 > qpos; mb = 16 * kb + 31 > qpos; }
            else { ma = ka > qpos; mb = kb > qpos; }
            if (MODE == 2) { ma = ma || (ka <= qpos - 512); mb = mb || (kb <= qpos - 512); }
            if (ma) s0[r] = -INFINITY;
            if (mb) s1[r] = -INFINITY;
        }
    }
    float mxa = max3f(s0[0], s0[1], s0[2]), mxb = max3f(s1[0], s1[1], s1[2]);
#pragma unroll
    for (int r = 3; r < 15; r += 2) { mxa = max3f(mxa, s0[r], s0[r + 1]); mxb = max3f(mxb, s1[r], s1[r + 1]); }
    float mx = max3f(mxa, mxb, fmaxf(s0[15], s1[15]));
    if (MODE == 3) mx = colsel ? mx : -INFINITY;
    mx = pair_max(mx);
    if (__any(mx > mref + FA_THR)) {
        const float mnew = (mx > mref + FA_THR) ? mx : mref;
        const float alpha = __builtin_amdgcn_exp2f(mref - mnew);
        mref = mnew; l *= alpha;
#pragma unroll
        for (int r = 0; r < 16; ++r) { o[0][r] *= alpha; o[1][r] *= alpha; }
    }
    const float mre = (MODE == 3) ? (colsel ? mref : INFINITY) : mref;
    const f32x2_t mm = {mre, mre};
    f32x2_t ps0 = {0.f, 0.f}, ps1 = {0.f, 0.f};
#pragma unroll
    for (int r = 0; r < 16; r += 2) {
        const f32x2_t d0 = f32x2_t{s0[r], s0[r + 1]} - mm, d1 = f32x2_t{s1[r], s1[r + 1]} - mm;
        s0[r] = __builtin_amdgcn_exp2f(d0.x); s0[r + 1] = __builtin_amdgcn_exp2f(d0.y); s1[r] = __builtin_amdgcn_exp2f(d1.x); s1[r + 1] = __builtin_amdgcn_exp2f(d1.y);
        ps0 += f32x2_t{s0[r], s0[r + 1]}; ps1 += f32x2_t{s1[r], s1[r + 1]};
    }
    ps0 += ps1;
    l += ps0.x + ps0.y;
    if (STATS_ONLY) return;
    bf16x8 pk[4];
#pragma unroll
    for (int s = 0; s < 2; ++s) {
        uint4 a, b;
        a.x = cvtpk(s0[8 * s], s0[8 * s + 1]); a.y = cvtpk(s0[8 * s + 2], s0[8 * s + 3]); a.z = cvtpk(s0[8 * s + 4], s0[8 * s + 5]); a.w = cvtpk(s0[8 * s + 6], s0[8 * s + 7]);
        b.x = cvtpk(s1[8 * s], s1[8 * s + 1]); b.y = cvtpk(s1[8 * s + 2], s1[8 * s + 3]); b.z = cvtpk(s1[8 * s + 4], s1[8 * s + 5]); b.w = cvtpk(s1[8 * s + 6], s1[8 * s + 7]);
        pk[s] = __builtin_bit_cast(bf16x8, a); pk[2 + s] = __builtin_bit_cast(bf16x8, b);
    }
    const unsigned char* vt = st + FA<DQK>::KBYTES;
    __builtin_amdgcn_sched_barrier(0);
    {
        bf16x8 v0 = *(const bf16x8*)(vt + r32 * FA<DQK>::VP + hi * 16);
        bf16x8 v1 = *(const bf16x8*)(vt + (32 + r32) * FA<DQK>::VP + hi * 16);
#pragma unroll
        for (int ks = 0; ks < 4; ++ks) {
            bf16x8 n0 = v0, n1 = v1;
            if (ks + 1 < 4) {
                n0 = *(const bf16x8*)(vt + r32 * FA<DQK>::VP + (ks + 1) * 32 + hi * 16);
                n1 = *(const bf16x8*)(vt + (32 + r32) * FA<DQK>::VP + (ks + 1) * 32 + hi * 16);
            }
            o[0] = MFMA32(v0, pk[ks], o[0]); o[1] = MFMA32(v1, pk[ks], o[1]);
            v0 = n0; v1 = n1;
            __builtin_amdgcn_sched_barrier(0);
        }
    }
}
template <int DQK>
__device__ __forceinline__ void fa_qk(const unsigned char* st, const bf16x8 (&qf)[FA<DQK>::NDS], f32x16& s0, f32x16& s1, int lane) {
    const int r32 = lane & 31, hi = lane >> 5;
#pragma unroll
    for (int r = 0; r < 16; ++r) { s0[r] = 0.f; s1[r] = 0.f; }
#pragma unroll
    for (int ds = 0; ds < FA<DQK>::NDS; ++ds) {
        const bf16x8 k0 = *(const bf16x8*)(st + r32 * FA<DQK>::KP + ds * 32 + hi * 16);
        const bf16x8 k1 = *(const bf16x8*)(st + (32 + r32) * FA<DQK>::KP + ds * 32 + hi * 16);
        s0 = MFMA32(k0, qf[ds], s0); s1 = MFMA32(k1, qf[ds], s1);
    }
}
template <int DQK, int MODE>
__device__ __forceinline__ void fa_step(const unsigned char* stc, const unsigned char* stn, const bf16x8 (&qf)[FA<DQK>::NDS], f32x16& s0, f32x16& s1, f32x16& n0, f32x16& n1,
                                        f32x16 (&o)[2], float& mref, float& l, int key0, int qpos, int lane, bool need_mask, bool colsel = true) {
    const int r32 = lane & 31, hi = lane >> 5;
    if (MODE != 0 && need_mask) {
#pragma unroll
        for (int r = 0; r < 16; ++r) {
            const int ka = key0 + crow(r, hi), kb = ka + 32;
            bool ma, mb;
            if (MODE == 4) { ma = 16 * ka + 31 > qpos; mb = 16 * kb + 31 > qpos; }
            else { ma = ka > qpos; mb = kb > qpos; }
            if (MODE == 2) { ma = ma || (ka <= qpos - 512); mb = mb || (kb <= qpos - 512); }
            if (ma) s0[r] = -INFINITY;
            if (mb) s1[r] = -INFINITY;
        }
    }
    float mxa = max3f(s0[0], s0[1], s0[2]), mxb = max3f(s1[0], s1[1], s1[2]);
#pragma unroll
    for (int r = 3; r < 15; r += 2) { mxa = max3f(mxa, s0[r], s0[r + 1]); mxb = max3f(mxb, s1[r], s1[r + 1]); }
    float mx = max3f(mxa, mxb, fmaxf(s0[15], s1[15]));
    if (MODE == 3) mx = colsel ? mx : -INFINITY;
    mx = pair_max(mx);
    if (__any(mx > mref + FA_THR)) {
        const float mnew = (mx > mref + FA_THR) ? mx : mref;
        const float alpha = __builtin_amdgcn_exp2f(mref - mnew);
        mref = mnew; l *= alpha;
#pragma unroll
        for (int r = 0; r < 16; ++r) { o[0][r] *= alpha; o[1][r] *= alpha; }
    }
    const float mre = (MODE == 3) ? (colsel ? mref : INFINITY) : mref;
    const f32x2_t mm = {mre, mre};
    __builtin_amdgcn_sched_barrier(0);
#pragma unroll
    for (int r = 0; r < 16; ++r) { n0[r] = 0.f; n1[r] = 0.f; }
    f32x2_t ps = {0.f, 0.f};
    constexpr int PER = (16 + FA<DQK>::NDS - 1) / FA<DQK>::NDS;
    {
        bf16x8 k0 = *(const bf16x8*)(stn + r32 * FA<DQK>::KP + hi * 16);
        bf16x8 k1 = *(const bf16x8*)(stn + (32 + r32) * FA<DQK>::KP + hi * 16);
#pragma unroll
        for (int ds = 0; ds < FA<DQK>::NDS; ++ds) {
            bf16x8 f0 = k0, f1 = k1;
            if (ds + 1 < FA<DQK>::NDS) {
                f0 = *(const bf16x8*)(stn + r32 * FA<DQK>::KP + (ds + 1) * 32 + hi * 16);
                f1 = *(const bf16x8*)(stn + (32 + r32) * FA<DQK>::KP + (ds + 1) * 32 + hi * 16);
            }
            n0 = MFMA32(k0, qf[ds], n0); n1 = MFMA32(k1, qf[ds], n1);
#pragma unroll
            for (int j = ds * PER; j < (ds + 1) * PER && j < 16; ++j) {
                if (j < 8) { const f32x2_t d = f32x2_t{s0[2 * j], s0[2 * j + 1]} - mm; s0[2 * j] = __builtin_amdgcn_exp2f(d.x); s0[2 * j + 1] = __builtin_amdgcn_exp2f(d.y); ps += f32x2_t{s0[2 * j], s0[2 * j + 1]}; }
                else { const int q = j - 8; const f32x2_t d = f32x2_t{s1[2 * q], s1[2 * q + 1]} - mm; s1[2 * q] = __builtin_amdgcn_exp2f(d.x); s1[2 * q + 1] = __builtin_amdgcn_exp2f(d.y); ps += f32x2_t{s1[2 * q], s1[2 * q + 1]}; }
            }
            asm volatile("" : "+v"(ps));
            k0 = f0; k1 = f1;
            __builtin_amdgcn_sched_barrier(0);
        }
    }
    l += ps.x + ps.y;
    bf16x8 pk[4];
#pragma unroll
    for (int s = 0; s < 2; ++s) {
        uint4 a, b;
        a.x = cvtpk(s0[8 * s], s0[8 * s + 1]); a.y = cvtpk(s0[8 * s + 2], s0[8 * s + 3]); a.z = cvtpk(s0[8 * s + 4], s0[8 * s + 5]); a.w = cvtpk(s0[8 * s + 6], s0[8 * s + 7]);
        b.x = cvtpk(s1[8 * s], s1[8 * s + 1]); b.y = cvtpk(s1[8 * s + 2], s1[8 * s + 3]); b.z = cvtpk(s1[8 * s + 4], s1[8 * s + 5]); b.w = cvtpk(s1[8 * s + 6], s1[8 * s + 7]);
        pk[s] = __builtin_bit_cast(bf16x8, a); pk[2 + s] = __builtin_bit_cast(bf16x8, b);
    }
    const unsigned char* vt = stc + FA<DQK>::KBYTES;
    {
        bf16x8 v0 = *(const bf16x8*)(vt + r32 * FA<DQK>::VP + hi * 16);
        bf16x8 v1 = *(const bf16x8*)(vt + (32 + r32) * FA<DQK>::VP + hi * 16);
#pragma unroll
        for (int ks = 0; ks < 4; ++ks) {
            bf16x8 f0 = v0, f1 = v1;
            if (ks + 1 < 4) {
                f0 = *(const bf16x8*)(vt + r32 * FA<DQK>::VP + (ks + 1) * 32 + hi * 16);
                f1 = *(const bf16x8*)(vt + (32 + r32) * FA<DQK>::VP + (ks + 1) * 32 + hi * 16);
            }
            o[0] = MFMA32(v0, pk[ks], o[0]); o[1] = MFMA32(v1, pk[ks], o[1]);
            v0 = f0; v1 = f1;
            __builtin_amdgcn_sched_barrier(0);
        }
    }
}
__device__ __forceinline__ int vperm(int s) { const int g = (s >> 2) & 3; const int pg = (g == 1) ? 2 : ((g == 2) ? 1 : g); return (s & ~15) | (pg << 2) | (s & 3); }

constexpr float MLA_QSCALE = 0.10206207261596575f * 1.4426950408889634f;
__device__ __forceinline__ void mla_unit(unsigned char* lds, int b, int h, int qb, const unsigned short* __restrict__ Q16, const unsigned short* __restrict__ K16, const unsigned short* __restrict__ VT16,
                                         unsigned short* __restrict__ ob16, float* __restrict__ ssqb, int tid) {
    typedef FA<96> F;
    const int lane = tid & 63, wave = __builtin_amdgcn_readfirstlane(tid >> 6), r32 = lane & 31, hi = lane >> 5;
    const int q0 = qb * 256, qpos = q0 + wave * 32 + r32; const long tok = (long)b * S_ + qpos;
    bf16x8 qf[F::NDS];
#pragma unroll
    for (int ds = 0; ds < F::NDS; ++ds) qf[ds] = *(const bf16x8*)(Q16 + tok * 768 + h * 96 + ds * 16 + hi * 8);
    f32x16 o[2];
#pragma unroll
    for (int r = 0; r < 16; ++r) { o[0][r] = 0.f; o[1][r] = 0.f; }
    float mref = FA_NEG, l = 0.f;
    const unsigned short* Kb = K16 + ((long)(b * 8 + h)) * S_ * 96;
    const unsigned short* Vb = VT16 + ((long)(b * 8 + h)) * 64 * S_;
    const int nt = (q0 + 256) / 64;
    FaRegs g;
    fa_load<96>(Kb, 96, Vb, S_, g, tid); fa_store<96>(lds, g, tid);
    fa_load<96>(Kb + (long)64 * 96, 96, Vb + 64, S_, g, tid); fa_store<96>(lds + F::STAGE, g, tid);
    __syncthreads();
    const int wmin = q0 + wave * 32, wmax = wmin + 31;
    f32x16 sa0, sa1, sb0, sb1;
    fa_qk<96>(lds, qf, sa0, sa1, lane);
#define MLA_STEP(C0, C1, N0, N1, t) do { \
        const int sc_ = (t) % 3, sn_ = ((t) + 1) % 3, sw_ = ((t) + 2) % 3; \
        if ((t) + 2 < nt) fa_load<96>(Kb + (long)((t) + 2) * 64 * 96, 96, Vb + ((t) + 2) * 64, S_, g, tid); \
        const int key0 = (t) * 64; \
        if (key0 <= wmax) fa_step<96, 1>(lds + sc_ * F::STAGE, lds + sn_ * F::STAGE, qf, C0, C1, N0, N1, o, mref, l, key0, qpos, lane, key0 + 63 > wmin); \
        if ((t) + 2 < nt) fa_store<96>(lds + sw_ * F::STAGE, g, tid); \
        __syncthreads(); } while (0)
    for (int t = 0; t < nt; t += 2) {
        MLA_STEP(sa0, sa1, sb0, sb1, t);
        MLA_STEP(sb0, sb1, sa0, sa1, t + 1);
    }
#undef MLA_STEP
    l = pair_sum(l);
    const float inv = 1.f / l;
    float ss = 0.f;
#pragma unroll
    for (int dt = 0; dt < 2; ++dt)
#pragma unroll
        for (int gq = 0; gq < 4; ++gq) {
            const float v0 = o[dt][4 * gq] * inv, v1 = o[dt][4 * gq + 1] * inv, v2 = o[dt][4 * gq + 2] * inv, v3 = o[dt][4 * gq + 3] * inv;
            uint2 pk; pk.x = cvtpk(v0, v1); pk.y = cvtpk(v2, v3);
            *(uint2*)(ob16 + tok * 1024 + 512 + h * 64 + dt * 32 + 8 * gq + 4 * hi) = pk;
            ss += v0 * v0 + v1 * v1 + v2 * v2 + v3 * v3;
        }
    ss = pair_sum(ss);
    if (hi == 0) ssqb[(long)h * T_ + tok] = ss;
}
namespace m128 {
constexpr int KP = 208, VP = 272, KBYTES = 128 * KP, VBYTES = 64 * VP, STAGE = KBYTES + VBYTES;
struct Regs { u32x4 g[5]; };
__device__ __forceinline__ void load(const unsigned short* __restrict__ Kg, const unsigned short* __restrict__ Vg, Regs& R, int tid) {
#pragma unroll
    for (int i = 0; i < 5; ++i) {
        const int c = tid + i * 512;
        if (i < 3) { const int key = c / 12, kc = c % 12; R.g[i] = *(const AS1 u32x4*)((const AS1 char*)Kg + (unsigned)(key * 96 + kc * 8) * 2u); }
        else { const int c2 = c - 1536; const int d = c2 >> 4, vc = c2 & 15; R.g[i] = *(const AS1 u32x4*)((const AS1 char*)Vg + (unsigned)(d * S_ + vc * 8) * 2u); }
    }
}
__device__ __forceinline__ void store(unsigned char* st, const Regs& R, int tid) {
#pragma unroll
    for (int i = 0; i < 5; ++i) {
        const int c = tid + i * 512;
        if (i < 3) { const int key = c / 12, kc = c % 12; *(u32x4*)(st + key * KP + kc * 16) = R.g[i]; }
        else { const int c2 = c - 1536; const int d = c2 >> 4, vc = c2 & 15; *(u32x4*)(st + KBYTES + d * VP + vc * 16) = R.g[i]; }
    }
}
__device__ __forceinline__ void tile(const unsigned char* st, const bf16x8 (&qf)[6], f32x16 (&o)[2], float& mref, float& l, int key0, int qpos, int lane, bool need_mask) {
    asm volatile("" : "+v"(lane));
    const int r32 = lane & 31, hi = lane >> 5;
    f32x16 s[4];
#pragma unroll
    for (int kb = 0; kb < 4; ++kb)
#pragma unroll
        for (int r = 0; r < 16; ++r) s[kb][r] = 0.f;
#pragma unroll
    for (int half = 0; half < 2; ++half) {
        const unsigned char* kb0 = st + ((2 * half) * 32 + r32) * KP + hi * 16, * kb1 = kb0 + 32 * KP;
        bf16x8 k0 = *(const bf16x8*)kb0, k1 = *(const bf16x8*)kb1;
#pragma unroll
        for (int ds = 0; ds < 6; ++ds) {
            bf16x8 n0 = k0, n1 = k1;
            if (ds + 1 < 6) { n0 = *(const bf16x8*)(kb0 + (ds + 1) * 32); n1 = *(const bf16x8*)(kb1 + (ds + 1) * 32); }
            s[2 * half] = MFMA32(k0, qf[ds], s[2 * half]); s[2 * half + 1] = MFMA32(k1, qf[ds], s[2 * half + 1]);
            k0 = n0; k1 = n1;
            __builtin_amdgcn_sched_barrier(0);
        }
    }
    if (need_mask) {
#pragma unroll
        for (int kb = 0; kb < 4; ++kb)
#pragma unroll
            for (int r = 0; r < 16; ++r) if (key0 + kb * 32 + crow(r, hi) > qpos) s[kb][r] = -INFINITY;
    }
    float mxa = max3f(s[0][0], s[0][1], s[0][2]), mxb = max3f(s[1][0], s[1][1], s[1][2]), mxc = max3f(s[2][0], s[2][1], s[2][2]), mxd = max3f(s[3][0], s[3][1], s[3][2]);
#pragma unroll
    for (int r = 3; r < 15; r += 2) { mxa = max3f(mxa, s[0][r], s[0][r + 1]); mxb = max3f(mxb, s[1][r], s[1][r + 1]); mxc = max3f(mxc, s[2][r], s[2][r + 1]); mxd = max3f(mxd, s[3][r], s[3][r + 1]); }
    float mx = max3f(max3f(mxa, mxb, s[0][15]), max3f(mxc, mxd, s[1][15]), fmaxf(s[2][15], s[3][15]));
    mx = pair_max(mx);
    if (__any(mx > mref + FA_THR)) {
        const float mnew = (mx > mref + FA_THR) ? mx : mref;
        const float alpha = __builtin_amdgcn_exp2f(mref - mnew);
        mref = mnew; l *= alpha;
#pragma unroll
        for (int r = 0; r < 16; ++r) { o[0][r] *= alpha; o[1][r] *= alpha; }
    }
    const f32x2_t mm = {mref, mref};
    f32x2_t ps0 = {0.f, 0.f}, ps1 = {0.f, 0.f};
    bf16x8 pk[8];
#pragma unroll
    for (int kb = 0; kb < 4; ++kb) {
        unsigned pw[8];
#pragma unroll
        for (int r = 0; r < 16; r += 2) {
            const f32x2_t d = f32x2_t{s[kb][r], s[kb][r + 1]} - mm;
            const f32x2_t e = {__builtin_amdgcn_exp2f(d.x), __builtin_amdgcn_exp2f(d.y)};
            if (r & 2) ps1 += e; else ps0 += e;
            pw[r >> 1] = cvtpk(e.x, e.y);
        }
        pk[2 * kb] = __builtin_bit_cast(bf16x8, u32x4{pw[0], pw[1], pw[2], pw[3]});
        pk[2 * kb + 1] = __builtin_bit_cast(bf16x8, u32x4{pw[4], pw[5], pw[6], pw[7]});
    }
    ps0 += ps1; l += ps0.x + ps0.y;
    const unsigned char* vt = st + KBYTES + r32 * VP + hi * 16;
    __builtin_amdgcn_sched_barrier(0);
    {
        bf16x8 v0 = *(const bf16x8*)vt, v1 = *(const bf16x8*)(vt + 32 * VP);
#pragma unroll
        for (int ks = 0; ks < 8; ++ks) {
            bf16x8 n0 = v0, n1 = v1;
            if (ks + 1 < 8) { n0 = *(const bf16x8*)(vt + (ks + 1) * 32); n1 = *(const bf16x8*)(vt + 32 * VP + (ks + 1) * 32); }
            o[0] = MFMA32(v0, pk[ks], o[0]); o[1] = MFMA32(v1, pk[ks], o[1]);
            v0 = n0; v1 = n1;
            __builtin_amdgcn_sched_barrier(0);
        }
    }
}
}
__device__ __forceinline__ void mla_unit128(unsigned char* lds, int b, int h, int qb, const unsigned short* __restrict__ Q16, const unsigned short* __restrict__ K16, const unsigned short* __restrict__ VT16,
                                            unsigned short* __restrict__ ob16, float* __restrict__ ssqb, int tid) {
    const int lane = tid & 63, wave = __builtin_amdgcn_readfirstlane(tid >> 6), r32 = lane & 31, hi = lane >> 5;
    const int q0 = qb * 256, qpos = q0 + wave * 32 + r32; const long tok = (long)b * S_ + qpos;
    bf16x8 qf[6];
#pragma unroll
    for (int ds = 0; ds < 6; ++ds) qf[ds] = *(const bf16x8*)(Q16 + tok * 768 + h * 96 + ds * 16 + hi * 8);
    f32x16 o[2];
#pragma unroll
    for (int r = 0; r < 16; ++r) { o[0][r] = 0.f; o[1][r] = 0.f; }
    float mref = FA_NEG, l = 0.f;
    const unsigned short* Kb = K16 + ((long)(b * 8 + h)) * S_ * 96;
    const unsigned short* Vb = VT16 + ((long)(b * 8 + h)) * 64 * S_;
    const int nt = (q0 + 256) / 128;
    m128::Regs g;
    m128::load(Kb, Vb, g, tid); m128::store(lds, g, tid);
    m128::load(Kb + (long)128 * 96, Vb + 128, g, tid);
    __syncthreads();
    const int wmin = q0 + wave * 32, wmax = wmin + 31;
    int sc = 0;
    for (int t = 0; t < nt; ++t) {
        const int sn = (sc == 2) ? 0 : sc + 1;
        const int key0 = t * 128;
        if (key0 <= wmax) m128::tile(lds + sc * m128::STAGE, qf, o, mref, l, key0, qpos, lane, key0 + 127 > wmin);
        if (t + 1 < nt) m128::store(lds + sn * m128::STAGE, g, tid);
        if (t + 2 < nt) m128::load(Kb + (long)(t + 2) * 128 * 96, Vb + (t + 2) * 128, g, tid);
        __syncthreads();
        sc = sn;
    }
    l = pair_sum(l);
    const float inv = 1.f / l;
    float ss = 0.f;
#pragma unroll
    for (int dt = 0; dt < 2; ++dt)
#pragma unroll
        for (int gq = 0; gq < 4; ++gq) {
            const float v0 = o[dt][4 * gq] * inv, v1 = o[dt][4 * gq + 1] * inv, v2 = o[dt][4 * gq + 2] * inv, v3 = o[dt][4 * gq + 3] * inv;
            uint2 pk2; pk2.x = cvtpk(v0, v1); pk2.y = cvtpk(v2, v3);
            *(uint2*)(ob16 + tok * 1024 + 512 + h * 64 + dt * 32 + 8 * gq + 4 * hi) = pk2;
            ss += v0 * v0 + v1 * v1 + v2 * v2 + v3 * v3;
        }
    ss = pair_sum(ss);
    if (hi == 0) ssqb[(long)h * T_ + tok] = ss;
}
__device__ __forceinline__ void mla_phase(unsigned char* lds, const unsigned short* __restrict__ Q16, const unsigned short* __restrict__ K16, const unsigned short* __restrict__ VT16,
                                          unsigned short* __restrict__ ob16, float* __restrict__ ssqb) {
    const int tid = tid_();
    for (int i = blockIdx.x; i < 256; i += NBLK) {
        const int xcd = i & 7, slot = i >> 3;
        { const int bh = xcd * 2; mla_unit128(lds, bh >> 3, bh & 7, 31 - slot, Q16, K16, VT16, ob16, ssqb, tid); }
        { const int bh = xcd * 2 + 1; mla_unit128(lds, bh >> 3, bh & 7, slot, Q16, K16, VT16, ob16, ssqb, tid); }
    }
}
constexpr float NSA_QSCALE = 0.125f * 1.4426950408889634f;
constexpr int IMP_PITCH = 129;
__device__ __forceinline__ void fa_tile_cmp2(const unsigned char* st, const bf16x8 (&qf)[4], f32x16 (&o)[2], float mref, float linv, int key0, int qpos, int lane, float* imp_row, bool need_mask) {
    typedef FA<64> F;
    asm volatile("" : "+v"(lane));
    const int r32 = lane & 31, hi = lane >> 5;
    f32x16 s0, s1;
#pragma unroll
    for (int r = 0; r < 16; ++r) { s0[r] = 0.f; s1[r] = 0.f; }
#pragma unroll
    for (int ds = 0; ds < 4; ++ds) {
        const bf16x8 k0 = *(const bf16x8*)(st + r32 * F::KP + ds * 32 + hi * 16);
        const bf16x8 k1 = *(const bf16x8*)(st + (32 + r32) * F::KP + ds * 32 + hi * 16);
        s0 = MFMA32(k0, qf[ds], s0); s1 = MFMA32(k1, qf[ds], s1);
    }
    {
        const f32x2_t mm = {mref, mref}, ll = {linv, linv};
#pragma unroll
        for (int r = 0; r < 16; r += 2) {
            const f32x2_t d0 = f32x2_t{s0[r], s0[r + 1]} - mm, d1 = f32x2_t{s1[r], s1[r + 1]} - mm;
            const f32x2_t p0 = f32x2_t{__builtin_amdgcn_exp2f(d0.x), __builtin_amdgcn_exp2f(d0.y)} * ll, p1 = f32x2_t{__builtin_amdgcn_exp2f(d1.x), __builtin_amdgcn_exp2f(d1.y)} * ll;
            s0[r] = p0.x; s0[r + 1] = p0.y; s1[r] = p1.x; s1[r + 1] = p1.y;
        }
    }
    if (need_mask) {
#pragma unroll
        for (int r = 0; r < 16; ++r) {
            const int ka = key0 + crow(r, hi), kb = ka + 32;
            if (16 * ka + 31 > qpos) s0[r] = 0.f;
            if (16 * kb + 31 > qpos) s1[r] = 0.f;
        }
    }
    bf16x8 pk[4];
#pragma unroll
    for (int s = 0; s < 2; ++s) {
        uint4 a, b;
        a.x = cvtpk(s0[8 * s], s0[8 * s + 1]); a.y = cvtpk(s0[8 * s + 2], s0[8 * s + 3]); a.z = cvtpk(s0[8 * s + 4], s0[8 * s + 5]); a.w = cvtpk(s0[8 * s + 6], s0[8 * s + 7]);
        b.x = cvtpk(s1[8 * s], s1[8 * s + 1]); b.y = cvtpk(s1[8 * s + 2], s1[8 * s + 3]); b.z = cvtpk(s1[8 * s + 4], s1[8 * s + 5]); b.w = cvtpk(s1[8 * s + 6], s1[8 * s + 7]);
        pk[s] = __builtin_bit_cast(bf16x8, a); pk[2 + s] = __builtin_bit_cast(bf16x8, b);
    }
    const unsigned char* vt = st + F::KBYTES;
#pragma unroll
    for (int ks = 0; ks < 4; ++ks) {
        const bf16x8 v0 = *(const bf16x8*)(vt + r32 * F::VP + ks * 32 + hi * 16);
        const bf16x8 v1 = *(const bf16x8*)(vt + (32 + r32) * F::VP + ks * 32 + hi * 16);
        o[0] = MFMA32(v0, pk[ks], o[0]); o[1] = MFMA32(v1, pk[ks], o[1]);
    }
#pragma unroll
    for (int g4 = 0; g4 < 4; ++g4) {
        const float qa = quad_sum(s0[4 * g4] + s0[4 * g4 + 1] + s0[4 * g4 + 2] + s0[4 * g4 + 3]), la = quad_sum(s0[4 * g4 + 3]);
        const float qb = quad_sum(s1[4 * g4] + s1[4 * g4 + 1] + s1[4 * g4 + 2] + s1[4 * g4 + 3]), lb = quad_sum(s1[4 * g4 + 3]);
        if ((lane & 3) == 0) {
            { const int j = (key0 + 8 * g4 + 4 * hi) >> 2;
              atomicAdd(imp_row + j, qa);
              if (j + 1 < 128) atomicAdd(imp_row + j + 1, la); }
            { const int j = (key0 + 32 + 8 * g4 + 4 * hi) >> 2;
              atomicAdd(imp_row + j, qb);
              if (j + 1 < 128) atomicAdd(imp_row + j + 1, lb); }
        }
    }
}
#define NSA_STEP_(GCUR, GNEXT, Kbase, kpitch, Vbase, vpitch, t_lo, t_hi, t_, ...) do { \
        const unsigned char* st = stg + (((t_) - (t_lo)) & 1) * FA<64>::STAGE; \
        if ((t_) + 2 <= (t_hi)) fa_load<64>((Kbase) + (long)((t_) + 2) * 64 * (kpitch), (kpitch), (Vbase) + ((t_) + 2) * 64, (vpitch), GCUR, tid); \
        const int key0 = (t_) * 64; (void)key0; \
        __VA_ARGS__ \
        if ((t_) + 1 <= (t_hi)) fa_store<64>(stg + (((t_) + 1 - (t_lo)) & 1) * FA<64>::STAGE, GNEXT, tid); \
        __syncthreads(); } while (0)
#define NSA_STREAM(Kbase, kpitch, Vbase, vpitch, t_lo, t_hi, ...) do { \
    FaRegs ga_, gb_; fa_load<64>((Kbase) + (long)(t_lo) * 64 * (kpitch), (kpitch), (Vbase) + (t_lo) * 64, (vpitch), ga_, tid); \
    if ((t_lo) + 1 <= (t_hi)) fa_load<64>((Kbase) + (long)((t_lo) + 1) * 64 * (kpitch), (kpitch), (Vbase) + ((t_lo) + 1) * 64, (vpitch), gb_, tid); \
    fa_store<64>(stg, ga_, tid); __syncthreads(); \
    for (int t_ = (t_lo); t_ <= (t_hi); t_ += 2) { \
        NSA_STEP_(ga_, gb_, Kbase, kpitch, Vbase, vpitch, t_lo, t_hi, t_, __VA_ARGS__); \
        if (t_ + 1 <= (t_hi)) { const int tt_ = t_ + 1; NSA_STEP2_(gb_, ga_, Kbase, kpitch, Vbase, vpitch, t_lo, t_hi, tt_, __VA_ARGS__); } \
    } } while (0)
#define NSA_STEP2_(GCUR, GNEXT, Kbase, kpitch, Vbase, vpitch, t_lo, t_hi, tq_, ...) do { \
        const int t_ = tq_; \
        const unsigned char* st = stg + ((t_ - (t_lo)) & 1) * FA<64>::STAGE; \
        if (t_ + 2 <= (t_hi)) fa_load<64>((Kbase) + (long)(t_ + 2) * 64 * (kpitch), (kpitch), (Vbase) + (t_ + 2) * 64, (vpitch), GCUR, tid); \
        const int key0 = t_ * 64; (void)key0; \
        __VA_ARGS__ \
        if (t_ + 1 <= (t_hi)) fa_store<64>(stg + ((t_ + 1 - (t_lo)) & 1) * FA<64>::STAGE, GNEXT, tid); \
        __syncthreads(); } while (0)

__device__ __forceinline__ void nsa_unit(unsigned char* lds, int b, int g, int qblk, const unsigned short* __restrict__ Q16A, const unsigned short* __restrict__ KC16, const unsigned short* __restrict__ VCT16,
                                         const unsigned short* __restrict__ KS16, const unsigned short* __restrict__ VST16, const unsigned short* __restrict__ KW16, const unsigned short* __restrict__ VWT16,
                                         const float* __restrict__ gates, unsigned short* __restrict__ oa16, float* __restrict__ ssqa, int tid) {
    typedef FA<64> F;
    const int lane = tid & 63, wave = __builtin_amdgcn_readfirstlane(tid >> 6), r32 = lane & 31, hi = lane >> 5;
    unsigned char* stg = lds;
    float* imp = (float*)(lds + 2 * F::STAGE);
    unsigned* selm = (unsigned*)(lds + 2 * F::STAGE + 64 * IMP_PITCH * 4);
    const int q0 = qblk * 64, cur = qblk;
    const int ql = wave * 8 + (r32 >> 2), hh = g * 4 + (r32 & 3), qpos = q0 + ql; const long tok = (long)b * S_ + qpos; const int bg = b * 2 + g;
    bf16x8 qf[4];
#pragma unroll
    for (int ds = 0; ds < 4; ++ds) qf[ds] = *(const bf16x8*)(Q16A + tok * 512 + hh * 64 + ds * 16 + hi * 8);
    for (int i = tid; i < 64 * IMP_PITCH; i += 512) imp[i] = 0.f;
    f32x16 acc[2], o[2];
#pragma unroll
    for (int r = 0; r < 16; ++r) { acc[0][r] = 0.f; acc[1][r] = 0.f; }
    const int wq_lo = q0 + wave * 8, wq_hi = wq_lo + 7;
    const int nvis_max = (q0 + 63 >= 31) ? ((q0 + 63 - 31) / 16 + 1) : 0;
    if (nvis_max > 0) {
        const int tc_hi = (nvis_max - 1) >> 6;
        const unsigned short* Kc = KC16 + (long)bg * 512 * 64; const unsigned short* Vc = VCT16 + (long)bg * 64 * 512;
        float mref = FA_NEG, l = 0.f;
        NSA_STREAM(Kc, 64, Vc, 512, 0, tc_hi, {
            if (16 * key0 + 31 <= wq_hi) fa_tile<64, 4, true>(st, qf, o, mref, l, key0, qpos, lane, 16 * (key0 + 63) + 31 > wq_lo);
        });
        l = pair_sum(l);
        const float linv = (l > 0.f) ? 1.f / l : 0.f;
#pragma unroll
        for (int r = 0; r < 16; ++r) { o[0][r] = 0.f; o[1][r] = 0.f; }
        NSA_STREAM(Kc, 64, Vc, 512, 0, tc_hi, {
            if (16 * key0 + 31 <= wq_hi) fa_tile_cmp2(st, qf, o, mref, linv, key0, qpos, lane, imp + ql * IMP_PITCH, 16 * (key0 + 63) + 31 > wq_lo);
        });
        const float g_c = gates[tok * 24 + hh * 3];
#pragma unroll
        for (int r = 0; r < 16; ++r) { acc[0][r] += g_c * o[0][r]; acc[1][r] += g_c * o[1][r]; }
    } else { __syncthreads(); }
    if (wave < 2) {
        const int qi = wave * 32 + r32;
        int his = hi; asm volatile("" : "+v"(his));
#define IMPKEY(jj) ({ const int j_ = (jj); const float v_ = (j_ == 0 || j_ == cur) ? 1e9f : ((j_ > cur) ? -1e30f : imp[qi * IMP_PITCH + j_]); (ordkey(v_) & ~127u) | (127u - (unsigned)j_); })
        unsigned k0[16];
        {
            unsigned k1[16];
#pragma unroll
            for (int i = 0; i < 16; ++i) { k0[i] = IMPKEY(his * 64 + i); k1[i] = IMPKEY(his * 64 + 16 + i); }
            sort16_desc(k0); sort16_desc(k1); merge16_desc(k0, k1);
        }
        __builtin_amdgcn_sched_barrier(0);
        {
            unsigned k2[16], k3[16];
#pragma unroll
            for (int i = 0; i < 16; ++i) { k2[i] = IMPKEY(his * 64 + 32 + i); k3[i] = IMPKEY(his * 64 + 48 + i); }
            sort16_desc(k2); sort16_desc(k3); merge16_desc(k2, k3); merge16_desc(k0, k2);
        }
#undef IMPKEY
        {
            unsigned o2[16];
#pragma unroll
            for (int i = 0; i < 16; ++i) { auto rr = __builtin_amdgcn_permlane32_swap(k0[i], k0[i], false, false); k0[i] = rr[0]; o2[i] = rr[1]; }
            merge16_desc(k0, o2);
        }
        unsigned m0 = 0u, m1 = 0u, m2 = 0u, m3 = 0u;
#pragma unroll
        for (int i = 0; i < 16; ++i) {
            const unsigned j = 127u - (k0[i] & 127u); const unsigned bit = 1u << (j & 31u); const unsigned wsel = j >> 5;
            m0 |= (wsel == 0u) ? bit : 0u; m1 |= (wsel == 1u) ? bit : 0u; m2 |= (wsel == 2u) ? bit : 0u; m3 |= (wsel == 3u) ? bit : 0u;
        }
        if (hi == 0) { selm[qi * 4] = m0; selm[qi * 4 + 1] = m1; selm[qi * 4 + 2] = m2; selm[qi * 4 + 3] = m3; }
    }
    __syncthreads();
    unsigned sm0 = selm[ql * 4], sm1 = selm[ql * 4 + 1], sm2 = selm[ql * 4 + 2], sm3 = selm[ql * 4 + 3];
    {
        float mref = FA_NEG, l = 0.f;
#pragma unroll
        for (int r = 0; r < 16; ++r) { o[0][r] = 0.f; o[1][r] = 0.f; }
        const unsigned short* Ks = KS16 + (long)bg * S_ * 64; const unsigned short* Vs = VST16 + (long)bg * 64 * S_;
        NSA_STREAM(Ks, 64, Vs, S_, 0, cur, {
            const int jw = t_ >> 5; const unsigned wsel = (jw == 0) ? sm0 : ((jw == 1) ? sm1 : ((jw == 2) ? sm2 : sm3));
            const bool colsel = (wsel >> (t_ & 31)) & 1u;
            if (__any(colsel)) fa_tile<64, 3>(st, qf, o, mref, l, key0, qpos, lane, t_ == cur, colsel);
        });
        l = pair_sum(l);
        const float sc = gates[tok * 24 + hh * 3 + 1] / l;
#pragma unroll
        for (int r = 0; r < 16; ++r) { acc[0][r] += sc * o[0][r]; acc[1][r] += sc * o[1][r]; }
    }
    {
        float mref = FA_NEG, l = 0.f;
#pragma unroll
        for (int r = 0; r < 16; ++r) { o[0][r] = 0.f; o[1][r] = 0.f; }
        const unsigned short* Kw = KW16 + (long)bg * S_ * 64; const unsigned short* Vw = VWT16 + (long)bg * 64 * S_;
        const int tw_lo = (cur >= 8) ? cur - 8 : 0;
        NSA_STREAM(Kw, 64, Vw, S_, tw_lo, cur, {
            fa_tile<64, 2>(st, qf, o, mref, l, key0, qpos, lane, (t_ == cur) || (t_ == cur - 8));
        });
        l = pair_sum(l);
        const float sc = gates[tok * 24 + hh * 3 + 2] / l;
#pragma unroll
        for (int r = 0; r < 16; ++r) { acc[0][r] += sc * o[0][r]; acc[1][r] += sc * o[1][r]; }
    }
    float ss = 0.f;
#pragma unroll
    for (int dt = 0; dt < 2; ++dt)
#pragma unroll
        for (int gq = 0; gq < 4; ++gq) {
            const float v0 = acc[dt][4 * gq], v1 = acc[dt][4 * gq + 1], v2 = acc[dt][4 * gq + 2], v3 = acc[dt][4 * gq + 3];
            uint2 pk; pk.x = cvtpk(v0, v1); pk.y = cvtpk(v2, v3);
            *(uint2*)(oa16 + tok * 1024 + hh * 64 + dt * 32 + 8 * gq + 4 * hi) = pk;
            ss += v0 * v0 + v1 * v1 + v2 * v2 + v3 * v3;
        }
    ss = pair_sum(ss);
    if (hi == 0) ssqa[(long)hh * T_ + tok] = ss;
    __syncthreads();
}
__device__ __forceinline__ void nsa_phase(unsigned char* lds, const unsigned short* __restrict__ Q16A, const unsigned short* __restrict__ KC16, const unsigned short* __restrict__ VCT16,
                                          const unsigned short* __restrict__ KS16, const unsigned short* __restrict__ VST16, const unsigned short* __restrict__ KW16, const unsigned short* __restrict__ VWT16,
                                          const float* __restrict__ gates, unsigned short* __restrict__ oa16, float* __restrict__ ssqa) {
    const int tid = tid_();
    for (int i = blockIdx.x; i < 256; i += NBLK) {
        const int xcd = i & 7, slot = i >> 3; const int bg = xcd >> 1, pr = (xcd & 1) * 32 + slot;
        nsa_unit(lds, bg >> 1, bg & 1, 127 - pr, Q16A, KC16, VCT16, KS16, VST16, KW16, VWT16, gates, oa16, ssqa, tid);
        nsa_unit(lds, bg >> 1, bg & 1, pr, Q16A, KC16, VCT16, KS16, VST16, KW16, VWT16, gates, oa16, ssqa, tid);
    }
}
__device__ __forceinline__ int nmap_in2(int n) {
    if (n < 768) return n;
    if (n < 896) return n;
    if (n < 1024) return n - 896 + 1024;
    if (n < 1152) return n - 1024 + 896;
    if (n < 1280) return n;
    if (n < 1304) return n - 1280 + 1696;
    if (n < 1560) return n - 1304 + 1280;
    if (n < 1688) return n - 1560 + 1536;
    return n - 1688 + 1664;
}
struct XT { const float* src; unsigned short* dst; const float* glo; const float* ghi; int K, N, ksplit, tile, nmap; };
__device__ __forceinline__ XT xt_make(const float* src, int K, int N, unsigned short* dst, const float* glo, const float* ghi, int ksplit, int nmap, int tile) {
    XT d; d.src = src; d.dst = dst; d.glo = glo; d.ghi = ghi; d.K = K; d.N = N; d.ksplit = ksplit; d.tile = tile; d.nmap = nmap; return d;
}
__device__ __forceinline__ void xt_load(const XT& d, float (&v)[8], int tid) {
    if (d.tile < 0) return;
    const int tn = (d.N + 63) >> 6; const int k0 = (d.tile / tn) * 64, n0 = (d.tile % tn) * 64;
    const float* __restrict__ s = as_global(d.src);
#pragma unroll
    for (int i = 0; i < 8; ++i) {
        const int kl = (tid >> 6) + 8 * i, n = n0 + (tid & 63), k = k0 + kl;
        float x = (n < d.N) ? s[(long)k * d.N + n] : 0.f;
        if (d.glo) x *= (k < d.ksplit) ? d.glo[k] : d.ghi[k - d.ksplit];
        v[i] = x;
    }
}
__device__ __forceinline__ void xt_store(const XT& d, const float (&v)[8], float* buf, int tid) {
    if (d.tile < 0) return;
    float (*tl)[65] = (float (*)[65])buf;
    const int tn = (d.N + 63) >> 6; const int k0 = (d.tile / tn) * 64, n0 = (d.tile % tn) * 64;
#pragma unroll
    for (int i = 0; i < 8; ++i) tl[(tid >> 6) + 8 * i][tid & 63] = v[i];
    __syncthreads();
    const int nl = tid >> 3, kc = (tid & 7) * 8; const int n = n0 + nl;
    if (n < d.N) {
        uint4 o; o.x = cvtpk(tl[kc][nl], tl[kc + 1][nl]); o.y = cvtpk(tl[kc + 2][nl], tl[kc + 3][nl]); o.z = cvtpk(tl[kc + 4][nl], tl[kc + 5][nl]); o.w = cvtpk(tl[kc + 6][nl], tl[kc + 7][nl]);
        const int nn = d.nmap ? nmap_in2(n) : n;
        *(uint4*)(d.dst + (long)nn * d.K + k0 + kc) = o;
    }
}
#define XT_RUN4(ldsf_, MAKE) do { const int tid_x = tid_(); float xv0[8], xv1[8], xv2[8], xv3[8]; \
    const XT xd0 = MAKE(0), xd1 = MAKE(1), xd2 = MAKE(2), xd3 = MAKE(3); \
    xt_load(xd0, xv0, tid_x); xt_load(xd1, xv1, tid_x); xt_load(xd2, xv2, tid_x); xt_load(xd3, xv3, tid_x); \
    xt_store(xd0, xv0, (ldsf_), tid_x); xt_store(xd1, xv1, (ldsf_) + 64 * 65, tid_x); xt_store(xd2, xv2, (ldsf_), tid_x); xt_store(xd3, xv3, (ldsf_) + 64 * 65, tid_x); __syncthreads(); } while (0)
__device__ __forceinline__ void p0_xn_rope(const float* __restrict__ x, const float* __restrict__ g1, const int* __restrict__ positions, unsigned short* __restrict__ xn16, float* __restrict__ rope) {
    const int tid = tid_(); const int lane = tid & 63, w = __builtin_amdgcn_readfirstlane(tid >> 6);
    const f32x4_t* gp = (const f32x4_t*)g1; const f32x4_t ga0 = gp[lane * 2], ga1 = gp[lane * 2 + 1], gb0 = gp[128 + lane * 2], gb1 = gp[128 + lane * 2 + 1];
    for (int t0 = blockIdx.x * 8 + w; t0 < T_; t0 += 4 * NBLK * 8) {
        f32x4_t v[4][4]; int pos[4];
#pragma unroll
        for (int j = 0; j < 4; ++j) {
            const int t = t0 + j * NBLK * 8;
            const f32x4_t* xp = (const f32x4_t*)(x + (long)t * 1024);
            v[j][0] = xp[lane * 2]; v[j][1] = xp[lane * 2 + 1]; v[j][2] = xp[128 + lane * 2]; v[j][3] = xp[128 + lane * 2 + 1];
            pos[j] = positions[t];
        }
#pragma unroll
        for (int j = 0; j < 4; ++j) {
            const int t = t0 + j * NBLK * 8;
            const f32x4_t a0 = v[j][0], a1 = v[j][1], b0 = v[j][2], b1 = v[j][3];
            float ss = a0.x * a0.x + a0.y * a0.y + a0.z * a0.z + a0.w * a0.w + a1.x * a1.x + a1.y * a1.y + a1.z * a1.z + a1.w * a1.w
                     + b0.x * b0.x + b0.y * b0.y + b0.z * b0.z + b0.w * b0.w + b1.x * b1.x + b1.y * b1.y + b1.z * b1.z + b1.w * b1.w;
            ss = wsum(ss); const float rs = rsqrtf(ss * (1.f / 1024.f) + EPS);
            uint4 pa, pb;
            pa.x = cvtpk(a0.x * rs * ga0.x, a0.y * rs * ga0.y); pa.y = cvtpk(a0.z * rs * ga0.z, a0.w * rs * ga0.w); pa.z = cvtpk(a1.x * rs * ga1.x, a1.y * rs * ga1.y); pa.w = cvtpk(a1.z * rs * ga1.z, a1.w * rs * ga1.w);
            pb.x = cvtpk(b0.x * rs * gb0.x, b0.y * rs * gb0.y); pb.y = cvtpk(b0.z * rs * gb0.z, b0.w * rs * gb0.w); pb.z = cvtpk(b1.x * rs * gb1.x, b1.y * rs * gb1.y); pb.w = cvtpk(b1.z * rs * gb1.z, b1.w * rs * gb1.w);
            ((uint4*)(xn16 + (long)t * 1024))[lane] = pa; ((uint4*)(xn16 + (long)t * 1024))[64 + lane] = pb;
            if (lane < 24) {
                const float f = lane < 8 ? ROPE_F16[lane] : ROPE_F32[lane - 8];
                const float angf = (float)pos[j] * f;
                const double ang = (double)angf; const double k = rint(ang * 0.15915494309189535);
                const float r = (float)(ang - k * 6.283185307179586);
                const float c = cosf(r), sn = sinf(r);
                if (lane < 8) { rope[(long)t * 48 + lane] = c; rope[(long)t * 48 + 8 + lane] = sn; }
                else { rope[(long)t * 48 + 16 + lane - 8] = c; rope[(long)t * 48 + 32 + lane - 8] = sn; }
            }
        }
    }
}
__device__ __forceinline__ void p0_cbias(const float* __restrict__ pos, const float* __restrict__ w1k, const float* __restrict__ w1v, float* __restrict__ cbias) {
    const int tid = tid_(); const int lane = tid & 63, w = __builtin_amdgcn_readfirstlane(tid >> 6);
    for (int task = blockIdx.x * 8 + w; task < 512; task += NBLK * 8) {
        const int mat = task >> 8, n = task & 255; const float* w1 = mat ? w1v : w1k;
        float acc = 0.f;
#pragma unroll 8
        for (int i = 0; i < 32; ++i) { const int k = lane + 64 * i; acc += pos[k] * w1[(long)k * 256 + n]; }
        acc = wsum(acc);
        if (lane == 0) cbias[task] = acc;
    }
}
__device__ __forceinline__ void zero_stream(unsigned short* __restrict__ p, long n) {
    const int tid = tid_();
    for (long c = (long)blockIdx.x * 512 + tid; c < (n >> 3); c += (long)NBLK * 512) ((uint4*)p)[c] = make_uint4(0u, 0u, 0u, 0u);
}

struct P1Out {
    unsigned short *q16a, *ks16, *kw16, *vst16, *vwt16, *kcmp16, *vcmp16, *cq16, *ckv16;
    float *krr, *ssq_kr, *ssq_cq, *ssq_ckv, *gates;
    const float *rope, *q_gain, *ks_gain, *kw_gain, *k_gain;
};
__device__ __forceinline__ void norm_rope64(f32x16& a0, f32x16& a1, const float* __restrict__ gain, const float* __restrict__ rope_t, int hi, float outscale) {
    float ss = 0.f;
#pragma unroll
    for (int r = 0; r < 16; ++r) ss += a0[r] * a0[r] + a1[r] * a1[r];
    ss = pair_sum(ss);
    const float rs = rsqrtf(ss * (1.f / 64.f) + EPS);
#pragma unroll
    for (int g = 0; g < 4; ++g) {
        const float4 g0 = *(const float4*)(gain + 8 * g + 4 * hi), g1 = *(const float4*)(gain + 32 + 8 * g + 4 * hi);
        a0[4 * g] *= rs * g0.x; a0[4 * g + 1] *= rs * g0.y; a0[4 * g + 2] *= rs * g0.z; a0[4 * g + 3] *= rs * g0.w;
        a1[4 * g] *= rs * g1.x; a1[4 * g + 1] *= rs * g1.y; a1[4 * g + 2] *= rs * g1.z; a1[4 * g + 3] *= rs * g1.w;
    }
    const float4 c4 = *(const float4*)(rope_t + 4 * hi), s4 = *(const float4*)(rope_t + 8 + 4 * hi);
    const float cc[4] = {c4.x, c4.y, c4.z, c4.w}, sn[4] = {s4.x, s4.y, s4.z, s4.w};
#pragma unroll
    for (int j = 0; j < 4; ++j) { const float x1 = a0[j], x2 = a0[4 + j]; a0[j] = x1 * cc[j] - x2 * sn[j]; a0[4 + j] = x2 * cc[j] + x1 * sn[j]; }
#pragma unroll
    for (int r = 0; r < 16; ++r) { a0[r] *= outscale; a1[r] *= outscale; }
}
__device__ __forceinline__ void store_row64(unsigned short* __restrict__ dst, const f32x16& a0, const f32x16& a1, int hi) {
#pragma unroll
    for (int g = 0; g < 4; ++g) {
        uint2 p0, p1; p0.x = cvtpk(a0[4 * g], a0[4 * g + 1]); p0.y = cvtpk(a0[4 * g + 2], a0[4 * g + 3]); p1.x = cvtpk(a1[4 * g], a1[4 * g + 1]); p1.y = cvtpk(a1[4 * g + 2], a1[4 * g + 3]);
        *(uint2*)(dst + 8 * g + 4 * hi) = p0; *(uint2*)(dst + 32 + 8 * g + 4 * hi) = p1;
    }
}
__device__ __forceinline__ float ssq64(const f32x16& a0, const f32x16& a1) {
    float ss = 0.f;
#pragma unroll
    for (int r = 0; r < 16; ++r) ss += a0[r] * a0[r] + a1[r] * a1[r];
    return pair_sum(ss);
}
__device__ __forceinline__ float sum4fq(float v) {
    auto r1 = __builtin_amdgcn_permlane16_swap(__float_as_uint(v), __float_as_uint(v), false, false);
    return pair_sum(__uint_as_float(r1[0]) + __uint_as_float(r1[1]));
}
#define P1V(m, j) acc[ai][bj][m][n][j]
__device__ __forceinline__ void p1_inproj_256(unsigned char* lds, const unsigned short* __restrict__ xn16, const unsigned short* __restrict__ wt_in, const P1Out& Oin) {
    const P1Out O = Oin;
    const int tbase = (blockIdx.x & 7) * 56;
    for (int tile = tbase + (blockIdx.x >> 3); tile < tbase + 56; tile += 32) {
        const int mt = tile / 7, nt = tile % 7; const int m0 = mt * 256;
        f32x4_t acc[2][2][4][2];
#pragma unroll
        for (int ai = 0; ai < 2; ++ai)
#pragma unroll
            for (int bj = 0; bj < 2; ++bj)
#pragma unroll
                for (int m = 0; m < 4; ++m)
#pragma unroll
                    for (int n = 0; n < 2; ++n) acc[ai][bj][m][n] = f32x4_t{0.f, 0.f, 0.f, 0.f};
        if (nt == 4) g256::mainloop<1024>(xn16, wt_in, m0, nt * 256, (unsigned short*)lds, acc);
        else g256::mainloop<1024>(wt_in, xn16, nt * 256, m0, (unsigned short*)lds, acc);
        const int tid = tid_(); const int lane = tid & 63, wave = __builtin_amdgcn_readfirstlane(tid >> 6), wr = wave >> 2, wc = wave & 3, fr = lane & 15, fq = lane >> 4;
        if (nt == 4) {
#pragma unroll
            for (int bj = 0; bj < 2; ++bj)
#pragma unroll
                for (int n = 0; n < 2; ++n) {
                    const int pc = bj * 2 + (wc >> 1), d = (wc & 1) * 32 + n * 16 + fr;
                    unsigned short* vt = (pc < 2) ? O.vst16 : O.vwt16; const int g = pc & 1;
#pragma unroll
                    for (int ai = 0; ai < 2; ++ai)
#pragma unroll
                        for (int m = 0; m < 4; ++m) {
                            const int tb = m0 + ai * 128 + wr * 64 + m * 16 + fq * 4; const int b = tb / S_, s0 = tb % S_;
                            uint2 pk; pk.x = cvtpk(P1V(m, 0), P1V(m, 1)); pk.y = cvtpk(P1V(m, 2), P1V(m, 3));
                            *(uint2*)(vt + ((long)(b * 2 + g) * 64 + d) * S_ + vperm(s0)) = pk;
                        }
                }
        } else {
#pragma unroll
            for (int ai = 0; ai < 2; ++ai) {
                const int pc = ai * 2 + wr;
#pragma unroll
                for (int bj = 0; bj < 2; ++bj)
#pragma unroll
                    for (int n = 0; n < 2; ++n) {
                        const long tok = m0 + bj * 128 + wc * 32 + n * 16 + fr; const int b = (int)(tok / S_), s = (int)(tok % S_);
                        const float* rope_t = O.rope + tok * 48;
                        const bool is_q = nt < 2, is_k = nt == 3;
                        if (is_q || is_k) {
                            const float* gain = is_q ? O.q_gain : ((pc < 2) ? O.ks_gain : O.kw_gain);
                            float ss = 0.f;
#pragma unroll
                            for (int m = 0; m < 4; ++m)
#pragma unroll
                                for (int j = 0; j < 4; ++j) ss += P1V(m, j) * P1V(m, j);
                            const float rs = rsqrtf(sum4fq(ss) * (1.f / 64.f) + EPS) ;
#pragma unroll
                            for (int m = 0; m < 4; ++m) { const float4 gv = *(const float4*)(gain + m * 16 + fq * 4);
                                P1V(m, 0) *= rs * gv.x; P1V(m, 1) *= rs * gv.y; P1V(m, 2) *= rs * gv.z; P1V(m, 3) *= rs * gv.w; }
                            { const float4 c4 = *(const float4*)(rope_t + (fq & 1) * 4), s4 = *(const float4*)(rope_t + 8 + (fq & 1) * 4);
                              const float cc[4] = {c4.x, c4.y, c4.z, c4.w}, sn[4] = {s4.x, s4.y, s4.z, s4.w};
#pragma unroll
                              for (int j = 0; j < 4; ++j) {
                                  auto rr = __builtin_amdgcn_permlane32_swap(__float_as_uint(P1V(0, j)), __float_as_uint(P1V(0, j)), false, false);
                                  const float x1 = __uint_as_float(rr[0]), x2 = __uint_as_float(rr[1]);
                                  P1V(0, j) = (fq < 2) ? (x1 * cc[j] - x2 * sn[j]) : (x2 * cc[j] + x1 * sn[j]);
                              } }
                            const float osc = is_q ? NSA_QSCALE : 1.f;
                            unsigned short* dst = is_q ? (O.q16a + tok * 512 + (nt * 4 + pc) * 64) : ((pc < 2 ? O.ks16 : O.kw16) + ((long)(b * 2 + (pc & 1)) * S_ + s) * 64);
#pragma unroll
                            for (int m = 0; m < 4; ++m) { uint2 pk; pk.x = cvtpk(P1V(m, 0) * osc, P1V(m, 1) * osc); pk.y = cvtpk(P1V(m, 2) * osc, P1V(m, 3) * osc); *(uint2*)(dst + m * 16 + fq * 4) = pk; }
                        } else if (nt == 2 || nt == 5 || (nt == 6 && pc < 2)) {
                            unsigned short* dst;
                            if (nt == 2) dst = (pc < 2 ? O.kcmp16 : O.vcmp16) + ((long)(b * 2 + (pc & 1)) * S_ + s) * 64;
                            else if (nt == 5) dst = O.cq16 + tok * 256 + pc * 64;
                            else dst = O.ckv16 + tok * 128 + pc * 64;
                            float ss = 0.f;
#pragma unroll
                            for (int m = 0; m < 4; ++m) { uint2 pk; pk.x = cvtpk(P1V(m, 0), P1V(m, 1)); pk.y = cvtpk(P1V(m, 2), P1V(m, 3)); *(uint2*)(dst + m * 16 + fq * 4) = pk;
#pragma unroll
                                for (int j = 0; j < 4; ++j) ss += P1V(m, j) * P1V(m, j); }
                            if (nt != 2) { ss = sum4fq(ss); if (fq == 0) { if (nt == 5) O.ssq_cq[(long)pc * T_ + tok] = ss; else O.ssq_ckv[(long)pc * T_ + tok] = ss; } }
                        } else if (nt == 6 && pc == 2) {
                            float ss = 0.f;
#pragma unroll
                            for (int m = 0; m < 2; ++m)
#pragma unroll
                                for (int j = 0; j < 4; ++j) ss += P1V(m, j) * P1V(m, j);
                            ss = sum4fq(ss);
                            if (fq == 0) O.ssq_kr[tok] = ss;
                            {
                                const float4 g0 = *(const float4*)(O.k_gain + 64 + fq * 4), g1 = *(const float4*)(O.k_gain + 80 + fq * 4);
                                const float4 c4 = *(const float4*)(rope_t + 16 + fq * 4), s4 = *(const float4*)(rope_t + 32 + fq * 4);
                                const float ga[4] = {g0.x, g0.y, g0.z, g0.w}, gb[4] = {g1.x, g1.y, g1.z, g1.w}, cc[4] = {c4.x, c4.y, c4.z, c4.w}, sn[4] = {s4.x, s4.y, s4.z, s4.w};
                                float o1[4], o2[4];
#pragma unroll
                                for (int j = 0; j < 4; ++j) { const float x1 = P1V(0, j) * ga[j], x2 = P1V(1, j) * gb[j]; o1[j] = x1 * cc[j] - x2 * sn[j]; o2[j] = x2 * cc[j] + x1 * sn[j]; }
                                *(float4*)(O.krr + tok * 32 + fq * 4) = make_float4(o1[0], o1[1], o1[2], o1[3]);
                                *(float4*)(O.krr + tok * 32 + 16 + fq * 4) = make_float4(o2[0], o2[1], o2[2], o2[3]);
                            }
                            *(float4*)(O.gates + tok * 24 + fq * 4) = make_float4(1.f / (1.f + __expf(-P1V(2, 0))), 1.f / (1.f + __expf(-P1V(2, 1))), 1.f / (1.f + __expf(-P1V(2, 2))), 1.f / (1.f + __expf(-P1V(2, 3))));
                            if (fq < 2) *(float4*)(O.gates + tok * 24 + 16 + fq * 4) = make_float4(1.f / (1.f + __expf(-P1V(3, 0))), 1.f / (1.f + __expf(-P1V(3, 1))), 1.f / (1.f + __expf(-P1V(3, 2))), 1.f / (1.f + __expf(-P1V(3, 3))));
                        }
                    }
            }
        }
        __syncthreads();
    }
}
#undef P1V

typedef GemmShape<2, 4, 2, 2> ShBig;
typedef GemmShape<4, 2, 1, 3> ShQb;
typedef GemmShape<4, 2, 1, 4> ShKvb;
struct P2Args {
    const unsigned short *cq16, *ckv16, *wt_uq, *wt_ukv, *kcmp16, *vcmp16, *w1t_k, *w1t_v;
    const float *ssq_cq, *ssq_ckv, *ssq_kr, *krr, *rope, *q_gain, *k_gain;
    unsigned short *q16, *k16, *vt16; float* hid;
};
__device__ __forceinline__ void p2_phase(unsigned char* lds, const P2Args& A) {
    const int tid = tid_(); const int lane = tid & 63, wave = __builtin_amdgcn_readfirstlane(tid >> 6), r32 = lane & 31, hi = lane >> 5;
    const int nmine = (blockIdx.x < 128) ? 4 : 5;
    for (int it = 0; it < nmine; ++it) {
        int u;
        if (blockIdx.x < 128) { if (it == 0) u = blockIdx.x; else { const int s = blockIdx.x * 3 + (it - 1); u = (s & 1) ? 640 + (s >> 1) : 128 + (s >> 1); } }
        else { const int s = 384 + (blockIdx.x - 128) * 5 + it; u = (s & 1) ? 640 + (s >> 1) : 128 + (s >> 1); }
        if (u < 128) {
            const int mat = u >> 6, mtile = (u >> 2) & 15, ks = u & 3; const int wm = wave >> 2, wn = wave & 3;
            f32x16 acc[2][2];
#pragma unroll
            for (int mi = 0; mi < 2; ++mi)
#pragma unroll
                for (int ni = 0; ni < 2; ++ni)
#pragma unroll
                    for (int r = 0; r < 16; ++r) acc[mi][ni][r] = 0.f;
            gemm_mainloop<ShBig, 3u>((mat ? A.vcmp16 : A.kcmp16) + (long)mtile * 128 * 1024 + ks * 512, 1024, (mat ? A.w1t_v : A.w1t_k) + ks * 512, 2048, 512, lds, acc, tid);
            float* slab = A.hid + (long)(mat * 4 + ks) * 2048 * 256;
#pragma unroll
            for (int mi = 0; mi < 2; ++mi) {
                const long row = mtile * 128 + wm * 64 + mi * 32 + r32;
#pragma unroll
                for (int ni = 0; ni < 2; ++ni)
#pragma unroll
                    for (int g = 0; g < 4; ++g)
                        *(float4*)(slab + row * 256 + wn * 64 + ni * 32 + 8 * g + 4 * hi) = make_float4(acc[mi][ni][4 * g], acc[mi][ni][4 * g + 1], acc[mi][ni][4 * g + 2], acc[mi][ni][4 * g + 3]);
            }
        } else if (u < 128 + 512) {
            const int v = u - 128; const int mt = v >> 2, nt = v & 3; const int m0 = mt * 128; const int wm = wave >> 1, wn = wave & 1; const int head = nt * 2 + wn;
            f32x16 acc[1][4];
#pragma unroll
            for (int ni = 0; ni < 4; ++ni)
#pragma unroll
                for (int r = 0; r < 16; ++r) acc[0][ni][r] = 0.f;
            const long tok = m0 + wm * 32 + r32;
            const float e_c0 = A.ssq_ckv[tok], e_c1 = A.ssq_ckv[(long)T_ + tok], e_kr = A.ssq_kr[tok];
            f32x4_t e_k[4];
#pragma unroll
            for (int i = 0; i < 4; ++i) e_k[i] = ((const f32x4_t*)(A.krr + tok * 32 + hi * 16))[i];
            gemm_mainloop<ShKvb, 3u>(A.ckv16 + (long)m0 * 128, 128, A.wt_ukv + (long)nt * 256 * 128, 128, 128, lds, acc, tid);
            {
                const int b = (int)(tok / S_), s = (int)(tok % S_);
                const float rc = rsqrtf((e_c0 + e_c1) * (1.f / 128.f) + EPS);
                float ss = 0.f;
#pragma unroll
                for (int r = 0; r < 16; ++r) { acc[0][0][r] *= rc; acc[0][1][r] *= rc; ss += acc[0][0][r] * acc[0][0][r] + acc[0][1][r] * acc[0][1][r]; }
                ss = pair_sum(ss) + e_kr;
                const float rk = rsqrtf(ss * (1.f / 96.f) + EPS);
#pragma unroll
                for (int g = 0; g < 4; ++g) {
                    const float4 g0 = *(const float4*)(A.k_gain + 8 * g + 4 * hi), g1 = *(const float4*)(A.k_gain + 32 + 8 * g + 4 * hi);
                    acc[0][0][4 * g] *= rk * g0.x; acc[0][0][4 * g + 1] *= rk * g0.y; acc[0][0][4 * g + 2] *= rk * g0.z; acc[0][0][4 * g + 3] *= rk * g0.w;
                    acc[0][1][4 * g] *= rk * g1.x; acc[0][1][4 * g + 1] *= rk * g1.y; acc[0][1][4 * g + 2] *= rk * g1.z; acc[0][1][4 * g + 3] *= rk * g1.w;
                }
                unsigned short* krow = A.k16 + ((long)(b * 8 + head) * S_ + s) * 96;
                store_row64(krow, acc[0][0], acc[0][1], hi);
                const f32x4_t k0 = e_k[0], k1 = e_k[1], k2 = e_k[2], k3 = e_k[3];
                uint4 o0, o1; o0.x = cvtpk(k0.x * rk, k0.y * rk); o0.y = cvtpk(k0.z * rk, k0.w * rk); o0.z = cvtpk(k1.x * rk, k1.y * rk); o0.w = cvtpk(k1.z * rk, k1.w * rk);
                o1.x = cvtpk(k2.x * rk, k2.y * rk); o1.y = cvtpk(k2.z * rk, k2.w * rk); o1.z = cvtpk(k3.x * rk, k3.y * rk); o1.w = cvtpk(k3.z * rk, k3.w * rk);
                *(uint4*)(krow + 64 + hi * 16) = o0; *(uint4*)(krow + 64 + hi * 16 + 8) = o1;
            }
            {
#pragma unroll
                for (int ni = 2; ni < 4; ++ni)
#pragma unroll
                    for (int g4 = 0; g4 < 4; ++g4) {
                        const int tb = m0 + wm * 32 + 8 * g4 + 4 * hi; const int b = tb / S_, s0 = tb % S_; const int d = (ni - 2) * 32 + r32;
                        const f32x4_t sa = *(const f32x4_t*)(A.ssq_ckv + tb), sb = *(const f32x4_t*)(A.ssq_ckv + (long)T_ + tb);
                        const float r0 = rsqrtf((sa.x + sb.x) * (1.f / 128.f) + EPS), r1 = rsqrtf((sa.y + sb.y) * (1.f / 128.f) + EPS), r2 = rsqrtf((sa.z + sb.z) * (1.f / 128.f) + EPS), r3 = rsqrtf((sa.w + sb.w) * (1.f / 128.f) + EPS);
                        uint2 pk; pk.x = cvtpk(acc[0][ni][4 * g4] * r0, acc[0][ni][4 * g4 + 1] * r1); pk.y = cvtpk(acc[0][ni][4 * g4 + 2] * r2, acc[0][ni][4 * g4 + 3] * r3);
                        *(uint2*)(A.vt16 + ((long)(b * 8 + head) * 64 + d) * S_ + vperm(s0)) = pk;
                    }
            }
        } else {
            const int v = u - 640; const int mt = v >> 2, nt = v & 3; const int m0 = mt * 128; const int wm = wave >> 1, wn = wave & 1; const int head = nt * 2 + wn;
            f32x16 acc[1][3];
#pragma unroll
            for (int ni = 0; ni < 3; ++ni)
#pragma unroll
                for (int r = 0; r < 16; ++r) acc[0][ni][r] = 0.f;
            const long tok = m0 + wm * 32 + r32;
            const float e_q0 = A.ssq_cq[tok], e_q1 = A.ssq_cq[(long)T_ + tok], e_q2 = A.ssq_cq[2L * T_ + tok], e_q3 = A.ssq_cq[3L * T_ + tok];
            const float* rope_t = A.rope + tok * 48;
            f32x4_t e_c[2], e_s[2];
#pragma unroll
            for (int g = 0; g < 2; ++g) { e_c[g] = *(const f32x4_t*)(rope_t + 16 + 8 * g + 4 * hi); e_s[g] = *(const f32x4_t*)(rope_t + 32 + 8 * g + 4 * hi); }
            gemm_mainloop<ShQb, 7u>(A.cq16 + (long)m0 * 256, 256, A.wt_uq + (long)nt * 192 * 256, 256, 256, lds, acc, tid);
            const float rc = rsqrtf((e_q0 + e_q1 + e_q2 + e_q3) * (1.f / 256.f) + EPS);
            float ss = 0.f;
#pragma unroll
            for (int ni = 0; ni < 3; ++ni)
#pragma unroll
                for (int r = 0; r < 16; ++r) { acc[0][ni][r] *= rc; ss += acc[0][ni][r] * acc[0][ni][r]; }
            ss = pair_sum(ss);
            const float rq = rsqrtf(ss * (1.f / 96.f) + EPS);
#pragma unroll
            for (int ni = 0; ni < 3; ++ni)
#pragma unroll
                for (int g = 0; g < 4; ++g) {
                    const float4 gg = *(const float4*)(A.q_gain + ni * 32 + 8 * g + 4 * hi);
                    acc[0][ni][4 * g] *= rq * gg.x; acc[0][ni][4 * g + 1] *= rq * gg.y; acc[0][ni][4 * g + 2] *= rq * gg.z; acc[0][ni][4 * g + 3] *= rq * gg.w;
                }
#pragma unroll
            for (int g = 0; g < 2; ++g) {
                const f32x4_t c4 = e_c[g], s4 = e_s[g];
                const float cc[4] = {c4.x, c4.y, c4.z, c4.w}, sn[4] = {s4.x, s4.y, s4.z, s4.w};
#pragma unroll
                for (int j = 0; j < 4; ++j) { const float x1 = acc[0][2][4 * g + j], x2 = acc[0][2][8 + 4 * g + j]; acc[0][2][4 * g + j] = x1 * cc[j] - x2 * sn[j]; acc[0][2][8 + 4 * g + j] = x2 * cc[j] + x1 * sn[j]; }
            }
            unsigned short* qrow = A.q16 + tok * 768 + head * 96;
#pragma unroll
            for (int ni = 0; ni < 3; ++ni)
#pragma unroll
                for (int g = 0; g < 4; ++g) {
                    uint2 pk; pk.x = cvtpk(acc[0][ni][4 * g] * MLA_QSCALE, acc[0][ni][4 * g + 1] * MLA_QSCALE); pk.y = cvtpk(acc[0][ni][4 * g + 2] * MLA_QSCALE, acc[0][ni][4 * g + 3] * MLA_QSCALE);
                    *(uint2*)(qrow + ni * 32 + 8 * g + 4 * hi) = pk;
                }
        }
    }
}
__device__ __forceinline__ void p3_cmp2(unsigned char* lds, const float* __restrict__ hid, const float* __restrict__ cbias, const unsigned short* __restrict__ w2t_k, const unsigned short* __restrict__ w2t_v,
                                        const float* __restrict__ kc_gain, const float* __restrict__ rope, unsigned short* __restrict__ kc16, unsigned short* __restrict__ vct16) {
    if (blockIdx.x >= 128) return;
    const int tid = tid_(); const int lane = tid & 63, w = __builtin_amdgcn_readfirstlane(tid >> 6), r32 = lane & 31, hi = lane >> 5;
    const int task = blockIdx.x; const int mat = task >> 6, rt = task & 63; const long row = rt * 32 + r32;
    const unsigned short* w2t = mat ? w2t_v : w2t_k;
    f32x16 acc[2];
#pragma unroll
    for (int r = 0; r < 16; ++r) { acc[0][r] = 0.f; acc[1][r] = 0.f; }
    f32x4_t hv[2][10]; bf16x8 wf[2][2];
#pragma unroll
    for (int s = 0; s < 2; ++s) {
        const int k0 = (w * 2 + s) * 16 + hi * 8;
        hv[s][0] = *(const f32x4_t*)(cbias + mat * 256 + k0); hv[s][1] = *(const f32x4_t*)(cbias + mat * 256 + k0 + 4);
#pragma unroll
        for (int sp = 0; sp < 4; ++sp) {
            const float* hp = hid + ((long)(mat * 4 + sp) * 2048 + row) * 256 + k0;
            hv[s][2 + 2 * sp] = *(const f32x4_t*)hp; hv[s][3 + 2 * sp] = *(const f32x4_t*)(hp + 4);
        }
        wf[s][0] = *(const bf16x8*)(w2t + (long)r32 * 256 + k0); wf[s][1] = *(const bf16x8*)(w2t + (long)(32 + r32) * 256 + k0);
    }
#pragma unroll
    for (int s = 0; s < 2; ++s) {
        f32x4_t lo = hv[s][0], up = hv[s][1];
#pragma unroll
        for (int sp = 0; sp < 4; ++sp) { lo += hv[s][2 + 2 * sp]; up += hv[s][3 + 2 * sp]; }
        uint4 pk; pk.x = cvtpk(gelu_tanh(lo.x), gelu_tanh(lo.y)); pk.y = cvtpk(gelu_tanh(lo.z), gelu_tanh(lo.w)); pk.z = cvtpk(gelu_tanh(up.x), gelu_tanh(up.y)); pk.w = cvtpk(gelu_tanh(up.z), gelu_tanh(up.w));
        const bf16x8 hf = __builtin_bit_cast(bf16x8, pk);
        acc[0] = MFMA32(wf[s][0], hf, acc[0]); acc[1] = MFMA32(wf[s][1], hf, acc[1]);
    }
    f32x4_t* red = (f32x4_t*)lds;
#pragma unroll
    for (int q = 0; q < 8; ++q) red[(w * 8 + q) * 64 + lane] = f32x4_t{acc[q >> 2][4 * (q & 3)], acc[q >> 2][4 * (q & 3) + 1], acc[q >> 2][4 * (q & 3) + 2], acc[q >> 2][4 * (q & 3) + 3]};
    __syncthreads();
    if (w != 0) return;
#pragma unroll
    for (int q = 0; q < 8; ++q) {
        f32x4_t s = red[q * 64 + lane];
#pragma unroll
        for (int ww = 1; ww < 8; ++ww) s += red[(ww * 8 + q) * 64 + lane];
        acc[q >> 2][4 * (q & 3)] = s.x; acc[q >> 2][4 * (q & 3) + 1] = s.y; acc[q >> 2][4 * (q & 3) + 2] = s.z; acc[q >> 2][4 * (q & 3) + 3] = s.w;
    }
    const int bg = (int)(row >> 9), n = (int)(row & 511); const bool valid = n < NCMP;
    if (mat == 0) {
        if (valid) {
            const long tokp = (long)(bg >> 1) * S_ + 16 * n + 31;
            norm_rope64(acc[0], acc[1], kc_gain, rope + tokp * 48, hi, 1.f);
        } else {
#pragma unroll
            for (int r = 0; r < 16; ++r) { acc[0][r] = 0.f; acc[1][r] = 0.f; }
        }
        store_row64(kc16 + row * 64, acc[0], acc[1], hi);
    } else {
#pragma unroll
        for (int ni = 0; ni < 2; ++ni)
#pragma unroll
            for (int r = 0; r < 16; ++r) {
                const float v = valid ? acc[ni][r] : 0.f;
                const float other = __uint_as_float(__builtin_amdgcn_mov_dpp(__float_as_uint(v), 0xB1, 0xF, 0xF, true));
                if ((lane & 1) == 0) *(unsigned*)(vct16 + ((long)bg * 64 + ni * 32 + crow(r, hi)) * 512 + vperm(n)) = cvtpk(v, other);
            }
    }
}

__device__ __forceinline__ void cvt_stream(const float* __restrict__ in, unsigned short* __restrict__ out, long n, int vb = blockIdx.x, int nb = NBLK) {
    const long nchunk = n >> 3;
    const int tid = tid_();
    for (long c = (long)vb * 512 + tid; c < nchunk; c += (long)nb * 512) {
        const float4 a = ((const float4*)in)[2 * c], b = ((const float4*)in)[2 * c + 1];
        uint4 o; o.x = cvtpk(a.x, a.y); o.y = cvtpk(a.z, a.w); o.z = cvtpk(b.x, b.y); o.w = cvtpk(b.z, b.w);
        ((uint4*)out)[c] = o;
    }
}


typedef unsigned u32x3 __attribute__((ext_vector_type(3)));
typedef unsigned u32x6 __attribute__((ext_vector_type(6)));
typedef float f32x32 __attribute__((ext_vector_type(32)));
constexpr int PROW = 768;
constexpr int PU_SPLIT = 12288;
template <int NR>
__device__ __forceinline__ void cvt_rows_fp6(const float* __restrict__ in, unsigned char* __restrict__ out6, float* __restrict__ scale, int rows, int vb = blockIdx.x, int nb = NBLK) {
    const int tid = tid_(); const int lane = tid & 63, w = __builtin_amdgcn_readfirstlane(tid >> 6);
    const int stride = nb * 8;
    for (int r0 = vb * 8 + w; r0 < rows; r0 += NR * stride) {
        f32x4_t v[NR][4];
#pragma unroll
        for (int j = 0; j < NR; ++j) {
            const int r = min(r0 + j * stride, rows - 1);
            const f32x4_t* p = (const f32x4_t*)(in + (long)r * 1024 + lane * 16);
#pragma unroll
            for (int i = 0; i < 4; ++i) v[j][i] = p[i];
        }
#pragma unroll
        for (int j = 0; j < NR; ++j) {
            const int r = r0 + j * stride;
            if (r < rows) {
                float m = 0.f;
#pragma unroll
                for (int i = 0; i < 4; ++i) m = fmaxf(m, fmaxf(fmaxf(fabsf(v[j][i].x), fabsf(v[j][i].y)), fmaxf(fabsf(v[j][i].z), fabsf(v[j][i].w))));
                m = wmax(m);
                const float q = (m > 0.f) ? 7.5f / m : 1.f;
                const f32x16 ve = {v[j][0].x * q, v[j][0].z * q, v[j][1].x * q, v[j][1].z * q, v[j][2].x * q, v[j][2].z * q, v[j][3].x * q, v[j][3].z * q, 0.f, 0.f, 0.f, 0.f, 0.f, 0.f, 0.f, 0.f};
                const f32x16 vo = {v[j][0].y * q, v[j][0].w * q, v[j][1].y * q, v[j][1].w * q, v[j][2].y * q, v[j][2].w * q, v[j][3].y * q, v[j][3].w * q, 0.f, 0.f, 0.f, 0.f, 0.f, 0.f, 0.f, 0.f};
                const u32x6 pk = __builtin_amdgcn_cvt_scalef32_2xpk16_fp6_f32(ve, vo, 1.0f);
                *(u32x3*)(out6 + (long)r * PROW + lane * 12) = u32x3{pk[0], pk[1], pk[2]};
                if (lane == 0) scale[r] = (m > 0.f) ? m * (1.f / 7.5f) : 1.f;
            }
        }
    }
}
__device__ __forceinline__ f32x32 dec2_fp6(const u32x3& r0, const u32x3& r1) {
    const u32x6 pk = {r0.x, r0.y, r0.z, r1.x, r1.y, r1.z};
    return __builtin_amdgcn_cvt_scalef32_pk32_f32_fp6(pk, 1.0f);
}
__device__ __forceinline__ void peer_sweep_a(const float* __restrict__ hss, const float* __restrict__ g2, const int* __restrict__ eo, const float* __restrict__ go,
                                             const unsigned char* __restrict__ U6, const float* __restrict__ su, const float* __restrict__ sv, const float* __restrict__ h, float* __restrict__ wout) {
    const int tid = tid_(); const int lane = tid & 63, w = __builtin_amdgcn_readfirstlane(tid >> 6);
    const int kcls = ((lane >> 5) & 1) * 4 + ((lane >> 4) & 1) * 2 + ((lane >> 3) & 1);
    for (int t = blockIdx.x * 8 + w; t < T_; t += NBLK * 8) {
        float x[16];
        {
            const float4* xp = (const float4*)(h + (long)t * 1024 + lane * 16); const float4* gp = (const float4*)(g2 + lane * 16); const float4* hp = (const float4*)(hss + (long)t * 16);
            const float4 s0 = hp[0], s1 = hp[1], s2 = hp[2], s3 = hp[3];
            const float rs = rsqrtf((s0.x + s0.y + s0.z + s0.w + s1.x + s1.y + s1.z + s1.w + s2.x + s2.y + s2.z + s2.w + s3.x + s3.y + s3.z + s3.w) * (1.f / 1024.f) + EPS);
#pragma unroll
            for (int k = 0; k < 4; ++k) { const float4 hv = xp[k], gv = gp[k]; x[4 * k] = hv.x * rs * gv.x; x[4 * k + 1] = hv.y * rs * gv.y; x[4 * k + 2] = hv.z * rs * gv.z; x[4 * k + 3] = hv.w * rs * gv.w; }
        }
        const int elo = eo[(long)t * 128 + lane], ehi = eo[(long)t * 128 + 64 + lane];
        const float glo = go[(long)t * 128 + lane], ghi = go[(long)t * 128 + 64 + lane];
        for (int bt = 0; bt < 16; ++bt) {
            int e[8];
#pragma unroll
            for (int k = 0; k < 8; ++k) e[k] = __builtin_amdgcn_readlane(bt < 8 ? elo : ehi, (bt * 8 + k) & 63);
            u32x3 u[8];
#pragma unroll
            for (int k = 0; k < 8; ++k) u[k] = *(const u32x3*)(U6 + (long)e[k] * PROW + lane * 12);
            const int emine = __shfl(bt < 8 ? elo : ehi, (bt * 8 + kcls) & 63);
            const float sum = su[emine], svm = sv[emine];
            const float gk = __shfl(bt < 8 ? glo : ghi, (bt * 8 + kcls) & 63);
            float a[8];
#pragma unroll
            for (int k = 0; k < 8; k += 2) {
                const f32x32 d = dec2_fp6(u[k], u[k + 1]);
                float s0 = 0.f, s1 = 0.f;
#pragma unroll
                for (int i = 0; i < 16; ++i) { s0 = fmaf(d[i], x[i], s0); s1 = fmaf(d[16 + i], x[i], s1); }
                a[k] = s0; a[k + 1] = s1;
            }
            float b4[4], c2[2], d1;
#pragma unroll
            for (int i = 0; i < 4; ++i) {
                auto rr = __builtin_amdgcn_permlane32_swap(__float_as_uint(a[i]), __float_as_uint(a[i + 4]), false, false);
                b4[i] = __uint_as_float(rr[0]) + __uint_as_float(rr[1]);
            }
#pragma unroll
            for (int i = 0; i < 2; ++i) {
                auto rr = __builtin_amdgcn_permlane16_swap(__float_as_uint(b4[i]), __float_as_uint(b4[i + 2]), false, false);
                c2[i] = __uint_as_float(rr[0]) + __uint_as_float(rr[1]);
            }
            { const bool up = (lane & 8) != 0; const float keep = up ? c2[1] : c2[0], send = up ? c2[0] : c2[1];
              d1 = keep + __uint_as_float(__builtin_amdgcn_mov_dpp(__float_as_uint(send), 0x128, 0xF, 0xF, true)); }
            d1 = quad_sum(d1);
            d1 += __uint_as_float(__builtin_amdgcn_mov_dpp(__float_as_uint(d1), 0x141, 0xF, 0xF, true));
            const float wl = gk * gelu_tanh(d1 * sum) * svm;
            if ((lane & 7) == 0) wout[(long)t * 128 + bt * 8 + kcls] = wl;
        }
    }
}
__device__ __forceinline__ void peer_sweep_b(const int* __restrict__ eo, const float* __restrict__ win, const unsigned char* __restrict__ V6, float* out) {
    const int tid = tid_(); const int lane = tid & 63, w = __builtin_amdgcn_readfirstlane(tid >> 6);
    for (int t = blockIdx.x * 8 + w; t < T_; t += NBLK * 8) {
        float y[16];
#pragma unroll
        for (int i = 0; i < 16; ++i) y[i] = 0.f;
        const int elo = eo[(long)t * 128 + lane], ehi = eo[(long)t * 128 + 64 + lane];
        const float wlo = win[(long)t * 128 + lane], whi = win[(long)t * 128 + 64 + lane];
        for (int bt = 0; bt < 16; ++bt) {
            int e[8]; float wk[8];
#pragma unroll
            for (int k = 0; k < 8; ++k) {
                e[k] = __builtin_amdgcn_readlane(bt < 8 ? elo : ehi, (bt * 8 + k) & 63);
                wk[k] = __uint_as_float(__builtin_amdgcn_readlane(__float_as_uint(bt < 8 ? wlo : whi), (bt * 8 + k) & 63));
            }
            u32x3 v[8];
#pragma unroll
            for (int k = 0; k < 8; ++k) v[k] = *(const u32x3*)(V6 + (long)e[k] * PROW + lane * 12);
#pragma unroll
            for (int k = 0; k < 8; k += 2) {
                const f32x32 d = dec2_fp6(v[k], v[k + 1]);
#pragma unroll
                for (int i = 0; i < 16; ++i) y[i] = fmaf(wk[k + 1], d[16 + i], fmaf(wk[k], d[i], y[i]));
            }
        }
        float4* o = (float4*)(out + (long)t * 1024 + lane * 16);
#pragma unroll
        for (int k = 0; k < 4; ++k) { float4 hv = o[k]; hv.x += y[4 * k]; hv.y += y[4 * k + 1]; hv.z += y[4 * k + 2]; hv.w += y[4 * k + 3]; o[k] = hv; }
    }
}

struct Params {
    const float* x; const int* positions; const float* norm1_gain; const float* w_in;
    const float *nsa_q_gain, *nsa_kc_gain, *nsa_ks_gain, *nsa_kw_gain, *cmp_pos, *cmp_k_w1, *cmp_k_w2, *cmp_v_w1, *cmp_v_w2;
    const float *mla_q_lora_gain, *mla_w_uq, *mla_kv_lora_gain, *mla_w_ukv, *mla_q_gain, *mla_k_gain, *out_gain_a, *out_gain_b, *w_out;
    const float *norm2_gain, *peer_w_q, *peer_sub_keys, *peer_u, *peer_v;
    float* out; float* W; unsigned* bar;
};
constexpr int LDS_BYTES = 64 + 256 * 528;
static_assert(LDS_BYTES >= 8 * 3200 * 4 + 64, "naive NSA phase needs 102,464 B");

typedef __attribute__((address_space(4))) const Params* cparams_t;
__device__ __forceinline__ cparams_t params_ptr() {
    cparams_t pp = (cparams_t)__builtin_amdgcn_kernarg_segment_ptr();
    asm volatile("" : "+s"(pp));
    return pp;
}
constexpr long M1 = 1 << 20;
constexpr long F_U8 = 0, F_V8 = 4 * M1, F_SU = 21 * M1 + 3 * M1 / 8, F_SV = F_SU + 16384,
               F_WTIN = 16 * M1, F_WTUQ = 17 * M1, F_WTUKV = 17 * M1 + M1 / 8, F_W1TK = 17 * M1 + M1 / 4, F_W1TV = 17 * M1 + M1 / 2, F_W2TK = 17 * M1 + 3 * M1 / 4,
               F_W2TV = F_W2TK + 8192, F_CBIAS = F_W2TV + 8192, F_WTOUT = 18 * M1, F_WTQ = 18 * M1 + M1 / 2, F_SK16 = 19 * M1 + M1 / 2,
               F_SSQCQ = 19 * M1 + 5 * M1 / 8, F_SSQCKV = F_SSQCQ + 4 * 16384, F_SSQKR = F_SSQCKV + 2 * 16384, F_SSQA = 19 * M1 + 3 * M1 / 4, F_SSQB = F_SSQA + 8 * 16384,
               F_ROPE = 20 * M1, F_GATES = 21 * M1, F_KRR = 21 * M1 + M1 / 2,
               F_XN16 = 22 * M1, F_MIX = 22 * M1,
               F_Q16A = 30 * M1, F_KS16 = 34 * M1, F_KW16 = 35 * M1, F_VST16 = 36 * M1, F_VWT16 = 37 * M1, F_KCMP16 = 38 * M1, F_VCMP16 = 39 * M1 + M1 / 8,
               F_CQ16 = 40 * M1 + M1 / 4, F_CKV16 = 42 * M1 + M1 / 4,
               F_Q16 = 43 * M1 + M1 / 2, F_K16 = 49 * M1 + M1 / 2, F_VT16 = 55 * M1 + M1 / 2, F_HID = 59 * M1 + M1 / 2, F_KC16 = 63 * M1 + M1 / 2, F_VCT16 = F_KC16 + M1 / 8,
               F_HB = 30 * M1, F_HSS = 38 * M1, F_PSS = 38 * M1 + M1 / 2, F_EO = 39 * M1, F_GO = 41 * M1, F_PQB = 43 * M1 + M1 / 2;
static_assert(F_SSQKR + 16384 <= F_SSQA && F_SSQB + 8 * 16384 <= F_ROPE && F_VCT16 + M1 / 8 <= 64 * M1 - 16384 && F_CKV16 + M1 <= F_Q16 && F_PQB + 16 * M1 <= F_HID, "workspace map");

#define G(x) (x)
__global__ __launch_bounds__(512, 2) void mega(Params p_unused) {
    extern __shared__ __attribute__((aligned(16))) unsigned char lds_raw[];
    float* ldsf = (float*)(lds_raw + 64);
    { const unsigned bid_ = blockIdx.x; __builtin_assume(bid_ < (unsigned)NBLK); }
    if (threadIdx.x == 0) *(uint4*)lds_raw = make_uint4(0u, 0u, 0u, 0u);
    __syncthreads();
    XcdBarrier bar = xcd_barrier_post(params_ptr()->bar, (volatile LAS unsigned*)lds_raw);
#define GRID_SYNC() xcd_barrier(bar)
#define U16P(off) ((unsigned short*)(W + (off)))
    { cparams_t p = params_ptr(); float* W = p->W;
      p0_xn_rope(p->x, p->norm1_gain, p->positions, U16P(F_XN16), W + F_ROPE); }
    { cparams_t p = params_ptr(); float* W = p->W;
#define P0_XT(j) ({ const int v_ = (int)blockIdx.x + NBLK * (j); \
        (v_ < 432) ? xt_make(p->w_in, 1024, INW, U16P(F_WTIN), nullptr, nullptr, 0, 2, v_) : \
        (v_ < 480) ? xt_make(p->mla_w_uq, 256, 768, U16P(F_WTUQ), p->mla_q_lora_gain, p->mla_q_lora_gain, 1 << 30, 0, v_ - 432) : \
        (v_ < 512) ? xt_make(p->mla_w_ukv, 128, 1024, U16P(F_WTUKV), p->mla_kv_lora_gain, p->mla_kv_lora_gain, 1 << 30, 0, v_ - 480) : \
        (v_ < 640) ? xt_make(p->cmp_k_w1, 2048, 256, U16P(F_W1TK), nullptr, nullptr, 0, 0, v_ - 512) : \
        (v_ < 768) ? xt_make(p->cmp_v_w1, 2048, 256, U16P(F_W1TV), nullptr, nullptr, 0, 0, v_ - 640) : \
        (v_ < 772) ? xt_make(p->cmp_k_w2, 256, 64, U16P(F_W2TK), nullptr, nullptr, 0, 0, v_ - 768) : \
        (v_ < 776) ? xt_make(p->cmp_v_w2, 256, 64, U16P(F_W2TV), nullptr, nullptr, 0, 0, v_ - 772) : xt_make(nullptr, 64, 64, nullptr, nullptr, nullptr, 0, 0, -1); })
      XT_RUN4(ldsf, P0_XT);
      zero_stream(U16P(F_WTIN) + (long)1720 * 1024, (long)72 * 1024); }
    { cparams_t p = params_ptr(); float* W = p->W;
      p0_cbias(p->cmp_pos, p->cmp_k_w1, p->cmp_v_w1, W + F_CBIAS); }
    GRID_SYNC();
    { cparams_t p = params_ptr(); float* W = p->W;
      P1Out O; O.q16a = U16P(F_Q16A); O.ks16 = U16P(F_KS16); O.kw16 = U16P(F_KW16); O.vst16 = U16P(F_VST16); O.vwt16 = U16P(F_VWT16); O.kcmp16 = U16P(F_KCMP16); O.vcmp16 = U16P(F_VCMP16);
      O.cq16 = U16P(F_CQ16); O.ckv16 = U16P(F_CKV16); O.krr = W + F_KRR; O.ssq_kr = W + F_SSQKR; O.ssq_cq = W + F_SSQCQ; O.ssq_ckv = W + F_SSQCKV; O.gates = W + F_GATES;
      O.rope = W + F_ROPE; O.q_gain = p->nsa_q_gain; O.ks_gain = p->nsa_ks_gain; O.kw_gain = p->nsa_kw_gain; O.k_gain = p->mla_k_gain;
      p1_inproj_256(lds_raw + 64, U16P(F_XN16), U16P(F_WTIN), O); }
    if ((blockIdx.x >> 3) >= 24) {
      cparams_t p = params_ptr(); float* W = p->W;
      cvt_rows_fp6<8>(p->peer_u, (unsigned char*)(W + F_U8), W + F_SU, PU_SPLIT, (int)(blockIdx.x & 7) * 8 + (int)(blockIdx.x >> 3) - 24, 64); }
    GRID_SYNC();
    { cparams_t p = params_ptr(); float* W = p->W;
      P2Args A; A.cq16 = U16P(F_CQ16); A.ckv16 = U16P(F_CKV16); A.wt_uq = U16P(F_WTUQ); A.wt_ukv = U16P(F_WTUKV); A.kcmp16 = U16P(F_KCMP16); A.vcmp16 = U16P(F_VCMP16); A.w1t_k = U16P(F_W1TK); A.w1t_v = U16P(F_W1TV);
      A.ssq_cq = W + F_SSQCQ; A.ssq_ckv = W + F_SSQCKV; A.ssq_kr = W + F_SSQKR; A.krr = W + F_KRR; A.rope = W + F_ROPE; A.q_gain = p->mla_q_gain; A.k_gain = p->mla_k_gain;
      A.q16 = U16P(F_Q16); A.k16 = U16P(F_K16); A.vt16 = U16P(F_VT16); A.hid = W + F_HID;
      p2_phase(lds_raw + 64, A); }
    GRID_SYNC();
    { const int vb = blockIdx.x, nb = NBLK;
      { cparams_t p = params_ptr(); float* W = p->W;
#define P3_XT(j) ({ const int v_ = vb + nb * (j); \
          (v_ < 256) ? xt_make(p->w_out, 1024, 1024, U16P(F_WTOUT), p->out_gain_a, p->out_gain_b, 512, 0, v_) : \
          (v_ < 768) ? xt_make(p->peer_w_q, 1024, 2048, U16P(F_WTQ), p->norm2_gain, p->norm2_gain, 1 << 30, 0, v_ - 256) : xt_make(nullptr, 64, 64, nullptr, nullptr, nullptr, 0, 0, -1); })
        XT_RUN4(ldsf, P3_XT); }
      { cparams_t p = params_ptr(); float* W = p->W;
        p3_cmp2(lds_raw + 64 + 36864, W + F_HID, W + F_CBIAS, U16P(F_W2TK), U16P(F_W2TV), p->nsa_kc_gain, W + F_ROPE, U16P(F_KC16), U16P(F_VCT16)); }
      { cparams_t p = params_ptr(); float* W = p->W;
        cvt_stream(p->peer_sub_keys, U16P(F_SK16), (long)8 * 2 * 128 * 128, vb, nb);
        cvt_rows_fp6<4>(p->peer_v, (unsigned char*)(W + F_V8), W + F_SV, 16384, vb, nb);
        cvt_rows_fp6<2>(p->peer_u + (long)PU_SPLIT * 1024, (unsigned char*)(W + F_U8) + (long)PU_SPLIT * PROW, W + F_SU + PU_SPLIT, 16384 - PU_SPLIT, vb, nb); }
    }
    GRID_SYNC();
    { cparams_t p = params_ptr(); float* W = p->W;
      nsa_phase(lds_raw + 64, U16P(F_Q16A), U16P(F_KC16), U16P(F_VCT16), U16P(F_KS16), U16P(F_VST16), U16P(F_KW16), U16P(F_VWT16), W + F_GATES, U16P(F_MIX), W + F_SSQA); }
    { cparams_t p = params_ptr(); float* W = p->W;
      mla_phase(lds_raw + 64, U16P(F_Q16), U16P(F_K16), U16P(F_VT16), U16P(F_MIX), W + F_SSQB); }
    GRID_SYNC();
    { cparams_t p = params_ptr(); float* W = p->W;
      p5_outproj_256(lds_raw + 64, U16P(F_MIX), U16P(F_WTOUT), W + F_SSQA, W + F_SSQB, p->x, p->out, U16P(F_HB), W + F_HSS); }
    GRID_SYNC();
    { cparams_t p = params_ptr(); float* W = p->W;
      p6_peerq_256(lds_raw + 64, U16P(F_HB), U16P(F_WTQ), W + F_HSS, U16P(F_PQB), W + F_PSS); }
    GRID_SYNC();
    { cparams_t p = params_ptr(); float* W = p->W;
      peer_route_mfma(lds_raw + 64, U16P(F_PQB), W + F_PSS, U16P(F_SK16), (int*)(W + F_EO), W + F_GO); }
    GRID_SYNC();
    { cparams_t p = params_ptr(); float* W = p->W;
      peer_sweep_a(W + F_HSS, p->norm2_gain, (const int*)(W + F_EO), W + F_GO, (const unsigned char*)(W + F_U8), W + F_SU, W + F_SV, p->out, W + F_PQB); }
    GRID_SYNC();
    { cparams_t p = params_ptr(); float* W = p->W;
      peer_sweep_b((const int*)(W + F_EO), W + F_PQB, (const unsigned char*)(W + F_V8), p->out); }
}

extern "C" void kernel_launch(void* const* d_in, const int* in_sizes, int n_in, void* d_out, int out_size, void* d_ws, size_t ws_size, hipStream_t stream) {
    (void)ws_size; (void)in_sizes; (void)n_in; (void)out_size;
    static int grid = 0;
    if (grid == 0) {
        int dev = 0, cus = 0, per_cu = 0;
        (void)hipGetDevice(&dev);
        (void)hipDeviceGetAttribute(&cus, hipDeviceAttributeMultiprocessorCount, dev);
        (void)hipFuncSetAttribute((const void*)mega, hipFuncAttributeMaxDynamicSharedMemorySize, LDS_BYTES);
        (void)hipOccupancyMaxActiveBlocksPerMultiprocessor(&per_cu, (const void*)mega, 512, LDS_BYTES);
        (void)hipGetLastError();
        if (per_cu < 1) fprintf(stderr, "kernel_launch: occupancy query reports %d blocks per CU\n", per_cu);
        if (cus != NBLK) fprintf(stderr, "kernel_launch: built for %d CUs, device reports %d\n", NBLK, cus);
        grid = NBLK;
    }
    Params p{};
    p.x = (const float*)d_in[0]; p.positions = (const int*)d_in[1]; p.norm1_gain = (const float*)d_in[2]; p.w_in = (const float*)d_in[3];
    p.nsa_q_gain = (const float*)d_in[4]; p.nsa_kc_gain = (const float*)d_in[5]; p.nsa_ks_gain = (const float*)d_in[6]; p.nsa_kw_gain = (const float*)d_in[7];
    p.cmp_pos = (const float*)d_in[8]; p.cmp_k_w1 = (const float*)d_in[9]; p.cmp_k_w2 = (const float*)d_in[10]; p.cmp_v_w1 = (const float*)d_in[11]; p.cmp_v_w2 = (const float*)d_in[12];
    p.mla_q_lora_gain = (const float*)d_in[13]; p.mla_w_uq = (const float*)d_in[14]; p.mla_kv_lora_gain = (const float*)d_in[15]; p.mla_w_ukv = (const float*)d_in[16];
    p.mla_q_gain = (const float*)d_in[17]; p.mla_k_gain = (const float*)d_in[18]; p.out_gain_a = (const float*)d_in[19]; p.out_gain_b = (const float*)d_in[20]; p.w_out = (const float*)d_in[21];
    p.norm2_gain = (const float*)d_in[22]; p.peer_w_q = (const float*)d_in[23]; p.peer_sub_keys = (const float*)d_in[24]; p.peer_u = (const float*)d_in[25]; p.peer_v = (const float*)d_in[26];
    p.out = (float*)d_out;
    p.bar = (unsigned*)d_ws;
    p.W = (float*)d_ws + 16384;
    (void)hipMemsetAsync(d_ws, 0, XCD_BAR_WORDS * sizeof(unsigned), stream);
    hipLaunchKernelGGL(mega, dim3(grid), dim3(512), LDS_BYTES, stream, p);
}
```

```cpp
#include <hip/hip_runtime.h>
#include <cmath>
#include <cstdint>
#include <cstdio>

#define XB_TMO      128
#define XB_XCNT(j)  (256  + 64 * (j))
#define XB_XSUB(j)  (1280 + 64 * (j))
#define XB_XGEN(j)  (2304 + 64 * (j))
#define XB_TOP      3328
#define XB_TOPGEN   3392
#define XCD_BAR_WORDS 3456
#define XB_SPIN_CAP (1u << 18)
#define LAS __attribute__((address_space(3)))

__device__ __forceinline__ unsigned xb_ld(unsigned* p)              { return __hip_atomic_load(p, __ATOMIC_RELAXED, __HIP_MEMORY_SCOPE_AGENT); }
__device__ __forceinline__ unsigned xb_add(unsigned* p, unsigned v) { return __hip_atomic_fetch_add(p, v, __ATOMIC_RELAXED, __HIP_MEMORY_SCOPE_AGENT); }
__device__ __forceinline__ unsigned xb_xcc_id() { return (unsigned)__builtin_amdgcn_s_getreg((3 << 11) | 20) & 0xFu; }
#define XB_SPIN(cond, bar) do { unsigned _sp = 0; while (cond) { __builtin_amdgcn_s_sleep(1); \
    if ((++_sp & 255u) == 0u) { if (xb_ld(&(bar)[XB_TMO])) break; if (_sp > XB_SPIN_CAP) { atomicAdd(&(bar)[XB_TMO], 1u); break; } } } } while (0)

struct XcdBarrier {
    unsigned* bar; unsigned x;
    volatile LAS unsigned* st;
};

__device__ __forceinline__ XcdBarrier xcd_barrier_post(unsigned* bar, volatile LAS unsigned* st) {
    XcdBarrier b; b.bar = bar; b.x = xb_xcc_id(); b.st = st;
    if (threadIdx.x == 0) (void)xb_add(&bar[XB_XCNT(b.x)], 1u);
    return b;
}
__device__ __forceinline__ void xcd_barrier_complete(unsigned* bar, unsigned x, unsigned& nloc, unsigned& nx) {
    const unsigned G = gridDim.x * gridDim.y * gridDim.z;
    unsigned sum, cnt, mine, sp = 0u;
    for (;;) {
        sum = 0u; cnt = 0u; mine = 0u;
#pragma unroll
        for (unsigned j = 0; j < 16; ++j) { const unsigned c = xb_ld(&bar[XB_XCNT(j)]); sum += c; cnt += (c > 0u) ? 1u : 0u; mine = (j == x) ? c : mine; }
        if (sum == G) break;
        __builtin_amdgcn_s_sleep(1);
        if ((++sp & 255u) == 0u) { if (xb_ld(&bar[XB_TMO])) break; if (sp > XB_SPIN_CAP) { atomicAdd(&bar[XB_TMO], 1u); break; } }
    }
    nloc = mine > 0u ? mine : 1u; nx = cnt > 0u ? cnt : 1u;
}

__device__ __forceinline__ void xcd_barrier(const XcdBarrier& b) {
    asm volatile("s_waitcnt vmcnt(0)" ::: "memory");
    __syncthreads();
    if (threadIdx.x == 0) {
        unsigned* bar = b.bar;
        __builtin_amdgcn_s_waitcnt(0);
        unsigned nloc = b.st[0], nx = b.st[1];
        if (nloc == 0u) { xcd_barrier_complete(bar, b.x, nloc, nx); b.st[0] = nloc; b.st[1] = nx; }
        const unsigned old = xb_add(&bar[XB_XSUB(b.x)], 1u);
        const unsigned gen = old / nloc;
        if (old + 1u == (gen + 1u) * nloc) {
            __builtin_amdgcn_fence(__ATOMIC_RELEASE, "agent");
            asm volatile("s_waitcnt vmcnt(0)" ::: "memory");
            const unsigned og = xb_add(&bar[XB_TOP], 1u);
            const unsigned tg = og / nx;
            if (og + 1u == (tg + 1u) * nx) xb_add(&bar[XB_TOPGEN], 1u);
            else XB_SPIN(xb_ld(&bar[XB_TOPGEN]) == tg, bar);
            __builtin_amdgcn_fence(__ATOMIC_ACQUIRE, "agent");
            xb_add(&bar[XB_XGEN(b.x)], 1u);
            asm volatile("s_waitcnt vmcnt(0)" ::: "memory");
        } else {
            XB_SPIN(xb_ld(&bar[XB_XGEN(b.x)]) == gen, bar);
            __builtin_amdgcn_fence(__ATOMIC_ACQUIRE, "agent");
            asm volatile("s_waitcnt vmcnt(0)" ::: "memory");
        }
    }
    __syncthreads();
}


#define AS1 __attribute__((address_space(1)))
constexpr int NBLK = 256;
constexpr int B_ = 2, S_ = 8192, T_ = B_ * S_, D_ = 1024, INW = 1720;
constexpr int G_ = 2, NCMP = 511;
constexpr float EPS = 1e-6f;
constexpr int C_Q = 0, C_KC = 512, C_VC = 640, C_KS = 768, C_VS = 896, C_KW = 1024, C_VW = 1152, C_GATE = 1280, C_CQ = 1304, C_CKV = 1560, C_KR = 1688;

#define WSYNC() do { __builtin_amdgcn_wave_barrier(); asm volatile("s_waitcnt lgkmcnt(0)" ::: "memory"); __builtin_amdgcn_wave_barrier(); } while (0)

__device__ __forceinline__ int tid_() { int t = threadIdx.x; asm volatile("" : "+v"(t)); return t; }
template <class T> __device__ __forceinline__ T* as_global(T* p) { return (T*)(__attribute__((address_space(1))) T*)p; }
__device__ __forceinline__ float wsum(float v) {
#pragma unroll
    for (int o = 32; o > 0; o >>= 1) v += __shfl_xor(v, o);
    return v;
}
__device__ __forceinline__ float wmax(float v) {
#pragma unroll
    for (int o = 32; o > 0; o >>= 1) v = fmaxf(v, __shfl_xor(v, o));
    return v;
}
__device__ __forceinline__ float gelu_tanh(float x) {
    const float u = 0.7978845608028654f * (x + 0.044715f * x * x * x);
    return 0.5f * x * (1.f + tanhf(u));
}

__device__ const float ROPE_F16[8] = {1.000000000e+00f, 1.939227432e-01f, 3.760603070e-02f, 7.292664610e-03f, 1.414213562e-03f, 2.742481884e-04f, 5.318296098e-05f, 1.031338616e-05f};
__device__ const float ROPE_F32[16] = {1.000000000e+00f, 4.403665960e-01f, 1.939227432e-01f, 8.539710194e-02f, 3.760603070e-02f, 1.656043902e-02f, 7.292664610e-03f, 3.211445874e-03f,
                                       1.414213562e-03f, 6.227723788e-04f, 2.742481884e-04f, 1.207697351e-04f, 5.318296098e-05f, 2.341999971e-05f, 1.031338616e-05f, 4.541670478e-06f};

typedef __attribute__((ext_vector_type(8))) short bf16x8;
typedef __attribute__((ext_vector_type(16))) float f32x16;
typedef __attribute__((ext_vector_type(2))) __bf16 bf16x2_t;
__device__ __forceinline__ unsigned cvtpk(float lo, float hi) { unsigned r; asm("v_cvt_pk_bf16_f32 %0, %1, %2" : "=v"(r) : "v"(lo), "v"(hi)); return r; }
__device__ __forceinline__ float bflo(unsigned u) { return __uint_as_float(u << 16); }
__device__ __forceinline__ float bfhi(unsigned u) { return __uint_as_float(u & 0xffff0000u); }
__device__ __forceinline__ float dot2bf(unsigned a, unsigned b, float c) { return __builtin_amdgcn_fdot2_f32_bf16(__builtin_bit_cast(bf16x2_t, a), __builtin_bit_cast(bf16x2_t, b), c, false); }

__device__ __forceinline__ float pair_max(float x) { auto rr = __builtin_amdgcn_permlane32_swap(__float_as_uint(x), __float_as_uint(x), false, false); return fmaxf(__uint_as_float(rr[0]), __uint_as_float(rr[1])); }
__device__ __forceinline__ float pair_sum(float x) { auto rr = __builtin_amdgcn_permlane32_swap(__float_as_uint(x), __float_as_uint(x), false, false); return __uint_as_float(rr[0]) + __uint_as_float(rr[1]); }
typedef float f32x2_t __attribute__((ext_vector_type(2)));
__device__ __forceinline__ float max3f(float a, float b, float c) { float r; asm("v_max3_f32 %0, %1, %2, %3" : "=v"(r) : "v"(a), "v"(b), "v"(c)); return r; }
__device__ __forceinline__ float quad_sum(float x) {
    float y = x + __uint_as_float(__builtin_amdgcn_mov_dpp(__float_as_uint(x), 0xB1, 0xF, 0xF, true));
    return y + __uint_as_float(__builtin_amdgcn_mov_dpp(__float_as_uint(y), 0x4E, 0xF, 0xF, true));
}
#define MFMA32(a, b, c) __builtin_amdgcn_mfma_f32_32x32x16_bf16(a, b, c, 0, 0, 0)
typedef unsigned u32x4 __attribute__((ext_vector_type(4)));
constexpr int LDS_PITCH = 144;
__device__ __forceinline__ int crow(int r, int hi) { return (r & 3) + 8 * (r >> 2) + 4 * hi; }

template <int WM_, int WN_, int MI_, int NI_>
struct GemmShape {
    static constexpr int WM = WM_, WN = WN_, MI = MI_, NI = NI_;
    static constexpr int BM = WM * MI * 32, BN = WN * NI * 32, ROWS = BM + BN;
    static constexpr int CHUNKS = ROWS * 8 / 512;
    static constexpr int STAGE_BYTES = ROWS * LDS_PITCH;
    static_assert(WM * WN == 8 && (ROWS * 8) % 512 == 0, "8 waves; whole chunks per thread");
};
template <class SH, unsigned TOKMASK, int CUR>
__device__ __forceinline__ void gemm_step(unsigned char* lds, const unsigned short* const (&gp)[SH::CHUNKS], const int (&lo)[SH::CHUNKS], u32x4 (&g)[2][SH::CHUNKS],
                                          f32x16 (&acc)[SH::MI][SH::NI], int kt, int nk, int aoff, int boff) {
    const unsigned char* st = lds + (kt & 1) * SH::STAGE_BYTES;
    if (kt + 2 < nk) {
#pragma unroll
        for (int i = 0; i < SH::CHUNKS; ++i) g[CUR][i] = *(const u32x4*)(gp[i] + (long)(kt + 2) * 64);
    }
#pragma unroll
    for (int ks = 0; ks < 4; ++ks) {
        bf16x8 af[SH::MI], bfr[SH::NI];
#pragma unroll
        for (int mi = 0; mi < SH::MI; ++mi) af[mi] = *(const bf16x8*)(st + aoff + mi * 32 * LDS_PITCH + ks * 32);
#pragma unroll
        for (int ni = 0; ni < SH::NI; ++ni) bfr[ni] = *(const bf16x8*)(st + boff + ni * 32 * LDS_PITCH + ks * 32);
#pragma unroll
        for (int mi = 0; mi < SH::MI; ++mi)
#pragma unroll
            for (int ni = 0; ni < SH::NI; ++ni)
                acc[mi][ni] = ((TOKMASK >> ni) & 1u) ? MFMA32(bfr[ni], af[mi], acc[mi][ni]) : MFMA32(af[mi], bfr[ni], acc[mi][ni]);
    }
    if (kt + 1 < nk) {
        unsigned char* sn = lds + ((kt + 1) & 1) * SH::STAGE_BYTES;
#pragma unroll
        for (int i = 0; i < SH::CHUNKS; ++i) *(u32x4*)(sn + lo[i]) = g[CUR ^ 1][i];
    }
    __syncthreads();
}
template <class SH, unsigned TOKMASK>
__device__ __forceinline__ void gemm_mainloop(const unsigned short* __restrict__ A0, long lda, const unsigned short* __restrict__ B0, long ldb, int K,
                                              unsigned char* lds, f32x16 (&acc)[SH::MI][SH::NI], int tid) {
    const int lane = tid & 63, wave = __builtin_amdgcn_readfirstlane(tid >> 6), r32 = lane & 31, hi = lane >> 5;
    const int wm = wave / SH::WN, wn = wave % SH::WN;
    const unsigned short* gp[SH::CHUNKS]; int lo[SH::CHUNKS];
#pragma unroll
    for (int i = 0; i < SH::CHUNKS; ++i) {
        const int c = tid + i * 512, row = c >> 3, kc = c & 7;
        gp[i] = (row < SH::BM) ? (A0 + (long)row * lda + kc * 8) : (B0 + (long)(row - SH::BM) * ldb + kc * 8);
        lo[i] = row * LDS_PITCH + kc * 16;
    }
    u32x4 g[2][SH::CHUNKS];
    const int nk = K >> 6;
#pragma unroll
    for (int i = 0; i < SH::CHUNKS; ++i) { g[0][i] = *(const u32x4*)gp[i]; g[1][i] = *(const u32x4*)(gp[i] + 64); }
#pragma unroll
    for (int i = 0; i < SH::CHUNKS; ++i) *(u32x4*)(lds + lo[i]) = g[0][i];
    __syncthreads();
    const int aoff = (wm * SH::MI * 32 + r32) * LDS_PITCH + hi * 16;
    const int boff = (SH::BM + wn * SH::NI * 32 + r32) * LDS_PITCH + hi * 16;
    for (int kt = 0; kt < nk; kt += 2) {
        gemm_step<SH, TOKMASK, 0>(lds, gp, lo, g, acc, kt, nk, aoff, boff);
        gemm_step<SH, TOKMASK, 1>(lds, gp, lo, g, acc, kt + 1, nk, aoff, boff);
    }
}

typedef __attribute__((ext_vector_type(4))) float f32x4_t;
namespace g256 {
constexpr int BK = 64, HALF = 128, HT = HALF * BK;
__device__ __forceinline__ int lds_byte(int r, int c) { const int st = (r >> 4) * 2 + (c >> 5), rr = r & 15, cc = c & 31, ob = rr * 64 + cc * 2; return st * 1024 + (ob ^ (((ob >> 9) & 1) << 5)); }
__device__ __forceinline__ void stage_rc(int b, int& R, int& C) { const int st = b / 1024, sb = b % 1024, swz = sb ^ (((sb >> 9) & 1) << 5); R = (st >> 1) * 16 + swz / 64; C = (st & 1) * 32 + (swz % 64) / 2; }
template <int K, int PITCH = K>
__device__ __forceinline__ void mainloop(const unsigned short* __restrict__ A, const unsigned short* __restrict__ Bt, int brow, int bcol, unsigned short* shm, f32x4_t (&acc)[2][2][4][2]) {
#define SA(b, h) (shm + ((b) * 2 + (h)) * HT)
#define SB(b, h) (shm + (4 + (b) * 2 + (h)) * HT)
#define STAGE_X(T, P, BASE, br, kt) do { const AS1 char* ub_ = (const AS1 char*)(BASE) + ((long)(br) * PITCH + (long)(kt) * BK) * 2;     \
    for (int i_ = 0; i_ < 2; ++i_) { const int b_ = (T) * 16 + i_ * 8192; int r_, c_; stage_rc(b_, r_, c_); \
      __builtin_amdgcn_global_load_lds((const AS1 unsigned*)(ub_ + (unsigned)(r_ * PITCH + c_) * 2u), (LAS unsigned*)((LAS char*)(P) + b_), 16, 0, 0); } } while (0)
#define STAGE(P, BASE, br, kt) STAGE_X(tx, P, BASE, br, kt)
#define LDA(dst, b, h) for (int m = 0; m < 4; ++m) for (int k = 0; k < 2; ++k) dst[m][k] = *reinterpret_cast<const bf16x8*>((char*)SA(b, h) + lds_byte(wr * 64 + m * 16 + fr, k * 32 + fq * 8))
#define LDB(dst, b, h) for (int n = 0; n < 2; ++n) for (int k = 0; k < 2; ++k) dst[n][k] = *reinterpret_cast<const bf16x8*>((char*)SB(b, h) + lds_byte(wc * 32 + n * 16 + fr, k * 32 + fq * 8))
#define MMA(ai, bj, At_, Bt_) do { __builtin_amdgcn_s_setprio(1); \
    for (int m = 0; m < 4; ++m) for (int n = 0; n < 2; ++n) for (int k = 0; k < 2; ++k) acc[ai][bj][m][n] = __builtin_amdgcn_mfma_f32_16x16x32_bf16(At_[m][k], Bt_[n][k], acc[ai][bj][m][n], 0, 0, 0); \
    __builtin_amdgcn_s_setprio(0); } while (0)
#define WAIT_V(n) asm volatile("s_waitcnt vmcnt(" #n ")" ::: "memory")
#define WAIT_L(n) asm volatile("s_waitcnt lgkmcnt(" #n ")" ::: "memory")
#define BAR __builtin_amdgcn_s_barrier()
#define SCHED __builtin_amdgcn_sched_barrier(0)
    int tx = threadIdx.x; asm volatile("" : "+v"(tx));
    int wid = tx >> 6, lane = tx & 63, wr = wid >> 2, wc = wid & 3, fr = lane & 15, fq = lane >> 4;
    bf16x8 At[4][2], B0[2][2], B1[2][2];
    const int nt = K / BK;
    STAGE(SB(0, 0), Bt, bcol, 0); STAGE(SA(0, 0), A, brow, 0);
    STAGE(SB(0, 1), Bt, bcol + HALF, 0); STAGE(SA(0, 1), A, brow + HALF, 0);
    if (wr == 1) BAR;
    WAIT_V(4); BAR;
    STAGE(SB(1, 0), Bt, bcol, 1); STAGE(SA(1, 0), A, brow, 1); STAGE(SB(1, 1), Bt, bcol + HALF, 1);
    WAIT_V(6); BAR;
    for (int t = 0; t < nt - 2; t += 2) {
        LDB(B0, 0, 0); SCHED; LDA(At, 0, 0); STAGE(SA(1, 1), A, brow + HALF, t + 1);
        WAIT_L(8); BAR; WAIT_L(0); MMA(0, 0, At, B0); BAR; SCHED;
        LDB(B1, 0, 1); STAGE(SB(0, 0), Bt, bcol, t + 2);
        BAR; WAIT_L(0); MMA(0, 1, At, B1); BAR;
        LDA(At, 0, 1); STAGE(SA(0, 0), A, brow, t + 2);
        BAR; WAIT_L(0); MMA(1, 0, At, B0); BAR; SCHED;
        STAGE(SB(0, 1), Bt, bcol + HALF, t + 2);
        WAIT_V(6); BAR; MMA(1, 1, At, B1); BAR;
        LDB(B0, 1, 0); SCHED; LDA(At, 1, 0); STAGE(SA(0, 1), A, brow + HALF, t + 2);
        WAIT_L(8); BAR; WAIT_L(0); MMA(0, 0, At, B0); BAR; SCHED;
        LDB(B1, 1, 1); STAGE(SB(1, 0), Bt, bcol, t + 3);
        BAR; WAIT_L(0); MMA(0, 1, At, B1); BAR;
        LDA(At, 1, 1); STAGE(SA(1, 0), A, brow, t + 3);
        BAR; WAIT_L(0); MMA(1, 0, At, B0); BAR; SCHED;
        STAGE(SB(1, 1), Bt, bcol + HALF, t + 3);
        WAIT_V(6); BAR; MMA(1, 1, At, B1); BAR;
    }
    int tz = threadIdx.x; asm volatile("" : "+v"(tz)); wid = tz >> 6; lane = tz & 63; wr = wid >> 2; wc = wid & 3; fr = lane & 15; fq = lane >> 4;
    { LDB(B0, 0, 0); WAIT_V(0); LDA(At, 0, 0); STAGE_X(tz, SA(1, 1), A, brow + HALF, nt - 1);
      BAR; WAIT_L(0); MMA(0, 0, At, B0); BAR;
      LDB(B1, 0, 1); BAR; WAIT_L(0); MMA(0, 1, At, B1); BAR;
      LDA(At, 0, 1); WAIT_V(4); BAR; WAIT_L(0); MMA(1, 0, At, B0); MMA(1, 1, At, B1); BAR; }
    { LDB(B0, 1, 0); LDA(At, 1, 0); WAIT_V(2); BAR; WAIT_L(0); MMA(0, 0, At, B0); BAR;
      LDB(B1, 1, 1); WAIT_V(0); BAR; WAIT_L(0); MMA(0, 1, At, B1); BAR;
      LDA(At, 1, 1); BAR; WAIT_L(0); MMA(1, 0, At, B0); MMA(1, 1, At, B1); BAR; }
    if (wr == 0) BAR;
#undef SA
#undef SB
#undef STAGE_X
#undef STAGE
#undef LDA
#undef LDB
#undef MMA
#undef WAIT_V
#undef WAIT_L
#undef BAR
#undef SCHED
}
}

__device__ __forceinline__ void p5_outproj_256(unsigned char* lds, const unsigned short* __restrict__ mix, const unsigned short* __restrict__ wt_out, const float* __restrict__ ssqa, const float* __restrict__ ssqb,
                                               const float* __restrict__ x, float* __restrict__ out, unsigned short* __restrict__ hb, float* __restrict__ hss) {
    const int vcu = (blockIdx.x & 7) * (NBLK / 8) + (blockIdx.x >> 3);
    for (int tile = vcu; tile < 64 * 4; tile += NBLK) {
        const int m0 = (tile >> 2) * 256, n0 = (tile & 3) * 256;
        f32x4_t acc[2][2][4][2];
#pragma unroll
        for (int ai = 0; ai < 2; ++ai)
#pragma unroll
            for (int bj = 0; bj < 2; ++bj)
#pragma unroll
                for (int m = 0; m < 4; ++m)
#pragma unroll
                    for (int n = 0; n < 2; ++n) acc[ai][bj][m][n] = f32x4_t{0.f, 0.f, 0.f, 0.f};
        g256::mainloop<512, 1024>(wt_out, mix, n0, m0, (unsigned short*)lds, acc);
        float rb[2][2];
        {
            const int tid = tid_(); const int lane = tid & 63, wave = __builtin_amdgcn_readfirstlane(tid >> 6), wc = wave & 3, fr = lane & 15;
#pragma unroll
            for (int bj = 0; bj < 2; ++bj)
#pragma unroll
                for (int n = 0; n < 2; ++n) {
                    const long tok = m0 + bj * 128 + wc * 32 + n * 16 + fr; float sa = 0.f, sb = 0.f;
#pragma unroll
                    for (int hh = 0; hh < 8; ++hh) { sa += ssqa[(long)hh * T_ + tok]; sb += ssqb[(long)hh * T_ + tok]; }
                    rb[bj][n] = rsqrtf(sb * (1.f / 512.f) + EPS); const float ratio = rsqrtf(sa * (1.f / 512.f) + EPS) / rb[bj][n];
#pragma unroll
                    for (int ai = 0; ai < 2; ++ai)
#pragma unroll
                        for (int m = 0; m < 4; ++m) acc[ai][bj][m][n] *= ratio;
                }
        }
        g256::mainloop<512, 1024>(wt_out + 512, mix + 512, n0, m0, (unsigned short*)lds, acc);
        const int tid = tid_(); const int lane = tid & 63, wave = __builtin_amdgcn_readfirstlane(tid >> 6), wr = wave >> 2, wc = wave & 3, fr = lane & 15, fq = lane >> 4;
#pragma unroll
        for (int bj = 0; bj < 2; ++bj)
#pragma unroll
            for (int n = 0; n < 2; ++n) {
                const long tok = m0 + bj * 128 + wc * 32 + n * 16 + fr; const float r = rb[bj][n];
                float ss = 0.f;
#pragma unroll
                for (int ai = 0; ai < 2; ++ai)
#pragma unroll
                    for (int m = 0; m < 4; ++m) {
                        const int nrow = n0 + ai * 128 + wr * 64 + m * 16 + fq * 4;
                        const float4 xv = *(const float4*)(x + tok * 1024 + nrow);
                        float4 hv; hv.x = xv.x + acc[ai][bj][m][n][0] * r; hv.y = xv.y + acc[ai][bj][m][n][1] * r; hv.z = xv.z + acc[ai][bj][m][n][2] * r; hv.w = xv.w + acc[ai][bj][m][n][3] * r;
                        *(float4*)(out + tok * 1024 + nrow) = hv;
                        uint2 pk; pk.x = cvtpk(hv.x, hv.y); pk.y = cvtpk(hv.z, hv.w);
                        *(uint2*)(hb + tok * 1024 + nrow) = pk;
                        ss += hv.x * hv.x + hv.y * hv.y + hv.z * hv.z + hv.w * hv.w;
                    }
                { auto r1 = __builtin_amdgcn_permlane16_swap(__float_as_uint(ss), __float_as_uint(ss), false, false); ss = __uint_as_float(r1[0]) + __uint_as_float(r1[1]); }
                ss = pair_sum(ss);
                if (fq == 0) { hss[tok * 16 + (n0 >> 8) * 4 + wr] = ss; hss[tok * 16 + (n0 >> 8) * 4 + 2 + wr] = 0.f; }
            }
        __syncthreads();
    }
}
constexpr int P6_OP = 528;
__device__ __forceinline__ void p6_peerq_256(unsigned char* lds, const unsigned short* __restrict__ hb, const unsigned short* __restrict__ wt_q, const float* __restrict__ hss,
                                             unsigned short* __restrict__ pqb, float* __restrict__ pss) {
    const int vcu = (blockIdx.x & 7) * (NBLK / 8) + (blockIdx.x >> 3);
    for (int tile = vcu; tile < 64 * 8; tile += NBLK) {
        const int m0 = (tile >> 3) * 256, n0 = (tile & 7) * 256;
        f32x4_t acc[2][2][4][2];
#pragma unroll
        for (int ai = 0; ai < 2; ++ai)
#pragma unroll
            for (int bj = 0; bj < 2; ++bj)
#pragma unroll
                for (int m = 0; m < 4; ++m)
#pragma unroll
                    for (int n = 0; n < 2; ++n) acc[ai][bj][m][n] = f32x4_t{0.f, 0.f, 0.f, 0.f};
        g256::mainloop<1024>(wt_q, hb, n0, m0, (unsigned short*)lds, acc);
        const int tid = tid_(); const int lane = tid & 63, wave = __builtin_amdgcn_readfirstlane(tid >> 6), wr = wave >> 2, wc = wave & 3, fr = lane & 15, fq = lane >> 4;
#pragma unroll
        for (int bj = 0; bj < 2; ++bj)
#pragma unroll
            for (int n = 0; n < 2; ++n) {
                const long tok = m0 + bj * 128 + wc * 32 + n * 16 + fr;
                const float4* hp = (const float4*)(hss + tok * 16);
                const float4 s0 = hp[0], s1 = hp[1], s2 = hp[2], s3 = hp[3];
                const float rs = rsqrtf((s0.x + s0.y + s0.z + s0.w + s1.x + s1.y + s1.z + s1.w + s2.x + s2.y + s2.z + s2.w + s3.x + s3.y + s3.z + s3.w) * (1.f / 1024.f) + EPS);
                float ss = 0.f;
#pragma unroll
                for (int ai = 0; ai < 2; ++ai)
#pragma unroll
                    for (int m = 0; m < 4; ++m) {
                        const int nrow = n0 + ai * 128 + wr * 64 + m * 16 + fq * 4;
                        const float v0 = acc[ai][bj][m][n][0] * rs, v1 = acc[ai][bj][m][n][1] * rs, v2 = acc[ai][bj][m][n][2] * rs, v3 = acc[ai][bj][m][n][3] * rs;
                        uint2 pk; pk.x = cvtpk(v0, v1); pk.y = cvtpk(v2, v3);
                        *(uint2*)(lds + (bj * 128 + wc * 32 + n * 16 + fr) * P6_OP + (ai * 128 + wr * 64 + m * 16 + fq * 4) * 2) = pk;
                        ss += v0 * v0 + v1 * v1 + v2 * v2 + v3 * v3;
                    }
                { auto r1 = __builtin_amdgcn_permlane16_swap(__float_as_uint(ss), __float_as_uint(ss), false, false); ss = __uint_as_float(r1[0]) + __uint_as_float(r1[1]); }
                ss = pair_sum(ss);
                if (fq == 0) { pss[tok * 32 + (n0 >> 8) * 4 + wr] = ss; pss[tok * 32 + (n0 >> 8) * 4 + 2 + wr] = 0.f; }
            }
        __syncthreads();
#pragma unroll
        for (int i = 0; i < 16; ++i) {
            const int c = tid + i * 512, row = c >> 5, cc = c & 31;
            *(uint4*)(pqb + (long)(m0 + row) * 2048 + n0 + cc * 8) = *(const uint4*)(lds + row * P6_OP + cc * 16);
        }
        __syncthreads();
    }
}

__device__ __forceinline__ unsigned ordkey(float f) { const unsigned u = __float_as_uint(f); return u ^ ((unsigned)((int)u >> 31) | 0x80000000u); }
__device__ __forceinline__ float orddec(unsigned k) { return __uint_as_float((k & 0x80000000u) ? (k & 0x7fffffffu) : ~k); }
#define CE_DESC(a, b) do { const unsigned mx_ = max(a, b), mn_ = min(a, b); a = mx_; b = mn_; } while (0)
__device__ __forceinline__ void sort16_desc(unsigned (&v)[16]) {
#define CE2(i, j) CE_DESC(v[i], v[j])
    CE2(0, 13); CE2(1, 12); CE2(2, 15); CE2(3, 14); CE2(4, 8); CE2(5, 6); CE2(7, 11); CE2(9, 10);
    CE2(0, 5); CE2(1, 7); CE2(2, 9); CE2(3, 4); CE2(6, 13); CE2(8, 14); CE2(10, 15); CE2(11, 12);
    CE2(0, 1); CE2(2, 3); CE2(4, 5); CE2(6, 8); CE2(7, 9); CE2(10, 11); CE2(12, 13); CE2(14, 15);
    CE2(0, 2); CE2(1, 3); CE2(4, 10); CE2(5, 11); CE2(6, 7); CE2(8, 9); CE2(12, 14); CE2(13, 15);
    CE2(1, 2); CE2(3, 12); CE2(4, 6); CE2(5, 7); CE2(8, 10); CE2(9, 11); CE2(13, 14);
    CE2(1, 4); CE2(2, 6); CE2(5, 8); CE2(7, 10); CE2(9, 13); CE2(11, 14);
    CE2(2, 4); CE2(3, 6); CE2(9, 12); CE2(11, 13);
    CE2(3, 5); CE2(6, 8); CE2(7, 9); CE2(10, 12);
    CE2(3, 4); CE2(5, 6); CE2(7, 8); CE2(9, 10); CE2(11, 12);
    CE2(6, 7); CE2(8, 9);
#undef CE2
}
__device__ __forceinline__ void bitonic16_desc(unsigned (&a)[16]) {
#pragma unroll
    for (int j = 8; j > 0; j >>= 1)
#pragma unroll
        for (int i = 0; i < 16; ++i) { const int l = i ^ j; if (l > i) CE_DESC(a[i], a[l]); }
}
__device__ __forceinline__ void merge16_desc(unsigned (&a)[16], const unsigned (&b)[16]) {
#pragma unroll
    for (int i = 0; i < 16; ++i) a[i] = max(a[i], b[15 - i]);
#pragma unroll
    for (int j = 8; j > 0; j >>= 1)
#pragma unroll
        for (int i = 0; i < 16; ++i) { const int l = i ^ j; if (l > i) CE_DESC(a[i], a[l]); }
}
__device__ __forceinline__ void top16_of_lanepair(unsigned (&k0)[16], unsigned (&k1)[16], unsigned (&k2)[16], unsigned (&k3)[16]) {
    sort16_desc(k0); sort16_desc(k1); sort16_desc(k2); sort16_desc(k3);
    merge16_desc(k0, k1); merge16_desc(k2, k3); merge16_desc(k0, k2);
    unsigned o[16];
#pragma unroll
    for (int i = 0; i < 16; ++i) { auto rr = __builtin_amdgcn_permlane32_swap(k0[i], k0[i], false, false); k0[i] = rr[0]; o[i] = rr[1]; }
    merge16_desc(k0, o);
}
__device__ __forceinline__ void peer_route_mfma(unsigned char* lds, const unsigned short* __restrict__ pqb, const float* __restrict__ pss, const unsigned short* __restrict__ sk16, int* __restrict__ eo, float* __restrict__ go) {
    const int tid = tid_(); const int lane = tid & 63, w = __builtin_amdgcn_readfirstlane(tid >> 6), r32 = lane & 31, hi = lane >> 5;
    const int h = blockIdx.x & 7;
    constexpr int SKP = 272;
    for (int c16 = tid; c16 < 256 * 16; c16 += 512) { const int row = c16 >> 4, ch = c16 & 15; *(uint4*)(lds + row * SKP + ch * 16) = *(const uint4*)(sk16 + ((long)h * 256 + row) * 128 + ch * 8); }
    __syncthreads();
    for (int it = 0; it < 2; ++it) {
        const long tok = (long)((blockIdx.x >> 3) * 16 + w * 2 + it) * 32 + r32;
        const float4 ps = *(const float4*)(pss + tok * 32 + h * 4);
        const float rs = rsqrtf((ps.x + ps.y + ps.z + ps.w) * (1.f / 256.f) + EPS);
        unsigned T1[16], T2[16];
#pragma unroll
        for (int c = 0; c < 2; ++c) {
            f32x16 acc[4];
#pragma unroll
            for (int mt = 0; mt < 4; ++mt)
#pragma unroll
                for (int r = 0; r < 16; ++r) acc[mt][r] = 0.f;
            const unsigned short* qrow = pqb + tok * 2048 + h * 256 + c * 128 + hi * 8;
            const unsigned char* krow = lds + (c * 128 + r32) * SKP + hi * 16;
#pragma unroll 2
            for (int ks = 0; ks < 8; ++ks) {
                const bf16x8 qf = *(const bf16x8*)(qrow + ks * 16);
#pragma unroll
                for (int mt = 0; mt < 4; ++mt) { const bf16x8 kf = *(const bf16x8*)(krow + mt * 32 * SKP + ks * 32); acc[mt] = MFMA32(kf, qf, acc[mt]); }
            }
            unsigned k0[16], k1[16], k2[16], k3[16];
#pragma unroll
            for (int r = 0; r < 16; ++r) {
                const unsigned idx = 127u - (unsigned)crow(r, hi);
                k0[r] = (ordkey(acc[0][r]) & ~127u) | idx; k1[r] = (ordkey(acc[1][r]) & ~127u) | (idx - 32u);
                k2[r] = (ordkey(acc[2][r]) & ~127u) | (idx - 64u); k3[r] = (ordkey(acc[3][r]) & ~127u) | (idx - 96u);
            }
            top16_of_lanepair(k0, k1, k2, k3);
            if (c == 0) {
#pragma unroll
                for (int i = 0; i < 16; ++i) T1[i] = k0[i];
            } else {
#pragma unroll
                for (int i = 0; i < 16; ++i) T2[i] = k0[i];
            }
        }
        float v1[16], v2[16]; unsigned p1[4] = {0u, 0u, 0u, 0u}, p2[4] = {0u, 0u, 0u, 0u};
#pragma unroll
        for (int i = 0; i < 16; ++i) {
            v1[i] = orddec(T1[i] & ~127u) * rs; v2[i] = orddec(T2[i] & ~127u) * rs;
            p1[i >> 2] |= (127u - (T1[i] & 127u)) << (8 * (i & 3)); p2[i >> 2] |= (127u - (T2[i] & 127u)) << (8 * (i & 3));
        }
        unsigned c0[16], c1[16], c2[16];
#define CAND(a, b) ((ordkey(v1[a] + v2[b]) & ~255u) | (255u - (unsigned)((a) * 16 + (b))))
        c0[0] = CAND(0, 0); c0[1] = CAND(0, 1); c0[2] = CAND(0, 2); c0[3] = CAND(0, 3); c0[4] = CAND(0, 4); c0[5] = CAND(0, 5); c0[6] = CAND(0, 6); c0[7] = CAND(0, 7);
        c0[8] = CAND(0, 8); c0[9] = CAND(0, 9); c0[10] = CAND(0, 10); c0[11] = CAND(0, 11); c0[12] = CAND(0, 12); c0[13] = CAND(0, 13); c0[14] = CAND(0, 14); c0[15] = CAND(0, 15);
        c1[0] = CAND(1, 0); c1[1] = CAND(1, 1); c1[2] = CAND(1, 2); c1[3] = CAND(1, 3); c1[4] = CAND(1, 4); c1[5] = CAND(1, 5); c1[6] = CAND(1, 6); c1[7] = CAND(1, 7);
        c1[8] = CAND(15, 0); c1[9] = CAND(14, 0); c1[10] = CAND(13, 0); c1[11] = CAND(12, 0); c1[12] = CAND(11, 0); c1[13] = CAND(10, 0); c1[14] = CAND(9, 0); c1[15] = CAND(8, 0);
        c2[0] = CAND(2, 0); c2[1] = CAND(2, 1); c2[2] = CAND(2, 2); c2[3] = CAND(2, 3); c2[4] = CAND(2, 4); c2[5] = CAND(3, 0); c2[6] = CAND(3, 1); c2[7] = CAND(3, 2);
        c2[8] = CAND(3, 3); c2[9] = CAND(4, 0); c2[10] = CAND(4, 1); c2[11] = CAND(4, 2); c2[12] = CAND(5, 0); c2[13] = CAND(5, 1); c2[14] = CAND(6, 0); c2[15] = CAND(6, 1);
        const unsigned c70 = CAND(7, 0), c71 = CAND(7, 1);
#undef CAND
        bitonic16_desc(c1); sort16_desc(c2);
        c2[15] = max(c2[15], c70); c2[14] = max(c2[14], c71); bitonic16_desc(c2);
        merge16_desc(c0, c1); merge16_desc(c0, c2);
        float ev[16]; int ee[16]; float l = 0.f; const float mx = orddec(c0[0] & ~255u);
#pragma unroll
        for (int i = 0; i < 16; ++i) {
            const unsigned ci = 255u - (c0[i] & 255u); const unsigned a = ci >> 4, b = ci & 15u;
            const unsigned wa = (a >> 2) == 0 ? p1[0] : ((a >> 2) == 1 ? p1[1] : ((a >> 2) == 2 ? p1[2] : p1[3]));
            const unsigned wb = (b >> 2) == 0 ? p2[0] : ((b >> 2) == 1 ? p2[1] : ((b >> 2) == 2 ? p2[2] : p2[3]));
            const unsigned i1 = (wa >> (8 * (a & 3u))) & 255u, i2 = (wb >> (8 * (b & 3u))) & 255u;
            ee[i] = (int)(i1 * 128u + i2);
            ev[i] = __expf(orddec(c0[i] & ~255u) - mx); l += ev[i];
        }
        const float inv = 1.f / l;
        if (hi == 0) {
            int4* ep = (int4*)(eo + tok * 128 + h * 16);
            ep[0] = make_int4(ee[0], ee[1], ee[2], ee[3]); ep[1] = make_int4(ee[4], ee[5], ee[6], ee[7]); ep[2] = make_int4(ee[8], ee[9], ee[10], ee[11]); ep[3] = make_int4(ee[12], ee[13], ee[14], ee[15]);
        } else {
            float4* gp = (float4*)(go + tok * 128 + h * 16);
            gp[0] = make_float4(ev[0] * inv, ev[1] * inv, ev[2] * inv, ev[3] * inv); gp[1] = make_float4(ev[4] * inv, ev[5] * inv, ev[6] * inv, ev[7] * inv);
            gp[2] = make_float4(ev[8] * inv, ev[9] * inv, ev[10] * inv, ev[11] * inv); gp[3] = make_float4(ev[12] * inv, ev[13] * inv, ev[14] * inv, ev[15] * inv);
        }
    }
}

template <int DQK>
struct FA {
    static constexpr int NDS = DQK / 16, KP = DQK * 2 + 16, KBYTES = 64 * KP, VP = 144, VBYTES = 64 * VP, STAGE = KBYTES + VBYTES;
    static constexpr int KCH = 64 * DQK / 8, NCH = KCH + 512, SLOTS = (NCH + 511) / 512;
};
constexpr float FA_THR = 8.f;
constexpr float FA_NEG = -1e30f;
struct FaRegs { uint4 g0, g1, g2; };
template <int DQK>
__device__ __forceinline__ uint4 fa_load1(const unsigned short* __restrict__ Kg, int kpitch, const unsigned short* __restrict__ Vg, int vpitch, int tid, int i) {
    int c = tid + i * 512; if (c >= FA<DQK>::NCH) c = 0;
    const int key = c / (DQK / 8), kc = c % (DQK / 8); const int c2 = c - FA<DQK>::KCH; const int d = c2 >> 3, vc = c2 & 7;
    const unsigned koff = (unsigned)(key * kpitch + kc * 8) * 2u, voff = (unsigned)(d * vpitch + vc * 8) * 2u;
#if defined(__HIP_DEVICE_COMPILE__)
    typedef unsigned u32x4_t __attribute__((ext_vector_type(4)));
    const u32x4_t v = (c < FA<DQK>::KCH) ? *(const AS1 u32x4_t*)((const AS1 char*)Kg + koff) : *(const AS1 u32x4_t*)((const AS1 char*)Vg + voff);
    return make_uint4(v.x, v.y, v.z, v.w);
#else
    (void)koff; (void)voff; return make_uint4(0u, 0u, 0u, 0u);
#endif
}
template <int DQK>
__device__ __forceinline__ void fa_store1(unsigned char* st, const uint4& g, int tid, int i) {
    const int c = tid + i * 512;
    const int key = c / (DQK / 8), kc = c % (DQK / 8); const int c2 = c - FA<DQK>::KCH; const int d = c2 >> 3, vc = c2 & 7;
    const int off = (c < FA<DQK>::KCH) ? (key * FA<DQK>::KP + kc * 16) : (FA<DQK>::KBYTES + d * FA<DQK>::VP + vc * 16);
    if (c < FA<DQK>::NCH) *(uint4*)(st + off) = g;
}
template <int DQK>
__device__ __forceinline__ void fa_load(const unsigned short* __restrict__ Kg, int kpitch, const unsigned short* __restrict__ Vg, int vpitch, FaRegs& g, int tid) {
    g.g0 = fa_load1<DQK>(Kg, kpitch, Vg, vpitch, tid, 0); g.g1 = fa_load1<DQK>(Kg, kpitch, Vg, vpitch, tid, 1);
    if (FA<DQK>::SLOTS > 2) g.g2 = fa_load1<DQK>(Kg, kpitch, Vg, vpitch, tid, 2);
}
template <int DQK>
__device__ __forceinline__ void fa_store(unsigned char* st, const FaRegs& g, int tid) {
    fa_store1<DQK>(st, g.g0, tid, 0); fa_store1<DQK>(st, g.g1, tid, 1);
    if (FA<DQK>::SLOTS > 2) fa_store1<DQK>(st, g.g2, tid, 2);
}
template <int DQK, int MODE, bool STATS_ONLY = false>
__device__ __forceinline__ void fa_tile(const unsigned char* st, const bf16x8 (&qf)[FA<DQK>::NDS], f32x16 (&o)[2], float& mref, float& l, int key0, int qpos, int lane, bool need_mask, bool colsel = true) {
    asm volatile("" : "+v"(lane));
    const int r32 = lane & 31, hi = lane >> 5;
    f32x16 s0, s1;
#pragma unroll
    for (int r = 0; r < 16; ++r) { s0[r] = 0.f; s1[r] = 0.f; }
    {
        bf16x8 k0 = *(const bf16x8*)(st + r32 * FA<DQK>::KP + hi * 16);
        bf16x8 k1 = *(const bf16x8*)(st + (32 + r32) * FA<DQK>::KP + hi * 16);
#pragma unroll
        for (int ds = 0; ds < FA<DQK>::NDS; ++ds) {
            bf16x8 n0 = k0, n1 = k1;
            if (ds + 1 < FA<DQK>::NDS) {
                n0 = *(const bf16x8*)(st + r32 * FA<DQK>::KP + (ds + 1) * 32 + hi * 16);
                n1 = *(const bf16x8*)(st + (32 + r32) * FA<DQK>::KP + (ds + 1) * 32 + hi * 16);
            }
            s0 = MFMA32(k0, qf[ds], s0); s1 = MFMA32(k1, qf[ds], s1);
            k0 = n0; k1 = n1;
            __builtin_amdgcn_sched_barrier(0);
        }
    }
    __builtin_amdgcn_sched_barrier(0);
    if (MODE != 0 && need_mask) {
#pragma unroll
        for (int r = 0; r < 16; ++r) {
            const int ka = key0 + crow(r, hi), kb = ka + 32;
            bool ma, mb;
            if (MODE == 4) { ma = 16 * ka + 31 > qpos; mb = 16 * kb + 31 > qpos; }
            else { ma = ka > qpos; mb = kb > qpos; }
            if (MODE == 2) { ma = ma || (ka <= qpos - 512); mb = mb || (kb <= qpos - 512); }
            if (ma) s0[r] = -INFINITY;
            if (mb) s1[r] = -INFINITY;
        }
    }
    float mxa = max3f(s0[0], s0[1], s0[2]), mxb = max3f(s1[0], s1[1], s1[2]);
#pragma unroll
    for (int r = 3; r < 15; r += 2) { mxa = max3f(mxa, s0[r], s0[r + 1]); mxb = max3f(mxb, s1[r], s1[r + 1]); }
    float mx = max3f(mxa, mxb, fmaxf(s0[15], s1[15]));
    if (MODE == 3) mx = colsel ? mx : -INFINITY;
    mx = pair_max(mx);
    if (__any(mx > mref + FA_THR)) {
        const float mnew = (mx > mref + FA_THR) ? mx : mref;
        const float alpha = __builtin_amdgcn_exp2f(mref - mnew);
        mref = mnew; l *= alpha;
#pragma unroll
        for (int r = 0; r < 16; ++r) { o[0][r] *= alpha; o[1][r] *= alpha; }
    }
    const float mre = (MODE == 3) ? (colsel ? mref : INFINITY) : mref;
    const f32x2_t mm = {mre, mre};
    f32x2_t ps0 = {0.f, 0.f}, ps1 = {0.f, 0.f};
#pragma unroll
    for (int r = 0; r < 16; r += 2) {
        const f32x2_t d0 = f32x2_t{s0[r], s0[r + 1]} - mm, d1 = f32x2_t{s1[r], s1[r + 1]} - mm;
        s0[r] = __builtin_amdgcn_exp2f(d0.x); s0[r + 1] = __builtin_amdgcn_exp2f(d0.y); s1[r] = __builtin_amdgcn_exp2f(d1.x); s1[r + 1] = __builtin_amdgcn_exp2f(d1.y);
        ps0 += f32x2_t{s0[r], s0[r + 1]}; ps1 += f32x2_t{s1[r], s1[r + 1]};
    }
    ps0 += ps1;
    l += ps0.x + ps0.y;
    if (STATS_ONLY) return;
    bf16x8 pk[4];
#pragma unroll
    for (int s = 0; s < 2; ++s) {
        uint4 a, b;
        a.x = cvtpk(s0[8 * s], s0[8 * s + 1]); a.y = cvtpk(s0[8 * s + 2], s0[8 * s + 3]); a.z = cvtpk(s0[8 * s + 4], s0[8 * s + 5]); a.w = cvtpk(s0[8 * s + 6], s0[8 * s + 7]);
        b.x = cvtpk(s1[8 * s], s1[8 * s + 1]); b.y = cvtpk(s1[8 * s + 2], s1[8 * s + 3]); b.z = cvtpk(s1[8 * s + 4], s1[8 * s + 5]); b.w = cvtpk(s1[8 * s + 6], s1[8 * s + 7]);
        pk[s] = __builtin_bit_cast(bf16x8, a); pk[2 + s] = __builtin_bit_cast(bf16x8, b);
    }
    const unsigned char* vt = st + FA<DQK>::KBYTES;
    __builtin_amdgcn_sched_barrier(0);
    {
        bf16x8 v0 = *(const bf16x8*)(vt + r32 * FA<DQK>::VP + hi * 16);
        bf16x8 v1 = *(const bf16x8*)(vt + (32 + r32) * FA<DQK>::VP + hi * 16);
#pragma unroll
        for (int ks = 0; ks < 4; ++ks) {
            bf16x8 n0 = v0, n1 = v1;
            if (ks + 1 < 4) {
                n0 = *(const bf16x8*)(vt + r32 * FA<DQK>::VP + (ks + 1) * 32 + hi * 16);
                n1 = *(const bf16x8*)(vt + (32 + r32) * FA<DQK>::VP + (ks + 1) * 32 + hi * 16);
            }
            o[0] = MFMA32(v0, pk[ks], o[0]); o[1] = MFMA32(v1, pk[ks], o[1]);
            v0 = n0; v1 = n1;
            __builtin_amdgcn_sched_barrier(0);
        }
    }
}
__device__ __forceinline__ int vperm(int s) { const int g = (s >> 2) & 3; const int pg = (g == 1) ? 2 : ((g == 2) ? 1 : g); return (s & ~15) | (pg << 2) | (s & 3); }

constexpr float MLA_QSCALE = 0.10206207261596575f * 1.4426950408889634f;
namespace m128 {
constexpr int KP = 208, VP = 272, KBYTES = 128 * KP, VBYTES = 64 * VP, STAGE = KBYTES + VBYTES;
struct Regs { u32x4 g[5]; };
__device__ __forceinline__ void load(const unsigned short* __restrict__ Kg, const unsigned short* __restrict__ Vg, Regs& R, int tid) {
#pragma unroll
    for (int i = 0; i < 5; ++i) {
        const int c = tid + i * 512;
        if (i < 3) { const int key = c / 12, kc = c % 12; R.g[i] = *(const AS1 u32x4*)((const AS1 char*)Kg + (unsigned)(key * 96 + kc * 8) * 2u); }
        else { const int c2 = c - 1536; const int d = c2 >> 4, vc = c2 & 15; R.g[i] = *(const AS1 u32x4*)((const AS1 char*)Vg + (unsigned)(d * S_ + vc * 8) * 2u); }
    }
}
__device__ __forceinline__ void store(unsigned char* st, const Regs& R, int tid) {
#pragma unroll
    for (int i = 0; i < 5; ++i) {
        const int c = tid + i * 512;
        if (i < 3) { const int key = c / 12, kc = c % 12; *(u32x4*)(st + key * KP + kc * 16) = R.g[i]; }
        else { const int c2 = c - 1536; const int d = c2 >> 4, vc = c2 & 15; *(u32x4*)(st + KBYTES + d * VP + vc * 16) = R.g[i]; }
    }
}
__device__ __forceinline__ void tile(const unsigned char* st, const bf16x8 (&qf)[6], f32x16 (&o)[2], float& mref, float& l, int key0, int qpos, int lane, bool need_mask) {
    asm volatile("" : "+v"(lane));
    const int r32 = lane & 31, hi = lane >> 5;
    f32x16 s[4];
#pragma unroll
    for (int kb = 0; kb < 4; ++kb)
#pragma unroll
        for (int r = 0; r < 16; ++r) s[kb][r] = 0.f;
#pragma unroll
    for (int half = 0; half < 2; ++half) {
        const unsigned char* kb0 = st + ((2 * half) * 32 + r32) * KP + hi * 16, * kb1 = kb0 + 32 * KP;
        bf16x8 k0 = *(const bf16x8*)kb0, k1 = *(const bf16x8*)kb1;
#pragma unroll
        for (int ds = 0; ds < 6; ++ds) {
            bf16x8 n0 = k0, n1 = k1;
            if (ds + 1 < 6) { n0 = *(const bf16x8*)(kb0 + (ds + 1) * 32); n1 = *(const bf16x8*)(kb1 + (ds + 1) * 32); }
            s[2 * half] = MFMA32(k0, qf[ds], s[2 * half]); s[2 * half + 1] = MFMA32(k1, qf[ds], s[2 * half + 1]);
            k0 = n0; k1 = n1;
            __builtin_amdgcn_sched_barrier(0);
        }
    }
    if (need_mask) {
#pragma unroll
        for (int kb = 0; kb < 4; ++kb)
#pragma unroll
            for (int r = 0; r < 16; ++r) if (key0 + kb * 32 + crow(r, hi) > qpos) s[kb][r] = -INFINITY;
    }
    float mxa = max3f(s[0][0], s[0][1], s[0][2]), mxb = max3f(s[1][0], s[1][1], s[1][2]), mxc = max3f(s[2][0], s[2][1], s[2][2]), mxd = max3f(s[3][0], s[3][1], s[3][2]);
#pragma unroll
    for (int r = 3; r < 15; r += 2) { mxa = max3f(mxa, s[0][r], s[0][r + 1]); mxb = max3f(mxb, s[1][r], s[1][r + 1]); mxc = max3f(mxc, s[2][r], s[2][r + 1]); mxd = max3f(mxd, s[3][r], s[3][r + 1]); }
    float mx = max3f(max3f(mxa, mxb, s[0][15]), max3f(mxc, mxd, s[1][15]), fmaxf(s[2][15], s[3][15]));
    mx = pair_max(mx);
    if (__any(mx > mref + FA_THR)) {
        const float mnew = (mx > mref + FA_THR) ? mx : mref;
        const float alpha = __builtin_amdgcn_exp2f(mref - mnew);
        mref = mnew; l *= alpha;
#pragma unroll
        for (int r = 0; r < 16; ++r) { o[0][r] *= alpha; o[1][r] *= alpha; }
    }
    const f32x2_t mm = {mref, mref};
    f32x2_t ps0 = {0.f, 0.f}, ps1 = {0.f, 0.f};
    bf16x8 pk[8];
#pragma unroll
    for (int kb = 0; kb < 4; ++kb) {
        unsigned pw[8];
#pragma unroll
        for (int r = 0; r < 16; r += 2) {
            const f32x2_t d = f32x2_t{s[kb][r], s[kb][r + 1]} - mm;
            const f32x2_t e = {__builtin_amdgcn_exp2f(d.x), __builtin_amdgcn_exp2f(d.y)};
            if (r & 2) ps1 += e; else ps0 += e;
            pw[r >> 1] = cvtpk(e.x, e.y);
        }
        pk[2 * kb] = __builtin_bit_cast(bf16x8, u32x4{pw[0], pw[1], pw[2], pw[3]});
        pk[2 * kb + 1] = __builtin_bit_cast(bf16x8, u32x4{pw[4], pw[5], pw[6], pw[7]});
    }
    ps0 += ps1; l += ps0.x + ps0.y;
    const unsigned char* vt = st + KBYTES + r32 * VP + hi * 16;
    __builtin_amdgcn_sched_barrier(0);
    {
        bf16x8 v0 = *(const bf16x8*)vt, v1 = *(const bf16x8*)(vt + 32 * VP);
#pragma unroll
        for (int ks = 0; ks < 8; ++ks) {
            bf16x8 n0 = v0, n1 = v1;
            if (ks + 1 < 8) { n0 = *(const bf16x8*)(vt + (ks + 1) * 32); n1 = *(const bf16x8*)(vt + 32 * VP + (ks + 1) * 32); }
            o[0] = MFMA32(v0, pk[ks], o[0]); o[1] = MFMA32(v1, pk[ks], o[1]);
            v0 = n0; v1 = n1;
            __builtin_amdgcn_sched_barrier(0);
        }
    }
}
}
__device__ __forceinline__ void mla_unit128(unsigned char* lds, int b, int h, int qb, const unsigned short* __restrict__ Q16, const unsigned short* __restrict__ K16, const unsigned short* __restrict__ VT16,
                                            unsigned short* __restrict__ ob16, float* __restrict__ ssqb, int tid) {
    const int lane = tid & 63, wave = __builtin_amdgcn_readfirstlane(tid >> 6), r32 = lane & 31, hi = lane >> 5;
    const int q0 = qb * 256, qpos = q0 + wave * 32 + r32; const long tok = (long)b * S_ + qpos;
    bf16x8 qf[6];
#pragma unroll
    for (int ds = 0; ds < 6; ++ds) qf[ds] = *(const bf16x8*)(Q16 + tok * 768 + h * 96 + ds * 16 + hi * 8);
    f32x16 o[2];
#pragma unroll
    for (int r = 0; r < 16; ++r) { o[0][r] = 0.f; o[1][r] = 0.f; }
    float mref = FA_NEG, l = 0.f;
    const unsigned short* Kb = K16 + ((long)(b * 8 + h)) * S_ * 96;
    const unsigned short* Vb = VT16 + ((long)(b * 8 + h)) * 64 * S_;
    const int nt = (q0 + 256) / 128;
    m128::Regs g;
    m128::load(Kb, Vb, g, tid); m128::store(lds, g, tid);
    m128::load(Kb + (long)128 * 96, Vb + 128, g, tid);
    __syncthreads();
    const int wmin = q0 + wave * 32, wmax = wmin + 31;
    int sc = 0;
    for (int t = 0; t < nt; ++t) {
        const int sn = (sc == 2) ? 0 : sc + 1;
        const int key0 = t * 128;
        if (key0 <= wmax) m128::tile(lds + sc * m128::STAGE, qf, o, mref, l, key0, qpos, lane, key0 + 127 > wmin);
        if (t + 1 < nt) m128::store(lds + sn * m128::STAGE, g, tid);
        if (t + 2 < nt) m128::load(Kb + (long)(t + 2) * 128 * 96, Vb + (t + 2) * 128, g, tid);
        __syncthreads();
        sc = sn;
    }
    l = pair_sum(l);
    const float inv = 1.f / l;
    float ss = 0.f;
#pragma unroll
    for (int dt = 0; dt < 2; ++dt)
#pragma unroll
        for (int gq = 0; gq < 4; ++gq) {
            const float v0 = o[dt][4 * gq] * inv, v1 = o[dt][4 * gq + 1] * inv, v2 = o[dt][4 * gq + 2] * inv, v3 = o[dt][4 * gq + 3] * inv;
            uint2 pk2; pk2.x = cvtpk(v0, v1); pk2.y = cvtpk(v2, v3);
            *(uint2*)(ob16 + tok * 1024 + 512 + h * 64 + dt * 32 + 8 * gq + 4 * hi) = pk2;
            ss += v0 * v0 + v1 * v1 + v2 * v2 + v3 * v3;
        }
    ss = pair_sum(ss);
    if (hi == 0) ssqb[(long)h * T_ + tok] = ss;
}
__device__ __forceinline__ void mla_phase(unsigned char* lds, const unsigned short* __restrict__ Q16, const unsigned short* __restrict__ K16, const unsigned short* __restrict__ VT16,
                                          unsigned short* __restrict__ ob16, float* __restrict__ ssqb) {
    const int tid = tid_();
    for (int i = blockIdx.x; i < 256; i += NBLK) {
        const int xcd = i & 7, slot = i >> 3;
        { const int bh = xcd * 2; mla_unit128(lds, bh >> 3, bh & 7, 31 - slot, Q16, K16, VT16, ob16, ssqb, tid); }
        { const int bh = xcd * 2 + 1; mla_unit128(lds, bh >> 3, bh & 7, slot, Q16, K16, VT16, ob16, ssqb, tid); }
    }
}
constexpr float NSA_QSCALE = 0.125f * 1.4426950408889634f;
constexpr int IMP_PITCH = 129;
__device__ __forceinline__ void fa_tile_cmp2(const unsigned char* st, const bf16x8 (&qf)[4], f32x16 (&o)[2], float mref, float linv, int key0, int qpos, int lane, float* imp_row, bool need_mask) {
    typedef FA<64> F;
    asm volatile("" : "+v"(lane));
    const int r32 = lane & 31, hi = lane >> 5;
    f32x16 s0, s1;
#pragma unroll
    for (int r = 0; r < 16; ++r) { s0[r] = 0.f; s1[r] = 0.f; }
#pragma unroll
    for (int ds = 0; ds < 4; ++ds) {
        const bf16x8 k0 = *(const bf16x8*)(st + r32 * F::KP + ds * 32 + hi * 16);
        const bf16x8 k1 = *(const bf16x8*)(st + (32 + r32) * F::KP + ds * 32 + hi * 16);
        s0 = MFMA32(k0, qf[ds], s0); s1 = MFMA32(k1, qf[ds], s1);
    }
    {
        const f32x2_t mm = {mref, mref}, ll = {linv, linv};
#pragma unroll
        for (int r = 0; r < 16; r += 2) {
            const f32x2_t d0 = f32x2_t{s0[r], s0[r + 1]} - mm, d1 = f32x2_t{s1[r], s1[r + 1]} - mm;
            const f32x2_t p0 = f32x2_t{__builtin_amdgcn_exp2f(d0.x), __builtin_amdgcn_exp2f(d0.y)} * ll, p1 = f32x2_t{__builtin_amdgcn_exp2f(d1.x), __builtin_amdgcn_exp2f(d1.y)} * ll;
            s0[r] = p0.x; s0[r + 1] = p0.y; s1[r] = p1.x; s1[r + 1] = p1.y;
        }
    }
    if (need_mask) {
#pragma unroll
        for (int r = 0; r < 16; ++r) {
            const int ka = key0 + crow(r, hi), kb = ka + 32;
            if (16 * ka + 31 > qpos) s0[r] = 0.f;
            if (16 * kb + 31 > qpos) s1[r] = 0.f;
        }
    }
    bf16x8 pk[4];
#pragma unroll
    for (int s = 0; s < 2; ++s) {
        uint4 a, b;
        a.x = cvtpk(s0[8 * s], s0[8 * s + 1]); a.y = cvtpk(s0[8 * s + 2], s0[8 * s + 3]); a.z = cvtpk(s0[8 * s + 4], s0[8 * s + 5]); a.w = cvtpk(s0[8 * s + 6], s0[8 * s + 7]);
        b.x = cvtpk(s1[8 * s], s1[8 * s + 1]); b.y = cvtpk(s1[8 * s + 2], s1[8 * s + 3]); b.z = cvtpk(s1[8 * s + 4], s1[8 * s + 5]); b.w = cvtpk(s1[8 * s + 6], s1[8 * s + 7]);
        pk[s] = __builtin_bit_cast(bf16x8, a); pk[2 + s] = __builtin_bit_cast(bf16x8, b);
    }
    const unsigned char* vt = st + F::KBYTES;
#pragma unroll
    for (int ks = 0; ks < 4; ++ks) {
        const bf16x8 v0 = *(const bf16x8*)(vt + r32 * F::VP + ks * 32 + hi * 16);
        const bf16x8 v1 = *(const bf16x8*)(vt + (32 + r32) * F::VP + ks * 32 + hi * 16);
        o[0] = MFMA32(v0, pk[ks], o[0]); o[1] = MFMA32(v1, pk[ks], o[1]);
    }
#pragma unroll
    for (int g4 = 0; g4 < 4; ++g4) {
        const float qa = quad_sum(s0[4 * g4] + s0[4 * g4 + 1] + s0[4 * g4 + 2] + s0[4 * g4 + 3]), la = quad_sum(s0[4 * g4 + 3]);
        const float qb = quad_sum(s1[4 * g4] + s1[4 * g4 + 1] + s1[4 * g4 + 2] + s1[4 * g4 + 3]), lb = quad_sum(s1[4 * g4 + 3]);
        if ((lane & 3) == 0) {
            { const int j = (key0 + 8 * g4 + 4 * hi) >> 2;
              atomicAdd(imp_row + j, qa);
              if (j + 1 < 128) atomicAdd(imp_row + j + 1, la); }
            { const int j = (key0 + 32 + 8 * g4 + 4 * hi) >> 2;
              atomicAdd(imp_row + j, qb);
              if (j + 1 < 128) atomicAdd(imp_row + j + 1, lb); }
        }
    }
}
#define NSA_STEP_(GCUR, GNEXT, Kbase, kpitch, Vbase, vpitch, t_lo, t_hi, t_, ...) do { \
        const unsigned char* st = stg + (((t_) - (t_lo)) & 1) * FA<64>::STAGE; \
        if ((t_) + 2 <= (t_hi)) fa_load<64>((Kbase) + (long)((t_) + 2) * 64 * (kpitch), (kpitch), (Vbase) + ((t_) + 2) * 64, (vpitch), GCUR, tid); \
        const int key0 = (t_) * 64; (void)key0; \
        __VA_ARGS__ \
        if ((t_) + 1 <= (t_hi)) fa_store<64>(stg + (((t_) + 1 - (t_lo)) & 1) * FA<64>::STAGE, GNEXT, tid); \
        __syncthreads(); } while (0)
#define NSA_STREAM(Kbase, kpitch, Vbase, vpitch, t_lo, t_hi, ...) do { \
    FaRegs ga_, gb_; fa_load<64>((Kbase) + (long)(t_lo) * 64 * (kpitch), (kpitch), (Vbase) + (t_lo) * 64, (vpitch), ga_, tid); \
    if ((t_lo) + 1 <= (t_hi)) fa_load<64>((Kbase) + (long)((t_lo) + 1) * 64 * (kpitch), (kpitch), (Vbase) + ((t_lo) + 1) * 64, (vpitch), gb_, tid); \
    fa_store<64>(stg, ga_, tid); __syncthreads(); \
    for (int t_ = (t_lo); t_ <= (t_hi); t_ += 2) { \
        NSA_STEP_(ga_, gb_, Kbase, kpitch, Vbase, vpitch, t_lo, t_hi, t_, __VA_ARGS__); \
        if (t_ + 1 <= (t_hi)) { const int tt_ = t_ + 1; NSA_STEP2_(gb_, ga_, Kbase, kpitch, Vbase, vpitch, t_lo, t_hi, tt_, __VA_ARGS__); } \
    } } while (0)
#define NSA_STEP2_(GCUR, GNEXT, Kbase, kpitch, Vbase, vpitch, t_lo, t_hi, tq_, ...) do { \
        const int t_ = tq_; \
        const unsigned char* st = stg + ((t_ - (t_lo)) & 1) * FA<64>::STAGE; \
        if (t_ + 2 <= (t_hi)) fa_load<64>((Kbase) + (long)(t_ + 2) * 64 * (kpitch), (kpitch), (Vbase) + (t_ + 2) * 64, (vpitch), GCUR, tid); \
        const int key0 = t_ * 64; (void)key0; \
        __VA_ARGS__ \
        if (t_ + 1 <= (t_hi)) fa_store<64>(stg + ((t_ + 1 - (t_lo)) & 1) * FA<64>::STAGE, GNEXT, tid); \
        __syncthreads(); } while (0)

__device__ __forceinline__ void nsa_unit(unsigned char* lds, int b, int g, int qblk, const unsigned short* __restrict__ Q16A, const unsigned short* __restrict__ KC16, const unsigned short* __restrict__ VCT16,
                                         const unsigned short* __restrict__ KS16, const unsigned short* __restrict__ VST16, const unsigned short* __restrict__ KW16, const unsigned short* __restrict__ VWT16,
                                         const float* __restrict__ gates, unsigned short* __restrict__ oa16, float* __restrict__ ssqa, int tid) {
    typedef FA<64> F;
    const int lane = tid & 63, wave = __builtin_amdgcn_readfirstlane(tid >> 6), r32 = lane & 31, hi = lane >> 5;
    unsigned char* stg = lds;
    float* imp = (float*)(lds + 2 * F::STAGE);
    unsigned* selm = (unsigned*)(lds + 2 * F::STAGE + 64 * IMP_PITCH * 4);
    const int q0 = qblk * 64, cur = qblk;
    const int ql = wave * 8 + (r32 >> 2), hh = g * 4 + (r32 & 3), qpos = q0 + ql; const long tok = (long)b * S_ + qpos; const int bg = b * 2 + g;
    bf16x8 qf[4];
#pragma unroll
    for (int ds = 0; ds < 4; ++ds) qf[ds] = *(const bf16x8*)(Q16A + tok * 512 + hh * 64 + ds * 16 + hi * 8);
    for (int i = tid; i < 64 * IMP_PITCH; i += 512) imp[i] = 0.f;
    f32x16 acc[2], o[2];
#pragma unroll
    for (int r = 0; r < 16; ++r) { acc[0][r] = 0.f; acc[1][r] = 0.f; }
    const int wq_lo = q0 + wave * 8, wq_hi = wq_lo + 7;
    const int nvis_max = (q0 + 63 >= 31) ? ((q0 + 63 - 31) / 16 + 1) : 0;
    if (nvis_max > 0) {
        const int tc_hi = (nvis_max - 1) >> 6;
        const unsigned short* Kc = KC16 + (long)bg * 512 * 64; const unsigned short* Vc = VCT16 + (long)bg * 64 * 512;
        float mref = FA_NEG, l = 0.f;
        NSA_STREAM(Kc, 64, Vc, 512, 0, tc_hi, {
            if (16 * key0 + 31 <= wq_hi) fa_tile<64, 4, true>(st, qf, o, mref, l, key0, qpos, lane, 16 * (key0 + 63) + 31 > wq_lo);
        });
        l = pair_sum(l);
        const float linv = (l > 0.f) ? 1.f / l : 0.f;
#pragma unroll
        for (int r = 0; r < 16; ++r) { o[0][r] = 0.f; o[1][r] = 0.f; }
        NSA_STREAM(Kc, 64, Vc, 512, 0, tc_hi, {
            if (16 * key0 + 31 <= wq_hi) fa_tile_cmp2(st, qf, o, mref, linv, key0, qpos, lane, imp + ql * IMP_PITCH, 16 * (key0 + 63) + 31 > wq_lo);
        });
        const float g_c = gates[tok * 24 + hh * 3];
#pragma unroll
        for (int r = 0; r < 16; ++r) { acc[0][r] += g_c * o[0][r]; acc[1][r] += g_c * o[1][r]; }
    } else { __syncthreads(); }
    if (wave < 2) {
        const int qi = wave * 32 + r32;
        int his = hi; asm volatile("" : "+v"(his));
#define IMPKEY(jj) ({ const int j_ = (jj); const float v_ = (j_ == 0 || j_ == cur) ? 1e9f : ((j_ > cur) ? -1e30f : imp[qi * IMP_PITCH + j_]); (ordkey(v_) & ~127u) | (127u - (unsigned)j_); })
        unsigned k0[16];
        {
            unsigned k1[16];
#pragma unroll
            for (int i = 0; i < 16; ++i) { k0[i] = IMPKEY(his * 64 + i); k1[i] = IMPKEY(his * 64 + 16 + i); }
            sort16_desc(k0); sort16_desc(k1); merge16_desc(k0, k1);
        }
        __builtin_amdgcn_sched_barrier(0);
        {
            unsigned k2[16], k3[16];
#pragma unroll
            for (int i = 0; i < 16; ++i) { k2[i] = IMPKEY(his * 64 + 32 + i); k3[i] = IMPKEY(his * 64 + 48 + i); }
            sort16_desc(k2); sort16_desc(k3); merge16_desc(k2, k3); merge16_desc(k0, k2);
        }
#undef IMPKEY
        {
            unsigned o2[16];
#pragma unroll
            for (int i = 0; i < 16; ++i) { auto rr = __builtin_amdgcn_permlane32_swap(k0[i], k0[i], false, false); k0[i] = rr[0]; o2[i] = rr[1]; }
            merge16_desc(k0, o2);
        }
        unsigned m0 = 0u, m1 = 0u, m2 = 0u, m3 = 0u;
#pragma unroll
        for (int i = 0; i < 16; ++i) {
            const unsigned j = 127u - (k0[i] & 127u); const unsigned bit = 1u << (j & 31u); const unsigned wsel = j >> 5;
            m0 |= (wsel == 0u) ? bit : 0u; m1 |= (wsel == 1u) ? bit : 0u; m2 |= (wsel == 2u) ? bit : 0u; m3 |= (wsel == 3u) ? bit : 0u;
        }
        if (hi == 0) { selm[qi * 4] = m0; selm[qi * 4 + 1] = m1; selm[qi * 4 + 2] = m2; selm[qi * 4 + 3] = m3; }
    }
    __syncthreads();
    unsigned sm0 = selm[ql * 4], sm1 = selm[ql * 4 + 1], sm2 = selm[ql * 4 + 2], sm3 = selm[ql * 4 + 3];
    {
        float mref = FA_NEG, l = 0.f;
#pragma unroll
        for (int r = 0; r < 16; ++r) { o[0][r] = 0.f; o[1][r] = 0.f; }
        const unsigned short* Ks = KS16 + (long)bg * S_ * 64; const unsigned short* Vs = VST16 + (long)bg * 64 * S_;
        NSA_STREAM(Ks, 64, Vs, S_, 0, cur, {
            const int jw = t_ >> 5; const unsigned wsel = (jw == 0) ? sm0 : ((jw == 1) ? sm1 : ((jw == 2) ? sm2 : sm3));
            const bool colsel = (wsel >> (t_ & 31)) & 1u;
            if (__any(colsel)) fa_tile<64, 3>(st, qf, o, mref, l, key0, qpos, lane, t_ == cur, colsel);
        });
        l = pair_sum(l);
        const float sc = gates[tok * 24 + hh * 3 + 1] / l;
#pragma unroll
        for (int r = 0; r < 16; ++r) { acc[0][r] += sc * o[0][r]; acc[1][r] += sc * o[1][r]; }
    }
    {
        float mref = FA_NEG, l = 0.f;
#pragma unroll
        for (int r = 0; r < 16; ++r) { o[0][r] = 0.f; o[1][r] = 0.f; }
        const unsigned short* Kw = KW16 + (long)bg * S_ * 64; const unsigned short* Vw = VWT16 + (long)bg * 64 * S_;
        const int tw_lo = (cur >= 8) ? cur - 8 : 0;
        NSA_STREAM(Kw, 64, Vw, S_, tw_lo, cur, {
            fa_tile<64, 2>(st, qf, o, mref, l, key0, qpos, lane, (t_ == cur) || (t_ == cur - 8));
        });
        l = pair_sum(l);
        const float sc = gates[tok * 24 + hh * 3 + 2] / l;
#pragma unroll
        for (int r = 0; r < 16; ++r) { acc[0][r] += sc * o[0][r]; acc[1][r] += sc * o[1][r]; }
    }
    float ss = 0.f;
#pragma unroll
    for (int dt = 0; dt < 2; ++dt)
#pragma unroll
        for (int gq = 0; gq < 4; ++gq) {
            const float v0 = acc[dt][4 * gq], v1 = acc[dt][4 * gq + 1], v2 = acc[dt][4 * gq + 2], v3 = acc[dt][4 * gq + 3];
            uint2 pk; pk.x = cvtpk(v0, v1); pk.y = cvtpk(v2, v3);
            *(uint2*)(oa16 + tok * 1024 + hh * 64 + dt * 32 + 8 * gq + 4 * hi) = pk;
            ss += v0 * v0 + v1 * v1 + v2 * v2 + v3 * v3;
        }
    ss = pair_sum(ss);
    if (hi == 0) ssqa[(long)hh * T_ + tok] = ss;
    __syncthreads();
}
__device__ __forceinline__ void nsa_phase(unsigned char* lds, const unsigned short* __restrict__ Q16A, const unsigned short* __restrict__ KC16, const unsigned short* __restrict__ VCT16,
                                          const unsigned short* __restrict__ KS16, const unsigned short* __restrict__ VST16, const unsigned short* __restrict__ KW16, const unsigned short* __restrict__ VWT16,
                                          const float* __restrict__ gates, unsigned short* __restrict__ oa16, float* __restrict__ ssqa) {
    const int tid = tid_();
    for (int i = blockIdx.x; i < 256; i += NBLK) {
        const int xcd = i & 7, slot = i >> 3; const int bg = xcd >> 1, pr = (xcd & 1) * 32 + slot;
        nsa_unit(lds, bg >> 1, bg & 1, 127 - pr, Q16A, KC16, VCT16, KS16, VST16, KW16, VWT16, gates, oa16, ssqa, tid);
        nsa_unit(lds, bg >> 1, bg & 1, pr, Q16A, KC16, VCT16, KS16, VST16, KW16, VWT16, gates, oa16, ssqa, tid);
    }
}
__device__ __forceinline__ int nmap_in2(int n) {
    if (n < 768) return n;
    if (n < 896) return n;
    if (n < 1024) return n - 896 + 1024;
    if (n < 1152) return n - 1024 + 896;
    if (n < 1280) return n;
    if (n < 1304) return n - 1280 + 1696;
    if (n < 1560) return n - 1304 + 1280;
    if (n < 1688) return n - 1560 + 1536;
    return n - 1688 + 1664;
}
struct XT { const float* src; unsigned short* dst; const float* glo; const float* ghi; int K, N, ksplit, tile, nmap; };
__device__ __forceinline__ XT xt_make(const float* src, int K, int N, unsigned short* dst, const float* glo, const float* ghi, int ksplit, int nmap, int tile) {
    XT d; d.src = src; d.dst = dst; d.glo = glo; d.ghi = ghi; d.K = K; d.N = N; d.ksplit = ksplit; d.tile = tile; d.nmap = nmap; return d;
}
__device__ __forceinline__ void xt_load(const XT& d, float (&v)[8], int tid) {
    if (d.tile < 0) return;
    const int tn = (d.N + 63) >> 6; const int k0 = (d.tile / tn) * 64, n0 = (d.tile % tn) * 64;
    const float* __restrict__ s = as_global(d.src);
#pragma unroll
    for (int i = 0; i < 8; ++i) {
        const int kl = (tid >> 6) + 8 * i, n = n0 + (tid & 63), k = k0 + kl;
        float x = (n < d.N) ? s[(long)k * d.N + n] : 0.f;
        if (d.glo) x *= (k < d.ksplit) ? d.glo[k] : d.ghi[k - d.ksplit];
        v[i] = x;
    }
}
__device__ __forceinline__ void xt_store(const XT& d, const float (&v)[8], float* buf, int tid) {
    if (d.tile < 0) return;
    float (*tl)[65] = (float (*)[65])buf;
    const int tn = (d.N + 63) >> 6; const int k0 = (d.tile / tn) * 64, n0 = (d.tile % tn) * 64;
#pragma unroll
    for (int i = 0; i < 8; ++i) tl[(tid >> 6) + 8 * i][tid & 63] = v[i];
    __syncthreads();
    const int nl = tid >> 3, kc = (tid & 7) * 8; const int n = n0 + nl;
    if (n < d.N) {
        uint4 o; o.x = cvtpk(tl[kc][nl], tl[kc + 1][nl]); o.y = cvtpk(tl[kc + 2][nl], tl[kc + 3][nl]); o.z = cvtpk(tl[kc + 4][nl], tl[kc + 5][nl]); o.w = cvtpk(tl[kc + 6][nl], tl[kc + 7][nl]);
        const int nn = d.nmap ? nmap_in2(n) : n;
        *(uint4*)(d.dst + (long)nn * d.K + k0 + kc) = o;
    }
}
#define XT_RUN4(ldsf_, MAKE) do { const int tid_x = tid_(); float xv0[8], xv1[8], xv2[8], xv3[8]; \
    const XT xd0 = MAKE(0), xd1 = MAKE(1), xd2 = MAKE(2), xd3 = MAKE(3); \
    xt_load(xd0, xv0, tid_x); xt_load(xd1, xv1, tid_x); xt_load(xd2, xv2, tid_x); xt_load(xd3, xv3, tid_x); \
    xt_store(xd0, xv0, (ldsf_), tid_x); xt_store(xd1, xv1, (ldsf_) + 64 * 65, tid_x); xt_store(xd2, xv2, (ldsf_), tid_x); xt_store(xd3, xv3, (ldsf_) + 64 * 65, tid_x); __syncthreads(); } while (0)
__device__ __forceinline__ void p0_xn_rope(const float* __restrict__ x, const float* __restrict__ g1, const int* __restrict__ positions, unsigned short* __restrict__ xn16, float* __restrict__ rope) {
    const int tid = tid_(); const int lane = tid & 63, w = __builtin_amdgcn_readfirstlane(tid >> 6);
    const f32x4_t* gp = (const f32x4_t*)g1; const f32x4_t ga0 = gp[lane * 2], ga1 = gp[lane * 2 + 1], gb0 = gp[128 + lane * 2], gb1 = gp[128 + lane * 2 + 1];
    for (int t0 = blockIdx.x * 8 + w; t0 < T_; t0 += 4 * NBLK * 8) {
        f32x4_t v[4][4]; int pos[4];
#pragma unroll
        for (int j = 0; j < 4; ++j) {
            const int t = t0 + j * NBLK * 8;
            const f32x4_t* xp = (const f32x4_t*)(x + (long)t * 1024);
            v[j][0] = xp[lane * 2]; v[j][1] = xp[lane * 2 + 1]; v[j][2] = xp[128 + lane * 2]; v[j][3] = xp[128 + lane * 2 + 1];
            pos[j] = positions[t];
        }
#pragma unroll
        for (int j = 0; j < 4; ++j) {
            const int t = t0 + j * NBLK * 8;
            const f32x4_t a0 = v[j][0], a1 = v[j][1], b0 = v[j][2], b1 = v[j][3];
            float ss = a0.x * a0.x + a0.y * a0.y + a0.z * a0.z + a0.w * a0.w + a1.x * a1.x + a1.y * a1.y + a1.z * a1.z + a1.w * a1.w
                     + b0.x * b0.x + b0.y * b0.y + b0.z * b0.z + b0.w * b0.w + b1.x * b1.x + b1.y * b1.y + b1.z * b1.z + b1.w * b1.w;
            ss = wsum(ss); const float rs = rsqrtf(ss * (1.f / 1024.f) + EPS);
            uint4 pa, pb;
            pa.x = cvtpk(a0.x * rs * ga0.x, a0.y * rs * ga0.y); pa.y = cvtpk(a0.z * rs * ga0.z, a0.w * rs * ga0.w); pa.z = cvtpk(a1.x * rs * ga1.x, a1.y * rs * ga1.y); pa.w = cvtpk(a1.z * rs * ga1.z, a1.w * rs * ga1.w);
            pb.x = cvtpk(b0.x * rs * gb0.x, b0.y * rs * gb0.y); pb.y = cvtpk(b0.z * rs * gb0.z, b0.w * rs * gb0.w); pb.z = cvtpk(b1.x * rs * gb1.x, b1.y * rs * gb1.y); pb.w = cvtpk(b1.z * rs * gb1.z, b1.w * rs * gb1.w);
            ((uint4*)(xn16 + (long)t * 1024))[lane] = pa; ((uint4*)(xn16 + (long)t * 1024))[64 + lane] = pb;
            if (lane < 24) {
                const float f = lane < 8 ? ROPE_F16[lane] : ROPE_F32[lane - 8];
                const float angf = (float)pos[j] * f;
                const double ang = (double)angf; const double k = rint(ang * 0.15915494309189535);
                const float r = (float)(ang - k * 6.283185307179586);
                const float c = cosf(r), sn = sinf(r);
                if (lane < 8) { rope[(long)t * 48 + lane] = c; rope[(long)t * 48 + 8 + lane] = sn; }
                else { rope[(long)t * 48 + 16 + lane - 8] = c; rope[(long)t * 48 + 32 + lane - 8] = sn; }
            }
        }
    }
}
__device__ __forceinline__ void p0_cbias(const float* __restrict__ pos, const float* __restrict__ w1k, const float* __restrict__ w1v, float* __restrict__ cbias) {
    const int tid = tid_(); const int lane = tid & 63, w = __builtin_amdgcn_readfirstlane(tid >> 6);
    for (int task = blockIdx.x * 8 + w; task < 512; task += NBLK * 8) {
        const int mat = task >> 8, n = task & 255; const float* w1 = mat ? w1v : w1k;
        float acc = 0.f;
#pragma unroll 8
        for (int i = 0; i < 32; ++i) { const int k = lane + 64 * i; acc += pos[k] * w1[(long)k * 256 + n]; }
        acc = wsum(acc);
        if (lane == 0) cbias[task] = acc;
    }
}
__device__ __forceinline__ void zero_stream(unsigned short* __restrict__ p, long n) {
    const int tid = tid_();
    for (long c = (long)blockIdx.x * 512 + tid; c < (n >> 3); c += (long)NBLK * 512) ((uint4*)p)[c] = make_uint4(0u, 0u, 0u, 0u);
}

struct P1Out {
    unsigned short *q16a, *ks16, *kw16, *vst16, *vwt16, *kcmp16, *vcmp16, *cq16, *ckv16;
    float *krr, *ssq_kr, *ssq_cq, *ssq_ckv, *gates;
    const float *rope, *q_gain, *ks_gain, *kw_gain, *k_gain;
};
__device__ __forceinline__ void norm_rope64(f32x16& a0, f32x16& a1, const float* __restrict__ gain, const float* __restrict__ rope_t, int hi, float outscale) {
    float ss = 0.f;
#pragma unroll
    for (int r = 0; r < 16; ++r) ss += a0[r] * a0[r] + a1[r] * a1[r];
    ss = pair_sum(ss);
    const float rs = rsqrtf(ss * (1.f / 64.f) + EPS);
#pragma unroll
    for (int g = 0; g < 4; ++g) {
        const float4 g0 = *(const float4*)(gain + 8 * g + 4 * hi), g1 = *(const float4*)(gain + 32 + 8 * g + 4 * hi);
        a0[4 * g] *= rs * g0.x; a0[4 * g + 1] *= rs * g0.y; a0[4 * g + 2] *= rs * g0.z; a0[4 * g + 3] *= rs * g0.w;
        a1[4 * g] *= rs * g1.x; a1[4 * g + 1] *= rs * g1.y; a1[4 * g + 2] *= rs * g1.z; a1[4 * g + 3] *= rs * g1.w;
    }
    const float4 c4 = *(const float4*)(rope_t + 4 * hi), s4 = *(const float4*)(rope_t + 8 + 4 * hi);
    const float cc[4] = {c4.x, c4.y, c4.z, c4.w}, sn[4] = {s4.x, s4.y, s4.z, s4.w};
#pragma unroll
    for (int j = 0; j < 4; ++j) { const float x1 = a0[j], x2 = a0[4 + j]; a0[j] = x1 * cc[j] - x2 * sn[j]; a0[4 + j] = x2 * cc[j] + x1 * sn[j]; }
#pragma unroll
    for (int r = 0; r < 16; ++r) { a0[r] *= outscale; a1[r] *= outscale; }
}
__device__ __forceinline__ void store_row64(unsigned short* __restrict__ dst, const f32x16& a0, const f32x16& a1, int hi) {
#pragma unroll
    for (int g = 0; g < 4; ++g) {
        uint2 p0, p1; p0.x = cvtpk(a0[4 * g], a0[4 * g + 1]); p0.y = cvtpk(a0[4 * g + 2], a0[4 * g + 3]); p1.x = cvtpk(a1[4 * g], a1[4 * g + 1]); p1.y = cvtpk(a1[4 * g + 2], a1[4 * g + 3]);
        *(uint2*)(dst + 8 * g + 4 * hi) = p0; *(uint2*)(dst + 32 + 8 * g + 4 * hi) = p1;
    }
}
__device__ __forceinline__ float ssq64(const f32x16& a0, const f32x16& a1) {
    float ss = 0.f;
#pragma unroll
    for (int r = 0; r < 16; ++r) ss += a0[r] * a0[r] + a1[r] * a1[r];
    return pair_sum(ss);
}
__device__ __forceinline__ float sum4fq(float v) {
    auto r1 = __builtin_amdgcn_permlane16_swap(__float_as_uint(v), __float_as_uint(v), false, false);
    return pair_sum(__uint_as_float(r1[0]) + __uint_as_float(r1[1]));
}
#define P1V(m, j) acc[ai][bj][m][n][j]
__device__ __forceinline__ void p1_inproj_256(unsigned char* lds, const unsigned short* __restrict__ xn16, const unsigned short* __restrict__ wt_in, const P1Out& Oin) {
    const P1Out O = Oin;
    const int tbase = (blockIdx.x & 7) * 56;
    for (int tile = tbase + (blockIdx.x >> 3); tile < tbase + 56; tile += 32) {
        const int mt = tile / 7, nt = tile % 7; const int m0 = mt * 256;
        f32x4_t acc[2][2][4][2];
#pragma unroll
        for (int ai = 0; ai < 2; ++ai)
#pragma unroll
            for (int bj = 0; bj < 2; ++bj)
#pragma unroll
                for (int m = 0; m < 4; ++m)
#pragma unroll
                    for (int n = 0; n < 2; ++n) acc[ai][bj][m][n] = f32x4_t{0.f, 0.f, 0.f, 0.f};
        if (nt == 4) g256::mainloop<1024>(xn16, wt_in, m0, nt * 256, (unsigned short*)lds, acc);
        else g256::mainloop<1024>(wt_in, xn16, nt * 256, m0, (unsigned short*)lds, acc);
        const int tid = tid_(); const int lane = tid & 63, wave = __builtin_amdgcn_readfirstlane(tid >> 6), wr = wave >> 2, wc = wave & 3, fr = lane & 15, fq = lane >> 4;
        if (nt == 4) {
#pragma unroll
            for (int bj = 0; bj < 2; ++bj)
#pragma unroll
                for (int n = 0; n < 2; ++n) {
                    const int pc = bj * 2 + (wc >> 1), d = (wc & 1) * 32 + n * 16 + fr;
                    unsigned short* vt = (pc < 2) ? O.vst16 : O.vwt16; const int g = pc & 1;
#pragma unroll
                    for (int ai = 0; ai < 2; ++ai)
#pragma unroll
                        for (int m = 0; m < 4; ++m) {
                            const int tb = m0 + ai * 128 + wr * 64 + m * 16 + fq * 4; const int b = tb / S_, s0 = tb % S_;
                            uint2 pk; pk.x = cvtpk(P1V(m, 0), P1V(m, 1)); pk.y = cvtpk(P1V(m, 2), P1V(m, 3));
                            *(uint2*)(vt + ((long)(b * 2 + g) * 64 + d) * S_ + vperm(s0)) = pk;
                        }
                }
        } else {
#pragma unroll
            for (int bj = 0; bj < 2; ++bj)
#pragma unroll
                for (int n = 0; n < 2; ++n) {
                    const long tok = m0 + bj * 128 + wc * 32 + n * 16 + fr; const int b = (int)(tok / S_), s = (int)(tok % S_);
                    const float* rope_t = O.rope + tok * 48;
                    const bool is_q = nt < 2, is_k = nt == 3;
                    f32x4_t rc4 = {0.f, 0.f, 0.f, 0.f}, rs4 = {0.f, 0.f, 0.f, 0.f};
                    if (is_q || is_k) { rc4 = *(const f32x4_t*)(rope_t + (fq & 1) * 4); rs4 = *(const f32x4_t*)(rope_t + 8 + (fq & 1) * 4); }
#pragma unroll
                    for (int ai = 0; ai < 2; ++ai) {
                        const int pc = ai * 2 + wr;
                        if (is_q || is_k) {
                            const float* gain = is_q ? O.q_gain : ((pc < 2) ? O.ks_gain : O.kw_gain);
                            float ss = 0.f;
#pragma unroll
                            for (int m = 0; m < 4; ++m)
#pragma unroll
                                for (int j = 0; j < 4; ++j) ss += P1V(m, j) * P1V(m, j);
                            const float rs = rsqrtf(sum4fq(ss) * (1.f / 64.f) + EPS) ;
#pragma unroll
                            for (int m = 0; m < 4; ++m) { const float4 gv = *(const float4*)(gain + m * 16 + fq * 4);
                                P1V(m, 0) *= rs * gv.x; P1V(m, 1) *= rs * gv.y; P1V(m, 2) *= rs * gv.z; P1V(m, 3) *= rs * gv.w; }
                            { const f32x4_t c4 = rc4, s4 = rs4;
                              const float cc[4] = {c4.x, c4.y, c4.z, c4.w}, sn[4] = {s4.x, s4.y, s4.z, s4.w};
#pragma unroll
                              for (int j = 0; j < 4; ++j) {
                                  auto rr = __builtin_amdgcn_permlane32_swap(__float_as_uint(P1V(0, j)), __float_as_uint(P1V(0, j)), false, false);
                                  const float x1 = __uint_as_float(rr[0]), x2 = __uint_as_float(rr[1]);
                                  P1V(0, j) = (fq < 2) ? (x1 * cc[j] - x2 * sn[j]) : (x2 * cc[j] + x1 * sn[j]);
                              } }
                            const float osc = is_q ? NSA_QSCALE : 1.f;
                            unsigned short* dst = is_q ? (O.q16a + tok * 512 + (nt * 4 + pc) * 64) : ((pc < 2 ? O.ks16 : O.kw16) + ((long)(b * 2 + (pc & 1)) * S_ + s) * 64);
#pragma unroll
                            for (int m = 0; m < 4; ++m) { uint2 pk; pk.x = cvtpk(P1V(m, 0) * osc, P1V(m, 1) * osc); pk.y = cvtpk(P1V(m, 2) * osc, P1V(m, 3) * osc); *(uint2*)(dst + m * 16 + fq * 4) = pk; }
                        } else if (nt == 2 || nt == 5 || (nt == 6 && pc < 2)) {
                            unsigned short* dst;
                            if (nt == 2) dst = (pc < 2 ? O.kcmp16 : O.vcmp16) + ((long)(b * 2 + (pc & 1)) * S_ + s) * 64;
                            else if (nt == 5) dst = O.cq16 + tok * 256 + pc * 64;
                            else dst = O.ckv16 + tok * 128 + pc * 64;
                            float ss = 0.f;
#pragma unroll
                            for (int m = 0; m < 4; ++m) { uint2 pk; pk.x = cvtpk(P1V(m, 0), P1V(m, 1)); pk.y = cvtpk(P1V(m, 2), P1V(m, 3)); *(uint2*)(dst + m * 16 + fq * 4) = pk;
#pragma unroll
                                for (int j = 0; j < 4; ++j) ss += P1V(m, j) * P1V(m, j); }
                            if (nt != 2) { ss = sum4fq(ss); if (fq == 0) { if (nt == 5) O.ssq_cq[(long)pc * T_ + tok] = ss; else O.ssq_ckv[(long)pc * T_ + tok] = ss; } }
                        } else if (nt == 6 && pc == 2) {
                            float ss = 0.f;
#pragma unroll
                            for (int m = 0; m < 2; ++m)
#pragma unroll
                                for (int j = 0; j < 4; ++j) ss += P1V(m, j) * P1V(m, j);
                            ss = sum4fq(ss);
                            if (fq == 0) O.ssq_kr[tok] = ss;
                            {
                                const float4 g0 = *(const float4*)(O.k_gain + 64 + fq * 4), g1 = *(const float4*)(O.k_gain + 80 + fq * 4);
                                const float4 c4 = *(const float4*)(rope_t + 16 + fq * 4), s4 = *(const float4*)(rope_t + 32 + fq * 4);
                                const float ga[4] = {g0.x, g0.y, g0.z, g0.w}, gb[4] = {g1.x, g1.y, g1.z, g1.w}, cc[4] = {c4.x, c4.y, c4.z, c4.w}, sn[4] = {s4.x, s4.y, s4.z, s4.w};
                                float o1[4], o2[4];
#pragma unroll
                                for (int j = 0; j < 4; ++j) { const float x1 = P1V(0, j) * ga[j], x2 = P1V(1, j) * gb[j]; o1[j] = x1 * cc[j] - x2 * sn[j]; o2[j] = x2 * cc[j] + x1 * sn[j]; }
                                *(float4*)(O.krr + tok * 32 + fq * 4) = make_float4(o1[0], o1[1], o1[2], o1[3]);
                                *(float4*)(O.krr + tok * 32 + 16 + fq * 4) = make_float4(o2[0], o2[1], o2[2], o2[3]);
                            }
                            *(float4*)(O.gates + tok * 24 + fq * 4) = make_float4(1.f / (1.f + __expf(-P1V(2, 0))), 1.f / (1.f + __expf(-P1V(2, 1))), 1.f / (1.f + __expf(-P1V(2, 2))), 1.f / (1.f + __expf(-P1V(2, 3))));
                            if (fq < 2) *(float4*)(O.gates + tok * 24 + 16 + fq * 4) = make_float4(1.f / (1.f + __expf(-P1V(3, 0))), 1.f / (1.f + __expf(-P1V(3, 1))), 1.f / (1.f + __expf(-P1V(3, 2))), 1.f / (1.f + __expf(-P1V(3, 3))));
                        }
                    }
            }
        }
        __syncthreads();
    }
}
#undef P1V

typedef GemmShape<2, 4, 2, 2> ShBig;
typedef GemmShape<4, 2, 1, 3> ShQb;
typedef GemmShape<4, 2, 1, 4> ShKvb;
struct P2Args {
    const unsigned short *cq16, *ckv16, *wt_uq, *wt_ukv, *kcmp16, *vcmp16, *w1t_k, *w1t_v;
    const float *ssq_cq, *ssq_ckv, *ssq_kr, *krr, *rope, *q_gain, *k_gain;
    unsigned short *q16, *k16, *vt16; float* hid;
};
__device__ __forceinline__ void p2_phase(unsigned char* lds, const P2Args& A) {
    const int tid = tid_(); const int lane = tid & 63, wave = __builtin_amdgcn_readfirstlane(tid >> 6), r32 = lane & 31, hi = lane >> 5;
    const int nmine = (blockIdx.x < 128) ? 4 : 5;
    for (int it = 0; it < nmine; ++it) {
        int u;
        if (blockIdx.x < 128) { if (it == 0) u = blockIdx.x; else { const int s = blockIdx.x * 3 + (it - 1); u = (s & 1) ? 640 + (s >> 1) : 128 + (s >> 1); } }
        else { const int s = 384 + (blockIdx.x - 128) * 5 + it; u = (s & 1) ? 640 + (s >> 1) : 128 + (s >> 1); }
        if (u < 128) {
            const int mat = u >> 6, mtile = (u >> 2) & 15, ks = u & 3; const int wm = wave >> 2, wn = wave & 3;
            f32x16 acc[2][2];
#pragma unroll
            for (int mi = 0; mi < 2; ++mi)
#pragma unroll
                for (int ni = 0; ni < 2; ++ni)
#pragma unroll
                    for (int r = 0; r < 16; ++r) acc[mi][ni][r] = 0.f;
            gemm_mainloop<ShBig, 3u>((mat ? A.vcmp16 : A.kcmp16) + (long)mtile * 128 * 1024 + ks * 512, 1024, (mat ? A.w1t_v : A.w1t_k) + ks * 512, 2048, 512, lds, acc, tid);
            float* slab = A.hid + (long)(mat * 4 + ks) * 2048 * 256;
#pragma unroll
            for (int mi = 0; mi < 2; ++mi) {
                const long row = mtile * 128 + wm * 64 + mi * 32 + r32;
#pragma unroll
                for (int ni = 0; ni < 2; ++ni)
#pragma unroll
                    for (int g = 0; g < 4; ++g)
                        *(float4*)(slab + row * 256 + wn * 64 + ni * 32 + 8 * g + 4 * hi) = make_float4(acc[mi][ni][4 * g], acc[mi][ni][4 * g + 1], acc[mi][ni][4 * g + 2], acc[mi][ni][4 * g + 3]);
            }
        } else if (u < 128 + 512) {
            const int v = u - 128; const int mt = v >> 2, nt = v & 3; const int m0 = mt * 128; const int wm = wave >> 1, wn = wave & 1; const int head = nt * 2 + wn;
            f32x16 acc[1][4];
#pragma unroll
            for (int ni = 0; ni < 4; ++ni)
#pragma unroll
                for (int r = 0; r < 16; ++r) acc[0][ni][r] = 0.f;
            const long tok = m0 + wm * 32 + r32;
            const float e_c0 = A.ssq_ckv[tok], e_c1 = A.ssq_ckv[(long)T_ + tok], e_kr = A.ssq_kr[tok];
            f32x4_t e_k[4];
#pragma unroll
            for (int i = 0; i < 4; ++i) e_k[i] = ((const f32x4_t*)(A.krr + tok * 32 + hi * 16))[i];
            gemm_mainloop<ShKvb, 3u>(A.ckv16 + (long)m0 * 128, 128, A.wt_ukv + (long)nt * 256 * 128, 128, 128, lds, acc, tid);
            {
                const int b = (int)(tok / S_), s = (int)(tok % S_);
                const float rc = rsqrtf((e_c0 + e_c1) * (1.f / 128.f) + EPS);
                float ss = 0.f;
#pragma unroll
                for (int r = 0; r < 16; ++r) { acc[0][0][r] *= rc; acc[0][1][r] *= rc; ss += acc[0][0][r] * acc[0][0][r] + acc[0][1][r] * acc[0][1][r]; }
                ss = pair_sum(ss) + e_kr;
                const float rk = rsqrtf(ss * (1.f / 96.f) + EPS);
#pragma unroll
                for (int g = 0; g < 4; ++g) {
                    const float4 g0 = *(const float4*)(A.k_gain + 8 * g + 4 * hi), g1 = *(const float4*)(A.k_gain + 32 + 8 * g + 4 * hi);
                    acc[0][0][4 * g] *= rk * g0.x; acc[0][0][4 * g + 1] *= rk * g0.y; acc[0][0][4 * g + 2] *= rk * g0.z; acc[0][0][4 * g + 3] *= rk * g0.w;
                    acc[0][1][4 * g] *= rk * g1.x; acc[0][1][4 * g + 1] *= rk * g1.y; acc[0][1][4 * g + 2] *= rk * g1.z; acc[0][1][4 * g + 3] *= rk * g1.w;
                }
                unsigned short* krow = A.k16 + ((long)(b * 8 + head) * S_ + s) * 96;
                store_row64(krow, acc[0][0], acc[0][1], hi);
                const f32x4_t k0 = e_k[0], k1 = e_k[1], k2 = e_k[2], k3 = e_k[3];
                uint4 o0, o1; o0.x = cvtpk(k0.x * rk, k0.y * rk); o0.y = cvtpk(k0.z * rk, k0.w * rk); o0.z = cvtpk(k1.x * rk, k1.y * rk); o0.w = cvtpk(k1.z * rk, k1.w * rk);
                o1.x = cvtpk(k2.x * rk, k2.y * rk); o1.y = cvtpk(k2.z * rk, k2.w * rk); o1.z = cvtpk(k3.x * rk, k3.y * rk); o1.w = cvtpk(k3.z * rk, k3.w * rk);
                *(uint4*)(krow + 64 + hi * 16) = o0; *(uint4*)(krow + 64 + hi * 16 + 8) = o1;
            }
            {
#pragma unroll
                for (int ni = 2; ni < 4; ++ni)
#pragma unroll
                    for (int g4 = 0; g4 < 4; ++g4) {
                        const int tb = m0 + wm * 32 + 8 * g4 + 4 * hi; const int b = tb / S_, s0 = tb % S_; const int d = (ni - 2) * 32 + r32;
                        const f32x4_t sa = *(const f32x4_t*)(A.ssq_ckv + tb), sb = *(const f32x4_t*)(A.ssq_ckv + (long)T_ + tb);
                        const float r0 = rsqrtf((sa.x + sb.x) * (1.f / 128.f) + EPS), r1 = rsqrtf((sa.y + sb.y) * (1.f / 128.f) + EPS), r2 = rsqrtf((sa.z + sb.z) * (1.f / 128.f) + EPS), r3 = rsqrtf((sa.w + sb.w) * (1.f / 128.f) + EPS);
                        uint2 pk; pk.x = cvtpk(acc[0][ni][4 * g4] * r0, acc[0][ni][4 * g4 + 1] * r1); pk.y = cvtpk(acc[0][ni][4 * g4 + 2] * r2, acc[0][ni][4 * g4 + 3] * r3);
                        *(uint2*)(A.vt16 + ((long)(b * 8 + head) * 64 + d) * S_ + vperm(s0)) = pk;
                    }
            }
        } else {
            const int v = u - 640; const int mt = v >> 2, nt = v & 3; const int m0 = mt * 128; const int wm = wave >> 1, wn = wave & 1; const int head = nt * 2 + wn;
            f32x16 acc[1][3];
#pragma unroll
            for (int ni = 0; ni < 3; ++ni)
#pragma unroll
                for (int r = 0; r < 16; ++r) acc[0][ni][r] = 0.f;
            const long tok = m0 + wm * 32 + r32;
            const float e_q0 = A.ssq_cq[tok], e_q1 = A.ssq_cq[(long)T_ + tok], e_q2 = A.ssq_cq[2L * T_ + tok], e_q3 = A.ssq_cq[3L * T_ + tok];
            const float* rope_t = A.rope + tok * 48;
            f32x4_t e_c[2], e_s[2];
#pragma unroll
            for (int g = 0; g < 2; ++g) { e_c[g] = *(const f32x4_t*)(rope_t + 16 + 8 * g + 4 * hi); e_s[g] = *(const f32x4_t*)(rope_t + 32 + 8 * g + 4 * hi); }
            gemm_mainloop<ShQb, 7u>(A.cq16 + (long)m0 * 256, 256, A.wt_uq + (long)nt * 192 * 256, 256, 256, lds, acc, tid);
            const float rc = rsqrtf((e_q0 + e_q1 + e_q2 + e_q3) * (1.f / 256.f) + EPS);
            float ss = 0.f;
#pragma unroll
            for (int ni = 0; ni < 3; ++ni)
#pragma unroll
                for (int r = 0; r < 16; ++r) { acc[0][ni][r] *= rc; ss += acc[0][ni][r] * acc[0][ni][r]; }
            ss = pair_sum(ss);
            const float rq = rsqrtf(ss * (1.f / 96.f) + EPS);
#pragma unroll
            for (int ni = 0; ni < 3; ++ni)
#pragma unroll
                for (int g = 0; g < 4; ++g) {
                    const float4 gg = *(const float4*)(A.q_gain + ni * 32 + 8 * g + 4 * hi);
                    acc[0][ni][4 * g] *= rq * gg.x; acc[0][ni][4 * g + 1] *= rq * gg.y; acc[0][ni][4 * g + 2] *= rq * gg.z; acc[0][ni][4 * g + 3] *= rq * gg.w;
                }
#pragma unroll
            for (int g = 0; g < 2; ++g) {
                const f32x4_t c4 = e_c[g], s4 = e_s[g];
                const float cc[4] = {c4.x, c4.y, c4.z, c4.w}, sn[4] = {s4.x, s4.y, s4.z, s4.w};
#pragma unroll
                for (int j = 0; j < 4; ++j) { const float x1 = acc[0][2][4 * g + j], x2 = acc[0][2][8 + 4 * g + j]; acc[0][2][4 * g + j] = x1 * cc[j] - x2 * sn[j]; acc[0][2][8 + 4 * g + j] = x2 * cc[j] + x1 * sn[j]; }
            }
            unsigned short* qrow = A.q16 + tok * 768 + head * 96;
#pragma unroll
            for (int ni = 0; ni < 3; ++ni)
#pragma unroll
                for (int g = 0; g < 4; ++g) {
                    uint2 pk; pk.x = cvtpk(acc[0][ni][4 * g] * MLA_QSCALE, acc[0][ni][4 * g + 1] * MLA_QSCALE); pk.y = cvtpk(acc[0][ni][4 * g + 2] * MLA_QSCALE, acc[0][ni][4 * g + 3] * MLA_QSCALE);
                    *(uint2*)(qrow + ni * 32 + 8 * g + 4 * hi) = pk;
                }
        }
    }
}
__device__ __forceinline__ void p3_cmp2(unsigned char* lds, const float* __restrict__ hid, const float* __restrict__ cbias, const unsigned short* __restrict__ w2t_k, const unsigned short* __restrict__ w2t_v,
                                        const float* __restrict__ kc_gain, const float* __restrict__ rope, unsigned short* __restrict__ kc16, unsigned short* __restrict__ vct16) {
    if (blockIdx.x >= 128) return;
    const int tid = tid_(); const int lane = tid & 63, w = __builtin_amdgcn_readfirstlane(tid >> 6), r32 = lane & 31, hi = lane >> 5;
    const int task = blockIdx.x; const int mat = task >> 6, rt = task & 63; const long row = rt * 32 + r32;
    const unsigned short* w2t = mat ? w2t_v : w2t_k;
    f32x16 acc[2];
#pragma unroll
    for (int r = 0; r < 16; ++r) { acc[0][r] = 0.f; acc[1][r] = 0.f; }
    f32x4_t hv[2][10]; bf16x8 wf[2][2];
#pragma unroll
    for (int s = 0; s < 2; ++s) {
        const int k0 = (w * 2 + s) * 16 + hi * 8;
        hv[s][0] = *(const f32x4_t*)(cbias + mat * 256 + k0); hv[s][1] = *(const f32x4_t*)(cbias + mat * 256 + k0 + 4);
#pragma unroll
        for (int sp = 0; sp < 4; ++sp) {
            const float* hp = hid + ((long)(mat * 4 + sp) * 2048 + row) * 256 + k0;
            hv[s][2 + 2 * sp] = *(const f32x4_t*)hp; hv[s][3 + 2 * sp] = *(const f32x4_t*)(hp + 4);
        }
        wf[s][0] = *(const bf16x8*)(w2t + (long)r32 * 256 + k0); wf[s][1] = *(const bf16x8*)(w2t + (long)(32 + r32) * 256 + k0);
    }
#pragma unroll
    for (int s = 0; s < 2; ++s) {
        f32x4_t lo = hv[s][0], up = hv[s][1];
#pragma unroll
        for (int sp = 0; sp < 4; ++sp) { lo += hv[s][2 + 2 * sp]; up += hv[s][3 + 2 * sp]; }
        uint4 pk; pk.x = cvtpk(gelu_tanh(lo.x), gelu_tanh(lo.y)); pk.y = cvtpk(gelu_tanh(lo.z), gelu_tanh(lo.w)); pk.z = cvtpk(gelu_tanh(up.x), gelu_tanh(up.y)); pk.w = cvtpk(gelu_tanh(up.z), gelu_tanh(up.w));
        const bf16x8 hf = __builtin_bit_cast(bf16x8, pk);
        acc[0] = MFMA32(wf[s][0], hf, acc[0]); acc[1] = MFMA32(wf[s][1], hf, acc[1]);
    }
    f32x4_t* red = (f32x4_t*)lds;
#pragma unroll
    for (int q = 0; q < 8; ++q) red[(w * 8 + q) * 64 + lane] = f32x4_t{acc[q >> 2][4 * (q & 3)], acc[q >> 2][4 * (q & 3) + 1], acc[q >> 2][4 * (q & 3) + 2], acc[q >> 2][4 * (q & 3) + 3]};
    __syncthreads();
    if (w != 0) return;
#pragma unroll
    for (int q = 0; q < 8; ++q) {
        f32x4_t s = red[q * 64 + lane];
#pragma unroll
        for (int ww = 1; ww < 8; ++ww) s += red[(ww * 8 + q) * 64 + lane];
        acc[q >> 2][4 * (q & 3)] = s.x; acc[q >> 2][4 * (q & 3) + 1] = s.y; acc[q >> 2][4 * (q & 3) + 2] = s.z; acc[q >> 2][4 * (q & 3) + 3] = s.w;
    }
    const int bg = (int)(row >> 9), n = (int)(row & 511); const bool valid = n < NCMP;
    if (mat == 0) {
        if (valid) {
            const long tokp = (long)(bg >> 1) * S_ + 16 * n + 31;
            norm_rope64(acc[0], acc[1], kc_gain, rope + tokp * 48, hi, 1.f);
        } else {
#pragma unroll
            for (int r = 0; r < 16; ++r) { acc[0][r] = 0.f; acc[1][r] = 0.f; }
        }
        store_row64(kc16 + row * 64, acc[0], acc[1], hi);
    } else {
#pragma unroll
        for (int ni = 0; ni < 2; ++ni)
#pragma unroll
            for (int r = 0; r < 16; ++r) {
                const float v = valid ? acc[ni][r] : 0.f;
                const float other = __uint_as_float(__builtin_amdgcn_mov_dpp(__float_as_uint(v), 0xB1, 0xF, 0xF, true));
                if ((lane & 1) == 0) *(unsigned*)(vct16 + ((long)bg * 64 + ni * 32 + crow(r, hi)) * 512 + vperm(n)) = cvtpk(v, other);
            }
    }
}

__device__ __forceinline__ void cvt_stream(const float* __restrict__ in, unsigned short* __restrict__ out, long n, int vb = blockIdx.x, int nb = NBLK) {
    const long nchunk = n >> 3;
    const int tid = tid_();
    for (long c = (long)vb * 512 + tid; c < nchunk; c += (long)nb * 512) {
        const float4 a = ((const float4*)in)[2 * c], b = ((const float4*)in)[2 * c + 1];
        uint4 o; o.x = cvtpk(a.x, a.y); o.y = cvtpk(a.z, a.w); o.z = cvtpk(b.x, b.y); o.w = cvtpk(b.z, b.w);
        ((uint4*)out)[c] = o;
    }
}


typedef unsigned u32x3 __attribute__((ext_vector_type(3)));
typedef unsigned u32x6 __attribute__((ext_vector_type(6)));
typedef float f32x32 __attribute__((ext_vector_type(32)));
constexpr int PROW = 768;
constexpr int PU_SPLIT = 12288;
template <int NR>
__device__ __forceinline__ void cvt_rows_fp6(const float* __restrict__ in, unsigned char* __restrict__ out6, float* __restrict__ scale, int rows, int vb = blockIdx.x, int nb = NBLK) {
    const int tid = tid_(); const int lane = tid & 63, w = __builtin_amdgcn_readfirstlane(tid >> 6);
    const int stride = nb * 8;
    for (int r0 = vb * 8 + w; r0 < rows; r0 += NR * stride) {
        f32x4_t v[NR][4];
#pragma unroll
        for (int j = 0; j < NR; ++j) {
            const int r = min(r0 + j * stride, rows - 1);
            const f32x4_t* p = (const f32x4_t*)(in + (long)r * 1024 + lane * 16);
#pragma unroll
            for (int i = 0; i < 4; ++i) v[j][i] = p[i];
        }
#pragma unroll
        for (int j = 0; j < NR; ++j) {
            const int r = r0 + j * stride;
            if (r < rows) {
                float m = 0.f;
#pragma unroll
                for (int i = 0; i < 4; ++i) m = fmaxf(m, fmaxf(fmaxf(fabsf(v[j][i].x), fabsf(v[j][i].y)), fmaxf(fabsf(v[j][i].z), fabsf(v[j][i].w))));
                m = wmax(m);
                const float q = (m > 0.f) ? 7.5f / m : 1.f;
                const f32x16 ve = {v[j][0].x * q, v[j][0].z * q, v[j][1].x * q, v[j][1].z * q, v[j][2].x * q, v[j][2].z * q, v[j][3].x * q, v[j][3].z * q, 0.f, 0.f, 0.f, 0.f, 0.f, 0.f, 0.f, 0.f};
                const f32x16 vo = {v[j][0].y * q, v[j][0].w * q, v[j][1].y * q, v[j][1].w * q, v[j][2].y * q, v[j][2].w * q, v[j][3].y * q, v[j][3].w * q, 0.f, 0.f, 0.f, 0.f, 0.f, 0.f, 0.f, 0.f};
                const u32x6 pk = __builtin_amdgcn_cvt_scalef32_2xpk16_fp6_f32(ve, vo, 1.0f);
                *(u32x3*)(out6 + (long)r * PROW + lane * 12) = u32x3{pk[0], pk[1], pk[2]};
                if (lane == 0) scale[r] = (m > 0.f) ? m * (1.f / 7.5f) : 1.f;
            }
        }
    }
}
__device__ __forceinline__ f32x32 dec2_fp6(const u32x3& r0, const u32x3& r1) {
    const u32x6 pk = {r0.x, r0.y, r0.z, r1.x, r1.y, r1.z};
    return __builtin_amdgcn_cvt_scalef32_pk32_f32_fp6(pk, 1.0f);
}
__device__ __forceinline__ void peer_sweep_a(const float* __restrict__ hss, const float* __restrict__ g2, const int* __restrict__ eo, const float* __restrict__ go,
                                             const unsigned char* __restrict__ U6, const float* __restrict__ su, const float* __restrict__ sv, const float* __restrict__ h, float* __restrict__ wout) {
    const int tid = tid_(); const int lane = tid & 63, w = __builtin_amdgcn_readfirstlane(tid >> 6);
    const int kcls = ((lane >> 5) & 1) * 4 + ((lane >> 4) & 1) * 2 + ((lane >> 3) & 1);
    for (int t = blockIdx.x * 8 + w; t < T_; t += NBLK * 8) {
        float x[16];
        {
            const float4* xp = (const float4*)(h + (long)t * 1024 + lane * 16); const float4* gp = (const float4*)(g2 + lane * 16); const float4* hp = (const float4*)(hss + (long)t * 16);
            const float4 s0 = hp[0], s1 = hp[1], s2 = hp[2], s3 = hp[3];
            const float rs = rsqrtf((s0.x + s0.y + s0.z + s0.w + s1.x + s1.y + s1.z + s1.w + s2.x + s2.y + s2.z + s2.w + s3.x + s3.y + s3.z + s3.w) * (1.f / 1024.f) + EPS);
#pragma unroll
            for (int k = 0; k < 4; ++k) { const float4 hv = xp[k], gv = gp[k]; x[4 * k] = hv.x * rs * gv.x; x[4 * k + 1] = hv.y * rs * gv.y; x[4 * k + 2] = hv.z * rs * gv.z; x[4 * k + 3] = hv.w * rs * gv.w; }
        }
        const int elo = eo[(long)t * 128 + lane], ehi = eo[(long)t * 128 + 64 + lane];
        const float glo = go[(long)t * 128 + lane], ghi = go[(long)t * 128 + 64 + lane];
        for (int bt = 0; bt < 16; ++bt) {
            int e[8];
#pragma unroll
            for (int k = 0; k < 8; ++k) e[k] = __builtin_amdgcn_readlane(bt < 8 ? elo : ehi, (bt * 8 + k) & 63);
            u32x3 u[8];
#pragma unroll
            for (int k = 0; k < 8; ++k) u[k] = *(const u32x3*)(U6 + (long)e[k] * PROW + lane * 12);
            const int emine = __shfl(bt < 8 ? elo : ehi, (bt * 8 + kcls) & 63);
            const float sum = su[emine], svm = sv[emine];
            const float gk = __shfl(bt < 8 ? glo : ghi, (bt * 8 + kcls) & 63);
            float a[8];
#pragma unroll
            for (int k = 0; k < 8; k += 2) {
                const f32x32 d = dec2_fp6(u[k], u[k + 1]);
                float s0 = 0.f, s1 = 0.f;
#pragma unroll
                for (int i = 0; i < 16; ++i) { s0 = fmaf(d[i], x[i], s0); s1 = fmaf(d[16 + i], x[i], s1); }
                a[k] = s0; a[k + 1] = s1;
            }
            float b4[4], c2[2], d1;
#pragma unroll
            for (int i = 0; i < 4; ++i) {
                auto rr = __builtin_amdgcn_permlane32_swap(__float_as_uint(a[i]), __float_as_uint(a[i + 4]), false, false);
                b4[i] = __uint_as_float(rr[0]) + __uint_as_float(rr[1]);
            }
#pragma unroll
            for (int i = 0; i < 2; ++i) {
                auto rr = __builtin_amdgcn_permlane16_swap(__float_as_uint(b4[i]), __float_as_uint(b4[i + 2]), false, false);
                c2[i] = __uint_as_float(rr[0]) + __uint_as_float(rr[1]);
            }
            { const bool up = (lane & 8) != 0; const float keep = up ? c2[1] : c2[0], send = up ? c2[0] : c2[1];
              d1 = keep + __uint_as_float(__builtin_amdgcn_mov_dpp(__float_as_uint(send), 0x128, 0xF, 0xF, true)); }
            d1 = quad_sum(d1);
            d1 += __uint_as_float(__builtin_amdgcn_mov_dpp(__float_as_uint(d1), 0x141, 0xF, 0xF, true));
            const float wl = gk * gelu_tanh(d1 * sum) * svm;
            if ((lane & 7) == 0) wout[(long)t * 128 + bt * 8 + kcls] = wl;
        }
    }
}
__device__ __forceinline__ void peer_sweep_b(const int* __restrict__ eo, const float* __restrict__ win, const unsigned char* __restrict__ V6, float* out) {
    const int tid = tid_(); const int lane = tid & 63, w = __builtin_amdgcn_readfirstlane(tid >> 6);
    for (int t = blockIdx.x * 8 + w; t < T_; t += NBLK * 8) {
        float y[16];
#pragma unroll
        for (int i = 0; i < 16; ++i) y[i] = 0.f;
        const int elo = eo[(long)t * 128 + lane], ehi = eo[(long)t * 128 + 64 + lane];
        const float wlo = win[(long)t * 128 + lane], whi = win[(long)t * 128 + 64 + lane];
        for (int bt = 0; bt < 16; ++bt) {
            int e[8]; float wk[8];
#pragma unroll
            for (int k = 0; k < 8; ++k) {
                e[k] = __builtin_amdgcn_readlane(bt < 8 ? elo : ehi, (bt * 8 + k) & 63);
                wk[k] = __uint_as_float(__builtin_amdgcn_readlane(__float_as_uint(bt < 8 ? wlo : whi), (bt * 8 + k) & 63));
            }
            u32x3 v[8];
#pragma unroll
            for (int k = 0; k < 8; ++k) v[k] = *(const u32x3*)(V6 + (long)e[k] * PROW + lane * 12);
#pragma unroll
            for (int k = 0; k < 8; k += 2) {
                const f32x32 d = dec2_fp6(v[k], v[k + 1]);
#pragma unroll
                for (int i = 0; i < 16; ++i) y[i] = fmaf(wk[k + 1], d[16 + i], fmaf(wk[k], d[i], y[i]));
            }
        }
        float4* o = (float4*)(out + (long)t * 1024 + lane * 16);
#pragma unroll
        for (int k = 0; k < 4; ++k) { float4 hv = o[k]; hv.x += y[4 * k]; hv.y += y[4 * k + 1]; hv.z += y[4 * k + 2]; hv.w += y[4 * k + 3]; o[k] = hv; }
    }
}

struct Params {
    const float* x; const int* positions; const float* norm1_gain; const float* w_in;
    const float *nsa_q_gain, *nsa_kc_gain, *nsa_ks_gain, *nsa_kw_gain, *cmp_pos, *cmp_k_w1, *cmp_k_w2, *cmp_v_w1, *cmp_v_w2;
    const float *mla_q_lora_gain, *mla_w_uq, *mla_kv_lora_gain, *mla_w_ukv, *mla_q_gain, *mla_k_gain, *out_gain_a, *out_gain_b, *w_out;
    const float *norm2_gain, *peer_w_q, *peer_sub_keys, *peer_u, *peer_v;
    float* out; float* W; unsigned* bar;
};
constexpr int LDS_BYTES = 64 + 256 * 528;
static_assert(LDS_BYTES >= 8 * 3200 * 4 + 64, "naive NSA phase needs 102,464 B");

typedef __attribute__((address_space(4))) const Params* cparams_t;
__device__ __forceinline__ cparams_t params_ptr() {
    cparams_t pp = (cparams_t)__builtin_amdgcn_kernarg_segment_ptr();
    asm volatile("" : "+s"(pp));
    return pp;
}
constexpr long M1 = 1 << 20;
constexpr long F_U8 = 0, F_V8 = 4 * M1, F_SU = 21 * M1 + 3 * M1 / 8, F_SV = F_SU + 16384,
               F_WTIN = 16 * M1, F_WTUQ = 17 * M1, F_WTUKV = 17 * M1 + M1 / 8, F_W1TK = 17 * M1 + M1 / 4, F_W1TV = 17 * M1 + M1 / 2, F_W2TK = 17 * M1 + 3 * M1 / 4,
               F_W2TV = F_W2TK + 8192, F_CBIAS = F_W2TV + 8192, F_WTOUT = 18 * M1, F_WTQ = 18 * M1 + M1 / 2, F_SK16 = 19 * M1 + M1 / 2,
               F_SSQCQ = 19 * M1 + 5 * M1 / 8, F_SSQCKV = F_SSQCQ + 4 * 16384, F_SSQKR = F_SSQCKV + 2 * 16384, F_SSQA = 19 * M1 + 3 * M1 / 4, F_SSQB = F_SSQA + 8 * 16384,
               F_ROPE = 20 * M1, F_GATES = 21 * M1, F_KRR = 21 * M1 + M1 / 2,
               F_XN16 = 22 * M1, F_MIX = 22 * M1,
               F_Q16A = 30 * M1, F_KS16 = 34 * M1, F_KW16 = 35 * M1, F_VST16 = 36 * M1, F_VWT16 = 37 * M1, F_KCMP16 = 38 * M1, F_VCMP16 = 39 * M1 + M1 / 8,
               F_CQ16 = 40 * M1 + M1 / 4, F_CKV16 = 42 * M1 + M1 / 4,
               F_Q16 = 43 * M1 + M1 / 2, F_K16 = 49 * M1 + M1 / 2, F_VT16 = 55 * M1 + M1 / 2, F_HID = 59 * M1 + M1 / 2, F_KC16 = 63 * M1 + M1 / 2, F_VCT16 = F_KC16 + M1 / 8,
               F_HB = 30 * M1, F_HSS = 38 * M1, F_PSS = 38 * M1 + M1 / 2, F_EO = 39 * M1, F_GO = 41 * M1, F_PQB = 43 * M1 + M1 / 2;
static_assert(F_SSQKR + 16384 <= F_SSQA && F_SSQB + 8 * 16384 <= F_ROPE && F_VCT16 + M1 / 8 <= 64 * M1 - 16384 && F_CKV16 + M1 <= F_Q16 && F_PQB + 16 * M1 <= F_HID, "workspace map");

#define G(x) (x)
__global__ __launch_bounds__(512, 2) void mega(Params p_unused) {
    extern __shared__ __attribute__((aligned(16))) unsigned char lds_raw[];
    float* ldsf = (float*)(lds_raw + 64);
    { const unsigned bid_ = blockIdx.x; __builtin_assume(bid_ < (unsigned)NBLK); }
    if (threadIdx.x == 0) *(uint4*)lds_raw = make_uint4(0u, 0u, 0u, 0u);
    __syncthreads();
    XcdBarrier bar = xcd_barrier_post(params_ptr()->bar, (volatile LAS unsigned*)lds_raw);
#define GRID_SYNC() xcd_barrier(bar)
#define U16P(off) ((unsigned short*)(W + (off)))
    { cparams_t p = params_ptr(); float* W = p->W;
      p0_xn_rope(p->x, p->norm1_gain, p->positions, U16P(F_XN16), W + F_ROPE); }
    { cparams_t p = params_ptr(); float* W = p->W;
#define P0_XT(j) ({ const int v_ = (int)blockIdx.x + NBLK * (j); \
        (v_ < 432) ? xt_make(p->w_in, 1024, INW, U16P(F_WTIN), nullptr, nullptr, 0, 2, v_) : \
        (v_ < 480) ? xt_make(p->mla_w_uq, 256, 768, U16P(F_WTUQ), p->mla_q_lora_gain, p->mla_q_lora_gain, 1 << 30, 0, v_ - 432) : \
        (v_ < 512) ? xt_make(p->mla_w_ukv, 128, 1024, U16P(F_WTUKV), p->mla_kv_lora_gain, p->mla_kv_lora_gain, 1 << 30, 0, v_ - 480) : \
        (v_ < 640) ? xt_make(p->cmp_k_w1, 2048, 256, U16P(F_W1TK), nullptr, nullptr, 0, 0, v_ - 512) : \
        (v_ < 768) ? xt_make(p->cmp_v_w1, 2048, 256, U16P(F_W1TV), nullptr, nullptr, 0, 0, v_ - 640) : \
        (v_ < 772) ? xt_make(p->cmp_k_w2, 256, 64, U16P(F_W2TK), nullptr, nullptr, 0, 0, v_ - 768) : \
        (v_ < 776) ? xt_make(p->cmp_v_w2, 256, 64, U16P(F_W2TV), nullptr, nullptr, 0, 0, v_ - 772) : xt_make(nullptr, 64, 64, nullptr, nullptr, nullptr, 0, 0, -1); })
      XT_RUN4(ldsf, P0_XT);
      zero_stream(U16P(F_WTIN) + (long)1720 * 1024, (long)72 * 1024); }
    { cparams_t p = params_ptr(); float* W = p->W;
      p0_cbias(p->cmp_pos, p->cmp_k_w1, p->cmp_v_w1, W + F_CBIAS); }
    GRID_SYNC();
    { cparams_t p = params_ptr(); float* W = p->W;
      P1Out O; O.q16a = U16P(F_Q16A); O.ks16 = U16P(F_KS16); O.kw16 = U16P(F_KW16); O.vst16 = U16P(F_VST16); O.vwt16 = U16P(F_VWT16); O.kcmp16 = U16P(F_KCMP16); O.vcmp16 = U16P(F_VCMP16);
      O.cq16 = U16P(F_CQ16); O.ckv16 = U16P(F_CKV16); O.krr = W + F_KRR; O.ssq_kr = W + F_SSQKR; O.ssq_cq = W + F_SSQCQ; O.ssq_ckv = W + F_SSQCKV; O.gates = W + F_GATES;
      O.rope = W + F_ROPE; O.q_gain = p->nsa_q_gain; O.ks_gain = p->nsa_ks_gain; O.kw_gain = p->nsa_kw_gain; O.k_gain = p->mla_k_gain;
      p1_inproj_256(lds_raw + 64, U16P(F_XN16), U16P(F_WTIN), O); }
    if ((blockIdx.x >> 3) >= 24) {
      cparams_t p = params_ptr(); float* W = p->W;
      cvt_rows_fp6<8>(p->peer_u, (unsigned char*)(W + F_U8), W + F_SU, PU_SPLIT, (int)(blockIdx.x & 7) * 8 + (int)(blockIdx.x >> 3) - 24, 64); }
    GRID_SYNC();
    { cparams_t p = params_ptr(); float* W = p->W;
      P2Args A; A.cq16 = U16P(F_CQ16); A.ckv16 = U16P(F_CKV16); A.wt_uq = U16P(F_WTUQ); A.wt_ukv = U16P(F_WTUKV); A.kcmp16 = U16P(F_KCMP16); A.vcmp16 = U16P(F_VCMP16); A.w1t_k = U16P(F_W1TK); A.w1t_v = U16P(F_W1TV);
      A.ssq_cq = W + F_SSQCQ; A.ssq_ckv = W + F_SSQCKV; A.ssq_kr = W + F_SSQKR; A.krr = W + F_KRR; A.rope = W + F_ROPE; A.q_gain = p->mla_q_gain; A.k_gain = p->mla_k_gain;
      A.q16 = U16P(F_Q16); A.k16 = U16P(F_K16); A.vt16 = U16P(F_VT16); A.hid = W + F_HID;
      p2_phase(lds_raw + 64, A); }
    GRID_SYNC();
    { const int vb = blockIdx.x, nb = NBLK;
      { cparams_t p = params_ptr(); float* W = p->W;
#define P3_XT(j) ({ const int v_ = vb + nb * (j); \
          (v_ < 256) ? xt_make(p->w_out, 1024, 1024, U16P(F_WTOUT), p->out_gain_a, p->out_gain_b, 512, 0, v_) : \
          (v_ < 768) ? xt_make(p->peer_w_q, 1024, 2048, U16P(F_WTQ), p->norm2_gain, p->norm2_gain, 1 << 30, 0, v_ - 256) : xt_make(nullptr, 64, 64, nullptr, nullptr, nullptr, 0, 0, -1); })
        XT_RUN4(ldsf, P3_XT); }
      { cparams_t p = params_ptr(); float* W = p->W;
        p3_cmp2(lds_raw + 64 + 36864, W + F_HID, W + F_CBIAS, U16P(F_W2TK), U16P(F_W2TV), p->nsa_kc_gain, W + F_ROPE, U16P(F_KC16), U16P(F_VCT16)); }
      { cparams_t p = params_ptr(); float* W = p->W;
        cvt_stream(p->peer_sub_keys, U16P(F_SK16), (long)8 * 2 * 128 * 128, vb, nb);
        cvt_rows_fp6<4>(p->peer_v, (unsigned char*)(W + F_V8), W + F_SV, 16384, vb, nb);
        cvt_rows_fp6<2>(p->peer_u + (long)PU_SPLIT * 1024, (unsigned char*)(W + F_U8) + (long)PU_SPLIT * PROW, W + F_SU + PU_SPLIT, 16384 - PU_SPLIT, vb, nb); }
    }
    GRID_SYNC();
    { cparams_t p = params_ptr(); float* W = p->W;
      nsa_phase(lds_raw + 64, U16P(F_Q16A), U16P(F_KC16), U16P(F_VCT16), U16P(F_KS16), U16P(F_VST16), U16P(F_KW16), U16P(F_VWT16), W + F_GATES, U16P(F_MIX), W + F_SSQA); }
    { cparams_t p = params_ptr(); float* W = p->W;
      mla_phase(lds_raw + 64, U16P(F_Q16), U16P(F_K16), U16P(F_VT16), U16P(F_MIX), W + F_SSQB); }
    GRID_SYNC();
    { cparams_t p = params_ptr(); float* W = p->W;
      p5_outproj_256(lds_raw + 64, U16P(F_MIX), U16P(F_WTOUT), W + F_SSQA, W + F_SSQB, p->x, p->out, U16P(F_HB), W + F_HSS); }
    GRID_SYNC();
    { cparams_t p = params_ptr(); float* W = p->W;
      p6_peerq_256(lds_raw + 64, U16P(F_HB), U16P(F_WTQ), W + F_HSS, U16P(F_PQB), W + F_PSS); }
    GRID_SYNC();
    { cparams_t p = params_ptr(); float* W = p->W;
      peer_route_mfma(lds_raw + 64, U16P(F_PQB), W + F_PSS, U16P(F_SK16), (int*)(W + F_EO), W + F_GO); }
    GRID_SYNC();
    { cparams_t p = params_ptr(); float* W = p->W;
      peer_sweep_a(W + F_HSS, p->norm2_gain, (const int*)(W + F_EO), W + F_GO, (const unsigned char*)(W + F_U8), W + F_SU, W + F_SV, p->out, W + F_PQB); }
    GRID_SYNC();
    { cparams_t p = params_ptr(); float* W = p->W;
      peer_sweep_b((const int*)(W + F_EO), W + F_PQB, (const unsigned char*)(W + F_V8), p->out); }
}

extern "C" void kernel_launch(void* const* d_in, const int* in_sizes, int n_in, void* d_out, int out_size, void* d_ws, size_t ws_size, hipStream_t stream) {
    (void)ws_size; (void)in_sizes; (void)n_in; (void)out_size;
    static int grid = 0;
    if (grid == 0) {
        int dev = 0, cus = 0, per_cu = 0;
        (void)hipGetDevice(&dev);
        (void)hipDeviceGetAttribute(&cus, hipDeviceAttributeMultiprocessorCount, dev);
        (void)hipFuncSetAttribute((const void*)mega, hipFuncAttributeMaxDynamicSharedMemorySize, LDS_BYTES);
        (void)hipOccupancyMaxActiveBlocksPerMultiprocessor(&per_cu, (const void*)mega, 512, LDS_BYTES);
        (void)hipGetLastError();
        if (per_cu < 1) fprintf(stderr, "kernel_launch: occupancy query reports %d blocks per CU\n", per_cu);
        if (cus != NBLK) fprintf(stderr, "kernel_launch: built for %d CUs, device reports %d\n", NBLK, cus);
        grid = NBLK;
    }
    Params p{};
    p.x = (const float*)d_in[0]; p.positions = (const int*)d_in[1]; p.norm1_gain = (const float*)d_in[2]; p.w_in = (const float*)d_in[3];
    p.nsa_q_gain = (const float*)d_in[4]; p.nsa_kc_gain = (const float*)d_in[5]; p.nsa_ks_gain = (const float*)d_in[6]; p.nsa_kw_gain = (const float*)d_in[7];
    p.cmp_pos = (const float*)d_in[8]; p.cmp_k_w1 = (const float*)d_in[9]; p.cmp_k_w2 = (const float*)d_in[10]; p.cmp_v_w1 = (const float*)d_in[11]; p.cmp_v_w2 = (const float*)d_in[12];
    p.mla_q_lora_gain = (const float*)d_in[13]; p.mla_w_uq = (const float*)d_in[14]; p.mla_kv_lora_gain = (const float*)d_in[15]; p.mla_w_ukv = (const float*)d_in[16];
    p.mla_q_gain = (const float*)d_in[17]; p.mla_k_gain = (const float*)d_in[18]; p.out_gain_a = (const float*)d_in[19]; p.out_gain_b = (const float*)d_in[20]; p.w_out = (const float*)d_in[21];
    p.norm2_gain = (const float*)d_in[22]; p.peer_w_q = (const float*)d_in[23]; p.peer_sub_keys = (const float*)d_in[24]; p.peer_u = (const float*)d_in[25]; p.peer_v = (const float*)d_in[26];
    p.out = (float*)d_out;
    p.bar = (unsigned*)d_ws;
    p.W = (float*)d_ws + 16384;
    (void)hipMemsetAsync(d_ws, 0, XCD_BAR_WORDS * sizeof(unsigned), stream);
    hipLaunchKernelGGL(mega, dim3(grid), dim3(512), LDS_BYTES, stream, p);
}
```

```cpp
#include <hip/hip_runtime.h>
#include <cmath>
#include <cstdint>
#include <cstdio>

#define XB_TMO      128
#define XB_XCNT(j)  (256  + 64 * (j))
#define XB_XSUB(j)  (1280 + 64 * (j))
#define XB_XGEN(j)  (2304 + 64 * (j))
#define XB_TOP      3328
#define XB_TOPGEN   3392
#define XCD_BAR_WORDS 3456
#define XB_SPIN_CAP (1u << 18)
#define LAS __attribute__((address_space(3)))

__device__ __forceinline__ unsigned xb_ld(unsigned* p)              { return __hip_atomic_load(p, __ATOMIC_RELAXED, __HIP_MEMORY_SCOPE_AGENT); }
__device__ __forceinline__ unsigned xb_add(unsigned* p, unsigned v) { return __hip_atomic_fetch_add(p, v, __ATOMIC_RELAXED, __HIP_MEMORY_SCOPE_AGENT); }
__device__ __forceinline__ unsigned xb_xcc_id() { return (unsigned)__builtin_amdgcn_s_getreg((3 << 11) | 20) & 0xFu; }
#define XB_SPIN(cond, bar) do { unsigned _sp = 0; while (cond) { __builtin_amdgcn_s_sleep(1); \
    if ((++_sp & 255u) == 0u) { if (xb_ld(&(bar)[XB_TMO])) break; if (_sp > XB_SPIN_CAP) { atomicAdd(&(bar)[XB_TMO], 1u); break; } } } } while (0)

struct XcdBarrier {
    unsigned* bar; unsigned x;
    volatile LAS unsigned* st;
};

__device__ __forceinline__ XcdBarrier xcd_barrier_post(unsigned* bar, volatile LAS unsigned* st) {
    XcdBarrier b; b.bar = bar; b.x = xb_xcc_id(); b.st = st;
    if (threadIdx.x == 0) (void)xb_add(&bar[XB_XCNT(b.x)], 1u);
    return b;
}
__device__ __forceinline__ void xcd_barrier_complete(unsigned* bar, unsigned x, unsigned& nloc, unsigned& nx) {
    const unsigned G = gridDim.x * gridDim.y * gridDim.z;
    unsigned sum, cnt, mine, sp = 0u;
    for (;;) {
        sum = 0u; cnt = 0u; mine = 0u;
#pragma unroll
        for (unsigned j = 0; j < 16; ++j) { const unsigned c = xb_ld(&bar[XB_XCNT(j)]); sum += c; cnt += (c > 0u) ? 1u : 0u; mine = (j == x) ? c : mine; }
        if (sum == G) break;
        __builtin_amdgcn_s_sleep(1);
        if ((++sp & 255u) == 0u) { if (xb_ld(&bar[XB_TMO])) break; if (sp > XB_SPIN_CAP) { atomicAdd(&bar[XB_TMO], 1u); break; } }
    }
    nloc = mine > 0u ? mine : 1u; nx = cnt > 0u ? cnt : 1u;
}

__device__ __forceinline__ void xcd_barrier(const XcdBarrier& b) {
    asm volatile("s_waitcnt vmcnt(0)" ::: "memory");
    __syncthreads();
    if (threadIdx.x == 0) {
        unsigned* bar = b.bar;
        __builtin_amdgcn_s_waitcnt(0);
        unsigned nloc = b.st[0], nx = b.st[1];
        if (nloc == 0u) { xcd_barrier_complete(bar, b.x, nloc, nx); b.st[0] = nloc; b.st[1] = nx; }
        const unsigned old = xb_add(&bar[XB_XSUB(b.x)], 1u);
        const unsigned gen = old / nloc;
        if (old + 1u == (gen + 1u) * nloc) {
            __builtin_amdgcn_fence(__ATOMIC_RELEASE, "agent");
            asm volatile("s_waitcnt vmcnt(0)" ::: "memory");
            const unsigned og = xb_add(&bar[XB_TOP], 1u);
            const unsigned tg = og / nx;
            if (og + 1u == (tg + 1u) * nx) xb_add(&bar[XB_TOPGEN], 1u);
            else XB_SPIN(xb_ld(&bar[XB_TOPGEN]) == tg, bar);
            __builtin_amdgcn_fence(__ATOMIC_ACQUIRE, "agent");
            xb_add(&bar[XB_XGEN(b.x)], 1u);
            asm volatile("s_waitcnt vmcnt(0)" ::: "memory");
        } else {
            XB_SPIN(xb_ld(&bar[XB_XGEN(b.x)]) == gen, bar);
            __builtin_amdgcn_fence(__ATOMIC_ACQUIRE, "agent");
            asm volatile("s_waitcnt vmcnt(0)" ::: "memory");
        }
    }
    __syncthreads();
}


#define AS1 __attribute__((address_space(1)))
constexpr int NBLK = 256;
constexpr int B_ = 2, S_ = 8192, T_ = B_ * S_, D_ = 1024, INW = 1720;
constexpr int G_ = 2, NCMP = 511;
constexpr float EPS = 1e-6f;
constexpr int C_Q = 0, C_KC = 512, C_VC = 640, C_KS = 768, C_VS = 896, C_KW = 1024, C_VW = 1152, C_GATE = 1280, C_CQ = 1304, C_CKV = 1560, C_KR = 1688;

#define WSYNC() do { __builtin_amdgcn_wave_barrier(); asm volatile("s_waitcnt lgkmcnt(0)" ::: "memory"); __builtin_amdgcn_wave_barrier(); } while (0)

__device__ __forceinline__ int tid_() { int t = threadIdx.x; asm volatile("" : "+v"(t)); return t; }
template <class T> __device__ __forceinline__ T* as_global(T* p) { return (T*)(__attribute__((address_space(1))) T*)p; }
__device__ __forceinline__ float wsum(float v) {
#pragma unroll
    for (int o = 32; o > 0; o >>= 1) v += __shfl_xor(v, o);
    return v;
}
__device__ __forceinline__ float wmax(float v) {
#pragma unroll
    for (int o = 32; o > 0; o >>= 1) v = fmaxf(v, __shfl_xor(v, o));
    return v;
}
__device__ __forceinline__ float gelu_tanh(float x) {
    const float u = 0.7978845608028654f * (x + 0.044715f * x * x * x);
    return 0.5f * x * (1.f + tanhf(u));
}

__device__ const float ROPE_F16[8] = {1.000000000e+00f, 1.939227432e-01f, 3.760603070e-02f, 7.292664610e-03f, 1.414213562e-03f, 2.742481884e-04f, 5.318296098e-05f, 1.031338616e-05f};
__device__ const float ROPE_F32[16] = {1.000000000e+00f, 4.403665960e-01f, 1.939227432e-01f, 8.539710194e-02f, 3.760603070e-02f, 1.656043902e-02f, 7.292664610e-03f, 3.211445874e-03f,
                                       1.414213562e-03f, 6.227723788e-04f, 2.742481884e-04f, 1.207697351e-04f, 5.318296098e-05f, 2.341999971e-05f, 1.031338616e-05f, 4.541670478e-06f};

typedef __attribute__((ext_vector_type(8))) short bf16x8;
typedef __attribute__((ext_vector_type(16))) float f32x16;
typedef __attribute__((ext_vector_type(2))) __bf16 bf16x2_t;
__device__ __forceinline__ unsigned cvtpk(float lo, float hi) { unsigned r; asm("v_cvt_pk_bf16_f32 %0, %1, %2" : "=v"(r) : "v"(lo), "v"(hi)); return r; }
__device__ __forceinline__ float bflo(unsigned u) { return __uint_as_float(u << 16); }
__device__ __forceinline__ float bfhi(unsigned u) { return __uint_as_float(u & 0xffff0000u); }
__device__ __forceinline__ float dot2bf(unsigned a, unsigned b, float c) { return __builtin_amdgcn_fdot2_f32_bf16(__builtin_bit_cast(bf16x2_t, a), __builtin_bit_cast(bf16x2_t, b), c, false); }

__device__ __forceinline__ float pair_max(float x) { auto rr = __builtin_amdgcn_permlane32_swap(__float_as_uint(x), __float_as_uint(x), false, false); return fmaxf(__uint_as_float(rr[0]), __uint_as_float(rr[1])); }
__device__ __forceinline__ float pair_sum(float x) { auto rr = __builtin_amdgcn_permlane32_swap(__float_as_uint(x), __float_as_uint(x), false, false); return __uint_as_float(rr[0]) + __uint_as_float(rr[1]); }
typedef float f32x2_t __attribute__((ext_vector_type(2)));
__device__ __forceinline__ float max3f(float a, float b, float c) { float r; asm("v_max3_f32 %0, %1, %2, %3" : "=v"(r) : "v"(a), "v"(b), "v"(c)); return r; }
__device__ __forceinline__ float quad_sum(float x) {
    float y = x + __uint_as_float(__builtin_amdgcn_mov_dpp(__float_as_uint(x), 0xB1, 0xF, 0xF, true));
    return y + __uint_as_float(__builtin_amdgcn_mov_dpp(__float_as_uint(y), 0x4E, 0xF, 0xF, true));
}
#define MFMA32(a, b, c) __builtin_amdgcn_mfma_f32_32x32x16_bf16(a, b, c, 0, 0, 0)
typedef unsigned u32x4 __attribute__((ext_vector_type(4)));
constexpr int LDS_PITCH = 144;
__device__ __forceinline__ int crow(int r, int hi) { return (r & 3) + 8 * (r >> 2) + 4 * hi; }
__device__ __forceinline__ void store_pair16(unsigned short* __restrict__ dst16, const f32x16& a, int p, int hi, float sc = 1.f) {
    unsigned ax = cvtpk(a[8 * p] * sc, a[8 * p + 1] * sc), ay = cvtpk(a[8 * p + 2] * sc, a[8 * p + 3] * sc);
    unsigned bx = cvtpk(a[8 * p + 4] * sc, a[8 * p + 5] * sc), by = cvtpk(a[8 * p + 6] * sc, a[8 * p + 7] * sc);
    { auto r = __builtin_amdgcn_permlane32_swap(ax, bx, false, false); ax = r[0]; bx = r[1]; }
    { auto r = __builtin_amdgcn_permlane32_swap(ay, by, false, false); ay = r[0]; by = r[1]; }
    *(uint4*)(dst16 + 16 * p + 8 * hi) = make_uint4(ax, ay, bx, by);
}

template <int WM_, int WN_, int MI_, int NI_>
struct GemmShape {
    static constexpr int WM = WM_, WN = WN_, MI = MI_, NI = NI_;
    static constexpr int BM = WM * MI * 32, BN = WN * NI * 32, ROWS = BM + BN;
    static constexpr int CHUNKS = ROWS * 8 / 512;
    static constexpr int STAGE_BYTES = ROWS * LDS_PITCH;
    static_assert(WM * WN == 8 && (ROWS * 8) % 512 == 0, "8 waves; whole chunks per thread");
};
template <class SH, unsigned TOKMASK, int CUR>
__device__ __forceinline__ void gemm_step(unsigned char* lds, const unsigned short* const (&gp)[SH::CHUNKS], const int (&lo)[SH::CHUNKS], u32x4 (&g)[2][SH::CHUNKS],
                                          f32x16 (&acc)[SH::MI][SH::NI], int kt, int nk, int aoff, int boff) {
    const unsigned char* st = lds + (kt & 1) * SH::STAGE_BYTES;
    if (kt + 2 < nk) {
#pragma unroll
        for (int i = 0; i < SH::CHUNKS; ++i) g[CUR][i] = *(const u32x4*)(gp[i] + (long)(kt + 2) * 64);
    }
#pragma unroll
    for (int ks = 0; ks < 4; ++ks) {
        bf16x8 af[SH::MI], bfr[SH::NI];
#pragma unroll
        for (int mi = 0; mi < SH::MI; ++mi) af[mi] = *(const bf16x8*)(st + aoff + mi * 32 * LDS_PITCH + ks * 32);
#pragma unroll
        for (int ni = 0; ni < SH::NI; ++ni) bfr[ni] = *(const bf16x8*)(st + boff + ni * 32 * LDS_PITCH + ks * 32);
#pragma unroll
        for (int mi = 0; mi < SH::MI; ++mi)
#pragma unroll
            for (int ni = 0; ni < SH::NI; ++ni)
                acc[mi][ni] = ((TOKMASK >> ni) & 1u) ? MFMA32(bfr[ni], af[mi], acc[mi][ni]) : MFMA32(af[mi], bfr[ni], acc[mi][ni]);
    }
    if (kt + 1 < nk) {
        unsigned char* sn = lds + ((kt + 1) & 1) * SH::STAGE_BYTES;
#pragma unroll
        for (int i = 0; i < SH::CHUNKS; ++i) *(u32x4*)(sn + lo[i]) = g[CUR ^ 1][i];
    }
    __syncthreads();
}
template <class SH, unsigned TOKMASK>
__device__ __forceinline__ void gemm_mainloop(const unsigned short* __restrict__ A0, long lda, const unsigned short* __restrict__ B0, long ldb, int K,
                                              unsigned char* lds, f32x16 (&acc)[SH::MI][SH::NI], int tid) {
    const int lane = tid & 63, wave = __builtin_amdgcn_readfirstlane(tid >> 6), r32 = lane & 31, hi = lane >> 5;
    const int wm = wave / SH::WN, wn = wave % SH::WN;
    const unsigned short* gp[SH::CHUNKS]; int lo[SH::CHUNKS];
#pragma unroll
    for (int i = 0; i < SH::CHUNKS; ++i) {
        const int c = tid + i * 512, row = c >> 3, kc = c & 7;
        gp[i] = (row < SH::BM) ? (A0 + (long)row * lda + kc * 8) : (B0 + (long)(row - SH::BM) * ldb + kc * 8);
        lo[i] = row * LDS_PITCH + kc * 16;
    }
    u32x4 g[2][SH::CHUNKS];
    const int nk = K >> 6;
#pragma unroll
    for (int i = 0; i < SH::CHUNKS; ++i) { g[0][i] = *(const u32x4*)gp[i]; g[1][i] = *(const u32x4*)(gp[i] + 64); }
#pragma unroll
    for (int i = 0; i < SH::CHUNKS; ++i) *(u32x4*)(lds + lo[i]) = g[0][i];
    __syncthreads();
    const int aoff = (wm * SH::MI * 32 + r32) * LDS_PITCH + hi * 16;
    const int boff = (SH::BM + wn * SH::NI * 32 + r32) * LDS_PITCH + hi * 16;
    for (int kt = 0; kt < nk; kt += 2) {
        gemm_step<SH, TOKMASK, 0>(lds, gp, lo, g, acc, kt, nk, aoff, boff);
        gemm_step<SH, TOKMASK, 1>(lds, gp, lo, g, acc, kt + 1, nk, aoff, boff);
    }
}

typedef __attribute__((ext_vector_type(4))) float f32x4_t;
namespace g256 {
constexpr int BK = 64, HALF = 128, HT = HALF * BK;
__device__ __forceinline__ int lds_byte(int r, int c) { const int st = (r >> 4) * 2 + (c >> 5), rr = r & 15, cc = c & 31, ob = rr * 64 + cc * 2; return st * 1024 + (ob ^ (((ob >> 9) & 1) << 5)); }
__device__ __forceinline__ void stage_rc(int b, int& R, int& C) { const int st = b / 1024, sb = b % 1024, swz = sb ^ (((sb >> 9) & 1) << 5); R = (st >> 1) * 16 + swz / 64; C = (st & 1) * 32 + (swz % 64) / 2; }
template <int K, int PITCH = K>
__device__ __forceinline__ void mainloop(const unsigned short* __restrict__ A, const unsigned short* __restrict__ Bt, int brow, int bcol, unsigned short* shm, f32x4_t (&acc)[2][2][4][2]) {
#define SA(b, h) (shm + ((b) * 2 + (h)) * HT)
#define SB(b, h) (shm + (4 + (b) * 2 + (h)) * HT)
#define STAGE_X(T, P, BASE, br, kt) do { const AS1 char* ub_ = (const AS1 char*)(BASE) + ((long)(br) * PITCH + (long)(kt) * BK) * 2;     \
    for (int i_ = 0; i_ < 2; ++i_) { const int b_ = (T) * 16 + i_ * 8192; int r_, c_; stage_rc(b_, r_, c_); \
      __builtin_amdgcn_global_load_lds((const AS1 unsigned*)(ub_ + (unsigned)(r_ * PITCH + c_) * 2u), (LAS unsigned*)((LAS char*)(P) + b_), 16, 0, 0); } } while (0)
#define STAGE(P, BASE, br, kt) STAGE_X(tx, P, BASE, br, kt)
#define LDA(dst, b, h) for (int m = 0; m < 4; ++m) for (int k = 0; k < 2; ++k) dst[m][k] = *reinterpret_cast<const bf16x8*>((char*)SA(b, h) + lds_byte(wr * 64 + m * 16 + fr, k * 32 + fq * 8))
#define LDB(dst, b, h) for (int n = 0; n < 2; ++n) for (int k = 0; k < 2; ++k) dst[n][k] = *reinterpret_cast<const bf16x8*>((char*)SB(b, h) + lds_byte(wc * 32 + n * 16 + fr, k * 32 + fq * 8))
#define MMA(ai, bj, At_, Bt_) do { __builtin_amdgcn_s_setprio(1); \
    for (int m = 0; m < 4; ++m) for (int n = 0; n < 2; ++n) for (int k = 0; k < 2; ++k) acc[ai][bj][m][n] = __builtin_amdgcn_mfma_f32_16x16x32_bf16(At_[m][k], Bt_[n][k], acc[ai][bj][m][n], 0, 0, 0); \
    __builtin_amdgcn_s_setprio(0); } while (0)
#define WAIT_V(n) asm volatile("s_waitcnt vmcnt(" #n ")" ::: "memory")
#define WAIT_L(n) asm volatile("s_waitcnt lgkmcnt(" #n ")" ::: "memory")
#define BAR __builtin_amdgcn_s_barrier()
#define SCHED __builtin_amdgcn_sched_barrier(0)
    int tx = threadIdx.x; asm volatile("" : "+v"(tx));
    int wid = tx >> 6, lane = tx & 63, wr = wid >> 2, wc = wid & 3, fr = lane & 15, fq = lane >> 4;
    bf16x8 At[4][2], B0[2][2], B1[2][2];
    const int nt = K / BK;
    STAGE(SB(0, 0), Bt, bcol, 0); STAGE(SA(0, 0), A, brow, 0);
    STAGE(SB(0, 1), Bt, bcol + HALF, 0); STAGE(SA(0, 1), A, brow + HALF, 0);
    if (wr == 1) BAR;
    WAIT_V(4); BAR;
    STAGE(SB(1, 0), Bt, bcol, 1); STAGE(SA(1, 0), A, brow, 1); STAGE(SB(1, 1), Bt, bcol + HALF, 1);
    WAIT_V(6); BAR;
    for (int t = 0; t < nt - 2; t += 2) {
        LDB(B0, 0, 0); SCHED; LDA(At, 0, 0); STAGE(SA(1, 1), A, brow + HALF, t + 1);
        WAIT_L(8); BAR; WAIT_L(0); MMA(0, 0, At, B0); BAR; SCHED;
        LDB(B1, 0, 1); STAGE(SB(0, 0), Bt, bcol, t + 2);
        BAR; WAIT_L(0); MMA(0, 1, At, B1); BAR;
        LDA(At, 0, 1); STAGE(SA(0, 0), A, brow, t + 2);
        BAR; WAIT_L(0); MMA(1, 0, At, B0); BAR; SCHED;
        STAGE(SB(0, 1), Bt, bcol + HALF, t + 2);
        WAIT_V(6); BAR; MMA(1, 1, At, B1); BAR;
        LDB(B0, 1, 0); SCHED; LDA(At, 1, 0); STAGE(SA(0, 1), A, brow + HALF, t + 2);
        WAIT_L(8); BAR; WAIT_L(0); MMA(0, 0, At, B0); BAR; SCHED;
        LDB(B1, 1, 1); STAGE(SB(1, 0), Bt, bcol, t + 3);
        BAR; WAIT_L(0); MMA(0, 1, At, B1); BAR;
        LDA(At, 1, 1); STAGE(SA(1, 0), A, brow, t + 3);
        BAR; WAIT_L(0); MMA(1, 0, At, B0); BAR; SCHED;
        STAGE(SB(1, 1), Bt, bcol + HALF, t + 3);
        WAIT_V(6); BAR; MMA(1, 1, At, B1); BAR;
    }
    int tz = threadIdx.x; asm volatile("" : "+v"(tz)); wid = tz >> 6; lane = tz & 63; wr = wid >> 2; wc = wid & 3; fr = lane & 15; fq = lane >> 4;
    { LDB(B0, 0, 0); WAIT_V(0); LDA(At, 0, 0); STAGE_X(tz, SA(1, 1), A, brow + HALF, nt - 1);
      BAR; WAIT_L(0); MMA(0, 0, At, B0); BAR;
      LDB(B1, 0, 1); BAR; WAIT_L(0); MMA(0, 1, At, B1); BAR;
      LDA(At, 0, 1); WAIT_V(4); BAR; WAIT_L(0); MMA(1, 0, At, B0); MMA(1, 1, At, B1); BAR; }
    { LDB(B0, 1, 0); LDA(At, 1, 0); WAIT_V(2); BAR; WAIT_L(0); MMA(0, 0, At, B0); BAR;
      LDB(B1, 1, 1); WAIT_V(0); BAR; WAIT_L(0); MMA(0, 1, At, B1); BAR;
      LDA(At, 1, 1); BAR; WAIT_L(0); MMA(1, 0, At, B0); MMA(1, 1, At, B1); BAR; }
    if (wr == 0) BAR;
#undef SA
#undef SB
#undef STAGE_X
#undef STAGE
#undef LDA
#undef LDB
#undef MMA
#undef WAIT_V
#undef WAIT_L
#undef BAR
#undef SCHED
}
}

__device__ __forceinline__ void p5_outproj_256(unsigned char* lds, const unsigned short* __restrict__ mix, const unsigned short* __restrict__ wt_out, const float* __restrict__ ssqa, const float* __restrict__ ssqb,
                                               const float* __restrict__ x, float* __restrict__ out, unsigned short* __restrict__ hb, float* __restrict__ hss) {
    const int vcu = (blockIdx.x & 7) * (NBLK / 8) + (blockIdx.x >> 3);
    for (int tile = vcu; tile < 64 * 4; tile += NBLK) {
        const int m0 = (tile >> 2) * 256, n0 = (tile & 3) * 256;
        f32x4_t acc[2][2][4][2];
#pragma unroll
        for (int ai = 0; ai < 2; ++ai)
#pragma unroll
            for (int bj = 0; bj < 2; ++bj)
#pragma unroll
                for (int m = 0; m < 4; ++m)
#pragma unroll
                    for (int n = 0; n < 2; ++n) acc[ai][bj][m][n] = f32x4_t{0.f, 0.f, 0.f, 0.f};
        g256::mainloop<512, 1024>(wt_out, mix, n0, m0, (unsigned short*)lds, acc);
        float rb[2][2];
        {
            const int tid = tid_(); const int lane = tid & 63, wave = __builtin_amdgcn_readfirstlane(tid >> 6), wc = wave & 3, fr = lane & 15;
#pragma unroll
            for (int bj = 0; bj < 2; ++bj)
#pragma unroll
                for (int n = 0; n < 2; ++n) {
                    const long tok = m0 + bj * 128 + wc * 32 + n * 16 + fr; float sa = 0.f, sb = 0.f;
#pragma unroll
                    for (int hh = 0; hh < 8; ++hh) { sa += ssqa[(long)hh * T_ + tok]; sb += ssqb[(long)hh * T_ + tok]; }
                    rb[bj][n] = rsqrtf(sb * (1.f / 512.f) + EPS); const float ratio = rsqrtf(sa * (1.f / 512.f) + EPS) / rb[bj][n];
#pragma unroll
                    for (int ai = 0; ai < 2; ++ai)
#pragma unroll
                        for (int m = 0; m < 4; ++m) acc[ai][bj][m][n] *= ratio;
                }
        }
        g256::mainloop<512, 1024>(wt_out + 512, mix + 512, n0, m0, (unsigned short*)lds, acc);
        const int tid = tid_(); const int lane = tid & 63, wave = __builtin_amdgcn_readfirstlane(tid >> 6), wr = wave >> 2, wc = wave & 3, fr = lane & 15, fq = lane >> 4;
#pragma unroll
        for (int bj = 0; bj < 2; ++bj)
#pragma unroll
            for (int n = 0; n < 2; ++n) {
                const long tok = m0 + bj * 128 + wc * 32 + n * 16 + fr; const float r = rb[bj][n];
                float ss = 0.f;
#pragma unroll
                for (int ai = 0; ai < 2; ++ai)
#pragma unroll
                    for (int m = 0; m < 4; ++m) {
                        const int nrow = n0 + ai * 128 + wr * 64 + m * 16 + fq * 4;
                        const float4 xv = *(const float4*)(x + tok * 1024 + nrow);
                        float4 hv; hv.x = xv.x + acc[ai][bj][m][n][0] * r; hv.y = xv.y + acc[ai][bj][m][n][1] * r; hv.z = xv.z + acc[ai][bj][m][n][2] * r; hv.w = xv.w + acc[ai][bj][m][n][3] * r;
                        *(float4*)(out + tok * 1024 + nrow) = hv;
                        uint2 pk; pk.x = cvtpk(hv.x, hv.y); pk.y = cvtpk(hv.z, hv.w);
                        *(uint2*)(hb + tok * 1024 + nrow) = pk;
                        ss += hv.x * hv.x + hv.y * hv.y + hv.z * hv.z + hv.w * hv.w;
                    }
                { auto r1 = __builtin_amdgcn_permlane16_swap(__float_as_uint(ss), __float_as_uint(ss), false, false); ss = __uint_as_float(r1[0]) + __uint_as_float(r1[1]); }
                ss = pair_sum(ss);
                if (fq == 0) { hss[tok * 16 + (n0 >> 8) * 4 + wr] = ss; hss[tok * 16 + (n0 >> 8) * 4 + 2 + wr] = 0.f; }
            }
        __syncthreads();
    }
}
constexpr int P6_OP = 528;
__device__ __forceinline__ void p6_peerq_256(unsigned char* lds, const unsigned short* __restrict__ hb, const unsigned short* __restrict__ wt_q, const float* __restrict__ hss,
                                             unsigned short* __restrict__ pqb, float* __restrict__ pss) {
    const int vcu = (blockIdx.x & 7) * (NBLK / 8) + (blockIdx.x >> 3);
    for (int tile = vcu; tile < 64 * 8; tile += NBLK) {
        const int m0 = (tile >> 3) * 256, n0 = (tile & 7) * 256;
        f32x4_t acc[2][2][4][2];
#pragma unroll
        for (int ai = 0; ai < 2; ++ai)
#pragma unroll
            for (int bj = 0; bj < 2; ++bj)
#pragma unroll
                for (int m = 0; m < 4; ++m)
#pragma unroll
                    for (int n = 0; n < 2; ++n) acc[ai][bj][m][n] = f32x4_t{0.f, 0.f, 0.f, 0.f};
        g256::mainloop<1024>(wt_q, hb, n0, m0, (unsigned short*)lds, acc);
        const int tid = tid_(); const int lane = tid & 63, wave = __builtin_amdgcn_readfirstlane(tid >> 6), wr = wave >> 2, wc = wave & 3, fr = lane & 15, fq = lane >> 4;
#pragma unroll
        for (int bj = 0; bj < 2; ++bj)
#pragma unroll
            for (int n = 0; n < 2; ++n) {
                const long tok = m0 + bj * 128 + wc * 32 + n * 16 + fr;
                const float4* hp = (const float4*)(hss + tok * 16);
                const float4 s0 = hp[0], s1 = hp[1], s2 = hp[2], s3 = hp[3];
                const float rs = rsqrtf((s0.x + s0.y + s0.z + s0.w + s1.x + s1.y + s1.z + s1.w + s2.x + s2.y + s2.z + s2.w + s3.x + s3.y + s3.z + s3.w) * (1.f / 1024.f) + EPS);
                float ss = 0.f;
#pragma unroll
                for (int ai = 0; ai < 2; ++ai)
#pragma unroll
                    for (int m = 0; m < 4; ++m) {
                        const int nrow = n0 + ai * 128 + wr * 64 + m * 16 + fq * 4;
                        const float v0 = acc[ai][bj][m][n][0] * rs, v1 = acc[ai][bj][m][n][1] * rs, v2 = acc[ai][bj][m][n][2] * rs, v3 = acc[ai][bj][m][n][3] * rs;
                        uint2 pk; pk.x = cvtpk(v0, v1); pk.y = cvtpk(v2, v3);
                        *(uint2*)(lds + (bj * 128 + wc * 32 + n * 16 + fr) * P6_OP + (ai * 128 + wr * 64 + m * 16 + fq * 4) * 2) = pk;
                        ss += v0 * v0 + v1 * v1 + v2 * v2 + v3 * v3;
                    }
                { auto r1 = __builtin_amdgcn_permlane16_swap(__float_as_uint(ss), __float_as_uint(ss), false, false); ss = __uint_as_float(r1[0]) + __uint_as_float(r1[1]); }
                ss = pair_sum(ss);
                if (fq == 0) { pss[tok * 32 + (n0 >> 8) * 4 + wr] = ss; pss[tok * 32 + (n0 >> 8) * 4 + 2 + wr] = 0.f; }
            }
        __syncthreads();
#pragma unroll
        for (int i = 0; i < 16; ++i) {
            const int c = tid + i * 512, row = c >> 5, cc = c & 31;
            *(uint4*)(pqb + (long)(m0 + row) * 2048 + n0 + cc * 8) = *(const uint4*)(lds + row * P6_OP + cc * 16);
        }
        __syncthreads();
    }
}

__device__ __forceinline__ unsigned ordkey(float f) { const unsigned u = __float_as_uint(f); return u ^ ((unsigned)((int)u >> 31) | 0x80000000u); }
__device__ __forceinline__ float orddec(unsigned k) { return __uint_as_float((k & 0x80000000u) ? (k & 0x7fffffffu) : ~k); }
#define CE_DESC(a, b) do { const unsigned mx_ = max(a, b), mn_ = min(a, b); a = mx_; b = mn_; } while (0)
__device__ __forceinline__ void sort16_desc(unsigned (&v)[16]) {
#define CE2(i, j) CE_DESC(v[i], v[j])
    CE2(0, 13); CE2(1, 12); CE2(2, 15); CE2(3, 14); CE2(4, 8); CE2(5, 6); CE2(7, 11); CE2(9, 10);
    CE2(0, 5); CE2(1, 7); CE2(2, 9); CE2(3, 4); CE2(6, 13); CE2(8, 14); CE2(10, 15); CE2(11, 12);
    CE2(0, 1); CE2(2, 3); CE2(4, 5); CE2(6, 8); CE2(7, 9); CE2(10, 11); CE2(12, 13); CE2(14, 15);
    CE2(0, 2); CE2(1, 3); CE2(4, 10); CE2(5, 11); CE2(6, 7); CE2(8, 9); CE2(12, 14); CE2(13, 15);
    CE2(1, 2); CE2(3, 12); CE2(4, 6); CE2(5, 7); CE2(8, 10); CE2(9, 11); CE2(13, 14);
    CE2(1, 4); CE2(2, 6); CE2(5, 8); CE2(7, 10); CE2(9, 13); CE2(11, 14);
    CE2(2, 4); CE2(3, 6); CE2(9, 12); CE2(11, 13);
    CE2(3, 5); CE2(6, 8); CE2(7, 9); CE2(10, 12);
    CE2(3, 4); CE2(5, 6); CE2(7, 8); CE2(9, 10); CE2(11, 12);
    CE2(6, 7); CE2(8, 9);
#undef CE2
}
__device__ __forceinline__ void bitonic16_desc(unsigned (&a)[16]) {
#pragma unroll
    for (int j = 8; j > 0; j >>= 1)
#pragma unroll
        for (int i = 0; i < 16; ++i) { const int l = i ^ j; if (l > i) CE_DESC(a[i], a[l]); }
}
__device__ __forceinline__ void merge16_desc(unsigned (&a)[16], const unsigned (&b)[16]) {
#pragma unroll
    for (int i = 0; i < 16; ++i) a[i] = max(a[i], b[15 - i]);
#pragma unroll
    for (int j = 8; j > 0; j >>= 1)
#pragma unroll
        for (int i = 0; i < 16; ++i) { const int l = i ^ j; if (l > i) CE_DESC(a[i], a[l]); }
}
__device__ __forceinline__ void top16_of_lanepair(unsigned (&k0)[16], unsigned (&k1)[16], unsigned (&k2)[16], unsigned (&k3)[16]) {
    sort16_desc(k0); sort16_desc(k1); sort16_desc(k2); sort16_desc(k3);
    merge16_desc(k0, k1); merge16_desc(k2, k3); merge16_desc(k0, k2);
    unsigned o[16];
#pragma unroll
    for (int i = 0; i < 16; ++i) { auto rr = __builtin_amdgcn_permlane32_swap(k0[i], k0[i], false, false); k0[i] = rr[0]; o[i] = rr[1]; }
    merge16_desc(k0, o);
}
__device__ __forceinline__ void peer_route_mfma(unsigned char* lds, const unsigned short* __restrict__ pqb, const float* __restrict__ pss, const unsigned short* __restrict__ sk16, int* __restrict__ eo, float* __restrict__ go) {
    const int tid = tid_(); const int lane = tid & 63, w = __builtin_amdgcn_readfirstlane(tid >> 6), r32 = lane & 31, hi = lane >> 5;
    const int h = blockIdx.x & 7;
    constexpr int SKP = 272;
    for (int c16 = tid; c16 < 256 * 16; c16 += 512) { const int row = c16 >> 4, ch = c16 & 15; *(uint4*)(lds + row * SKP + ch * 16) = *(const uint4*)(sk16 + ((long)h * 256 + row) * 128 + ch * 8); }
    __syncthreads();
    for (int it = 0; it < 2; ++it) {
        const long tok = (long)((blockIdx.x >> 3) * 16 + w * 2 + it) * 32 + r32;
        const float4 ps = *(const float4*)(pss + tok * 32 + h * 4);
        const float rs = rsqrtf((ps.x + ps.y + ps.z + ps.w) * (1.f / 256.f) + EPS);
        unsigned T1[16], T2[16];
#pragma unroll
        for (int c = 0; c < 2; ++c) {
            f32x16 acc[4];
#pragma unroll
            for (int mt = 0; mt < 4; ++mt)
#pragma unroll
                for (int r = 0; r < 16; ++r) acc[mt][r] = 0.f;
            const unsigned short* qrow = pqb + tok * 2048 + h * 256 + c * 128 + hi * 8;
            const unsigned char* krow = lds + (c * 128 + r32) * SKP + hi * 16;
#pragma unroll 2
            for (int ks = 0; ks < 8; ++ks) {
                const bf16x8 qf = *(const bf16x8*)(qrow + ks * 16);
#pragma unroll
                for (int mt = 0; mt < 4; ++mt) { const bf16x8 kf = *(const bf16x8*)(krow + mt * 32 * SKP + ks * 32); acc[mt] = MFMA32(kf, qf, acc[mt]); }
            }
            unsigned k0[16], k1[16], k2[16], k3[16];
#pragma unroll
            for (int r = 0; r < 16; ++r) {
                const unsigned idx = 127u - (unsigned)crow(r, hi);
                k0[r] = (ordkey(acc[0][r]) & ~127u) | idx; k1[r] = (ordkey(acc[1][r]) & ~127u) | (idx - 32u);
                k2[r] = (ordkey(acc[2][r]) & ~127u) | (idx - 64u); k3[r] = (ordkey(acc[3][r]) & ~127u) | (idx - 96u);
            }
            top16_of_lanepair(k0, k1, k2, k3);
            if (c == 0) {
#pragma unroll
                for (int i = 0; i < 16; ++i) T1[i] = k0[i];
            } else {
#pragma unroll
                for (int i = 0; i < 16; ++i) T2[i] = k0[i];
            }
        }
        float v1[16], v2[16]; unsigned p1[4] = {0u, 0u, 0u, 0u}, p2[4] = {0u, 0u, 0u, 0u};
#pragma unroll
        for (int i = 0; i < 16; ++i) {
            v1[i] = orddec(T1[i] & ~127u) * rs; v2[i] = orddec(T2[i] & ~127u) * rs;
            p1[i >> 2] |= (127u - (T1[i] & 127u)) << (8 * (i & 3)); p2[i >> 2] |= (127u - (T2[i] & 127u)) << (8 * (i & 3));
        }
        unsigned c0[16], c1[16], c2[16];
#define CAND(a, b) ((ordkey(v1[a] + v2[b]) & ~255u) | (255u - (unsigned)((a) * 16 + (b))))
        c0[0] = CAND(0, 0); c0[1] = CAND(0, 1); c0[2] = CAND(0, 2); c0[3] = CAND(0, 3); c0[4] = CAND(0, 4); c0[5] = CAND(0, 5); c0[6] = CAND(0, 6); c0[7] = CAND(0, 7);
        c0[8] = CAND(0, 8); c0[9] = CAND(0, 9); c0[10] = CAND(0, 10); c0[11] = CAND(0, 11); c0[12] = CAND(0, 12); c0[13] = CAND(0, 13); c0[14] = CAND(0, 14); c0[15] = CAND(0, 15);
        c1[0] = CAND(1, 0); c1[1] = CAND(1, 1); c1[2] = CAND(1, 2); c1[3] = CAND(1, 3); c1[4] = CAND(1, 4); c1[5] = CAND(1, 5); c1[6] = CAND(1, 6); c1[7] = CAND(1, 7);
        c1[8] = CAND(15, 0); c1[9] = CAND(14, 0); c1[10] = CAND(13, 0); c1[11] = CAND(12, 0); c1[12] = CAND(11, 0); c1[13] = CAND(10, 0); c1[14] = CAND(9, 0); c1[15] = CAND(8, 0);
        c2[0] = CAND(2, 0); c2[1] = CAND(2, 1); c2[2] = CAND(2, 2); c2[3] = CAND(2, 3); c2[4] = CAND(2, 4); c2[5] = CAND(3, 0); c2[6] = CAND(3, 1); c2[7] = CAND(3, 2);
        c2[8] = CAND(3, 3); c2[9] = CAND(4, 0); c2[10] = CAND(4, 1); c2[11] = CAND(4, 2); c2[12] = CAND(5, 0); c2[13] = CAND(5, 1); c2[14] = CAND(6, 0); c2[15] = CAND(6, 1);
        const unsigned c70 = CAND(7, 0), c71 = CAND(7, 1);
#undef CAND
        bitonic16_desc(c1); sort16_desc(c2);
        c2[15] = max(c2[15], c70); c2[14] = max(c2[14], c71); bitonic16_desc(c2);
        merge16_desc(c0, c1); merge16_desc(c0, c2);
        float ev[16]; int ee[16]; float l = 0.f; const float mx = orddec(c0[0] & ~255u);
#pragma unroll
        for (int i = 0; i < 16; ++i) {
            const unsigned ci = 255u - (c0[i] & 255u); const unsigned a = ci >> 4, b = ci & 15u;
            const unsigned wa = (a >> 2) == 0 ? p1[0] : ((a >> 2) == 1 ? p1[1] : ((a >> 2) == 2 ? p1[2] : p1[3]));
            const unsigned wb = (b >> 2) == 0 ? p2[0] : ((b >> 2) == 1 ? p2[1] : ((b >> 2) == 2 ? p2[2] : p2[3]));
            const unsigned i1 = (wa >> (8 * (a & 3u))) & 255u, i2 = (wb >> (8 * (b & 3u))) & 255u;
            ee[i] = (int)(i1 * 128u + i2);
            ev[i] = __expf(orddec(c0[i] & ~255u) - mx); l += ev[i];
        }
        const float inv = 1.f / l;
        if (hi == 0) {
            int4* ep = (int4*)(eo + tok * 128 + h * 16);
            ep[0] = make_int4(ee[0], ee[1], ee[2], ee[3]); ep[1] = make_int4(ee[4], ee[5], ee[6], ee[7]); ep[2] = make_int4(ee[8], ee[9], ee[10], ee[11]); ep[3] = make_int4(ee[12], ee[13], ee[14], ee[15]);
        } else {
            float4* gp = (float4*)(go + tok * 128 + h * 16);
            gp[0] = make_float4(ev[0] * inv, ev[1] * inv, ev[2] * inv, ev[3] * inv); gp[1] = make_float4(ev[4] * inv, ev[5] * inv, ev[6] * inv, ev[7] * inv);
            gp[2] = make_float4(ev[8] * inv, ev[9] * inv, ev[10] * inv, ev[11] * inv); gp[3] = make_float4(ev[12] * inv, ev[13] * inv, ev[14] * inv, ev[15] * inv);
        }
    }
}

template <int DQK>
struct FA {
    static constexpr int NDS = DQK / 16, KP = DQK * 2 + 16, KBYTES = 64 * KP, VP = 144, VBYTES = 64 * VP, STAGE = KBYTES + VBYTES;
    static constexpr int KCH = 64 * DQK / 8, NCH = KCH + 512, SLOTS = (NCH + 511) / 512;
};
constexpr float FA_THR = 8.f;
constexpr float FA_NEG = -1e30f;
struct FaRegs { uint4 g0, g1, g2; };
template <int DQK>
__device__ __forceinline__ uint4 fa_load1(const unsigned short* __restrict__ Kg, int kpitch, const unsigned short* __restrict__ Vg, int vpitch, int tid, int i) {
    int c = tid + i * 512; if (c >= FA<DQK>::NCH) c = 0;
    const int key = c / (DQK / 8), kc = c % (DQK / 8); const int c2 = c - FA<DQK>::KCH; const int d = c2 >> 3, vc = c2 & 7;
    const unsigned koff = (unsigned)(key * kpitch + kc * 8) * 2u, voff = (unsigned)(d * vpitch + vc * 8) * 2u;
#if defined(__HIP_DEVICE_COMPILE__)
    typedef unsigned u32x4_t __attribute__((ext_vector_type(4)));
    const u32x4_t v = (c < FA<DQK>::KCH) ? *(const AS1 u32x4_t*)((const AS1 char*)Kg + koff) : *(const AS1 u32x4_t*)((const AS1 char*)Vg + voff);
    return make_uint4(v.x, v.y, v.z, v.w);
#else
    (void)koff; (void)voff; return make_uint4(0u, 0u, 0u, 0u);
#endif
}
template <int DQK>
__device__ __forceinline__ void fa_store1(unsigned char* st, const uint4& g, int tid, int i) {
    const int c = tid + i * 512;
    const int key = c / (DQK / 8), kc = c % (DQK / 8); const int c2 = c - FA<DQK>::KCH; const int d = c2 >> 3, vc = c2 & 7;
    const int off = (c < FA<DQK>::KCH) ? (key * FA<DQK>::KP + kc * 16) : (FA<DQK>::KBYTES + d * FA<DQK>::VP + vc * 16);
    if (c < FA<DQK>::NCH) *(uint4*)(st + off) = g;
}
template <int DQK>
__device__ __forceinline__ void fa_load(const unsigned short* __restrict__ Kg, int kpitch, const unsigned short* __restrict__ Vg, int vpitch, FaRegs& g, int tid) {
    g.g0 = fa_load1<DQK>(Kg, kpitch, Vg, vpitch, tid, 0); g.g1 = fa_load1<DQK>(Kg, kpitch, Vg, vpitch, tid, 1);
    if (FA<DQK>::SLOTS > 2) g.g2 = fa_load1<DQK>(Kg, kpitch, Vg, vpitch, tid, 2);
}
template <int DQK>
__device__ __forceinline__ void fa_store(unsigned char* st, const FaRegs& g, int tid) {
    fa_store1<DQK>(st, g.g0, tid, 0); fa_store1<DQK>(st, g.g1, tid, 1);
    if (FA<DQK>::SLOTS > 2) fa_store1<DQK>(st, g.g2, tid, 2);
}
template <int DQK, int MODE, bool STATS_ONLY = false>
__device__ __forceinline__ void fa_tile(const unsigned char* st, const bf16x8 (&qf)[FA<DQK>::NDS], f32x16 (&o)[2], float& mref, float& l, int key0, int qpos, int lane, bool need_mask, bool colsel = true) {
    asm volatile("" : "+v"(lane));
    const int r32 = lane & 31, hi = lane >> 5;
    f32x16 s0, s1;
#pragma unroll
    for (int r = 0; r < 16; ++r) { s0[r] = 0.f; s1[r] = 0.f; }
    {
        bf16x8 k0 = *(const bf16x8*)(st + r32 * FA<DQK>::KP + hi * 16);
        bf16x8 k1 = *(const bf16x8*)(st + (32 + r32) * FA<DQK>::KP + hi * 16);
#pragma unroll
        for (int ds = 0; ds < FA<DQK>::NDS; ++ds) {
            bf16x8 n0 = k0, n1 = k1;
            if (ds + 1 < FA<DQK>::NDS) {
                n0 = *(const bf16x8*)(st + r32 * FA<DQK>::KP + (ds + 1) * 32 + hi * 16);
                n1 = *(const bf16x8*)(st + (32 + r32) * FA<DQK>::KP + (ds + 1) * 32 + hi * 16);
            }
            s0 = MFMA32(k0, qf[ds], s0); s1 = MFMA32(k1, qf[ds], s1);
            k0 = n0; k1 = n1;
            __builtin_amdgcn_sched_barrier(0);
        }
    }
    __builtin_amdgcn_sched_barrier(0);
    if (MODE != 0 && need_mask) {
#pragma unroll
        for (int r = 0; r < 16; ++r) {
            const int ka = key0 + crow(r, hi), kb = ka + 32;
            bool ma, mb;
            if (MODE == 4) { ma = 16 * ka + 31 > qpos; mb = 16 * kb + 31 > qpos; }
            else { ma = ka > qpos; mb = kb > qpos; }
            if (MODE == 2) { ma = ma || (ka <= qpos - 512); mb = mb || (kb <= qpos - 512); }
            if (ma) s0[r] = -INFINITY;
            if (mb) s1[r] = -INFINITY;
        }
    }
    float mxa = max3f(s0[0], s0[1], s0[2]), mxb = max3f(s1[0], s1[1], s1[2]);
#pragma unroll
    for (int r = 3; r < 15; r += 2) { mxa = max3f(mxa, s0[r], s0[r + 1]); mxb = max3f(mxb, s1[r], s1[r + 1]); }
    float mx = max3f(mxa, mxb, fmaxf(s0[15], s1[15]));
    if (MODE == 3) mx = colsel ? mx : -INFINITY;
    mx = pair_max(mx);
    if (__any(mx > mref + FA_THR)) {
        const float mnew = (mx > mref + FA_THR) ? mx : mref;
        const float alpha = __builtin_amdgcn_exp2f(mref - mnew);
        mref = mnew; l *= alpha;
#pragma unroll
        for (int r = 0; r < 16; ++r) { o[0][r] *= alpha; o[1][r] *= alpha; }
    }
    const float mre = (MODE == 3) ? (colsel ? mref : INFINITY) : mref;
    const f32x2_t mm = {mre, mre};
    f32x2_t ps0 = {0.f, 0.f}, ps1 = {0.f, 0.f};
#pragma unroll
    for (int r = 0; r < 16; r += 2) {
        const f32x2_t d0 = f32x2_t{s0[r], s0[r + 1]} - mm, d1 = f32x2_t{s1[r], s1[r + 1]} - mm;
        s0[r] = __builtin_amdgcn_exp2f(d0.x); s0[r + 1] = __builtin_amdgcn_exp2f(d0.y); s1[r] = __builtin_amdgcn_exp2f(d1.x); s1[r + 1] = __builtin_amdgcn_exp2f(d1.y);
        ps0 += f32x2_t{s0[r], s0[r + 1]}; ps1 += f32x2_t{s1[r], s1[r + 1]};
    }
    ps0 += ps1;
    l += ps0.x + ps0.y;
    if (STATS_ONLY) return;
    bf16x8 pk[4];
#pragma unroll
    for (int s = 0; s < 2; ++s) {
        uint4 a, b;
        a.x = cvtpk(s0[8 * s], s0[8 * s + 1]); a.y = cvtpk(s0[8 * s + 2], s0[8 * s + 3]); a.z = cvtpk(s0[8 * s + 4], s0[8 * s + 5]); a.w = cvtpk(s0[8 * s + 6], s0[8 * s + 7]);
        b.x = cvtpk(s1[8 * s], s1[8 * s + 1]); b.y = cvtpk(s1[8 * s + 2], s1[8 * s + 3]); b.z = cvtpk(s1[8 * s + 4], s1[8 * s + 5]); b.w = cvtpk(s1[8 * s + 6], s1[8 * s + 7]);
        pk[s] = __builtin_bit_cast(bf16x8, a); pk[2 + s] = __builtin_bit_cast(bf16x8, b);
    }
    const unsigned char* vt = st + FA<DQK>::KBYTES;
    __builtin_amdgcn_sched_barrier(0);
    {
        bf16x8 v0 = *(const bf16x8*)(vt + r32 * FA<DQK>::VP + hi * 16);
        bf16x8 v1 = *(const bf16x8*)(vt + (32 + r32) * FA<DQK>::VP + hi * 16);
#pragma unroll
        for (int ks = 0; ks < 4; ++ks) {
            bf16x8 n0 = v0, n1 = v1;
            if (ks + 1 < 4) {
                n0 = *(const bf16x8*)(vt + r32 * FA<DQK>::VP + (ks + 1) * 32 + hi * 16);
                n1 = *(const bf16x8*)(vt + (32 + r32) * FA<DQK>::VP + (ks + 1) * 32 + hi * 16);
            }
            o[0] = MFMA32(v0, pk[ks], o[0]); o[1] = MFMA32(v1, pk[ks], o[1]);
            v0 = n0; v1 = n1;
            __builtin_amdgcn_sched_barrier(0);
        }
    }
}
__device__ __forceinline__ int vperm(int s) { const int g = (s >> 2) & 3; const int pg = (g == 1) ? 2 : ((g == 2) ? 1 : g); return (s & ~15) | (pg << 2) | (s & 3); }

constexpr float MLA_QSCALE = 0.10206207261596575f * 1.4426950408889634f;
namespace m128 {
constexpr int KP = 208, VP = 272, KBYTES = 128 * KP, VBYTES = 64 * VP, STAGE = KBYTES + VBYTES;
struct Regs { u32x4 g[5]; };
__device__ __forceinline__ void load(const unsigned short* __restrict__ Kg, const unsigned short* __restrict__ Vg, Regs& R, int tid) {
#pragma unroll
    for (int i = 0; i < 5; ++i) {
        const int c = tid + i * 512;
        if (i < 3) { const int key = c / 12, kc = c % 12; R.g[i] = *(const AS1 u32x4*)((const AS1 char*)Kg + (unsigned)(key * 96 + kc * 8) * 2u); }
        else { const int c2 = c - 1536; const int d = c2 >> 4, vc = c2 & 15; R.g[i] = *(const AS1 u32x4*)((const AS1 char*)Vg + (unsigned)(d * S_ + vc * 8) * 2u); }
    }
}
__device__ __forceinline__ void store(unsigned char* st, const Regs& R, int tid) {
#pragma unroll
    for (int i = 0; i < 5; ++i) {
        const int c = tid + i * 512;
        if (i < 3) { const int key = c / 12, kc = c % 12; *(u32x4*)(st + key * KP + kc * 16) = R.g[i]; }
        else { const int c2 = c - 1536; const int d = c2 >> 4, vc = c2 & 15; *(u32x4*)(st + KBYTES + d * VP + vc * 16) = R.g[i]; }
    }
}
__device__ __forceinline__ void tile(const unsigned char* st, const bf16x8 (&qf)[6], f32x16 (&o)[2], float& mref, float& l, int key0, int qpos, int lane, bool need_mask) {
    asm volatile("" : "+v"(lane));
    const int r32 = lane & 31, hi = lane >> 5;
    f32x16 s[4];
#pragma unroll
    for (int kb = 0; kb < 4; ++kb)
#pragma unroll
        for (int r = 0; r < 16; ++r) s[kb][r] = 0.f;
#pragma unroll
    for (int half = 0; half < 2; ++half) {
        const unsigned char* kb0 = st + ((2 * half) * 32 + r32) * KP + hi * 16, * kb1 = kb0 + 32 * KP;
        bf16x8 k0 = *(const bf16x8*)kb0, k1 = *(const bf16x8*)kb1;
#pragma unroll
        for (int ds = 0; ds < 6; ++ds) {
            bf16x8 n0 = k0, n1 = k1;
            if (ds + 1 < 6) { n0 = *(const bf16x8*)(kb0 + (ds + 1) * 32); n1 = *(const bf16x8*)(kb1 + (ds + 1) * 32); }
            s[2 * half] = MFMA32(k0, qf[ds], s[2 * half]); s[2 * half + 1] = MFMA32(k1, qf[ds], s[2 * half + 1]);
            k0 = n0; k1 = n1;
            __builtin_amdgcn_sched_barrier(0);
        }
    }
    if (need_mask) {
#pragma unroll
        for (int kb = 0; kb < 4; ++kb)
#pragma unroll
            for (int r = 0; r < 16; ++r) if (key0 + kb * 32 + crow(r, hi) > qpos) s[kb][r] = -INFINITY;
    }
    float mxa = max3f(s[0][0], s[0][1], s[0][2]), mxb = max3f(s[1][0], s[1][1], s[1][2]), mxc = max3f(s[2][0], s[2][1], s[2][2]), mxd = max3f(s[3][0], s[3][1], s[3][2]);
#pragma unroll
    for (int r = 3; r < 15; r += 2) { mxa = max3f(mxa, s[0][r], s[0][r + 1]); mxb = max3f(mxb, s[1][r], s[1][r + 1]); mxc = max3f(mxc, s[2][r], s[2][r + 1]); mxd = max3f(mxd, s[3][r], s[3][r + 1]); }
    float mx = max3f(max3f(mxa, mxb, s[0][15]), max3f(mxc, mxd, s[1][15]), fmaxf(s[2][15], s[3][15]));
    mx = pair_max(mx);
    if (__any(mx > mref + FA_THR)) {
        const float mnew = (mx > mref + FA_THR) ? mx : mref;
        const float alpha = __builtin_amdgcn_exp2f(mref - mnew);
        mref = mnew; l *= alpha;
#pragma unroll
        for (int r = 0; r < 16; ++r) { o[0][r] *= alpha; o[1][r] *= alpha; }
    }
    const f32x2_t mm = {mref, mref};
    f32x2_t ps0 = {0.f, 0.f}, ps1 = {0.f, 0.f};
    bf16x8 pk[8];
#pragma unroll
    for (int kb = 0; kb < 4; ++kb) {
        unsigned pw[8];
#pragma unroll
        for (int r = 0; r < 16; r += 2) {
            const f32x2_t d = f32x2_t{s[kb][r], s[kb][r + 1]} - mm;
            const f32x2_t e = {__builtin_amdgcn_exp2f(d.x), __builtin_amdgcn_exp2f(d.y)};
            if (r & 2) ps1 += e; else ps0 += e;
            pw[r >> 1] = cvtpk(e.x, e.y);
        }
        pk[2 * kb] = __builtin_bit_cast(bf16x8, u32x4{pw[0], pw[1], pw[2], pw[3]});
        pk[2 * kb + 1] = __builtin_bit_cast(bf16x8, u32x4{pw[4], pw[5], pw[6], pw[7]});
    }
    ps0 += ps1; l += ps0.x + ps0.y;
    const unsigned char* vt = st + KBYTES + r32 * VP + hi * 16;
    __builtin_amdgcn_sched_barrier(0);
    {
        bf16x8 v0 = *(const bf16x8*)vt, v1 = *(const bf16x8*)(vt + 32 * VP);
#pragma unroll
        for (int ks = 0; ks < 8; ++ks) {
            bf16x8 n0 = v0, n1 = v1;
            if (ks + 1 < 8) { n0 = *(const bf16x8*)(vt + (ks + 1) * 32); n1 = *(const bf16x8*)(vt + 32 * VP + (ks + 1) * 32); }
            o[0] = MFMA32(v0, pk[ks], o[0]); o[1] = MFMA32(v1, pk[ks], o[1]);
            v0 = n0; v1 = n1;
            __builtin_amdgcn_sched_barrier(0);
        }
    }
}
}
__device__ __forceinline__ void mla_unit128(unsigned char* lds, int b, int h, int qb, const unsigned short* __restrict__ Q16, const unsigned short* __restrict__ K16, const unsigned short* __restrict__ VT16,
                                            unsigned short* __restrict__ ob16, float* __restrict__ ssqb, int tid) {
    const int lane = tid & 63, wave = __builtin_amdgcn_readfirstlane(tid >> 6), r32 = lane & 31, hi = lane >> 5;
    const int q0 = qb * 256, qpos = q0 + wave * 32 + r32; const long tok = (long)b * S_ + qpos;
    bf16x8 qf[6];
#pragma unroll
    for (int ds = 0; ds < 6; ++ds) qf[ds] = *(const bf16x8*)(Q16 + tok * 768 + h * 96 + ds * 16 + hi * 8);
    f32x16 o[2];
#pragma unroll
    for (int r = 0; r < 16; ++r) { o[0][r] = 0.f; o[1][r] = 0.f; }
    float mref = FA_NEG, l = 0.f;
    const unsigned short* Kb = K16 + ((long)(b * 8 + h)) * S_ * 96;
    const unsigned short* Vb = VT16 + ((long)(b * 8 + h)) * 64 * S_;
    const int nt = (q0 + 256) / 128;
    m128::Regs g;
    m128::load(Kb, Vb, g, tid); m128::store(lds, g, tid);
    m128::load(Kb + (long)128 * 96, Vb + 128, g, tid);
    __syncthreads();
    const int wmin = q0 + wave * 32, wmax = wmin + 31;
    int sc = 0;
    for (int t = 0; t < nt; ++t) {
        const int sn = (sc == 2) ? 0 : sc + 1;
        const int key0 = t * 128;
        if (key0 <= wmax) m128::tile(lds + sc * m128::STAGE, qf, o, mref, l, key0, qpos, lane, key0 + 127 > wmin);
        if (t + 1 < nt) m128::store(lds + sn * m128::STAGE, g, tid);
        if (t + 2 < nt) m128::load(Kb + (long)(t + 2) * 128 * 96, Vb + (t + 2) * 128, g, tid);
        __syncthreads();
        sc = sn;
    }
    l = pair_sum(l);
    const float inv = 1.f / l;
    float ss = 0.f;
#pragma unroll
    for (int dt = 0; dt < 2; ++dt) {
#pragma unroll
        for (int r = 0; r < 16; ++r) { const float v = o[dt][r] * inv; ss += v * v; }
#pragma unroll
        for (int p = 0; p < 2; ++p) store_pair16(ob16 + tok * 1024 + 512 + h * 64 + dt * 32, o[dt], p, hi, inv);
    }
    ss = pair_sum(ss);
    if (hi == 0) ssqb[(long)h * T_ + tok] = ss;
}
__device__ __forceinline__ void mla_phase(unsigned char* lds, const unsigned short* __restrict__ Q16, const unsigned short* __restrict__ K16, const unsigned short* __restrict__ VT16,
                                          unsigned short* __restrict__ ob16, float* __restrict__ ssqb) {
    const int tid = tid_();
    for (int i = blockIdx.x; i < 256; i += NBLK) {
        const int xcd = i & 7, slot = i >> 3;
        { const int bh = xcd * 2; mla_unit128(lds, bh >> 3, bh & 7, 31 - slot, Q16, K16, VT16, ob16, ssqb, tid); }
        { const int bh = xcd * 2 + 1; mla_unit128(lds, bh >> 3, bh & 7, slot, Q16, K16, VT16, ob16, ssqb, tid); }
    }
}
constexpr float NSA_QSCALE = 0.125f * 1.4426950408889634f;
constexpr int IMP_PITCH = 129;
__device__ __forceinline__ void fa_tile_cmp2(const unsigned char* st, const bf16x8 (&qf)[4], f32x16 (&o)[2], float mref, float linv, int key0, int qpos, int lane, float* imp_row, bool need_mask) {
    typedef FA<64> F;
    asm volatile("" : "+v"(lane));
    const int r32 = lane & 31, hi = lane >> 5;
    f32x16 s0, s1;
#pragma unroll
    for (int r = 0; r < 16; ++r) { s0[r] = 0.f; s1[r] = 0.f; }
#pragma unroll
    for (int ds = 0; ds < 4; ++ds) {
        const bf16x8 k0 = *(const bf16x8*)(st + r32 * F::KP + ds * 32 + hi * 16);
        const bf16x8 k1 = *(const bf16x8*)(st + (32 + r32) * F::KP + ds * 32 + hi * 16);
        s0 = MFMA32(k0, qf[ds], s0); s1 = MFMA32(k1, qf[ds], s1);
    }
    {
        const f32x2_t mm = {mref, mref}, ll = {linv, linv};
#pragma unroll
        for (int r = 0; r < 16; r += 2) {
            const f32x2_t d0 = f32x2_t{s0[r], s0[r + 1]} - mm, d1 = f32x2_t{s1[r], s1[r + 1]} - mm;
            const f32x2_t p0 = f32x2_t{__builtin_amdgcn_exp2f(d0.x), __builtin_amdgcn_exp2f(d0.y)} * ll, p1 = f32x2_t{__builtin_amdgcn_exp2f(d1.x), __builtin_amdgcn_exp2f(d1.y)} * ll;
            s0[r] = p0.x; s0[r + 1] = p0.y; s1[r] = p1.x; s1[r + 1] = p1.y;
        }
    }
    if (need_mask) {
#pragma unroll
        for (int r = 0; r < 16; ++r) {
            const int ka = key0 + crow(r, hi), kb = ka + 32;
            if (16 * ka + 31 > qpos) s0[r] = 0.f;
            if (16 * kb + 31 > qpos) s1[r] = 0.f;
        }
    }
    bf16x8 pk[4];
#pragma unroll
    for (int s = 0; s < 2; ++s) {
        uint4 a, b;
        a.x = cvtpk(s0[8 * s], s0[8 * s + 1]); a.y = cvtpk(s0[8 * s + 2], s0[8 * s + 3]); a.z = cvtpk(s0[8 * s + 4], s0[8 * s + 5]); a.w = cvtpk(s0[8 * s + 6], s0[8 * s + 7]);
        b.x = cvtpk(s1[8 * s], s1[8 * s + 1]); b.y = cvtpk(s1[8 * s + 2], s1[8 * s + 3]); b.z = cvtpk(s1[8 * s + 4], s1[8 * s + 5]); b.w = cvtpk(s1[8 * s + 6], s1[8 * s + 7]);
        pk[s] = __builtin_bit_cast(bf16x8, a); pk[2 + s] = __builtin_bit_cast(bf16x8, b);
    }
    const unsigned char* vt = st + F::KBYTES;
#pragma unroll
    for (int ks = 0; ks < 4; ++ks) {
        const bf16x8 v0 = *(const bf16x8*)(vt + r32 * F::VP + ks * 32 + hi * 16);
        const bf16x8 v1 = *(const bf16x8*)(vt + (32 + r32) * F::VP + ks * 32 + hi * 16);
        o[0] = MFMA32(v0, pk[ks], o[0]); o[1] = MFMA32(v1, pk[ks], o[1]);
    }
#pragma unroll
    for (int g4 = 0; g4 < 4; ++g4) {
        const float qa = quad_sum(s0[4 * g4] + s0[4 * g4 + 1] + s0[4 * g4 + 2] + s0[4 * g4 + 3]), la = quad_sum(s0[4 * g4 + 3]);
        const float qb = quad_sum(s1[4 * g4] + s1[4 * g4 + 1] + s1[4 * g4 + 2] + s1[4 * g4 + 3]), lb = quad_sum(s1[4 * g4 + 3]);
        if ((lane & 3) == 0) {
            { const int j = (key0 + 8 * g4 + 4 * hi) >> 2;
              atomicAdd(imp_row + j, qa);
              if (j + 1 < 128) atomicAdd(imp_row + j + 1, la); }
            { const int j = (key0 + 32 + 8 * g4 + 4 * hi) >> 2;
              atomicAdd(imp_row + j, qb);
              if (j + 1 < 128) atomicAdd(imp_row + j + 1, lb); }
        }
    }
}
#define NSA_STEP_(GCUR, GNEXT, Kbase, kpitch, Vbase, vpitch, t_lo, t_hi, t_, ...) do { \
        const unsigned char* st = stg + (((t_) - (t_lo)) & 1) * FA<64>::STAGE; \
        if ((t_) + 2 <= (t_hi)) fa_load<64>((Kbase) + (long)((t_) + 2) * 64 * (kpitch), (kpitch), (Vbase) + ((t_) + 2) * 64, (vpitch), GCUR, tid); \
        const int key0 = (t_) * 64; (void)key0; \
        __VA_ARGS__ \
        if ((t_) + 1 <= (t_hi)) fa_store<64>(stg + (((t_) + 1 - (t_lo)) & 1) * FA<64>::STAGE, GNEXT, tid); \
        __syncthreads(); } while (0)
#define NSA_STREAM(Kbase, kpitch, Vbase, vpitch, t_lo, t_hi, ...) do { \
    FaRegs ga_, gb_; fa_load<64>((Kbase) + (long)(t_lo) * 64 * (kpitch), (kpitch), (Vbase) + (t_lo) * 64, (vpitch), ga_, tid); \
    if ((t_lo) + 1 <= (t_hi)) fa_load<64>((Kbase) + (long)((t_lo) + 1) * 64 * (kpitch), (kpitch), (Vbase) + ((t_lo) + 1) * 64, (vpitch), gb_, tid); \
    fa_store<64>(stg, ga_, tid); __syncthreads(); \
    for (int t_ = (t_lo); t_ <= (t_hi); t_ += 2) { \
        NSA_STEP_(ga_, gb_, Kbase, kpitch, Vbase, vpitch, t_lo, t_hi, t_, __VA_ARGS__); \
        if (t_ + 1 <= (t_hi)) { const int tt_ = t_ + 1; NSA_STEP2_(gb_, ga_, Kbase, kpitch, Vbase, vpitch, t_lo, t_hi, tt_, __VA_ARGS__); } \
    } } while (0)
#define NSA_STEP2_(GCUR, GNEXT, Kbase, kpitch, Vbase, vpitch, t_lo, t_hi, tq_, ...) do { \
        const int t_ = tq_; \
        const unsigned char* st = stg + ((t_ - (t_lo)) & 1) * FA<64>::STAGE; \
        if (t_ + 2 <= (t_hi)) fa_load<64>((Kbase) + (long)(t_ + 2) * 64 * (kpitch), (kpitch), (Vbase) + (t_ + 2) * 64, (vpitch), GCUR, tid); \
        const int key0 = t_ * 64; (void)key0; \
        __VA_ARGS__ \
        if (t_ + 1 <= (t_hi)) fa_store<64>(stg + ((t_ + 1 - (t_lo)) & 1) * FA<64>::STAGE, GNEXT, tid); \
        __syncthreads(); } while (0)

__device__ __forceinline__ void nsa_unit(unsigned char* lds, int b, int g, int qblk, const unsigned short* __restrict__ Q16A, const unsigned short* __restrict__ KC16, const unsigned short* __restrict__ VCT16,
                                         const unsigned short* __restrict__ KS16, const unsigned short* __restrict__ VST16, const unsigned short* __restrict__ KW16, const unsigned short* __restrict__ VWT16,
                                         const float* __restrict__ gates, unsigned short* __restrict__ oa16, float* __restrict__ ssqa, int tid) {
    typedef FA<64> F;
    const int lane = tid & 63, wave = __builtin_amdgcn_readfirstlane(tid >> 6), r32 = lane & 31, hi = lane >> 5;
    unsigned char* stg = lds;
    float* imp = (float*)(lds + 2 * F::STAGE);
    unsigned* selm = (unsigned*)(lds + 2 * F::STAGE + 64 * IMP_PITCH * 4);
    const int q0 = qblk * 64, cur = qblk;
    const int ql = wave * 8 + (r32 >> 2), hh = g * 4 + (r32 & 3), qpos = q0 + ql; const long tok = (long)b * S_ + qpos; const int bg = b * 2 + g;
    bf16x8 qf[4];
#pragma unroll
    for (int ds = 0; ds < 4; ++ds) qf[ds] = *(const bf16x8*)(Q16A + tok * 512 + hh * 64 + ds * 16 + hi * 8);
    for (int i = tid; i < 64 * IMP_PITCH; i += 512) imp[i] = 0.f;
    f32x16 acc[2], o[2];
#pragma unroll
    for (int r = 0; r < 16; ++r) { acc[0][r] = 0.f; acc[1][r] = 0.f; }
    const int wq_lo = q0 + wave * 8, wq_hi = wq_lo + 7;
    const int nvis_max = (q0 + 63 >= 31) ? ((q0 + 63 - 31) / 16 + 1) : 0;
    if (nvis_max > 0) {
        const int tc_hi = (nvis_max - 1) >> 6;
        const unsigned short* Kc = KC16 + (long)bg * 512 * 64; const unsigned short* Vc = VCT16 + (long)bg * 64 * 512;
        float mref = FA_NEG, l = 0.f;
        NSA_STREAM(Kc, 64, Vc, 512, 0, tc_hi, {
            if (16 * key0 + 31 <= wq_hi) fa_tile<64, 4, true>(st, qf, o, mref, l, key0, qpos, lane, 16 * (key0 + 63) + 31 > wq_lo);
        });
        l = pair_sum(l);
        const float linv = (l > 0.f) ? 1.f / l : 0.f;
#pragma unroll
        for (int r = 0; r < 16; ++r) { o[0][r] = 0.f; o[1][r] = 0.f; }
        NSA_STREAM(Kc, 64, Vc, 512, 0, tc_hi, {
            if (16 * key0 + 31 <= wq_hi) fa_tile_cmp2(st, qf, o, mref, linv, key0, qpos, lane, imp + ql * IMP_PITCH, 16 * (key0 + 63) + 31 > wq_lo);
        });
        const float g_c = gates[tok * 24 + hh * 3];
#pragma unroll
        for (int r = 0; r < 16; ++r) { acc[0][r] += g_c * o[0][r]; acc[1][r] += g_c * o[1][r]; }
    } else { __syncthreads(); }
    if (wave < 2) {
        const int qi = wave * 32 + r32;
        int his = hi; asm volatile("" : "+v"(his));
#define IMPKEY(jj) ({ const int j_ = (jj); const float v_ = (j_ == 0 || j_ == cur) ? 1e9f : ((j_ > cur) ? -1e30f : imp[qi * IMP_PITCH + j_]); (ordkey(v_) & ~127u) | (127u - (unsigned)j_); })
        unsigned k0[16];
        {
            unsigned k1[16];
#pragma unroll
            for (int i = 0; i < 16; ++i) { k0[i] = IMPKEY(his * 64 + i); k1[i] = IMPKEY(his * 64 + 16 + i); }
            sort16_desc(k0); sort16_desc(k1); merge16_desc(k0, k1);
        }
        __builtin_amdgcn_sched_barrier(0);
        {
            unsigned k2[16], k3[16];
#pragma unroll
            for (int i = 0; i < 16; ++i) { k2[i] = IMPKEY(his * 64 + 32 + i); k3[i] = IMPKEY(his * 64 + 48 + i); }
            sort16_desc(k2); sort16_desc(k3); merge16_desc(k2, k3); merge16_desc(k0, k2);
        }
#undef IMPKEY
        {
            unsigned o2[16];
#pragma unroll
            for (int i = 0; i < 16; ++i) { auto rr = __builtin_amdgcn_permlane32_swap(k0[i], k0[i], false, false); k0[i] = rr[0]; o2[i] = rr[1]; }
            merge16_desc(k0, o2);
        }
        unsigned m0 = 0u, m1 = 0u, m2 = 0u, m3 = 0u;
#pragma unroll
        for (int i = 0; i < 16; ++i) {
            const unsigned j = 127u - (k0[i] & 127u); const unsigned bit = 1u << (j & 31u); const unsigned wsel = j >> 5;
            m0 |= (wsel == 0u) ? bit : 0u; m1 |= (wsel == 1u) ? bit : 0u; m2 |= (wsel == 2u) ? bit : 0u; m3 |= (wsel == 3u) ? bit : 0u;
        }
        if (hi == 0) { selm[qi * 4] = m0; selm[qi * 4 + 1] = m1; selm[qi * 4 + 2] = m2; selm[qi * 4 + 3] = m3; }
    }
    __syncthreads();
    unsigned sm0 = selm[ql * 4], sm1 = selm[ql * 4 + 1], sm2 = selm[ql * 4 + 2], sm3 = selm[ql * 4 + 3];
    {
        float mref = FA_NEG, l = 0.f;
#pragma unroll
        for (int r = 0; r < 16; ++r) { o[0][r] = 0.f; o[1][r] = 0.f; }
        const unsigned short* Ks = KS16 + (long)bg * S_ * 64; const unsigned short* Vs = VST16 + (long)bg * 64 * S_;
        NSA_STREAM(Ks, 64, Vs, S_, 0, cur, {
            const int jw = t_ >> 5; const unsigned wsel = (jw == 0) ? sm0 : ((jw == 1) ? sm1 : ((jw == 2) ? sm2 : sm3));
            const bool colsel = (wsel >> (t_ & 31)) & 1u;
            if (__any(colsel)) fa_tile<64, 3>(st, qf, o, mref, l, key0, qpos, lane, t_ == cur, colsel);
        });
        l = pair_sum(l);
        const float sc = gates[tok * 24 + hh * 3 + 1] / l;
#pragma unroll
        for (int r = 0; r < 16; ++r) { acc[0][r] += sc * o[0][r]; acc[1][r] += sc * o[1][r]; }
    }
    {
        float mref = FA_NEG, l = 0.f;
#pragma unroll
        for (int r = 0; r < 16; ++r) { o[0][r] = 0.f; o[1][r] = 0.f; }
        const unsigned short* Kw = KW16 + (long)bg * S_ * 64; const unsigned short* Vw = VWT16 + (long)bg * 64 * S_;
        const int tw_lo = (cur >= 8) ? cur - 8 : 0;
        NSA_STREAM(Kw, 64, Vw, S_, tw_lo, cur, {
            fa_tile<64, 2>(st, qf, o, mref, l, key0, qpos, lane, (t_ == cur) || (t_ == cur - 8));
        });
        l = pair_sum(l);
        const float sc = gates[tok * 24 + hh * 3 + 2] / l;
#pragma unroll
        for (int r = 0; r < 16; ++r) { acc[0][r] += sc * o[0][r]; acc[1][r] += sc * o[1][r]; }
    }
    float ss = 0.f;
#pragma unroll
    for (int dt = 0; dt < 2; ++dt) {
#pragma unroll
        for (int r = 0; r < 16; ++r) ss += acc[dt][r] * acc[dt][r];
#pragma unroll
        for (int p = 0; p < 2; ++p) store_pair16(oa16 + tok * 1024 + hh * 64 + dt * 32, acc[dt], p, hi);
    }
    ss = pair_sum(ss);
    if (hi == 0) ssqa[(long)hh * T_ + tok] = ss;
    __syncthreads();
}
__device__ __forceinline__ void nsa_phase(unsigned char* lds, const unsigned short* __restrict__ Q16A, const unsigned short* __restrict__ KC16, const unsigned short* __restrict__ VCT16,
                                          const unsigned short* __restrict__ KS16, const unsigned short* __restrict__ VST16, const unsigned short* __restrict__ KW16, const unsigned short* __restrict__ VWT16,
                                          const float* __restrict__ gates, unsigned short* __restrict__ oa16, float* __restrict__ ssqa) {
    const int tid = tid_();
    for (int i = blockIdx.x; i < 256; i += NBLK) {
        const int xcd = i & 7, slot = i >> 3; const int bg = xcd >> 1, pr = (xcd & 1) * 32 + slot;
        nsa_unit(lds, bg >> 1, bg & 1, 127 - pr, Q16A, KC16, VCT16, KS16, VST16, KW16, VWT16, gates, oa16, ssqa, tid);
        nsa_unit(lds, bg >> 1, bg & 1, pr, Q16A, KC16, VCT16, KS16, VST16, KW16, VWT16, gates, oa16, ssqa, tid);
    }
}
__device__ __forceinline__ int nmap_in2(int n) {
    if (n < 768) return n;
    if (n < 896) return n;
    if (n < 1024) return n - 896 + 1024;
    if (n < 1152) return n - 1024 + 896;
    if (n < 1280) return n;
    if (n < 1304) return n - 1280 + 1696;
    if (n < 1560) return n - 1304 + 1280;
    if (n < 1688) return n - 1560 + 1536;
    return n - 1688 + 1664;
}
struct XT { const float* src; unsigned short* dst; const float* glo; const float* ghi; int K, N, ksplit, tile, nmap; };
__device__ __forceinline__ XT xt_make(const float* src, int K, int N, unsigned short* dst, const float* glo, const float* ghi, int ksplit, int nmap, int tile) {
    XT d; d.src = src; d.dst = dst; d.glo = glo; d.ghi = ghi; d.K = K; d.N = N; d.ksplit = ksplit; d.tile = tile; d.nmap = nmap; return d;
}
__device__ __forceinline__ void xt_load(const XT& d, float (&v)[8], int tid) {
    if (d.tile < 0) return;
    const int tn = (d.N + 63) >> 6; const int k0 = (d.tile / tn) * 64, n0 = (d.tile % tn) * 64;
    const float* __restrict__ s = as_global(d.src);
#pragma unroll
    for (int i = 0; i < 8; ++i) {
        const int kl = (tid >> 6) + 8 * i, n = n0 + (tid & 63), k = k0 + kl;
        float x = (n < d.N) ? s[(long)k * d.N + n] : 0.f;
        if (d.glo) x *= (k < d.ksplit) ? d.glo[k] : d.ghi[k - d.ksplit];
        v[i] = x;
    }
}
__device__ __forceinline__ void xt_store(const XT& d, const float (&v)[8], float* buf, int tid) {
    if (d.tile < 0) return;
    float (*tl)[65] = (float (*)[65])buf;
    const int tn = (d.N + 63) >> 6; const int k0 = (d.tile / tn) * 64, n0 = (d.tile % tn) * 64;
#pragma unroll
    for (int i = 0; i < 8; ++i) tl[(tid >> 6) + 8 * i][tid & 63] = v[i];
    __syncthreads();
    const int nl = tid >> 3, kc = (tid & 7) * 8; const int n = n0 + nl;
    if (n < d.N) {
        uint4 o; o.x = cvtpk(tl[kc][nl], tl[kc + 1][nl]); o.y = cvtpk(tl[kc + 2][nl], tl[kc + 3][nl]); o.z = cvtpk(tl[kc + 4][nl], tl[kc + 5][nl]); o.w = cvtpk(tl[kc + 6][nl], tl[kc + 7][nl]);
        const int nn = d.nmap ? nmap_in2(n) : n;
        *(uint4*)(d.dst + (long)nn * d.K + k0 + kc) = o;
    }
}
#define XT_RUN4(ldsf_, MAKE) do { const int tid_x = tid_(); float xv0[8], xv1[8], xv2[8], xv3[8]; \
    const XT xd0 = MAKE(0), xd1 = MAKE(1), xd2 = MAKE(2), xd3 = MAKE(3); \
    xt_load(xd0, xv0, tid_x); xt_load(xd1, xv1, tid_x); xt_load(xd2, xv2, tid_x); xt_load(xd3, xv3, tid_x); \
    xt_store(xd0, xv0, (ldsf_), tid_x); xt_store(xd1, xv1, (ldsf_) + 64 * 65, tid_x); xt_store(xd2, xv2, (ldsf_), tid_x); xt_store(xd3, xv3, (ldsf_) + 64 * 65, tid_x); __syncthreads(); } while (0)
__device__ __forceinline__ void p0_xn_rope(const float* __restrict__ x, const float* __restrict__ g1, const int* __restrict__ positions, unsigned short* __restrict__ xn16, float* __restrict__ rope) {
    const int tid = tid_(); const int lane = tid & 63, w = __builtin_amdgcn_readfirstlane(tid >> 6);
    const f32x4_t* gp = (const f32x4_t*)g1; const f32x4_t ga0 = gp[lane * 2], ga1 = gp[lane * 2 + 1], gb0 = gp[128 + lane * 2], gb1 = gp[128 + lane * 2 + 1];
    for (int t0 = blockIdx.x * 8 + w; t0 < T_; t0 += 4 * NBLK * 8) {
        f32x4_t v[4][4]; int pos[4];
#pragma unroll
        for (int j = 0; j < 4; ++j) {
            const int t = t0 + j * NBLK * 8;
            const f32x4_t* xp = (const f32x4_t*)(x + (long)t * 1024);
            v[j][0] = xp[lane * 2]; v[j][1] = xp[lane * 2 + 1]; v[j][2] = xp[128 + lane * 2]; v[j][3] = xp[128 + lane * 2 + 1];
            pos[j] = positions[t];
        }
#pragma unroll
        for (int j = 0; j < 4; ++j) {
            const int t = t0 + j * NBLK * 8;
            const f32x4_t a0 = v[j][0], a1 = v[j][1], b0 = v[j][2], b1 = v[j][3];
            float ss = a0.x * a0.x + a0.y * a0.y + a0.z * a0.z + a0.w * a0.w + a1.x * a1.x + a1.y * a1.y + a1.z * a1.z + a1.w * a1.w
                     + b0.x * b0.x + b0.y * b0.y + b0.z * b0.z + b0.w * b0.w + b1.x * b1.x + b1.y * b1.y + b1.z * b1.z + b1.w * b1.w;
            ss = wsum(ss); const float rs = rsqrtf(ss * (1.f / 1024.f) + EPS);
            uint4 pa, pb;
            pa.x = cvtpk(a0.x * rs * ga0.x, a0.y * rs * ga0.y); pa.y = cvtpk(a0.z * rs * ga0.z, a0.w * rs * ga0.w); pa.z = cvtpk(a1.x * rs * ga1.x, a1.y * rs * ga1.y); pa.w = cvtpk(a1.z * rs * ga1.z, a1.w * rs * ga1.w);
            pb.x = cvtpk(b0.x * rs * gb0.x, b0.y * rs * gb0.y); pb.y = cvtpk(b0.z * rs * gb0.z, b0.w * rs * gb0.w); pb.z = cvtpk(b1.x * rs * gb1.x, b1.y * rs * gb1.y); pb.w = cvtpk(b1.z * rs * gb1.z, b1.w * rs * gb1.w);
            ((uint4*)(xn16 + (long)t * 1024))[lane] = pa; ((uint4*)(xn16 + (long)t * 1024))[64 + lane] = pb;
            if (lane < 24) {
                const float f = lane < 8 ? ROPE_F16[lane] : ROPE_F32[lane - 8];
                const float angf = (float)pos[j] * f;
                const double ang = (double)angf; const double k = rint(ang * 0.15915494309189535);
                const float r = (float)(ang - k * 6.283185307179586);
                const float c = cosf(r), sn = sinf(r);
                if (lane < 8) { rope[(long)t * 48 + lane] = c; rope[(long)t * 48 + 8 + lane] = sn; }
                else { rope[(long)t * 48 + 16 + lane - 8] = c; rope[(long)t * 48 + 32 + lane - 8] = sn; }
            }
        }
    }
}
__device__ __forceinline__ void p0_cbias(const float* __restrict__ pos, const float* __restrict__ w1k, const float* __restrict__ w1v, float* __restrict__ cbias) {
    const int tid = tid_(); const int lane = tid & 63, w = __builtin_amdgcn_readfirstlane(tid >> 6);
    for (int task = blockIdx.x * 8 + w; task < 512; task += NBLK * 8) {
        const int mat = task >> 8, n = task & 255; const float* w1 = mat ? w1v : w1k;
        float acc = 0.f;
#pragma unroll 8
        for (int i = 0; i < 32; ++i) { const int k = lane + 64 * i; acc += pos[k] * w1[(long)k * 256 + n]; }
        acc = wsum(acc);
        if (lane == 0) cbias[task] = acc;
    }
}
__device__ __forceinline__ void zero_stream(unsigned short* __restrict__ p, long n) {
    const int tid = tid_();
    for (long c = (long)blockIdx.x * 512 + tid; c < (n >> 3); c += (long)NBLK * 512) ((uint4*)p)[c] = make_uint4(0u, 0u, 0u, 0u);
}

struct P1Out {
    unsigned short *q16a, *ks16, *kw16, *vst16, *vwt16, *kcmp16, *vcmp16, *cq16, *ckv16;
    float *krr, *ssq_kr, *ssq_cq, *ssq_ckv, *gates;
    const float *rope, *q_gain, *ks_gain, *kw_gain, *k_gain;
};
__device__ __forceinline__ void norm_rope64(f32x16& a0, f32x16& a1, const float* __restrict__ gain, const float* __restrict__ rope_t, int hi, float outscale) {
    float ss = 0.f;
#pragma unroll
    for (int r = 0; r < 16; ++r) ss += a0[r] * a0[r] + a1[r] * a1[r];
    ss = pair_sum(ss);
    const float rs = rsqrtf(ss * (1.f / 64.f) + EPS);
#pragma unroll
    for (int g = 0; g < 4; ++g) {
        const float4 g0 = *(const float4*)(gain + 8 * g + 4 * hi), g1 = *(const float4*)(gain + 32 + 8 * g + 4 * hi);
        a0[4 * g] *= rs * g0.x; a0[4 * g + 1] *= rs * g0.y; a0[4 * g + 2] *= rs * g0.z; a0[4 * g + 3] *= rs * g0.w;
        a1[4 * g] *= rs * g1.x; a1[4 * g + 1] *= rs * g1.y; a1[4 * g + 2] *= rs * g1.z; a1[4 * g + 3] *= rs * g1.w;
    }
    const float4 c4 = *(const float4*)(rope_t + 4 * hi), s4 = *(const float4*)(rope_t + 8 + 4 * hi);
    const float cc[4] = {c4.x, c4.y, c4.z, c4.w}, sn[4] = {s4.x, s4.y, s4.z, s4.w};
#pragma unroll
    for (int j = 0; j < 4; ++j) { const float x1 = a0[j], x2 = a0[4 + j]; a0[j] = x1 * cc[j] - x2 * sn[j]; a0[4 + j] = x2 * cc[j] + x1 * sn[j]; }
#pragma unroll
    for (int r = 0; r < 16; ++r) { a0[r] *= outscale; a1[r] *= outscale; }
}
__device__ __forceinline__ void store_row64(unsigned short* __restrict__ dst, const f32x16& a0, const f32x16& a1, int hi) {
#pragma unroll
    for (int p = 0; p < 2; ++p) { store_pair16(dst, a0, p, hi); store_pair16(dst + 32, a1, p, hi); }
}
__device__ __forceinline__ float ssq64(const f32x16& a0, const f32x16& a1) {
    float ss = 0.f;
#pragma unroll
    for (int r = 0; r < 16; ++r) ss += a0[r] * a0[r] + a1[r] * a1[r];
    return pair_sum(ss);
}
__device__ __forceinline__ float sum4fq(float v) {
    auto r1 = __builtin_amdgcn_permlane16_swap(__float_as_uint(v), __float_as_uint(v), false, false);
    return pair_sum(__uint_as_float(r1[0]) + __uint_as_float(r1[1]));
}
#define P1V(m, j) acc[ai][bj][m][n][j]
__device__ __forceinline__ void p1_inproj_256(unsigned char* lds, const unsigned short* __restrict__ xn16, const unsigned short* __restrict__ wt_in, const P1Out& Oin) {
    const P1Out O = Oin;
    const int tbase = (blockIdx.x & 7) * 56;
    for (int tile = tbase + (blockIdx.x >> 3); tile < tbase + 56; tile += 32) {
        const int mt = tile / 7, nt = tile % 7; const int m0 = mt * 256;
        f32x4_t acc[2][2][4][2];
#pragma unroll
        for (int ai = 0; ai < 2; ++ai)
#pragma unroll
            for (int bj = 0; bj < 2; ++bj)
#pragma unroll
                for (int m = 0; m < 4; ++m)
#pragma unroll
                    for (int n = 0; n < 2; ++n) acc[ai][bj][m][n] = f32x4_t{0.f, 0.f, 0.f, 0.f};
        if (nt == 4) g256::mainloop<1024>(xn16, wt_in, m0, nt * 256, (unsigned short*)lds, acc);
        else g256::mainloop<1024>(wt_in, xn16, nt * 256, m0, (unsigned short*)lds, acc);
        const int tid = tid_(); const int lane = tid & 63, wave = __builtin_amdgcn_readfirstlane(tid >> 6), wr = wave >> 2, wc = wave & 3, fr = lane & 15, fq = lane >> 4;
        if (nt == 4) {
#pragma unroll
            for (int bj = 0; bj < 2; ++bj)
#pragma unroll
                for (int n = 0; n < 2; ++n) {
                    const int pc = bj * 2 + (wc >> 1), d = (wc & 1) * 32 + n * 16 + fr;
                    unsigned short* vt = (pc < 2) ? O.vst16 : O.vwt16; const int g = pc & 1;
#pragma unroll
                    for (int ai = 0; ai < 2; ++ai)
#pragma unroll
                        for (int m = 0; m < 4; ++m) {
                            const int tb = m0 + ai * 128 + wr * 64 + m * 16 + fq * 4; const int b = tb / S_, s0 = tb % S_;
                            uint2 pk; pk.x = cvtpk(P1V(m, 0), P1V(m, 1)); pk.y = cvtpk(P1V(m, 2), P1V(m, 3));
                            *(uint2*)(vt + ((long)(b * 2 + g) * 64 + d) * S_ + vperm(s0)) = pk;
                        }
                }
        } else {
#pragma unroll
            for (int bj = 0; bj < 2; ++bj)
#pragma unroll
                for (int n = 0; n < 2; ++n) {
                    const long tok = m0 + bj * 128 + wc * 32 + n * 16 + fr; const int b = (int)(tok / S_), s = (int)(tok % S_);
                    const float* rope_t = O.rope + tok * 48;
                    const bool is_q = nt < 2, is_k = nt == 3;
                    f32x4_t rc4 = {0.f, 0.f, 0.f, 0.f}, rs4 = {0.f, 0.f, 0.f, 0.f};
                    if (is_q || is_k) { rc4 = *(const f32x4_t*)(rope_t + (fq & 1) * 4); rs4 = *(const f32x4_t*)(rope_t + 8 + (fq & 1) * 4); }
#pragma unroll
                    for (int ai = 0; ai < 2; ++ai) {
                        const int pc = ai * 2 + wr;
                        if (is_q || is_k) {
                            const float* gain = is_q ? O.q_gain : ((pc < 2) ? O.ks_gain : O.kw_gain);
                            float ss = 0.f;
#pragma unroll
                            for (int m = 0; m < 4; ++m)
#pragma unroll
                                for (int j = 0; j < 4; ++j) ss += P1V(m, j) * P1V(m, j);
                            const float rs = rsqrtf(sum4fq(ss) * (1.f / 64.f) + EPS) ;
#pragma unroll
                            for (int m = 0; m < 4; ++m) { const float4 gv = *(const float4*)(gain + m * 16 + fq * 4);
                                P1V(m, 0) *= rs * gv.x; P1V(m, 1) *= rs * gv.y; P1V(m, 2) *= rs * gv.z; P1V(m, 3) *= rs * gv.w; }
                            { const f32x4_t c4 = rc4, s4 = rs4;
                              const float cc[4] = {c4.x, c4.y, c4.z, c4.w}, sn[4] = {s4.x, s4.y, s4.z, s4.w};
#pragma unroll
                              for (int j = 0; j < 4; ++j) {
                                  auto rr = __builtin_amdgcn_permlane32_swap(__float_as_uint(P1V(0, j)), __float_as_uint(P1V(0, j)), false, false);
                                  const float x1 = __uint_as_float(rr[0]), x2 = __uint_as_float(rr[1]);
                                  P1V(0, j) = (fq < 2) ? (x1 * cc[j] - x2 * sn[j]) : (x2 * cc[j] + x1 * sn[j]);
                              } }
                            const float osc = is_q ? NSA_QSCALE : 1.f;
                            unsigned short* dst = is_q ? (O.q16a + tok * 512 + (nt * 4 + pc) * 64) : ((pc < 2 ? O.ks16 : O.kw16) + ((long)(b * 2 + (pc & 1)) * S_ + s) * 64);
#pragma unroll
                            for (int m = 0; m < 4; ++m) { uint2 pk; pk.x = cvtpk(P1V(m, 0) * osc, P1V(m, 1) * osc); pk.y = cvtpk(P1V(m, 2) * osc, P1V(m, 3) * osc); *(uint2*)(dst + m * 16 + fq * 4) = pk; }
                        } else if (nt == 2 || nt == 5 || (nt == 6 && pc < 2)) {
                            unsigned short* dst;
                            if (nt == 2) dst = (pc < 2 ? O.kcmp16 : O.vcmp16) + ((long)(b * 2 + (pc & 1)) * S_ + s) * 64;
                            else if (nt == 5) dst = O.cq16 + tok * 256 + pc * 64;
                            else dst = O.ckv16 + tok * 128 + pc * 64;
                            float ss = 0.f;
#pragma unroll
                            for (int m = 0; m < 4; ++m) { uint2 pk; pk.x = cvtpk(P1V(m, 0), P1V(m, 1)); pk.y = cvtpk(P1V(m, 2), P1V(m, 3)); *(uint2*)(dst + m * 16 + fq * 4) = pk;
#pragma unroll
                                for (int j = 0; j < 4; ++j) ss += P1V(m, j) * P1V(m, j); }
                            if (nt != 2) { ss = sum4fq(ss); if (fq == 0) { if (nt == 5) O.ssq_cq[(long)pc * T_ + tok] = ss; else O.ssq_ckv[(long)pc * T_ + tok] = ss; } }
                        } else if (nt == 6 && pc == 2) {
                            float ss = 0.f;
#pragma unroll
                            for (int m = 0; m < 2; ++m)
#pragma unroll
                                for (int j = 0; j < 4; ++j) ss += P1V(m, j) * P1V(m, j);
                            ss = sum4fq(ss);
                            if (fq == 0) O.ssq_kr[tok] = ss;
                            {
                                const float4 g0 = *(const float4*)(O.k_gain + 64 + fq * 4), g1 = *(const float4*)(O.k_gain + 80 + fq * 4);
                                const float4 c4 = *(const float4*)(rope_t + 16 + fq * 4), s4 = *(const float4*)(rope_t + 32 + fq * 4);
                                const float ga[4] = {g0.x, g0.y, g0.z, g0.w}, gb[4] = {g1.x, g1.y, g1.z, g1.w}, cc[4] = {c4.x, c4.y, c4.z, c4.w}, sn[4] = {s4.x, s4.y, s4.z, s4.w};
                                float o1[4], o2[4];
#pragma unroll
                                for (int j = 0; j < 4; ++j) { const float x1 = P1V(0, j) * ga[j], x2 = P1V(1, j) * gb[j]; o1[j] = x1 * cc[j] - x2 * sn[j]; o2[j] = x2 * cc[j] + x1 * sn[j]; }
                                *(float4*)(O.krr + tok * 32 + fq * 4) = make_float4(o1[0], o1[1], o1[2], o1[3]);
                                *(float4*)(O.krr + tok * 32 + 16 + fq * 4) = make_float4(o2[0], o2[1], o2[2], o2[3]);
                            }
                            *(float4*)(O.gates + tok * 24 + fq * 4) = make_float4(1.f / (1.f + __expf(-P1V(2, 0))), 1.f / (1.f + __expf(-P1V(2, 1))), 1.f / (1.f + __expf(-P1V(2, 2))), 1.f / (1.f + __expf(-P1V(2, 3))));
                            if (fq < 2) *(float4*)(O.gates + tok * 24 + 16 + fq * 4) = make_float4(1.f / (1.f + __expf(-P1V(3, 0))), 1.f / (1.f + __expf(-P1V(3, 1))), 1.f / (1.f + __expf(-P1V(3, 2))), 1.f / (1.f + __expf(-P1V(3, 3))));
                        }
                    }
            }
        }
        __syncthreads();
    }
}
#undef P1V

typedef GemmShape<2, 4, 2, 2> ShBig;
typedef GemmShape<4, 2, 1, 3> ShQb;
typedef GemmShape<4, 2, 1, 4> ShKvb;
struct P2Args {
    const unsigned short *cq16, *ckv16, *wt_uq, *wt_ukv, *kcmp16, *vcmp16, *w1t_k, *w1t_v;
    const float *ssq_cq, *ssq_ckv, *ssq_kr, *krr, *rope, *q_gain, *k_gain;
    unsigned short *q16, *k16, *vt16; float* hid;
};
__device__ __forceinline__ void p2_phase(unsigned char* lds, const P2Args& A) {
    const int tid = tid_(); const int lane = tid & 63, wave = __builtin_amdgcn_readfirstlane(tid >> 6), r32 = lane & 31, hi = lane >> 5;
    const int nmine = (blockIdx.x < 128) ? 4 : 5;
    for (int it = 0; it < nmine; ++it) {
        int u;
        if (blockIdx.x < 128) { if (it == 0) u = blockIdx.x; else { const int s = blockIdx.x * 3 + (it - 1); u = (s & 1) ? 640 + (s >> 1) : 128 + (s >> 1); } }
        else { const int s = 384 + (blockIdx.x - 128) * 5 + it; u = (s & 1) ? 640 + (s >> 1) : 128 + (s >> 1); }
        if (u < 128) {
            const int mat = u >> 6, mtile = (u >> 2) & 15, ks = u & 3; const int wm = wave >> 2, wn = wave & 3;
            f32x16 acc[2][2];
#pragma unroll
            for (int mi = 0; mi < 2; ++mi)
#pragma unroll
                for (int ni = 0; ni < 2; ++ni)
#pragma unroll
                    for (int r = 0; r < 16; ++r) acc[mi][ni][r] = 0.f;
            gemm_mainloop<ShBig, 3u>((mat ? A.vcmp16 : A.kcmp16) + (long)mtile * 128 * 1024 + ks * 512, 1024, (mat ? A.w1t_v : A.w1t_k) + ks * 512, 2048, 512, lds, acc, tid);
            float* slab = A.hid + (long)(mat * 4 + ks) * 2048 * 256;
#pragma unroll
            for (int mi = 0; mi < 2; ++mi) {
                const long row = mtile * 128 + wm * 64 + mi * 32 + r32;
#pragma unroll
                for (int ni = 0; ni < 2; ++ni)
#pragma unroll
                    for (int g = 0; g < 4; ++g)
                        *(float4*)(slab + row * 256 + wn * 64 + ni * 32 + 8 * g + 4 * hi) = make_float4(acc[mi][ni][4 * g], acc[mi][ni][4 * g + 1], acc[mi][ni][4 * g + 2], acc[mi][ni][4 * g + 3]);
            }
        } else if (u < 128 + 512) {
            const int v = u - 128; const int mt = v >> 2, nt = v & 3; const int m0 = mt * 128; const int wm = wave >> 1, wn = wave & 1; const int head = nt * 2 + wn;
            f32x16 acc[1][4];
#pragma unroll
            for (int ni = 0; ni < 4; ++ni)
#pragma unroll
                for (int r = 0; r < 16; ++r) acc[0][ni][r] = 0.f;
            const long tok = m0 + wm * 32 + r32;
            const float e_c0 = A.ssq_ckv[tok], e_c1 = A.ssq_ckv[(long)T_ + tok], e_kr = A.ssq_kr[tok];
            f32x4_t e_k[4];
#pragma unroll
            for (int i = 0; i < 4; ++i) e_k[i] = ((const f32x4_t*)(A.krr + tok * 32 + hi * 16))[i];
            gemm_mainloop<ShKvb, 3u>(A.ckv16 + (long)m0 * 128, 128, A.wt_ukv + (long)nt * 256 * 128, 128, 128, lds, acc, tid);
            {
                const int b = (int)(tok / S_), s = (int)(tok % S_);
                const float rc = rsqrtf((e_c0 + e_c1) * (1.f / 128.f) + EPS);
                float ss = 0.f;
#pragma unroll
                for (int r = 0; r < 16; ++r) { acc[0][0][r] *= rc; acc[0][1][r] *= rc; ss += acc[0][0][r] * acc[0][0][r] + acc[0][1][r] * acc[0][1][r]; }
                ss = pair_sum(ss) + e_kr;
                const float rk = rsqrtf(ss * (1.f / 96.f) + EPS);
#pragma unroll
                for (int g = 0; g < 4; ++g) {
                    const float4 g0 = *(const float4*)(A.k_gain + 8 * g + 4 * hi), g1 = *(const float4*)(A.k_gain + 32 + 8 * g + 4 * hi);
                    acc[0][0][4 * g] *= rk * g0.x; acc[0][0][4 * g + 1] *= rk * g0.y; acc[0][0][4 * g + 2] *= rk * g0.z; acc[0][0][4 * g + 3] *= rk * g0.w;
                    acc[0][1][4 * g] *= rk * g1.x; acc[0][1][4 * g + 1] *= rk * g1.y; acc[0][1][4 * g + 2] *= rk * g1.z; acc[0][1][4 * g + 3] *= rk * g1.w;
                }
                unsigned short* krow = A.k16 + ((long)(b * 8 + head) * S_ + s) * 96;
                store_row64(krow, acc[0][0], acc[0][1], hi);
                const f32x4_t k0 = e_k[0], k1 = e_k[1], k2 = e_k[2], k3 = e_k[3];
                uint4 o0, o1; o0.x = cvtpk(k0.x * rk, k0.y * rk); o0.y = cvtpk(k0.z * rk, k0.w * rk); o0.z = cvtpk(k1.x * rk, k1.y * rk); o0.w = cvtpk(k1.z * rk, k1.w * rk);
                o1.x = cvtpk(k2.x * rk, k2.y * rk); o1.y = cvtpk(k2.z * rk, k2.w * rk); o1.z = cvtpk(k3.x * rk, k3.y * rk); o1.w = cvtpk(k3.z * rk, k3.w * rk);
                *(uint4*)(krow + 64 + hi * 16) = o0; *(uint4*)(krow + 64 + hi * 16 + 8) = o1;
            }
            {
#pragma unroll
                for (int ni = 2; ni < 4; ++ni)
#pragma unroll
                    for (int g4 = 0; g4 < 4; ++g4) {
                        const int tb = m0 + wm * 32 + 8 * g4 + 4 * hi; const int b = tb / S_, s0 = tb % S_; const int d = (ni - 2) * 32 + r32;
                        const f32x4_t sa = *(const f32x4_t*)(A.ssq_ckv + tb), sb = *(const f32x4_t*)(A.ssq_ckv + (long)T_ + tb);
                        const float r0 = rsqrtf((sa.x + sb.x) * (1.f / 128.f) + EPS), r1 = rsqrtf((sa.y + sb.y) * (1.f / 128.f) + EPS), r2 = rsqrtf((sa.z + sb.z) * (1.f / 128.f) + EPS), r3 = rsqrtf((sa.w + sb.w) * (1.f / 128.f) + EPS);
                        uint2 pk; pk.x = cvtpk(acc[0][ni][4 * g4] * r0, acc[0][ni][4 * g4 + 1] * r1); pk.y = cvtpk(acc[0][ni][4 * g4 + 2] * r2, acc[0][ni][4 * g4 + 3] * r3);
                        *(uint2*)(A.vt16 + ((long)(b * 8 + head) * 64 + d) * S_ + vperm(s0)) = pk;
                    }
            }
        } else {
            const int v = u - 640; const int mt = v >> 2, nt = v & 3; const int m0 = mt * 128; const int wm = wave >> 1, wn = wave & 1; const int head = nt * 2 + wn;
            f32x16 acc[1][3];
#pragma unroll
            for (int ni = 0; ni < 3; ++ni)
#pragma unroll
                for (int r = 0; r < 16; ++r) acc[0][ni][r] = 0.f;
            const long tok = m0 + wm * 32 + r32;
            const float e_q0 = A.ssq_cq[tok], e_q1 = A.ssq_cq[(long)T_ + tok], e_q2 = A.ssq_cq[2L * T_ + tok], e_q3 = A.ssq_cq[3L * T_ + tok];
            const float* rope_t = A.rope + tok * 48;
            f32x4_t e_c[2], e_s[2];
#pragma unroll
            for (int g = 0; g < 2; ++g) { e_c[g] = *(const f32x4_t*)(rope_t + 16 + 8 * g + 4 * hi); e_s[g] = *(const f32x4_t*)(rope_t + 32 + 8 * g + 4 * hi); }
            gemm_mainloop<ShQb, 7u>(A.cq16 + (long)m0 * 256, 256, A.wt_uq + (long)nt * 192 * 256, 256, 256, lds, acc, tid);
            const float rc = rsqrtf((e_q0 + e_q1 + e_q2 + e_q3) * (1.f / 256.f) + EPS);
            float ss = 0.f;
#pragma unroll
            for (int ni = 0; ni < 3; ++ni)
#pragma unroll
                for (int r = 0; r < 16; ++r) { acc[0][ni][r] *= rc; ss += acc[0][ni][r] * acc[0][ni][r]; }
            ss = pair_sum(ss);
            const float rq = rsqrtf(ss * (1.f / 96.f) + EPS);
#pragma unroll
            for (int ni = 0; ni < 3; ++ni)
#pragma unroll
                for (int g = 0; g < 4; ++g) {
                    const float4 gg = *(const float4*)(A.q_gain + ni * 32 + 8 * g + 4 * hi);
                    acc[0][ni][4 * g] *= rq * gg.x; acc[0][ni][4 * g + 1] *= rq * gg.y; acc[0][ni][4 * g + 2] *= rq * gg.z; acc[0][ni][4 * g + 3] *= rq * gg.w;
                }
#pragma unroll
            for (int g = 0; g < 2; ++g) {
                const f32x4_t c4 = e_c[g], s4 = e_s[g];
                const float cc[4] = {c4.x, c4.y, c4.z, c4.w}, sn[4] = {s4.x, s4.y, s4.z, s4.w};
#pragma unroll
                for (int j = 0; j < 4; ++j) { const float x1 = acc[0][2][4 * g + j], x2 = acc[0][2][8 + 4 * g + j]; acc[0][2][4 * g + j] = x1 * cc[j] - x2 * sn[j]; acc[0][2][8 + 4 * g + j] = x2 * cc[j] + x1 * sn[j]; }
            }
            unsigned short* qrow = A.q16 + tok * 768 + head * 96;
#pragma unroll
            for (int ni = 0; ni < 3; ++ni)
#pragma unroll
                for (int p = 0; p < 2; ++p) store_pair16(qrow + ni * 32, acc[0][ni], p, hi, MLA_QSCALE);
        }
    }
}
__device__ __forceinline__ void p3_cmp2(unsigned char* lds, const float* __restrict__ hid, const float* __restrict__ cbias, const unsigned short* __restrict__ w2t_k, const unsigned short* __restrict__ w2t_v,
                                        const float* __restrict__ kc_gain, const float* __restrict__ rope, unsigned short* __restrict__ kc16, unsigned short* __restrict__ vct16) {
    if (blockIdx.x >= 128) return;
    const int tid = tid_(); const int lane = tid & 63, w = __builtin_amdgcn_readfirstlane(tid >> 6), r32 = lane & 31, hi = lane >> 5;
    const int task = blockIdx.x; const int mat = task >> 6, rt = task & 63; const long row = rt * 32 + r32;
    const unsigned short* w2t = mat ? w2t_v : w2t_k;
    f32x16 acc[2];
#pragma unroll
    for (int r = 0; r < 16; ++r) { acc[0][r] = 0.f; acc[1][r] = 0.f; }
    f32x4_t hv[2][10]; bf16x8 wf[2][2];
#pragma unroll
    for (int s = 0; s < 2; ++s) {
        const int k0 = (w * 2 + s) * 16 + hi * 8;
        hv[s][0] = *(const f32x4_t*)(cbias + mat * 256 + k0); hv[s][1] = *(const f32x4_t*)(cbias + mat * 256 + k0 + 4);
#pragma unroll
        for (int sp = 0; sp < 4; ++sp) {
            const float* hp = hid + ((long)(mat * 4 + sp) * 2048 + row) * 256 + k0;
            hv[s][2 + 2 * sp] = *(const f32x4_t*)hp; hv[s][3 + 2 * sp] = *(const f32x4_t*)(hp + 4);
        }
        wf[s][0] = *(const bf16x8*)(w2t + (long)r32 * 256 + k0); wf[s][1] = *(const bf16x8*)(w2t + (long)(32 + r32) * 256 + k0);
    }
#pragma unroll
    for (int s = 0; s < 2; ++s) {
        f32x4_t lo = hv[s][0], up = hv[s][1];
#pragma unroll
        for (int sp = 0; sp < 4; ++sp) { lo += hv[s][2 + 2 * sp]; up += hv[s][3 + 2 * sp]; }
        uint4 pk; pk.x = cvtpk(gelu_tanh(lo.x), gelu_tanh(lo.y)); pk.y = cvtpk(gelu_tanh(lo.z), gelu_tanh(lo.w)); pk.z = cvtpk(gelu_tanh(up.x), gelu_tanh(up.y)); pk.w = cvtpk(gelu_tanh(up.z), gelu_tanh(up.w));
        const bf16x8 hf = __builtin_bit_cast(bf16x8, pk);
        acc[0] = MFMA32(wf[s][0], hf, acc[0]); acc[1] = MFMA32(wf[s][1], hf, acc[1]);
    }
    f32x4_t* red = (f32x4_t*)lds;
#pragma unroll
    for (int q = 0; q < 8; ++q) red[(w * 8 + q) * 64 + lane] = f32x4_t{acc[q >> 2][4 * (q & 3)], acc[q >> 2][4 * (q & 3) + 1], acc[q >> 2][4 * (q & 3) + 2], acc[q >> 2][4 * (q & 3) + 3]};
    __syncthreads();
    if (w != 0) return;
#pragma unroll
    for (int q = 0; q < 8; ++q) {
        f32x4_t s = red[q * 64 + lane];
#pragma unroll
        for (int ww = 1; ww < 8; ++ww) s += red[(ww * 8 + q) * 64 + lane];
        acc[q >> 2][4 * (q & 3)] = s.x; acc[q >> 2][4 * (q & 3) + 1] = s.y; acc[q >> 2][4 * (q & 3) + 2] = s.z; acc[q >> 2][4 * (q & 3) + 3] = s.w;
    }
    const int bg = (int)(row >> 9), n = (int)(row & 511); const bool valid = n < NCMP;
    if (mat == 0) {
        if (valid) {
            const long tokp = (long)(bg >> 1) * S_ + 16 * n + 31;
            norm_rope64(acc[0], acc[1], kc_gain, rope + tokp * 48, hi, 1.f);
        } else {
#pragma unroll
            for (int r = 0; r < 16; ++r) { acc[0][r] = 0.f; acc[1][r] = 0.f; }
        }
        store_row64(kc16 + row * 64, acc[0], acc[1], hi);
    } else {
#pragma unroll
        for (int ni = 0; ni < 2; ++ni)
#pragma unroll
            for (int r = 0; r < 16; ++r) {
                const float v = valid ? acc[ni][r] : 0.f;
                const float other = __uint_as_float(__builtin_amdgcn_mov_dpp(__float_as_uint(v), 0xB1, 0xF, 0xF, true));
                if ((lane & 1) == 0) *(unsigned*)(vct16 + ((long)bg * 64 + ni * 32 + crow(r, hi)) * 512 + vperm(n)) = cvtpk(v, other);
            }
    }
}

__device__ __forceinline__ void cvt_stream(const float* __restrict__ in, unsigned short* __restrict__ out, long n, int vb = blockIdx.x, int nb = NBLK) {
    const long nchunk = n >> 3;
    const int tid = tid_();
    for (long c = (long)vb * 512 + tid; c < nchunk; c += (long)nb * 512) {
        const float4 a = ((const float4*)in)[2 * c], b = ((const float4*)in)[2 * c + 1];
        uint4 o; o.x = cvtpk(a.x, a.y); o.y = cvtpk(a.z, a.w); o.z = cvtpk(b.x, b.y); o.w = cvtpk(b.z, b.w);
        ((uint4*)out)[c] = o;
    }
}


typedef unsigned u32x3 __attribute__((ext_vector_type(3)));
typedef unsigned u32x6 __attribute__((ext_vector_type(6)));
typedef float f32x32 __attribute__((ext_vector_type(32)));
constexpr int PROW = 768;
constexpr int PU_SPLIT = 12288;
template <int NR>
__device__ __forceinline__ void cvt_rows_fp6(const float* __restrict__ in, unsigned char* __restrict__ out6, float* __restrict__ scale, int rows, int vb = blockIdx.x, int nb = NBLK) {
    const int tid = tid_(); const int lane = tid & 63, w = __builtin_amdgcn_readfirstlane(tid >> 6);
    const int stride = nb * 8;
    for (int r0 = vb * 8 + w; r0 < rows; r0 += NR * stride) {
        f32x4_t v[NR][4];
#pragma unroll
        for (int j = 0; j < NR; ++j) {
            const int r = min(r0 + j * stride, rows - 1);
            const f32x4_t* p = (const f32x4_t*)(in + (long)r * 1024 + lane * 16);
#pragma unroll
            for (int i = 0; i < 4; ++i) v[j][i] = p[i];
        }
#pragma unroll
        for (int j = 0; j < NR; ++j) {
            const int r = r0 + j * stride;
            if (r < rows) {
                float m = 0.f;
#pragma unroll
                for (int i = 0; i < 4; ++i) m = fmaxf(m, fmaxf(fmaxf(fabsf(v[j][i].x), fabsf(v[j][i].y)), fmaxf(fabsf(v[j][i].z), fabsf(v[j][i].w))));
                m = wmax(m);
                const float q = (m > 0.f) ? 7.5f / m : 1.f;
                const f32x16 ve = {v[j][0].x * q, v[j][0].z * q, v[j][1].x * q, v[j][1].z * q, v[j][2].x * q, v[j][2].z * q, v[j][3].x * q, v[j][3].z * q, 0.f, 0.f, 0.f, 0.f, 0.f, 0.f, 0.f, 0.f};
                const f32x16 vo = {v[j][0].y * q, v[j][0].w * q, v[j][1].y * q, v[j][1].w * q, v[j][2].y * q, v[j][2].w * q, v[j][3].y * q, v[j][3].w * q, 0.f, 0.f, 0.f, 0.f, 0.f, 0.f, 0.f, 0.f};
                const u32x6 pk = __builtin_amdgcn_cvt_scalef32_2xpk16_fp6_f32(ve, vo, 1.0f);
                *(u32x3*)(out6 + (long)r * PROW + lane * 12) = u32x3{pk[0], pk[1], pk[2]};
                if (lane == 0) scale[r] = (m > 0.f) ? m * (1.f / 7.5f) : 1.f;
            }
        }
    }
}
__device__ __forceinline__ f32x32 dec2_fp6(const u32x3& r0, const u32x3& r1) {
    const u32x6 pk = {r0.x, r0.y, r0.z, r1.x, r1.y, r1.z};
    return __builtin_amdgcn_cvt_scalef32_pk32_f32_fp6(pk, 1.0f);
}
__device__ __forceinline__ void peer_sweep_a(const float* __restrict__ hss, const float* __restrict__ g2, const int* __restrict__ eo, const float* __restrict__ go,
                                             const unsigned char* __restrict__ U6, const float* __restrict__ su, const float* __restrict__ sv, const float* __restrict__ h, float* __restrict__ wout) {
    const int tid = tid_(); const int lane = tid & 63, w = __builtin_amdgcn_readfirstlane(tid >> 6);
    const int kcls = ((lane >> 5) & 1) * 4 + ((lane >> 4) & 1) * 2 + ((lane >> 3) & 1);
    for (int t = blockIdx.x * 8 + w; t < T_; t += NBLK * 8) {
        float x[16];
        {
            const float4* xp = (const float4*)(h + (long)t * 1024 + lane * 16); const float4* gp = (const float4*)(g2 + lane * 16); const float4* hp = (const float4*)(hss + (long)t * 16);
            const float4 s0 = hp[0], s1 = hp[1], s2 = hp[2], s3 = hp[3];
            const float rs = rsqrtf((s0.x + s0.y + s0.z + s0.w + s1.x + s1.y + s1.z + s1.w + s2.x + s2.y + s2.z + s2.w + s3.x + s3.y + s3.z + s3.w) * (1.f / 1024.f) + EPS);
#pragma unroll
            for (int k = 0; k < 4; ++k) { const float4 hv = xp[k], gv = gp[k]; x[4 * k] = hv.x * rs * gv.x; x[4 * k + 1] = hv.y * rs * gv.y; x[4 * k + 2] = hv.z * rs * gv.z; x[4 * k + 3] = hv.w * rs * gv.w; }
        }
        const int elo = eo[(long)t * 128 + lane], ehi = eo[(long)t * 128 + 64 + lane];
        const float glo = go[(long)t * 128 + lane], ghi = go[(long)t * 128 + 64 + lane];
        for (int bt = 0; bt < 16; ++bt) {
            int e[8];
#pragma unroll
            for (int k = 0; k < 8; ++k) e[k] = __builtin_amdgcn_readlane(bt < 8 ? elo : ehi, (bt * 8 + k) & 63);
            u32x3 u[8];
#pragma unroll
            for (int k = 0; k < 8; ++k) u[k] = *(const u32x3*)(U6 + (long)e[k] * PROW + lane * 12);
            const int emine = __shfl(bt < 8 ? elo : ehi, (bt * 8 + kcls) & 63);
            const float sum = su[emine], svm = sv[emine];
            const float gk = __shfl(bt < 8 ? glo : ghi, (bt * 8 + kcls) & 63);
            float a[8];
#pragma unroll
            for (int k = 0; k < 8; k += 2) {
                const f32x32 d = dec2_fp6(u[k], u[k + 1]);
                float s0 = 0.f, s1 = 0.f;
#pragma unroll
                for (int i = 0; i < 16; ++i) { s0 = fmaf(d[i], x[i], s0); s1 = fmaf(d[16 + i], x[i], s1); }
                a[k] = s0; a[k + 1] = s1;
            }
            float b4[4], c2[2], d1;
#pragma unroll
            for (int i = 0; i < 4; ++i) {
                auto rr = __builtin_amdgcn_permlane32_swap(__float_as_uint(a[i]), __float_as_uint(a[i + 4]), false, false);
                b4[i] = __uint_as_float(rr[0]) + __uint_as_float(rr[1]);
            }
#pragma unroll
            for (int i = 0; i < 2; ++i) {
                auto rr = __builtin_amdgcn_permlane16_swap(__float_as_uint(b4[i]), __float_as_uint(b4[i + 2]), false, false);
                c2[i] = __uint_as_float(rr[0]) + __uint_as_float(rr[1]);
            }
            { const bool up = (lane & 8) != 0; const float keep = up ? c2[1] : c2[0], send = up ? c2[0] : c2[1];
              d1 = keep + __uint_as_float(__builtin_amdgcn_mov_dpp(__float_as_uint(send), 0x128, 0xF, 0xF, true)); }
            d1 = quad_sum(d1);
            d1 += __uint_as_float(__builtin_amdgcn_mov_dpp(__float_as_uint(d1), 0x141, 0xF, 0xF, true));
            const float wl = gk * gelu_tanh(d1 * sum) * svm;
            if ((lane & 7) == 0) wout[(long)t * 128 + bt * 8 + kcls] = wl;
        }
    }
}
__device__ __forceinline__ void peer_sweep_b(const int* __restrict__ eo, const float* __restrict__ win, const unsigned char* __restrict__ V6, float* out) {
    const int tid = tid_(); const int lane = tid & 63, w = __builtin_amdgcn_readfirstlane(tid >> 6);
    for (int t = blockIdx.x * 8 + w; t < T_; t += NBLK * 8) {
        float y[16];
#pragma unroll
        for (int i = 0; i < 16; ++i) y[i] = 0.f;
        const int elo = eo[(long)t * 128 + lane], ehi = eo[(long)t * 128 + 64 + lane];
        const float wlo = win[(long)t * 128 + lane], whi = win[(long)t * 128 + 64 + lane];
        for (int bt = 0; bt < 16; ++bt) {
            int e[8]; float wk[8];
#pragma unroll
            for (int k = 0; k < 8; ++k) {
                e[k] = __builtin_amdgcn_readlane(bt < 8 ? elo : ehi, (bt * 8 + k) & 63);
                wk[k] = __uint_as_float(__builtin_amdgcn_readlane(__float_as_uint(bt < 8 ? wlo : whi), (bt * 8 + k) & 63));
            }
            u32x3 v[8];
#pragma unroll
            for (int k = 0; k < 8; ++k) v[k] = *(const u32x3*)(V6 + (long)e[k] * PROW + lane * 12);
#pragma unroll
            for (int k = 0; k < 8; k += 2) {
                const f32x32 d = dec2_fp6(v[k], v[k + 1]);
#pragma unroll
                for (int i = 0; i < 16; ++i) y[i] = fmaf(wk[k + 1], d[16 + i], fmaf(wk[k], d[i], y[i]));
            }
        }
        float4* o = (float4*)(out + (long)t * 1024 + lane * 16);
#pragma unroll
        for (int k = 0; k < 4; ++k) { float4 hv = o[k]; hv.x += y[4 * k]; hv.y += y[4 * k + 1]; hv.z += y[4 * k + 2]; hv.w += y[4 * k + 3]; o[k] = hv; }
    }
}

struct Params {
    const float* x; const int* positions; const float* norm1_gain; const float* w_in;
    const float *nsa_q_gain, *nsa_kc_gain, *nsa_ks_gain, *nsa_kw_gain, *cmp_pos, *cmp_k_w1, *cmp_k_w2, *cmp_v_w1, *cmp_v_w2;
    const float *mla_q_lora_gain, *mla_w_uq, *mla_kv_lora_gain, *mla_w_ukv, *mla_q_gain, *mla_k_gain, *out_gain_a, *out_gain_b, *w_out;
    const float *norm2_gain, *peer_w_q, *peer_sub_keys, *peer_u, *peer_v;
    float* out; float* W; unsigned* bar;
};
constexpr int LDS_BYTES = 64 + 256 * 528;
static_assert(LDS_BYTES >= 8 * 3200 * 4 + 64, "naive NSA phase needs 102,464 B");

typedef __attribute__((address_space(4))) const Params* cparams_t;
__device__ __forceinline__ cparams_t params_ptr() {
    cparams_t pp = (cparams_t)__builtin_amdgcn_kernarg_segment_ptr();
    asm volatile("" : "+s"(pp));
    return pp;
}
constexpr long M1 = 1 << 20;
constexpr long F_U8 = 0, F_V8 = 4 * M1, F_SU = 21 * M1 + 3 * M1 / 8, F_SV = F_SU + 16384,
               F_WTIN = 16 * M1, F_WTUQ = 17 * M1, F_WTUKV = 17 * M1 + M1 / 8, F_W1TK = 17 * M1 + M1 / 4, F_W1TV = 17 * M1 + M1 / 2, F_W2TK = 17 * M1 + 3 * M1 / 4,
               F_W2TV = F_W2TK + 8192, F_CBIAS = F_W2TV + 8192, F_WTOUT = 18 * M1, F_WTQ = 18 * M1 + M1 / 2, F_SK16 = 19 * M1 + M1 / 2,
               F_SSQCQ = 19 * M1 + 5 * M1 / 8, F_SSQCKV = F_SSQCQ + 4 * 16384, F_SSQKR = F_SSQCKV + 2 * 16384, F_SSQA = 19 * M1 + 3 * M1 / 4, F_SSQB = F_SSQA + 8 * 16384,
               F_ROPE = 20 * M1, F_GATES = 21 * M1, F_KRR = 21 * M1 + M1 / 2,
               F_XN16 = 22 * M1, F_MIX = 22 * M1,
               F_Q16A = 30 * M1, F_KS16 = 34 * M1, F_KW16 = 35 * M1, F_VST16 = 36 * M1, F_VWT16 = 37 * M1, F_KCMP16 = 38 * M1, F_VCMP16 = 39 * M1 + M1 / 8,
               F_CQ16 = 40 * M1 + M1 / 4, F_CKV16 = 42 * M1 + M1 / 4,
               F_Q16 = 43 * M1 + M1 / 2, F_K16 = 49 * M1 + M1 / 2, F_VT16 = 55 * M1 + M1 / 2, F_HID = 59 * M1 + M1 / 2, F_KC16 = 63 * M1 + M1 / 2, F_VCT16 = F_KC16 + M1 / 8,
               F_HB = 30 * M1, F_HSS = 38 * M1, F_PSS = 38 * M1 + M1 / 2, F_EO = 39 * M1, F_GO = 41 * M1, F_PQB = 43 * M1 + M1 / 2;
static_assert(F_SSQKR + 16384 <= F_SSQA && F_SSQB + 8 * 16384 <= F_ROPE && F_VCT16 + M1 / 8 <= 64 * M1 - 16384 && F_CKV16 + M1 <= F_Q16 && F_PQB + 16 * M1 <= F_HID, "workspace map");

#define G(x) (x)
__global__ __launch_bounds__(512, 2) void mega(Params p_unused) {
    extern __shared__ __attribute__((aligned(16))) unsigned char lds_raw[];
    float* ldsf = (float*)(lds_raw + 64);
    { const unsigned bid_ = blockIdx.x; __builtin_assume(bid_ < (unsigned)NBLK); }
    if (threadIdx.x == 0) *(uint4*)lds_raw = make_uint4(0u, 0u, 0u, 0u);
    __syncthreads();
    XcdBarrier bar = xcd_barrier_post(params_ptr()->bar, (volatile LAS unsigned*)lds_raw);
#define GRID_SYNC() xcd_barrier(bar)
#define U16P(off) ((unsigned short*)(W + (off)))
    { cparams_t p = params_ptr(); float* W = p->W;
      p0_xn_rope(p->x, p->norm1_gain, p->positions, U16P(F_XN16), W + F_ROPE); }
    { cparams_t p = params_ptr(); float* W = p->W;
#define P0_XT(j) ({ const int v_ = (int)blockIdx.x + NBLK * (j); \
        (v_ < 432) ? xt_make(p->w_in, 1024, INW, U16P(F_WTIN), nullptr, nullptr, 0, 2, v_) : \
        (v_ < 480) ? xt_make(p->mla_w_uq, 256, 768, U16P(F_WTUQ), p->mla_q_lora_gain, p->mla_q_lora_gain, 1 << 30, 0, v_ - 432) : \
        (v_ < 512) ? xt_make(p->mla_w_ukv, 128, 1024, U16P(F_WTUKV), p->mla_kv_lora_gain, p->mla_kv_lora_gain, 1 << 30, 0, v_ - 480) : \
        (v_ < 640) ? xt_make(p->cmp_k_w1, 2048, 256, U16P(F_W1TK), nullptr, nullptr, 0, 0, v_ - 512) : \
        (v_ < 768) ? xt_make(p->cmp_v_w1, 2048, 256, U16P(F_W1TV), nullptr, nullptr, 0, 0, v_ - 640) : \
        (v_ < 772) ? xt_make(p->cmp_k_w2, 256, 64, U16P(F_W2TK), nullptr, nullptr, 0, 0, v_ - 768) : \
        (v_ < 776) ? xt_make(p->cmp_v_w2, 256, 64, U16P(F_W2TV), nullptr, nullptr, 0, 0, v_ - 772) : xt_make(nullptr, 64, 64, nullptr, nullptr, nullptr, 0, 0, -1); })
      XT_RUN4(ldsf, P0_XT);
      zero_stream(U16P(F_WTIN) + (long)1720 * 1024, (long)72 * 1024); }
    { cparams_t p = params_ptr(); float* W = p->W;
      p0_cbias(p->cmp_pos, p->cmp_k_w1, p->cmp_v_w1, W + F_CBIAS); }
    GRID_SYNC();
    { cparams_t p = params_ptr(); float* W = p->W;
      P1Out O; O.q16a = U16P(F_Q16A); O.ks16 = U16P(F_KS16); O.kw16 = U16P(F_KW16); O.vst16 = U16P(F_VST16); O.vwt16 = U16P(F_VWT16); O.kcmp16 = U16P(F_KCMP16); O.vcmp16 = U16P(F_VCMP16);
      O.cq16 = U16P(F_CQ16); O.ckv16 = U16P(F_CKV16); O.krr = W + F_KRR; O.ssq_kr = W + F_SSQKR; O.ssq_cq = W + F_SSQCQ; O.ssq_ckv = W + F_SSQCKV; O.gates = W + F_GATES;
      O.rope = W + F_ROPE; O.q_gain = p->nsa_q_gain; O.ks_gain = p->nsa_ks_gain; O.kw_gain = p->nsa_kw_gain; O.k_gain = p->mla_k_gain;
      p1_inproj_256(lds_raw + 64, U16P(F_XN16), U16P(F_WTIN), O); }
    if ((blockIdx.x >> 3) >= 24) {
      cparams_t p = params_ptr(); float* W = p->W;
      cvt_rows_fp6<8>(p->peer_u, (unsigned char*)(W + F_U8), W + F_SU, PU_SPLIT, (int)(blockIdx.x & 7) * 8 + (int)(blockIdx.x >> 3) - 24, 64); }
    GRID_SYNC();
    { cparams_t p = params_ptr(); float* W = p->W;
      P2Args A; A.cq16 = U16P(F_CQ16); A.ckv16 = U16P(F_CKV16); A.wt_uq = U16P(F_WTUQ); A.wt_ukv = U16P(F_WTUKV); A.kcmp16 = U16P(F_KCMP16); A.vcmp16 = U16P(F_VCMP16); A.w1t_k = U16P(F_W1TK); A.w1t_v = U16P(F_W1TV);
      A.ssq_cq = W + F_SSQCQ; A.ssq_ckv = W + F_SSQCKV; A.ssq_kr = W + F_SSQKR; A.krr = W + F_KRR; A.rope = W + F_ROPE; A.q_gain = p->mla_q_gain; A.k_gain = p->mla_k_gain;
      A.q16 = U16P(F_Q16); A.k16 = U16P(F_K16); A.vt16 = U16P(F_VT16); A.hid = W + F_HID;
      p2_phase(lds_raw + 64, A); }
    GRID_SYNC();
    { const int vb = blockIdx.x, nb = NBLK;
      { cparams_t p = params_ptr(); float* W = p->W;
#define P3_XT(j) ({ const int v_ = vb + nb * (j); \
          (v_ < 256) ? xt_make(p->w_out, 1024, 1024, U16P(F_WTOUT), p->out_gain_a, p->out_gain_b, 512, 0, v_) : \
          (v_ < 768) ? xt_make(p->peer_w_q, 1024, 2048, U16P(F_WTQ), p->norm2_gain, p->norm2_gain, 1 << 30, 0, v_ - 256) : xt_make(nullptr, 64, 64, nullptr, nullptr, nullptr, 0, 0, -1); })
        XT_RUN4(ldsf, P3_XT); }
      { cparams_t p = params_ptr(); float* W = p->W;
        p3_cmp2(lds_raw + 64 + 36864, W + F_HID, W + F_CBIAS, U16P(F_W2TK), U16P(F_W2TV), p->nsa_kc_gain, W + F_ROPE, U16P(F_KC16), U16P(F_VCT16)); }
      { cparams_t p = params_ptr(); float* W = p->W;
        cvt_stream(p->peer_sub_keys, U16P(F_SK16), (long)8 * 2 * 128 * 128, vb, nb);
        cvt_rows_fp6<4>(p->peer_v, (unsigned char*)(W + F_V8), W + F_SV, 16384, vb, nb);
        cvt_rows_fp6<2>(p->peer_u + (long)PU_SPLIT * 1024, (unsigned char*)(W + F_U8) + (long)PU_SPLIT * PROW, W + F_SU + PU_SPLIT, 16384 - PU_SPLIT, vb, nb); }
    }
    GRID_SYNC();
    { cparams_t p = params_ptr(); float* W = p->W;
      nsa_phase(lds_raw + 64, U16P(F_Q16A), U16P(F_KC16), U16P(F_VCT16), U16P(F_KS16), U16P(F_VST16), U16P(F_KW16), U16P(F_VWT16), W + F_GATES, U16P(F_MIX), W + F_SSQA); }
    { cparams_t p = params_ptr(); float* W = p->W;
      mla_phase(lds_raw + 64, U16P(F_Q16), U16P(F_K16), U16P(F_VT16), U16P(F_MIX), W + F_SSQB); }
    GRID_SYNC();
    { cparams_t p = params_ptr(); float* W = p->W;
      p5_outproj_256(lds_raw + 64, U16P(F_MIX), U16P(F_WTOUT), W + F_SSQA, W + F_SSQB, p->x, p->out, U16P(F_HB), W + F_HSS); }
    GRID_SYNC();
    { cparams_t p = params_ptr(); float* W = p->W;
      p6_peerq_256(lds_raw + 64, U16P(F_HB), U16P(F_WTQ), W + F_HSS, U16P(F_PQB), W + F_PSS); }
    GRID_SYNC();
    { cparams_t p = params_ptr(); float* W = p->W;
      peer_route_mfma(lds_raw + 64, U16P(F_PQB), W + F_PSS, U16P(F_SK16), (int*)(W + F_EO), W + F_GO); }
    GRID_SYNC();
    { cparams_t p = params_ptr(); float* W = p->W;
      peer_sweep_a(W + F_HSS, p->norm2_gain, (const int*)(W + F_EO), W + F_GO, (const unsigned char*)(W + F_U8), W + F_SU, W + F_SV, p->out, W + F_PQB); }
    GRID_SYNC();
    { cparams_t p = params_ptr(); float* W = p->W;
      peer_sweep_b((const int*)(W + F_EO), W + F_PQB, (const unsigned char*)(W + F_V8), p->out); }
}

extern "C" void kernel_launch(void* const* d_in, const int* in_sizes, int n_in, void* d_out, int out_size, void* d_ws, size_t ws_size, hipStream_t stream) {
    (void)ws_size; (void)in_sizes; (void)n_in; (void)out_size;
    static int grid = 0;
    if (grid == 0) {
        int dev = 0, cus = 0, per_cu = 0;
        (void)hipGetDevice(&dev);
        (void)hipDeviceGetAttribute(&cus, hipDeviceAttributeMultiprocessorCount, dev);
        (void)hipFuncSetAttribute((const void*)mega, hipFuncAttributeMaxDynamicSharedMemorySize, LDS_BYTES);
        (void)hipOccupancyMaxActiveBlocksPerMultiprocessor(&per_cu, (const void*)mega, 512, LDS_BYTES);
        (void)hipGetLastError();
        if (per_cu < 1) fprintf(stderr, "kernel_launch: occupancy query reports %d blocks per CU\n", per_cu);
        if (cus != NBLK) fprintf(stderr, "kernel_launch: built for %d CUs, device reports %d\n", NBLK, cus);
        grid = NBLK;
    }
    Params p{};
    p.x = (const float*)d_in[0]; p.positions = (const int*)d_in[1]; p.norm1_gain = (const float*)d_in[2]; p.w_in = (const float*)d_in[3];
    p.nsa_q_gain = (const float*)d_in[4]; p.nsa_kc_gain = (const float*)d_in[5]; p.nsa_ks_gain = (const float*)d_in[6]; p.nsa_kw_gain = (const float*)d_in[7];
    p.cmp_pos = (const float*)d_in[8]; p.cmp_k_w1 = (const float*)d_in[9]; p.cmp_k_w2 = (const float*)d_in[10]; p.cmp_v_w1 = (const float*)d_in[11]; p.cmp_v_w2 = (const float*)d_in[12];
    p.mla_q_lora_gain = (const float*)d_in[13]; p.mla_w_uq = (const float*)d_in[14]; p.mla_kv_lora_gain = (const float*)d_in[15]; p.mla_w_ukv = (const float*)d_in[16];
    p.mla_q_gain = (const float*)d_in[17]; p.mla_k_gain = (const float*)d_in[18]; p.out_gain_a = (const float*)d_in[19]; p.out_gain_b = (const float*)d_in[20]; p.w_out = (const float*)d_in[21];
    p.norm2_gain = (const float*)d_in[22]; p.peer_w_q = (const float*)d_in[23]; p.peer_sub_keys = (const float*)d_in[24]; p.peer_u = (const float*)d_in[25]; p.peer_v = (const float*)d_in[26];
    p.out = (float*)d_out;
    p.bar = (unsigned*)d_ws;
    p.W = (float*)d_ws + 16384;
    (void)hipMemsetAsync(d_ws, 0, XCD_BAR_WORDS * sizeof(unsigned), stream);
    hipLaunchKernelGGL(mega, dim3(grid), dim3(512), LDS_BYTES, stream, p);
}
```
